# Optimizing an MI355X kernel written in HIP

```python
import jax, jax.numpy as jnp
from jax import lax
import numpy as np

D_MODEL = 1024
BATCH = 8
SEQ = 4096
DEPTH = 2

CHUNK = 64
Q_BLOCK = 128
EPS = 1e-6
HEAD_DIM = 64
FOX_HEADS = 8
FOX_W = FOX_HEADS * HEAD_DIM
SB_HEADS = 8
SB_W = SB_HEADS * HEAD_DIM
MLA_HEADS = 8
MLA_Q_RANK = 384
MLA_KV_RANK = 256
MLA_NOPE = 64
MLA_ROPE = 32
MLA_V = 64
MLA_W = MLA_HEADS * MLA_V
ROPE_BASE = 10000.0
N_BRANCH = 3
D_FF = -(-8 * D_MODEL // (3 * 256)) * 256

SPLIT_WIDTHS = (3 * FOX_W, FOX_HEADS, MLA_Q_RANK, MLA_KV_RANK, MLA_ROPE, 3 * SB_W, N_BRANCH * D_MODEL)
IN_WIDTH = int(sum(SPLIT_WIDTHS))
SPLIT_POINTS = [int(p) for p in np.cumsum(SPLIT_WIDTHS)[:-1]]

kernel_name = "hybrid_fox_mla_stickbreak_gated_encoder"


def rms_norm(x, g):
    xf = x.astype(jnp.float32)
    y = xf * lax.rsqrt(jnp.mean(xf * xf, axis=-1, keepdims=True) + EPS)
    return (y * g.astype(jnp.float32)).astype(x.dtype)


def rope_tables(positions, dim):
    half = dim // 2
    inv = ROPE_BASE ** (-jnp.arange(half, dtype=jnp.float32) / half)
    ang = positions.astype(jnp.float32)[..., None] * inv
    return jnp.cos(ang), jnp.sin(ang)


def apply_rope(x, cos, sin):
    x1, x2 = jnp.split(x.astype(jnp.float32), 2, axis=-1)
    out = jnp.concatenate([x1 * cos - x2 * sin, x1 * sin + x2 * cos], axis=-1)
    return out.astype(x.dtype)


def to_heads(t, n_heads):
    b, s, w = t.shape
    return t.reshape(b, s, n_heads, w // n_heads).transpose(0, 2, 1, 3)


def merge_heads(t):
    b, h, s, d = t.shape
    return t.transpose(0, 2, 1, 3).reshape(b, s, h * d)


def to_blocks(t):
    b, h, s = t.shape[:3]
    t = t.reshape((b, h, s // Q_BLOCK, Q_BLOCK) + t.shape[3:])
    return jnp.moveaxis(t, 2, 0)


def from_blocks(t):
    nb, b, h, qb = t.shape[:4]
    return jnp.moveaxis(t, 0, 2).reshape((b, h, nb * qb) + t.shape[4:])


def fox_attention(q, k, v, log_f):
    s = q.shape[2]
    scale = q.shape[-1] ** -0.5
    cum = jnp.cumsum(log_f, axis=-1)
    kpos = jnp.arange(s)
    starts = jnp.arange(s // Q_BLOCK) * Q_BLOCK

    def block(args):
        qb, fq, start = args
        qpos = start + jnp.arange(Q_BLOCK)
        logits = jnp.einsum('bhqd,bhkd->bhqk', qb, k, preferred_element_type=jnp.float32) * scale
        logits = logits + fq[..., None] - cum[..., None, :]
        logits = jnp.where(kpos[None, :] <= qpos[:, None], logits, -jnp.inf)
        p = jax.nn.softmax(logits, axis=-1)
        return jnp.einsum('bhqk,bhkd->bhqd', p.astype(v.dtype), v)

    return from_blocks(lax.map(block, (to_blocks(q), to_blocks(cum), starts)))


def mla_attention(q_nope, q_rope, k_nope, k_rope, v):
    s = q_nope.shape[2]
    scale = (MLA_NOPE + MLA_ROPE) ** -0.5
    kchunk = jnp.arange(s) // CHUNK
    starts = jnp.arange(s // Q_BLOCK) * Q_BLOCK

    def block(args):
        qn, qr, start = args
        qchunk = (start + jnp.arange(Q_BLOCK)) // CHUNK
        logits = (jnp.einsum('bhqn,bhkn->bhqk', qn, k_nope, preferred_element_type=jnp.float32)
                  + jnp.einsum('bhqr,bkr->bhqk', qr, k_rope, preferred_element_type=jnp.float32)) * scale
        logits = jnp.where(kchunk[None, :] <= qchunk[:, None], logits, -jnp.inf)
        p = jax.nn.softmax(logits, axis=-1)
        return jnp.einsum('bhqk,bhkv->bhqv', p.astype(v.dtype), v)

    return from_blocks(lax.map(block, (to_blocks(q_nope), to_blocks(q_rope), starts)))


def stick_breaking_attention(q, k, v):
    s = q.shape[2]
    scale = q.shape[-1] ** -0.5
    kpos = jnp.arange(s)
    starts = jnp.arange(s // Q_BLOCK) * Q_BLOCK

    def block(args):
        qb, start = args
        qpos = start + jnp.arange(Q_BLOCK)
        mask = kpos[None, :] < qpos[:, None]
        z = jnp.einsum('bhqd,bhkd->bhqk', qb, k, preferred_element_type=jnp.float32) * scale
        log_beta = jax.nn.log_sigmoid(z)
        log_keep = jnp.where(mask, jax.nn.log_sigmoid(-z), 0.0)
        suffix = lax.cumsum(log_keep, axis=3, reverse=True) - log_keep
        a = jnp.where(mask, jnp.exp(log_beta + suffix), 0.0)
        return jnp.einsum('bhqk,bhkd->bhqd', a.astype(v.dtype), v)

    return from_blocks(lax.map(block, (to_blocks(q), starts)))


def setup_inputs(seed: int = 0) -> dict:
    key = jax.random.key(seed)
    ks = jax.random.split(key, 24)

    def nrm(k, shape, fan_in, gain=1.0):
        return jax.random.normal(k, shape, jnp.float32) * (gain * fan_in ** -0.5)

    def gain(k, shape):
        return 1.0 + 0.1 * jax.random.normal(k, shape, jnp.float32)

    x = jax.random.normal(ks[0], (BATCH, SEQ, D_MODEL), jnp.float32)
    c = jax.random.normal(ks[1], (BATCH, D_MODEL), jnp.float32)
    offs = jax.random.randint(ks[2], (BATCH, 1), 0, 10000, dtype=jnp.int32)
    positions = jnp.arange(SEQ, dtype=jnp.int32)[None, :] + offs
    return {
        "x": x,
        "c": c,
        "positions": positions,
        "g_mix": gain(ks[3], (DEPTH, D_MODEL)),
        "w_ada": nrm(ks[4], (DEPTH, D_MODEL, 6 * D_MODEL), D_MODEL, 0.5),
        "b_ada": 0.01 * jax.random.normal(ks[5], (DEPTH, 6 * D_MODEL), jnp.float32),
        "w_in": nrm(ks[6], (DEPTH, D_MODEL, IN_WIDTH), D_MODEL),
        "b_fox_f": jax.random.uniform(ks[7], (DEPTH, FOX_HEADS), jnp.float32, 1.0, 5.0),
        "g_mla_q": gain(ks[8], (DEPTH, MLA_Q_RANK)),
        "w_mla_uq": nrm(ks[9], (DEPTH, MLA_Q_RANK, MLA_HEADS * (MLA_NOPE + MLA_ROPE)), MLA_Q_RANK),
        "g_mla_kv": gain(ks[10], (DEPTH, MLA_KV_RANK)),
        "w_mla_ukv": nrm(ks[11], (DEPTH, MLA_KV_RANK, MLA_HEADS * (MLA_NOPE + MLA_V)), MLA_KV_RANK),
        "w_o_fox": nrm(ks[12], (DEPTH, FOX_W, D_MODEL), FOX_W),
        "w_o_mla": nrm(ks[13], (DEPTH, MLA_W, D_MODEL), MLA_W),
        "w_o_sb": nrm(ks[14], (DEPTH, SB_W, D_MODEL), SB_W),
        "w_out": nrm(ks[15], (DEPTH, D_MODEL, D_MODEL), D_MODEL),
        "g_ffn": gain(ks[16], (DEPTH, D_MODEL)),
        "w_ffn_gate": nrm(ks[17], (DEPTH, D_MODEL, D_FF), D_MODEL),
        "w_ffn_up": nrm(ks[18], (DEPTH, D_MODEL, D_FF), D_MODEL),
        "w_ffn_down": nrm(ks[19], (DEPTH, D_FF, D_MODEL), D_FF),
        "g_final": gain(ks[20], (D_MODEL,)),
    }


def reference(x, c, positions, g_mix, w_ada, b_ada, w_in, b_fox_f, g_mla_q, w_mla_uq, g_mla_kv,
              w_mla_ukv, w_o_fox, w_o_mla, w_o_sb, w_out, g_ffn, w_ffn_gate, w_ffn_up, w_ffn_down,
              g_final):
    b, s, d = x.shape
    cos, sin = rope_tables(positions, MLA_ROPE)
    cond = jax.nn.silu(c)
    for l in range(DEPTH):
        mod = (cond @ w_ada[l] + b_ada[l]).reshape(b, 6, d)
        sh_a, sc_a, gt_a, sh_f, sc_f, gt_f = [mod[:, i, None, :] for i in range(6)]

        u = rms_norm(x, g_mix[l]) * (1 + sc_a) + sh_a
        proj = u @ w_in[l]
        fox_qkv, fox_f, mla_ql, mla_kvl, mla_kr, sb_qkv, gate_logit = jnp.split(proj, SPLIT_POINTS, axis=-1)

        fq, fk, fv = [to_heads(t, FOX_HEADS) for t in jnp.split(fox_qkv, 3, axis=-1)]
        log_f = jax.nn.log_sigmoid((fox_f + b_fox_f[l]).astype(jnp.float32)).transpose(0, 2, 1)
        y_fox = merge_heads(fox_attention(fq, fk, fv, log_f))

        cq = rms_norm(mla_ql, g_mla_q[l])
        q = to_heads(cq @ w_mla_uq[l], MLA_HEADS)
        q_nope = q[..., :MLA_NOPE]
        q_rope = apply_rope(q[..., MLA_NOPE:], cos[:, None], sin[:, None])
        ckv = rms_norm(mla_kvl, g_mla_kv[l])
        kv = to_heads(ckv @ w_mla_ukv[l], MLA_HEADS)
        k_nope, mla_v = kv[..., :MLA_NOPE], kv[..., MLA_NOPE:]
        k_rope = apply_rope(mla_kr, cos, sin)
        y_mla = merge_heads(mla_attention(q_nope, q_rope, k_nope, k_rope, mla_v))

        sq, sk, sv = [to_heads(t, SB_HEADS) for t in jnp.split(sb_qkv, 3, axis=-1)]
        y_sb = merge_heads(stick_breaking_attention(sq, sk, sv))

        g = jax.nn.sigmoid(gate_logit.astype(jnp.float32)).astype(x.dtype).reshape(b, s, N_BRANCH, d)
        merged = (g[:, :, 0] * (y_fox @ w_o_fox[l])
                  + g[:, :, 1] * (y_mla @ w_o_mla[l])
                  + g[:, :, 2] * (y_sb @ w_o_sb[l]))
        x = x + gt_a * (merged @ w_out[l])

        u = rms_norm(x, g_ffn[l]) * (1 + sc_f) + sh_f
        h = jax.nn.silu(u @ w_ffn_gate[l]) * (u @ w_ffn_up[l])
        x = x + gt_f * (h @ w_ffn_down[l])
    return rms_norm(x, g_final)
```

```cpp
#include <hip/hip_runtime.h>
#include <hip/hip_cooperative_groups.h>
#include <cstdint>
#include <cstdio>
namespace cg = cooperative_groups;

#ifndef MEGA
#define MEGA 0
#endif

typedef unsigned short bf16_t;
typedef short bf16x8 __attribute__((ext_vector_type(8)));
typedef float f32x16 __attribute__((ext_vector_type(16)));
typedef float f32x4 __attribute__((ext_vector_type(4)));
typedef unsigned u32x2 __attribute__((ext_vector_type(2)));
#define DI __device__ __forceinline__
#define MFMA(a, b, c) __builtin_amdgcn_mfma_f32_32x32x16_bf16((a), (b), (c), 0, 0, 0)

constexpr int T_TOK = 32768;
constexpr int SEQ = 4096;
constexpr float LOG2E = 1.4426950408889634f;
constexpr float FOX_QS = 0.125f * 1.4426950408889634f;
constexpr float MLA_QS = 0.10206207261596575f * 1.4426950408889634f;
constexpr float EPS = 1e-6f;

constexpr size_t W_IN = 0, W_GATE = 3932160, W_UQ = 7077888, W_UKV = 7372800, W_OF = 7634944, W_OM = 8159232, W_OS = 8683520,
                 W_OUT = 9207808, W_FGU = 10256384, W_FD = 16023552, W_LAYER = 18907136;

constexpr int SMEM_BYTES = 73728 + 1024;

struct Params {
    const float* x; const float* c; const int* pos;
    const float* g_mix; const float* w_ada; const float* b_ada; const float* w_in; const float* b_fox_f;
    const float* g_mla_q; const float* w_mla_uq; const float* g_mla_kv; const float* w_mla_ukv;
    const float* w_o_fox; const float* w_o_mla; const float* w_o_sb; const float* w_out;
    const float* g_ffn; const float* w_ffn_gate; const float* w_ffn_up; const float* w_ffn_down; const float* g_final;
    float* out;
    bf16_t* wt; float* mod; float* ropetab; float* logf; float* cum;
    bf16_t* u; bf16_t* qf; bf16_t* kf; bf16_t* vtf; bf16_t* qs; bf16_t* ks; bf16_t* vts;
    bf16_t* ql; bf16_t* kvl; bf16_t* kr; bf16_t* qn; bf16_t* qr; bf16_t* kn; bf16_t* vtm;
    bf16_t* merged; bf16_t* h;
};

__device__ const float ROPE_INV[16] = {1.0f, 0.5623413324356079f, 0.3162277638912201f, 0.17782793939113617f, 0.10000000149011612f, 0.05623413249850273f,
    0.03162277489900589f, 0.017782794311642647f, 0.009999999776482582f, 0.005623413249850273f, 0.003162277629598975f, 0.0017782794311642647f,
    0.0010000000474974513f, 0.000562341301701963f, 0.0003162277571391314f, 0.00017782794020604342f};

typedef __bf16 bf16x2_t __attribute__((ext_vector_type(2)));
typedef float f32x2_t __attribute__((ext_vector_type(2)));
DI unsigned pack_bf16(float lo, float hi) { const f32x2_t v = {lo, hi}; const bf16x2_t b = __builtin_convertvector(v, bf16x2_t); return __builtin_bit_cast(unsigned, b); }
DI bf16_t f2bf(float x) { return (bf16_t)(pack_bf16(x, 0.f) & 0xffffu); }
DI float fexp2(float x) { return __builtin_amdgcn_exp2f(x); }
DI float flog2(float x) { return __builtin_amdgcn_logf(x); }
DI float frcp(float x) { return __builtin_amdgcn_rcpf(x); }
DI float sigmoidf_(float x) { return frcp(1.0f + fexp2(-x * LOG2E)); }

DI bool next_tile(int it, int MT, int NT, int& mt, int& nt) {
    const int perx = gridDim.x >> 3, xcd = blockIdx.x & 7, slot = blockIdx.x >> 3;
    const long L = ((long)it * 8 + xcd) * perx + slot;
    if (L >= (long)MT * NT) return false;
    const int gsz = 8 * NT; const int grp = (int)(L / gsz), wi = (int)(L % gsz);
    mt = grp * 8 + (wi & 7); nt = wi >> 3; return true;
}

template <int BK>
DI void gemm_mainloop(const bf16_t* __restrict__ A, int lda, const bf16_t* __restrict__ B, int ldb, int K, f32x16 (&acc)[2][2], unsigned char* smem) {
    constexpr int CPR = BK / 8;
    constexpr int RPP = 256 / CPR;
    constexpr int NJ = 128 / RPP;
    constexpr int ROWB = BK * 2 + 16;
    constexpr int OPB = 128 * ROWB;
    constexpr int STB = 2 * OPB;
    const int tid = threadIdx.x, lane = tid & 63, w = tid >> 6, wm = w >> 1, wn = w & 1, r = lane & 31, hh = lane >> 5;
    const int lrow = tid / CPR, lcol = (tid % CPR) * 8;
    const bf16_t* ap = A + (size_t)lrow * lda + lcol;
    const bf16_t* bp = B + (size_t)lrow * ldb + lcol;
    const size_t astep = (size_t)RPP * lda, bstep = (size_t)RPP * ldb;
    uint4 ra[NJ], rb[NJ];
#pragma unroll
    for (int j = 0; j < NJ; ++j) { ra[j] = *(const uint4*)(ap + j * astep); rb[j] = *(const uint4*)(bp + j * bstep); }
    const int st_off = lrow * ROWB + (tid % CPR) * 16;
#pragma unroll
    for (int j = 0; j < NJ; ++j) { *(uint4*)(smem + st_off + j * RPP * ROWB) = ra[j]; *(uint4*)(smem + OPB + st_off + j * RPP * ROWB) = rb[j]; }
    __syncthreads();
    const int nk = K / BK;
    const int rdA = (wm * 64 + r) * ROWB + hh * 16;
    const int rdB = OPB + (wn * 64 + r) * ROWB + hh * 16;
    for (int kt = 0; kt < nk; ++kt) {
        const int buf = kt & 1;
        const bool more = (kt + 1 < nk);
        if (more) {
            ap += BK; bp += BK;
#pragma unroll
            for (int j = 0; j < NJ; ++j) { ra[j] = *(const uint4*)(ap + j * astep); rb[j] = *(const uint4*)(bp + j * bstep); }
        }
        const unsigned char* sa = smem + buf * STB + rdA;
        const unsigned char* sb = smem + buf * STB + rdB;
#pragma unroll
        for (int ks = 0; ks < BK / 16; ++ks) {
            const bf16x8 a0 = *(const bf16x8*)(sa + ks * 32), a1 = *(const bf16x8*)(sa + 32 * ROWB + ks * 32);
            const bf16x8 b0 = *(const bf16x8*)(sb + ks * 32), b1 = *(const bf16x8*)(sb + 32 * ROWB + ks * 32);
            acc[0][0] = MFMA(a0, b0, acc[0][0]); acc[0][1] = MFMA(a0, b1, acc[0][1]);
            acc[1][0] = MFMA(a1, b0, acc[1][0]); acc[1][1] = MFMA(a1, b1, acc[1][1]);
        }
        if (more) {
            unsigned char* d = smem + (buf ^ 1) * STB + st_off;
#pragma unroll
            for (int j = 0; j < NJ; ++j) { *(uint4*)(d + j * RPP * ROWB) = ra[j]; *(uint4*)(d + OPB + j * RPP * ROWB) = rb[j]; }
        }
        __syncthreads();
    }
}

DI void zero_acc(f32x16 (&acc)[2][2]) {
#pragma unroll
    for (int a = 0; a < 2; ++a)
#pragma unroll
        for (int b = 0; b < 2; ++b)
#pragma unroll
            for (int i = 0; i < 16; ++i) acc[a][b][i] = 0.f;
}

DI void stage_store_128(const f32x16 (&acc)[2][2], bf16_t* dst, int ld, unsigned char* smem) {
    const int tid = threadIdx.x, lane = tid & 63, w = tid >> 6, wm = w >> 1, wn = w & 1, r = lane & 31, hh = lane >> 5;
#pragma unroll
    for (int qi = 0; qi < 2; ++qi) {
        unsigned char* trow = smem + (wn * 64 + qi * 32 + r) * 272 + (wm * 64 + 4 * hh) * 2;
#pragma unroll
        for (int pi = 0; pi < 2; ++pi)
#pragma unroll
            for (int g = 0; g < 4; ++g) {
                u32x2 pk; pk.x = pack_bf16(acc[pi][qi][4 * g], acc[pi][qi][4 * g + 1]); pk.y = pack_bf16(acc[pi][qi][4 * g + 2], acc[pi][qi][4 * g + 3]);
                *(u32x2*)(trow + (pi * 32 + 8 * g) * 2) = pk;
            }
    }
    __syncthreads();
    const int q0 = tid >> 4, x = tid & 15;
#pragma unroll
    for (int j = 0; j < 8; ++j) {
        const uint4 v = *(const uint4*)(smem + (q0 + 16 * j) * 272 + x * 16);
        *(uint4*)(dst + (size_t)(q0 + 16 * j) * ld + x * 8) = v;
    }
    __syncthreads();
}
DI void scale_acc(f32x16 (&acc)[2][2], float sc) {
#pragma unroll
    for (int a = 0; a < 2; ++a)
#pragma unroll
        for (int b = 0; b < 2; ++b)
#pragma unroll
            for (int i = 0; i < 16; ++i) acc[a][b][i] *= sc;
}
DI void scale_acc_q(f32x16 (&acc)[2][2], const float* rs, float sc) {
    const int lane = threadIdx.x & 63, wn = (threadIdx.x >> 6) & 1, r = lane & 31;
#pragma unroll
    for (int qi = 0; qi < 2; ++qi) { const float f = rs[wn * 64 + qi * 32 + r] * sc;
#pragma unroll
        for (int pi = 0; pi < 2; ++pi)
#pragma unroll
            for (int i = 0; i < 16; ++i) acc[pi][qi][i] *= f; }
}
DI void scale_acc_p(f32x16 (&acc)[2][2], const float* rs) {
    const int lane = threadIdx.x & 63, wm = threadIdx.x >> 7, hh = lane >> 5;
#pragma unroll
    for (int pi = 0; pi < 2; ++pi)
#pragma unroll
        for (int g = 0; g < 4; ++g) { const f32x4 f = *(const f32x4*)(rs + wm * 64 + pi * 32 + 8 * g + 4 * hh);
#pragma unroll
            for (int qi = 0; qi < 2; ++qi)
#pragma unroll
                for (int e = 0; e < 4; ++e) acc[pi][qi][4 * g + e] *= f[e]; }
}

DI int map_col(int map, int n) {
    switch (map) {
    case 1:
        if (n < 1536) return n;
        if (n < 3072) return 2216 + (n - 1536);
        if (n < 3456) return 1544 + (n - 3072);
        if (n < 3712) return 1928 + (n - 3456);
        { const int c = n - 3712; if (c < 16) return 2184 + c; if (c < 24) return 1536 + (c - 16); if (c < 32) return -1; if (c < 48) return 2200 + (c - 32); return -1; }
    case 2: return 3752 + n;
    case 3:
        if (n < 512) return (n >> 6) * 96 + (n & 63);
        { const int cc = n - 512, tt = cc >> 7, c7 = cc & 127, wn = c7 >> 6, ni = (c7 >> 5) & 1, c = c7 & 31; const int head = tt * 4 + wn * 2 + (c >> 4); return head * 96 + 64 + ni * 16 + (c & 15); }
    case 4:
        if (n < 512) return (n >> 6) * 128 + (n & 63);
        { const int n2 = n - 512; return (n2 >> 6) * 128 + 64 + (n2 & 63); }
    case 5: return (n >> 7) * 64 + ((n >> 6) & 1) * 32 + (n & 31);
    default: return n;
    }
}

DI void transpose_tile(const float* __restrict__ src, const float* __restrict__ src2, int ld, int K, bf16_t* __restrict__ dst, int map, const float* __restrict__ kscale, int n0, int k0, float* tile) {
    const int tid = threadIdx.x, tx = tid & 63, ty = tid >> 6;
    const int sc = map_col(map, n0 + tx);
    if (map == 5 && (((n0 + tx) >> 5) & 1)) src = src2;
#pragma unroll 4
    for (int kk = ty; kk < 64; kk += 4) {
        float v = 0.f;
        if (sc >= 0) { v = src[(size_t)(k0 + kk) * ld + sc]; if (kscale) v *= kscale[k0 + kk]; }
        tile[kk * 65 + tx] = v;
    }
    __syncthreads();
    const int n = tid >> 2, kq = (tid & 3) * 16;
    unsigned wv[8];
#pragma unroll
    for (int j = 0; j < 8; ++j) wv[j] = pack_bf16(tile[(kq + 2 * j) * 65 + n], tile[(kq + 2 * j + 1) * 65 + n]);
    uint4* d = (uint4*)(dst + (size_t)(n0 + n) * K + k0 + kq);
    d[0] = make_uint4(wv[0], wv[1], wv[2], wv[3]);
    d[1] = make_uint4(wv[4], wv[5], wv[6], wv[7]);
    __syncthreads();
}

DI void phase_prep(const Params& p, unsigned char* smem) {
    const int tid = threadIdx.x;
    float* fs = (float*)smem;
    constexpr int NW = 9232, NMOD = 192, NROPE = 2048;
    for (int item = blockIdx.x; item < NW + NMOD + NROPE; item += gridDim.x) {
        if (item < NW) {
            const int l = item / 4616; int ti = item % 4616;
            const float* src; const float* src2 = nullptr; int ld, K, Nd, map; size_t doff; const float* ksc = nullptr;
            if (ti < 960)       { src = p.w_in + (size_t)l * 1024 * 6824; ld = 6824; K = 1024; Nd = 3840; doff = W_IN; map = 1; }
            else if (ti < 1728) { ti -= 960;  src = p.w_in + (size_t)l * 1024 * 6824; ld = 6824; K = 1024; Nd = 3072; doff = W_GATE; map = 2; }
            else if (ti < 1800) { ti -= 1728; src = p.w_mla_uq + (size_t)l * 384 * 768; ld = 768; K = 384; Nd = 768; doff = W_UQ; map = 3; ksc = p.g_mla_q + l * 384; }
            else if (ti < 1864) { ti -= 1800; src = p.w_mla_ukv + (size_t)l * 256 * 1024; ld = 1024; K = 256; Nd = 1024; doff = W_UKV; map = 4; ksc = p.g_mla_kv + l * 256; }
            else if (ti < 1992) { ti -= 1864; src = p.w_o_fox + (size_t)l * 512 * 1024; ld = 1024; K = 512; Nd = 1024; doff = W_OF; map = 0; }
            else if (ti < 2120) { ti -= 1992; src = p.w_o_mla + (size_t)l * 512 * 1024; ld = 1024; K = 512; Nd = 1024; doff = W_OM; map = 0; }
            else if (ti < 2248) { ti -= 2120; src = p.w_o_sb + (size_t)l * 512 * 1024; ld = 1024; K = 512; Nd = 1024; doff = W_OS; map = 0; }
            else if (ti < 2504) { ti -= 2248; src = p.w_out + (size_t)l * 1024 * 1024; ld = 1024; K = 1024; Nd = 1024; doff = W_OUT; map = 0; }
            else if (ti < 3912) { ti -= 2504; src = p.w_ffn_gate + (size_t)l * 1024 * 2816; src2 = p.w_ffn_up + (size_t)l * 1024 * 2816; ld = 2816; K = 1024; Nd = 5632; doff = W_FGU; map = 5; }
            else                { ti -= 3912; src = p.w_ffn_down + (size_t)l * 2816 * 1024; ld = 1024; K = 2816; Nd = 1024; doff = W_FD; map = 0; }
            (void)Nd;
            const int kts = K >> 6; const int ntile = ti / kts, ktile = ti % kts;
            transpose_tile(src, src2, ld, K, p.wt + (size_t)l * W_LAYER + doff, map, ksc, ntile * 64, ktile * 64, fs);
        } else if (item < NW + NMOD) {
            const int mi = item - NW; const int l = mi / 96, c0 = (mi % 96) * 64;
            float* cond = fs;
            float* red = fs + 8192;
            for (int e = tid; e < 8192; e += 256) { const float cv = p.c[e]; cond[e] = cv * sigmoidf_(cv); }
            __syncthreads();
            const int tx = tid & 63, ty = tid >> 6;
            float a0 = 0, a1 = 0, a2 = 0, a3 = 0, a4 = 0, a5 = 0, a6 = 0, a7 = 0;
            const float* wsrc = p.w_ada + (size_t)l * 1024 * 6144 + c0 + tx;
            for (int k = ty * 256; k < ty * 256 + 256; ++k) {
                const float wv = wsrc[(size_t)k * 6144];
                a0 += cond[k] * wv; a1 += cond[1024 + k] * wv; a2 += cond[2048 + k] * wv; a3 += cond[3072 + k] * wv;
                a4 += cond[4096 + k] * wv; a5 += cond[5120 + k] * wv; a6 += cond[6144 + k] * wv; a7 += cond[7168 + k] * wv;
            }
            float* rr = red + ty * 512 + tx;
            rr[0] = a0; rr[64] = a1; rr[128] = a2; rr[192] = a3; rr[256] = a4; rr[320] = a5; rr[384] = a6; rr[448] = a7;
            __syncthreads();
            for (int o = tid; o < 512; o += 256) {
                const int b = o >> 6, xx = o & 63;
                const float s = red[o] + red[512 + o] + red[1024 + o] + red[1536 + o] + p.b_ada[l * 6144 + c0 + xx];
                p.mod[(size_t)(l * 8 + b) * 6144 + c0 + xx] = s;
            }
            __syncthreads();
        } else {
            const int e = (item - NW - NMOD) * 256 + tid;
            const int i = e & 15, tok = e >> 4;
            const float ang = (float)p.pos[tok] * ROPE_INV[i];
            const double a = (double)ang;
            const double kq = rint(a * 0.63661977236758134308);
            const double rr = fma(-kq, 1.57079632679489661923, a);
            const double r2 = rr * rr;
            const double sn = rr * (1.0 + r2 * (-1.0 / 6 + r2 * (1.0 / 120 + r2 * (-1.0 / 5040 + r2 * (1.0 / 362880 + r2 * (-1.0 / 39916800))))));
            const double cs = 1.0 + r2 * (-0.5 + r2 * (1.0 / 24 + r2 * (-1.0 / 720 + r2 * (1.0 / 40320 + r2 * (-1.0 / 3628800 + r2 * (1.0 / 479001600))))));
            const int q = ((int)(long long)kq) & 3;
            const double co = (q == 0) ? cs : (q == 1) ? -sn : (q == 2) ? -cs : sn;
            const double si = (q == 0) ? sn : (q == 1) ? cs : (q == 2) ? -sn : -cs;
            p.ropetab[2 * (size_t)e] = (float)co; p.ropetab[2 * (size_t)e + 1] = (float)si;
        }
    }
}

DI float wave_sum(float v) {
#pragma unroll
    for (int o = 32; o >= 1; o >>= 1) v += __shfl_xor(v, o);
    return v;
}
DI void phase_norm(const float* __restrict__ xin, const float* __restrict__ g, const float* __restrict__ modl, int sh_idx, int sc_idx, bf16_t* __restrict__ uout) {
    const int lane = threadIdx.x & 63, w = threadIdx.x >> 6;
    for (int row = blockIdx.x * 4 + w; row < T_TOK; row += gridDim.x * 4) {
        const int b = row >> 12;
        const f32x4* xr = (const f32x4*)(xin + (size_t)row * 1024);
        f32x4 v[4]; float ss = 0.f;
#pragma unroll
        for (int j = 0; j < 4; ++j) { v[j] = xr[lane + 64 * j]; ss += v[j][0] * v[j][0] + v[j][1] * v[j][1] + v[j][2] * v[j][2] + v[j][3] * v[j][3]; }
        ss = wave_sum(ss);
        const float rstd = rsqrtf(ss * (1.0f / 1024.0f) + EPS);
        const float* mb = modl + (size_t)b * 6144;
#pragma unroll
        for (int j = 0; j < 4; ++j) {
            const int col = 4 * (lane + 64 * j);
            const f32x4 g4 = *(const f32x4*)(g + col), sc4 = *(const f32x4*)(mb + sc_idx * 1024 + col), sh4 = *(const f32x4*)(mb + sh_idx * 1024 + col);
            float y[4];
#pragma unroll
            for (int e = 0; e < 4; ++e) y[e] = (v[j][e] * rstd) * g4[e] * (1.0f + sc4[e]) + sh4[e];
            u32x2 pk; pk.x = pack_bf16(y[0], y[1]); pk.y = pack_bf16(y[2], y[3]);
            *(u32x2*)(uout + (size_t)row * 1024 + col) = pk;
        }
    }
}
DI void phase_final(const Params& p) {
    const int lane = threadIdx.x & 63, w = threadIdx.x >> 6;
    for (int row = blockIdx.x * 4 + w; row < T_TOK; row += gridDim.x * 4) {
        f32x4* xr = (f32x4*)(p.out + (size_t)row * 1024);
        f32x4 v[4]; float ss = 0.f;
#pragma unroll
        for (int j = 0; j < 4; ++j) { v[j] = xr[lane + 64 * j]; ss += v[j][0] * v[j][0] + v[j][1] * v[j][1] + v[j][2] * v[j][2] + v[j][3] * v[j][3]; }
        ss = wave_sum(ss);
        const float rstd = rsqrtf(ss * (1.0f / 1024.0f) + EPS);
#pragma unroll
        for (int j = 0; j < 4; ++j) {
            const f32x4 g4 = *(const f32x4*)(p.g_final + 4 * (lane + 64 * j));
            f32x4 o;
#pragma unroll
            for (int e = 0; e < 4; ++e) o[e] = (v[j][e] * rstd) * g4[e];
            xr[lane + 64 * j] = o;
        }
    }
}

DI void phase_inproj(const Params& p, int l, unsigned char* smem) {
    const int tid = threadIdx.x, lane = tid & 63, w = tid >> 6, wm = w >> 1, wn = w & 1, r = lane & 31, hh = lane >> 5;
    const bf16_t* W = p.wt + (size_t)l * W_LAYER + W_IN;
    for (int it = 0;; ++it) {
        int mt, nt; if (!next_tile(it, 256, 30, mt, nt)) break;
        const int m0 = mt * 128, b = m0 >> 12, s0 = m0 & 4095;
        const bf16_t* Au = p.u + (size_t)m0 * 1024;
        const bf16_t* Bw = W + (size_t)nt * 128 * 1024;
        const bool vt_tile = (nt >= 8 && nt < 12) || (nt >= 20 && nt < 24) || nt == 29;
        f32x16 acc[2][2]; zero_acc(acc);
        gemm_mainloop<64>(vt_tile ? Au : Bw, 1024, vt_tile ? Bw : Au, 1024, 1024, acc, smem);
        if (nt < 4)        { scale_acc(acc, FOX_QS); stage_store_128(acc, p.qf + (size_t)m0 * 512 + nt * 128, 512, smem); }
        else if (nt < 8)   stage_store_128(acc, p.kf + (size_t)m0 * 512 + (nt - 4) * 128, 512, smem);
        else if (nt < 12)  stage_store_128(acc, p.vtf + (size_t)(b * 512 + (nt - 8) * 128) * SEQ + s0, SEQ, smem);
        else if (nt < 16)  { scale_acc(acc, FOX_QS); stage_store_128(acc, p.qs + (size_t)m0 * 512 + (nt - 12) * 128, 512, smem); }
        else if (nt < 20)  stage_store_128(acc, p.ks + (size_t)m0 * 512 + (nt - 16) * 128, 512, smem);
        else if (nt < 24)  stage_store_128(acc, p.vts + (size_t)(b * 512 + (nt - 20) * 128) * SEQ + s0, SEQ, smem);
        else if (nt < 27)  stage_store_128(acc, p.ql + (size_t)m0 * 384 + (nt - 24) * 128, 384, smem);
        else if (nt < 29)  stage_store_128(acc, p.kvl + (size_t)m0 * 256 + (nt - 27) * 128, 256, smem);
        else if (wn == 0) {
#pragma unroll
            for (int mi = 0; mi < 2; ++mi)
#pragma unroll
                for (int i = 0; i < 16; ++i) {
                    const int row = wm * 64 + mi * 32 + 8 * (i >> 2) + 4 * hh + (i & 3);
                    const int t = m0 + row;
                    if (r < 16) {
                        const float x1 = acc[mi][0][i], x2 = acc[mi][1][i];
                        const float co = p.ropetab[2 * (t * 16 + r)], si = p.ropetab[2 * (t * 16 + r) + 1];
                        p.kr[t * 32 + r] = f2bf(x1 * co - x2 * si);
                        p.kr[t * 32 + 16 + r] = f2bf(x1 * si + x2 * co);
                    } else if (r < 24) {
                        const int head = r - 16;
                        const float f = acc[mi][0][i] + p.b_fox_f[l * 8 + head];
                        const float lf = fminf(f, 0.f) - log1pf(expf(-fabsf(f)));
                        p.logf[(b * 8 + head) * SEQ + s0 + row] = lf;
                    }
                }
        }
    }
}

DI void phase_mla_up(const Params& p, int l, unsigned char* smem) {
    const int tid = threadIdx.x, lane = tid & 63, w = tid >> 6, wm = w >> 1, wn = w & 1, r = lane & 31, hh = lane >> 5;
    float* rs = (float*)(smem + 73728);
    const bf16_t* WQ = p.wt + (size_t)l * W_LAYER + W_UQ;
    const bf16_t* WKV = p.wt + (size_t)l * W_LAYER + W_UKV;
    for (int it = 0;; ++it) {
        int mt, nt; if (!next_tile(it, 256, 14, mt, nt)) break;
        const int m0 = mt * 128, b = m0 >> 12, s0 = m0 & 4095;
        const bool isq = nt < 6;
        const int K = isq ? 384 : 256;
        const bf16_t* A = (isq ? p.ql : p.kvl) + (size_t)m0 * K;
        __syncthreads();
        {
            const int row = tid >> 1, half = tid & 1; const int hk = K >> 1;
            const uint4* ar = (const uint4*)(A + (size_t)row * K + half * hk);
            float ss = 0.f;
            for (int j = 0; j < (hk >> 3); ++j) {
                const uint4 v = ar[j];
                const unsigned uu[4] = {v.x, v.y, v.z, v.w};
#pragma unroll
                for (int e = 0; e < 4; ++e) { const float lo = __uint_as_float(uu[e] << 16), hi = __uint_as_float(uu[e] & 0xffff0000u); ss += lo * lo + hi * hi; }
            }
            ss += __shfl_xor(ss, 1);
            if (half == 0) rs[row] = rsqrtf(ss / (float)K + EPS);
        }
        __syncthreads();
        f32x16 acc[2][2]; zero_acc(acc);
        if (isq) {
            const bf16_t* Bw = WQ + (size_t)nt * 128 * 384;
            if (nt < 4) {
                gemm_mainloop<64>(Bw, 384, A, 384, 384, acc, smem);
                scale_acc_q(acc, rs, MLA_QS);
                stage_store_128(acc, p.qn + (size_t)m0 * 512 + nt * 128, 512, smem);
            } else {
                gemm_mainloop<64>(A, 384, Bw, 384, 384, acc, smem);
                const int tt = nt - 4; const int head = tt * 4 + wn * 2 + (r >> 4), ii = r & 15;
#pragma unroll
                for (int mi = 0; mi < 2; ++mi)
#pragma unroll
                    for (int i = 0; i < 16; ++i) {
                        const int row = wm * 64 + mi * 32 + 8 * (i >> 2) + 4 * hh + (i & 3);
                        const int t = m0 + row; const float sc = rs[row] * MLA_QS;
                        const float x1 = acc[mi][0][i] * sc, x2 = acc[mi][1][i] * sc;
                        const float co = p.ropetab[2 * (t * 16 + ii)], si = p.ropetab[2 * (t * 16 + ii) + 1];
                        p.qr[t * 256 + head * 32 + ii] = f2bf(x1 * co - x2 * si);
                        p.qr[t * 256 + head * 32 + 16 + ii] = f2bf(x1 * si + x2 * co);
                    }
            }
        } else {
            const int n2 = nt - 6;
            const bf16_t* Bw = WKV + (size_t)n2 * 128 * 256;
            if (n2 < 4) {
                gemm_mainloop<64>(Bw, 256, A, 256, 256, acc, smem);
                scale_acc_q(acc, rs, 1.0f);
                stage_store_128(acc, p.kn + (size_t)m0 * 512 + n2 * 128, 512, smem);
            } else {
                gemm_mainloop<64>(A, 256, Bw, 256, 256, acc, smem);
                scale_acc_p(acc, rs);
                stage_store_128(acc, p.vtm + (size_t)(b * 512 + (n2 - 4) * 128) * SEQ + s0, SEQ, smem);
            }
        }
    }
    __syncthreads();
    float* fs = (float*)smem;
    for (int bh = blockIdx.x; bh < 64; bh += gridDim.x) {
        const f32x4* src = (const f32x4*)(p.logf + (size_t)bh * SEQ + tid * 16);
        f32x4 v[4];
        float run = 0.f;
#pragma unroll
        for (int j = 0; j < 4; ++j) { v[j] = src[j];
#pragma unroll
            for (int e = 0; e < 4; ++e) { run += v[j][e]; v[j][e] = run; } }
        float incl = run;
#pragma unroll
        for (int o = 1; o < 64; o <<= 1) { const float tv = __shfl_up(incl, o); if (lane >= o) incl += tv; }
        if (lane == 63) fs[w] = incl;
        __syncthreads();
        float pre = incl - run;
        for (int ww = 0; ww < w; ++ww) pre += fs[ww];
        f32x4* dst = (f32x4*)(p.cum + (size_t)bh * SEQ + tid * 16);
#pragma unroll
        for (int j = 0; j < 4; ++j) { f32x4 o;
#pragma unroll
            for (int e = 0; e < 4; ++e) o[e] = v[j][e] + pre; dst[j] = o; }
        __syncthreads();
    }
}

template <int TYPE>
DI void attn_item(const Params& p, int b, int h, int qb, unsigned char* smem) {
    constexpr int DK = (TYPE == 1) ? 96 : 64, KS = DK / 16, KROWB = (DK + 8) * 2, VROWB = 144;
    constexpr int KBYTES = 64 * KROWB, VBYTES = 64 * VROWB, BUFB = KBYTES + VBYTES + 256;
    const int tid = threadIdx.x, lane = tid & 63, w = tid >> 6, r = lane & 31, hh = lane >> 5;
    const int q0 = qb * 128, qw = q0 + 32 * w, myq = qw + r;
    const size_t tokq = (size_t)b * SEQ + myq;
    unsigned* flags = (unsigned*)(smem + 2 * BUFB);

    bf16x8 qfrag[KS];
    if (TYPE == 1) {
#pragma unroll
        for (int ks = 0; ks < 4; ++ks) qfrag[ks] = *(const bf16x8*)(p.qn + tokq * 512 + h * 64 + ks * 16 + hh * 8);
#pragma unroll
        for (int ks = 4; ks < KS; ++ks) qfrag[ks] = *(const bf16x8*)(p.qr + tokq * 256 + h * 32 + (ks - 4) * 16 + hh * 8);
    } else {
        const bf16_t* qg = (TYPE == 0 ? p.qf : p.qs) + tokq * 512 + h * 64;
#pragma unroll
        for (int ks = 0; ks < KS; ++ks) qfrag[ks] = *(const bf16x8*)(qg + ks * 16 + hh * 8);
    }
    const bf16_t* Kg = (TYPE == 0 ? p.kf : TYPE == 1 ? p.kn : p.ks) + (size_t)b * SEQ * 512 + h * 64;
    const bf16_t* Vg = (TYPE == 0 ? p.vtf : TYPE == 1 ? p.vtm : p.vts) + (size_t)(b * 8 + h) * 64 * SEQ;
    const bf16_t* Krg = p.kr + (size_t)b * SEQ * 32;
    const float* cumg = p.cum + (size_t)(b * 8 + h) * SEQ;
    float cq = 0.f;
    if (TYPE == 0) cq = cumg[myq] * LOG2E;

    const int ntiles = 2 * qb + 2;
    uint4 rk0, rk1, rv0, rv1, rkr; float rck = 0.f;
    rkr = make_uint4(0, 0, 0, 0);
    const int ldrow = tid >> 3, ldch = tid & 7;
    const int vpos = 16 * (ldch >> 1) + 4 * (ldch & 1);
#define LOAD_TILE(KT_) do { \
        const int k0_ = (KT_) * 64; \
        rk0 = *(const uint4*)(Kg + (size_t)(k0_ + ldrow) * 512 + ldch * 8); \
        rk1 = *(const uint4*)(Kg + (size_t)(k0_ + 32 + ldrow) * 512 + ldch * 8); \
        rv0 = *(const uint4*)(Vg + (size_t)ldrow * SEQ + k0_ + ldch * 8); \
        rv1 = *(const uint4*)(Vg + (size_t)(32 + ldrow) * SEQ + k0_ + ldch * 8); \
        if (TYPE == 1) rkr = *(const uint4*)(Krg + (size_t)(k0_ + (tid >> 2)) * 32 + (tid & 3) * 8); \
        if (TYPE == 0) { if (tid < 64) rck = cumg[k0_ + tid] * LOG2E; } \
    } while (0)
#define STORE_TILE(BUF_) do { \
        unsigned char* kb_ = smem + (BUF_) * BUFB; unsigned char* vb_ = kb_ + KBYTES; \
        *(uint4*)(kb_ + ldrow * KROWB + ldch * 16) = rk0; \
        *(uint4*)(kb_ + (32 + ldrow) * KROWB + ldch * 16) = rk1; \
        { u32x2 lo, hi; lo.x = rv0.x; lo.y = rv0.y; hi.x = rv0.z; hi.y = rv0.w; \
          *(u32x2*)(vb_ + ldrow * VROWB + vpos * 2) = lo; *(u32x2*)(vb_ + ldrow * VROWB + (vpos + 8) * 2) = hi; } \
        { u32x2 lo, hi; lo.x = rv1.x; lo.y = rv1.y; hi.x = rv1.z; hi.y = rv1.w; \
          *(u32x2*)(vb_ + (32 + ldrow) * VROWB + vpos * 2) = lo; *(u32x2*)(vb_ + (32 + ldrow) * VROWB + (vpos + 8) * 2) = hi; } \
        if (TYPE == 1) *(uint4*)(kb_ + (tid >> 2) * KROWB + 128 + (tid & 3) * 16) = rkr; \
        if (TYPE == 0) { if (tid < 64) *(float*)(vb_ + VBYTES + tid * 4) = rck; } \
    } while (0)

    f32x16 o0, o1;
#pragma unroll
    for (int i = 0; i < 16; ++i) { o0[i] = 0.f; o1[i] = 0.f; }
    float m = -1e30f, lsum = 0.f, carry = 0.f;
    bool wdone = false;

    __syncthreads();
    if (TYPE == 2 && tid < 8) flags[tid] = 0;
    LOAD_TILE(TYPE == 2 ? ntiles - 1 : 0);
    STORE_TILE(0);
    __syncthreads();
    for (int n = 0; n < ntiles; ++n) {
        const int kt = (TYPE == 2) ? (ntiles - 1 - n) : n;
        const int buf = n & 1;
        const bool more = (n + 1 < ntiles);
        if (more) LOAD_TILE(TYPE == 2 ? kt - 1 : kt + 1);
        const unsigned char* kb = smem + buf * BUFB; const unsigned char* vb = kb + KBYTES;
        const int k0 = kt * 64;
        bool need;
        if (TYPE == 0) need = (k0 <= qw + 31);
        else if (TYPE == 1) need = (k0 <= qw);
        else need = (k0 <= qw + 30) && !wdone;
        if (need) {
            f32x16 s0, s1;
#pragma unroll
            for (int i = 0; i < 16; ++i) { s0[i] = 0.f; s1[i] = 0.f; }
#pragma unroll
            for (int ks = 0; ks < KS; ++ks) {
                const bf16x8 a0 = *(const bf16x8*)(kb + r * KROWB + ks * 32 + hh * 16);
                const bf16x8 a1 = *(const bf16x8*)(kb + (32 + r) * KROWB + ks * 32 + hh * 16);
                s0 = MFMA(a0, qfrag[ks], s0); s1 = MFMA(a1, qfrag[ks], s1);
            }
            if (TYPE != 2) {
                if (TYPE == 0) {
                    const float* ck = (const float*)(vb + VBYTES);
#pragma unroll
                    for (int g = 0; g < 4; ++g) {
                        const f32x4 c0 = *(const f32x4*)(ck + 8 * g + 4 * hh), c1 = *(const f32x4*)(ck + 32 + 8 * g + 4 * hh);
#pragma unroll
                        for (int e = 0; e < 4; ++e) { s0[4 * g + e] += cq - c0[e]; s1[4 * g + e] += cq - c1[e]; }
                    }
                    if (k0 + 63 > qw) {
#pragma unroll
                        for (int i = 0; i < 16; ++i) {
                            const int key = k0 + 8 * (i >> 2) + 4 * hh + (i & 3);
                            if (key > myq) s0[i] = -1e30f;
                            if (key + 32 > myq) s1[i] = -1e30f;
                        }
                    }
                }
                float mx = s0[0];
#pragma unroll
                for (int i = 1; i < 16; ++i) mx = fmaxf(mx, s0[i]);
#pragma unroll
                for (int i = 0; i < 16; ++i) mx = fmaxf(mx, s1[i]);
                mx = fmaxf(mx, __shfl_xor(mx, 32));
                const float mnew = fmaxf(m, mx);
                const float alpha = fexp2(m - mnew);
                m = mnew;
                float ps = 0.f;
#pragma unroll
                for (int i = 0; i < 16; ++i) { s0[i] = fexp2(s0[i] - mnew); s1[i] = fexp2(s1[i] - mnew); ps += s0[i] + s1[i]; }
                lsum = lsum * alpha + ps;
#pragma unroll
                for (int i = 0; i < 16; ++i) { o0[i] *= alpha; o1[i] *= alpha; }
            } else {
                const bool diag = (k0 + 63 >= qw);
                float lk0[16], lk1[16];
#pragma unroll
                for (int i = 0; i < 16; ++i) {
                    const int key = k0 + 8 * (i >> 2) + 4 * hh + (i & 3);
                    {
                        const float z = s0[i]; const float sp = flog2(1.0f + fexp2(-fabsf(z)));
                        const float lb = fminf(z, 0.f) - sp; float lk = lb - z; float lbv = lb;
                        if (diag && key >= myq) { lk = 0.f; lbv = -1e30f; }
                        s0[i] = lbv; lk0[i] = lk;
                    }
                    {
                        const float z = s1[i]; const float sp = flog2(1.0f + fexp2(-fabsf(z)));
                        const float lb = fminf(z, 0.f) - sp; float lk = lb - z; float lbv = lb;
                        if (diag && key + 32 >= myq) { lk = 0.f; lbv = -1e30f; }
                        s1[i] = lbv; lk1[i] = lk;
                    }
                }
                float run = carry;
#pragma unroll
                for (int g = 3; g >= 0; --g) {
                    const float G = (lk1[4 * g] + lk1[4 * g + 1]) + (lk1[4 * g + 2] + lk1[4 * g + 3]);
                    const float Gp = __shfl_xor(G, 32);
                    const float base = run + (hh == 0 ? Gp : 0.f);
                    const float e3 = base, e2 = e3 + lk1[4 * g + 3], e1 = e2 + lk1[4 * g + 2], e0 = e1 + lk1[4 * g + 1];
                    s1[4 * g + 3] = fexp2(s1[4 * g + 3] + e3); s1[4 * g + 2] = fexp2(s1[4 * g + 2] + e2);
                    s1[4 * g + 1] = fexp2(s1[4 * g + 1] + e1); s1[4 * g] = fexp2(s1[4 * g] + e0);
                    run += G + Gp;
                }
#pragma unroll
                for (int g = 3; g >= 0; --g) {
                    const float G = (lk0[4 * g] + lk0[4 * g + 1]) + (lk0[4 * g + 2] + lk0[4 * g + 3]);
                    const float Gp = __shfl_xor(G, 32);
                    const float base = run + (hh == 0 ? Gp : 0.f);
                    const float e3 = base, e2 = e3 + lk0[4 * g + 3], e1 = e2 + lk0[4 * g + 2], e0 = e1 + lk0[4 * g + 1];
                    s0[4 * g + 3] = fexp2(s0[4 * g + 3] + e3); s0[4 * g + 2] = fexp2(s0[4 * g + 2] + e2);
                    s0[4 * g + 1] = fexp2(s0[4 * g + 1] + e1); s0[4 * g] = fexp2(s0[4 * g] + e0);
                    run += G + Gp;
                }
                carry = run;
            }
#pragma unroll
            for (int s2 = 0; s2 < 2; ++s2) {
                unsigned pk0[4], pk1[4];
#pragma unroll
                for (int j = 0; j < 4; ++j) { pk0[j] = pack_bf16(s0[8 * s2 + 2 * j], s0[8 * s2 + 2 * j + 1]); pk1[j] = pack_bf16(s1[8 * s2 + 2 * j], s1[8 * s2 + 2 * j + 1]); }
                const uint4 u0 = make_uint4(pk0[0], pk0[1], pk0[2], pk0[3]), u1 = make_uint4(pk1[0], pk1[1], pk1[2], pk1[3]);
                const bf16x8 pf0 = __builtin_bit_cast(bf16x8, u0), pf1 = __builtin_bit_cast(bf16x8, u1);
                const bf16x8 v00 = *(const bf16x8*)(vb + r * VROWB + (16 * s2 + 8 * hh) * 2);
                const bf16x8 v01 = *(const bf16x8*)(vb + (32 + r) * VROWB + (16 * s2 + 8 * hh) * 2);
                const bf16x8 v10 = *(const bf16x8*)(vb + r * VROWB + (32 + 16 * s2 + 8 * hh) * 2);
                const bf16x8 v11 = *(const bf16x8*)(vb + (32 + r) * VROWB + (32 + 16 * s2 + 8 * hh) * 2);
                o0 = MFMA(v00, pf0, o0); o1 = MFMA(v01, pf0, o1);
                o0 = MFMA(v10, pf1, o0); o1 = MFMA(v11, pf1, o1);
            }
        }
        if (more) STORE_TILE(buf ^ 1);
        if (TYPE == 2) {
            wdone = (__all(carry < -170.f) != 0);
            if (lane == 0) flags[(n & 1) * 4 + w] = wdone ? 1u : 0u;
        }
        __syncthreads();
        if (TYPE == 2) {
            const unsigned* ff = flags + (n & 1) * 4;
            const unsigned f = ff[0] & ff[1] & ff[2] & ff[3];
            if (f) break;
        }
    }
    float inv = 1.0f;
    if (TYPE != 2) { const float lt = lsum + __shfl_xor(lsum, 32); inv = frcp(lt); }
    bf16_t* yg = (TYPE == 0 ? p.qf : TYPE == 1 ? p.qn : p.qs) + tokq * 512 + h * 64;
#pragma unroll
    for (int g = 0; g < 4; ++g) {
        u32x2 a, c2;
        a.x = pack_bf16(o0[4 * g] * inv, o0[4 * g + 1] * inv); a.y = pack_bf16(o0[4 * g + 2] * inv, o0[4 * g + 3] * inv);
        c2.x = pack_bf16(o1[4 * g] * inv, o1[4 * g + 1] * inv); c2.y = pack_bf16(o1[4 * g + 2] * inv, o1[4 * g + 3] * inv);
        *(u32x2*)(yg + 8 * g + 4 * hh) = a;
        *(u32x2*)(yg + 32 + 8 * g + 4 * hh) = c2;
    }
}

DI void phase_attn(const Params& p, unsigned char* smem) {
    for (int idx = blockIdx.x; idx < 6144; idx += gridDim.x) {
        if (idx < 4096) {
            const int qb = 31 - (idx >> 7), rem = idx & 127, bh = rem & 63;
            if (rem < 64) attn_item<0>(p, bh >> 3, bh & 7, qb, smem);
            else attn_item<1>(p, bh >> 3, bh & 7, qb, smem);
        } else {
            const int j = idx - 4096; const int qb = 31 - (j >> 6), bh = j & 63;
            attn_item<2>(p, bh >> 3, bh & 7, qb, smem);
        }
    }
}

DI void phase_merge(const Params& p, int l, unsigned char* smem) {
    const bf16_t* WL = p.wt + (size_t)l * W_LAYER;
    unsigned* park = (unsigned*)(smem + 40960) + threadIdx.x;
    for (int it = 0;; ++it) {
        int mt, nt; if (!next_tile(it, 256, 8, mt, nt)) break;
        const int m0 = mt * 128;
        f32x16 mer[2][2]; zero_acc(mer);
#pragma unroll 1
        for (int br = 0; br < 3; ++br) {
            f32x16 acc[2][2]; zero_acc(acc);
            gemm_mainloop<32>(WL + W_GATE + (size_t)(br * 1024 + nt * 128) * 1024, 1024, p.u + (size_t)m0 * 1024, 1024, 1024, acc, smem);
#pragma unroll
            for (int a = 0; a < 2; ++a)
#pragma unroll
                for (int c = 0; c < 2; ++c)
#pragma unroll
                    for (int j = 0; j < 8; ++j) park[((a * 2 + c) * 8 + j) * 256] = pack_bf16(sigmoidf_(acc[a][c][2 * j]), sigmoidf_(acc[a][c][2 * j + 1]));
            zero_acc(acc);
            const bf16_t* Y = (br == 0 ? p.qf : br == 1 ? p.qn : p.qs) + (size_t)m0 * 512;
            const bf16_t* WO = WL + (br == 0 ? W_OF : br == 1 ? W_OM : W_OS) + (size_t)nt * 128 * 512;
            gemm_mainloop<32>(WO, 512, Y, 512, 512, acc, smem);
#pragma unroll
            for (int a = 0; a < 2; ++a)
#pragma unroll
                for (int c = 0; c < 2; ++c)
#pragma unroll
                    for (int j = 0; j < 8; ++j) {
                        const unsigned gv = park[((a * 2 + c) * 8 + j) * 256];
                        const float g0 = __uint_as_float(gv << 16), g1 = __uint_as_float(gv & 0xffff0000u);
                        mer[a][c][2 * j] += g0 * acc[a][c][2 * j]; mer[a][c][2 * j + 1] += g1 * acc[a][c][2 * j + 1];
                    }
        }
        stage_store_128(mer, p.merged + (size_t)m0 * 1024 + nt * 128, 1024, smem);
    }
}

DI void store_residual(const f32x16 (&acc)[2][2], const float* xin, float* xout, const float* gate, int m0, int n0) {
    const int tid = threadIdx.x, lane = tid & 63, w = tid >> 6, wm = w >> 1, wn = w & 1, r = lane & 31, hh = lane >> 5;
#pragma unroll
    for (int ni = 0; ni < 2; ++ni) {
        const int col = n0 + wn * 64 + ni * 32 + r;
        const float gt = gate[col];
#pragma unroll
        for (int mi = 0; mi < 2; ++mi)
#pragma unroll
            for (int i = 0; i < 16; ++i) {
                const int row = m0 + wm * 64 + mi * 32 + 8 * (i >> 2) + 4 * hh + (i & 3);
                const size_t o = (size_t)row * 1024 + col;
                xout[o] = xin[o] + gt * acc[mi][ni][i];
            }
    }
}

DI void phase_outproj(const Params& p, int l, unsigned char* smem) {
    const bf16_t* W = p.wt + (size_t)l * W_LAYER + W_OUT;
    const float* xin = (l == 0) ? p.x : p.out;
    for (int it = 0;; ++it) {
        int mt, nt; if (!next_tile(it, 256, 8, mt, nt)) break;
        const int m0 = mt * 128, b = m0 >> 12;
        f32x16 acc[2][2]; zero_acc(acc);
        gemm_mainloop<64>(p.merged + (size_t)m0 * 1024, 1024, W + (size_t)nt * 128 * 1024, 1024, 1024, acc, smem);
        store_residual(acc, xin, p.out, p.mod + (size_t)(l * 8 + b) * 6144 + 2 * 1024, m0, nt * 128);
    }
}

DI void phase_ffn_up(const Params& p, int l, unsigned char* smem) {
    const int tid = threadIdx.x, lane = tid & 63, w = tid >> 6, wm = w >> 1, wn = w & 1, r = lane & 31, hh = lane >> 5;
    const bf16_t* W = p.wt + (size_t)l * W_LAYER + W_FGU;
    for (int it = 0;; ++it) {
        int mt, nt; if (!next_tile(it, 256, 44, mt, nt)) break;
        const int m0 = mt * 128;
        f32x16 acc[2][2]; zero_acc(acc);
        gemm_mainloop<64>(W + (size_t)nt * 128 * 1024, 1024, p.u + (size_t)m0 * 1024, 1024, 1024, acc, smem);
#pragma unroll
        for (int qi = 0; qi < 2; ++qi) {
            unsigned char* trow = smem + (wn * 64 + qi * 32 + r) * 144 + (wm * 32 + 4 * hh) * 2;
#pragma unroll
            for (int g = 0; g < 4; ++g) {
                float hv[4];
#pragma unroll
                for (int e = 0; e < 4; ++e) { const float gv = acc[0][qi][4 * g + e]; hv[e] = gv * sigmoidf_(gv) * acc[1][qi][4 * g + e]; }
                u32x2 pk; pk.x = pack_bf16(hv[0], hv[1]); pk.y = pack_bf16(hv[2], hv[3]);
                *(u32x2*)(trow + 8 * g * 2) = pk;
            }
        }
        __syncthreads();
        bf16_t* dst = p.h + (size_t)m0 * 2816 + nt * 64;
        const int q0 = tid >> 3, x = tid & 7;
#pragma unroll
        for (int j = 0; j < 4; ++j) {
            const uint4 v = *(const uint4*)(smem + (q0 + 32 * j) * 144 + x * 16);
            *(uint4*)(dst + (size_t)(q0 + 32 * j) * 2816 + x * 8) = v;
        }
        __syncthreads();
    }
}

DI void phase_ffn_down(const Params& p, int l, unsigned char* smem) {
    const bf16_t* W = p.wt + (size_t)l * W_LAYER + W_FD;
    for (int it = 0;; ++it) {
        int mt, nt; if (!next_tile(it, 256, 8, mt, nt)) break;
        const int m0 = mt * 128, b = m0 >> 12;
        f32x16 acc[2][2]; zero_acc(acc);
        gemm_mainloop<64>(p.h + (size_t)m0 * 2816, 2816, W + (size_t)nt * 128 * 2816, 2816, 2816, acc, smem);
        store_residual(acc, p.out, p.out, p.mod + (size_t)(l * 8 + b) * 6144 + 5 * 1024, m0, nt * 128);
    }
}

DI void run_phase(const Params& p, int ph, int l, unsigned char* smem) {
#ifdef ONLY_PH
    if (ph != ONLY_PH) return;
#endif
    switch (ph) {
    case 0: phase_prep(p, smem); break;
    case 1: phase_norm((l == 0) ? p.x : p.out, p.g_mix + l * 1024, p.mod + (size_t)l * 8 * 6144, 0, 1, p.u); break;
    case 2: phase_inproj(p, l, smem); break;
    case 3: phase_mla_up(p, l, smem); break;
    case 4: phase_attn(p, smem); break;
    case 5: phase_merge(p, l, smem); break;
    case 6: phase_outproj(p, l, smem); break;
    case 7: phase_norm(p.out, p.g_ffn + l * 1024, p.mod + (size_t)l * 8 * 6144, 3, 4, p.u); break;
    case 8: phase_ffn_up(p, l, smem); break;
    case 9: phase_ffn_down(p, l, smem); break;
    default: phase_final(p); break;
    }
}

#if MEGA
__global__ void __launch_bounds__(256, 2) mega_kernel(Params p) {
    extern __shared__ __attribute__((aligned(16))) unsigned char smem[];
    cg::grid_group grid = cg::this_grid();
    run_phase(p, 0, 0, smem); grid.sync();
#pragma unroll 1
    for (int l = 0; l < 2; ++l) {
#pragma unroll 1
        for (int ph = 1; ph <= 9; ++ph) { run_phase(p, ph, l, smem); grid.sync(); }
    }
    run_phase(p, 10, 0, smem);
}
#else
__global__ void __launch_bounds__(256, 2) phase_kernel(Params p, int ph, int l) {
    extern __shared__ __attribute__((aligned(16))) unsigned char smem[];
    run_phase(p, ph, l, smem);
}
#endif

extern "C" void kernel_launch(void* const* d_in, const int* in_sizes, int n_in, void* d_out, int out_size, void* d_ws, size_t ws_size, hipStream_t stream) {
    (void)in_sizes; (void)n_in; (void)out_size;
    Params p{};
    p.x = (const float*)d_in[0]; p.c = (const float*)d_in[1]; p.pos = (const int*)d_in[2];
    p.g_mix = (const float*)d_in[3]; p.w_ada = (const float*)d_in[4]; p.b_ada = (const float*)d_in[5]; p.w_in = (const float*)d_in[6]; p.b_fox_f = (const float*)d_in[7];
    p.g_mla_q = (const float*)d_in[8]; p.w_mla_uq = (const float*)d_in[9]; p.g_mla_kv = (const float*)d_in[10]; p.w_mla_ukv = (const float*)d_in[11];
    p.w_o_fox = (const float*)d_in[12]; p.w_o_mla = (const float*)d_in[13]; p.w_o_sb = (const float*)d_in[14]; p.w_out = (const float*)d_in[15];
    p.g_ffn = (const float*)d_in[16]; p.w_ffn_gate = (const float*)d_in[17]; p.w_ffn_up = (const float*)d_in[18]; p.w_ffn_down = (const float*)d_in[19]; p.g_final = (const float*)d_in[20];
    p.out = (float*)d_out;
    unsigned char* ws = (unsigned char*)d_ws; size_t off = 0;
    auto take = [&](size_t bytes) { unsigned char* q = ws + off; off += (bytes + 255) & ~(size_t)255; return q; };
    p.wt = (bf16_t*)take(2 * W_LAYER * 2);
    p.mod = (float*)take(2 * 8 * 6144 * 4);
    p.ropetab = (float*)take((size_t)T_TOK * 16 * 2 * 4);
    p.logf = (float*)take((size_t)64 * SEQ * 4);
    p.cum = (float*)take((size_t)64 * SEQ * 4);
    p.u = (bf16_t*)take((size_t)T_TOK * 1024 * 2);
    p.qf = (bf16_t*)take((size_t)T_TOK * 512 * 2);
    p.kf = (bf16_t*)take((size_t)T_TOK * 512 * 2);
    p.vtf = (bf16_t*)take((size_t)T_TOK * 512 * 2);
    p.qs = (bf16_t*)take((size_t)T_TOK * 512 * 2);
    p.ks = (bf16_t*)take((size_t)T_TOK * 512 * 2);
    p.vts = (bf16_t*)take((size_t)T_TOK * 512 * 2);
    p.ql = (bf16_t*)take((size_t)T_TOK * 384 * 2);
    p.kvl = (bf16_t*)take((size_t)T_TOK * 256 * 2);
    p.kr = (bf16_t*)take((size_t)T_TOK * 32 * 2);
    p.qn = (bf16_t*)take((size_t)T_TOK * 512 * 2);
    p.qr = (bf16_t*)take((size_t)T_TOK * 256 * 2);
    p.kn = (bf16_t*)take((size_t)T_TOK * 512 * 2);
    p.vtm = (bf16_t*)take((size_t)T_TOK * 512 * 2);
    p.merged = p.kf;
    p.h = p.qf;
    if (off > ws_size) { fprintf(stderr, "kernel_launch: workspace too small: need %zu, have %zu\n", off, ws_size); return; }

#if MEGA
    static int grid_blocks = 0;
    if (!grid_blocks) {
        int dev = 0, cus = 0, per_cu = 0;
        hipGetDevice(&dev);
        hipDeviceGetAttribute(&cus, hipDeviceAttributeMultiprocessorCount, dev);
        hipFuncSetAttribute((const void*)mega_kernel, hipFuncAttributeMaxDynamicSharedMemorySize, SMEM_BYTES);
        hipOccupancyMaxActiveBlocksPerMultiprocessor(&per_cu, (const void*)mega_kernel, 256, SMEM_BYTES);
        if (per_cu > 2) per_cu = 2;
        if (per_cu < 1) per_cu = 1;
        grid_blocks = cus * per_cu;
        grid_blocks &= ~7;
    }
    void* args[] = {&p};
    hipError_t e = hipLaunchCooperativeKernel((const void*)mega_kernel, dim3(grid_blocks), dim3(256), args, SMEM_BYTES, stream);
    if (e != hipSuccess) fprintf(stderr, "cooperative launch failed: %s (grid %d)\n", hipGetErrorString(e), grid_blocks);
#else
    static bool attr = false;
    if (!attr) { (void)hipFuncSetAttribute((const void*)phase_kernel, hipFuncAttributeMaxDynamicSharedMemorySize, SMEM_BYTES); attr = true; }
    const int G = 512;
    hipLaunchKernelGGL(phase_kernel, dim3(G), dim3(256), SMEM_BYTES, stream, p, 0, 0);
    for (int l = 0; l < 2; ++l)
        for (int ph = 1; ph <= 9; ++ph) hipLaunchKernelGGL(phase_kernel, dim3(G), dim3(256), SMEM_BYTES, stream, p, ph, l);
    hipLaunchKernelGGL(phase_kernel, dim3(G), dim3(256), SMEM_BYTES, stream, p, 10, 0);
#endif
}
```

```cpp
#include <hip/hip_runtime.h>
#include <hip/hip_cooperative_groups.h>
#include <cstdint>
#include <cstdio>
namespace cg = cooperative_groups;

#ifndef MEGA
#define MEGA 1
#endif

typedef unsigned short bf16_t;
typedef short bf16x8 __attribute__((ext_vector_type(8)));
typedef float f32x16 __attribute__((ext_vector_type(16)));
typedef float f32x4 __attribute__((ext_vector_type(4)));
typedef unsigned u32x2 __attribute__((ext_vector_type(2)));
#define DI __device__ __forceinline__
typedef unsigned u32x4 __attribute__((ext_vector_type(4)));
#define GLOAD16(dst, ptr) asm volatile("global_load_dwordx4 %0, %1, off" : "=v"(dst) : "v"(ptr))
#define GLOAD4(dst, ptr)  asm volatile("global_load_dword %0, %1, off" : "=v"(dst) : "v"(ptr))
#define MFMA(a, b, c) __builtin_amdgcn_mfma_f32_32x32x16_bf16((a), (b), (c), 0, 0, 0)

constexpr int T_TOK = 32768;
constexpr int SEQ = 4096;
constexpr float LOG2E = 1.4426950408889634f;
constexpr float FOX_QS = 0.125f * 1.4426950408889634f;
constexpr float MLA_QS = 0.10206207261596575f * 1.4426950408889634f;
constexpr float EPS = 1e-6f;

constexpr size_t W_IN = 0, W_GATE = 3932160, W_UQ = 7077888, W_UKV = 7372800, W_OF = 7634944, W_OM = 8159232, W_OS = 8683520,
                 W_OUT = 9207808, W_FGU = 10256384, W_FD = 16023552, W_LAYER = 18907136;

constexpr int SMEM_BYTES = 73728 + 1024 + 16;

struct Params {
    const float* x; const float* c; const int* pos;
    const float* g_mix; const float* w_ada; const float* b_ada; const float* w_in; const float* b_fox_f;
    const float* g_mla_q; const float* w_mla_uq; const float* g_mla_kv; const float* w_mla_ukv;
    const float* w_o_fox; const float* w_o_mla; const float* w_o_sb; const float* w_out;
    const float* g_ffn; const float* w_ffn_gate; const float* w_ffn_up; const float* w_ffn_down; const float* g_final;
    float* out;
    bf16_t* wt; float* mod; float* ropetab; float* logf; float* cum;
    bf16_t* u; bf16_t* qf; bf16_t* kf; bf16_t* vtf; bf16_t* qs; bf16_t* ks; bf16_t* vts;
    bf16_t* ql; bf16_t* kvl; bf16_t* kr; bf16_t* qn; bf16_t* qr; bf16_t* kn; bf16_t* vtm;
    bf16_t* merged; bf16_t* h;
    unsigned* bar;
};
typedef const __attribute__((address_space(4))) Params* KargPtr;
#if defined(__HIP_DEVICE_COMPILE__)
__device__ __forceinline__ KargPtr karg() { KargPtr pp = (KargPtr)__builtin_amdgcn_kernarg_segment_ptr(); asm volatile("" : "+s"(pp)); return pp; }
#else
__device__ __forceinline__ KargPtr karg() { return nullptr; }
#endif

__device__ const float ROPE_INV[16] = {1.0f, 0.5623413324356079f, 0.3162277638912201f, 0.17782793939113617f, 0.10000000149011612f, 0.05623413249850273f,
    0.03162277489900589f, 0.017782794311642647f, 0.009999999776482582f, 0.005623413249850273f, 0.003162277629598975f, 0.0017782794311642647f,
    0.0010000000474974513f, 0.000562341301701963f, 0.0003162277571391314f, 0.00017782794020604342f};

typedef __bf16 bf16x2_t __attribute__((ext_vector_type(2)));
typedef float f32x2_t __attribute__((ext_vector_type(2)));
DI unsigned pack_bf16(float lo, float hi) { const f32x2_t v = {lo, hi}; const bf16x2_t b = __builtin_convertvector(v, bf16x2_t); return __builtin_bit_cast(unsigned, b); }
DI bf16_t f2bf(float x) { return (bf16_t)(pack_bf16(x, 0.f) & 0xffffu); }
DI int tidx() { int t = threadIdx.x; asm volatile("" : "+v"(t)); return t; }
DI int bidx() { int t = blockIdx.x; asm volatile("" : "+s"(t)); return t; }
DI int gdim() { int t = gridDim.x; asm volatile("" : "+s"(t)); return t; }
DI float fexp2(float x) { return __builtin_amdgcn_exp2f(x); }
DI float flog2(float x) { return __builtin_amdgcn_logf(x); }
DI float frcp(float x) { return __builtin_amdgcn_rcpf(x); }
DI float sigmoidf_(float x) { return frcp(1.0f + fexp2(-x * LOG2E)); }

DI bool next_tile(int it, int MT, int NT, int& mt, int& nt) {
    const int perx = gdim() >> 3, xcd = bidx() & 7, slot = bidx() >> 3;
    const long L = ((long)it * 8 + xcd) * perx + slot;
    if (L >= (long)MT * NT) return false;
    const int gsz = 8 * NT; const int grp = (int)(L / gsz), wi = (int)(L % gsz);
    mt = grp * 8 + (wi & 7); nt = wi >> 3; return true;
}

template <int BK>
DI void gemm_mainloop(const bf16_t* A, int lda, const bf16_t* B, int ldb, int K, f32x16 (&acc)[2][2], unsigned char* smem) {
    constexpr int CPR = BK / 8;
    constexpr int RPP = 256 / CPR;
    constexpr int NJ = 128 / RPP;
    constexpr int ROWB = BK * 2 + 16;
    constexpr int OPB = 128 * ROWB;
    constexpr int STB = 2 * OPB;
    constexpr int PASSB = RPP * ROWB;
    const int tid = tidx(), lane = tid & 63, w = tid >> 6, wm = w >> 1, wn = w & 1, r = lane & 31, hh = lane >> 5;
    const int lrow = tid / CPR, lcol = (tid % CPR) * 8;
    const bf16_t* ap = A + (size_t)lrow * lda + lcol;
    const bf16_t* bp = B + (size_t)lrow * ldb + lcol;
    const size_t astep = (size_t)RPP * lda, bstep = (size_t)RPP * ldb;
    const int st_off = lrow * ROWB + (tid % CPR) * 16;
    u32x4 ra0, ra1, ra2, ra3, rb0, rb1, rb2, rb3;
    ra0 = *(const u32x4*)(ap); rb0 = *(const u32x4*)(bp);
    ra1 = *(const u32x4*)(ap + astep); rb1 = *(const u32x4*)(bp + bstep);
    if constexpr (NJ == 4) { ra2 = *(const u32x4*)(ap + 2 * astep); rb2 = *(const u32x4*)(bp + 2 * bstep); ra3 = *(const u32x4*)(ap + 3 * astep); rb3 = *(const u32x4*)(bp + 3 * bstep); }
    else { ra2 = ra0; ra3 = ra0; rb2 = rb0; rb3 = rb0; }
#define GEMM_STAGE(D_) do { unsigned char* d_ = (D_); \
        *(u32x4*)(d_) = ra0; *(u32x4*)(d_ + OPB) = rb0; *(u32x4*)(d_ + PASSB) = ra1; *(u32x4*)(d_ + OPB + PASSB) = rb1; \
        if constexpr (NJ == 4) { *(u32x4*)(d_ + 2 * PASSB) = ra2; *(u32x4*)(d_ + OPB + 2 * PASSB) = rb2; *(u32x4*)(d_ + 3 * PASSB) = ra3; *(u32x4*)(d_ + OPB + 3 * PASSB) = rb3; } } while (0)
    GEMM_STAGE(smem + st_off);
    __syncthreads();
    const int nk = K / BK;
    const int rdA = (wm * 64 + r) * ROWB + hh * 16;
    const int rdB = OPB + (wn * 64 + r) * ROWB + hh * 16;
#define GEMM_FRAGS(KS_, A0_, A1_, B0_, B1_) do { \
        A0_ = *(const bf16x8*)(sa + (KS_) * 32); A1_ = *(const bf16x8*)(sa + 32 * ROWB + (KS_) * 32); \
        B0_ = *(const bf16x8*)(sb + (KS_) * 32); B1_ = *(const bf16x8*)(sb + 32 * ROWB + (KS_) * 32); } while (0)
#define GEMM_MFMA4(A0_, A1_, B0_, B1_) do { \
        acc[0][0] = MFMA(A0_, B0_, acc[0][0]); acc[0][1] = MFMA(A0_, B1_, acc[0][1]); \
        acc[1][0] = MFMA(A1_, B0_, acc[1][0]); acc[1][1] = MFMA(A1_, B1_, acc[1][1]); } while (0)
#define GEMM_COMPUTE(BUF_) do { \
        const unsigned char* sa = smem + (BUF_) * STB + rdA; \
        const unsigned char* sb = smem + (BUF_) * STB + rdB; \
        bf16x8 fa0, fa1, fb0, fb1, ga0, ga1, gb0, gb1; \
        GEMM_FRAGS(0, fa0, fa1, fb0, fb1); \
        GEMM_FRAGS(1, ga0, ga1, gb0, gb1); \
        __builtin_amdgcn_sched_barrier(0); \
        GEMM_MFMA4(fa0, fa1, fb0, fb1); \
        if constexpr (BK == 64) { \
            __builtin_amdgcn_sched_barrier(0); \
            GEMM_FRAGS(2, fa0, fa1, fb0, fb1); \
            __builtin_amdgcn_sched_barrier(0); \
            GEMM_MFMA4(ga0, ga1, gb0, gb1); \
            __builtin_amdgcn_sched_barrier(0); \
            GEMM_FRAGS(3, ga0, ga1, gb0, gb1); \
            __builtin_amdgcn_sched_barrier(0); \
            GEMM_MFMA4(fa0, fa1, fb0, fb1); \
        } \
        __builtin_amdgcn_sched_barrier(0); \
        GEMM_MFMA4(ga0, ga1, gb0, gb1); \
    } while (0)
    for (int kt = 0; kt < nk - 1; ++kt) {
        const int buf = kt & 1;
        ap += BK; bp += BK;
        GLOAD16(ra0, ap); GLOAD16(rb0, bp); GLOAD16(ra1, ap + astep); GLOAD16(rb1, bp + bstep);
        if constexpr (NJ == 4) { GLOAD16(ra2, ap + 2 * astep); GLOAD16(rb2, bp + 2 * bstep); GLOAD16(ra3, ap + 3 * astep); GLOAD16(rb3, bp + 3 * bstep); }
        __builtin_amdgcn_sched_barrier(0);
        GEMM_COMPUTE(buf);
        __builtin_amdgcn_sched_barrier(0);
        if constexpr (NJ == 4) asm volatile("s_waitcnt vmcnt(0)" : "+v"(ra0), "+v"(rb0), "+v"(ra1), "+v"(rb1), "+v"(ra2), "+v"(rb2), "+v"(ra3), "+v"(rb3));
        else asm volatile("s_waitcnt vmcnt(0)" : "+v"(ra0), "+v"(rb0), "+v"(ra1), "+v"(rb1));
        GEMM_STAGE(smem + (buf ^ 1) * STB + st_off);
        __syncthreads();
    }
    GEMM_COMPUTE((nk - 1) & 1);
    __syncthreads();
#undef GEMM_COMPUTE
#undef GEMM_MFMA4
#undef GEMM_FRAGS
#undef GEMM_STAGE
}

DI void zero_acc(f32x16 (&acc)[2][2]) {
#pragma unroll
    for (int a = 0; a < 2; ++a)
#pragma unroll
        for (int b = 0; b < 2; ++b)
#pragma unroll
            for (int i = 0; i < 16; ++i) acc[a][b][i] = 0.f;
}

DI void stage_store_128(const f32x16 (&acc)[2][2], bf16_t* dst, int ld, unsigned char* smem) {
    const int tid = tidx(), lane = tid & 63, w = tid >> 6, wm = w >> 1, wn = w & 1, r = lane & 31, hh = lane >> 5;
#pragma unroll
    for (int qi = 0; qi < 2; ++qi) {
        unsigned char* trow = smem + (wn * 64 + qi * 32 + r) * 272 + (wm * 64 + 4 * hh) * 2;
#pragma unroll
        for (int pi = 0; pi < 2; ++pi)
#pragma unroll
            for (int g = 0; g < 4; ++g) {
                u32x2 pk; pk.x = pack_bf16(acc[pi][qi][4 * g], acc[pi][qi][4 * g + 1]); pk.y = pack_bf16(acc[pi][qi][4 * g + 2], acc[pi][qi][4 * g + 3]);
                *(u32x2*)(trow + (pi * 32 + 8 * g) * 2) = pk;
            }
    }
    __syncthreads();
    const int q0 = tid >> 4, x = tid & 15;
#pragma unroll
    for (int j = 0; j < 8; ++j) {
        const uint4 v = *(const uint4*)(smem + (q0 + 16 * j) * 272 + x * 16);
        *(uint4*)(dst + (size_t)(q0 + 16 * j) * ld + x * 8) = v;
    }
    __syncthreads();
}
DI void scale_acc(f32x16 (&acc)[2][2], float sc) {
#pragma unroll
    for (int a = 0; a < 2; ++a)
#pragma unroll
        for (int b = 0; b < 2; ++b)
#pragma unroll
            for (int i = 0; i < 16; ++i) acc[a][b][i] *= sc;
}
DI void scale_acc_q(f32x16 (&acc)[2][2], const float* rs, float sc) {
    const int lane = tidx() & 63, wn = (tidx() >> 6) & 1, r = lane & 31;
#pragma unroll
    for (int qi = 0; qi < 2; ++qi) { const float f = rs[wn * 64 + qi * 32 + r] * sc;
#pragma unroll
        for (int pi = 0; pi < 2; ++pi)
#pragma unroll
            for (int i = 0; i < 16; ++i) acc[pi][qi][i] *= f; }
}
DI void scale_acc_p(f32x16 (&acc)[2][2], const float* rs) {
    const int lane = tidx() & 63, wm = tidx() >> 7, hh = lane >> 5;
#pragma unroll
    for (int pi = 0; pi < 2; ++pi)
#pragma unroll
        for (int g = 0; g < 4; ++g) { const f32x4 f = *(const f32x4*)(rs + wm * 64 + pi * 32 + 8 * g + 4 * hh);
#pragma unroll
            for (int qi = 0; qi < 2; ++qi)
#pragma unroll
                for (int e = 0; e < 4; ++e) acc[pi][qi][4 * g + e] *= f[e]; }
}

DI int map_col(int map, int n) {
    switch (map) {
    case 1:
        if (n < 1536) return n;
        if (n < 3072) return 2216 + (n - 1536);
        if (n < 3456) return 1544 + (n - 3072);
        if (n < 3712) return 1928 + (n - 3456);
        { const int c = n - 3712; if (c < 16) return 2184 + c; if (c < 24) return 1536 + (c - 16); if (c < 32) return -1; if (c < 48) return 2200 + (c - 32); return -1; }
    case 2: return 3752 + n;
    case 3:
        if (n < 512) return (n >> 6) * 96 + (n & 63);
        { const int cc = n - 512, tt = cc >> 7, c7 = cc & 127, wn = c7 >> 6, ni = (c7 >> 5) & 1, c = c7 & 31; const int head = tt * 4 + wn * 2 + (c >> 4); return head * 96 + 64 + ni * 16 + (c & 15); }
    case 4:
        if (n < 512) return (n >> 6) * 128 + (n & 63);
        { const int n2 = n - 512; return (n2 >> 6) * 128 + 64 + (n2 & 63); }
    case 5: return (n >> 7) * 64 + ((n >> 6) & 1) * 32 + (n & 31);
    default: return n;
    }
}

DI void transpose_tile(const float* __restrict__ src, const float* __restrict__ src2, int ld, int K, bf16_t* __restrict__ dst, int map, const float* __restrict__ kscale, int n0, int k0, float* tile) {
    const int tid = tidx(), tx = tid & 63, ty = tid >> 6;
    const int sc = map_col(map, n0 + tx);
    if (map == 5 && (((n0 + tx) >> 5) & 1)) src = src2;
#pragma unroll 4
    for (int kk = ty; kk < 64; kk += 4) {
        float v = 0.f;
        if (sc >= 0) { v = src[(size_t)(k0 + kk) * ld + sc]; if (kscale) v *= kscale[k0 + kk]; }
        tile[kk * 65 + tx] = v;
    }
    __syncthreads();
    const int n = tid >> 2, kq = (tid & 3) * 16;
    unsigned wv[8];
#pragma unroll
    for (int j = 0; j < 8; ++j) wv[j] = pack_bf16(tile[(kq + 2 * j) * 65 + n], tile[(kq + 2 * j + 1) * 65 + n]);
    uint4* d = (uint4*)(dst + (size_t)(n0 + n) * K + k0 + kq);
    d[0] = make_uint4(wv[0], wv[1], wv[2], wv[3]);
    d[1] = make_uint4(wv[4], wv[5], wv[6], wv[7]);
    __syncthreads();
}

DI void phase_prep(KargPtr p, unsigned char* smem) {
    const int tid = tidx();
    float* fs = (float*)smem;
    constexpr int NW = 9232, NMOD = 192, NROPE = 2048;
    for (int item = bidx(); item < NW + NMOD + NROPE; item += gdim()) {
        if (item < NW) {
            const int l = item / 4616; int ti = item % 4616;
            const float* src; const float* src2 = nullptr; int ld, K, Nd, map; size_t doff; const float* ksc = nullptr;
            if (ti < 960)       { src = p->w_in + (size_t)l * 1024 * 6824; ld = 6824; K = 1024; Nd = 3840; doff = W_IN; map = 1; }
            else if (ti < 1728) { ti -= 960;  src = p->w_in + (size_t)l * 1024 * 6824; ld = 6824; K = 1024; Nd = 3072; doff = W_GATE; map = 2; }
            else if (ti < 1800) { ti -= 1728; src = p->w_mla_uq + (size_t)l * 384 * 768; ld = 768; K = 384; Nd = 768; doff = W_UQ; map = 3; ksc = p->g_mla_q + l * 384; }
            else if (ti < 1864) { ti -= 1800; src = p->w_mla_ukv + (size_t)l * 256 * 1024; ld = 1024; K = 256; Nd = 1024; doff = W_UKV; map = 4; ksc = p->g_mla_kv + l * 256; }
            else if (ti < 1992) { ti -= 1864; src = p->w_o_fox + (size_t)l * 512 * 1024; ld = 1024; K = 512; Nd = 1024; doff = W_OF; map = 0; }
            else if (ti < 2120) { ti -= 1992; src = p->w_o_mla + (size_t)l * 512 * 1024; ld = 1024; K = 512; Nd = 1024; doff = W_OM; map = 0; }
            else if (ti < 2248) { ti -= 2120; src = p->w_o_sb + (size_t)l * 512 * 1024; ld = 1024; K = 512; Nd = 1024; doff = W_OS; map = 0; }
            else if (ti < 2504) { ti -= 2248; src = p->w_out + (size_t)l * 1024 * 1024; ld = 1024; K = 1024; Nd = 1024; doff = W_OUT; map = 0; }
            else if (ti < 3912) { ti -= 2504; src = p->w_ffn_gate + (size_t)l * 1024 * 2816; src2 = p->w_ffn_up + (size_t)l * 1024 * 2816; ld = 2816; K = 1024; Nd = 5632; doff = W_FGU; map = 5; }
            else                { ti -= 3912; src = p->w_ffn_down + (size_t)l * 2816 * 1024; ld = 1024; K = 2816; Nd = 1024; doff = W_FD; map = 0; }
            (void)Nd;
            const int kts = K >> 6; const int ntile = ti / kts, ktile = ti % kts;
            transpose_tile(src, src2, ld, K, p->wt + (size_t)l * W_LAYER + doff, map, ksc, ntile * 64, ktile * 64, fs);
        } else if (item < NW + NMOD) {
            const int mi = item - NW; const int l = mi / 96, c0 = (mi % 96) * 64;
            float* cond = fs;
            float* red = fs + 8192;
            for (int e = tid; e < 8192; e += 256) { const float cv = p->c[e]; cond[e] = cv * sigmoidf_(cv); }
            __syncthreads();
            const int tx = tid & 63, ty = tid >> 6;
            float a0 = 0, a1 = 0, a2 = 0, a3 = 0, a4 = 0, a5 = 0, a6 = 0, a7 = 0;
            const float* wsrc = p->w_ada + (size_t)l * 1024 * 6144 + c0 + tx;
            for (int k = ty * 256; k < ty * 256 + 256; ++k) {
                const float wv = wsrc[(size_t)k * 6144];
                a0 += cond[k] * wv; a1 += cond[1024 + k] * wv; a2 += cond[2048 + k] * wv; a3 += cond[3072 + k] * wv;
                a4 += cond[4096 + k] * wv; a5 += cond[5120 + k] * wv; a6 += cond[6144 + k] * wv; a7 += cond[7168 + k] * wv;
            }
            float* rr = red + ty * 512 + tx;
            rr[0] = a0; rr[64] = a1; rr[128] = a2; rr[192] = a3; rr[256] = a4; rr[320] = a5; rr[384] = a6; rr[448] = a7;
            __syncthreads();
            for (int o = tid; o < 512; o += 256) {
                const int b = o >> 6, xx = o & 63;
                const float s = red[o] + red[512 + o] + red[1024 + o] + red[1536 + o] + p->b_ada[l * 6144 + c0 + xx];
                p->mod[(size_t)(l * 8 + b) * 6144 + c0 + xx] = s;
            }
            __syncthreads();
        } else {
            const int e = (item - NW - NMOD) * 256 + tid;
            const int i = e & 15, tok = e >> 4;
            const float ang = (float)p->pos[tok] * ROPE_INV[i];
            const double a = (double)ang;
            const double kq = rint(a * 0.63661977236758134308);
            const double rr = fma(-kq, 1.57079632679489661923, a);
            const double r2 = rr * rr;
            const double sn = rr * (1.0 + r2 * (-1.0 / 6 + r2 * (1.0 / 120 + r2 * (-1.0 / 5040 + r2 * (1.0 / 362880 + r2 * (-1.0 / 39916800))))));
            const double cs = 1.0 + r2 * (-0.5 + r2 * (1.0 / 24 + r2 * (-1.0 / 720 + r2 * (1.0 / 40320 + r2 * (-1.0 / 3628800 + r2 * (1.0 / 479001600))))));
            const int q = ((int)(long long)kq) & 3;
            const double co = (q == 0) ? cs : (q == 1) ? -sn : (q == 2) ? -cs : sn;
            const double si = (q == 0) ? sn : (q == 1) ? cs : (q == 2) ? -sn : -cs;
            p->ropetab[2 * (size_t)e] = (float)co; p->ropetab[2 * (size_t)e + 1] = (float)si;
        }
    }
}

DI float wave_sum(float v) {
#pragma unroll
    for (int o = 32; o >= 1; o >>= 1) v += __shfl_xor(v, o);
    return v;
}
DI void phase_norm(const float* __restrict__ xin, const float* __restrict__ g, const float* __restrict__ modl, int sh_idx, int sc_idx, bf16_t* __restrict__ uout) {
    const int lane = tidx() & 63, w = tidx() >> 6;
    for (int row = bidx() * 4 + w; row < T_TOK; row += gdim() * 4) {
        const int b = row >> 12;
        const f32x4* xr = (const f32x4*)(xin + (size_t)row * 1024);
        f32x4 v[4]; float ss = 0.f;
#pragma unroll
        for (int j = 0; j < 4; ++j) { v[j] = xr[lane + 64 * j]; ss += v[j][0] * v[j][0] + v[j][1] * v[j][1] + v[j][2] * v[j][2] + v[j][3] * v[j][3]; }
        ss = wave_sum(ss);
        const float rstd = rsqrtf(ss * (1.0f / 1024.0f) + EPS);
        const float* mb = modl + (size_t)b * 6144;
#pragma unroll
        for (int j = 0; j < 4; ++j) {
            const int col = 4 * (lane + 64 * j);
            const f32x4 g4 = *(const f32x4*)(g + col), sc4 = *(const f32x4*)(mb + sc_idx * 1024 + col), sh4 = *(const f32x4*)(mb + sh_idx * 1024 + col);
            float y[4];
#pragma unroll
            for (int e = 0; e < 4; ++e) y[e] = (v[j][e] * rstd) * g4[e] * (1.0f + sc4[e]) + sh4[e];
            u32x2 pk; pk.x = pack_bf16(y[0], y[1]); pk.y = pack_bf16(y[2], y[3]);
            *(u32x2*)(uout + (size_t)row * 1024 + col) = pk;
        }
    }
}
DI void phase_final(KargPtr p) {
    const int lane = tidx() & 63, w = tidx() >> 6;
    for (int row = bidx() * 4 + w; row < T_TOK; row += gdim() * 4) {
        f32x4* xr = (f32x4*)(p->out + (size_t)row * 1024);
        f32x4 v[4]; float ss = 0.f;
#pragma unroll
        for (int j = 0; j < 4; ++j) { v[j] = xr[lane + 64 * j]; ss += v[j][0] * v[j][0] + v[j][1] * v[j][1] + v[j][2] * v[j][2] + v[j][3] * v[j][3]; }
        ss = wave_sum(ss);
        const float rstd = rsqrtf(ss * (1.0f / 1024.0f) + EPS);
#pragma unroll
        for (int j = 0; j < 4; ++j) {
            const f32x4 g4 = *(const f32x4*)(p->g_final + 4 * (lane + 64 * j));
            f32x4 o;
#pragma unroll
            for (int e = 0; e < 4; ++e) o[e] = (v[j][e] * rstd) * g4[e];
            xr[lane + 64 * j] = o;
        }
    }
}

DI void phase_inproj(KargPtr p, int l, unsigned char* smem) {
    const int tid = tidx(), lane = tid & 63, w = tid >> 6, wm = w >> 1, wn = w & 1, r = lane & 31, hh = lane >> 5;
    const bf16_t* W = p->wt + (size_t)l * W_LAYER + W_IN;
    for (int it = 0;; ++it) {
        int mt, nt; if (!next_tile(it, 256, 30, mt, nt)) break;
        const int m0 = mt * 128, b = m0 >> 12, s0 = m0 & 4095;
        const bf16_t* Au = p->u + (size_t)m0 * 1024;
        const bf16_t* Bw = W + (size_t)nt * 128 * 1024;
        const bool vt_tile = (nt >= 8 && nt < 12) || (nt >= 20 && nt < 24) || nt == 29;
        f32x16 acc[2][2]; zero_acc(acc);
        gemm_mainloop<64>(vt_tile ? Au : Bw, 1024, vt_tile ? Bw : Au, 1024, 1024, acc, smem);
        if (nt < 4)        { scale_acc(acc, FOX_QS); stage_store_128(acc, p->qf + (size_t)m0 * 512 + nt * 128, 512, smem); }
        else if (nt < 8)   stage_store_128(acc, p->kf + (size_t)m0 * 512 + (nt - 4) * 128, 512, smem);
        else if (nt < 12)  stage_store_128(acc, p->vtf + (size_t)(b * 512 + (nt - 8) * 128) * SEQ + s0, SEQ, smem);
        else if (nt < 16)  { scale_acc(acc, FOX_QS); stage_store_128(acc, p->qs + (size_t)m0 * 512 + (nt - 12) * 128, 512, smem); }
        else if (nt < 20)  stage_store_128(acc, p->ks + (size_t)m0 * 512 + (nt - 16) * 128, 512, smem);
        else if (nt < 24)  stage_store_128(acc, p->vts + (size_t)(b * 512 + (nt - 20) * 128) * SEQ + s0, SEQ, smem);
        else if (nt < 27)  stage_store_128(acc, p->ql + (size_t)m0 * 384 + (nt - 24) * 128, 384, smem);
        else if (nt < 29)  stage_store_128(acc, p->kvl + (size_t)m0 * 256 + (nt - 27) * 128, 256, smem);
        else if (wn == 0) {
#pragma unroll
            for (int mi = 0; mi < 2; ++mi)
#pragma unroll
                for (int i = 0; i < 16; ++i) {
                    const int row = wm * 64 + mi * 32 + 8 * (i >> 2) + 4 * hh + (i & 3);
                    const int t = m0 + row;
                    if (r < 16) {
                        const float x1 = acc[mi][0][i], x2 = acc[mi][1][i];
                        const float co = p->ropetab[2 * (t * 16 + r)], si = p->ropetab[2 * (t * 16 + r) + 1];
                        p->kr[t * 32 + r] = f2bf(x1 * co - x2 * si);
                        p->kr[t * 32 + 16 + r] = f2bf(x1 * si + x2 * co);
                    } else if (r < 24) {
                        const int head = r - 16;
                        const float f = acc[mi][0][i] + p->b_fox_f[l * 8 + head];
                        const float lf = fminf(f, 0.f) - log1pf(expf(-fabsf(f)));
                        p->logf[(b * 8 + head) * SEQ + s0 + row] = lf;
                    }
                }
        }
    }
}

DI void phase_mla_up(KargPtr p, int l, unsigned char* smem) {
    const int tid = tidx(), lane = tid & 63, w = tid >> 6, wm = w >> 1, wn = w & 1, r = lane & 31, hh = lane >> 5;
    float* rs = (float*)(smem + 73728);
    const bf16_t* WQ = p->wt + (size_t)l * W_LAYER + W_UQ;
    const bf16_t* WKV = p->wt + (size_t)l * W_LAYER + W_UKV;
    for (int it = 0;; ++it) {
        int mt, nt; if (!next_tile(it, 256, 14, mt, nt)) break;
        const int m0 = mt * 128, b = m0 >> 12, s0 = m0 & 4095;
        const bool isq = nt < 6;
        const int K = isq ? 384 : 256;
        const bf16_t* A = (isq ? p->ql : p->kvl) + (size_t)m0 * K;
        __syncthreads();
        {
            const int row = tid >> 1, half = tid & 1; const int hk = K >> 1;
            const uint4* ar = (const uint4*)(A + (size_t)row * K + half * hk);
            float ss = 0.f;
            for (int j = 0; j < (hk >> 3); ++j) {
                const uint4 v = ar[j];
                const unsigned uu[4] = {v.x, v.y, v.z, v.w};
#pragma unroll
                for (int e = 0; e < 4; ++e) { const float lo = __uint_as_float(uu[e] << 16), hi = __uint_as_float(uu[e] & 0xffff0000u); ss += lo * lo + hi * hi; }
            }
            ss += __shfl_xor(ss, 1);
            if (half == 0) rs[row] = rsqrtf(ss / (float)K + EPS);
        }
        __syncthreads();
        f32x16 acc[2][2]; zero_acc(acc);
        if (isq) {
            const bf16_t* Bw = WQ + (size_t)nt * 128 * 384;
            if (nt < 4) {
                gemm_mainloop<64>(Bw, 384, A, 384, 384, acc, smem);
                scale_acc_q(acc, rs, MLA_QS);
                stage_store_128(acc, p->qn + (size_t)m0 * 512 + nt * 128, 512, smem);
            } else {
                gemm_mainloop<64>(A, 384, Bw, 384, 384, acc, smem);
                const int tt = nt - 4; const int head = tt * 4 + wn * 2 + (r >> 4), ii = r & 15;
#pragma unroll
                for (int mi = 0; mi < 2; ++mi)
#pragma unroll
                    for (int i = 0; i < 16; ++i) {
                        const int row = wm * 64 + mi * 32 + 8 * (i >> 2) + 4 * hh + (i & 3);
                        const int t = m0 + row; const float sc = rs[row] * MLA_QS;
                        const float x1 = acc[mi][0][i] * sc, x2 = acc[mi][1][i] * sc;
                        const float co = p->ropetab[2 * (t * 16 + ii)], si = p->ropetab[2 * (t * 16 + ii) + 1];
                        p->qr[t * 256 + head * 32 + ii] = f2bf(x1 * co - x2 * si);
                        p->qr[t * 256 + head * 32 + 16 + ii] = f2bf(x1 * si + x2 * co);
                    }
            }
        } else {
            const int n2 = nt - 6;
            const bf16_t* Bw = WKV + (size_t)n2 * 128 * 256;
            if (n2 < 4) {
                gemm_mainloop<64>(Bw, 256, A, 256, 256, acc, smem);
                scale_acc_q(acc, rs, 1.0f);
                stage_store_128(acc, p->kn + (size_t)m0 * 512 + n2 * 128, 512, smem);
            } else {
                gemm_mainloop<64>(A, 256, Bw, 256, 256, acc, smem);
                scale_acc_p(acc, rs);
                stage_store_128(acc, p->vtm + (size_t)(b * 512 + (n2 - 4) * 128) * SEQ + s0, SEQ, smem);
            }
        }
    }
    __syncthreads();
    float* fs = (float*)smem;
    for (int bh = bidx(); bh < 64; bh += gdim()) {
        const f32x4* src = (const f32x4*)(p->logf + (size_t)bh * SEQ + tid * 16);
        f32x4 v[4];
        float run = 0.f;
#pragma unroll
        for (int j = 0; j < 4; ++j) { v[j] = src[j];
#pragma unroll
            for (int e = 0; e < 4; ++e) { run += v[j][e]; v[j][e] = run; } }
        float incl = run;
#pragma unroll
        for (int o = 1; o < 64; o <<= 1) { const float tv = __shfl_up(incl, o); if (lane >= o) incl += tv; }
        if (lane == 63) fs[w] = incl;
        __syncthreads();
        float pre = incl - run;
        for (int ww = 0; ww < w; ++ww) pre += fs[ww];
        f32x4* dst = (f32x4*)(p->cum + (size_t)bh * SEQ + tid * 16);
#pragma unroll
        for (int j = 0; j < 4; ++j) { f32x4 o;
#pragma unroll
            for (int e = 0; e < 4; ++e) o[e] = v[j][e] + pre; dst[j] = o; }
        __syncthreads();
    }
}

template <int TYPE>
DI void attn_item(KargPtr p, int b, int h, int qb, unsigned char* smem) {
    constexpr int DK = (TYPE == 1) ? 96 : 64, KS = DK / 16, KROWB = (DK + 8) * 2, VROWB = 144;
    constexpr int KBYTES = 64 * KROWB, VBYTES = 64 * VROWB, BUFB = KBYTES + VBYTES + 256;
    const int tid = tidx(), lane = tid & 63, w = tid >> 6, r = lane & 31, hh = lane >> 5;
    const int q0 = qb * 128, qw = q0 + 32 * w, myq = qw + r;
    const size_t tokq = (size_t)b * SEQ + myq;
    unsigned* flags = (unsigned*)(smem + 2 * BUFB);

    bf16x8 qfrag[KS];
    if (TYPE == 1) {
#pragma unroll
        for (int ks = 0; ks < 4; ++ks) qfrag[ks] = *(const bf16x8*)(p->qn + tokq * 512 + h * 64 + ks * 16 + hh * 8);
#pragma unroll
        for (int ks = 4; ks < KS; ++ks) qfrag[ks] = *(const bf16x8*)(p->qr + tokq * 256 + h * 32 + (ks - 4) * 16 + hh * 8);
    } else {
        const bf16_t* qg = (TYPE == 0 ? p->qf : p->qs) + tokq * 512 + h * 64;
#pragma unroll
        for (int ks = 0; ks < KS; ++ks) qfrag[ks] = *(const bf16x8*)(qg + ks * 16 + hh * 8);
    }
    const bf16_t* Kg = (TYPE == 0 ? p->kf : TYPE == 1 ? p->kn : p->ks) + (size_t)b * SEQ * 512 + h * 64;
    const bf16_t* Vg = (TYPE == 0 ? p->vtf : TYPE == 1 ? p->vtm : p->vts) + (size_t)(b * 8 + h) * 64 * SEQ;
    const bf16_t* Krg = p->kr + (size_t)b * SEQ * 32;
    const float* cumg = p->cum + (size_t)(b * 8 + h) * SEQ;
    float cq = 0.f;
    if (TYPE == 0) cq = cumg[myq] * LOG2E;

    const int ntiles = 2 * qb + 2;
    u32x4 rk0, rk1, rv0, rv1, rkr; float rck = 0.f;
    rkr = (u32x4){0u, 0u, 0u, 0u};
    const int ldrow = tid >> 3, ldch = tid & 7;
    const int vpos = 16 * (ldch >> 1) + 4 * (ldch & 1);
#define LOAD_TILE(KT_) do { \
        const int k0_ = (KT_) * 64; \
        GLOAD16(rk0, Kg + (size_t)(k0_ + ldrow) * 512 + ldch * 8); \
        GLOAD16(rk1, Kg + (size_t)(k0_ + 32 + ldrow) * 512 + ldch * 8); \
        GLOAD16(rv0, Vg + (size_t)ldrow * SEQ + k0_ + ldch * 8); \
        GLOAD16(rv1, Vg + (size_t)(32 + ldrow) * SEQ + k0_ + ldch * 8); \
        if (TYPE == 1) GLOAD16(rkr, Krg + (size_t)(k0_ + (tid >> 2)) * 32 + (tid & 3) * 8); \
        if (TYPE == 0) GLOAD4(rck, cumg + k0_ + (tid & 63)); \
    } while (0)
#define WAIT_TILE() asm volatile("s_waitcnt vmcnt(0)" : "+v"(rk0), "+v"(rk1), "+v"(rv0), "+v"(rv1), "+v"(rkr), "+v"(rck))
#define STORE_TILE(BUF_) do { \
        unsigned char* kb_ = smem + (BUF_) * BUFB; unsigned char* vb_ = kb_ + KBYTES; \
        *(u32x4*)(kb_ + ldrow * KROWB + ldch * 16) = rk0; \
        *(u32x4*)(kb_ + (32 + ldrow) * KROWB + ldch * 16) = rk1; \
        { u32x2 lo, hi; lo.x = rv0.x; lo.y = rv0.y; hi.x = rv0.z; hi.y = rv0.w; \
          *(u32x2*)(vb_ + ldrow * VROWB + vpos * 2) = lo; *(u32x2*)(vb_ + ldrow * VROWB + (vpos + 8) * 2) = hi; } \
        { u32x2 lo, hi; lo.x = rv1.x; lo.y = rv1.y; hi.x = rv1.z; hi.y = rv1.w; \
          *(u32x2*)(vb_ + (32 + ldrow) * VROWB + vpos * 2) = lo; *(u32x2*)(vb_ + (32 + ldrow) * VROWB + (vpos + 8) * 2) = hi; } \
        if (TYPE == 1) *(u32x4*)(kb_ + (tid >> 2) * KROWB + 128 + (tid & 3) * 16) = rkr; \
        if (TYPE == 0) { if (tid < 64) *(float*)(vb_ + VBYTES + tid * 4) = rck * LOG2E; } \
    } while (0)

    f32x16 o0, o1;
#pragma unroll
    for (int i = 0; i < 16; ++i) { o0[i] = 0.f; o1[i] = 0.f; }
    float m = -1e30f, lsum = 0.f, carry = 0.f;
    bool wdone = false;

    __syncthreads();
    if (TYPE == 2 && tid < 8) flags[tid] = 0;
    LOAD_TILE(TYPE == 2 ? ntiles - 1 : 0);
    WAIT_TILE();
    STORE_TILE(0);
    __syncthreads();
    for (int n = 0; n < ntiles; ++n) {
        const int kt = (TYPE == 2) ? (ntiles - 1 - n) : n;
        const int buf = n & 1;
        const bool more = (n + 1 < ntiles);
        LOAD_TILE(more ? (TYPE == 2 ? kt - 1 : kt + 1) : kt);
        __builtin_amdgcn_sched_barrier(0);
        const unsigned char* kb = smem + buf * BUFB; const unsigned char* vb = kb + KBYTES;
        const int k0 = kt * 64;
        bool need;
        if (TYPE == 0) need = (k0 <= qw + 31);
        else if (TYPE == 1) need = (k0 <= qw);
        else need = (k0 <= qw + 30) && !wdone;
        if (need) {
            f32x16 s0, s1;
#pragma unroll
            for (int i = 0; i < 16; ++i) { s0[i] = 0.f; s1[i] = 0.f; }
#pragma unroll
            for (int ks = 0; ks < KS; ++ks) {
                const bf16x8 a0 = *(const bf16x8*)(kb + r * KROWB + ks * 32 + hh * 16);
                const bf16x8 a1 = *(const bf16x8*)(kb + (32 + r) * KROWB + ks * 32 + hh * 16);
                s0 = MFMA(a0, qfrag[ks], s0); s1 = MFMA(a1, qfrag[ks], s1);
            }
            if (TYPE != 2) {
                if (TYPE == 0) {
                    const float* ck = (const float*)(vb + VBYTES);
#pragma unroll
                    for (int g = 0; g < 4; ++g) {
                        const f32x4 c0 = *(const f32x4*)(ck + 8 * g + 4 * hh), c1 = *(const f32x4*)(ck + 32 + 8 * g + 4 * hh);
#pragma unroll
                        for (int e = 0; e < 4; ++e) { s0[4 * g + e] += cq - c0[e]; s1[4 * g + e] += cq - c1[e]; }
                    }
                    if (k0 + 63 > qw) {
#pragma unroll
                        for (int i = 0; i < 16; ++i) {
                            const int key = k0 + 8 * (i >> 2) + 4 * hh + (i & 3);
                            if (key > myq) s0[i] = -1e30f;
                            if (key + 32 > myq) s1[i] = -1e30f;
                        }
                    }
                }
                float mx = s0[0];
#pragma unroll
                for (int i = 1; i < 16; ++i) mx = fmaxf(mx, s0[i]);
#pragma unroll
                for (int i = 0; i < 16; ++i) mx = fmaxf(mx, s1[i]);
                mx = fmaxf(mx, __shfl_xor(mx, 32));
                const float mnew = fmaxf(m, mx);
                const float alpha = fexp2(m - mnew);
                m = mnew;
                float ps = 0.f;
#pragma unroll
                for (int i = 0; i < 16; ++i) { s0[i] = fexp2(s0[i] - mnew); s1[i] = fexp2(s1[i] - mnew); ps += s0[i] + s1[i]; }
                lsum = lsum * alpha + ps;
#pragma unroll
                for (int i = 0; i < 16; ++i) { o0[i] *= alpha; o1[i] *= alpha; }
            } else {
                const bool diag = (k0 + 63 >= qw);
                float lk0[16], lk1[16];
#pragma unroll
                for (int i = 0; i < 16; ++i) {
                    const int key = k0 + 8 * (i >> 2) + 4 * hh + (i & 3);
                    {
                        const float z = s0[i]; const float sp = flog2(1.0f + fexp2(-fabsf(z)));
                        const float lb = fminf(z, 0.f) - sp; float lk = lb - z; float lbv = lb;
                        if (diag && key >= myq) { lk = 0.f; lbv = -1e30f; }
                        s0[i] = lbv; lk0[i] = lk;
                    }
                    {
                        const float z = s1[i]; const float sp = flog2(1.0f + fexp2(-fabsf(z)));
                        const float lb = fminf(z, 0.f) - sp; float lk = lb - z; float lbv = lb;
                        if (diag && key + 32 >= myq) { lk = 0.f; lbv = -1e30f; }
                        s1[i] = lbv; lk1[i] = lk;
                    }
                }
                float run = carry;
#pragma unroll
                for (int g = 3; g >= 0; --g) {
                    const float G = (lk1[4 * g] + lk1[4 * g + 1]) + (lk1[4 * g + 2] + lk1[4 * g + 3]);
                    const float Gp = __shfl_xor(G, 32);
                    const float base = run + (hh == 0 ? Gp : 0.f);
                    const float e3 = base, e2 = e3 + lk1[4 * g + 3], e1 = e2 + lk1[4 * g + 2], e0 = e1 + lk1[4 * g + 1];
                    s1[4 * g + 3] = fexp2(s1[4 * g + 3] + e3); s1[4 * g + 2] = fexp2(s1[4 * g + 2] + e2);
                    s1[4 * g + 1] = fexp2(s1[4 * g + 1] + e1); s1[4 * g] = fexp2(s1[4 * g] + e0);
                    run += G + Gp;
                }
#pragma unroll
                for (int g = 3; g >= 0; --g) {
                    const float G = (lk0[4 * g] + lk0[4 * g + 1]) + (lk0[4 * g + 2] + lk0[4 * g + 3]);
                    const float Gp = __shfl_xor(G, 32);
                    const float base = run + (hh == 0 ? Gp : 0.f);
                    const float e3 = base, e2 = e3 + lk0[4 * g + 3], e1 = e2 + lk0[4 * g + 2], e0 = e1 + lk0[4 * g + 1];
                    s0[4 * g + 3] = fexp2(s0[4 * g + 3] + e3); s0[4 * g + 2] = fexp2(s0[4 * g + 2] + e2);
                    s0[4 * g + 1] = fexp2(s0[4 * g + 1] + e1); s0[4 * g] = fexp2(s0[4 * g] + e0);
                    run += G + Gp;
                }
                carry = run;
            }
#pragma unroll
            for (int s2 = 0; s2 < 2; ++s2) {
                unsigned pk0[4], pk1[4];
#pragma unroll
                for (int j = 0; j < 4; ++j) { pk0[j] = pack_bf16(s0[8 * s2 + 2 * j], s0[8 * s2 + 2 * j + 1]); pk1[j] = pack_bf16(s1[8 * s2 + 2 * j], s1[8 * s2 + 2 * j + 1]); }
                const uint4 u0 = make_uint4(pk0[0], pk0[1], pk0[2], pk0[3]), u1 = make_uint4(pk1[0], pk1[1], pk1[2], pk1[3]);
                const bf16x8 pf0 = __builtin_bit_cast(bf16x8, u0), pf1 = __builtin_bit_cast(bf16x8, u1);
                const bf16x8 v00 = *(const bf16x8*)(vb + r * VROWB + (16 * s2 + 8 * hh) * 2);
                const bf16x8 v01 = *(const bf16x8*)(vb + (32 + r) * VROWB + (16 * s2 + 8 * hh) * 2);
                const bf16x8 v10 = *(const bf16x8*)(vb + r * VROWB + (32 + 16 * s2 + 8 * hh) * 2);
                const bf16x8 v11 = *(const bf16x8*)(vb + (32 + r) * VROWB + (32 + 16 * s2 + 8 * hh) * 2);
                o0 = MFMA(v00, pf0, o0); o1 = MFMA(v01, pf0, o1);
                o0 = MFMA(v10, pf1, o0); o1 = MFMA(v11, pf1, o1);
            }
        }
        __builtin_amdgcn_sched_barrier(0);
        WAIT_TILE();
        STORE_TILE(buf ^ 1);
        if (TYPE == 2) {
            wdone = (__all(carry < -170.f) != 0);
            if (lane == 0) flags[(n & 1) * 4 + w] = wdone ? 1u : 0u;
        }
        __syncthreads();
        if (TYPE == 2) {
            const unsigned* ff = flags + (n & 1) * 4;
            const unsigned f = ff[0] & ff[1] & ff[2] & ff[3];
            if (f) break;
        }
    }
    float inv = 1.0f;
    if (TYPE != 2) { const float lt = lsum + __shfl_xor(lsum, 32); inv = frcp(lt); }
    bf16_t* yg = (TYPE == 0 ? p->qf : TYPE == 1 ? p->qn : p->qs) + tokq * 512 + h * 64;
#pragma unroll
    for (int g = 0; g < 4; ++g) {
        u32x2 a, c2;
        a.x = pack_bf16(o0[4 * g] * inv, o0[4 * g + 1] * inv); a.y = pack_bf16(o0[4 * g + 2] * inv, o0[4 * g + 3] * inv);
        c2.x = pack_bf16(o1[4 * g] * inv, o1[4 * g + 1] * inv); c2.y = pack_bf16(o1[4 * g + 2] * inv, o1[4 * g + 3] * inv);
        *(u32x2*)(yg + 8 * g + 4 * hh) = a;
        *(u32x2*)(yg + 32 + 8 * g + 4 * hh) = c2;
    }
}

DI void phase_attn(KargPtr p, unsigned char* smem) {
    for (int idx = bidx(); idx < 6144; idx += gdim()) {
        if (idx < 4096) {
            const int qb = 31 - (idx >> 7), rem = idx & 127, bh = rem & 63;
            if (rem < 64) attn_item<0>(p, bh >> 3, bh & 7, qb, smem);
            else attn_item<1>(p, bh >> 3, bh & 7, qb, smem);
        } else {
            const int j = idx - 4096; const int qb = 31 - (j >> 6), bh = j & 63;
            attn_item<2>(p, bh >> 3, bh & 7, qb, smem);
        }
    }
}

DI void phase_merge(KargPtr p, int l, unsigned char* smem) {
    const bf16_t* WL = p->wt + (size_t)l * W_LAYER;
    unsigned* park = (unsigned*)(smem + 40960) + tidx();
    for (int it = 0;; ++it) {
        int mt, nt; if (!next_tile(it, 256, 8, mt, nt)) break;
        const int m0 = mt * 128;
        f32x16 mer[2][2]; zero_acc(mer);
#pragma unroll 1
        for (int br = 0; br < 3; ++br) {
            f32x16 acc[2][2]; zero_acc(acc);
            gemm_mainloop<32>(WL + W_GATE + (size_t)(br * 1024 + nt * 128) * 1024, 1024, p->u + (size_t)m0 * 1024, 1024, 1024, acc, smem);
#pragma unroll
            for (int a = 0; a < 2; ++a)
#pragma unroll
                for (int c = 0; c < 2; ++c)
#pragma unroll
                    for (int j = 0; j < 8; ++j) park[((a * 2 + c) * 8 + j) * 256] = pack_bf16(sigmoidf_(acc[a][c][2 * j]), sigmoidf_(acc[a][c][2 * j + 1]));
            zero_acc(acc);
            const bf16_t* Y = (br == 0 ? p->qf : br == 1 ? p->qn : p->qs) + (size_t)m0 * 512;
            const bf16_t* WO = WL + (br == 0 ? W_OF : br == 1 ? W_OM : W_OS) + (size_t)nt * 128 * 512;
            gemm_mainloop<32>(WO, 512, Y, 512, 512, acc, smem);
#pragma unroll
            for (int a = 0; a < 2; ++a)
#pragma unroll
                for (int c = 0; c < 2; ++c)
#pragma unroll
                    for (int j = 0; j < 8; ++j) {
                        const unsigned gv = park[((a * 2 + c) * 8 + j) * 256];
                        const float g0 = __uint_as_float(gv << 16), g1 = __uint_as_float(gv & 0xffff0000u);
                        mer[a][c][2 * j] += g0 * acc[a][c][2 * j]; mer[a][c][2 * j + 1] += g1 * acc[a][c][2 * j + 1];
                    }
        }
        stage_store_128(mer, p->merged + (size_t)m0 * 1024 + nt * 128, 1024, smem);
    }
}

DI void store_residual(const f32x16 (&acc)[2][2], const float* xin, float* xout, const float* gate, int m0, int n0) {
    const int tid = tidx(), lane = tid & 63, w = tid >> 6, wm = w >> 1, wn = w & 1, r = lane & 31, hh = lane >> 5;
#pragma unroll
    for (int ni = 0; ni < 2; ++ni) {
        const int col = n0 + wn * 64 + ni * 32 + r;
        const float gt = gate[col];
#pragma unroll
        for (int mi = 0; mi < 2; ++mi)
#pragma unroll
            for (int i = 0; i < 16; ++i) {
                const int row = m0 + wm * 64 + mi * 32 + 8 * (i >> 2) + 4 * hh + (i & 3);
                const size_t o = (size_t)row * 1024 + col;
                xout[o] = xin[o] + gt * acc[mi][ni][i];
            }
    }
}

DI void phase_outproj(KargPtr p, int l, unsigned char* smem) {
    const bf16_t* W = p->wt + (size_t)l * W_LAYER + W_OUT;
    const float* xin = (l == 0) ? p->x : p->out;
    for (int it = 0;; ++it) {
        int mt, nt; if (!next_tile(it, 256, 8, mt, nt)) break;
        const int m0 = mt * 128, b = m0 >> 12;
        f32x16 acc[2][2]; zero_acc(acc);
        gemm_mainloop<64>(p->merged + (size_t)m0 * 1024, 1024, W + (size_t)nt * 128 * 1024, 1024, 1024, acc, smem);
        store_residual(acc, xin, p->out, p->mod + (size_t)(l * 8 + b) * 6144 + 2 * 1024, m0, nt * 128);
    }
}

DI void phase_ffn_up(KargPtr p, int l, unsigned char* smem) {
    const int tid = tidx(), lane = tid & 63, w = tid >> 6, wm = w >> 1, wn = w & 1, r = lane & 31, hh = lane >> 5;
    const bf16_t* W = p->wt + (size_t)l * W_LAYER + W_FGU;
    for (int it = 0;; ++it) {
        int mt, nt; if (!next_tile(it, 256, 44, mt, nt)) break;
        const int m0 = mt * 128;
        f32x16 acc[2][2]; zero_acc(acc);
        gemm_mainloop<64>(W + (size_t)nt * 128 * 1024, 1024, p->u + (size_t)m0 * 1024, 1024, 1024, acc, smem);
#pragma unroll
        for (int qi = 0; qi < 2; ++qi) {
            unsigned char* trow = smem + (wn * 64 + qi * 32 + r) * 144 + (wm * 32 + 4 * hh) * 2;
#pragma unroll
            for (int g = 0; g < 4; ++g) {
                float hv[4];
#pragma unroll
                for (int e = 0; e < 4; ++e) { const float gv = acc[0][qi][4 * g + e]; hv[e] = gv * sigmoidf_(gv) * acc[1][qi][4 * g + e]; }
                u32x2 pk; pk.x = pack_bf16(hv[0], hv[1]); pk.y = pack_bf16(hv[2], hv[3]);
                *(u32x2*)(trow + 8 * g * 2) = pk;
            }
        }
        __syncthreads();
        bf16_t* dst = p->h + (size_t)m0 * 2816 + nt * 64;
        const int q0 = tid >> 3, x = tid & 7;
#pragma unroll
        for (int j = 0; j < 4; ++j) {
            const uint4 v = *(const uint4*)(smem + (q0 + 32 * j) * 144 + x * 16);
            *(uint4*)(dst + (size_t)(q0 + 32 * j) * 2816 + x * 8) = v;
        }
        __syncthreads();
    }
}

DI void phase_ffn_down(KargPtr p, int l, unsigned char* smem) {
    const bf16_t* W = p->wt + (size_t)l * W_LAYER + W_FD;
    for (int it = 0;; ++it) {
        int mt, nt; if (!next_tile(it, 256, 8, mt, nt)) break;
        const int m0 = mt * 128, b = m0 >> 12;
        f32x16 acc[2][2]; zero_acc(acc);
        gemm_mainloop<64>(p->h + (size_t)m0 * 2816, 2816, W + (size_t)nt * 128 * 2816, 2816, 2816, acc, smem);
        store_residual(acc, p->out, p->out, p->mod + (size_t)(l * 8 + b) * 6144 + 5 * 1024, m0, nt * 128);
    }
}

DI void run_phase(int ph, int l, unsigned char* smem) {
#ifdef ONLY_PH
    if (ph != ONLY_PH) return;
#endif
    KargPtr p = karg();
    switch (ph) {
    case 0: phase_prep(p, smem); break;
    case 1: phase_norm((l == 0) ? p->x : p->out, p->g_mix + l * 1024, p->mod + (size_t)l * 8 * 6144, 0, 1, p->u); break;
    case 2: phase_inproj(p, l, smem); break;
    case 3: phase_mla_up(p, l, smem); break;
    case 4: phase_attn(p, smem); break;
    case 5: phase_merge(p, l, smem); break;
    case 6: phase_outproj(p, l, smem); break;
    case 7: phase_norm(p->out, p->g_ffn + l * 1024, p->mod + (size_t)l * 8 * 6144, 3, 4, p->u); break;
    case 8: phase_ffn_up(p, l, smem); break;
    case 9: phase_ffn_down(p, l, smem); break;
    default: phase_final(p); break;
    }
}


#define XB_TMO      128
#define XB_XCNT(j)  (256  + 64 * (j))
#define XB_XSUB(j)  (1280 + 64 * (j))
#define XB_XGEN(j)  (2304 + 64 * (j))
#define XB_TOP      3328
#define XB_TOPGEN   3392
#define XCD_BAR_WORDS 3456
#define XB_SPIN_CAP (1u << 20)
#define LAS __attribute__((address_space(3)))
DI unsigned xb_ld(unsigned* p)              { return __hip_atomic_load(p, __ATOMIC_RELAXED, __HIP_MEMORY_SCOPE_AGENT); }
DI unsigned xb_add(unsigned* p, unsigned v) { return __hip_atomic_fetch_add(p, v, __ATOMIC_RELAXED, __HIP_MEMORY_SCOPE_AGENT); }
DI unsigned xb_xcc_id() { return (unsigned)__builtin_amdgcn_s_getreg((3 << 11) | 20) & 0xFu; }
#define XB_SPIN(cond, bar) do { unsigned _sp = 0; while (cond) { __builtin_amdgcn_s_sleep(1); \
    if ((++_sp & 255u) == 0u) { if (xb_ld(&(bar)[XB_TMO])) break; if (_sp > XB_SPIN_CAP) { atomicAdd(&(bar)[XB_TMO], 1u); break; } } } } while (0)
struct XcdBarrier { unsigned* bar; unsigned x; volatile LAS unsigned* st; };
DI XcdBarrier xcd_barrier_post(unsigned* bar, volatile LAS unsigned* st) {
    XcdBarrier b; b.bar = bar; b.x = xb_xcc_id(); b.st = st;
    if (threadIdx.x == 0) (void)xb_add(&bar[XB_XCNT(b.x)], 1u);
    return b;
}
DI void xcd_barrier_complete(unsigned* bar, unsigned x, unsigned& nloc, unsigned& nx) {
    const unsigned G = gridDim.x * gridDim.y * gridDim.z;
    unsigned sum, cnt, mine, sp = 0u;
    for (;;) {
        sum = 0u; cnt = 0u; mine = 0u;
#pragma unroll
        for (unsigned j = 0; j < 16; ++j) { const unsigned c = xb_ld(&bar[XB_XCNT(j)]); sum += c; cnt += (c > 0u) ? 1u : 0u; mine = (j == x) ? c : mine; }
        if (sum == G) break;
        __builtin_amdgcn_s_sleep(1);
        if ((++sp & 255u) == 0u) { if (xb_ld(&bar[XB_TMO])) break; if (sp > XB_SPIN_CAP) { atomicAdd(&bar[XB_TMO], 1u); break; } }
    }
    nloc = mine > 0u ? mine : 1u; nx = cnt > 0u ? cnt : 1u;
}
DI void xcd_barrier(const XcdBarrier& b) {
    asm volatile("s_waitcnt vmcnt(0)" ::: "memory");
    __syncthreads();
    if (threadIdx.x == 0) {
        unsigned* bar = b.bar;
        __builtin_amdgcn_s_waitcnt(0);
        unsigned nloc = b.st[0], nx = b.st[1];
        if (nloc == 0u) { xcd_barrier_complete(bar, b.x, nloc, nx); b.st[0] = nloc; b.st[1] = nx; }
        const unsigned old = xb_add(&bar[XB_XSUB(b.x)], 1u);
        const unsigned gen = old / nloc;
        if (old + 1u == (gen + 1u) * nloc) {
            __builtin_amdgcn_fence(__ATOMIC_RELEASE, "agent");
            asm volatile("s_waitcnt vmcnt(0)" ::: "memory");
            const unsigned og = xb_add(&bar[XB_TOP], 1u);
            const unsigned tg = og / nx;
            if (og + 1u == (tg + 1u) * nx) xb_add(&bar[XB_TOPGEN], 1u);
            else XB_SPIN(xb_ld(&bar[XB_TOPGEN]) == tg, bar);
            __builtin_amdgcn_fence(__ATOMIC_ACQUIRE, "agent");
            xb_add(&bar[XB_XGEN(b.x)], 1u);
            asm volatile("s_waitcnt vmcnt(0)" ::: "memory");
        } else {
            XB_SPIN(xb_ld(&bar[XB_XGEN(b.x)]) == gen, bar);
            __builtin_amdgcn_fence(__ATOMIC_ACQUIRE, "agent");
            asm volatile("s_waitcnt vmcnt(0)" ::: "memory");
        }
    }
    __syncthreads();
}

#if MEGA
__global__ void __launch_bounds__(256, 2) __attribute__((amdgpu_waves_per_eu(2, 2))) mega_kernel(Params p) {
    extern __shared__ __attribute__((aligned(16))) unsigned char smem[];
    cg::grid_group grid = cg::this_grid();
    volatile LAS unsigned* st = (volatile LAS unsigned*)(smem + SMEM_BYTES - 16);
    if (threadIdx.x == 0) { st[0] = 0u; st[1] = 0u; }
    __syncthreads();
    const XcdBarrier xb = xcd_barrier_post(karg()->bar, st);
    run_phase(0, 0, smem);
    grid.sync();
#pragma unroll 1
    for (int l = 0; l < 2; ++l) {
#pragma unroll 1
        for (int ph = 1; ph <= 9; ++ph) { run_phase(ph, l, smem); xcd_barrier(xb); }
    }
    run_phase(10, 0, smem);
}
#else
__global__ void __launch_bounds__(256, 2) __attribute__((amdgpu_waves_per_eu(2, 2))) phase_kernel(Params p, int ph, int l) {
    extern __shared__ __attribute__((aligned(16))) unsigned char smem[];
    run_phase(ph, l, smem);
}
#endif

extern "C" void kernel_launch(void* const* d_in, const int* in_sizes, int n_in, void* d_out, int out_size, void* d_ws, size_t ws_size, hipStream_t stream) {
    (void)in_sizes; (void)n_in; (void)out_size;
    Params p{};
    p.x = (const float*)d_in[0]; p.c = (const float*)d_in[1]; p.pos = (const int*)d_in[2];
    p.g_mix = (const float*)d_in[3]; p.w_ada = (const float*)d_in[4]; p.b_ada = (const float*)d_in[5]; p.w_in = (const float*)d_in[6]; p.b_fox_f = (const float*)d_in[7];
    p.g_mla_q = (const float*)d_in[8]; p.w_mla_uq = (const float*)d_in[9]; p.g_mla_kv = (const float*)d_in[10]; p.w_mla_ukv = (const float*)d_in[11];
    p.w_o_fox = (const float*)d_in[12]; p.w_o_mla = (const float*)d_in[13]; p.w_o_sb = (const float*)d_in[14]; p.w_out = (const float*)d_in[15];
    p.g_ffn = (const float*)d_in[16]; p.w_ffn_gate = (const float*)d_in[17]; p.w_ffn_up = (const float*)d_in[18]; p.w_ffn_down = (const float*)d_in[19]; p.g_final = (const float*)d_in[20];
    p.out = (float*)d_out;
    unsigned char* ws = (unsigned char*)d_ws; size_t off = 0;
    auto take = [&](size_t bytes) { unsigned char* q = ws + off; off += (bytes + 255) & ~(size_t)255; return q; };
    p.bar = (unsigned*)take(16384);
    p.wt = (bf16_t*)take(2 * W_LAYER * 2);
    p.mod = (float*)take(2 * 8 * 6144 * 4);
    p.ropetab = (float*)take((size_t)T_TOK * 16 * 2 * 4);
    p.logf = (float*)take((size_t)64 * SEQ * 4);
    p.cum = (float*)take((size_t)64 * SEQ * 4);
    p.u = (bf16_t*)take((size_t)T_TOK * 1024 * 2);
    p.qf = (bf16_t*)take((size_t)T_TOK * 512 * 2);
    p.kf = (bf16_t*)take((size_t)T_TOK * 512 * 2);
    p.vtf = (bf16_t*)take((size_t)T_TOK * 512 * 2);
    p.qs = (bf16_t*)take((size_t)T_TOK * 512 * 2);
    p.ks = (bf16_t*)take((size_t)T_TOK * 512 * 2);
    p.vts = (bf16_t*)take((size_t)T_TOK * 512 * 2);
    p.ql = (bf16_t*)take((size_t)T_TOK * 384 * 2);
    p.kvl = (bf16_t*)take((size_t)T_TOK * 256 * 2);
    p.kr = (bf16_t*)take((size_t)T_TOK * 32 * 2);
    p.qn = (bf16_t*)take((size_t)T_TOK * 512 * 2);
    p.qr = (bf16_t*)take((size_t)T_TOK * 256 * 2);
    p.kn = (bf16_t*)take((size_t)T_TOK * 512 * 2);
    p.vtm = (bf16_t*)take((size_t)T_TOK * 512 * 2);
    p.merged = p.kf;
    p.h = p.qf;
    if (off > ws_size) { fprintf(stderr, "kernel_launch: workspace too small: need %zu, have %zu\n", off, ws_size); return; }

#if MEGA
    static int grid_blocks = 0;
    if (!grid_blocks) {
        int dev = 0, cus = 0, per_cu = 0;
        (void)hipGetDevice(&dev);
        (void)hipDeviceGetAttribute(&cus, hipDeviceAttributeMultiprocessorCount, dev);
        (void)hipFuncSetAttribute((const void*)mega_kernel, hipFuncAttributeMaxDynamicSharedMemorySize, SMEM_BYTES);
        (void)hipOccupancyMaxActiveBlocksPerMultiprocessor(&per_cu, (const void*)mega_kernel, 256, SMEM_BYTES);
        per_cu = 2;
        grid_blocks = cus * per_cu;
        grid_blocks &= ~7;
    }
    (void)hipMemsetAsync(p.bar, 0, 16384, stream);
    void* args[] = {&p};
    hipError_t e = hipLaunchCooperativeKernel((const void*)mega_kernel, dim3(grid_blocks), dim3(256), args, SMEM_BYTES, stream);
    if (e != hipSuccess) fprintf(stderr, "cooperative launch failed: %s (grid %d)\n", hipGetErrorString(e), grid_blocks);
#else
    static bool attr = false;
    if (!attr) { (void)hipFuncSetAttribute((const void*)phase_kernel, hipFuncAttributeMaxDynamicSharedMemorySize, SMEM_BYTES); attr = true; }
    const int G = 512;
    hipLaunchKernelGGL(phase_kernel, dim3(G), dim3(256), SMEM_BYTES, stream, p, 0, 0);
    for (int l = 0; l < 2; ++l)
        for (int ph = 1; ph <= 9; ++ph) hipLaunchKernelGGL(phase_kernel, dim3(G), dim3(256), SMEM_BYTES, stream, p, ph, l);
    hipLaunchKernelGGL(phase_kernel, dim3(G), dim3(256), SMEM_BYTES, stream, p, 10, 0);
#endif
}
```

```cpp
#include <hip/hip_runtime.h>
#include <hip/hip_cooperative_groups.h>
#include <cstdint>
#include <cstdio>
namespace cg = cooperative_groups;

#ifndef MEGA
#define MEGA 1
#endif

typedef unsigned short bf16_t;
typedef short bf16x8 __attribute__((ext_vector_type(8)));
typedef float f32x16 __attribute__((ext_vector_type(16)));
typedef float f32x4 __attribute__((ext_vector_type(4)));
typedef unsigned u32x2 __attribute__((ext_vector_type(2)));
#define DI __device__ __forceinline__
typedef unsigned u32x4 __attribute__((ext_vector_type(4)));
#define GLOAD16(dst, ptr) asm volatile("global_load_dwordx4 %0, %1, off" : "=v"(dst) : "v"(ptr))
#define GLOAD4(dst, ptr)  asm volatile("global_load_dword %0, %1, off" : "=v"(dst) : "v"(ptr))
#define MFMA(a, b, c) __builtin_amdgcn_mfma_f32_32x32x16_bf16((a), (b), (c), 0, 0, 0)

constexpr int T_TOK = 32768;
constexpr int SEQ = 4096;
constexpr float LOG2E = 1.4426950408889634f;
constexpr float FOX_QS = 0.125f * 1.4426950408889634f;
constexpr float MLA_QS = 0.10206207261596575f * 1.4426950408889634f;
constexpr float EPS = 1e-6f;

constexpr size_t W_IN = 0, W_GATE = 4063232, W_UQ = 7208960, W_UKV = 7503872, W_OF = 7766016, W_OM = 8290304, W_OS = 8814592,
                 W_OUT = 9338880, W_FGU = 10387456, W_FD = 16154624, W_LAYER = 19038208;

constexpr int SMEM_BYTES = 73728 + 1024 + 16;

struct Params {
    const float* x; const float* c; const int* pos;
    const float* g_mix; const float* w_ada; const float* b_ada; const float* w_in; const float* b_fox_f;
    const float* g_mla_q; const float* w_mla_uq; const float* g_mla_kv; const float* w_mla_ukv;
    const float* w_o_fox; const float* w_o_mla; const float* w_o_sb; const float* w_out;
    const float* g_ffn; const float* w_ffn_gate; const float* w_ffn_up; const float* w_ffn_down; const float* g_final;
    float* out;
    bf16_t* wt; float* mod; float* ropetab; float* logf; float* cum;
    bf16_t* u; bf16_t* qf; bf16_t* kf; bf16_t* vtf; bf16_t* qs; bf16_t* ks; bf16_t* vts;
    bf16_t* ql; bf16_t* kvl; bf16_t* kr; bf16_t* qn; bf16_t* qr; bf16_t* kn; bf16_t* vtm;
    bf16_t* merged; bf16_t* h;
    unsigned* bar;
};
typedef const __attribute__((address_space(4))) Params* KargPtr;
#if defined(__HIP_DEVICE_COMPILE__)
__device__ __forceinline__ KargPtr karg() { KargPtr pp = (KargPtr)__builtin_amdgcn_kernarg_segment_ptr(); asm volatile("" : "+s"(pp)); return pp; }
#else
__device__ __forceinline__ KargPtr karg() { return nullptr; }
#endif

__device__ const float ROPE_INV[16] = {1.0f, 0.5623413324356079f, 0.3162277638912201f, 0.17782793939113617f, 0.10000000149011612f, 0.05623413249850273f,
    0.03162277489900589f, 0.017782794311642647f, 0.009999999776482582f, 0.005623413249850273f, 0.003162277629598975f, 0.0017782794311642647f,
    0.0010000000474974513f, 0.000562341301701963f, 0.0003162277571391314f, 0.00017782794020604342f};

typedef __bf16 bf16x2_t __attribute__((ext_vector_type(2)));
typedef float f32x2_t __attribute__((ext_vector_type(2)));
DI unsigned pack_bf16(float lo, float hi) { const f32x2_t v = {lo, hi}; const bf16x2_t b = __builtin_convertvector(v, bf16x2_t); return __builtin_bit_cast(unsigned, b); }
DI bf16_t f2bf(float x) { return (bf16_t)(pack_bf16(x, 0.f) & 0xffffu); }
DI int tidx() { int t = threadIdx.x; asm volatile("" : "+v"(t)); return t; }
DI int bidx() { int t = blockIdx.x; asm volatile("" : "+s"(t)); return t; }
DI int gdim() { int t = gridDim.x; asm volatile("" : "+s"(t)); return t; }
DI float fexp2(float x) { return __builtin_amdgcn_exp2f(x); }
DI float flog2(float x) { return __builtin_amdgcn_logf(x); }
DI float frcp(float x) { return __builtin_amdgcn_rcpf(x); }
DI float sigmoidf_(float x) { return frcp(1.0f + fexp2(-x * LOG2E)); }

DI bool next_tile(int it, int MT, int NT, int& mt, int& nt) {
    const int perx = gdim() >> 3, xcd = bidx() & 7, slot = bidx() >> 3;
    const long L = ((long)it * 8 + xcd) * perx + slot;
    if (L >= (long)MT * NT) return false;
    const int gsz = 8 * NT; const int grp = (int)(L / gsz), wi = (int)(L % gsz);
    mt = grp * 8 + (wi & 7); nt = wi >> 3; return true;
}

template <int BK>
DI void gemm_mainloop(const bf16_t* A, int lda, const bf16_t* B, int ldb, int K, f32x16 (&acc)[2][2], unsigned char* smem) {
    constexpr int CPR = BK / 8;
    constexpr int RPP = 256 / CPR;
    constexpr int NJ = 128 / RPP;
    constexpr int ROWB = BK * 2 + 16;
    constexpr int OPB = 128 * ROWB;
    constexpr int STB = 2 * OPB;
    constexpr int PASSB = RPP * ROWB;
    const int tid = tidx(), lane = tid & 63, w = tid >> 6, wm = w >> 1, wn = w & 1, r = lane & 31, hh = lane >> 5;
    const int lrow = tid / CPR, lcol = (tid % CPR) * 8;
    const bf16_t* ap = A + (size_t)lrow * lda + lcol;
    const bf16_t* bp = B + (size_t)lrow * ldb + lcol;
    const size_t astep = (size_t)RPP * lda, bstep = (size_t)RPP * ldb;
    const int st_off = lrow * ROWB + (tid % CPR) * 16;
    u32x4 ra0, ra1, ra2, ra3, rb0, rb1, rb2, rb3;
    ra0 = *(const u32x4*)(ap); rb0 = *(const u32x4*)(bp);
    ra1 = *(const u32x4*)(ap + astep); rb1 = *(const u32x4*)(bp + bstep);
    if constexpr (NJ == 4) { ra2 = *(const u32x4*)(ap + 2 * astep); rb2 = *(const u32x4*)(bp + 2 * bstep); ra3 = *(const u32x4*)(ap + 3 * astep); rb3 = *(const u32x4*)(bp + 3 * bstep); }
    else { ra2 = ra0; ra3 = ra0; rb2 = rb0; rb3 = rb0; }
#define GEMM_STAGE(D_) do { unsigned char* d_ = (D_); \
        *(u32x4*)(d_) = ra0; *(u32x4*)(d_ + OPB) = rb0; *(u32x4*)(d_ + PASSB) = ra1; *(u32x4*)(d_ + OPB + PASSB) = rb1; \
        if constexpr (NJ == 4) { *(u32x4*)(d_ + 2 * PASSB) = ra2; *(u32x4*)(d_ + OPB + 2 * PASSB) = rb2; *(u32x4*)(d_ + 3 * PASSB) = ra3; *(u32x4*)(d_ + OPB + 3 * PASSB) = rb3; } } while (0)
    GEMM_STAGE(smem + st_off);
    __syncthreads();
    const int nk = K / BK;
    const int rdA = (wm * 64 + r) * ROWB + hh * 16;
    const int rdB = OPB + (wn * 64 + r) * ROWB + hh * 16;
#define GEMM_FRAGS(KS_, A0_, A1_, B0_, B1_) do { \
        A0_ = *(const bf16x8*)(sa + (KS_) * 32); A1_ = *(const bf16x8*)(sa + 32 * ROWB + (KS_) * 32); \
        B0_ = *(const bf16x8*)(sb + (KS_) * 32); B1_ = *(const bf16x8*)(sb + 32 * ROWB + (KS_) * 32); } while (0)
#define GEMM_MFMA4(A0_, A1_, B0_, B1_) do { \
        acc[0][0] = MFMA(A0_, B0_, acc[0][0]); acc[0][1] = MFMA(A0_, B1_, acc[0][1]); \
        acc[1][0] = MFMA(A1_, B0_, acc[1][0]); acc[1][1] = MFMA(A1_, B1_, acc[1][1]); } while (0)
#define GEMM_COMPUTE(BUF_) do { \
        const unsigned char* sa = smem + (BUF_) * STB + rdA; \
        const unsigned char* sb = smem + (BUF_) * STB + rdB; \
        bf16x8 fa0, fa1, fb0, fb1, ga0, ga1, gb0, gb1; \
        GEMM_FRAGS(0, fa0, fa1, fb0, fb1); \
        GEMM_FRAGS(1, ga0, ga1, gb0, gb1); \
        __builtin_amdgcn_sched_barrier(0); \
        GEMM_MFMA4(fa0, fa1, fb0, fb1); \
        if constexpr (BK == 64) { \
            __builtin_amdgcn_sched_barrier(0); \
            GEMM_FRAGS(2, fa0, fa1, fb0, fb1); \
            __builtin_amdgcn_sched_barrier(0); \
            GEMM_MFMA4(ga0, ga1, gb0, gb1); \
            __builtin_amdgcn_sched_barrier(0); \
            GEMM_FRAGS(3, ga0, ga1, gb0, gb1); \
            __builtin_amdgcn_sched_barrier(0); \
            GEMM_MFMA4(fa0, fa1, fb0, fb1); \
        } \
        __builtin_amdgcn_sched_barrier(0); \
        GEMM_MFMA4(ga0, ga1, gb0, gb1); \
    } while (0)
    for (int kt = 0; kt < nk - 1; ++kt) {
        const int buf = kt & 1;
        ap += BK; bp += BK;
        GLOAD16(ra0, ap); GLOAD16(rb0, bp); GLOAD16(ra1, ap + astep); GLOAD16(rb1, bp + bstep);
        if constexpr (NJ == 4) { GLOAD16(ra2, ap + 2 * astep); GLOAD16(rb2, bp + 2 * bstep); GLOAD16(ra3, ap + 3 * astep); GLOAD16(rb3, bp + 3 * bstep); }
        __builtin_amdgcn_sched_barrier(0);
        GEMM_COMPUTE(buf);
        __builtin_amdgcn_sched_barrier(0);
        if constexpr (NJ == 4) asm volatile("s_waitcnt vmcnt(0)" : "+v"(ra0), "+v"(rb0), "+v"(ra1), "+v"(rb1), "+v"(ra2), "+v"(rb2), "+v"(ra3), "+v"(rb3));
        else asm volatile("s_waitcnt vmcnt(0)" : "+v"(ra0), "+v"(rb0), "+v"(ra1), "+v"(rb1));
        GEMM_STAGE(smem + (buf ^ 1) * STB + st_off);
        __syncthreads();
    }
    GEMM_COMPUTE((nk - 1) & 1);
    __syncthreads();
#undef GEMM_COMPUTE
#undef GEMM_MFMA4
#undef GEMM_FRAGS
#undef GEMM_STAGE
}


DI void gemm_big(const bf16_t* P, int ldp, const bf16_t* Q, int ldq, int K, f32x16 (&acc)[2][4], unsigned char* smem) {
    constexpr int ROWB = 80, PB = 128 * ROWB, STB = 384 * ROWB, PASSB = 64 * ROWB;
    const int tid = tidx(), lane = tid & 63, w = tid >> 6, wm = w >> 1, wn = w & 1, r = lane & 31, hh = lane >> 5;
    const int lrow = tid >> 2, lcol = (tid & 3) * 8;
    const bf16_t* pp = P + (size_t)lrow * ldp + lcol;
    const bf16_t* qp = Q + (size_t)lrow * ldq + lcol;
    const size_t pstep = (size_t)64 * ldp, qstep = (size_t)64 * ldq;
    const int st_off = lrow * ROWB + (tid & 3) * 16;
    u32x4 rp0, rp1, rq0, rq1, rq2, rq3;
    rp0 = *(const u32x4*)(pp); rp1 = *(const u32x4*)(pp + pstep);
    rq0 = *(const u32x4*)(qp); rq1 = *(const u32x4*)(qp + qstep); rq2 = *(const u32x4*)(qp + 2 * qstep); rq3 = *(const u32x4*)(qp + 3 * qstep);
#define BIG_STAGE(D_) do { unsigned char* d_ = (D_); \
        *(u32x4*)(d_) = rp0; *(u32x4*)(d_ + PASSB) = rp1; \
        *(u32x4*)(d_ + PB) = rq0; *(u32x4*)(d_ + PB + PASSB) = rq1; *(u32x4*)(d_ + PB + 2 * PASSB) = rq2; *(u32x4*)(d_ + PB + 3 * PASSB) = rq3; } while (0)
    BIG_STAGE(smem + st_off);
    __syncthreads();
    const int nk = K >> 5;
    const int rdP = (wm * 64 + r) * ROWB + hh * 16;
    const int rdQ = PB + (wn * 128 + r) * ROWB + hh * 16;
#define BIG_FRAGS(KS_, A0_, A1_, B0_, B1_, B2_, B3_) do { \
        A0_ = *(const bf16x8*)(sp + (KS_) * 32); A1_ = *(const bf16x8*)(sp + 32 * ROWB + (KS_) * 32); \
        B0_ = *(const bf16x8*)(sq + (KS_) * 32); B1_ = *(const bf16x8*)(sq + 32 * ROWB + (KS_) * 32); \
        B2_ = *(const bf16x8*)(sq + 64 * ROWB + (KS_) * 32); B3_ = *(const bf16x8*)(sq + 96 * ROWB + (KS_) * 32); } while (0)
#define BIG_MFMA8(A0_, A1_, B0_, B1_, B2_, B3_) do { \
        acc[0][0] = MFMA(A0_, B0_, acc[0][0]); acc[0][1] = MFMA(A0_, B1_, acc[0][1]); acc[0][2] = MFMA(A0_, B2_, acc[0][2]); acc[0][3] = MFMA(A0_, B3_, acc[0][3]); \
        acc[1][0] = MFMA(A1_, B0_, acc[1][0]); acc[1][1] = MFMA(A1_, B1_, acc[1][1]); acc[1][2] = MFMA(A1_, B2_, acc[1][2]); acc[1][3] = MFMA(A1_, B3_, acc[1][3]); } while (0)
#define BIG_COMPUTE(BUF_) do { \
        const unsigned char* sp = smem + (BUF_) * STB + rdP; \
        const unsigned char* sq = smem + (BUF_) * STB + rdQ; \
        bf16x8 fa0, fa1, fb0, fb1, fb2, fb3, ga0, ga1, gb0, gb1, gb2, gb3; \
        BIG_FRAGS(0, fa0, fa1, fb0, fb1, fb2, fb3); \
        BIG_FRAGS(1, ga0, ga1, gb0, gb1, gb2, gb3); \
        __builtin_amdgcn_sched_barrier(0); \
        BIG_MFMA8(fa0, fa1, fb0, fb1, fb2, fb3); \
        __builtin_amdgcn_sched_barrier(0); \
        BIG_MFMA8(ga0, ga1, gb0, gb1, gb2, gb3); \
    } while (0)
    for (int kt = 0; kt < nk - 1; ++kt) {
        const int buf = kt & 1;
        pp += 32; qp += 32;
        GLOAD16(rp0, pp); GLOAD16(rq0, qp); GLOAD16(rp1, pp + pstep); GLOAD16(rq1, qp + qstep); GLOAD16(rq2, qp + 2 * qstep); GLOAD16(rq3, qp + 3 * qstep);
        __builtin_amdgcn_sched_barrier(0);
        BIG_COMPUTE(buf);
        __builtin_amdgcn_sched_barrier(0);
        asm volatile("s_waitcnt vmcnt(0)" : "+v"(rp0), "+v"(rp1), "+v"(rq0), "+v"(rq1), "+v"(rq2), "+v"(rq3));
        BIG_STAGE(smem + (buf ^ 1) * STB + st_off);
        __syncthreads();
    }
    BIG_COMPUTE((nk - 1) & 1);
    __syncthreads();
#undef BIG_COMPUTE
#undef BIG_MFMA8
#undef BIG_FRAGS
#undef BIG_STAGE
}
DI void zero_big(f32x16 (&acc)[2][4]) {
#pragma unroll
    for (int a = 0; a < 2; ++a)
#pragma unroll
        for (int b = 0; b < 4; ++b)
#pragma unroll
            for (int i = 0; i < 16; ++i) acc[a][b][i] = 0.f;
}
DI void stage_store_big(const f32x16 (&acc)[2][4], bf16_t* dst, int ld, unsigned char* smem) {
    const int tid = tidx(), lane = tid & 63, w = tid >> 6, wm = w >> 1, wn = w & 1, r = lane & 31, hh = lane >> 5;
#pragma unroll
    for (int qi = 0; qi < 4; ++qi) {
        unsigned char* trow = smem + (wn * 128 + qi * 32 + r) * 272 + (wm * 64 + 4 * hh) * 2;
#pragma unroll
        for (int pi = 0; pi < 2; ++pi)
#pragma unroll
            for (int g = 0; g < 4; ++g) {
                u32x2 pk; pk.x = pack_bf16(acc[pi][qi][4 * g], acc[pi][qi][4 * g + 1]); pk.y = pack_bf16(acc[pi][qi][4 * g + 2], acc[pi][qi][4 * g + 3]);
                *(u32x2*)(trow + (pi * 32 + 8 * g) * 2) = pk;
            }
    }
    __syncthreads();
    const int q0 = tid >> 4, x = tid & 15;
#pragma unroll
    for (int j = 0; j < 16; ++j) {
        const uint4 v = *(const uint4*)(smem + (q0 + 16 * j) * 272 + x * 16);
        *(uint4*)(dst + (size_t)(q0 + 16 * j) * ld + x * 8) = v;
    }
    __syncthreads();
}
DI void scale_big(f32x16 (&acc)[2][4], float sc) {
#pragma unroll
    for (int a = 0; a < 2; ++a)
#pragma unroll
        for (int b = 0; b < 4; ++b)
#pragma unroll
            for (int i = 0; i < 16; ++i) acc[a][b][i] *= sc;
}
DI void scale_big_q(f32x16 (&acc)[2][4], const float* rs, float sc) {
    const int lane = tidx() & 63, wn = (tidx() >> 6) & 1, r = lane & 31;
#pragma unroll
    for (int qi = 0; qi < 4; ++qi) { const float f = rs[wn * 128 + qi * 32 + r] * sc;
#pragma unroll
        for (int pi = 0; pi < 2; ++pi)
#pragma unroll
            for (int i = 0; i < 16; ++i) acc[pi][qi][i] *= f; }
}
DI void scale_big_p(f32x16 (&acc)[2][4], const float* rs) {
    const int lane = tidx() & 63, wm = tidx() >> 7, hh = lane >> 5;
#pragma unroll
    for (int pi = 0; pi < 2; ++pi)
#pragma unroll
        for (int g = 0; g < 4; ++g) { const f32x4 f = *(const f32x4*)(rs + wm * 64 + pi * 32 + 8 * g + 4 * hh);
#pragma unroll
            for (int qi = 0; qi < 4; ++qi)
#pragma unroll
                for (int e = 0; e < 4; ++e) acc[pi][qi][4 * g + e] *= f[e]; }
}
DI long tile_linear(int it, long total) {
    const int perx = gdim() >> 3, xcd = bidx() & 7, slot = bidx() >> 3;
    const long L = ((long)it * 8 + xcd) * perx + slot;
    return L < total ? L : -1;
}
DI void tile_decode(int L, int NT, int& mt, int& nt) { const int gsz = 8 * NT; const int grp = L / gsz, wi = L % gsz; mt = grp * 8 + (wi & 7); nt = wi >> 3; }

DI void zero_acc(f32x16 (&acc)[2][2]) {
#pragma unroll
    for (int a = 0; a < 2; ++a)
#pragma unroll
        for (int b = 0; b < 2; ++b)
#pragma unroll
            for (int i = 0; i < 16; ++i) acc[a][b][i] = 0.f;
}

DI void stage_store_128(const f32x16 (&acc)[2][2], bf16_t* dst, int ld, unsigned char* smem) {
    const int tid = tidx(), lane = tid & 63, w = tid >> 6, wm = w >> 1, wn = w & 1, r = lane & 31, hh = lane >> 5;
#pragma unroll
    for (int qi = 0; qi < 2; ++qi) {
        unsigned char* trow = smem + (wn * 64 + qi * 32 + r) * 272 + (wm * 64 + 4 * hh) * 2;
#pragma unroll
        for (int pi = 0; pi < 2; ++pi)
#pragma unroll
            for (int g = 0; g < 4; ++g) {
                u32x2 pk; pk.x = pack_bf16(acc[pi][qi][4 * g], acc[pi][qi][4 * g + 1]); pk.y = pack_bf16(acc[pi][qi][4 * g + 2], acc[pi][qi][4 * g + 3]);
                *(u32x2*)(trow + (pi * 32 + 8 * g) * 2) = pk;
            }
    }
    __syncthreads();
    const int q0 = tid >> 4, x = tid & 15;
#pragma unroll
    for (int j = 0; j < 8; ++j) {
        const uint4 v = *(const uint4*)(smem + (q0 + 16 * j) * 272 + x * 16);
        *(uint4*)(dst + (size_t)(q0 + 16 * j) * ld + x * 8) = v;
    }
    __syncthreads();
}
DI void scale_acc(f32x16 (&acc)[2][2], float sc) {
#pragma unroll
    for (int a = 0; a < 2; ++a)
#pragma unroll
        for (int b = 0; b < 2; ++b)
#pragma unroll
            for (int i = 0; i < 16; ++i) acc[a][b][i] *= sc;
}
DI void scale_acc_q(f32x16 (&acc)[2][2], const float* rs, float sc) {
    const int lane = tidx() & 63, wn = (tidx() >> 6) & 1, r = lane & 31;
#pragma unroll
    for (int qi = 0; qi < 2; ++qi) { const float f = rs[wn * 64 + qi * 32 + r] * sc;
#pragma unroll
        for (int pi = 0; pi < 2; ++pi)
#pragma unroll
            for (int i = 0; i < 16; ++i) acc[pi][qi][i] *= f; }
}
DI void scale_acc_p(f32x16 (&acc)[2][2], const float* rs) {
    const int lane = tidx() & 63, wm = tidx() >> 7, hh = lane >> 5;
#pragma unroll
    for (int pi = 0; pi < 2; ++pi)
#pragma unroll
        for (int g = 0; g < 4; ++g) { const f32x4 f = *(const f32x4*)(rs + wm * 64 + pi * 32 + 8 * g + 4 * hh);
#pragma unroll
            for (int qi = 0; qi < 2; ++qi)
#pragma unroll
                for (int e = 0; e < 4; ++e) acc[pi][qi][4 * g + e] *= f[e]; }
}

DI int map_col(int map, int n) {
    switch (map) {
    case 1:
        if (n < 1536) return n;
        if (n < 3072) return 2216 + (n - 1536);
        if (n < 3456) return 1544 + (n - 3072);
        if (n < 3712) return 1928 + (n - 3456);
        { const int c = n - 3712; if (c < 16) return 2184 + c; if (c < 24) return 1536 + (c - 16); if (c < 32) return -1; if (c < 48) return 2200 + (c - 32); return -1; }
    case 2: return 3752 + n;
    case 3:
        if (n < 512) return (n >> 6) * 96 + (n & 63);
        { const int cc = n - 512, tt = cc >> 7, c7 = cc & 127, wn = c7 >> 6, ni = (c7 >> 5) & 1, c = c7 & 31; const int head = tt * 4 + wn * 2 + (c >> 4); return head * 96 + 64 + ni * 16 + (c & 15); }
    case 4:
        if (n < 512) return (n >> 6) * 128 + (n & 63);
        { const int n2 = n - 512; return (n2 >> 6) * 128 + 64 + (n2 & 63); }
    case 5: return (n >> 7) * 64 + ((n >> 6) & 1) * 32 + (n & 31);
    default: return n;
    }
}

DI void transpose_tile(const float* __restrict__ src, const float* __restrict__ src2, int ld, int K, bf16_t* __restrict__ dst, int map, const float* __restrict__ kscale, int n0, int k0, float* tile) {
    const int tid = tidx(), tx = tid & 63, ty = tid >> 6;
    const int sc = map_col(map, n0 + tx);
    if (map == 5 && (((n0 + tx) >> 5) & 1)) src = src2;
#pragma unroll 4
    for (int kk = ty; kk < 64; kk += 4) {
        float v = 0.f;
        if (sc >= 0) { v = src[(size_t)(k0 + kk) * ld + sc]; if (kscale) v *= kscale[k0 + kk]; }
        tile[kk * 65 + tx] = v;
    }
    __syncthreads();
    const int n = tid >> 2, kq = (tid & 3) * 16;
    unsigned wv[8];
#pragma unroll
    for (int j = 0; j < 8; ++j) wv[j] = pack_bf16(tile[(kq + 2 * j) * 65 + n], tile[(kq + 2 * j + 1) * 65 + n]);
    uint4* d = (uint4*)(dst + (size_t)(n0 + n) * K + k0 + kq);
    d[0] = make_uint4(wv[0], wv[1], wv[2], wv[3]);
    d[1] = make_uint4(wv[4], wv[5], wv[6], wv[7]);
    __syncthreads();
}

DI void phase_prep(KargPtr p, unsigned char* smem) {
    const int tid = tidx();
    float* fs = (float*)smem;
    constexpr int NW = 9296, NMOD = 192, NROPE = 2048;
    for (int item = bidx(); item < NW + NMOD + NROPE; item += gdim()) {
        if (item < NW) {
            const int l = item / 4648; int ti = item % 4648;
            const float* src; const float* src2 = nullptr; int ld, K, Nd, map; size_t doff; const float* ksc = nullptr;
            if (ti < 992)       { src = p->w_in + (size_t)l * 1024 * 6824; ld = 6824; K = 1024; Nd = 3968; doff = W_IN; map = 1; }
            else if (ti < 1760) { ti -= 992;  src = p->w_in + (size_t)l * 1024 * 6824; ld = 6824; K = 1024; Nd = 3072; doff = W_GATE; map = 2; }
            else if (ti < 1832) { ti -= 1760; src = p->w_mla_uq + (size_t)l * 384 * 768; ld = 768; K = 384; Nd = 768; doff = W_UQ; map = 3; ksc = p->g_mla_q + l * 384; }
            else if (ti < 1896) { ti -= 1832; src = p->w_mla_ukv + (size_t)l * 256 * 1024; ld = 1024; K = 256; Nd = 1024; doff = W_UKV; map = 4; ksc = p->g_mla_kv + l * 256; }
            else if (ti < 2024) { ti -= 1896; src = p->w_o_fox + (size_t)l * 512 * 1024; ld = 1024; K = 512; Nd = 1024; doff = W_OF; map = 0; }
            else if (ti < 2152) { ti -= 2024; src = p->w_o_mla + (size_t)l * 512 * 1024; ld = 1024; K = 512; Nd = 1024; doff = W_OM; map = 0; }
            else if (ti < 2280) { ti -= 2152; src = p->w_o_sb + (size_t)l * 512 * 1024; ld = 1024; K = 512; Nd = 1024; doff = W_OS; map = 0; }
            else if (ti < 2536) { ti -= 2280; src = p->w_out + (size_t)l * 1024 * 1024; ld = 1024; K = 1024; Nd = 1024; doff = W_OUT; map = 0; }
            else if (ti < 3944) { ti -= 2536; src = p->w_ffn_gate + (size_t)l * 1024 * 2816; src2 = p->w_ffn_up + (size_t)l * 1024 * 2816; ld = 2816; K = 1024; Nd = 5632; doff = W_FGU; map = 5; }
            else                { ti -= 3944; src = p->w_ffn_down + (size_t)l * 2816 * 1024; ld = 1024; K = 2816; Nd = 1024; doff = W_FD; map = 0; }
            (void)Nd;
            const int kts = K >> 6; const int ntile = ti / kts, ktile = ti % kts;
            transpose_tile(src, src2, ld, K, p->wt + (size_t)l * W_LAYER + doff, map, ksc, ntile * 64, ktile * 64, fs);
        } else if (item < NW + NMOD) {
            const int mi = item - NW; const int l = mi / 96, c0 = (mi % 96) * 64;
            float* cond = fs;
            float* red = fs + 8192;
            for (int e = tid; e < 8192; e += 256) { const float cv = p->c[e]; cond[e] = cv * sigmoidf_(cv); }
            __syncthreads();
            const int tx = tid & 63, ty = tid >> 6;
            float a0 = 0, a1 = 0, a2 = 0, a3 = 0, a4 = 0, a5 = 0, a6 = 0, a7 = 0;
            const float* wsrc = p->w_ada + (size_t)l * 1024 * 6144 + c0 + tx;
            for (int k = ty * 256; k < ty * 256 + 256; ++k) {
                const float wv = wsrc[(size_t)k * 6144];
                a0 += cond[k] * wv; a1 += cond[1024 + k] * wv; a2 += cond[2048 + k] * wv; a3 += cond[3072 + k] * wv;
                a4 += cond[4096 + k] * wv; a5 += cond[5120 + k] * wv; a6 += cond[6144 + k] * wv; a7 += cond[7168 + k] * wv;
            }
            float* rr = red + ty * 512 + tx;
            rr[0] = a0; rr[64] = a1; rr[128] = a2; rr[192] = a3; rr[256] = a4; rr[320] = a5; rr[384] = a6; rr[448] = a7;
            __syncthreads();
            for (int o = tid; o < 512; o += 256) {
                const int b = o >> 6, xx = o & 63;
                const float s = red[o] + red[512 + o] + red[1024 + o] + red[1536 + o] + p->b_ada[l * 6144 + c0 + xx];
                p->mod[(size_t)(l * 8 + b) * 6144 + c0 + xx] = s;
            }
            __syncthreads();
        } else {
            const int e = (item - NW - NMOD) * 256 + tid;
            const int i = e & 15, tok = e >> 4;
            const float ang = (float)p->pos[tok] * ROPE_INV[i];
            const double a = (double)ang;
            const double kq = rint(a * 0.63661977236758134308);
            const double rr = fma(-kq, 1.57079632679489661923, a);
            const double r2 = rr * rr;
            const double sn = rr * (1.0 + r2 * (-1.0 / 6 + r2 * (1.0 / 120 + r2 * (-1.0 / 5040 + r2 * (1.0 / 362880 + r2 * (-1.0 / 39916800))))));
            const double cs = 1.0 + r2 * (-0.5 + r2 * (1.0 / 24 + r2 * (-1.0 / 720 + r2 * (1.0 / 40320 + r2 * (-1.0 / 3628800 + r2 * (1.0 / 479001600))))));
            const int q = ((int)(long long)kq) & 3;
            const double co = (q == 0) ? cs : (q == 1) ? -sn : (q == 2) ? -cs : sn;
            const double si = (q == 0) ? sn : (q == 1) ? cs : (q == 2) ? -sn : -cs;
            p->ropetab[2 * (size_t)e] = (float)co; p->ropetab[2 * (size_t)e + 1] = (float)si;
        }
    }
}

DI float wave_sum(float v) {
#pragma unroll
    for (int o = 32; o >= 1; o >>= 1) v += __shfl_xor(v, o);
    return v;
}
DI void phase_norm(const float* __restrict__ xin, const float* __restrict__ g, const float* __restrict__ modl, int sh_idx, int sc_idx, bf16_t* __restrict__ uout) {
    const int lane = tidx() & 63, w = tidx() >> 6;
    for (int row = bidx() * 4 + w; row < T_TOK; row += gdim() * 4) {
        const int b = row >> 12;
        const f32x4* xr = (const f32x4*)(xin + (size_t)row * 1024);
        f32x4 v[4]; float ss = 0.f;
#pragma unroll
        for (int j = 0; j < 4; ++j) { v[j] = xr[lane + 64 * j]; ss += v[j][0] * v[j][0] + v[j][1] * v[j][1] + v[j][2] * v[j][2] + v[j][3] * v[j][3]; }
        ss = wave_sum(ss);
        const float rstd = rsqrtf(ss * (1.0f / 1024.0f) + EPS);
        const float* mb = modl + (size_t)b * 6144;
#pragma unroll
        for (int j = 0; j < 4; ++j) {
            const int col = 4 * (lane + 64 * j);
            const f32x4 g4 = *(const f32x4*)(g + col), sc4 = *(const f32x4*)(mb + sc_idx * 1024 + col), sh4 = *(const f32x4*)(mb + sh_idx * 1024 + col);
            float y[4];
#pragma unroll
            for (int e = 0; e < 4; ++e) y[e] = (v[j][e] * rstd) * g4[e] * (1.0f + sc4[e]) + sh4[e];
            u32x2 pk; pk.x = pack_bf16(y[0], y[1]); pk.y = pack_bf16(y[2], y[3]);
            *(u32x2*)(uout + (size_t)row * 1024 + col) = pk;
        }
    }
}
DI void phase_final(KargPtr p) {
    const int lane = tidx() & 63, w = tidx() >> 6;
    for (int row = bidx() * 4 + w; row < T_TOK; row += gdim() * 4) {
        f32x4* xr = (f32x4*)(p->out + (size_t)row * 1024);
        f32x4 v[4]; float ss = 0.f;
#pragma unroll
        for (int j = 0; j < 4; ++j) { v[j] = xr[lane + 64 * j]; ss += v[j][0] * v[j][0] + v[j][1] * v[j][1] + v[j][2] * v[j][2] + v[j][3] * v[j][3]; }
        ss = wave_sum(ss);
        const float rstd = rsqrtf(ss * (1.0f / 1024.0f) + EPS);
#pragma unroll
        for (int j = 0; j < 4; ++j) {
            const f32x4 g4 = *(const f32x4*)(p->g_final + 4 * (lane + 64 * j));
            f32x4 o;
#pragma unroll
            for (int e = 0; e < 4; ++e) o[e] = (v[j][e] * rstd) * g4[e];
            xr[lane + 64 * j] = o;
        }
    }
}

DI void phase_inproj(KargPtr p, int l, unsigned char* smem) {
    const bf16_t* W = p->wt + (size_t)l * W_LAYER + W_IN;
    constexpr int TA = 128 * 21, TB = 256 * 4, TC = 256;
    for (int it = 0;; ++it) {
        const long L = tile_linear(it, TA + TB + TC); if (L < 0) break;
        if (L < TA + TB) {
            const bool swapped = L < TA;
            int mt, a; if (swapped) tile_decode((int)L, 21, mt, a); else tile_decode((int)L - TA, 4, mt, a);
            const int nt = a < 8 ? a : (a < 16 ? a + 4 : a + 8);
            const int wrow = swapped ? nt * 128 : (a < 2 ? 1024 + 256 * a : 2560 + 256 * (a - 2));
            const int m0 = swapped ? mt * 256 : mt * 128, b = m0 >> 12, s0 = m0 & 4095;
            const bf16_t* Wp = W + (size_t)wrow * 1024; const bf16_t* Up = p->u + (size_t)m0 * 1024;
            f32x16 acc[2][4]; zero_big(acc);
            gemm_big(swapped ? Wp : Up, 1024, swapped ? Up : Wp, 1024, 1024, acc, smem);
            bf16_t* dst; int ld;
            if (swapped) {
                if (nt < 4 || (nt >= 12 && nt < 16)) scale_big(acc, FOX_QS);
                if (nt < 4)        { dst = p->qf + (size_t)m0 * 512 + nt * 128; ld = 512; }
                else if (nt < 8)   { dst = p->kf + (size_t)m0 * 512 + (nt - 4) * 128; ld = 512; }
                else if (nt < 16)  { dst = p->qs + (size_t)m0 * 512 + (nt - 12) * 128; ld = 512; }
                else if (nt < 20)  { dst = p->ks + (size_t)m0 * 512 + (nt - 16) * 128; ld = 512; }
                else if (nt < 27)  { dst = p->ql + (size_t)m0 * 384 + (nt - 24) * 128; ld = 384; }
                else               { dst = p->kvl + (size_t)m0 * 256 + (nt - 27) * 128; ld = 256; }
            } else {
                dst = (a < 2 ? p->vtf + (size_t)(b * 512 + 256 * a) * SEQ : p->vts + (size_t)(b * 512 + 256 * (a - 2)) * SEQ) + s0; ld = SEQ;
            }
            stage_store_big(acc, dst, ld, smem);
        } else {
            const int tid = tidx(), lane = tid & 63, w = tid >> 6, wm = w >> 1, wn = w & 1, r = lane & 31, hh = lane >> 5;
            const int mt = (int)L - TA - TB;
            const int m0 = mt * 128, b = m0 >> 12, s0 = m0 & 4095;
            f32x16 acc[2][2]; zero_acc(acc);
            gemm_mainloop<32>(p->u + (size_t)m0 * 1024, 1024, W + (size_t)3712 * 1024, 1024, 1024, acc, smem);
            if (wn == 0) {
                const float* __restrict__ rt = p->ropetab; bf16_t* __restrict__ krp = p->kr; float* __restrict__ lfp = p->logf;
                const float bf = (r >= 16 && r < 24) ? p->b_fox_f[l * 8 + (r - 16)] : 0.f;
#pragma unroll
                for (int mi = 0; mi < 2; ++mi) {
                    const int rbase = wm * 64 + mi * 32 + 4 * hh;
#pragma unroll
                    for (int hf = 0; hf < 2; ++hf) {
                        f32x2_t cs[8];
                        if (r < 16) {
#pragma unroll
                            for (int i = 0; i < 8; ++i) cs[i] = *(const f32x2_t*)(rt + 2 * ((m0 + rbase + 8 * ((8 * hf + i) >> 2) + (i & 3)) * 16 + r));
                        }
#pragma unroll
                        for (int i8 = 0; i8 < 8; ++i8) {
                            const int i = 8 * hf + i8;
                            const int row = rbase + 8 * (i >> 2) + (i & 3);
                            const int t = m0 + row;
                            if (r < 16) {
                                const float x1 = acc[mi][0][i], x2 = acc[mi][1][i];
                                krp[t * 32 + r] = f2bf(x1 * cs[i8][0] - x2 * cs[i8][1]);
                                krp[t * 32 + 16 + r] = f2bf(x1 * cs[i8][1] + x2 * cs[i8][0]);
                            } else if (r < 24) {
                                const float f = acc[mi][0][i] + bf;
                                lfp[(b * 8 + (r - 16)) * SEQ + s0 + row] = fminf(f, 0.f) - log1pf(expf(-fabsf(f)));
                            }
                        }
                    }
                }
            }
        }
    }
}

DI void phase_mla_up(KargPtr p, int l, unsigned char* smem) {
    const int tid = tidx(), lane = tid & 63, w = tid >> 6, wm = w >> 1, wn = w & 1, r = lane & 31, hh = lane >> 5;
    float* rs = (float*)(smem + 73728);
    const bf16_t* WQ = p->wt + (size_t)l * W_LAYER + W_UQ;
    const bf16_t* WKV = p->wt + (size_t)l * W_LAYER + W_UKV;
    for (int it = 0;; ++it) {
        int mt, nt; if (!next_tile(it, 256, 14, mt, nt)) break;
        const int m0 = mt * 128, b = m0 >> 12, s0 = m0 & 4095;
        const bool isq = nt < 6;
        const int K = isq ? 384 : 256;
        const bf16_t* A = (isq ? p->ql : p->kvl) + (size_t)m0 * K;
        __syncthreads();
        {
            const int row = tid >> 1, half = tid & 1; const int hk = K >> 1;
            const uint4* ar = (const uint4*)(A + (size_t)row * K + half * hk);
            float ss = 0.f;
            for (int j = 0; j < (hk >> 3); ++j) {
                const uint4 v = ar[j];
                const unsigned uu[4] = {v.x, v.y, v.z, v.w};
#pragma unroll
                for (int e = 0; e < 4; ++e) { const float lo = __uint_as_float(uu[e] << 16), hi = __uint_as_float(uu[e] & 0xffff0000u); ss += lo * lo + hi * hi; }
            }
            ss += __shfl_xor(ss, 1);
            if (half == 0) rs[row] = rsqrtf(ss / (float)K + EPS);
        }
        __syncthreads();
        f32x16 acc[2][2]; zero_acc(acc);
        if (isq) {
            const bf16_t* Bw = WQ + (size_t)nt * 128 * 384;
            if (nt < 4) {
                gemm_mainloop<64>(Bw, 384, A, 384, 384, acc, smem);
                scale_acc_q(acc, rs, MLA_QS);
                stage_store_128(acc, p->qn + (size_t)m0 * 512 + nt * 128, 512, smem);
            } else {
                gemm_mainloop<64>(A, 384, Bw, 384, 384, acc, smem);
                const int tt = nt - 4; const int head = tt * 4 + wn * 2 + (r >> 4), ii = r & 15;
                const float* __restrict__ rt = p->ropetab; bf16_t* __restrict__ qrp = p->qr;
#pragma unroll
                for (int mi = 0; mi < 2; ++mi) {
                    const int rbase = wm * 64 + mi * 32 + 4 * hh;
                    f32x2_t cs[16];
#pragma unroll
                    for (int i = 0; i < 16; ++i) cs[i] = *(const f32x2_t*)(rt + 2 * ((m0 + rbase + 8 * (i >> 2) + (i & 3)) * 16 + ii));
#pragma unroll
                    for (int i = 0; i < 16; ++i) {
                        const int row = rbase + 8 * (i >> 2) + (i & 3);
                        const int t = m0 + row; const float sc = rs[row] * MLA_QS;
                        const float x1 = acc[mi][0][i] * sc, x2 = acc[mi][1][i] * sc;
                        qrp[t * 256 + head * 32 + ii] = f2bf(x1 * cs[i][0] - x2 * cs[i][1]);
                        qrp[t * 256 + head * 32 + 16 + ii] = f2bf(x1 * cs[i][1] + x2 * cs[i][0]);
                    }
                }
            }
        } else {
            const int n2 = nt - 6;
            const bf16_t* Bw = WKV + (size_t)n2 * 128 * 256;
            if (n2 < 4) {
                gemm_mainloop<64>(Bw, 256, A, 256, 256, acc, smem);
                scale_acc_q(acc, rs, 1.0f);
                stage_store_128(acc, p->kn + (size_t)m0 * 512 + n2 * 128, 512, smem);
            } else {
                gemm_mainloop<64>(A, 256, Bw, 256, 256, acc, smem);
                scale_acc_p(acc, rs);
                stage_store_128(acc, p->vtm + (size_t)(b * 512 + (n2 - 4) * 128) * SEQ + s0, SEQ, smem);
            }
        }
    }
    __syncthreads();
    float* fs = (float*)smem;
    for (int bh = bidx(); bh < 64; bh += gdim()) {
        const f32x4* src = (const f32x4*)(p->logf + (size_t)bh * SEQ + tid * 16);
        f32x4 v[4];
        float run = 0.f;
#pragma unroll
        for (int j = 0; j < 4; ++j) { v[j] = src[j];
#pragma unroll
            for (int e = 0; e < 4; ++e) { run += v[j][e]; v[j][e] = run; } }
        float incl = run;
#pragma unroll
        for (int o = 1; o < 64; o <<= 1) { const float tv = __shfl_up(incl, o); if (lane >= o) incl += tv; }
        if (lane == 63) fs[w] = incl;
        __syncthreads();
        float pre = incl - run;
        for (int ww = 0; ww < w; ++ww) pre += fs[ww];
        f32x4* dst = (f32x4*)(p->cum + (size_t)bh * SEQ + tid * 16);
#pragma unroll
        for (int j = 0; j < 4; ++j) { f32x4 o;
#pragma unroll
            for (int e = 0; e < 4; ++e) o[e] = v[j][e] + pre; dst[j] = o; }
        __syncthreads();
    }
}

template <int TYPE>
DI void attn_item(KargPtr p, int b, int h, int qb, unsigned char* smem) {
    constexpr int DK = (TYPE == 1) ? 96 : (TYPE == 0 ? 80 : 64), KS = DK / 16, KROWB = (DK + 8) * 2, VROWB = 144;
    constexpr int KBYTES = 64 * KROWB, VBYTES = 64 * VROWB, BUFB = KBYTES + VBYTES + 256;
    const int tid = tidx(), lane = tid & 63, w = tid >> 6, r = lane & 31, hh = lane >> 5;
    const int q0 = qb * 128, qw = q0 + 32 * w, myq = qw + r;
    const size_t tokq = (size_t)b * SEQ + myq;
    unsigned* flags = (unsigned*)(smem + 2 * BUFB);

    bf16x8 qfrag[KS];
    if (TYPE == 1) {
#pragma unroll
        for (int ks = 0; ks < 4; ++ks) qfrag[ks] = *(const bf16x8*)(p->qn + tokq * 512 + h * 64 + ks * 16 + hh * 8);
#pragma unroll
        for (int ks = 4; ks < KS; ++ks) qfrag[ks] = *(const bf16x8*)(p->qr + tokq * 256 + h * 32 + (ks - 4) * 16 + hh * 8);
    } else {
        const bf16_t* qg = (TYPE == 0 ? p->qf : p->qs) + tokq * 512 + h * 64;
#pragma unroll
        for (int ks = 0; ks < 4; ++ks) qfrag[ks] = *(const bf16x8*)(qg + ks * 16 + hh * 8);
        if (TYPE == 0) { const u32x4 one3 = hh == 0 ? (u32x4){0x3F803F80u, 0x00003F80u, 0u, 0u} : (u32x4){0u, 0u, 0u, 0u}; qfrag[KS - 1] = __builtin_bit_cast(bf16x8, one3); }
    }
    const bf16_t* Kg = (TYPE == 0 ? p->kf : TYPE == 1 ? p->kn : p->ks) + (size_t)b * SEQ * 512 + h * 64;
    const bf16_t* Vg = (TYPE == 0 ? p->vtf : TYPE == 1 ? p->vtm : p->vts) + (size_t)(b * 8 + h) * 64 * SEQ;
    const bf16_t* Krg = p->kr + (size_t)b * SEQ * 32;
    const float* cumg = p->cum + (size_t)(b * 8 + h) * SEQ;

    const int ntiles = 2 * qb + 2;
    u32x4 rk0A, rk1A, rv0A, rv1A, rkrA, rk0B, rk1B, rv0B, rv1B, rkrB; float rckA = 0.f, rckB = 0.f;
    rkrA = (u32x4){0u, 0u, 0u, 0u}; rkrB = rkrA;
    const int ldrow = tid >> 3, ldch = tid & 7;
    const int vpos = 16 * (ldch >> 1) + 4 * (ldch & 1);
#define LOAD_TILE(S, KT_) do { \
        const int k0_ = (KT_) * 64; \
        GLOAD16(rk0##S, Kg + (size_t)(k0_ + ldrow) * 512 + ldch * 8); \
        GLOAD16(rk1##S, Kg + (size_t)(k0_ + 32 + ldrow) * 512 + ldch * 8); \
        GLOAD16(rv0##S, Vg + (size_t)ldrow * SEQ + k0_ + ldch * 8); \
        GLOAD16(rv1##S, Vg + (size_t)(32 + ldrow) * SEQ + k0_ + ldch * 8); \
        if (TYPE == 1) GLOAD16(rkr##S, Krg + (size_t)(k0_ + (tid >> 2)) * 32 + (tid & 3) * 8); \
        if (TYPE == 0) GLOAD4(rck##S, cumg + k0_ + (tid & 63)); \
    } while (0)
#define WAIT_ALL(S) asm volatile("s_waitcnt vmcnt(0)" : "+v"(rk0##S), "+v"(rk1##S), "+v"(rv0##S), "+v"(rv1##S), "+v"(rkr##S), "+v"(rck##S))
#define WAIT_OLD(S) do { if (TYPE == 2) asm volatile("s_waitcnt vmcnt(4)" : "+v"(rk0##S), "+v"(rk1##S), "+v"(rv0##S), "+v"(rv1##S), "+v"(rkr##S), "+v"(rck##S)); \
        else asm volatile("s_waitcnt vmcnt(5)" : "+v"(rk0##S), "+v"(rk1##S), "+v"(rv0##S), "+v"(rv1##S), "+v"(rkr##S), "+v"(rck##S)); } while (0)
#define STORE_TILE(S, BUF_) do { \
        unsigned char* kb_ = smem + (BUF_) * BUFB; unsigned char* vb_ = kb_ + KBYTES; \
        *(u32x4*)(kb_ + ldrow * KROWB + ldch * 16) = rk0##S; \
        *(u32x4*)(kb_ + (32 + ldrow) * KROWB + ldch * 16) = rk1##S; \
        { u32x2 lo, hi; lo.x = rv0##S.x; lo.y = rv0##S.y; hi.x = rv0##S.z; hi.y = rv0##S.w; \
          *(u32x2*)(vb_ + ldrow * VROWB + vpos * 2) = lo; *(u32x2*)(vb_ + ldrow * VROWB + (vpos + 8) * 2) = hi; } \
        { u32x2 lo, hi; lo.x = rv1##S.x; lo.y = rv1##S.y; hi.x = rv1##S.z; hi.y = rv1##S.w; \
          *(u32x2*)(vb_ + (32 + ldrow) * VROWB + vpos * 2) = lo; *(u32x2*)(vb_ + (32 + ldrow) * VROWB + (vpos + 8) * 2) = hi; } \
        if (TYPE == 1) *(u32x4*)(kb_ + (tid >> 2) * KROWB + 128 + (tid & 3) * 16) = rkr##S; \
        if (TYPE == 0) { if (tid < 64) { \
            const float c_ = -rck##S * LOG2E; \
            const unsigned h_ = pack_bf16(c_, 0.f) & 0xffffu; const float r1_ = c_ - __uint_as_float(h_ << 16); \
            const unsigned m_ = pack_bf16(r1_, 0.f) & 0xffffu; const float r2_ = r1_ - __uint_as_float(m_ << 16); \
            const unsigned l_ = pack_bf16(r2_, 0.f) & 0xffffu; \
            *(u32x4*)(kb_ + tid * KROWB + 128) = (u32x4){h_ | (m_ << 16), l_, 0u, 0u}; \
            *(u32x4*)(kb_ + tid * KROWB + 144) = (u32x4){0u, 0u, 0u, 0u}; } } \
    } while (0)
#define TILE_OF(J_) ((TYPE == 2) ? (ntiles - 1 - ((J_) < ntiles ? (J_) : ntiles - 1)) : ((J_) < ntiles ? (J_) : ntiles - 1))

    f32x16 o0, o1;
#pragma unroll
    for (int i = 0; i < 16; ++i) { o0[i] = 0.f; o1[i] = 0.f; }
    float m = -1e30f, lsum = 0.f, carry = 0.f;
    bool wdone = false;

    auto compute = [&](const int kt, const int buf) __attribute__((always_inline)) {
        const unsigned char* kb = smem + buf * BUFB; const unsigned char* vb = kb + KBYTES;
        const int k0 = kt * 64;
        bool need;
        if (TYPE == 0) need = (k0 <= qw + 31);
        else if (TYPE == 1) need = (k0 <= qw);
        else need = (k0 <= qw + 30) && !wdone;
        if (need) {
            f32x16 s0, s1;
#pragma unroll
            for (int i = 0; i < 16; ++i) { s0[i] = 0.f; s1[i] = 0.f; }
#pragma unroll
            for (int ks = 0; ks < KS; ++ks) {
                const bf16x8 a0 = *(const bf16x8*)(kb + r * KROWB + ks * 32 + hh * 16);
                const bf16x8 a1 = *(const bf16x8*)(kb + (32 + r) * KROWB + ks * 32 + hh * 16);
                s0 = MFMA(a0, qfrag[ks], s0); s1 = MFMA(a1, qfrag[ks], s1);
            }
            if (TYPE != 2) {
                if (TYPE == 0) {
                    if (k0 + 63 > qw) {
#pragma unroll
                        for (int i = 0; i < 16; ++i) {
                            const int key = k0 + 8 * (i >> 2) + 4 * hh + (i & 3);
                            if (key > myq) s0[i] = -1e30f;
                            if (key + 32 > myq) s1[i] = -1e30f;
                        }
                    }
                }
                float mx = s0[0];
#pragma unroll
                for (int i = 1; i < 16; ++i) mx = fmaxf(mx, s0[i]);
#pragma unroll
                for (int i = 0; i < 16; ++i) mx = fmaxf(mx, s1[i]);
                mx = fmaxf(mx, __shfl_xor(mx, 32));
                const float mnew = fmaxf(m, mx);
                const float alpha = fexp2(m - mnew);
                m = mnew;
                float ps = 0.f;
#pragma unroll
                for (int i = 0; i < 16; ++i) { s0[i] = fexp2(s0[i] - mnew); s1[i] = fexp2(s1[i] - mnew); ps += s0[i] + s1[i]; }
                lsum = lsum * alpha + ps;
#pragma unroll
                for (int i = 0; i < 16; ++i) { o0[i] *= alpha; o1[i] *= alpha; }
            } else {
                const bool diag = (k0 + 63 >= qw);
                float lk0[16], lk1[16];
#pragma unroll
                for (int i = 0; i < 16; ++i) {
                    const int key = k0 + 8 * (i >> 2) + 4 * hh + (i & 3);
                    {
                        const float z = s0[i]; const float sp = flog2(1.0f + fexp2(-fabsf(z)));
                        const float lb = fminf(z, 0.f) - sp; float lk = lb - z; float lbv = lb;
                        if (diag && key >= myq) { lk = 0.f; lbv = -1e30f; }
                        s0[i] = lbv; lk0[i] = lk;
                    }
                    {
                        const float z = s1[i]; const float sp = flog2(1.0f + fexp2(-fabsf(z)));
                        const float lb = fminf(z, 0.f) - sp; float lk = lb - z; float lbv = lb;
                        if (diag && key + 32 >= myq) { lk = 0.f; lbv = -1e30f; }
                        s1[i] = lbv; lk1[i] = lk;
                    }
                }
                float run = carry;
#pragma unroll
                for (int g = 3; g >= 0; --g) {
                    const float G = (lk1[4 * g] + lk1[4 * g + 1]) + (lk1[4 * g + 2] + lk1[4 * g + 3]);
                    const float Gp = __shfl_xor(G, 32);
                    const float base = run + (hh == 0 ? Gp : 0.f);
                    const float e3 = base, e2 = e3 + lk1[4 * g + 3], e1 = e2 + lk1[4 * g + 2], e0 = e1 + lk1[4 * g + 1];
                    s1[4 * g + 3] = fexp2(s1[4 * g + 3] + e3); s1[4 * g + 2] = fexp2(s1[4 * g + 2] + e2);
                    s1[4 * g + 1] = fexp2(s1[4 * g + 1] + e1); s1[4 * g] = fexp2(s1[4 * g] + e0);
                    run += G + Gp;
                }
#pragma unroll
                for (int g = 3; g >= 0; --g) {
                    const float G = (lk0[4 * g] + lk0[4 * g + 1]) + (lk0[4 * g + 2] + lk0[4 * g + 3]);
                    const float Gp = __shfl_xor(G, 32);
                    const float base = run + (hh == 0 ? Gp : 0.f);
                    const float e3 = base, e2 = e3 + lk0[4 * g + 3], e1 = e2 + lk0[4 * g + 2], e0 = e1 + lk0[4 * g + 1];
                    s0[4 * g + 3] = fexp2(s0[4 * g + 3] + e3); s0[4 * g + 2] = fexp2(s0[4 * g + 2] + e2);
                    s0[4 * g + 1] = fexp2(s0[4 * g + 1] + e1); s0[4 * g] = fexp2(s0[4 * g] + e0);
                    run += G + Gp;
                }
                carry = run;
            }
#pragma unroll
            for (int s2 = 0; s2 < 2; ++s2) {
                unsigned pk0[4], pk1[4];
#pragma unroll
                for (int j = 0; j < 4; ++j) { pk0[j] = pack_bf16(s0[8 * s2 + 2 * j], s0[8 * s2 + 2 * j + 1]); pk1[j] = pack_bf16(s1[8 * s2 + 2 * j], s1[8 * s2 + 2 * j + 1]); }
                const uint4 u0 = make_uint4(pk0[0], pk0[1], pk0[2], pk0[3]), u1 = make_uint4(pk1[0], pk1[1], pk1[2], pk1[3]);
                const bf16x8 pf0 = __builtin_bit_cast(bf16x8, u0), pf1 = __builtin_bit_cast(bf16x8, u1);
                const bf16x8 v00 = *(const bf16x8*)(vb + r * VROWB + (16 * s2 + 8 * hh) * 2);
                const bf16x8 v01 = *(const bf16x8*)(vb + (32 + r) * VROWB + (16 * s2 + 8 * hh) * 2);
                const bf16x8 v10 = *(const bf16x8*)(vb + r * VROWB + (32 + 16 * s2 + 8 * hh) * 2);
                const bf16x8 v11 = *(const bf16x8*)(vb + (32 + r) * VROWB + (32 + 16 * s2 + 8 * hh) * 2);
                o0 = MFMA(v00, pf0, o0); o1 = MFMA(v01, pf0, o1);
                o0 = MFMA(v10, pf1, o0); o1 = MFMA(v11, pf1, o1);
            }
        }
    };
#define SB_FLAGS(N_) do { if (TYPE == 2) { wdone = (__all(carry < -170.f) != 0); if (lane == 0) flags[((N_) & 1) * 4 + w] = wdone ? 1u : 0u; } } while (0)
#define SB_DONE(N_) (TYPE == 2 && ((flags[((N_) & 1) * 4] & flags[((N_) & 1) * 4 + 1] & flags[((N_) & 1) * 4 + 2] & flags[((N_) & 1) * 4 + 3]) != 0u))
    __syncthreads();
    if (TYPE == 2 && tid < 8) flags[tid] = 0;
    LOAD_TILE(A, TILE_OF(0));
    WAIT_ALL(A);
    STORE_TILE(A, 0);
    LOAD_TILE(A, TILE_OF(1));
    __syncthreads();
    for (int n = 0; n < ntiles; n += 2) {
        LOAD_TILE(B, TILE_OF(n + 2));
        __builtin_amdgcn_sched_barrier(0);
        compute(TILE_OF(n), 0);
        __builtin_amdgcn_sched_barrier(0);
        WAIT_OLD(A);
        STORE_TILE(A, 1);
        SB_FLAGS(n);
        __syncthreads();
        if (SB_DONE(n)) break;
        if (n + 1 >= ntiles) break;
        LOAD_TILE(A, TILE_OF(n + 3));
        __builtin_amdgcn_sched_barrier(0);
        compute(TILE_OF(n + 1), 1);
        __builtin_amdgcn_sched_barrier(0);
        WAIT_OLD(B);
        STORE_TILE(B, 0);
        SB_FLAGS(n + 1);
        __syncthreads();
        if (SB_DONE(n + 1)) break;
    }
    asm volatile("s_waitcnt vmcnt(0)" : "+v"(rk0A), "+v"(rk1A), "+v"(rv0A), "+v"(rv1A), "+v"(rkrA), "+v"(rckA), "+v"(rk0B), "+v"(rk1B), "+v"(rv0B), "+v"(rv1B), "+v"(rkrB), "+v"(rckB));
    float inv = 1.0f;
    if (TYPE != 2) { const float lt = lsum + __shfl_xor(lsum, 32); inv = frcp(lt); }
    bf16_t* yg = (TYPE == 0 ? p->qf : TYPE == 1 ? p->qn : p->qs) + tokq * 512 + h * 64;
#pragma unroll
    for (int g = 0; g < 4; ++g) {
        u32x2 a, c2;
        a.x = pack_bf16(o0[4 * g] * inv, o0[4 * g + 1] * inv); a.y = pack_bf16(o0[4 * g + 2] * inv, o0[4 * g + 3] * inv);
        c2.x = pack_bf16(o1[4 * g] * inv, o1[4 * g + 1] * inv); c2.y = pack_bf16(o1[4 * g + 2] * inv, o1[4 * g + 3] * inv);
        *(u32x2*)(yg + 8 * g + 4 * hh) = a;
        *(u32x2*)(yg + 32 + 8 * g + 4 * hh) = c2;
    }
}

DI void phase_attn(KargPtr p, unsigned char* smem) {
    for (int idx = bidx(); idx < 6144; idx += gdim()) {
        if (idx < 4096) {
            const int j = idx >> 9, g = (idx >> 7) & 3, rem = idx & 127, bh = rem & 63;
            const int qb = 31 - 4 * j - ((j & 1) ? 3 - g : g);
            const int type = ((rem >> 6) + j) & 1;
            if (type == 0) attn_item<0>(p, bh >> 3, bh & 7, qb, smem);
            else attn_item<1>(p, bh >> 3, bh & 7, qb, smem);
        } else {
            const int j = idx - 4096; const int qb = 31 - (j >> 6), bh = j & 63;
            attn_item<2>(p, bh >> 3, bh & 7, qb, smem);
        }
    }
}

DI void phase_merge(KargPtr p, int l, unsigned char* smem) {
    const bf16_t* WL = p->wt + (size_t)l * W_LAYER;
    unsigned* park = (unsigned*)(smem + 40960) + tidx();
    for (int it = 0;; ++it) {
        int mt, nt; if (!next_tile(it, 256, 8, mt, nt)) break;
        const int m0 = mt * 128;
        f32x16 mer[2][2]; zero_acc(mer);
#pragma unroll 1
        for (int br = 0; br < 3; ++br) {
            f32x16 acc[2][2]; zero_acc(acc);
            gemm_mainloop<32>(WL + W_GATE + (size_t)(br * 1024 + nt * 128) * 1024, 1024, p->u + (size_t)m0 * 1024, 1024, 1024, acc, smem);
#pragma unroll
            for (int a = 0; a < 2; ++a)
#pragma unroll
                for (int c = 0; c < 2; ++c)
#pragma unroll
                    for (int j = 0; j < 8; ++j) park[((a * 2 + c) * 8 + j) * 256] = pack_bf16(sigmoidf_(acc[a][c][2 * j]), sigmoidf_(acc[a][c][2 * j + 1]));
            zero_acc(acc);
            const bf16_t* Y = (br == 0 ? p->qf : br == 1 ? p->qn : p->qs) + (size_t)m0 * 512;
            const bf16_t* WO = WL + (br == 0 ? W_OF : br == 1 ? W_OM : W_OS) + (size_t)nt * 128 * 512;
            gemm_mainloop<32>(WO, 512, Y, 512, 512, acc, smem);
#pragma unroll
            for (int a = 0; a < 2; ++a)
#pragma unroll
                for (int c = 0; c < 2; ++c)
#pragma unroll
                    for (int j = 0; j < 8; ++j) {
                        const unsigned gv = park[((a * 2 + c) * 8 + j) * 256];
                        const float g0 = __uint_as_float(gv << 16), g1 = __uint_as_float(gv & 0xffff0000u);
                        mer[a][c][2 * j] += g0 * acc[a][c][2 * j]; mer[a][c][2 * j + 1] += g1 * acc[a][c][2 * j + 1];
                    }
        }
        stage_store_128(mer, p->merged + (size_t)m0 * 1024 + nt * 128, 1024, smem);
    }
}

DI void store_residual_big(const f32x16 (&acc)[2][4], const float* xin, float* xout, const float* gate, int m0, int n0) {
    const int tid = tidx(), lane = tid & 63, w = tid >> 6, wm = w >> 1, wn = w & 1, r = lane & 31, hh = lane >> 5;
#pragma unroll
    for (int qi = 0; qi < 4; ++qi) {
        const int col = n0 + wn * 128 + qi * 32 + r;
        const float gt = gate[col];
#pragma unroll
        for (int mi = 0; mi < 2; ++mi) {
            const size_t base = (size_t)(m0 + wm * 64 + mi * 32 + 4 * hh) * 1024 + col;
#pragma unroll
            for (int hf = 0; hf < 2; ++hf) {
                float xv[8];
#pragma unroll
                for (int i = 0; i < 8; ++i) xv[i] = xin[base + (size_t)(8 * ((8 * hf + i) >> 2) + (i & 3)) * 1024];
#pragma unroll
                for (int i = 0; i < 8; ++i) xout[base + (size_t)(8 * ((8 * hf + i) >> 2) + (i & 3)) * 1024] = xv[i] + gt * acc[mi][qi][8 * hf + i];
            }
        }
    }
}

DI void phase_outproj(KargPtr p, int l, unsigned char* smem) {
    const bf16_t* W = p->wt + (size_t)l * W_LAYER + W_OUT;
    const float* xin = (l == 0) ? p->x : p->out;
    for (int it = 0;; ++it) {
        int mt, nt; if (!next_tile(it, 256, 4, mt, nt)) break;
        const int m0 = mt * 128, b = m0 >> 12;
        f32x16 acc[2][4]; zero_big(acc);
        gemm_big(p->merged + (size_t)m0 * 1024, 1024, W + (size_t)nt * 256 * 1024, 1024, 1024, acc, smem);
        store_residual_big(acc, xin, p->out, p->mod + (size_t)(l * 8 + b) * 6144 + 2 * 1024, m0, nt * 256);
    }
}

DI void phase_ffn_up(KargPtr p, int l, unsigned char* smem) {
    const int tid = tidx(), lane = tid & 63, w = tid >> 6, wm = w >> 1, wn = w & 1, r = lane & 31, hh = lane >> 5;
    const bf16_t* W = p->wt + (size_t)l * W_LAYER + W_FGU;
    for (int it = 0;; ++it) {
        int mt, nt; if (!next_tile(it, 128, 44, mt, nt)) break;
        const int m0 = mt * 256;
        f32x16 acc[2][4]; zero_big(acc);
        gemm_big(W + (size_t)nt * 128 * 1024, 1024, p->u + (size_t)m0 * 1024, 1024, 1024, acc, smem);
#pragma unroll
        for (int qi = 0; qi < 4; ++qi) {
            unsigned char* trow = smem + (wn * 128 + qi * 32 + r) * 144 + (wm * 32 + 4 * hh) * 2;
#pragma unroll
            for (int g = 0; g < 4; ++g) {
                float hv[4];
#pragma unroll
                for (int e = 0; e < 4; ++e) { const float gv = acc[0][qi][4 * g + e]; hv[e] = gv * sigmoidf_(gv) * acc[1][qi][4 * g + e]; }
                u32x2 pk; pk.x = pack_bf16(hv[0], hv[1]); pk.y = pack_bf16(hv[2], hv[3]);
                *(u32x2*)(trow + 8 * g * 2) = pk;
            }
        }
        __syncthreads();
        bf16_t* dst = p->h + (size_t)m0 * 2816 + nt * 64;
        const int q0 = tid >> 3, x = tid & 7;
#pragma unroll
        for (int j = 0; j < 8; ++j) {
            const uint4 v = *(const uint4*)(smem + (q0 + 32 * j) * 144 + x * 16);
            *(uint4*)(dst + (size_t)(q0 + 32 * j) * 2816 + x * 8) = v;
        }
        __syncthreads();
    }
}

DI void phase_ffn_down(KargPtr p, int l, unsigned char* smem) {
    const bf16_t* W = p->wt + (size_t)l * W_LAYER + W_FD;
    for (int it = 0;; ++it) {
        int mt, nt; if (!next_tile(it, 256, 4, mt, nt)) break;
        const int m0 = mt * 128, b = m0 >> 12;
        f32x16 acc[2][4]; zero_big(acc);
        gemm_big(p->h + (size_t)m0 * 2816, 2816, W + (size_t)nt * 256 * 2816, 2816, 2816, acc, smem);
        store_residual_big(acc, p->out, p->out, p->mod + (size_t)(l * 8 + b) * 6144 + 5 * 1024, m0, nt * 256);
    }
}

DI void run_phase(int ph, int l, unsigned char* smem) {
#ifdef ONLY_PH
    if (ph != ONLY_PH) return;
#endif
    KargPtr p = karg();
    switch (ph) {
    case 0: phase_prep(p, smem); break;
    case 1: phase_norm((l == 0) ? p->x : p->out, p->g_mix + l * 1024, p->mod + (size_t)l * 8 * 6144, 0, 1, p->u); break;
    case 2: phase_inproj(p, l, smem); break;
    case 3: phase_mla_up(p, l, smem); break;
    case 4: phase_attn(p, smem); break;
    case 5: phase_merge(p, l, smem); break;
    case 6: phase_outproj(p, l, smem); break;
    case 7: phase_norm(p->out, p->g_ffn + l * 1024, p->mod + (size_t)l * 8 * 6144, 3, 4, p->u); break;
    case 8: phase_ffn_up(p, l, smem); break;
    case 9: phase_ffn_down(p, l, smem); break;
    default: phase_final(p); break;
    }
}


#define XB_TMO      128
#define XB_XCNT(j)  (256  + 64 * (j))
#define XB_XSUB(j)  (1280 + 64 * (j))
#define XB_XGEN(j)  (2304 + 64 * (j))
#define XB_TOP      3328
#define XB_TOPGEN   3392
#define XCD_BAR_WORDS 3456
#define XB_SPIN_CAP (1u << 20)
#define LAS __attribute__((address_space(3)))
DI unsigned xb_ld(unsigned* p)              { return __hip_atomic_load(p, __ATOMIC_RELAXED, __HIP_MEMORY_SCOPE_AGENT); }
DI unsigned xb_add(unsigned* p, unsigned v) { return __hip_atomic_fetch_add(p, v, __ATOMIC_RELAXED, __HIP_MEMORY_SCOPE_AGENT); }
DI unsigned xb_xcc_id() { return (unsigned)__builtin_amdgcn_s_getreg((3 << 11) | 20) & 0xFu; }
#define XB_SPIN(cond, bar) do { unsigned _sp = 0; while (cond) { __builtin_amdgcn_s_sleep(1); \
    if ((++_sp & 255u) == 0u) { if (xb_ld(&(bar)[XB_TMO])) break; if (_sp > XB_SPIN_CAP) { atomicAdd(&(bar)[XB_TMO], 1u); break; } } } } while (0)
struct XcdBarrier { unsigned* bar; unsigned x; volatile LAS unsigned* st; };
DI XcdBarrier xcd_barrier_post(unsigned* bar, volatile LAS unsigned* st) {
    XcdBarrier b; b.bar = bar; b.x = xb_xcc_id(); b.st = st;
    if (threadIdx.x == 0) (void)xb_add(&bar[XB_XCNT(b.x)], 1u);
    return b;
}
DI void xcd_barrier_complete(unsigned* bar, unsigned x, unsigned& nloc, unsigned& nx) {
    const unsigned G = gridDim.x * gridDim.y * gridDim.z;
    unsigned sum, cnt, mine, sp = 0u;
    for (;;) {
        sum = 0u; cnt = 0u; mine = 0u;
#pragma unroll
        for (unsigned j = 0; j < 16; ++j) { const unsigned c = xb_ld(&bar[XB_XCNT(j)]); sum += c; cnt += (c > 0u) ? 1u : 0u; mine = (j == x) ? c : mine; }
        if (sum == G) break;
        __builtin_amdgcn_s_sleep(1);
        if ((++sp & 255u) == 0u) { if (xb_ld(&bar[XB_TMO])) break; if (sp > XB_SPIN_CAP) { atomicAdd(&bar[XB_TMO], 1u); break; } }
    }
    nloc = mine > 0u ? mine : 1u; nx = cnt > 0u ? cnt : 1u;
}
DI void xcd_barrier(const XcdBarrier& b) {
    asm volatile("s_waitcnt vmcnt(0)" ::: "memory");
    __syncthreads();
    if (threadIdx.x == 0) {
        unsigned* bar = b.bar;
        __builtin_amdgcn_s_waitcnt(0);
        unsigned nloc = b.st[0], nx = b.st[1];
        if (nloc == 0u) { xcd_barrier_complete(bar, b.x, nloc, nx); b.st[0] = nloc; b.st[1] = nx; }
        const unsigned old = xb_add(&bar[XB_XSUB(b.x)], 1u);
        const unsigned gen = old / nloc;
        if (old + 1u == (gen + 1u) * nloc) {
            __builtin_amdgcn_fence(__ATOMIC_RELEASE, "agent");
            asm volatile("s_waitcnt vmcnt(0)" ::: "memory");
            const unsigned og = xb_add(&bar[XB_TOP], 1u);
            const unsigned tg = og / nx;
            if (og + 1u == (tg + 1u) * nx) xb_add(&bar[XB_TOPGEN], 1u);
            else XB_SPIN(xb_ld(&bar[XB_TOPGEN]) == tg, bar);
            __builtin_amdgcn_fence(__ATOMIC_ACQUIRE, "agent");
            xb_add(&bar[XB_XGEN(b.x)], 1u);
            asm volatile("s_waitcnt vmcnt(0)" ::: "memory");
        } else {
            XB_SPIN(xb_ld(&bar[XB_XGEN(b.x)]) == gen, bar);
            __builtin_amdgcn_fence(__ATOMIC_ACQUIRE, "agent");
            asm volatile("s_waitcnt vmcnt(0)" ::: "memory");
        }
    }
    __syncthreads();
}

#if MEGA
__global__ void __launch_bounds__(256, 2) __attribute__((amdgpu_waves_per_eu(2, 2))) mega_kernel(Params p) {
    extern __shared__ __attribute__((aligned(16))) unsigned char smem[];
    cg::grid_group grid = cg::this_grid();
    volatile LAS unsigned* st = (volatile LAS unsigned*)(smem + SMEM_BYTES - 16);
    if (threadIdx.x == 0) { st[0] = 0u; st[1] = 0u; }
    __syncthreads();
    const XcdBarrier xb = xcd_barrier_post(karg()->bar, st);
    run_phase(0, 0, smem);
    grid.sync();
#pragma unroll 1
    for (int l = 0; l < 2; ++l) {
#pragma unroll 1
        for (int ph = 1; ph <= 9; ++ph) {
            run_phase(ph, l, smem); xcd_barrier(xb);
#ifdef DBL_PH
            if (ph == DBL_PH) { run_phase(ph, l, smem); xcd_barrier(xb); }
#endif
        }
    }
    run_phase(10, 0, smem);
}
#else
__global__ void __launch_bounds__(256, 2) __attribute__((amdgpu_waves_per_eu(2, 2))) phase_kernel(Params p, int ph, int l) {
    extern __shared__ __attribute__((aligned(16))) unsigned char smem[];
    run_phase(ph, l, smem);
}
#endif

extern "C" void kernel_launch(void* const* d_in, const int* in_sizes, int n_in, void* d_out, int out_size, void* d_ws, size_t ws_size, hipStream_t stream) {
    (void)in_sizes; (void)n_in; (void)out_size;
    Params p{};
    p.x = (const float*)d_in[0]; p.c = (const float*)d_in[1]; p.pos = (const int*)d_in[2];
    p.g_mix = (const float*)d_in[3]; p.w_ada = (const float*)d_in[4]; p.b_ada = (const float*)d_in[5]; p.w_in = (const float*)d_in[6]; p.b_fox_f = (const float*)d_in[7];
    p.g_mla_q = (const float*)d_in[8]; p.w_mla_uq = (const float*)d_in[9]; p.g_mla_kv = (const float*)d_in[10]; p.w_mla_ukv = (const float*)d_in[11];
    p.w_o_fox = (const float*)d_in[12]; p.w_o_mla = (const float*)d_in[13]; p.w_o_sb = (const float*)d_in[14]; p.w_out = (const float*)d_in[15];
    p.g_ffn = (const float*)d_in[16]; p.w_ffn_gate = (const float*)d_in[17]; p.w_ffn_up = (const float*)d_in[18]; p.w_ffn_down = (const float*)d_in[19]; p.g_final = (const float*)d_in[20];
    p.out = (float*)d_out;
    unsigned char* ws = (unsigned char*)d_ws; size_t off = 0;
    auto take = [&](size_t bytes) { unsigned char* q = ws + off; off += (bytes + 255) & ~(size_t)255; return q; };
    p.bar = (unsigned*)take(16384);
    p.wt = (bf16_t*)take(2 * W_LAYER * 2);
    p.mod = (float*)take(2 * 8 * 6144 * 4);
    p.ropetab = (float*)take((size_t)T_TOK * 16 * 2 * 4);
    p.logf = (float*)take((size_t)64 * SEQ * 4);
    p.cum = (float*)take((size_t)64 * SEQ * 4);
    p.u = (bf16_t*)take((size_t)T_TOK * 1024 * 2);
    p.qf = (bf16_t*)take((size_t)T_TOK * 512 * 2);
    p.kf = (bf16_t*)take((size_t)T_TOK * 512 * 2);
    p.vtf = (bf16_t*)take((size_t)T_TOK * 512 * 2);
    p.qs = (bf16_t*)take((size_t)T_TOK * 512 * 2);
    p.ks = (bf16_t*)take((size_t)T_TOK * 512 * 2);
    p.vts = (bf16_t*)take((size_t)T_TOK * 512 * 2);
    p.ql = (bf16_t*)take((size_t)T_TOK * 384 * 2);
    p.kvl = (bf16_t*)take((size_t)T_TOK * 256 * 2);
    p.kr = (bf16_t*)take((size_t)T_TOK * 32 * 2);
    p.qn = (bf16_t*)take((size_t)T_TOK * 512 * 2);
    p.qr = (bf16_t*)take((size_t)T_TOK * 256 * 2);
    p.kn = (bf16_t*)take((size_t)T_TOK * 512 * 2);
    p.vtm = (bf16_t*)take((size_t)T_TOK * 512 * 2);
    p.merged = p.kf;
    p.h = p.qf;
    if (off > ws_size) { fprintf(stderr, "kernel_launch: workspace too small: need %zu, have %zu\n", off, ws_size); return; }

#if MEGA
    static int grid_blocks = 0;
    if (!grid_blocks) {
        int dev = 0, cus = 0, per_cu = 0;
        (void)hipGetDevice(&dev);
        (void)hipDeviceGetAttribute(&cus, hipDeviceAttributeMultiprocessorCount, dev);
        (void)hipFuncSetAttribute((const void*)mega_kernel, hipFuncAttributeMaxDynamicSharedMemorySize, SMEM_BYTES);
        (void)hipOccupancyMaxActiveBlocksPerMultiprocessor(&per_cu, (const void*)mega_kernel, 256, SMEM_BYTES);
        per_cu = 2;
        grid_blocks = cus * per_cu;
        grid_blocks &= ~7;
    }
    (void)hipMemsetAsync(p.bar, 0, 16384, stream);
    void* args[] = {&p};
    hipError_t e = hipLaunchCooperativeKernel((const void*)mega_kernel, dim3(grid_blocks), dim3(256), args, SMEM_BYTES, stream);
    if (e != hipSuccess) fprintf(stderr, "cooperative launch failed: %s (grid %d)\n", hipGetErrorString(e), grid_blocks);
#else
    static bool attr = false;
    if (!attr) { (void)hipFuncSetAttribute((const void*)phase_kernel, hipFuncAttributeMaxDynamicSharedMemorySize, SMEM_BYTES); attr = true; }
    const int G = 512;
    hipLaunchKernelGGL(phase_kernel, dim3(G), dim3(256), SMEM_BYTES, stream, p, 0, 0);
    for (int l = 0; l < 2; ++l)
        for (int ph = 1; ph <= 9; ++ph) hipLaunchKernelGGL(phase_kernel, dim3(G), dim3(256), SMEM_BYTES, stream, p, ph, l);
    hipLaunchKernelGGL(phase_kernel, dim3(G), dim3(256), SMEM_BYTES, stream, p, 10, 0);
#endif
}
```

```cpp
#include <hip/hip_runtime.h>
#include <hip/hip_cooperative_groups.h>
#include <cstdint>
#include <cstdio>
namespace cg = cooperative_groups;

#ifndef MEGA
#define MEGA 1
#endif

typedef unsigned short bf16_t;
typedef short bf16x8 __attribute__((ext_vector_type(8)));
typedef float f32x16 __attribute__((ext_vector_type(16)));
typedef float f32x4 __attribute__((ext_vector_type(4)));
typedef unsigned u32x2 __attribute__((ext_vector_type(2)));
#define DI __device__ __forceinline__
typedef unsigned u32x4 __attribute__((ext_vector_type(4)));
#define GLOAD16(dst, ptr) asm volatile("global_load_dwordx4 %0, %1, off" : "=v"(dst) : "v"(ptr))
#define GLOAD4(dst, ptr)  asm volatile("global_load_dword %0, %1, off" : "=v"(dst) : "v"(ptr))
#define MFMA(a, b, c) __builtin_amdgcn_mfma_f32_32x32x16_bf16((a), (b), (c), 0, 0, 0)

constexpr int T_TOK = 32768;
constexpr int SEQ = 4096;
constexpr float LOG2E = 1.4426950408889634f;
constexpr float FOX_QS = 0.125f * 1.4426950408889634f;
constexpr float MLA_QS = 0.10206207261596575f * 1.4426950408889634f;
constexpr float EPS = 1e-6f;

constexpr size_t W_IN = 0, W_GATE = 4063232, W_UQ = 7208960, W_UKV = 7503872, W_OF = 7766016, W_OM = 8290304, W_OS = 8814592,
                 W_OUT = 9338880, W_FGU = 10387456, W_FD = 16154624, W_LAYER = 19038208;

constexpr int SMEM_BYTES = 73728 + 1024 + 16;

struct Params {
    const float* x; const float* c; const int* pos;
    const float* g_mix; const float* w_ada; const float* b_ada; const float* w_in; const float* b_fox_f;
    const float* g_mla_q; const float* w_mla_uq; const float* g_mla_kv; const float* w_mla_ukv;
    const float* w_o_fox; const float* w_o_mla; const float* w_o_sb; const float* w_out;
    const float* g_ffn; const float* w_ffn_gate; const float* w_ffn_up; const float* w_ffn_down; const float* g_final;
    float* out;
    bf16_t* wt; float* mod; float* ropetab; float* logf; float* cum;
    bf16_t* u; bf16_t* qf; bf16_t* kf; bf16_t* vtf; bf16_t* qs; bf16_t* ks; bf16_t* vts;
    bf16_t* ql; bf16_t* kvl; bf16_t* kr; bf16_t* qn; bf16_t* qr; bf16_t* kn; bf16_t* vtm;
    bf16_t* merged; bf16_t* h;
    unsigned* bar;
};
typedef const __attribute__((address_space(4))) Params* KargPtr;
#if defined(__HIP_DEVICE_COMPILE__)
__device__ __forceinline__ KargPtr karg() { KargPtr pp = (KargPtr)__builtin_amdgcn_kernarg_segment_ptr(); asm volatile("" : "+s"(pp)); return pp; }
#else
__device__ __forceinline__ KargPtr karg() { return nullptr; }
#endif

__device__ const float ROPE_INV[16] = {1.0f, 0.5623413324356079f, 0.3162277638912201f, 0.17782793939113617f, 0.10000000149011612f, 0.05623413249850273f,
    0.03162277489900589f, 0.017782794311642647f, 0.009999999776482582f, 0.005623413249850273f, 0.003162277629598975f, 0.0017782794311642647f,
    0.0010000000474974513f, 0.000562341301701963f, 0.0003162277571391314f, 0.00017782794020604342f};

typedef __bf16 bf16x2_t __attribute__((ext_vector_type(2)));
typedef float f32x2_t __attribute__((ext_vector_type(2)));
DI unsigned pack_bf16(float lo, float hi) { const f32x2_t v = {lo, hi}; const bf16x2_t b = __builtin_convertvector(v, bf16x2_t); return __builtin_bit_cast(unsigned, b); }
DI bf16_t f2bf(float x) { return (bf16_t)(pack_bf16(x, 0.f) & 0xffffu); }
DI int tidx() { int t = threadIdx.x; asm volatile("" : "+v"(t)); return t; }
DI int bidx() { int t = blockIdx.x; asm volatile("" : "+s"(t)); return t; }
DI int gdim() { int t = gridDim.x; asm volatile("" : "+s"(t)); return t; }
DI float fexp2(float x) { return __builtin_amdgcn_exp2f(x); }
DI float flog2(float x) { return __builtin_amdgcn_logf(x); }
DI float frcp(float x) { return __builtin_amdgcn_rcpf(x); }
DI float sigmoidf_(float x) { return frcp(1.0f + fexp2(-x * LOG2E)); }

DI bool next_tile(int it, int MT, int NT, int& mt, int& nt) {
    const int perx = gdim() >> 3, xcd = bidx() & 7, slot = bidx() >> 3;
    const long L = ((long)it * 8 + xcd) * perx + slot;
    if (L >= (long)MT * NT) return false;
    const int gsz = 8 * NT; const int grp = (int)(L / gsz), wi = (int)(L % gsz);
    mt = grp * 8 + (wi & 7); nt = wi >> 3; return true;
}

template <int BK>
DI void gemm_mainloop(const bf16_t* A, int lda, const bf16_t* B, int ldb, int K, f32x16 (&acc)[2][2], unsigned char* smem) {
    constexpr int CPR = BK / 8;
    constexpr int RPP = 256 / CPR;
    constexpr int NJ = 128 / RPP;
    constexpr int ROWB = BK * 2 + 16;
    constexpr int OPB = 128 * ROWB;
    constexpr int STB = 2 * OPB;
    constexpr int PASSB = RPP * ROWB;
    const int tid = tidx(), lane = tid & 63, w = tid >> 6, wm = w >> 1, wn = w & 1, r = lane & 31, hh = lane >> 5;
    const int lrow = tid / CPR, lcol = (tid % CPR) * 8;
    const bf16_t* ap = A + (size_t)lrow * lda + lcol;
    const bf16_t* bp = B + (size_t)lrow * ldb + lcol;
    const size_t astep = (size_t)RPP * lda, bstep = (size_t)RPP * ldb;
    const int st_off = lrow * ROWB + (tid % CPR) * 16;
    u32x4 ra0, ra1, ra2, ra3, rb0, rb1, rb2, rb3;
    ra0 = *(const u32x4*)(ap); rb0 = *(const u32x4*)(bp);
    ra1 = *(const u32x4*)(ap + astep); rb1 = *(const u32x4*)(bp + bstep);
    if constexpr (NJ == 4) { ra2 = *(const u32x4*)(ap + 2 * astep); rb2 = *(const u32x4*)(bp + 2 * bstep); ra3 = *(const u32x4*)(ap + 3 * astep); rb3 = *(const u32x4*)(bp + 3 * bstep); }
    else { ra2 = ra0; ra3 = ra0; rb2 = rb0; rb3 = rb0; }
#define GEMM_STAGE(D_) do { unsigned char* d_ = (D_); \
        *(u32x4*)(d_) = ra0; *(u32x4*)(d_ + OPB) = rb0; *(u32x4*)(d_ + PASSB) = ra1; *(u32x4*)(d_ + OPB + PASSB) = rb1; \
        if constexpr (NJ == 4) { *(u32x4*)(d_ + 2 * PASSB) = ra2; *(u32x4*)(d_ + OPB + 2 * PASSB) = rb2; *(u32x4*)(d_ + 3 * PASSB) = ra3; *(u32x4*)(d_ + OPB + 3 * PASSB) = rb3; } } while (0)
    GEMM_STAGE(smem + st_off);
    __syncthreads();
    const int nk = K / BK;
    const int rdA = (wm * 64 + r) * ROWB + hh * 16;
    const int rdB = OPB + (wn * 64 + r) * ROWB + hh * 16;
#define GEMM_FRAGS(KS_, A0_, A1_, B0_, B1_) do { \
        A0_ = *(const bf16x8*)(sa + (KS_) * 32); A1_ = *(const bf16x8*)(sa + 32 * ROWB + (KS_) * 32); \
        B0_ = *(const bf16x8*)(sb + (KS_) * 32); B1_ = *(const bf16x8*)(sb + 32 * ROWB + (KS_) * 32); } while (0)
#define GEMM_MFMA4(A0_, A1_, B0_, B1_) do { \
        acc[0][0] = MFMA(A0_, B0_, acc[0][0]); acc[0][1] = MFMA(A0_, B1_, acc[0][1]); \
        acc[1][0] = MFMA(A1_, B0_, acc[1][0]); acc[1][1] = MFMA(A1_, B1_, acc[1][1]); } while (0)
#define GEMM_COMPUTE(BUF_) do { \
        const unsigned char* sa = smem + (BUF_) * STB + rdA; \
        const unsigned char* sb = smem + (BUF_) * STB + rdB; \
        bf16x8 fa0, fa1, fb0, fb1, ga0, ga1, gb0, gb1; \
        GEMM_FRAGS(0, fa0, fa1, fb0, fb1); \
        GEMM_FRAGS(1, ga0, ga1, gb0, gb1); \
        __builtin_amdgcn_sched_barrier(0); \
        GEMM_MFMA4(fa0, fa1, fb0, fb1); \
        if constexpr (BK == 64) { \
            __builtin_amdgcn_sched_barrier(0); \
            GEMM_FRAGS(2, fa0, fa1, fb0, fb1); \
            __builtin_amdgcn_sched_barrier(0); \
            GEMM_MFMA4(ga0, ga1, gb0, gb1); \
            __builtin_amdgcn_sched_barrier(0); \
            GEMM_FRAGS(3, ga0, ga1, gb0, gb1); \
            __builtin_amdgcn_sched_barrier(0); \
            GEMM_MFMA4(fa0, fa1, fb0, fb1); \
        } \
        __builtin_amdgcn_sched_barrier(0); \
        GEMM_MFMA4(ga0, ga1, gb0, gb1); \
    } while (0)
    for (int kt = 0; kt < nk - 1; ++kt) {
        const int buf = kt & 1;
        ap += BK; bp += BK;
        GLOAD16(ra0, ap); GLOAD16(rb0, bp); GLOAD16(ra1, ap + astep); GLOAD16(rb1, bp + bstep);
        if constexpr (NJ == 4) { GLOAD16(ra2, ap + 2 * astep); GLOAD16(rb2, bp + 2 * bstep); GLOAD16(ra3, ap + 3 * astep); GLOAD16(rb3, bp + 3 * bstep); }
        __builtin_amdgcn_sched_barrier(0);
        GEMM_COMPUTE(buf);
        __builtin_amdgcn_sched_barrier(0);
        if constexpr (NJ == 4) asm volatile("s_waitcnt vmcnt(0)" : "+v"(ra0), "+v"(rb0), "+v"(ra1), "+v"(rb1), "+v"(ra2), "+v"(rb2), "+v"(ra3), "+v"(rb3));
        else asm volatile("s_waitcnt vmcnt(0)" : "+v"(ra0), "+v"(rb0), "+v"(ra1), "+v"(rb1));
        GEMM_STAGE(smem + (buf ^ 1) * STB + st_off);
        __syncthreads();
    }
    GEMM_COMPUTE((nk - 1) & 1);
    __syncthreads();
#undef GEMM_COMPUTE
#undef GEMM_MFMA4
#undef GEMM_FRAGS
#undef GEMM_STAGE
}


DI void gemm_big(const bf16_t* P, int ldp, const bf16_t* Q, int ldq, int K, f32x16 (&acc)[2][4], unsigned char* smem) {
    constexpr int ROWB = 80, PB = 128 * ROWB, STB = 384 * ROWB, PASSB = 64 * ROWB;
    const int tid = tidx(), lane = tid & 63, w = tid >> 6, wm = w >> 1, wn = w & 1, r = lane & 31, hh = lane >> 5;
    const int lrow = tid >> 2, lcol = (tid & 3) * 8;
    const bf16_t* pp = P + (size_t)lrow * ldp + lcol;
    const bf16_t* qp = Q + (size_t)lrow * ldq + lcol;
    const size_t pstep = (size_t)64 * ldp, qstep = (size_t)64 * ldq;
    const int st_off = lrow * ROWB + (tid & 3) * 16;
    u32x4 rp0, rp1, rq0, rq1, rq2, rq3;
    rp0 = *(const u32x4*)(pp); rp1 = *(const u32x4*)(pp + pstep);
    rq0 = *(const u32x4*)(qp); rq1 = *(const u32x4*)(qp + qstep); rq2 = *(const u32x4*)(qp + 2 * qstep); rq3 = *(const u32x4*)(qp + 3 * qstep);
#define BIG_STAGE(D_) do { unsigned char* d_ = (D_); \
        *(u32x4*)(d_) = rp0; *(u32x4*)(d_ + PASSB) = rp1; \
        *(u32x4*)(d_ + PB) = rq0; *(u32x4*)(d_ + PB + PASSB) = rq1; *(u32x4*)(d_ + PB + 2 * PASSB) = rq2; *(u32x4*)(d_ + PB + 3 * PASSB) = rq3; } while (0)
    BIG_STAGE(smem + st_off);
    __syncthreads();
    const int nk = K >> 5;
    const int rdP = (wm * 64 + r) * ROWB + hh * 16;
    const int rdQ = PB + (wn * 128 + r) * ROWB + hh * 16;
#define BIG_FRAGS(KS_, A0_, A1_, B0_, B1_, B2_, B3_) do { \
        A0_ = *(const bf16x8*)(sp + (KS_) * 32); A1_ = *(const bf16x8*)(sp + 32 * ROWB + (KS_) * 32); \
        B0_ = *(const bf16x8*)(sq + (KS_) * 32); B1_ = *(const bf16x8*)(sq + 32 * ROWB + (KS_) * 32); \
        B2_ = *(const bf16x8*)(sq + 64 * ROWB + (KS_) * 32); B3_ = *(const bf16x8*)(sq + 96 * ROWB + (KS_) * 32); } while (0)
#define BIG_MFMA8(A0_, A1_, B0_, B1_, B2_, B3_) do { \
        acc[0][0] = MFMA(A0_, B0_, acc[0][0]); acc[0][1] = MFMA(A0_, B1_, acc[0][1]); acc[0][2] = MFMA(A0_, B2_, acc[0][2]); acc[0][3] = MFMA(A0_, B3_, acc[0][3]); \
        acc[1][0] = MFMA(A1_, B0_, acc[1][0]); acc[1][1] = MFMA(A1_, B1_, acc[1][1]); acc[1][2] = MFMA(A1_, B2_, acc[1][2]); acc[1][3] = MFMA(A1_, B3_, acc[1][3]); } while (0)
#define BIG_COMPUTE(BUF_) do { \
        const unsigned char* sp = smem + (BUF_) * STB + rdP; \
        const unsigned char* sq = smem + (BUF_) * STB + rdQ; \
        bf16x8 fa0, fa1, fb0, fb1, fb2, fb3, ga0, ga1, gb0, gb1, gb2, gb3; \
        BIG_FRAGS(0, fa0, fa1, fb0, fb1, fb2, fb3); \
        BIG_FRAGS(1, ga0, ga1, gb0, gb1, gb2, gb3); \
        __builtin_amdgcn_sched_barrier(0); \
        BIG_MFMA8(fa0, fa1, fb0, fb1, fb2, fb3); \
        __builtin_amdgcn_sched_barrier(0); \
        BIG_MFMA8(ga0, ga1, gb0, gb1, gb2, gb3); \
    } while (0)
    for (int kt = 0; kt < nk - 1; ++kt) {
        const int buf = kt & 1;
        pp += 32; qp += 32;
        GLOAD16(rp0, pp); GLOAD16(rq0, qp); GLOAD16(rp1, pp + pstep); GLOAD16(rq1, qp + qstep); GLOAD16(rq2, qp + 2 * qstep); GLOAD16(rq3, qp + 3 * qstep);
        __builtin_amdgcn_sched_barrier(0);
        BIG_COMPUTE(buf);
        __builtin_amdgcn_sched_barrier(0);
        asm volatile("s_waitcnt vmcnt(0)" : "+v"(rp0), "+v"(rp1), "+v"(rq0), "+v"(rq1), "+v"(rq2), "+v"(rq3));
        BIG_STAGE(smem + (buf ^ 1) * STB + st_off);
        __syncthreads();
    }
    BIG_COMPUTE((nk - 1) & 1);
    __syncthreads();
#undef BIG_COMPUTE
#undef BIG_MFMA8
#undef BIG_FRAGS
#undef BIG_STAGE
}
DI void zero_big(f32x16 (&acc)[2][4]) {
#pragma unroll
    for (int a = 0; a < 2; ++a)
#pragma unroll
        for (int b = 0; b < 4; ++b)
#pragma unroll
            for (int i = 0; i < 16; ++i) acc[a][b][i] = 0.f;
}
DI void stage_store_big(const f32x16 (&acc)[2][4], bf16_t* dst, int ld, unsigned char* smem) {
    const int tid = tidx(), lane = tid & 63, w = tid >> 6, wm = w >> 1, wn = w & 1, r = lane & 31, hh = lane >> 5;
#pragma unroll
    for (int qi = 0; qi < 4; ++qi) {
        unsigned char* trow = smem + (wn * 128 + qi * 32 + r) * 272 + (wm * 64 + 4 * hh) * 2;
#pragma unroll
        for (int pi = 0; pi < 2; ++pi)
#pragma unroll
            for (int g = 0; g < 4; ++g) {
                u32x2 pk; pk.x = pack_bf16(acc[pi][qi][4 * g], acc[pi][qi][4 * g + 1]); pk.y = pack_bf16(acc[pi][qi][4 * g + 2], acc[pi][qi][4 * g + 3]);
                *(u32x2*)(trow + (pi * 32 + 8 * g) * 2) = pk;
            }
    }
    __syncthreads();
    const int q0 = tid >> 4, x = tid & 15;
#pragma unroll
    for (int j = 0; j < 16; ++j) {
        const uint4 v = *(const uint4*)(smem + (q0 + 16 * j) * 272 + x * 16);
        *(uint4*)(dst + (size_t)(q0 + 16 * j) * ld + x * 8) = v;
    }
    __syncthreads();
}
DI void scale_big(f32x16 (&acc)[2][4], float sc) {
#pragma unroll
    for (int a = 0; a < 2; ++a)
#pragma unroll
        for (int b = 0; b < 4; ++b)
#pragma unroll
            for (int i = 0; i < 16; ++i) acc[a][b][i] *= sc;
}
DI void scale_big_q(f32x16 (&acc)[2][4], const float* rs, float sc) {
    const int lane = tidx() & 63, wn = (tidx() >> 6) & 1, r = lane & 31;
#pragma unroll
    for (int qi = 0; qi < 4; ++qi) { const float f = rs[wn * 128 + qi * 32 + r] * sc;
#pragma unroll
        for (int pi = 0; pi < 2; ++pi)
#pragma unroll
            for (int i = 0; i < 16; ++i) acc[pi][qi][i] *= f; }
}
DI void scale_big_p(f32x16 (&acc)[2][4], const float* rs) {
    const int lane = tidx() & 63, wm = tidx() >> 7, hh = lane >> 5;
#pragma unroll
    for (int pi = 0; pi < 2; ++pi)
#pragma unroll
        for (int g = 0; g < 4; ++g) { const f32x4 f = *(const f32x4*)(rs + wm * 64 + pi * 32 + 8 * g + 4 * hh);
#pragma unroll
            for (int qi = 0; qi < 4; ++qi)
#pragma unroll
                for (int e = 0; e < 4; ++e) acc[pi][qi][4 * g + e] *= f[e]; }
}
DI long tile_linear(int it, long total) {
    const int perx = gdim() >> 3, xcd = bidx() & 7, slot = bidx() >> 3;
    const long L = ((long)it * 8 + xcd) * perx + slot;
    return L < total ? L : -1;
}
DI void tile_decode(int L, int NT, int& mt, int& nt) { const int gsz = 8 * NT; const int grp = L / gsz, wi = L % gsz; mt = grp * 8 + (wi & 7); nt = wi >> 3; }

DI void zero_acc(f32x16 (&acc)[2][2]) {
#pragma unroll
    for (int a = 0; a < 2; ++a)
#pragma unroll
        for (int b = 0; b < 2; ++b)
#pragma unroll
            for (int i = 0; i < 16; ++i) acc[a][b][i] = 0.f;
}

DI void stage_store_128(const f32x16 (&acc)[2][2], bf16_t* dst, int ld, unsigned char* smem) {
    const int tid = tidx(), lane = tid & 63, w = tid >> 6, wm = w >> 1, wn = w & 1, r = lane & 31, hh = lane >> 5;
#pragma unroll
    for (int qi = 0; qi < 2; ++qi) {
        unsigned char* trow = smem + (wn * 64 + qi * 32 + r) * 272 + (wm * 64 + 4 * hh) * 2;
#pragma unroll
        for (int pi = 0; pi < 2; ++pi)
#pragma unroll
            for (int g = 0; g < 4; ++g) {
                u32x2 pk; pk.x = pack_bf16(acc[pi][qi][4 * g], acc[pi][qi][4 * g + 1]); pk.y = pack_bf16(acc[pi][qi][4 * g + 2], acc[pi][qi][4 * g + 3]);
                *(u32x2*)(trow + (pi * 32 + 8 * g) * 2) = pk;
            }
    }
    __syncthreads();
    const int q0 = tid >> 4, x = tid & 15;
#pragma unroll
    for (int j = 0; j < 8; ++j) {
        const uint4 v = *(const uint4*)(smem + (q0 + 16 * j) * 272 + x * 16);
        *(uint4*)(dst + (size_t)(q0 + 16 * j) * ld + x * 8) = v;
    }
    __syncthreads();
}
DI void scale_acc(f32x16 (&acc)[2][2], float sc) {
#pragma unroll
    for (int a = 0; a < 2; ++a)
#pragma unroll
        for (int b = 0; b < 2; ++b)
#pragma unroll
            for (int i = 0; i < 16; ++i) acc[a][b][i] *= sc;
}
DI void scale_acc_q(f32x16 (&acc)[2][2], const float* rs, float sc) {
    const int lane = tidx() & 63, wn = (tidx() >> 6) & 1, r = lane & 31;
#pragma unroll
    for (int qi = 0; qi < 2; ++qi) { const float f = rs[wn * 64 + qi * 32 + r] * sc;
#pragma unroll
        for (int pi = 0; pi < 2; ++pi)
#pragma unroll
            for (int i = 0; i < 16; ++i) acc[pi][qi][i] *= f; }
}
DI void scale_acc_p(f32x16 (&acc)[2][2], const float* rs) {
    const int lane = tidx() & 63, wm = tidx() >> 7, hh = lane >> 5;
#pragma unroll
    for (int pi = 0; pi < 2; ++pi)
#pragma unroll
        for (int g = 0; g < 4; ++g) { const f32x4 f = *(const f32x4*)(rs + wm * 64 + pi * 32 + 8 * g + 4 * hh);
#pragma unroll
            for (int qi = 0; qi < 2; ++qi)
#pragma unroll
                for (int e = 0; e < 4; ++e) acc[pi][qi][4 * g + e] *= f[e]; }
}

DI int map_col(int map, int n) {
    switch (map) {
    case 1:
        if (n < 1536) return n;
        if (n < 3072) return 2216 + (n - 1536);
        if (n < 3456) return 1544 + (n - 3072);
        if (n < 3712) return 1928 + (n - 3456);
        { const int c = n - 3712; if (c < 16) return 2184 + c; if (c < 24) return 1536 + (c - 16); if (c < 32) return -1; if (c < 48) return 2200 + (c - 32); return -1; }
    case 2: return 3752 + n;
    case 3:
        if (n < 512) return (n >> 6) * 96 + (n & 63);
        { const int cc = n - 512, tt = cc >> 7, c7 = cc & 127, wn = c7 >> 6, ni = (c7 >> 5) & 1, c = c7 & 31; const int head = tt * 4 + wn * 2 + (c >> 4); return head * 96 + 64 + ni * 16 + (c & 15); }
    case 4:
        if (n < 512) return (n >> 6) * 128 + (n & 63);
        { const int n2 = n - 512; return (n2 >> 6) * 128 + 64 + (n2 & 63); }
    case 5: return (n >> 7) * 64 + ((n >> 6) & 1) * 32 + (n & 31);
    default: return n;
    }
}

DI void transpose_tile(const float* __restrict__ src, const float* __restrict__ src2, int ld, int K, bf16_t* __restrict__ dst, int map, const float* __restrict__ kscale, int n0, int k0, float* tile) {
    const int tid = tidx(), tx = tid & 63, ty = tid >> 6;
    const int sc = map_col(map, n0 + tx);
    if (map == 5 && (((n0 + tx) >> 5) & 1)) src = src2;
    const int scc = sc < 0 ? 0 : sc;
    const float* sp = src + (size_t)(k0 + ty) * ld + scc;
    float vals[16];
#pragma unroll
    for (int j = 0; j < 16; ++j) vals[j] = sp[(size_t)(4 * j) * ld];
    if (kscale) {
#pragma unroll
        for (int j = 0; j < 16; ++j) vals[j] *= kscale[k0 + ty + 4 * j];
    }
#pragma unroll
    for (int j = 0; j < 16; ++j) tile[(ty + 4 * j) * 65 + tx] = sc < 0 ? 0.f : vals[j];
    __syncthreads();
    const int n = tid >> 2, kq = (tid & 3) * 16;
    unsigned wv[8];
#pragma unroll
    for (int j = 0; j < 8; ++j) wv[j] = pack_bf16(tile[(kq + 2 * j) * 65 + n], tile[(kq + 2 * j + 1) * 65 + n]);
    uint4* d = (uint4*)(dst + (size_t)(n0 + n) * K + k0 + kq);
    d[0] = make_uint4(wv[0], wv[1], wv[2], wv[3]);
    d[1] = make_uint4(wv[4], wv[5], wv[6], wv[7]);
    __syncthreads();
}

DI void phase_prep(KargPtr p, unsigned char* smem) {
    const int tid = tidx();
    float* fs = (float*)smem;
    constexpr int NW = 9296, NMOD = 192, NROPE = 2048;
    for (int item = bidx(); item < NW + NMOD + NROPE; item += gdim()) {
        if (item < NW) {
            const int l = item / 4648; int ti = item % 4648;
            const float* src; const float* src2 = nullptr; int ld, K, Nd, map; size_t doff; const float* ksc = nullptr;
            if (ti < 992)       { src = p->w_in + (size_t)l * 1024 * 6824; ld = 6824; K = 1024; Nd = 3968; doff = W_IN; map = 1; }
            else if (ti < 1760) { ti -= 992;  src = p->w_in + (size_t)l * 1024 * 6824; ld = 6824; K = 1024; Nd = 3072; doff = W_GATE; map = 2; }
            else if (ti < 1832) { ti -= 1760; src = p->w_mla_uq + (size_t)l * 384 * 768; ld = 768; K = 384; Nd = 768; doff = W_UQ; map = 3; ksc = p->g_mla_q + l * 384; }
            else if (ti < 1896) { ti -= 1832; src = p->w_mla_ukv + (size_t)l * 256 * 1024; ld = 1024; K = 256; Nd = 1024; doff = W_UKV; map = 4; ksc = p->g_mla_kv + l * 256; }
            else if (ti < 2024) { ti -= 1896; src = p->w_o_fox + (size_t)l * 512 * 1024; ld = 1024; K = 512; Nd = 1024; doff = W_OF; map = 0; }
            else if (ti < 2152) { ti -= 2024; src = p->w_o_mla + (size_t)l * 512 * 1024; ld = 1024; K = 512; Nd = 1024; doff = W_OM; map = 0; }
            else if (ti < 2280) { ti -= 2152; src = p->w_o_sb + (size_t)l * 512 * 1024; ld = 1024; K = 512; Nd = 1024; doff = W_OS; map = 0; }
            else if (ti < 2536) { ti -= 2280; src = p->w_out + (size_t)l * 1024 * 1024; ld = 1024; K = 1024; Nd = 1024; doff = W_OUT; map = 0; }
            else if (ti < 3944) { ti -= 2536; src = p->w_ffn_gate + (size_t)l * 1024 * 2816; src2 = p->w_ffn_up + (size_t)l * 1024 * 2816; ld = 2816; K = 1024; Nd = 5632; doff = W_FGU; map = 5; }
            else                { ti -= 3944; src = p->w_ffn_down + (size_t)l * 2816 * 1024; ld = 1024; K = 2816; Nd = 1024; doff = W_FD; map = 0; }
            (void)Nd;
            const int kts = K >> 6; const int ntile = ti / kts, ktile = ti % kts;
            transpose_tile(src, src2, ld, K, p->wt + (size_t)l * W_LAYER + doff, map, ksc, ntile * 64, ktile * 64, fs);
        } else if (item < NW + NMOD) {
            const int mi = item - NW; const int l = mi / 96, c0 = (mi % 96) * 64;
            float* cond = fs;
            float* red = fs + 8192;
            for (int e = tid; e < 8192; e += 256) { const float cv = p->c[e]; cond[e] = cv * sigmoidf_(cv); }
            __syncthreads();
            const int tx = tid & 63, ty = tid >> 6;
            float a0 = 0, a1 = 0, a2 = 0, a3 = 0, a4 = 0, a5 = 0, a6 = 0, a7 = 0;
            const float* wsrc = p->w_ada + (size_t)l * 1024 * 6144 + c0 + tx;
#pragma unroll 8
            for (int k = ty * 256; k < ty * 256 + 256; ++k) {
                const float wv = wsrc[(size_t)k * 6144];
                a0 += cond[k] * wv; a1 += cond[1024 + k] * wv; a2 += cond[2048 + k] * wv; a3 += cond[3072 + k] * wv;
                a4 += cond[4096 + k] * wv; a5 += cond[5120 + k] * wv; a6 += cond[6144 + k] * wv; a7 += cond[7168 + k] * wv;
            }
            float* rr = red + ty * 512 + tx;
            rr[0] = a0; rr[64] = a1; rr[128] = a2; rr[192] = a3; rr[256] = a4; rr[320] = a5; rr[384] = a6; rr[448] = a7;
            __syncthreads();
            for (int o = tid; o < 512; o += 256) {
                const int b = o >> 6, xx = o & 63;
                const float s = red[o] + red[512 + o] + red[1024 + o] + red[1536 + o] + p->b_ada[l * 6144 + c0 + xx];
                p->mod[(size_t)(l * 8 + b) * 6144 + c0 + xx] = s;
            }
            __syncthreads();
        } else {
            const int e = (item - NW - NMOD) * 256 + tid;
            const int i = e & 15, tok = e >> 4;
            const float ang = (float)p->pos[tok] * ROPE_INV[i];
            const double a = (double)ang;
            const double kq = rint(a * 0.63661977236758134308);
            const double rr = fma(-kq, 1.57079632679489661923, a);
            const double r2 = rr * rr;
            const double sn = rr * (1.0 + r2 * (-1.0 / 6 + r2 * (1.0 / 120 + r2 * (-1.0 / 5040 + r2 * (1.0 / 362880 + r2 * (-1.0 / 39916800))))));
            const double cs = 1.0 + r2 * (-0.5 + r2 * (1.0 / 24 + r2 * (-1.0 / 720 + r2 * (1.0 / 40320 + r2 * (-1.0 / 3628800 + r2 * (1.0 / 479001600))))));
            const int q = ((int)(long long)kq) & 3;
            const double co = (q == 0) ? cs : (q == 1) ? -sn : (q == 2) ? -cs : sn;
            const double si = (q == 0) ? sn : (q == 1) ? cs : (q == 2) ? -sn : -cs;
            p->ropetab[2 * (size_t)e] = (float)co; p->ropetab[2 * (size_t)e + 1] = (float)si;
        }
    }
}

DI float wave_sum(float v) {
#pragma unroll
    for (int o = 32; o >= 1; o >>= 1) v += __shfl_xor(v, o);
    return v;
}
DI void phase_norm(const float* __restrict__ xin, const float* __restrict__ g, const float* __restrict__ modl, int sh_idx, int sc_idx, bf16_t* __restrict__ uout) {
    const int lane = tidx() & 63, w = tidx() >> 6;
    for (int row = bidx() * 4 + w; row < T_TOK; row += gdim() * 4) {
        const int b = row >> 12;
        const f32x4* xr = (const f32x4*)(xin + (size_t)row * 1024);
        f32x4 v[4]; float ss = 0.f;
#pragma unroll
        for (int j = 0; j < 4; ++j) { v[j] = xr[lane + 64 * j]; ss += v[j][0] * v[j][0] + v[j][1] * v[j][1] + v[j][2] * v[j][2] + v[j][3] * v[j][3]; }
        ss = wave_sum(ss);
        const float rstd = rsqrtf(ss * (1.0f / 1024.0f) + EPS);
        const float* mb = modl + (size_t)b * 6144;
#pragma unroll
        for (int j = 0; j < 4; ++j) {
            const int col = 4 * (lane + 64 * j);
            const f32x4 g4 = *(const f32x4*)(g + col), sc4 = *(const f32x4*)(mb + sc_idx * 1024 + col), sh4 = *(const f32x4*)(mb + sh_idx * 1024 + col);
            float y[4];
#pragma unroll
            for (int e = 0; e < 4; ++e) y[e] = (v[j][e] * rstd) * g4[e] * (1.0f + sc4[e]) + sh4[e];
            u32x2 pk; pk.x = pack_bf16(y[0], y[1]); pk.y = pack_bf16(y[2], y[3]);
            *(u32x2*)(uout + (size_t)row * 1024 + col) = pk;
        }
    }
}
DI void phase_final(KargPtr p) {
    const int lane = tidx() & 63, w = tidx() >> 6;
    for (int row = bidx() * 4 + w; row < T_TOK; row += gdim() * 4) {
        f32x4* xr = (f32x4*)(p->out + (size_t)row * 1024);
        f32x4 v[4]; float ss = 0.f;
#pragma unroll
        for (int j = 0; j < 4; ++j) { v[j] = xr[lane + 64 * j]; ss += v[j][0] * v[j][0] + v[j][1] * v[j][1] + v[j][2] * v[j][2] + v[j][3] * v[j][3]; }
        ss = wave_sum(ss);
        const float rstd = rsqrtf(ss * (1.0f / 1024.0f) + EPS);
#pragma unroll
        for (int j = 0; j < 4; ++j) {
            const f32x4 g4 = *(const f32x4*)(p->g_final + 4 * (lane + 64 * j));
            f32x4 o;
#pragma unroll
            for (int e = 0; e < 4; ++e) o[e] = (v[j][e] * rstd) * g4[e];
            xr[lane + 64 * j] = o;
        }
    }
}

DI void phase_inproj(KargPtr p, int l, unsigned char* smem) {
    const bf16_t* W = p->wt + (size_t)l * W_LAYER + W_IN;
    constexpr int TA = 128 * 21, TB = 256 * 4, TC = 256;
    for (int it = 0;; ++it) {
        const long L = tile_linear(it, TA + TB + TC); if (L < 0) break;
        if (L < TA + TB) {
            const bool swapped = L < TA;
            int mt, a; if (swapped) tile_decode((int)L, 21, mt, a); else tile_decode((int)L - TA, 4, mt, a);
            const int nt = a < 8 ? a : (a < 16 ? a + 4 : a + 8);
            const int wrow = swapped ? nt * 128 : (a < 2 ? 1024 + 256 * a : 2560 + 256 * (a - 2));
            const int m0 = swapped ? mt * 256 : mt * 128, b = m0 >> 12, s0 = m0 & 4095;
            const bf16_t* Wp = W + (size_t)wrow * 1024; const bf16_t* Up = p->u + (size_t)m0 * 1024;
            f32x16 acc[2][4]; zero_big(acc);
            gemm_big(swapped ? Wp : Up, 1024, swapped ? Up : Wp, 1024, 1024, acc, smem);
            bf16_t* dst; int ld;
            if (swapped) {
                if (nt < 4 || (nt >= 12 && nt < 16)) scale_big(acc, FOX_QS);
                if (nt < 4)        { dst = p->qf + (size_t)m0 * 512 + nt * 128; ld = 512; }
                else if (nt < 8)   { dst = p->kf + (size_t)m0 * 512 + (nt - 4) * 128; ld = 512; }
                else if (nt < 16)  { dst = p->qs + (size_t)m0 * 512 + (nt - 12) * 128; ld = 512; }
                else if (nt < 20)  { dst = p->ks + (size_t)m0 * 512 + (nt - 16) * 128; ld = 512; }
                else if (nt < 27)  { dst = p->ql + (size_t)m0 * 384 + (nt - 24) * 128; ld = 384; }
                else               { dst = p->kvl + (size_t)m0 * 256 + (nt - 27) * 128; ld = 256; }
            } else {
                dst = (a < 2 ? p->vtf + (size_t)(b * 512 + 256 * a) * SEQ : p->vts + (size_t)(b * 512 + 256 * (a - 2)) * SEQ) + s0; ld = SEQ;
            }
            stage_store_big(acc, dst, ld, smem);
        } else {
            const int tid = tidx(), lane = tid & 63, w = tid >> 6, wm = w >> 1, wn = w & 1, r = lane & 31, hh = lane >> 5;
            const int mt = (int)L - TA - TB;
            const int m0 = mt * 128, b = m0 >> 12, s0 = m0 & 4095;
            f32x16 acc[2][2]; zero_acc(acc);
            gemm_mainloop<32>(p->u + (size_t)m0 * 1024, 1024, W + (size_t)3712 * 1024, 1024, 1024, acc, smem);
            if (wn == 0) {
                const float* __restrict__ rt = p->ropetab; bf16_t* __restrict__ krp = p->kr; float* __restrict__ lfp = p->logf;
                const float bf = (r >= 16 && r < 24) ? p->b_fox_f[l * 8 + (r - 16)] : 0.f;
#pragma unroll
                for (int mi = 0; mi < 2; ++mi) {
                    const int rbase = wm * 64 + mi * 32 + 4 * hh;
#pragma unroll
                    for (int hf = 0; hf < 2; ++hf) {
                        f32x2_t cs[8];
                        if (r < 16) {
#pragma unroll
                            for (int i = 0; i < 8; ++i) cs[i] = *(const f32x2_t*)(rt + 2 * ((m0 + rbase + 8 * ((8 * hf + i) >> 2) + (i & 3)) * 16 + r));
                        }
#pragma unroll
                        for (int i8 = 0; i8 < 8; ++i8) {
                            const int i = 8 * hf + i8;
                            const int row = rbase + 8 * (i >> 2) + (i & 3);
                            const int t = m0 + row;
                            if (r < 16) {
                                const float x1 = acc[mi][0][i], x2 = acc[mi][1][i];
                                krp[t * 32 + r] = f2bf(x1 * cs[i8][0] - x2 * cs[i8][1]);
                                krp[t * 32 + 16 + r] = f2bf(x1 * cs[i8][1] + x2 * cs[i8][0]);
                            } else if (r < 24) {
                                const float f = acc[mi][0][i] + bf;
                                lfp[(b * 8 + (r - 16)) * SEQ + s0 + row] = fminf(f, 0.f) - log1pf(expf(-fabsf(f)));
                            }
                        }
                    }
                }
            }
        }
    }
}

DI void phase_mla_up(KargPtr p, int l, unsigned char* smem) {
    const int tid = tidx(), lane = tid & 63, w = tid >> 6, wm = w >> 1, wn = w & 1, r = lane & 31, hh = lane >> 5;
    float* rs = (float*)(smem + 73728);
    const bf16_t* WQ = p->wt + (size_t)l * W_LAYER + W_UQ;
    const bf16_t* WKV = p->wt + (size_t)l * W_LAYER + W_UKV;
    for (int it = 0;; ++it) {
        int mt, nt; if (!next_tile(it, 256, 14, mt, nt)) break;
        const int m0 = mt * 128, b = m0 >> 12, s0 = m0 & 4095;
        const bool isq = nt < 6;
        const int K = isq ? 384 : 256;
        const bf16_t* A = (isq ? p->ql : p->kvl) + (size_t)m0 * K;
        __syncthreads();
        {
            const int row = tid >> 1, half = tid & 1; const int hk = K >> 1;
            const uint4* ar = (const uint4*)(A + (size_t)row * K + half * hk);
            float ss = 0.f;
#pragma unroll 8
            for (int j = 0; j < (hk >> 3); ++j) {
                const uint4 v = ar[j];
                const unsigned uu[4] = {v.x, v.y, v.z, v.w};
#pragma unroll
                for (int e = 0; e < 4; ++e) { const float lo = __uint_as_float(uu[e] << 16), hi = __uint_as_float(uu[e] & 0xffff0000u); ss += lo * lo + hi * hi; }
            }
            ss += __shfl_xor(ss, 1);
            if (half == 0) rs[row] = rsqrtf(ss / (float)K + EPS);
        }
        __syncthreads();
        f32x16 acc[2][2]; zero_acc(acc);
        if (isq) {
            const bf16_t* Bw = WQ + (size_t)nt * 128 * 384;
            if (nt < 4) {
                gemm_mainloop<64>(Bw, 384, A, 384, 384, acc, smem);
                scale_acc_q(acc, rs, MLA_QS);
                stage_store_128(acc, p->qn + (size_t)m0 * 512 + nt * 128, 512, smem);
            } else {
                gemm_mainloop<64>(A, 384, Bw, 384, 384, acc, smem);
                const int tt = nt - 4; const int head = tt * 4 + wn * 2 + (r >> 4), ii = r & 15;
                const float* __restrict__ rt = p->ropetab; bf16_t* __restrict__ qrp = p->qr;
#pragma unroll
                for (int mi = 0; mi < 2; ++mi) {
                    const int rbase = wm * 64 + mi * 32 + 4 * hh;
                    f32x2_t cs[16];
#pragma unroll
                    for (int i = 0; i < 16; ++i) cs[i] = *(const f32x2_t*)(rt + 2 * ((m0 + rbase + 8 * (i >> 2) + (i & 3)) * 16 + ii));
#pragma unroll
                    for (int i = 0; i < 16; ++i) {
                        const int row = rbase + 8 * (i >> 2) + (i & 3);
                        const int t = m0 + row; const float sc = rs[row] * MLA_QS;
                        const float x1 = acc[mi][0][i] * sc, x2 = acc[mi][1][i] * sc;
                        qrp[t * 256 + head * 32 + ii] = f2bf(x1 * cs[i][0] - x2 * cs[i][1]);
                        qrp[t * 256 + head * 32 + 16 + ii] = f2bf(x1 * cs[i][1] + x2 * cs[i][0]);
                    }
                }
            }
        } else {
            const int n2 = nt - 6;
            const bf16_t* Bw = WKV + (size_t)n2 * 128 * 256;
            if (n2 < 4) {
                gemm_mainloop<64>(Bw, 256, A, 256, 256, acc, smem);
                scale_acc_q(acc, rs, 1.0f);
                stage_store_128(acc, p->kn + (size_t)m0 * 512 + n2 * 128, 512, smem);
            } else {
                gemm_mainloop<64>(A, 256, Bw, 256, 256, acc, smem);
                scale_acc_p(acc, rs);
                stage_store_128(acc, p->vtm + (size_t)(b * 512 + (n2 - 4) * 128) * SEQ + s0, SEQ, smem);
            }
        }
    }
    __syncthreads();
    float* fs = (float*)smem;
    for (int bh = bidx(); bh < 64; bh += gdim()) {
        const f32x4* src = (const f32x4*)(p->logf + (size_t)bh * SEQ + tid * 16);
        f32x4 v[4];
        float run = 0.f;
#pragma unroll
        for (int j = 0; j < 4; ++j) { v[j] = src[j];
#pragma unroll
            for (int e = 0; e < 4; ++e) { run += v[j][e]; v[j][e] = run; } }
        float incl = run;
#pragma unroll
        for (int o = 1; o < 64; o <<= 1) { const float tv = __shfl_up(incl, o); if (lane >= o) incl += tv; }
        if (lane == 63) fs[w] = incl;
        __syncthreads();
        float pre = incl - run;
        for (int ww = 0; ww < w; ++ww) pre += fs[ww];
        f32x4* dst = (f32x4*)(p->cum + (size_t)bh * SEQ + tid * 16);
#pragma unroll
        for (int j = 0; j < 4; ++j) { f32x4 o;
#pragma unroll
            for (int e = 0; e < 4; ++e) o[e] = v[j][e] + pre; dst[j] = o; }
        __syncthreads();
    }
}

template <int TYPE>
DI void attn_item(KargPtr p, int b, int h, int qb, unsigned char* smem) {
    constexpr int DK = (TYPE == 1) ? 96 : (TYPE == 0 ? 80 : 64), KS = DK / 16, KROWB = (DK + 8) * 2, VROWB = 144;
    constexpr int KBYTES = 64 * KROWB, VBYTES = 64 * VROWB, BUFB = KBYTES + VBYTES + 256;
    const int tid = tidx(), lane = tid & 63, w = tid >> 6, r = lane & 31, hh = lane >> 5;
    const int q0 = qb * 128, qw = q0 + 32 * w, myq = qw + r;
    const size_t tokq = (size_t)b * SEQ + myq;
    unsigned* flags = (unsigned*)(smem + 2 * BUFB);

    bf16x8 qfrag[KS];
    if (TYPE == 1) {
#pragma unroll
        for (int ks = 0; ks < 4; ++ks) qfrag[ks] = *(const bf16x8*)(p->qn + tokq * 512 + h * 64 + ks * 16 + hh * 8);
#pragma unroll
        for (int ks = 4; ks < KS; ++ks) qfrag[ks] = *(const bf16x8*)(p->qr + tokq * 256 + h * 32 + (ks - 4) * 16 + hh * 8);
    } else {
        const bf16_t* qg = (TYPE == 0 ? p->qf : p->qs) + tokq * 512 + h * 64;
#pragma unroll
        for (int ks = 0; ks < 4; ++ks) qfrag[ks] = *(const bf16x8*)(qg + ks * 16 + hh * 8);
        if (TYPE == 0) { const u32x4 one3 = hh == 0 ? (u32x4){0x3F803F80u, 0x00003F80u, 0u, 0u} : (u32x4){0u, 0u, 0u, 0u}; qfrag[KS - 1] = __builtin_bit_cast(bf16x8, one3); }
    }
    const bf16_t* Kg = (TYPE == 0 ? p->kf : TYPE == 1 ? p->kn : p->ks) + (size_t)b * SEQ * 512 + h * 64;
    const bf16_t* Vg = (TYPE == 0 ? p->vtf : TYPE == 1 ? p->vtm : p->vts) + (size_t)(b * 8 + h) * 64 * SEQ;
    const bf16_t* Krg = p->kr + (size_t)b * SEQ * 32;
    const float* cumg = p->cum + (size_t)(b * 8 + h) * SEQ;

    const int ntiles = 2 * qb + 2;
    u32x4 rk0A, rk1A, rv0A, rv1A, rkrA, rk0B, rk1B, rv0B, rv1B, rkrB; float rckA = 0.f, rckB = 0.f;
    rkrA = (u32x4){0u, 0u, 0u, 0u}; rkrB = rkrA;
    const int ldrow = tid >> 3, ldch = tid & 7;
    const int vpos = 16 * (ldch >> 1) + 4 * (ldch & 1);
#define LOAD_TILE(S, KT_) do { \
        const int k0_ = (KT_) * 64; \
        GLOAD16(rk0##S, Kg + (size_t)(k0_ + ldrow) * 512 + ldch * 8); \
        GLOAD16(rk1##S, Kg + (size_t)(k0_ + 32 + ldrow) * 512 + ldch * 8); \
        GLOAD16(rv0##S, Vg + (size_t)ldrow * SEQ + k0_ + ldch * 8); \
        GLOAD16(rv1##S, Vg + (size_t)(32 + ldrow) * SEQ + k0_ + ldch * 8); \
        if (TYPE == 1) GLOAD16(rkr##S, Krg + (size_t)(k0_ + (tid >> 2)) * 32 + (tid & 3) * 8); \
        if (TYPE == 0) GLOAD4(rck##S, cumg + k0_ + (tid & 63)); \
    } while (0)
#define WAIT_ALL(S) asm volatile("s_waitcnt vmcnt(0)" : "+v"(rk0##S), "+v"(rk1##S), "+v"(rv0##S), "+v"(rv1##S), "+v"(rkr##S), "+v"(rck##S))
#define WAIT_OLD(S) do { if (TYPE == 2) asm volatile("s_waitcnt vmcnt(4)" : "+v"(rk0##S), "+v"(rk1##S), "+v"(rv0##S), "+v"(rv1##S), "+v"(rkr##S), "+v"(rck##S)); \
        else asm volatile("s_waitcnt vmcnt(5)" : "+v"(rk0##S), "+v"(rk1##S), "+v"(rv0##S), "+v"(rv1##S), "+v"(rkr##S), "+v"(rck##S)); } while (0)
#define STORE_TILE(S, BUF_) do { \
        unsigned char* kb_ = smem + (BUF_) * BUFB; unsigned char* vb_ = kb_ + KBYTES; \
        *(u32x4*)(kb_ + ldrow * KROWB + ldch * 16) = rk0##S; \
        *(u32x4*)(kb_ + (32 + ldrow) * KROWB + ldch * 16) = rk1##S; \
        { u32x2 lo, hi; lo.x = rv0##S.x; lo.y = rv0##S.y; hi.x = rv0##S.z; hi.y = rv0##S.w; \
          *(u32x2*)(vb_ + ldrow * VROWB + vpos * 2) = lo; *(u32x2*)(vb_ + ldrow * VROWB + (vpos + 8) * 2) = hi; } \
        { u32x2 lo, hi; lo.x = rv1##S.x; lo.y = rv1##S.y; hi.x = rv1##S.z; hi.y = rv1##S.w; \
          *(u32x2*)(vb_ + (32 + ldrow) * VROWB + vpos * 2) = lo; *(u32x2*)(vb_ + (32 + ldrow) * VROWB + (vpos + 8) * 2) = hi; } \
        if (TYPE == 1) *(u32x4*)(kb_ + (tid >> 2) * KROWB + 128 + (tid & 3) * 16) = rkr##S; \
        if (TYPE == 0) { if (tid < 64) { \
            const float c_ = -rck##S * LOG2E; \
            const unsigned h_ = pack_bf16(c_, 0.f) & 0xffffu; const float r1_ = c_ - __uint_as_float(h_ << 16); \
            const unsigned m_ = pack_bf16(r1_, 0.f) & 0xffffu; const float r2_ = r1_ - __uint_as_float(m_ << 16); \
            const unsigned l_ = pack_bf16(r2_, 0.f) & 0xffffu; \
            *(u32x4*)(kb_ + tid * KROWB + 128) = (u32x4){h_ | (m_ << 16), l_, 0u, 0u}; \
            *(u32x4*)(kb_ + tid * KROWB + 144) = (u32x4){0u, 0u, 0u, 0u}; } } \
    } while (0)
#define TILE_OF(J_) ((TYPE == 2) ? (ntiles - 1 - ((J_) < ntiles ? (J_) : ntiles - 1)) : ((J_) < ntiles ? (J_) : ntiles - 1))

    f32x16 o0, o1;
#pragma unroll
    for (int i = 0; i < 16; ++i) { o0[i] = 0.f; o1[i] = 0.f; }
    float m = -1e30f, lsum = 0.f, carry = 0.f;
    bool wdone = false;

    auto compute = [&](const int kt, const int buf) __attribute__((always_inline)) {
        const unsigned char* kb = smem + buf * BUFB; const unsigned char* vb = kb + KBYTES;
        const int k0 = kt * 64;
        bool need;
        if (TYPE == 0) need = (k0 <= qw + 31);
        else if (TYPE == 1) need = (k0 <= qw);
        else need = (k0 <= qw + 30) && !wdone;
        if (need) {
            f32x16 s0, s1;
#pragma unroll
            for (int i = 0; i < 16; ++i) { s0[i] = 0.f; s1[i] = 0.f; }
#pragma unroll
            for (int ks = 0; ks < KS; ++ks) {
                const bf16x8 a0 = *(const bf16x8*)(kb + r * KROWB + ks * 32 + hh * 16);
                const bf16x8 a1 = *(const bf16x8*)(kb + (32 + r) * KROWB + ks * 32 + hh * 16);
                s0 = MFMA(a0, qfrag[ks], s0); s1 = MFMA(a1, qfrag[ks], s1);
            }
            if (TYPE != 2) {
                if (TYPE == 0) {
                    if (k0 + 63 > qw) {
                        asm volatile("");
                        const int rel = myq - k0 - 4 * hh;
#pragma unroll
                        for (int i = 0; i < 16; ++i) {
                            const int off = 8 * (i >> 2) + (i & 3);
                            if (off > rel) s0[i] = -1e30f;
                            if (off + 32 > rel) s1[i] = -1e30f;
                        }
                    }
                }
                float mx = s0[0];
#pragma unroll
                for (int i = 1; i < 16; ++i) mx = fmaxf(mx, s0[i]);
#pragma unroll
                for (int i = 0; i < 16; ++i) mx = fmaxf(mx, s1[i]);
                mx = fmaxf(mx, __shfl_xor(mx, 32));
                const float mnew = fmaxf(m, mx);
                const float alpha = fexp2(m - mnew);
                m = mnew;
                float ps = 0.f;
#pragma unroll
                for (int i = 0; i < 16; ++i) { s0[i] = fexp2(s0[i] - mnew); s1[i] = fexp2(s1[i] - mnew); ps += s0[i] + s1[i]; }
                lsum = lsum * alpha + ps;
#pragma unroll
                for (int i = 0; i < 16; ++i) { o0[i] *= alpha; o1[i] *= alpha; }
            } else {
                float lk0[16], lk1[16];
#pragma unroll
                for (int i = 0; i < 16; ++i) {
                    {
                        const float z = s0[i]; const float sp = flog2(1.0f + fexp2(-fabsf(z)));
                        const float lb = fminf(z, 0.f) - sp;
                        s0[i] = lb; lk0[i] = lb - z;
                    }
                    {
                        const float z = s1[i]; const float sp = flog2(1.0f + fexp2(-fabsf(z)));
                        const float lb = fminf(z, 0.f) - sp;
                        s1[i] = lb; lk1[i] = lb - z;
                    }
                }
                if (k0 + 63 >= qw) {
                    asm volatile("");
                    const int rel = myq - k0 - 4 * hh;
#pragma unroll
                    for (int i = 0; i < 16; ++i) {
                        const int off = 8 * (i >> 2) + (i & 3);
                        if (off >= rel) { lk0[i] = 0.f; s0[i] = -1e30f; }
                        if (off + 32 >= rel) { lk1[i] = 0.f; s1[i] = -1e30f; }
                    }
                }
                float run = carry;
#pragma unroll
                for (int g = 3; g >= 0; --g) {
                    const float G = (lk1[4 * g] + lk1[4 * g + 1]) + (lk1[4 * g + 2] + lk1[4 * g + 3]);
                    const float Gp = __shfl_xor(G, 32);
                    const float base = run + (hh == 0 ? Gp : 0.f);
                    const float e3 = base, e2 = e3 + lk1[4 * g + 3], e1 = e2 + lk1[4 * g + 2], e0 = e1 + lk1[4 * g + 1];
                    s1[4 * g + 3] = fexp2(s1[4 * g + 3] + e3); s1[4 * g + 2] = fexp2(s1[4 * g + 2] + e2);
                    s1[4 * g + 1] = fexp2(s1[4 * g + 1] + e1); s1[4 * g] = fexp2(s1[4 * g] + e0);
                    run += G + Gp;
                }
#pragma unroll
                for (int g = 3; g >= 0; --g) {
                    const float G = (lk0[4 * g] + lk0[4 * g + 1]) + (lk0[4 * g + 2] + lk0[4 * g + 3]);
                    const float Gp = __shfl_xor(G, 32);
                    const float base = run + (hh == 0 ? Gp : 0.f);
                    const float e3 = base, e2 = e3 + lk0[4 * g + 3], e1 = e2 + lk0[4 * g + 2], e0 = e1 + lk0[4 * g + 1];
                    s0[4 * g + 3] = fexp2(s0[4 * g + 3] + e3); s0[4 * g + 2] = fexp2(s0[4 * g + 2] + e2);
                    s0[4 * g + 1] = fexp2(s0[4 * g + 1] + e1); s0[4 * g] = fexp2(s0[4 * g] + e0);
                    run += G + Gp;
                }
                carry = run;
            }
#pragma unroll
            for (int s2 = 0; s2 < 2; ++s2) {
                unsigned pk0[4], pk1[4];
#pragma unroll
                for (int j = 0; j < 4; ++j) { pk0[j] = pack_bf16(s0[8 * s2 + 2 * j], s0[8 * s2 + 2 * j + 1]); pk1[j] = pack_bf16(s1[8 * s2 + 2 * j], s1[8 * s2 + 2 * j + 1]); }
                const uint4 u0 = make_uint4(pk0[0], pk0[1], pk0[2], pk0[3]), u1 = make_uint4(pk1[0], pk1[1], pk1[2], pk1[3]);
                const bf16x8 pf0 = __builtin_bit_cast(bf16x8, u0), pf1 = __builtin_bit_cast(bf16x8, u1);
                const bf16x8 v00 = *(const bf16x8*)(vb + r * VROWB + (16 * s2 + 8 * hh) * 2);
                const bf16x8 v01 = *(const bf16x8*)(vb + (32 + r) * VROWB + (16 * s2 + 8 * hh) * 2);
                const bf16x8 v10 = *(const bf16x8*)(vb + r * VROWB + (32 + 16 * s2 + 8 * hh) * 2);
                const bf16x8 v11 = *(const bf16x8*)(vb + (32 + r) * VROWB + (32 + 16 * s2 + 8 * hh) * 2);
                o0 = MFMA(v00, pf0, o0); o1 = MFMA(v01, pf0, o1);
                o0 = MFMA(v10, pf1, o0); o1 = MFMA(v11, pf1, o1);
            }
        }
    };
#define SB_FLAGS(N_) do { if (TYPE == 2) { wdone = (__all(carry < -170.f) != 0); if (lane == 0) flags[((N_) & 1) * 4 + w] = wdone ? 1u : 0u; } } while (0)
#define SB_DONE(N_) (TYPE == 2 && ((flags[((N_) & 1) * 4] & flags[((N_) & 1) * 4 + 1] & flags[((N_) & 1) * 4 + 2] & flags[((N_) & 1) * 4 + 3]) != 0u))
    __syncthreads();
    if (TYPE == 2 && tid < 8) flags[tid] = 0;
    LOAD_TILE(A, TILE_OF(0));
    WAIT_ALL(A);
    STORE_TILE(A, 0);
    LOAD_TILE(A, TILE_OF(1));
    __syncthreads();
    for (int n = 0; n < ntiles; n += 2) {
        LOAD_TILE(B, TILE_OF(n + 2));
        __builtin_amdgcn_sched_barrier(0);
        compute(TILE_OF(n), 0);
        __builtin_amdgcn_sched_barrier(0);
        WAIT_OLD(A);
        STORE_TILE(A, 1);
        SB_FLAGS(n);
        __syncthreads();
        if (SB_DONE(n)) break;
        if (n + 1 >= ntiles) break;
        LOAD_TILE(A, TILE_OF(n + 3));
        __builtin_amdgcn_sched_barrier(0);
        compute(TILE_OF(n + 1), 1);
        __builtin_amdgcn_sched_barrier(0);
        WAIT_OLD(B);
        STORE_TILE(B, 0);
        SB_FLAGS(n + 1);
        __syncthreads();
        if (SB_DONE(n + 1)) break;
    }
    asm volatile("s_waitcnt vmcnt(0)" : "+v"(rk0A), "+v"(rk1A), "+v"(rv0A), "+v"(rv1A), "+v"(rkrA), "+v"(rckA), "+v"(rk0B), "+v"(rk1B), "+v"(rv0B), "+v"(rv1B), "+v"(rkrB), "+v"(rckB));
    float inv = 1.0f;
    if (TYPE != 2) { const float lt = lsum + __shfl_xor(lsum, 32); inv = frcp(lt); }
    bf16_t* yg = (TYPE == 0 ? p->qf : TYPE == 1 ? p->qn : p->qs) + tokq * 512 + h * 64;
#pragma unroll
    for (int g = 0; g < 4; ++g) {
        u32x2 a, c2;
        a.x = pack_bf16(o0[4 * g] * inv, o0[4 * g + 1] * inv); a.y = pack_bf16(o0[4 * g + 2] * inv, o0[4 * g + 3] * inv);
        c2.x = pack_bf16(o1[4 * g] * inv, o1[4 * g + 1] * inv); c2.y = pack_bf16(o1[4 * g + 2] * inv, o1[4 * g + 3] * inv);
        *(u32x2*)(yg + 8 * g + 4 * hh) = a;
        *(u32x2*)(yg + 32 + 8 * g + 4 * hh) = c2;
    }
}

DI void phase_attn(KargPtr p, unsigned char* smem) {
    for (int idx = bidx(); idx < 6144; idx += gdim()) {
        if (idx < 4096) {
            const int j = idx >> 9, g = (idx >> 7) & 3, rem = idx & 127, bh = rem & 63;
            const int qb = 31 - 4 * j - ((j & 1) ? 3 - g : g);
            const int type = ((rem >> 6) + j) & 1;
            if (type == 0) attn_item<0>(p, bh >> 3, bh & 7, qb, smem);
            else attn_item<1>(p, bh >> 3, bh & 7, qb, smem);
        } else {
            const int j = idx - 4096; const int qb = 31 - (j >> 6), bh = j & 63;
            attn_item<2>(p, bh >> 3, bh & 7, qb, smem);
        }
    }
}

DI void phase_merge(KargPtr p, int l, unsigned char* smem) {
    const bf16_t* WL = p->wt + (size_t)l * W_LAYER;
    unsigned* park = (unsigned*)(smem + 40960) + tidx();
    for (int it = 0;; ++it) {
        int mt, nt; if (!next_tile(it, 256, 8, mt, nt)) break;
        const int m0 = mt * 128;
        f32x16 mer[2][2]; zero_acc(mer);
#pragma unroll 1
        for (int br = 0; br < 3; ++br) {
            f32x16 acc[2][2]; zero_acc(acc);
            gemm_mainloop<32>(WL + W_GATE + (size_t)(br * 1024 + nt * 128) * 1024, 1024, p->u + (size_t)m0 * 1024, 1024, 1024, acc, smem);
#pragma unroll
            for (int a = 0; a < 2; ++a)
#pragma unroll
                for (int c = 0; c < 2; ++c)
#pragma unroll
                    for (int j = 0; j < 8; ++j) park[((a * 2 + c) * 8 + j) * 256] = pack_bf16(sigmoidf_(acc[a][c][2 * j]), sigmoidf_(acc[a][c][2 * j + 1]));
            zero_acc(acc);
            const bf16_t* Y = (br == 0 ? p->qf : br == 1 ? p->qn : p->qs) + (size_t)m0 * 512;
            const bf16_t* WO = WL + (br == 0 ? W_OF : br == 1 ? W_OM : W_OS) + (size_t)nt * 128 * 512;
            gemm_mainloop<32>(WO, 512, Y, 512, 512, acc, smem);
#pragma unroll
            for (int a = 0; a < 2; ++a)
#pragma unroll
                for (int c = 0; c < 2; ++c)
#pragma unroll
                    for (int j = 0; j < 8; ++j) {
                        const unsigned gv = park[((a * 2 + c) * 8 + j) * 256];
                        const float g0 = __uint_as_float(gv << 16), g1 = __uint_as_float(gv & 0xffff0000u);
                        mer[a][c][2 * j] += g0 * acc[a][c][2 * j]; mer[a][c][2 * j + 1] += g1 * acc[a][c][2 * j + 1];
                    }
        }
        stage_store_128(mer, p->merged + (size_t)m0 * 1024 + nt * 128, 1024, smem);
    }
}

DI void store_residual_big(const f32x16 (&acc)[2][4], const float* xin, float* xout, const float* gate, int m0, int n0) {
    const int tid = tidx(), lane = tid & 63, w = tid >> 6, wm = w >> 1, wn = w & 1, r = lane & 31, hh = lane >> 5;
#pragma unroll
    for (int qi = 0; qi < 4; ++qi) {
        const int col = n0 + wn * 128 + qi * 32 + r;
        const float gt = gate[col];
#pragma unroll
        for (int mi = 0; mi < 2; ++mi) {
            const size_t base = (size_t)(m0 + wm * 64 + mi * 32 + 4 * hh) * 1024 + col;
#pragma unroll
            for (int hf = 0; hf < 2; ++hf) {
                float xv[8];
#pragma unroll
                for (int i = 0; i < 8; ++i) xv[i] = xin[base + (size_t)(8 * ((8 * hf + i) >> 2) + (i & 3)) * 1024];
#pragma unroll
                for (int i = 0; i < 8; ++i) xout[base + (size_t)(8 * ((8 * hf + i) >> 2) + (i & 3)) * 1024] = xv[i] + gt * acc[mi][qi][8 * hf + i];
            }
        }
    }
}

DI void phase_outproj(KargPtr p, int l, unsigned char* smem) {
    const bf16_t* W = p->wt + (size_t)l * W_LAYER + W_OUT;
    const float* xin = (l == 0) ? p->x : p->out;
    for (int it = 0;; ++it) {
        int mt, nt; if (!next_tile(it, 256, 4, mt, nt)) break;
        const int m0 = mt * 128, b = m0 >> 12;
        f32x16 acc[2][4]; zero_big(acc);
        gemm_big(p->merged + (size_t)m0 * 1024, 1024, W + (size_t)nt * 256 * 1024, 1024, 1024, acc, smem);
        store_residual_big(acc, xin, p->out, p->mod + (size_t)(l * 8 + b) * 6144 + 2 * 1024, m0, nt * 256);
    }
}

DI void phase_ffn_up(KargPtr p, int l, unsigned char* smem) {
    const int tid = tidx(), lane = tid & 63, w = tid >> 6, wm = w >> 1, wn = w & 1, r = lane & 31, hh = lane >> 5;
    const bf16_t* W = p->wt + (size_t)l * W_LAYER + W_FGU;
    for (int it = 0;; ++it) {
        int mt, nt; if (!next_tile(it, 128, 44, mt, nt)) break;
        const int m0 = mt * 256;
        f32x16 acc[2][4]; zero_big(acc);
        gemm_big(W + (size_t)nt * 128 * 1024, 1024, p->u + (size_t)m0 * 1024, 1024, 1024, acc, smem);
#pragma unroll
        for (int qi = 0; qi < 4; ++qi) {
            unsigned char* trow = smem + (wn * 128 + qi * 32 + r) * 144 + (wm * 32 + 4 * hh) * 2;
#pragma unroll
            for (int g = 0; g < 4; ++g) {
                float hv[4];
#pragma unroll
                for (int e = 0; e < 4; ++e) { const float gv = acc[0][qi][4 * g + e]; hv[e] = gv * sigmoidf_(gv) * acc[1][qi][4 * g + e]; }
                u32x2 pk; pk.x = pack_bf16(hv[0], hv[1]); pk.y = pack_bf16(hv[2], hv[3]);
                *(u32x2*)(trow + 8 * g * 2) = pk;
            }
        }
        __syncthreads();
        bf16_t* dst = p->h + (size_t)m0 * 2816 + nt * 64;
        const int q0 = tid >> 3, x = tid & 7;
#pragma unroll
        for (int j = 0; j < 8; ++j) {
            const uint4 v = *(const uint4*)(smem + (q0 + 32 * j) * 144 + x * 16);
            *(uint4*)(dst + (size_t)(q0 + 32 * j) * 2816 + x * 8) = v;
        }
        __syncthreads();
    }
}

DI void phase_ffn_down(KargPtr p, int l, unsigned char* smem) {
    const bf16_t* W = p->wt + (size_t)l * W_LAYER + W_FD;
    for (int it = 0;; ++it) {
        int mt, nt; if (!next_tile(it, 256, 4, mt, nt)) break;
        const int m0 = mt * 128, b = m0 >> 12;
        f32x16 acc[2][4]; zero_big(acc);
        gemm_big(p->h + (size_t)m0 * 2816, 2816, W + (size_t)nt * 256 * 2816, 2816, 2816, acc, smem);
        store_residual_big(acc, p->out, p->out, p->mod + (size_t)(l * 8 + b) * 6144 + 5 * 1024, m0, nt * 256);
    }
}

DI void run_phase(int ph, int l, unsigned char* smem) {
#ifdef ONLY_PH
    if (ph != ONLY_PH) return;
#endif
    KargPtr p = karg();
    switch (ph) {
    case 0: phase_prep(p, smem); break;
    case 1: phase_norm((l == 0) ? p->x : p->out, p->g_mix + l * 1024, p->mod + (size_t)l * 8 * 6144, 0, 1, p->u); break;
    case 2: phase_inproj(p, l, smem); break;
    case 3: phase_mla_up(p, l, smem); break;
    case 4: phase_attn(p, smem); break;
    case 5: phase_merge(p, l, smem); break;
    case 6: phase_outproj(p, l, smem); break;
    case 7: phase_norm(p->out, p->g_ffn + l * 1024, p->mod + (size_t)l * 8 * 6144, 3, 4, p->u); break;
    case 8: phase_ffn_up(p, l, smem); break;
    case 9: phase_ffn_down(p, l, smem); break;
    default: phase_final(p); break;
    }
}


#define XB_TMO      128
#define XB_XCNT(j)  (256  + 64 * (j))
#define XB_XSUB(j)  (1280 + 64 * (j))
#define XB_XGEN(j)  (2304 + 64 * (j))
#define XB_TOP      3328
#define XB_TOPGEN   3392
#define XCD_BAR_WORDS 3456
#define XB_SPIN_CAP (1u << 20)
#define LAS __attribute__((address_space(3)))
DI unsigned xb_ld(unsigned* p)              { return __hip_atomic_load(p, __ATOMIC_RELAXED, __HIP_MEMORY_SCOPE_AGENT); }
DI unsigned xb_add(unsigned* p, unsigned v) { return __hip_atomic_fetch_add(p, v, __ATOMIC_RELAXED, __HIP_MEMORY_SCOPE_AGENT); }
DI unsigned xb_xcc_id() { return (unsigned)__builtin_amdgcn_s_getreg((3 << 11) | 20) & 0xFu; }
#define XB_SPIN(cond, bar) do { unsigned _sp = 0; while (cond) { __builtin_amdgcn_s_sleep(1); \
    if ((++_sp & 255u) == 0u) { if (xb_ld(&(bar)[XB_TMO])) break; if (_sp > XB_SPIN_CAP) { atomicAdd(&(bar)[XB_TMO], 1u); break; } } } } while (0)
struct XcdBarrier { unsigned* bar; unsigned x; volatile LAS unsigned* st; };
DI XcdBarrier xcd_barrier_post(unsigned* bar, volatile LAS unsigned* st) {
    XcdBarrier b; b.bar = bar; b.x = xb_xcc_id(); b.st = st;
    if (threadIdx.x == 0) (void)xb_add(&bar[XB_XCNT(b.x)], 1u);
    return b;
}
DI void xcd_barrier_complete(unsigned* bar, unsigned x, unsigned& nloc, unsigned& nx) {
    const unsigned G = gridDim.x * gridDim.y * gridDim.z;
    unsigned sum, cnt, mine, sp = 0u;
    for (;;) {
        sum = 0u; cnt = 0u; mine = 0u;
#pragma unroll
        for (unsigned j = 0; j < 16; ++j) { const unsigned c = xb_ld(&bar[XB_XCNT(j)]); sum += c; cnt += (c > 0u) ? 1u : 0u; mine = (j == x) ? c : mine; }
        if (sum == G) break;
        __builtin_amdgcn_s_sleep(1);
        if ((++sp & 255u) == 0u) { if (xb_ld(&bar[XB_TMO])) break; if (sp > XB_SPIN_CAP) { atomicAdd(&bar[XB_TMO], 1u); break; } }
    }
    nloc = mine > 0u ? mine : 1u; nx = cnt > 0u ? cnt : 1u;
}
DI void xcd_barrier(const XcdBarrier& b) {
    asm volatile("s_waitcnt vmcnt(0)" ::: "memory");
    __syncthreads();
    if (threadIdx.x == 0) {
        unsigned* bar = b.bar;
        __builtin_amdgcn_s_waitcnt(0);
        unsigned nloc = b.st[0], nx = b.st[1];
        if (nloc == 0u) { xcd_barrier_complete(bar, b.x, nloc, nx); b.st[0] = nloc; b.st[1] = nx; }
        const unsigned old = xb_add(&bar[XB_XSUB(b.x)], 1u);
        const unsigned gen = old / nloc;
        if (old + 1u == (gen + 1u) * nloc) {
            __builtin_amdgcn_fence(__ATOMIC_RELEASE, "agent");
            asm volatile("s_waitcnt vmcnt(0)" ::: "memory");
            const unsigned og = xb_add(&bar[XB_TOP], 1u);
            const unsigned tg = og / nx;
            if (og + 1u == (tg + 1u) * nx) xb_add(&bar[XB_TOPGEN], 1u);
            else XB_SPIN(xb_ld(&bar[XB_TOPGEN]) == tg, bar);
            __builtin_amdgcn_fence(__ATOMIC_ACQUIRE, "agent");
            xb_add(&bar[XB_XGEN(b.x)], 1u);
            asm volatile("s_waitcnt vmcnt(0)" ::: "memory");
        } else {
            XB_SPIN(xb_ld(&bar[XB_XGEN(b.x)]) == gen, bar);
            __builtin_amdgcn_fence(__ATOMIC_ACQUIRE, "agent");
            asm volatile("s_waitcnt vmcnt(0)" ::: "memory");
        }
    }
    __syncthreads();
}

#if MEGA
__global__ void __launch_bounds__(256, 2) __attribute__((amdgpu_waves_per_eu(2, 2))) mega_kernel(Params p) {
    extern __shared__ __attribute__((aligned(16))) unsigned char smem[];
    cg::grid_group grid = cg::this_grid();
    volatile LAS unsigned* st = (volatile LAS unsigned*)(smem + SMEM_BYTES - 16);
    if (threadIdx.x == 0) { st[0] = 0u; st[1] = 0u; }
    __syncthreads();
    const XcdBarrier xb = xcd_barrier_post(karg()->bar, st);
    run_phase(0, 0, smem);
    grid.sync();
#pragma unroll 1
    for (int l = 0; l < 2; ++l) {
#pragma unroll 1
        for (int ph = 1; ph <= 9; ++ph) {
            run_phase(ph, l, smem); xcd_barrier(xb);
#ifdef DBL_PH
            if (ph == DBL_PH) { run_phase(ph, l, smem); xcd_barrier(xb); }
#endif
        }
    }
    run_phase(10, 0, smem);
}
#else
__global__ void __launch_bounds__(256, 2) __attribute__((amdgpu_waves_per_eu(2, 2))) phase_kernel(Params p, int ph, int l) {
    extern __shared__ __attribute__((aligned(16))) unsigned char smem[];
    run_phase(ph, l, smem);
}
#endif

extern "C" void kernel_launch(void* const* d_in, const int* in_sizes, int n_in, void* d_out, int out_size, void* d_ws, size_t ws_size, hipStream_t stream) {
    (void)in_sizes; (void)n_in; (void)out_size;
    Params p{};
    p.x = (const float*)d_in[0]; p.c = (const float*)d_in[1]; p.pos = (const int*)d_in[2];
    p.g_mix = (const float*)d_in[3]; p.w_ada = (const float*)d_in[4]; p.b_ada = (const float*)d_in[5]; p.w_in = (const float*)d_in[6]; p.b_fox_f = (const float*)d_in[7];
    p.g_mla_q = (const float*)d_in[8]; p.w_mla_uq = (const float*)d_in[9]; p.g_mla_kv = (const float*)d_in[10]; p.w_mla_ukv = (const float*)d_in[11];
    p.w_o_fox = (const float*)d_in[12]; p.w_o_mla = (const float*)d_in[13]; p.w_o_sb = (const float*)d_in[14]; p.w_out = (const float*)d_in[15];
    p.g_ffn = (const float*)d_in[16]; p.w_ffn_gate = (const float*)d_in[17]; p.w_ffn_up = (const float*)d_in[18]; p.w_ffn_down = (const float*)d_in[19]; p.g_final = (const float*)d_in[20];
    p.out = (float*)d_out;
    unsigned char* ws = (unsigned char*)d_ws; size_t off = 0;
    auto take = [&](size_t bytes) { unsigned char* q = ws + off; off += (bytes + 255) & ~(size_t)255; return q; };
    p.bar = (unsigned*)take(16384);
    p.wt = (bf16_t*)take(2 * W_LAYER * 2);
    p.mod = (float*)take(2 * 8 * 6144 * 4);
    p.ropetab = (float*)take((size_t)T_TOK * 16 * 2 * 4);
    p.logf = (float*)take((size_t)64 * SEQ * 4);
    p.cum = (float*)take((size_t)64 * SEQ * 4);
    p.u = (bf16_t*)take((size_t)T_TOK * 1024 * 2);
    p.qf = (bf16_t*)take((size_t)T_TOK * 512 * 2);
    p.kf = (bf16_t*)take((size_t)T_TOK * 512 * 2);
    p.vtf = (bf16_t*)take((size_t)T_TOK * 512 * 2);
    p.qs = (bf16_t*)take((size_t)T_TOK * 512 * 2);
    p.ks = (bf16_t*)take((size_t)T_TOK * 512 * 2);
    p.vts = (bf16_t*)take((size_t)T_TOK * 512 * 2);
    p.ql = (bf16_t*)take((size_t)T_TOK * 384 * 2);
    p.kvl = (bf16_t*)take((size_t)T_TOK * 256 * 2);
    p.kr = (bf16_t*)take((size_t)T_TOK * 32 * 2);
    p.qn = (bf16_t*)take((size_t)T_TOK * 512 * 2);
    p.qr = (bf16_t*)take((size_t)T_TOK * 256 * 2);
    p.kn = (bf16_t*)take((size_t)T_TOK * 512 * 2);
    p.vtm = (bf16_t*)take((size_t)T_TOK * 512 * 2);
    p.merged = p.kf;
    p.h = p.qf;
    if (off > ws_size) { fprintf(stderr, "kernel_launch: workspace too small: need %zu, have %zu\n", off, ws_size); return; }

#if MEGA
    static int grid_blocks = 0;
    if (!grid_blocks) {
        int dev = 0, cus = 0, per_cu = 0;
        (void)hipGetDevice(&dev);
        (void)hipDeviceGetAttribute(&cus, hipDeviceAttributeMultiprocessorCount, dev);
        (void)hipFuncSetAttribute((const void*)mega_kernel, hipFuncAttributeMaxDynamicSharedMemorySize, SMEM_BYTES);
        (void)hipOccupancyMaxActiveBlocksPerMultiprocessor(&per_cu, (const void*)mega_kernel, 256, SMEM_BYTES);
        per_cu = 2;
        grid_blocks = cus * per_cu;
        grid_blocks &= ~7;
    }
    (void)hipMemsetAsync(p.bar, 0, 16384, stream);
    void* args[] = {&p};
    hipError_t e = hipLaunchCooperativeKernel((const void*)mega_kernel, dim3(grid_blocks), dim3(256), args, SMEM_BYTES, stream);
    if (e != hipSuccess) fprintf(stderr, "cooperative launch failed: %s (grid %d)\n", hipGetErrorString(e), grid_blocks);
#else
    static bool attr = false;
    if (!attr) { (void)hipFuncSetAttribute((const void*)phase_kernel, hipFuncAttributeMaxDynamicSharedMemorySize, SMEM_BYTES); attr = true; }
    const int G = 512;
    hipLaunchKernelGGL(phase_kernel, dim3(G), dim3(256), SMEM_BYTES, stream, p, 0, 0);
    for (int l = 0; l < 2; ++l)
        for (int ph = 1; ph <= 9; ++ph) hipLaunchKernelGGL(phase_kernel, dim3(G), dim3(256), SMEM_BYTES, stream, p, ph, l);
    hipLaunchKernelGGL(phase_kernel, dim3(G), dim3(256), SMEM_BYTES, stream, p, 10, 0);
#endif
}
```

```cpp
#include <hip/hip_runtime.h>
#include <hip/hip_cooperative_groups.h>
#include <cstdint>
#include <cstdio>
namespace cg = cooperative_groups;

#ifndef MEGA
#define MEGA 1
#endif

typedef unsigned short bf16_t;
typedef short bf16x8 __attribute__((ext_vector_type(8)));
typedef float f32x16 __attribute__((ext_vector_type(16)));
typedef float f32x4 __attribute__((ext_vector_type(4)));
typedef unsigned u32x2 __attribute__((ext_vector_type(2)));
#define DI __device__ __forceinline__
typedef unsigned u32x4 __attribute__((ext_vector_type(4)));
#define GLOAD16(dst, ptr) asm volatile("global_load_dwordx4 %0, %1, off" : "=v"(dst) : "v"(ptr))
#define GLOAD4(dst, ptr)  asm volatile("global_load_dword %0, %1, off" : "=v"(dst) : "v"(ptr))
#define MFMA(a, b, c) __builtin_amdgcn_mfma_f32_32x32x16_bf16((a), (b), (c), 0, 0, 0)

namespace pg8 {
#define PG8_LAS __attribute__((address_space(3)))
typedef unsigned short bf16_t;
typedef short bf16x8 __attribute__((ext_vector_type(8)));
typedef float f32x4 __attribute__((ext_vector_type(4)));
typedef unsigned u32x4 __attribute__((ext_vector_type(4)));
constexpr int BM = 256, BK = 64, HALF = 128, HTB = HALF * BK * 2  , STAGE_BYTES = 8 * HTB, NXCD = 8, WGM = 8;

__host__ __device__ __forceinline__ int lds_byte(int r, int c) { const int st = (r >> 4) * 2 + (c >> 5), rr = r & 15, cc = c & 31, ob = rr * 64 + cc * 2; return st * 1024 + (ob ^ (((ob >> 9) & 1) << 5)); }
__host__ __device__ __forceinline__ void stage_rc(int b, int& R, int& C) { const int st = b / 1024, sb = b % 1024, swz = sb ^ (((sb >> 9) & 1) << 5); R = (st >> 1) * 16 + swz / 64; C = (st & 1) * 32 + (swz % 64) / 2; }
__host__ __device__ __forceinline__ int perm32(int rho) { const int n = rho >> 4, i = rho & 15; return 8 * (i >> 2) + 4 * n + (i & 3); }

struct Unit { int pm, pn; };
struct Gemm { const bf16_t* A; const bf16_t* Bt; int M, N, K; };

struct StaticOrder {
    int nM, nN, nwg, G, c;
    __host__ __device__ void init(int M, int N, int G_, int c_) { nM = M / BM; nN = N / BM; nwg = nM * nN; G = G_; c = c_; }
    __host__ __device__ bool next(int i, Unit& u) const {
        const long L = (long)i * G + c; if (L >= nwg) return false;
        int wgid = (int)L; { const int q = nwg / NXCD, r = nwg % NXCD, xcd = wgid % NXCD, off = wgid / NXCD; wgid = (xcd < r ? xcd * (q + 1) : r * (q + 1) + (xcd - r) * q) + off; }
        const int nig = WGM * nN, gid = wgid / nig, fm = gid * WGM, gsz = (nM - fm) < WGM ? (nM - fm) : WGM;
        u.pm = fm + ((wgid % nig) % gsz); u.pn = (wgid % nig) / gsz; return true;
    }
    __device__ __forceinline__ void a_ready(const Unit&) const {}
    __device__ __forceinline__ void done(const Unit&) const {}
};
template <class Epi, class Sched, bool ALIGN_EPI = false, bool SP2 = false>
__device__ __forceinline__ void gemm_phase(PG8_LAS unsigned char* lds, const Gemm g, const Sched& S, const Epi& E) {
    int tid = threadIdx.x; asm volatile("" : "+v"(tid)); const int wid = __builtin_amdgcn_readfirstlane(tid >> 6), lane = tid & 63, wr = wid >> 2, wc = wid & 3, fr = lane & 15, fq = lane >> 4;
    const int K = g.K, nt = K / BK;
    unsigned voffA[2], voffB[2];
#pragma unroll
    for (int i = 0; i < 2; ++i) { int R, C; stage_rc(tid * 16 + i * 8192, R, C); const int Rb = Epi::PERM ? ((R & ~31) + perm32(R & 31)) : R;
        voffA[i] = (unsigned)(R * K + C) * 2u; voffB[i] = (unsigned)(Rb * K + C) * 2u; }
    const size_t kstep = (size_t)(BK * 2);
    const size_t hstep = (size_t)HALF * K * 2;
    const size_t tstep = 2 * hstep;
    const unsigned ldsw = (unsigned)wid * 1024u;
    const int aoff = lds_byte(wr * 64 + fr, fq * 8), boff = lds_byte(wc * 32 + fr, fq * 8);
#define PG8_SA(b, h) (((b) * 2 + (h)) * HTB)
#define PG8_SB(b, h) ((4 + (b) * 2 + (h)) * HTB)
#define PG8_STAGE(bufoff, gbase, voff) do { _Pragma("unroll") for (int _i = 0; _i < 2; ++_i) \
        __builtin_amdgcn_global_load_lds((const unsigned*)((const char*)(gbase) + (voff)[_i]), (PG8_LAS unsigned*)(lds + (bufoff) + ldsw + _i * 8192), 16, 0, 0); } while (0)
#define PG8_LDA(dst, b, h) do { _Pragma("unroll") for (int m = 0; m < 4; ++m) _Pragma("unroll") for (int k = 0; k < 2; ++k) dst[m][k] = *(const PG8_LAS bf16x8*)(lds + PG8_SA(b, h) + aoff + m * 2048 + k * 1024); } while (0)
#define PG8_LDB(dst, b, h) do { _Pragma("unroll") for (int n = 0; n < 2; ++n) _Pragma("unroll") for (int k = 0; k < 2; ++k) dst[n][k] = *(const PG8_LAS bf16x8*)(lds + PG8_SB(b, h) + boff + n * 2048 + k * 1024); } while (0)
#define PG8_MMA(ai, bj, At, Bt) do { __builtin_amdgcn_s_setprio(1); _Pragma("unroll") for (int m = 0; m < 4; ++m) _Pragma("unroll") for (int n = 0; n < 2; ++n) _Pragma("unroll") for (int k = 0; k < 2; ++k) \
        acc[ai][bj][m][n] = __builtin_amdgcn_mfma_f32_16x16x32_bf16(Bt[n][k], At[m][k], acc[ai][bj][m][n], 0, 0, 0); __builtin_amdgcn_s_setprio(0); } while (0)
#define PG8_WAIT_V(n) asm volatile("s_waitcnt vmcnt(" #n ")" ::: "memory")
#define PG8_WAIT_L(n) asm volatile("s_waitcnt lgkmcnt(" #n ")" ::: "memory")
#define PG8_BAR __builtin_amdgcn_s_barrier()
#define PG8_SCHED __builtin_amdgcn_sched_barrier(0)
    Unit cur, nxt; int ui = 0;
    if (!S.next(0, cur)) return;
    f32x4 acc[2][2][4][2];
#pragma unroll
    for (int a = 0; a < 2; ++a)
#pragma unroll
        for (int b = 0; b < 2; ++b)
#pragma unroll
            for (int m = 0; m < 4; ++m)
#pragma unroll
                for (int n = 0; n < 2; ++n) acc[a][b][m][n] = (f32x4){0.f, 0.f, 0.f, 0.f};
    bf16x8 At[4][2], B0[2][2], B1[2][2];
    const char* cA = (const char*)g.A + (size_t)cur.pm * tstep; const char* cB = (const char*)g.Bt + (size_t)cur.pn * tstep;
    S.a_ready(cur);
    if constexpr (SP2) {
        PG8_STAGE(PG8_SB(0, 0), cB, voffB); PG8_STAGE(PG8_SB(0, 1), cB + hstep, voffB); PG8_STAGE(PG8_SA(0, 0), cA, voffA); PG8_STAGE(PG8_SA(0, 1), cA + hstep, voffA);
        if (wr == 1) PG8_BAR;
        PG8_WAIT_V(2); PG8_BAR;
        PG8_STAGE(PG8_SB(1, 0), cB + kstep, voffB); PG8_STAGE(PG8_SA(1, 0), cA + kstep, voffA); PG8_STAGE(PG8_SB(1, 1), cB + hstep + kstep, voffB);
        PG8_WAIT_V(6); PG8_BAR;
    } else {
        PG8_STAGE(PG8_SB(0, 0), cB, voffB); PG8_STAGE(PG8_SA(0, 0), cA, voffA); PG8_STAGE(PG8_SB(0, 1), cB + hstep, voffB); PG8_STAGE(PG8_SA(0, 1), cA + hstep, voffA);
        if (wr == 1) PG8_BAR;
        PG8_WAIT_V(4); PG8_BAR;
        PG8_STAGE(PG8_SB(1, 0), cB + kstep, voffB); PG8_STAGE(PG8_SA(1, 0), cA + kstep, voffA); PG8_STAGE(PG8_SB(1, 1), cB + hstep + kstep, voffB);
        PG8_WAIT_V(6); PG8_BAR;
    }
    for (;;) {
        const bool has_next = S.next(ui + 1, nxt);
        const char* nA = has_next ? (const char*)g.A + (size_t)nxt.pm * tstep : cA; const char* nB = has_next ? (const char*)g.Bt + (size_t)nxt.pn * tstep : cB;
        for (int t = 0; t < nt; t += 2) {
            const bool last = (t == nt - 2);
            const char* a1 = cA + (size_t)(t + 1) * kstep;
            const char* a2 = last ? nA : cA + (size_t)(t + 2) * kstep; const char* b2 = last ? nB : cB + (size_t)(t + 2) * kstep;
            const char* a3 = a2 + kstep; const char* b3 = b2 + kstep;
            if (last && has_next) S.a_ready(nxt);
            if constexpr (SP2) {
            PG8_LDB(B0, 0, 0); PG8_LDB(B1, 0, 1); PG8_SCHED; PG8_LDA(At, 0, 0); PG8_STAGE(PG8_SA(1, 1), a1 + hstep, voffA);
            PG8_WAIT_V(8); PG8_WAIT_L(0); PG8_BAR; PG8_MMA(0, 0, At, B0); PG8_MMA(0, 1, At, B1); PG8_BAR; PG8_SCHED;
            PG8_LDA(At, 0, 1); PG8_STAGE(PG8_SB(0, 0), b2, voffB); PG8_STAGE(PG8_SB(0, 1), b2 + hstep, voffB); PG8_STAGE(PG8_SA(0, 0), a2, voffA);
            PG8_WAIT_V(8); PG8_WAIT_L(0); PG8_BAR; PG8_MMA(1, 0, At, B0); PG8_MMA(1, 1, At, B1); PG8_BAR; PG8_SCHED;
            PG8_LDB(B0, 1, 0); PG8_LDB(B1, 1, 1); PG8_SCHED; PG8_LDA(At, 1, 0); PG8_STAGE(PG8_SA(0, 1), a2 + hstep, voffA);
            PG8_WAIT_V(8); PG8_WAIT_L(0); PG8_BAR; PG8_MMA(0, 0, At, B0); PG8_MMA(0, 1, At, B1); PG8_BAR; PG8_SCHED;
            PG8_LDA(At, 1, 1); PG8_STAGE(PG8_SB(1, 0), b3, voffB); PG8_STAGE(PG8_SB(1, 1), b3 + hstep, voffB); PG8_STAGE(PG8_SA(1, 0), a3, voffA);
            PG8_WAIT_V(8); PG8_WAIT_L(0); PG8_BAR; PG8_MMA(1, 0, At, B0); PG8_MMA(1, 1, At, B1); PG8_BAR; PG8_SCHED;
            } else {
            PG8_LDB(B0, 0, 0); PG8_SCHED; PG8_LDA(At, 0, 0); PG8_STAGE(PG8_SA(1, 1), a1 + hstep, voffA);
            PG8_WAIT_L(8); PG8_BAR; PG8_WAIT_L(0); PG8_MMA(0, 0, At, B0); PG8_BAR; PG8_SCHED;
            PG8_LDB(B1, 0, 1); PG8_STAGE(PG8_SB(0, 0), b2, voffB);
            PG8_BAR; PG8_WAIT_L(0); PG8_MMA(0, 1, At, B1); PG8_BAR;
            PG8_LDA(At, 0, 1); PG8_STAGE(PG8_SA(0, 0), a2, voffA);
            PG8_BAR; PG8_WAIT_L(0); PG8_MMA(1, 0, At, B0); PG8_BAR; PG8_SCHED;
            PG8_STAGE(PG8_SB(0, 1), b2 + hstep, voffB);
            PG8_WAIT_V(6); PG8_BAR; PG8_MMA(1, 1, At, B1); PG8_BAR;
            PG8_LDB(B0, 1, 0); PG8_SCHED; PG8_LDA(At, 1, 0); PG8_STAGE(PG8_SA(0, 1), a2 + hstep, voffA);
            PG8_WAIT_L(8); PG8_BAR; PG8_WAIT_L(0); PG8_MMA(0, 0, At, B0); PG8_BAR; PG8_SCHED;
            PG8_LDB(B1, 1, 1); PG8_STAGE(PG8_SB(1, 0), b3, voffB);
            PG8_BAR; PG8_WAIT_L(0); PG8_MMA(0, 1, At, B1); PG8_BAR;
            PG8_LDA(At, 1, 1); PG8_STAGE(PG8_SA(1, 0), a3, voffA);
            PG8_BAR; PG8_WAIT_L(0); PG8_MMA(1, 0, At, B0); PG8_BAR; PG8_SCHED;
            PG8_STAGE(PG8_SB(1, 1), b3 + hstep, voffB);
            PG8_WAIT_V(6); PG8_BAR; PG8_MMA(1, 1, At, B1); PG8_BAR;
            }
        }
        if constexpr (ALIGN_EPI) { if (wr == 0) PG8_BAR; }
        if constexpr (!Epi::AFTER_DRAIN) { E(acc, cur, wr, wc, fr, fq); S.done(cur); }
        if (!has_next) break;
#pragma unroll
        for (int a = 0; a < 2; ++a)
#pragma unroll
            for (int b = 0; b < 2; ++b)
#pragma unroll
                for (int m = 0; m < 4; ++m)
#pragma unroll
                    for (int n = 0; n < 2; ++n) acc[a][b][m][n] = (f32x4){0.f, 0.f, 0.f, 0.f};
        cur = nxt; cA = nA; cB = nB; ++ui;
        if constexpr (ALIGN_EPI) { if (wr == 1) PG8_BAR; }
    }
    PG8_WAIT_V(0);
    if constexpr (!ALIGN_EPI) { if (wr == 0) PG8_BAR; }
    PG8_BAR;
    if constexpr (Epi::AFTER_DRAIN) { E.fused(acc, cur, wr, wc, fr, fq, lds, wid, lane); S.done(cur); }
#undef PG8_SA
#undef PG8_SB
#undef PG8_STAGE
#undef PG8_LDA
#undef PG8_LDB
#undef PG8_MMA
#undef PG8_WAIT_V
#undef PG8_WAIT_L
#undef PG8_BAR
#undef PG8_SCHED
}
}

constexpr int T_TOK = 32768;
constexpr int SEQ = 4096;
constexpr float LOG2E = 1.4426950408889634f;
constexpr float FOX_QS = 0.125f * 1.4426950408889634f;
constexpr float MLA_QS = 0.10206207261596575f * 1.4426950408889634f;
constexpr float EPS = 1e-6f;

constexpr size_t W_IN = 0, W_GATE = 4063232, W_UQ = 7208960, W_UKV = 7503872, W_OF = 7766016, W_OM = 8290304, W_OS = 8814592,
                 W_OUT = 9338880, W_FGU = 10387456, W_FD = 16154624, W_LAYER = 19038208;

constexpr int SMEM_BYTES = 2 * 74752 + 64 + 16;

struct Params {
    const float* x; const float* c; const int* pos;
    const float* g_mix; const float* w_ada; const float* b_ada; const float* w_in; const float* b_fox_f;
    const float* g_mla_q; const float* w_mla_uq; const float* g_mla_kv; const float* w_mla_ukv;
    const float* w_o_fox; const float* w_o_mla; const float* w_o_sb; const float* w_out;
    const float* g_ffn; const float* w_ffn_gate; const float* w_ffn_up; const float* w_ffn_down; const float* g_final;
    float* out;
    bf16_t* wt; float* mod; float* ropetab; float* logf; float* cum;
    bf16_t* u; bf16_t* qf; bf16_t* kf; bf16_t* vtf; bf16_t* qs; bf16_t* ks; bf16_t* vts;
    bf16_t* ql; bf16_t* kvl; bf16_t* kr; bf16_t* qn; bf16_t* qr; bf16_t* kn; bf16_t* vtm;
    bf16_t* merged; bf16_t* h;
    unsigned* bar;
};
typedef const __attribute__((address_space(4))) Params* KargPtr;
#if defined(__HIP_DEVICE_COMPILE__)
__device__ __forceinline__ KargPtr karg() { KargPtr pp = (KargPtr)__builtin_amdgcn_kernarg_segment_ptr(); asm volatile("" : "+s"(pp)); return pp; }
#else
__device__ __forceinline__ KargPtr karg() { return nullptr; }
#endif

__device__ const float ROPE_INV[16] = {1.0f, 0.5623413324356079f, 0.3162277638912201f, 0.17782793939113617f, 0.10000000149011612f, 0.05623413249850273f,
    0.03162277489900589f, 0.017782794311642647f, 0.009999999776482582f, 0.005623413249850273f, 0.003162277629598975f, 0.0017782794311642647f,
    0.0010000000474974513f, 0.000562341301701963f, 0.0003162277571391314f, 0.00017782794020604342f};

typedef __bf16 bf16x2_t __attribute__((ext_vector_type(2)));
typedef float f32x2_t __attribute__((ext_vector_type(2)));
DI unsigned pack_bf16(float lo, float hi) { const f32x2_t v = {lo, hi}; const bf16x2_t b = __builtin_convertvector(v, bf16x2_t); return __builtin_bit_cast(unsigned, b); }
DI bf16_t f2bf(float x) { return (bf16_t)(pack_bf16(x, 0.f) & 0xffffu); }
DI int vhalf() { return __builtin_amdgcn_readfirstlane((int)(threadIdx.x >> 8)); }
DI int tidx() { int t = threadIdx.x & 255; asm volatile("" : "+v"(t)); return t; }
DI int bidx() { int t = __builtin_amdgcn_readfirstlane((int)(blockIdx.x * 2 + (threadIdx.x >> 8))); asm volatile("" : "+s"(t)); return t; }
DI int gdim() { int t = gridDim.x * 2; asm volatile("" : "+s"(t)); return t; }
constexpr int VSMEM = 74752;
constexpr int FLAGS_OFF = 2 * VSMEM;
DI float fexp2(float x) { return __builtin_amdgcn_exp2f(x); }
DI float flog2(float x) { return __builtin_amdgcn_logf(x); }
DI float frcp(float x) { return __builtin_amdgcn_rcpf(x); }
DI float sigmoidf_(float x) { return frcp(1.0f + fexp2(-x * LOG2E)); }

DI bool next_tile(int it, int MT, int NT, int& mt, int& nt) {
    const int perx = gdim() >> 3, xcd = bidx() & 7, slot = bidx() >> 3;
    const long L = ((long)it * 8 + xcd) * perx + slot;
    if (L >= (long)MT * NT) return false;
    const int gsz = 8 * NT; const int grp = (int)(L / gsz), wi = (int)(L % gsz);
    mt = grp * 8 + (wi & 7); nt = wi >> 3; return true;
}

template <int BK>
DI void gemm_mainloop(const bf16_t* A, int lda, const bf16_t* B, int ldb, int K, f32x16 (&acc)[2][2], unsigned char* smem) {
    constexpr int CPR = BK / 8;
    constexpr int RPP = 256 / CPR;
    constexpr int NJ = 128 / RPP;
    constexpr int ROWB = BK * 2 + 16;
    constexpr int OPB = 128 * ROWB;
    constexpr int STB = 2 * OPB;
    constexpr int PASSB = RPP * ROWB;
    const int tid = tidx(), lane = tid & 63, w = tid >> 6, wm = w >> 1, wn = w & 1, r = lane & 31, hh = lane >> 5;
    const int lrow = tid / CPR, lcol = (tid % CPR) * 8;
    const bf16_t* ap = A + (size_t)lrow * lda + lcol;
    const bf16_t* bp = B + (size_t)lrow * ldb + lcol;
    const size_t astep = (size_t)RPP * lda, bstep = (size_t)RPP * ldb;
    const int st_off = lrow * ROWB + (tid % CPR) * 16;
    u32x4 ra0, ra1, ra2, ra3, rb0, rb1, rb2, rb3;
    ra0 = *(const u32x4*)(ap); rb0 = *(const u32x4*)(bp);
    ra1 = *(const u32x4*)(ap + astep); rb1 = *(const u32x4*)(bp + bstep);
    if constexpr (NJ == 4) { ra2 = *(const u32x4*)(ap + 2 * astep); rb2 = *(const u32x4*)(bp + 2 * bstep); ra3 = *(const u32x4*)(ap + 3 * astep); rb3 = *(const u32x4*)(bp + 3 * bstep); }
    else { ra2 = ra0; ra3 = ra0; rb2 = rb0; rb3 = rb0; }
#define GEMM_STAGE(D_) do { unsigned char* d_ = (D_); \
        *(u32x4*)(d_) = ra0; *(u32x4*)(d_ + OPB) = rb0; *(u32x4*)(d_ + PASSB) = ra1; *(u32x4*)(d_ + OPB + PASSB) = rb1; \
        if constexpr (NJ == 4) { *(u32x4*)(d_ + 2 * PASSB) = ra2; *(u32x4*)(d_ + OPB + 2 * PASSB) = rb2; *(u32x4*)(d_ + 3 * PASSB) = ra3; *(u32x4*)(d_ + OPB + 3 * PASSB) = rb3; } } while (0)
    GEMM_STAGE(smem + st_off);
    __syncthreads();
    const int nk = K / BK;
    const int rdA = (wm * 64 + r) * ROWB + hh * 16;
    const int rdB = OPB + (wn * 64 + r) * ROWB + hh * 16;
#define GEMM_FRAGS(KS_, A0_, A1_, B0_, B1_) do { \
        A0_ = *(const bf16x8*)(sa + (KS_) * 32); A1_ = *(const bf16x8*)(sa + 32 * ROWB + (KS_) * 32); \
        B0_ = *(const bf16x8*)(sb + (KS_) * 32); B1_ = *(const bf16x8*)(sb + 32 * ROWB + (KS_) * 32); } while (0)
#define GEMM_MFMA4(A0_, A1_, B0_, B1_) do { \
        acc[0][0] = MFMA(A0_, B0_, acc[0][0]); acc[0][1] = MFMA(A0_, B1_, acc[0][1]); \
        acc[1][0] = MFMA(A1_, B0_, acc[1][0]); acc[1][1] = MFMA(A1_, B1_, acc[1][1]); } while (0)
#define GEMM_COMPUTE(BUF_) do { \
        const unsigned char* sa = smem + (BUF_) * STB + rdA; \
        const unsigned char* sb = smem + (BUF_) * STB + rdB; \
        bf16x8 fa0, fa1, fb0, fb1, ga0, ga1, gb0, gb1; \
        GEMM_FRAGS(0, fa0, fa1, fb0, fb1); \
        GEMM_FRAGS(1, ga0, ga1, gb0, gb1); \
        __builtin_amdgcn_sched_barrier(0); \
        GEMM_MFMA4(fa0, fa1, fb0, fb1); \
        if constexpr (BK == 64) { \
            __builtin_amdgcn_sched_barrier(0); \
            GEMM_FRAGS(2, fa0, fa1, fb0, fb1); \
            __builtin_amdgcn_sched_barrier(0); \
            GEMM_MFMA4(ga0, ga1, gb0, gb1); \
            __builtin_amdgcn_sched_barrier(0); \
            GEMM_FRAGS(3, ga0, ga1, gb0, gb1); \
            __builtin_amdgcn_sched_barrier(0); \
            GEMM_MFMA4(fa0, fa1, fb0, fb1); \
        } \
        __builtin_amdgcn_sched_barrier(0); \
        GEMM_MFMA4(ga0, ga1, gb0, gb1); \
    } while (0)
    for (int kt = 0; kt < nk - 1; ++kt) {
        const int buf = kt & 1;
        ap += BK; bp += BK;
        GLOAD16(ra0, ap); GLOAD16(rb0, bp); GLOAD16(ra1, ap + astep); GLOAD16(rb1, bp + bstep);
        if constexpr (NJ == 4) { GLOAD16(ra2, ap + 2 * astep); GLOAD16(rb2, bp + 2 * bstep); GLOAD16(ra3, ap + 3 * astep); GLOAD16(rb3, bp + 3 * bstep); }
        __builtin_amdgcn_sched_barrier(0);
        GEMM_COMPUTE(buf);
        __builtin_amdgcn_sched_barrier(0);
        if constexpr (NJ == 4) asm volatile("s_waitcnt vmcnt(0)" : "+v"(ra0), "+v"(rb0), "+v"(ra1), "+v"(rb1), "+v"(ra2), "+v"(rb2), "+v"(ra3), "+v"(rb3));
        else asm volatile("s_waitcnt vmcnt(0)" : "+v"(ra0), "+v"(rb0), "+v"(ra1), "+v"(rb1));
        GEMM_STAGE(smem + (buf ^ 1) * STB + st_off);
        __syncthreads();
    }
    GEMM_COMPUTE((nk - 1) & 1);
    __syncthreads();
#undef GEMM_COMPUTE
#undef GEMM_MFMA4
#undef GEMM_FRAGS
#undef GEMM_STAGE
}


DI void gemm_big(const bf16_t* P, int ldp, const bf16_t* Q, int ldq, int K, f32x16 (&acc)[2][4], unsigned char* smem) {
    constexpr int ROWB = 80, PB = 128 * ROWB, STB = 384 * ROWB, PASSB = 64 * ROWB;
    const int tid = tidx(), lane = tid & 63, w = tid >> 6, wm = w >> 1, wn = w & 1, r = lane & 31, hh = lane >> 5;
    const int lrow = tid >> 2, lcol = (tid & 3) * 8;
    const bf16_t* pp = P + (size_t)lrow * ldp + lcol;
    const bf16_t* qp = Q + (size_t)lrow * ldq + lcol;
    const size_t pstep = (size_t)64 * ldp, qstep = (size_t)64 * ldq;
    const int st_off = lrow * ROWB + (tid & 3) * 16;
    u32x4 rp0, rp1, rq0, rq1, rq2, rq3;
    rp0 = *(const u32x4*)(pp); rp1 = *(const u32x4*)(pp + pstep);
    rq0 = *(const u32x4*)(qp); rq1 = *(const u32x4*)(qp + qstep); rq2 = *(const u32x4*)(qp + 2 * qstep); rq3 = *(const u32x4*)(qp + 3 * qstep);
#define BIG_STAGE(D_) do { unsigned char* d_ = (D_); \
        *(u32x4*)(d_) = rp0; *(u32x4*)(d_ + PASSB) = rp1; \
        *(u32x4*)(d_ + PB) = rq0; *(u32x4*)(d_ + PB + PASSB) = rq1; *(u32x4*)(d_ + PB + 2 * PASSB) = rq2; *(u32x4*)(d_ + PB + 3 * PASSB) = rq3; } while (0)
    BIG_STAGE(smem + st_off);
    __syncthreads();
    const int nk = K >> 5;
    const int rdP = (wm * 64 + r) * ROWB + hh * 16;
    const int rdQ = PB + (wn * 128 + r) * ROWB + hh * 16;
#define BIG_FRAGS(KS_, A0_, A1_, B0_, B1_, B2_, B3_) do { \
        A0_ = *(const bf16x8*)(sp + (KS_) * 32); A1_ = *(const bf16x8*)(sp + 32 * ROWB + (KS_) * 32); \
        B0_ = *(const bf16x8*)(sq + (KS_) * 32); B1_ = *(const bf16x8*)(sq + 32 * ROWB + (KS_) * 32); \
        B2_ = *(const bf16x8*)(sq + 64 * ROWB + (KS_) * 32); B3_ = *(const bf16x8*)(sq + 96 * ROWB + (KS_) * 32); } while (0)
#define BIG_MFMA8(A0_, A1_, B0_, B1_, B2_, B3_) do { \
        acc[0][0] = MFMA(A0_, B0_, acc[0][0]); acc[0][1] = MFMA(A0_, B1_, acc[0][1]); acc[0][2] = MFMA(A0_, B2_, acc[0][2]); acc[0][3] = MFMA(A0_, B3_, acc[0][3]); \
        acc[1][0] = MFMA(A1_, B0_, acc[1][0]); acc[1][1] = MFMA(A1_, B1_, acc[1][1]); acc[1][2] = MFMA(A1_, B2_, acc[1][2]); acc[1][3] = MFMA(A1_, B3_, acc[1][3]); } while (0)
#define BIG_COMPUTE(BUF_) do { \
        const unsigned char* sp = smem + (BUF_) * STB + rdP; \
        const unsigned char* sq = smem + (BUF_) * STB + rdQ; \
        bf16x8 fa0, fa1, fb0, fb1, fb2, fb3, ga0, ga1, gb0, gb1, gb2, gb3; \
        BIG_FRAGS(0, fa0, fa1, fb0, fb1, fb2, fb3); \
        BIG_FRAGS(1, ga0, ga1, gb0, gb1, gb2, gb3); \
        __builtin_amdgcn_sched_barrier(0); \
        BIG_MFMA8(fa0, fa1, fb0, fb1, fb2, fb3); \
        __builtin_amdgcn_sched_barrier(0); \
        BIG_MFMA8(ga0, ga1, gb0, gb1, gb2, gb3); \
    } while (0)
    for (int kt = 0; kt < nk - 1; ++kt) {
        const int buf = kt & 1;
        pp += 32; qp += 32;
        GLOAD16(rp0, pp); GLOAD16(rq0, qp); GLOAD16(rp1, pp + pstep); GLOAD16(rq1, qp + qstep); GLOAD16(rq2, qp + 2 * qstep); GLOAD16(rq3, qp + 3 * qstep);
        __builtin_amdgcn_sched_barrier(0);
        BIG_COMPUTE(buf);
        __builtin_amdgcn_sched_barrier(0);
        asm volatile("s_waitcnt vmcnt(0)" : "+v"(rp0), "+v"(rp1), "+v"(rq0), "+v"(rq1), "+v"(rq2), "+v"(rq3));
        BIG_STAGE(smem + (buf ^ 1) * STB + st_off);
        __syncthreads();
    }
    BIG_COMPUTE((nk - 1) & 1);
    __syncthreads();
#undef BIG_COMPUTE
#undef BIG_MFMA8
#undef BIG_FRAGS
#undef BIG_STAGE
}
DI void zero_big(f32x16 (&acc)[2][4]) {
#pragma unroll
    for (int a = 0; a < 2; ++a)
#pragma unroll
        for (int b = 0; b < 4; ++b)
#pragma unroll
            for (int i = 0; i < 16; ++i) acc[a][b][i] = 0.f;
}
DI void stage_store_big(const f32x16 (&acc)[2][4], bf16_t* dst, int ld, unsigned char* smem) {
    const int tid = tidx(), lane = tid & 63, w = tid >> 6, wm = w >> 1, wn = w & 1, r = lane & 31, hh = lane >> 5;
#pragma unroll
    for (int qi = 0; qi < 4; ++qi) {
        unsigned char* trow = smem + (wn * 128 + qi * 32 + r) * 272 + (wm * 64 + 4 * hh) * 2;
#pragma unroll
        for (int pi = 0; pi < 2; ++pi)
#pragma unroll
            for (int g = 0; g < 4; ++g) {
                u32x2 pk; pk.x = pack_bf16(acc[pi][qi][4 * g], acc[pi][qi][4 * g + 1]); pk.y = pack_bf16(acc[pi][qi][4 * g + 2], acc[pi][qi][4 * g + 3]);
                *(u32x2*)(trow + (pi * 32 + 8 * g) * 2) = pk;
            }
    }
    __syncthreads();
    const int q0 = tid >> 4, x = tid & 15;
#pragma unroll
    for (int j = 0; j < 16; ++j) {
        const uint4 v = *(const uint4*)(smem + (q0 + 16 * j) * 272 + x * 16);
        *(uint4*)(dst + (size_t)(q0 + 16 * j) * ld + x * 8) = v;
    }
    __syncthreads();
}
DI void scale_big(f32x16 (&acc)[2][4], float sc) {
#pragma unroll
    for (int a = 0; a < 2; ++a)
#pragma unroll
        for (int b = 0; b < 4; ++b)
#pragma unroll
            for (int i = 0; i < 16; ++i) acc[a][b][i] *= sc;
}
DI void scale_big_q(f32x16 (&acc)[2][4], const float* rs, float sc) {
    const int lane = tidx() & 63, wn = (tidx() >> 6) & 1, r = lane & 31;
#pragma unroll
    for (int qi = 0; qi < 4; ++qi) { const float f = rs[wn * 128 + qi * 32 + r] * sc;
#pragma unroll
        for (int pi = 0; pi < 2; ++pi)
#pragma unroll
            for (int i = 0; i < 16; ++i) acc[pi][qi][i] *= f; }
}
DI void scale_big_p(f32x16 (&acc)[2][4], const float* rs) {
    const int lane = tidx() & 63, wm = tidx() >> 7, hh = lane >> 5;
#pragma unroll
    for (int pi = 0; pi < 2; ++pi)
#pragma unroll
        for (int g = 0; g < 4; ++g) { const f32x4 f = *(const f32x4*)(rs + wm * 64 + pi * 32 + 8 * g + 4 * hh);
#pragma unroll
            for (int qi = 0; qi < 4; ++qi)
#pragma unroll
                for (int e = 0; e < 4; ++e) acc[pi][qi][4 * g + e] *= f[e]; }
}
DI long tile_linear(int it, long total) {
    const int perx = gdim() >> 3, xcd = bidx() & 7, slot = bidx() >> 3;
    const long L = ((long)it * 8 + xcd) * perx + slot;
    return L < total ? L : -1;
}
DI void tile_decode(int L, int NT, int& mt, int& nt) { const int gsz = 8 * NT; const int grp = L / gsz, wi = L % gsz; mt = grp * 8 + (wi & 7); nt = wi >> 3; }

DI void zero_acc(f32x16 (&acc)[2][2]) {
#pragma unroll
    for (int a = 0; a < 2; ++a)
#pragma unroll
        for (int b = 0; b < 2; ++b)
#pragma unroll
            for (int i = 0; i < 16; ++i) acc[a][b][i] = 0.f;
}

DI void stage_store_128(const f32x16 (&acc)[2][2], bf16_t* dst, int ld, unsigned char* smem) {
    const int tid = tidx(), lane = tid & 63, w = tid >> 6, wm = w >> 1, wn = w & 1, r = lane & 31, hh = lane >> 5;
#pragma unroll
    for (int qi = 0; qi < 2; ++qi) {
        unsigned char* trow = smem + (wn * 64 + qi * 32 + r) * 272 + (wm * 64 + 4 * hh) * 2;
#pragma unroll
        for (int pi = 0; pi < 2; ++pi)
#pragma unroll
            for (int g = 0; g < 4; ++g) {
                u32x2 pk; pk.x = pack_bf16(acc[pi][qi][4 * g], acc[pi][qi][4 * g + 1]); pk.y = pack_bf16(acc[pi][qi][4 * g + 2], acc[pi][qi][4 * g + 3]);
                *(u32x2*)(trow + (pi * 32 + 8 * g) * 2) = pk;
            }
    }
    __syncthreads();
    const int q0 = tid >> 4, x = tid & 15;
#pragma unroll
    for (int j = 0; j < 8; ++j) {
        const uint4 v = *(const uint4*)(smem + (q0 + 16 * j) * 272 + x * 16);
        *(uint4*)(dst + (size_t)(q0 + 16 * j) * ld + x * 8) = v;
    }
    __syncthreads();
}
DI void scale_acc(f32x16 (&acc)[2][2], float sc) {
#pragma unroll
    for (int a = 0; a < 2; ++a)
#pragma unroll
        for (int b = 0; b < 2; ++b)
#pragma unroll
            for (int i = 0; i < 16; ++i) acc[a][b][i] *= sc;
}
DI void scale_acc_q(f32x16 (&acc)[2][2], const float* rs, float sc) {
    const int lane = tidx() & 63, wn = (tidx() >> 6) & 1, r = lane & 31;
#pragma unroll
    for (int qi = 0; qi < 2; ++qi) { const float f = rs[wn * 64 + qi * 32 + r] * sc;
#pragma unroll
        for (int pi = 0; pi < 2; ++pi)
#pragma unroll
            for (int i = 0; i < 16; ++i) acc[pi][qi][i] *= f; }
}
DI void scale_acc_p(f32x16 (&acc)[2][2], const float* rs) {
    const int lane = tidx() & 63, wm = tidx() >> 7, hh = lane >> 5;
#pragma unroll
    for (int pi = 0; pi < 2; ++pi)
#pragma unroll
        for (int g = 0; g < 4; ++g) { const f32x4 f = *(const f32x4*)(rs + wm * 64 + pi * 32 + 8 * g + 4 * hh);
#pragma unroll
            for (int qi = 0; qi < 2; ++qi)
#pragma unroll
                for (int e = 0; e < 4; ++e) acc[pi][qi][4 * g + e] *= f[e]; }
}

DI int map_col(int map, int n) {
    switch (map) {
    case 1:
        if (n < 1536) return n;
        if (n < 3072) return 2216 + (n - 1536);
        if (n < 3456) return 1544 + (n - 3072);
        if (n < 3712) return 1928 + (n - 3456);
        { const int c = n - 3712; if (c < 16) return 2184 + c; if (c < 24) return 1536 + (c - 16); if (c < 32) return -1; if (c < 48) return 2200 + (c - 32); return -1; }
    case 2: return 3752 + n;
    case 3:
        if (n < 512) return (n >> 6) * 96 + (n & 63);
        { const int cc = n - 512, tt = cc >> 7, c7 = cc & 127, wn = c7 >> 6, ni = (c7 >> 5) & 1, c = c7 & 31; const int head = tt * 4 + wn * 2 + (c >> 4); return head * 96 + 64 + ni * 16 + (c & 15); }
    case 4:
        if (n < 512) return (n >> 6) * 128 + (n & 63);
        { const int n2 = n - 512; return (n2 >> 6) * 128 + 64 + (n2 & 63); }
    case 5: return (n >> 5) * 16 + (n & 15);
    default: return n;
    }
}

DI void transpose_tile(const float* __restrict__ src, const float* __restrict__ src2, int ld, int K, bf16_t* __restrict__ dst, int map, const float* __restrict__ kscale, int n0, int k0, float* tile) {
    const int tid = tidx(), tx = tid & 63, ty = tid >> 6;
    const int sc = map_col(map, n0 + tx);
    if (map == 5 && (((n0 + tx) >> 4) & 1)) src = src2;
    const int scc = sc < 0 ? 0 : sc;
    const float* sp = src + (size_t)(k0 + ty) * ld + scc;
    float vals[16];
#pragma unroll
    for (int j = 0; j < 16; ++j) vals[j] = sp[(size_t)(4 * j) * ld];
    if (kscale) {
#pragma unroll
        for (int j = 0; j < 16; ++j) vals[j] *= kscale[k0 + ty + 4 * j];
    }
#pragma unroll
    for (int j = 0; j < 16; ++j) tile[(ty + 4 * j) * 65 + tx] = sc < 0 ? 0.f : vals[j];
    __syncthreads();
    const int n = tid >> 2, kq = (tid & 3) * 16;
    unsigned wv[8];
#pragma unroll
    for (int j = 0; j < 8; ++j) wv[j] = pack_bf16(tile[(kq + 2 * j) * 65 + n], tile[(kq + 2 * j + 1) * 65 + n]);
    uint4* d = (uint4*)(dst + (size_t)(n0 + n) * K + k0 + kq);
    d[0] = make_uint4(wv[0], wv[1], wv[2], wv[3]);
    d[1] = make_uint4(wv[4], wv[5], wv[6], wv[7]);
    __syncthreads();
}

DI void phase_prep(KargPtr p, unsigned char* smem) {
    const int tid = tidx();
    float* fs = (float*)smem;
    constexpr int NW = 9296, NMOD = 192, NROPE = 2048;
    for (int item = bidx(); item < NW + NMOD + NROPE; item += gdim()) {
        if (item < NW) {
            const int l = item / 4648; int ti = item % 4648;
            const float* src; const float* src2 = nullptr; int ld, K, Nd, map; size_t doff; const float* ksc = nullptr;
            if (ti < 992)       { src = p->w_in + (size_t)l * 1024 * 6824; ld = 6824; K = 1024; Nd = 3968; doff = W_IN; map = 1; }
            else if (ti < 1760) { ti -= 992;  src = p->w_in + (size_t)l * 1024 * 6824; ld = 6824; K = 1024; Nd = 3072; doff = W_GATE; map = 2; }
            else if (ti < 1832) { ti -= 1760; src = p->w_mla_uq + (size_t)l * 384 * 768; ld = 768; K = 384; Nd = 768; doff = W_UQ; map = 3; ksc = p->g_mla_q + l * 384; }
            else if (ti < 1896) { ti -= 1832; src = p->w_mla_ukv + (size_t)l * 256 * 1024; ld = 1024; K = 256; Nd = 1024; doff = W_UKV; map = 4; ksc = p->g_mla_kv + l * 256; }
            else if (ti < 2024) { ti -= 1896; src = p->w_o_fox + (size_t)l * 512 * 1024; ld = 1024; K = 512; Nd = 1024; doff = W_OF; map = 0; }
            else if (ti < 2152) { ti -= 2024; src = p->w_o_mla + (size_t)l * 512 * 1024; ld = 1024; K = 512; Nd = 1024; doff = W_OM; map = 0; }
            else if (ti < 2280) { ti -= 2152; src = p->w_o_sb + (size_t)l * 512 * 1024; ld = 1024; K = 512; Nd = 1024; doff = W_OS; map = 0; }
            else if (ti < 2536) { ti -= 2280; src = p->w_out + (size_t)l * 1024 * 1024; ld = 1024; K = 1024; Nd = 1024; doff = W_OUT; map = 0; }
            else if (ti < 3944) { ti -= 2536; src = p->w_ffn_gate + (size_t)l * 1024 * 2816; src2 = p->w_ffn_up + (size_t)l * 1024 * 2816; ld = 2816; K = 1024; Nd = 5632; doff = W_FGU; map = 5; }
            else                { ti -= 3944; src = p->w_ffn_down + (size_t)l * 2816 * 1024; ld = 1024; K = 2816; Nd = 1024; doff = W_FD; map = 0; }
            (void)Nd;
            const int kts = K >> 6; const int ntile = ti / kts, ktile = ti % kts;
            transpose_tile(src, src2, ld, K, p->wt + (size_t)l * W_LAYER + doff, map, ksc, ntile * 64, ktile * 64, fs);
        } else if (item < NW + NMOD) {
            const int mi = item - NW; const int l = mi / 96, c0 = (mi % 96) * 64;
            float* cond = fs;
            float* red = fs + 8192;
            for (int e = tid; e < 8192; e += 256) { const float cv = p->c[e]; cond[e] = cv * sigmoidf_(cv); }
            __syncthreads();
            const int tx = tid & 63, ty = tid >> 6;
            float a0 = 0, a1 = 0, a2 = 0, a3 = 0, a4 = 0, a5 = 0, a6 = 0, a7 = 0;
            const float* wsrc = p->w_ada + (size_t)l * 1024 * 6144 + c0 + tx;
#pragma unroll 8
            for (int k = ty * 256; k < ty * 256 + 256; ++k) {
                const float wv = wsrc[(size_t)k * 6144];
                a0 += cond[k] * wv; a1 += cond[1024 + k] * wv; a2 += cond[2048 + k] * wv; a3 += cond[3072 + k] * wv;
                a4 += cond[4096 + k] * wv; a5 += cond[5120 + k] * wv; a6 += cond[6144 + k] * wv; a7 += cond[7168 + k] * wv;
            }
            float* rr = red + ty * 512 + tx;
            rr[0] = a0; rr[64] = a1; rr[128] = a2; rr[192] = a3; rr[256] = a4; rr[320] = a5; rr[384] = a6; rr[448] = a7;
            __syncthreads();
            for (int o = tid; o < 512; o += 256) {
                const int b = o >> 6, xx = o & 63;
                const float s = red[o] + red[512 + o] + red[1024 + o] + red[1536 + o] + p->b_ada[l * 6144 + c0 + xx];
                p->mod[(size_t)(l * 8 + b) * 6144 + c0 + xx] = s;
            }
            __syncthreads();
        } else {
            const int e = (item - NW - NMOD) * 256 + tid;
            const int i = e & 15, tok = e >> 4;
            const float ang = (float)p->pos[tok] * ROPE_INV[i];
            const double a = (double)ang;
            const double kq = rint(a * 0.63661977236758134308);
            const double rr = fma(-kq, 1.57079632679489661923, a);
            const double r2 = rr * rr;
            const double sn = rr * (1.0 + r2 * (-1.0 / 6 + r2 * (1.0 / 120 + r2 * (-1.0 / 5040 + r2 * (1.0 / 362880 + r2 * (-1.0 / 39916800))))));
            const double cs = 1.0 + r2 * (-0.5 + r2 * (1.0 / 24 + r2 * (-1.0 / 720 + r2 * (1.0 / 40320 + r2 * (-1.0 / 3628800 + r2 * (1.0 / 479001600))))));
            const int q = ((int)(long long)kq) & 3;
            const double co = (q == 0) ? cs : (q == 1) ? -sn : (q == 2) ? -cs : sn;
            const double si = (q == 0) ? sn : (q == 1) ? cs : (q == 2) ? -sn : -cs;
            p->ropetab[2 * (size_t)e] = (float)co; p->ropetab[2 * (size_t)e + 1] = (float)si;
        }
    }
}

DI float wave_sum(float v) {
#pragma unroll
    for (int o = 32; o >= 1; o >>= 1) v += __shfl_xor(v, o);
    return v;
}
DI void phase_norm(const float* __restrict__ xin, const float* __restrict__ g, const float* __restrict__ modl, int sh_idx, int sc_idx, bf16_t* __restrict__ uout) {
    const int lane = tidx() & 63, w = tidx() >> 6;
    for (int row = bidx() * 4 + w; row < T_TOK; row += gdim() * 4) {
        const int b = row >> 12;
        const f32x4* xr = (const f32x4*)(xin + (size_t)row * 1024);
        f32x4 v[4]; float ss = 0.f;
#pragma unroll
        for (int j = 0; j < 4; ++j) { v[j] = xr[lane + 64 * j]; ss += v[j][0] * v[j][0] + v[j][1] * v[j][1] + v[j][2] * v[j][2] + v[j][3] * v[j][3]; }
        ss = wave_sum(ss);
        const float rstd = rsqrtf(ss * (1.0f / 1024.0f) + EPS);
        const float* mb = modl + (size_t)b * 6144;
#pragma unroll
        for (int j = 0; j < 4; ++j) {
            const int col = 4 * (lane + 64 * j);
            const f32x4 g4 = *(const f32x4*)(g + col), sc4 = *(const f32x4*)(mb + sc_idx * 1024 + col), sh4 = *(const f32x4*)(mb + sh_idx * 1024 + col);
            float y[4];
#pragma unroll
            for (int e = 0; e < 4; ++e) y[e] = (v[j][e] * rstd) * g4[e] * (1.0f + sc4[e]) + sh4[e];
            u32x2 pk; pk.x = pack_bf16(y[0], y[1]); pk.y = pack_bf16(y[2], y[3]);
            *(u32x2*)(uout + (size_t)row * 1024 + col) = pk;
        }
    }
}
DI void phase_final(KargPtr p) {
    const int lane = tidx() & 63, w = tidx() >> 6;
    for (int row = bidx() * 4 + w; row < T_TOK; row += gdim() * 4) {
        f32x4* xr = (f32x4*)(p->out + (size_t)row * 1024);
        f32x4 v[4]; float ss = 0.f;
#pragma unroll
        for (int j = 0; j < 4; ++j) { v[j] = xr[lane + 64 * j]; ss += v[j][0] * v[j][0] + v[j][1] * v[j][1] + v[j][2] * v[j][2] + v[j][3] * v[j][3]; }
        ss = wave_sum(ss);
        const float rstd = rsqrtf(ss * (1.0f / 1024.0f) + EPS);
#pragma unroll
        for (int j = 0; j < 4; ++j) {
            const f32x4 g4 = *(const f32x4*)(p->g_final + 4 * (lane + 64 * j));
            f32x4 o;
#pragma unroll
            for (int e = 0; e < 4; ++e) o[e] = (v[j][e] * rstd) * g4[e];
            xr[lane + 64 * j] = o;
        }
    }
}

struct EpiInproj {
    static constexpr bool PERM = false, AFTER_DRAIN = false;
    bf16_t* qf; bf16_t* kf; bf16_t* vtf; bf16_t* qs; bf16_t* ks; bf16_t* vts;
    __device__ __forceinline__ void operator()(const pg8::f32x4 (&acc)[2][2][4][2], const pg8::Unit& u, int wr, int wc, int fr, int fq) const {
        const int region = u.pn >> 1, colbase = (u.pn & 1) * 256 + wc * 32 + fq * 4;
        const int row0 = u.pm * 256 + wr * 64 + fr;
        if (region == 2 || region == 5) {
            bf16_t* vt = region == 2 ? vtf : vts;
            const int b = row0 >> 12, s0 = row0 & 4095;
#pragma unroll
            for (int bj = 0; bj < 2; ++bj)
#pragma unroll
                for (int n = 0; n < 2; ++n) {
                    bf16_t* vp = vt + (size_t)(b * 512 + colbase + bj * 128 + n * 16) * SEQ + s0;
#pragma unroll
                    for (int ai = 0; ai < 2; ++ai)
#pragma unroll
                        for (int m = 0; m < 4; ++m)
#pragma unroll
                            for (int j = 0; j < 4; ++j) vp[(size_t)j * SEQ + ai * 128 + m * 16] = f2bf(acc[ai][bj][m][n][j]);
                }
        } else {
            bf16_t* dst = region == 0 ? qf : region == 1 ? kf : region == 3 ? qs : ks;
            const float sc = (region == 0 || region == 3) ? FOX_QS : 1.0f;
#pragma unroll
            for (int ai = 0; ai < 2; ++ai)
#pragma unroll
                for (int m = 0; m < 4; ++m) {
                    bf16_t* rowp = dst + (size_t)(row0 + ai * 128 + m * 16) * 512 + colbase;
#pragma unroll
                    for (int bj = 0; bj < 2; ++bj)
#pragma unroll
                        for (int n = 0; n < 2; ++n) { const pg8::f32x4 v = acc[ai][bj][m][n] * sc; u32x2 pk; pk.x = pack_bf16(v[0], v[1]); pk.y = pack_bf16(v[2], v[3]); *(u32x2*)(rowp + bj * 128 + n * 16) = pk; }
                }
        }
    }
};
struct EpiFfnUp {
    static constexpr bool PERM = false, AFTER_DRAIN = false;
    bf16_t* h;
    __device__ __forceinline__ void operator()(const pg8::f32x4 (&acc)[2][2][4][2], const pg8::Unit& u, int wr, int wc, int fr, int fq) const {
        const int row0 = u.pm * 256 + wr * 64 + fr;
#pragma unroll
        for (int ai = 0; ai < 2; ++ai)
#pragma unroll
            for (int m = 0; m < 4; ++m) {
                bf16_t* rowp = h + (size_t)(row0 + ai * 128 + m * 16) * 2816 + u.pn * 128 + wc * 16 + fq * 4;
#pragma unroll
                for (int bj = 0; bj < 2; ++bj) {
                    const pg8::f32x4 g = acc[ai][bj][m][0], up = acc[ai][bj][m][1];
                    float hv[4];
#pragma unroll
                    for (int j = 0; j < 4; ++j) hv[j] = g[j] * sigmoidf_(g[j]) * up[j];
                    u32x2 pk; pk.x = pack_bf16(hv[0], hv[1]); pk.y = pack_bf16(hv[2], hv[3]);
                    *(u32x2*)(rowp + bj * 64) = pk;
                }
            }
    }
};
struct EpiResidual {
    static constexpr bool PERM = false, AFTER_DRAIN = false;
    const float* xin; float* xout; const float* modl; int gidx;
    __device__ __forceinline__ void operator()(const pg8::f32x4 (&acc)[2][2][4][2], const pg8::Unit& u, int wr, int wc, int fr, int fq) const {
        const int row0 = u.pm * 256 + wr * 64 + fr, b = row0 >> 12;
        const float* gt = modl + (size_t)b * 6144 + gidx * 1024;
#pragma unroll
        for (int bj = 0; bj < 2; ++bj)
#pragma unroll
            for (int n = 0; n < 2; ++n) {
                const int col = u.pn * 256 + bj * 128 + wc * 32 + n * 16 + fq * 4;
                const pg8::f32x4 g4 = *(const pg8::f32x4*)(gt + col);
                pg8::f32x4 xv[2][4];
#pragma unroll
                for (int ai = 0; ai < 2; ++ai)
#pragma unroll
                    for (int m = 0; m < 4; ++m) xv[ai][m] = *(const pg8::f32x4*)(xin + (size_t)(row0 + ai * 128 + m * 16) * 1024 + col);
#pragma unroll
                for (int ai = 0; ai < 2; ++ai)
#pragma unroll
                    for (int m = 0; m < 4; ++m) *(pg8::f32x4*)(xout + (size_t)(row0 + ai * 128 + m * 16) * 1024 + col) = xv[ai][m] + g4 * acc[ai][bj][m][n];
            }
    }
};
template <class Epi>
DI void big_gemm(const bf16_t* A, const bf16_t* Bt, int N, int K, const Epi& E, unsigned char* smem) {
    __syncthreads();
    pg8::StaticOrder S; S.init(T_TOK, N, (int)gridDim.x, (int)blockIdx.x);
    pg8::Gemm g; g.A = A; g.Bt = Bt; g.M = T_TOK; g.N = N; g.K = K;
    pg8::gemm_phase<Epi, pg8::StaticOrder, true, true>((PG8_LAS unsigned char*)smem, g, S, E);
    __syncthreads();
}

DI void phase_inproj(KargPtr p, int l, unsigned char* smem_phys) {
    const bf16_t* W = p->wt + (size_t)l * W_LAYER + W_IN;
    { EpiInproj E; E.qf = p->qf; E.kf = p->kf; E.vtf = p->vtf; E.qs = p->qs; E.ks = p->ks; E.vts = p->vts;
      big_gemm(p->u, W, 3072, 1024, E, smem_phys); }
    unsigned char* smem = smem_phys + vhalf() * VSMEM;
    const int tid = tidx(), lane = tid & 63, w = tid >> 6, wm = w >> 1, wn = w & 1, r = lane & 31, hh = lane >> 5;
    for (int it = 0;; ++it) {
        int mt, a; if (!next_tile(it, 256, 6, mt, a)) break;
        const int m0 = mt * 128, b = m0 >> 12, s0 = m0 & 4095;
        const bf16_t* Au = p->u + (size_t)m0 * 1024;
        const bf16_t* Bw = W + (size_t)(24 + a) * 128 * 1024;
        f32x16 acc[2][2]; zero_acc(acc);
        if (a < 5) {
            gemm_mainloop<64>(Bw, 1024, Au, 1024, 1024, acc, smem);
            stage_store_128(acc, a < 3 ? p->ql + (size_t)m0 * 384 + a * 128 : p->kvl + (size_t)m0 * 256 + (a - 3) * 128, a < 3 ? 384 : 256, smem);
        } else {
            gemm_mainloop<64>(Au, 1024, Bw, 1024, 1024, acc, smem);
            if (wn == 0) {
                const float* __restrict__ rt = p->ropetab; bf16_t* __restrict__ krp = p->kr; float* __restrict__ lfp = p->logf;
                const float bf = (r >= 16 && r < 24) ? p->b_fox_f[l * 8 + (r - 16)] : 0.f;
#pragma unroll
                for (int mi = 0; mi < 2; ++mi) {
                    const int rbase = wm * 64 + mi * 32 + 4 * hh;
#pragma unroll
                    for (int hf = 0; hf < 2; ++hf) {
                        f32x2_t cs[8];
                        if (r < 16) {
#pragma unroll
                            for (int i = 0; i < 8; ++i) cs[i] = *(const f32x2_t*)(rt + 2 * ((m0 + rbase + 8 * ((8 * hf + i) >> 2) + (i & 3)) * 16 + r));
                        }
#pragma unroll
                        for (int i8 = 0; i8 < 8; ++i8) {
                            const int i = 8 * hf + i8;
                            const int row = rbase + 8 * (i >> 2) + (i & 3);
                            const int t = m0 + row;
                            if (r < 16) {
                                const float x1 = acc[mi][0][i], x2 = acc[mi][1][i];
                                krp[t * 32 + r] = f2bf(x1 * cs[i8][0] - x2 * cs[i8][1]);
                                krp[t * 32 + 16 + r] = f2bf(x1 * cs[i8][1] + x2 * cs[i8][0]);
                            } else if (r < 24) {
                                const float f = acc[mi][0][i] + bf;
                                lfp[(b * 8 + (r - 16)) * SEQ + s0 + row] = fminf(f, 0.f) - log1pf(expf(-fabsf(f)));
                            }
                        }
                    }
                }
            }
            __syncthreads(); __syncthreads();
        }
    }
}

DI void phase_mla_up(KargPtr p, int l, unsigned char* smem) {
    const int tid = tidx(), lane = tid & 63, w = tid >> 6, wm = w >> 1, wn = w & 1, r = lane & 31, hh = lane >> 5;
    float* rs = (float*)(smem + 73728);
    const bf16_t* WQ = p->wt + (size_t)l * W_LAYER + W_UQ;
    const bf16_t* WKV = p->wt + (size_t)l * W_LAYER + W_UKV;
    for (int it = 0;; ++it) {
        const int L = it * gdim() + bidx(); if (L >= 3584) break;
        int mt, nt; if (L < 1536) { mt = L / 6; nt = L % 6; } else { mt = (L - 1536) >> 3; nt = 6 + ((L - 1536) & 7); }
        const int m0 = mt * 128, b = m0 >> 12, s0 = m0 & 4095;
        const bool isq = nt < 6;
        const int K = isq ? 384 : 256;
        const bf16_t* A = (isq ? p->ql : p->kvl) + (size_t)m0 * K;
        __syncthreads();
        {
            const int row = tid >> 1, half = tid & 1; const int hk = K >> 1;
            const uint4* ar = (const uint4*)(A + (size_t)row * K + half * hk);
            float ss = 0.f;
#pragma unroll 8
            for (int j = 0; j < (hk >> 3); ++j) {
                const uint4 v = ar[j];
                const unsigned uu[4] = {v.x, v.y, v.z, v.w};
#pragma unroll
                for (int e = 0; e < 4; ++e) { const float lo = __uint_as_float(uu[e] << 16), hi = __uint_as_float(uu[e] & 0xffff0000u); ss += lo * lo + hi * hi; }
            }
            ss += __shfl_xor(ss, 1);
            if (half == 0) rs[row] = rsqrtf(ss / (float)K + EPS);
        }
        __syncthreads();
        f32x16 acc[2][2]; zero_acc(acc);
        if (isq) {
            const bf16_t* Bw = WQ + (size_t)nt * 128 * 384;
            if (nt < 4) {
                gemm_mainloop<64>(Bw, 384, A, 384, 384, acc, smem);
                scale_acc_q(acc, rs, MLA_QS);
                stage_store_128(acc, p->qn + (size_t)m0 * 512 + nt * 128, 512, smem);
            } else {
                gemm_mainloop<64>(A, 384, Bw, 384, 384, acc, smem);
                const int tt = nt - 4; const int head = tt * 4 + wn * 2 + (r >> 4), ii = r & 15;
                const float* __restrict__ rt = p->ropetab; bf16_t* __restrict__ qrp = p->qr;
#pragma unroll
                for (int mi = 0; mi < 2; ++mi) {
                    const int rbase = wm * 64 + mi * 32 + 4 * hh;
                    f32x2_t cs[16];
#pragma unroll
                    for (int i = 0; i < 16; ++i) cs[i] = *(const f32x2_t*)(rt + 2 * ((m0 + rbase + 8 * (i >> 2) + (i & 3)) * 16 + ii));
#pragma unroll
                    for (int i = 0; i < 16; ++i) {
                        const int row = rbase + 8 * (i >> 2) + (i & 3);
                        const int t = m0 + row; const float sc = rs[row] * MLA_QS;
                        const float x1 = acc[mi][0][i] * sc, x2 = acc[mi][1][i] * sc;
                        qrp[t * 256 + head * 32 + ii] = f2bf(x1 * cs[i][0] - x2 * cs[i][1]);
                        qrp[t * 256 + head * 32 + 16 + ii] = f2bf(x1 * cs[i][1] + x2 * cs[i][0]);
                    }
                }
                __syncthreads(); __syncthreads();
            }
        } else {
            const int n2 = nt - 6;
            const bf16_t* Bw = WKV + (size_t)n2 * 128 * 256;
            if (n2 < 4) {
                gemm_mainloop<64>(Bw, 256, A, 256, 256, acc, smem);
                scale_acc_q(acc, rs, 1.0f);
                stage_store_128(acc, p->kn + (size_t)m0 * 512 + n2 * 128, 512, smem);
            } else {
                gemm_mainloop<64>(A, 256, Bw, 256, 256, acc, smem);
                scale_acc_p(acc, rs);
                stage_store_128(acc, p->vtm + (size_t)(b * 512 + (n2 - 4) * 128) * SEQ + s0, SEQ, smem);
            }
        }
    }
    __syncthreads();
    float* fs = (float*)smem;
    for (int bh = bidx(); bh < 64; bh += gdim()) {
        const f32x4* src = (const f32x4*)(p->logf + (size_t)bh * SEQ + tid * 16);
        f32x4 v[4];
        float run = 0.f;
#pragma unroll
        for (int j = 0; j < 4; ++j) { v[j] = src[j];
#pragma unroll
            for (int e = 0; e < 4; ++e) { run += v[j][e]; v[j][e] = run; } }
        float incl = run;
#pragma unroll
        for (int o = 1; o < 64; o <<= 1) { const float tv = __shfl_up(incl, o); if (lane >= o) incl += tv; }
        if (lane == 63) fs[w] = incl;
        __syncthreads();
        float pre = incl - run;
        for (int ww = 0; ww < w; ++ww) pre += fs[ww];
        f32x4* dst = (f32x4*)(p->cum + (size_t)bh * SEQ + tid * 16);
#pragma unroll
        for (int j = 0; j < 4; ++j) { f32x4 o;
#pragma unroll
            for (int e = 0; e < 4; ++e) o[e] = v[j][e] + pre; dst[j] = o; }
        __syncthreads();
    }
}

template <int TYPE>
DI void attn_item(KargPtr p, int b, int h, int qb, unsigned char* smem) {
    constexpr int DK = (TYPE == 1) ? 96 : (TYPE == 0 ? 80 : 64), KS = DK / 16, KROWB = (DK + 8) * 2, VROWB = 144;
    constexpr int KBYTES = 64 * KROWB, VBYTES = 64 * VROWB, BUFB = KBYTES + VBYTES + 256;
    const int tid = tidx(), lane = tid & 63, w = tid >> 6, r = lane & 31, hh = lane >> 5;
    const int q0 = qb * 128, qw = q0 + 32 * w, myq = qw + r;
    const size_t tokq = (size_t)b * SEQ + myq;
    unsigned* flags = (unsigned*)(smem - vhalf() * VSMEM + FLAGS_OFF);
    const int w8 = vhalf() * 4 + w;

    bf16x8 qfrag[KS];
    if (TYPE == 1) {
#pragma unroll
        for (int ks = 0; ks < 4; ++ks) qfrag[ks] = *(const bf16x8*)(p->qn + tokq * 512 + h * 64 + ks * 16 + hh * 8);
#pragma unroll
        for (int ks = 4; ks < KS; ++ks) qfrag[ks] = *(const bf16x8*)(p->qr + tokq * 256 + h * 32 + (ks - 4) * 16 + hh * 8);
    } else {
        const bf16_t* qg = (TYPE == 0 ? p->qf : p->qs) + tokq * 512 + h * 64;
#pragma unroll
        for (int ks = 0; ks < 4; ++ks) qfrag[ks] = *(const bf16x8*)(qg + ks * 16 + hh * 8);
        if (TYPE == 0) { const u32x4 one3 = hh == 0 ? (u32x4){0x3F803F80u, 0x00003F80u, 0u, 0u} : (u32x4){0u, 0u, 0u, 0u}; qfrag[KS - 1] = __builtin_bit_cast(bf16x8, one3); }
    }
    const bf16_t* Kg = (TYPE == 0 ? p->kf : TYPE == 1 ? p->kn : p->ks) + (size_t)b * SEQ * 512 + h * 64;
    const bf16_t* Vg = (TYPE == 0 ? p->vtf : TYPE == 1 ? p->vtm : p->vts) + (size_t)(b * 8 + h) * 64 * SEQ;
    const bf16_t* Krg = p->kr + (size_t)b * SEQ * 32;
    const float* cumg = p->cum + (size_t)(b * 8 + h) * SEQ;

    const int ntiles = 2 * qb + 2;
    u32x4 rk0A, rk1A, rv0A, rv1A, rkrA, rk0B, rk1B, rv0B, rv1B, rkrB; float rckA = 0.f, rckB = 0.f;
    rkrA = (u32x4){0u, 0u, 0u, 0u}; rkrB = rkrA;
    const int ldrow = tid >> 3, ldch = tid & 7;
    const int vpos = 16 * (ldch >> 1) + 4 * (ldch & 1);
#define LOAD_TILE(S, KT_) do { \
        const int k0_ = (KT_) * 64; \
        GLOAD16(rk0##S, Kg + (size_t)(k0_ + ldrow) * 512 + ldch * 8); \
        GLOAD16(rk1##S, Kg + (size_t)(k0_ + 32 + ldrow) * 512 + ldch * 8); \
        GLOAD16(rv0##S, Vg + (size_t)ldrow * SEQ + k0_ + ldch * 8); \
        GLOAD16(rv1##S, Vg + (size_t)(32 + ldrow) * SEQ + k0_ + ldch * 8); \
        if (TYPE == 1) GLOAD16(rkr##S, Krg + (size_t)(k0_ + (tid >> 2)) * 32 + (tid & 3) * 8); \
        if (TYPE == 0) GLOAD4(rck##S, cumg + k0_ + (tid & 63)); \
    } while (0)
#define WAIT_ALL(S) asm volatile("s_waitcnt vmcnt(0)" : "+v"(rk0##S), "+v"(rk1##S), "+v"(rv0##S), "+v"(rv1##S), "+v"(rkr##S), "+v"(rck##S))
#define WAIT_OLD(S) do { if (TYPE == 2) asm volatile("s_waitcnt vmcnt(4)" : "+v"(rk0##S), "+v"(rk1##S), "+v"(rv0##S), "+v"(rv1##S), "+v"(rkr##S), "+v"(rck##S)); \
        else asm volatile("s_waitcnt vmcnt(5)" : "+v"(rk0##S), "+v"(rk1##S), "+v"(rv0##S), "+v"(rv1##S), "+v"(rkr##S), "+v"(rck##S)); } while (0)
#define STORE_TILE(S, BUF_) do { \
        unsigned char* kb_ = smem + (BUF_) * BUFB; unsigned char* vb_ = kb_ + KBYTES; \
        *(u32x4*)(kb_ + ldrow * KROWB + ldch * 16) = rk0##S; \
        *(u32x4*)(kb_ + (32 + ldrow) * KROWB + ldch * 16) = rk1##S; \
        { u32x2 lo, hi; lo.x = rv0##S.x; lo.y = rv0##S.y; hi.x = rv0##S.z; hi.y = rv0##S.w; \
          *(u32x2*)(vb_ + ldrow * VROWB + vpos * 2) = lo; *(u32x2*)(vb_ + ldrow * VROWB + (vpos + 8) * 2) = hi; } \
        { u32x2 lo, hi; lo.x = rv1##S.x; lo.y = rv1##S.y; hi.x = rv1##S.z; hi.y = rv1##S.w; \
          *(u32x2*)(vb_ + (32 + ldrow) * VROWB + vpos * 2) = lo; *(u32x2*)(vb_ + (32 + ldrow) * VROWB + (vpos + 8) * 2) = hi; } \
        if (TYPE == 1) *(u32x4*)(kb_ + (tid >> 2) * KROWB + 128 + (tid & 3) * 16) = rkr##S; \
        if (TYPE == 0) { if (tid < 64) { \
            const float c_ = -rck##S * LOG2E; \
            const unsigned h_ = pack_bf16(c_, 0.f) & 0xffffu; const float r1_ = c_ - __uint_as_float(h_ << 16); \
            const unsigned m_ = pack_bf16(r1_, 0.f) & 0xffffu; const float r2_ = r1_ - __uint_as_float(m_ << 16); \
            const unsigned l_ = pack_bf16(r2_, 0.f) & 0xffffu; \
            *(u32x4*)(kb_ + tid * KROWB + 128) = (u32x4){h_ | (m_ << 16), l_, 0u, 0u}; \
            *(u32x4*)(kb_ + tid * KROWB + 144) = (u32x4){0u, 0u, 0u, 0u}; } } \
    } while (0)
#define TILE_OF(J_) ((TYPE == 2) ? (ntiles - 1 - ((J_) < ntiles ? (J_) : ntiles - 1)) : ((J_) < ntiles ? (J_) : ntiles - 1))

    f32x16 o0, o1;
#pragma unroll
    for (int i = 0; i < 16; ++i) { o0[i] = 0.f; o1[i] = 0.f; }
    float m = -1e30f, lsum = 0.f, carry = 0.f;
    bool wdone = false;

    auto compute = [&](const int kt, const int buf) __attribute__((always_inline)) {
        const unsigned char* kb = smem + buf * BUFB; const unsigned char* vb = kb + KBYTES;
        const int k0 = kt * 64;
        bool need;
        if (TYPE == 0) need = (k0 <= qw + 31);
        else if (TYPE == 1) need = (k0 <= qw);
        else need = (k0 <= qw + 30) && !wdone;
        if (need) {
            f32x16 s0, s1;
#pragma unroll
            for (int i = 0; i < 16; ++i) { s0[i] = 0.f; s1[i] = 0.f; }
#pragma unroll
            for (int ks = 0; ks < KS; ++ks) {
                const bf16x8 a0 = *(const bf16x8*)(kb + r * KROWB + ks * 32 + hh * 16);
                const bf16x8 a1 = *(const bf16x8*)(kb + (32 + r) * KROWB + ks * 32 + hh * 16);
                s0 = MFMA(a0, qfrag[ks], s0); s1 = MFMA(a1, qfrag[ks], s1);
            }
            if (TYPE != 2) {
                if (TYPE == 0) {
                    if (k0 + 63 > qw) {
                        asm volatile("");
                        const int rel = myq - k0 - 4 * hh;
#pragma unroll
                        for (int i = 0; i < 16; ++i) {
                            const int off = 8 * (i >> 2) + (i & 3);
                            if (off > rel) s0[i] = -1e30f;
                            if (off + 32 > rel) s1[i] = -1e30f;
                        }
                    }
                }
                float mx = s0[0];
#pragma unroll
                for (int i = 1; i < 16; ++i) mx = fmaxf(mx, s0[i]);
#pragma unroll
                for (int i = 0; i < 16; ++i) mx = fmaxf(mx, s1[i]);
                mx = fmaxf(mx, __shfl_xor(mx, 32));
                const float mnew = fmaxf(m, mx);
                const float alpha = fexp2(m - mnew);
                m = mnew;
                float ps = 0.f;
#pragma unroll
                for (int i = 0; i < 16; ++i) { s0[i] = fexp2(s0[i] - mnew); s1[i] = fexp2(s1[i] - mnew); ps += s0[i] + s1[i]; }
                lsum = lsum * alpha + ps;
#pragma unroll
                for (int i = 0; i < 16; ++i) { o0[i] *= alpha; o1[i] *= alpha; }
            } else {
                float lk0[16], lk1[16];
#pragma unroll
                for (int i = 0; i < 16; ++i) {
                    {
                        const float z = s0[i]; const float sp = flog2(1.0f + fexp2(-fabsf(z)));
                        const float lb = fminf(z, 0.f) - sp;
                        s0[i] = lb; lk0[i] = lb - z;
                    }
                    {
                        const float z = s1[i]; const float sp = flog2(1.0f + fexp2(-fabsf(z)));
                        const float lb = fminf(z, 0.f) - sp;
                        s1[i] = lb; lk1[i] = lb - z;
                    }
                }
                if (k0 + 63 >= qw) {
                    asm volatile("");
                    const int rel = myq - k0 - 4 * hh;
#pragma unroll
                    for (int i = 0; i < 16; ++i) {
                        const int off = 8 * (i >> 2) + (i & 3);
                        if (off >= rel) { lk0[i] = 0.f; s0[i] = -1e30f; }
                        if (off + 32 >= rel) { lk1[i] = 0.f; s1[i] = -1e30f; }
                    }
                }
                float run = carry;
#pragma unroll
                for (int g = 3; g >= 0; --g) {
                    const float G = (lk1[4 * g] + lk1[4 * g + 1]) + (lk1[4 * g + 2] + lk1[4 * g + 3]);
                    const float Gp = __shfl_xor(G, 32);
                    const float base = run + (hh == 0 ? Gp : 0.f);
                    const float e3 = base, e2 = e3 + lk1[4 * g + 3], e1 = e2 + lk1[4 * g + 2], e0 = e1 + lk1[4 * g + 1];
                    s1[4 * g + 3] = fexp2(s1[4 * g + 3] + e3); s1[4 * g + 2] = fexp2(s1[4 * g + 2] + e2);
                    s1[4 * g + 1] = fexp2(s1[4 * g + 1] + e1); s1[4 * g] = fexp2(s1[4 * g] + e0);
                    run += G + Gp;
                }
#pragma unroll
                for (int g = 3; g >= 0; --g) {
                    const float G = (lk0[4 * g] + lk0[4 * g + 1]) + (lk0[4 * g + 2] + lk0[4 * g + 3]);
                    const float Gp = __shfl_xor(G, 32);
                    const float base = run + (hh == 0 ? Gp : 0.f);
                    const float e3 = base, e2 = e3 + lk0[4 * g + 3], e1 = e2 + lk0[4 * g + 2], e0 = e1 + lk0[4 * g + 1];
                    s0[4 * g + 3] = fexp2(s0[4 * g + 3] + e3); s0[4 * g + 2] = fexp2(s0[4 * g + 2] + e2);
                    s0[4 * g + 1] = fexp2(s0[4 * g + 1] + e1); s0[4 * g] = fexp2(s0[4 * g] + e0);
                    run += G + Gp;
                }
                carry = run;
            }
#pragma unroll
            for (int s2 = 0; s2 < 2; ++s2) {
                unsigned pk0[4], pk1[4];
#pragma unroll
                for (int j = 0; j < 4; ++j) { pk0[j] = pack_bf16(s0[8 * s2 + 2 * j], s0[8 * s2 + 2 * j + 1]); pk1[j] = pack_bf16(s1[8 * s2 + 2 * j], s1[8 * s2 + 2 * j + 1]); }
                const uint4 u0 = make_uint4(pk0[0], pk0[1], pk0[2], pk0[3]), u1 = make_uint4(pk1[0], pk1[1], pk1[2], pk1[3]);
                const bf16x8 pf0 = __builtin_bit_cast(bf16x8, u0), pf1 = __builtin_bit_cast(bf16x8, u1);
                const bf16x8 v00 = *(const bf16x8*)(vb + r * VROWB + (16 * s2 + 8 * hh) * 2);
                const bf16x8 v01 = *(const bf16x8*)(vb + (32 + r) * VROWB + (16 * s2 + 8 * hh) * 2);
                const bf16x8 v10 = *(const bf16x8*)(vb + r * VROWB + (32 + 16 * s2 + 8 * hh) * 2);
                const bf16x8 v11 = *(const bf16x8*)(vb + (32 + r) * VROWB + (32 + 16 * s2 + 8 * hh) * 2);
                o0 = MFMA(v00, pf0, o0); o1 = MFMA(v01, pf0, o1);
                o0 = MFMA(v10, pf1, o0); o1 = MFMA(v11, pf1, o1);
            }
        }
    };
#define SB_FLAGS(N_) do { if (TYPE == 2) { wdone = (__all(carry < -170.f) != 0); if (lane == 0) flags[((N_) & 1) * 8 + w8] = wdone ? 1u : 0u; } } while (0)
#define SB_DONE(N_) (TYPE == 2 && ((flags[((N_) & 1) * 8] & flags[((N_) & 1) * 8 + 1] & flags[((N_) & 1) * 8 + 2] & flags[((N_) & 1) * 8 + 3] & flags[((N_) & 1) * 8 + 4] & flags[((N_) & 1) * 8 + 5] & flags[((N_) & 1) * 8 + 6] & flags[((N_) & 1) * 8 + 7]) != 0u))
    __syncthreads();
    if (TYPE == 2 && tid < 16) flags[tid] = 0;
    LOAD_TILE(A, TILE_OF(0));
    WAIT_ALL(A);
    STORE_TILE(A, 0);
    LOAD_TILE(A, TILE_OF(1));
    __syncthreads();
    for (int n = 0; n < ntiles; n += 2) {
        LOAD_TILE(B, TILE_OF(n + 2));
        __builtin_amdgcn_sched_barrier(0);
        compute(TILE_OF(n), 0);
        __builtin_amdgcn_sched_barrier(0);
        WAIT_OLD(A);
        STORE_TILE(A, 1);
        SB_FLAGS(n);
        __syncthreads();
        if (SB_DONE(n)) break;
        if (n + 1 >= ntiles) break;
        LOAD_TILE(A, TILE_OF(n + 3));
        __builtin_amdgcn_sched_barrier(0);
        compute(TILE_OF(n + 1), 1);
        __builtin_amdgcn_sched_barrier(0);
        WAIT_OLD(B);
        STORE_TILE(B, 0);
        SB_FLAGS(n + 1);
        __syncthreads();
        if (SB_DONE(n + 1)) break;
    }
    asm volatile("s_waitcnt vmcnt(0)" : "+v"(rk0A), "+v"(rk1A), "+v"(rv0A), "+v"(rv1A), "+v"(rkrA), "+v"(rckA), "+v"(rk0B), "+v"(rk1B), "+v"(rv0B), "+v"(rv1B), "+v"(rkrB), "+v"(rckB));
    float inv = 1.0f;
    if (TYPE != 2) { const float lt = lsum + __shfl_xor(lsum, 32); inv = frcp(lt); }
    bf16_t* yg = (TYPE == 0 ? p->qf : TYPE == 1 ? p->qn : p->qs) + tokq * 512 + h * 64;
#pragma unroll
    for (int g = 0; g < 4; ++g) {
        u32x2 a, c2;
        a.x = pack_bf16(o0[4 * g] * inv, o0[4 * g + 1] * inv); a.y = pack_bf16(o0[4 * g + 2] * inv, o0[4 * g + 3] * inv);
        c2.x = pack_bf16(o1[4 * g] * inv, o1[4 * g + 1] * inv); c2.y = pack_bf16(o1[4 * g + 2] * inv, o1[4 * g + 3] * inv);
        *(u32x2*)(yg + 8 * g + 4 * hh) = a;
        *(u32x2*)(yg + 32 + 8 * g + 4 * hh) = c2;
    }
}

DI void phase_attn(KargPtr p, unsigned char* smem) {
    for (int idx = bidx(); idx < 6144; idx += gdim()) {
        if (idx < 4096) {
            const int j = idx >> 9, g = (idx >> 7) & 3, rem = idx & 127, bh = rem & 63;
            const int qb = 31 - 4 * j - ((j & 1) ? 3 - g : g);
            const int type = ((rem >> 6) + j) & 1;
            if (type == 0) attn_item<0>(p, bh >> 3, bh & 7, qb, smem);
            else attn_item<1>(p, bh >> 3, bh & 7, qb, smem);
        } else {
            const int j = idx - 4096; const int qb = 31 - (j >> 6), bh = j & 63;
            attn_item<2>(p, bh >> 3, bh & 7, qb, smem);
        }
    }
}

DI void phase_merge(KargPtr p, int l, unsigned char* smem) {
    const bf16_t* WL = p->wt + (size_t)l * W_LAYER;
    unsigned* park = (unsigned*)(smem + 40960) + tidx();
    for (int it = 0;; ++it) {
        int mt, nt; if (!next_tile(it, 256, 8, mt, nt)) break;
        const int m0 = mt * 128;
        f32x16 mer[2][2]; zero_acc(mer);
#pragma unroll 1
        for (int br = 0; br < 3; ++br) {
            f32x16 acc[2][2]; zero_acc(acc);
            gemm_mainloop<32>(WL + W_GATE + (size_t)(br * 1024 + nt * 128) * 1024, 1024, p->u + (size_t)m0 * 1024, 1024, 1024, acc, smem);
#pragma unroll
            for (int a = 0; a < 2; ++a)
#pragma unroll
                for (int c = 0; c < 2; ++c)
#pragma unroll
                    for (int j = 0; j < 8; ++j) park[((a * 2 + c) * 8 + j) * 256] = pack_bf16(sigmoidf_(acc[a][c][2 * j]), sigmoidf_(acc[a][c][2 * j + 1]));
            zero_acc(acc);
            const bf16_t* Y = (br == 0 ? p->qf : br == 1 ? p->qn : p->qs) + (size_t)m0 * 512;
            const bf16_t* WO = WL + (br == 0 ? W_OF : br == 1 ? W_OM : W_OS) + (size_t)nt * 128 * 512;
            gemm_mainloop<32>(WO, 512, Y, 512, 512, acc, smem);
#pragma unroll
            for (int a = 0; a < 2; ++a)
#pragma unroll
                for (int c = 0; c < 2; ++c)
#pragma unroll
                    for (int j = 0; j < 8; ++j) {
                        const unsigned gv = park[((a * 2 + c) * 8 + j) * 256];
                        const float g0 = __uint_as_float(gv << 16), g1 = __uint_as_float(gv & 0xffff0000u);
                        mer[a][c][2 * j] += g0 * acc[a][c][2 * j]; mer[a][c][2 * j + 1] += g1 * acc[a][c][2 * j + 1];
                    }
        }
        stage_store_128(mer, p->merged + (size_t)m0 * 1024 + nt * 128, 1024, smem);
    }
}

DI void phase_outproj(KargPtr p, int l, unsigned char* smem_phys) {
    EpiResidual E; E.xin = (l == 0) ? p->x : p->out; E.xout = p->out; E.modl = p->mod + (size_t)l * 8 * 6144; E.gidx = 2;
    big_gemm(p->merged, p->wt + (size_t)l * W_LAYER + W_OUT, 1024, 1024, E, smem_phys);
}
DI void phase_ffn_up(KargPtr p, int l, unsigned char* smem_phys) {
    EpiFfnUp E; E.h = p->h;
    big_gemm(p->u, p->wt + (size_t)l * W_LAYER + W_FGU, 5632, 1024, E, smem_phys);
}
DI void phase_ffn_down(KargPtr p, int l, unsigned char* smem_phys) {
    EpiResidual E; E.xin = p->out; E.xout = p->out; E.modl = p->mod + (size_t)l * 8 * 6144; E.gidx = 5;
    big_gemm(p->h, p->wt + (size_t)l * W_LAYER + W_FD, 1024, 2816, E, smem_phys);
}

DI void run_phase(int ph, int l, unsigned char* smem_phys) {
#ifdef ONLY_PH
    if (ph != ONLY_PH) return;
#endif
    KargPtr p = karg();
    unsigned char* smem = smem_phys + vhalf() * VSMEM;
    switch (ph) {
    case 0: phase_prep(p, smem); break;
    case 1: phase_norm((l == 0) ? p->x : p->out, p->g_mix + l * 1024, p->mod + (size_t)l * 8 * 6144, 0, 1, p->u); break;
    case 2: phase_inproj(p, l, smem_phys); break;
    case 3: phase_mla_up(p, l, smem); break;
    case 4: phase_attn(p, smem); break;
    case 5: phase_merge(p, l, smem); break;
    case 6: phase_outproj(p, l, smem_phys); break;
    case 7: phase_norm(p->out, p->g_ffn + l * 1024, p->mod + (size_t)l * 8 * 6144, 3, 4, p->u); break;
    case 8: phase_ffn_up(p, l, smem_phys); break;
    case 9: phase_ffn_down(p, l, smem_phys); break;
    default: phase_final(p); break;
    }
}

#define XB_TMO      128
#define XB_XCNT(j)  (256  + 64 * (j))
#define XB_XSUB(j)  (1280 + 64 * (j))
#define XB_XGEN(j)  (2304 + 64 * (j))
#define XB_TOP      3328
#define XB_TOPGEN   3392
#define XCD_BAR_WORDS 3456
#define XB_SPIN_CAP (1u << 20)
#define LAS __attribute__((address_space(3)))
DI unsigned xb_ld(unsigned* p)              { return __hip_atomic_load(p, __ATOMIC_RELAXED, __HIP_MEMORY_SCOPE_AGENT); }
DI unsigned xb_add(unsigned* p, unsigned v) { return __hip_atomic_fetch_add(p, v, __ATOMIC_RELAXED, __HIP_MEMORY_SCOPE_AGENT); }
DI unsigned xb_xcc_id() { return (unsigned)__builtin_amdgcn_s_getreg((3 << 11) | 20) & 0xFu; }
#define XB_SPIN(cond, bar) do { unsigned _sp = 0; while (cond) { __builtin_amdgcn_s_sleep(1); \
    if ((++_sp & 255u) == 0u) { if (xb_ld(&(bar)[XB_TMO])) break; if (_sp > XB_SPIN_CAP) { atomicAdd(&(bar)[XB_TMO], 1u); break; } } } } while (0)
struct XcdBarrier { unsigned* bar; unsigned x; volatile LAS unsigned* st; };
DI XcdBarrier xcd_barrier_post(unsigned* bar, volatile LAS unsigned* st) {
    XcdBarrier b; b.bar = bar; b.x = xb_xcc_id(); b.st = st;
    if (threadIdx.x == 0) (void)xb_add(&bar[XB_XCNT(b.x)], 1u);
    return b;
}
DI void xcd_barrier_complete(unsigned* bar, unsigned x, unsigned& nloc, unsigned& nx) {
    const unsigned G = gridDim.x * gridDim.y * gridDim.z;
    unsigned sum, cnt, mine, sp = 0u;
    for (;;) {
        sum = 0u; cnt = 0u; mine = 0u;
#pragma unroll
        for (unsigned j = 0; j < 16; ++j) { const unsigned c = xb_ld(&bar[XB_XCNT(j)]); sum += c; cnt += (c > 0u) ? 1u : 0u; mine = (j == x) ? c : mine; }
        if (sum == G) break;
        __builtin_amdgcn_s_sleep(1);
        if ((++sp & 255u) == 0u) { if (xb_ld(&bar[XB_TMO])) break; if (sp > XB_SPIN_CAP) { atomicAdd(&bar[XB_TMO], 1u); break; } }
    }
    nloc = mine > 0u ? mine : 1u; nx = cnt > 0u ? cnt : 1u;
}
DI void xcd_barrier(const XcdBarrier& b) {
    asm volatile("s_waitcnt vmcnt(0)" ::: "memory");
    __syncthreads();
    if (threadIdx.x == 0) {
        unsigned* bar = b.bar;
        __builtin_amdgcn_s_waitcnt(0);
        unsigned nloc = b.st[0], nx = b.st[1];
        if (nloc == 0u) { xcd_barrier_complete(bar, b.x, nloc, nx); b.st[0] = nloc; b.st[1] = nx; }
        const unsigned old = xb_add(&bar[XB_XSUB(b.x)], 1u);
        const unsigned gen = old / nloc;
        if (old + 1u == (gen + 1u) * nloc) {
            __builtin_amdgcn_fence(__ATOMIC_RELEASE, "agent");
            asm volatile("s_waitcnt vmcnt(0)" ::: "memory");
            const unsigned og = xb_add(&bar[XB_TOP], 1u);
            const unsigned tg = og / nx;
            if (og + 1u == (tg + 1u) * nx) xb_add(&bar[XB_TOPGEN], 1u);
            else XB_SPIN(xb_ld(&bar[XB_TOPGEN]) == tg, bar);
            __builtin_amdgcn_fence(__ATOMIC_ACQUIRE, "agent");
            xb_add(&bar[XB_XGEN(b.x)], 1u);
            asm volatile("s_waitcnt vmcnt(0)" ::: "memory");
        } else {
            XB_SPIN(xb_ld(&bar[XB_XGEN(b.x)]) == gen, bar);
            __builtin_amdgcn_fence(__ATOMIC_ACQUIRE, "agent");
            asm volatile("s_waitcnt vmcnt(0)" ::: "memory");
        }
    }
    __syncthreads();
}

#if MEGA
__global__ void __launch_bounds__(512, 2) __attribute__((amdgpu_waves_per_eu(2, 2))) mega_kernel(Params p) {
    extern __shared__ __attribute__((aligned(16))) unsigned char smem[];
    cg::grid_group grid = cg::this_grid();
    volatile LAS unsigned* st = (volatile LAS unsigned*)(smem + SMEM_BYTES - 16);
    if (threadIdx.x == 0) { st[0] = 0u; st[1] = 0u; }
    __syncthreads();
    const XcdBarrier xb = xcd_barrier_post(karg()->bar, st);
    run_phase(0, 0, smem);
    grid.sync();
#pragma unroll 1
    for (int l = 0; l < 2; ++l) {
#pragma unroll 1
        for (int ph = 1; ph <= 9; ++ph) {
            run_phase(ph, l, smem); xcd_barrier(xb);
#ifdef DBL_PH
            if (ph == DBL_PH) { run_phase(ph, l, smem); xcd_barrier(xb); }
#endif
        }
    }
    run_phase(10, 0, smem);
}
#else
__global__ void __launch_bounds__(512, 2) __attribute__((amdgpu_waves_per_eu(2, 2))) phase_kernel(Params p, int ph, int l) {
    extern __shared__ __attribute__((aligned(16))) unsigned char smem[];
    run_phase(ph, l, smem);
}
#endif

extern "C" void kernel_launch(void* const* d_in, const int* in_sizes, int n_in, void* d_out, int out_size, void* d_ws, size_t ws_size, hipStream_t stream) {
    (void)in_sizes; (void)n_in; (void)out_size;
    Params p{};
    p.x = (const float*)d_in[0]; p.c = (const float*)d_in[1]; p.pos = (const int*)d_in[2];
    p.g_mix = (const float*)d_in[3]; p.w_ada = (const float*)d_in[4]; p.b_ada = (const float*)d_in[5]; p.w_in = (const float*)d_in[6]; p.b_fox_f = (const float*)d_in[7];
    p.g_mla_q = (const float*)d_in[8]; p.w_mla_uq = (const float*)d_in[9]; p.g_mla_kv = (const float*)d_in[10]; p.w_mla_ukv = (const float*)d_in[11];
    p.w_o_fox = (const float*)d_in[12]; p.w_o_mla = (const float*)d_in[13]; p.w_o_sb = (const float*)d_in[14]; p.w_out = (const float*)d_in[15];
    p.g_ffn = (const float*)d_in[16]; p.w_ffn_gate = (const float*)d_in[17]; p.w_ffn_up = (const float*)d_in[18]; p.w_ffn_down = (const float*)d_in[19]; p.g_final = (const float*)d_in[20];
    p.out = (float*)d_out;
    unsigned char* ws = (unsigned char*)d_ws; size_t off = 0;
    auto take = [&](size_t bytes) { unsigned char* q = ws + off; off += (bytes + 255) & ~(size_t)255; return q; };
    p.bar = (unsigned*)take(16384);
    p.wt = (bf16_t*)take(2 * W_LAYER * 2);
    p.mod = (float*)take(2 * 8 * 6144 * 4);
    p.ropetab = (float*)take((size_t)T_TOK * 16 * 2 * 4);
    p.logf = (float*)take((size_t)64 * SEQ * 4);
    p.cum = (float*)take((size_t)64 * SEQ * 4);
    p.u = (bf16_t*)take((size_t)T_TOK * 1024 * 2);
    p.qf = (bf16_t*)take((size_t)T_TOK * 512 * 2);
    p.kf = (bf16_t*)take((size_t)T_TOK * 512 * 2);
    p.vtf = (bf16_t*)take((size_t)T_TOK * 512 * 2);
    p.qs = (bf16_t*)take((size_t)T_TOK * 512 * 2);
    p.ks = (bf16_t*)take((size_t)T_TOK * 512 * 2);
    p.vts = (bf16_t*)take((size_t)T_TOK * 512 * 2);
    p.ql = (bf16_t*)take((size_t)T_TOK * 384 * 2);
    p.kvl = (bf16_t*)take((size_t)T_TOK * 256 * 2);
    p.kr = (bf16_t*)take((size_t)T_TOK * 32 * 2);
    p.qn = (bf16_t*)take((size_t)T_TOK * 512 * 2);
    p.qr = (bf16_t*)take((size_t)T_TOK * 256 * 2);
    p.kn = (bf16_t*)take((size_t)T_TOK * 512 * 2);
    p.vtm = (bf16_t*)take((size_t)T_TOK * 512 * 2);
    p.merged = p.kf;
    p.h = p.qf;
    if (off > ws_size) { fprintf(stderr, "kernel_launch: workspace too small: need %zu, have %zu\n", off, ws_size); return; }

#if MEGA
    static int grid_blocks = 0;
    if (!grid_blocks) {
        int dev = 0, cus = 0, per_cu = 0;
        (void)hipGetDevice(&dev);
        (void)hipDeviceGetAttribute(&cus, hipDeviceAttributeMultiprocessorCount, dev);
        (void)hipFuncSetAttribute((const void*)mega_kernel, hipFuncAttributeMaxDynamicSharedMemorySize, SMEM_BYTES);
        (void)hipOccupancyMaxActiveBlocksPerMultiprocessor(&per_cu, (const void*)mega_kernel, 512, SMEM_BYTES);
        per_cu = 1;
        grid_blocks = cus * per_cu;
        grid_blocks &= ~7;
    }
    (void)hipMemsetAsync(p.bar, 0, 16384, stream);
    void* args[] = {&p};
    hipError_t e = hipLaunchCooperativeKernel((const void*)mega_kernel, dim3(grid_blocks), dim3(512), args, SMEM_BYTES, stream);
    if (e != hipSuccess) fprintf(stderr, "cooperative launch failed: %s (grid %d)\n", hipGetErrorString(e), grid_blocks);
#else
    static bool attr = false;
    if (!attr) { (void)hipFuncSetAttribute((const void*)phase_kernel, hipFuncAttributeMaxDynamicSharedMemorySize, SMEM_BYTES); attr = true; }
    const int G = 512;
    hipLaunchKernelGGL(phase_kernel, dim3(G), dim3(256), SMEM_BYTES, stream, p, 0, 0);
    for (int l = 0; l < 2; ++l)
        for (int ph = 1; ph <= 9; ++ph) hipLaunchKernelGGL(phase_kernel, dim3(G), dim3(256), SMEM_BYTES, stream, p, ph, l);
    hipLaunchKernelGGL(phase_kernel, dim3(G), dim3(256), SMEM_BYTES, stream, p, 10, 0);
#endif
}
```

```cpp
#include <hip/hip_runtime.h>
#include <hip/hip_cooperative_groups.h>
#include <cstdint>
#include <cstdio>
namespace cg = cooperative_groups;

#ifndef MEGA
#define MEGA 1
#endif

typedef unsigned short bf16_t;
typedef short bf16x8 __attribute__((ext_vector_type(8)));
typedef float f32x16 __attribute__((ext_vector_type(16)));
typedef float f32x4 __attribute__((ext_vector_type(4)));
typedef unsigned u32x2 __attribute__((ext_vector_type(2)));
#define DI __device__ __forceinline__
typedef unsigned u32x4 __attribute__((ext_vector_type(4)));
#define GLOAD16(dst, ptr) asm volatile("global_load_dwordx4 %0, %1, off" : "=v"(dst) : "v"(ptr))
#define GLOAD4(dst, ptr)  asm volatile("global_load_dword %0, %1, off" : "=v"(dst) : "v"(ptr))
#define MFMA(a, b, c) __builtin_amdgcn_mfma_f32_32x32x16_bf16((a), (b), (c), 0, 0, 0)

namespace pg8 {
#define PG8_LAS __attribute__((address_space(3)))
typedef unsigned short bf16_t;
typedef short bf16x8 __attribute__((ext_vector_type(8)));
typedef float f32x4 __attribute__((ext_vector_type(4)));
typedef unsigned u32x4 __attribute__((ext_vector_type(4)));
constexpr int BM = 256, BK = 64, HALF = 128, HTB = HALF * BK * 2  , STAGE_BYTES = 8 * HTB, NXCD = 8, WGM = 8;

__host__ __device__ __forceinline__ int lds_byte(int r, int c) { const int st = (r >> 4) * 2 + (c >> 5), rr = r & 15, cc = c & 31, ob = rr * 64 + cc * 2; return st * 1024 + (ob ^ (((ob >> 9) & 1) << 5)); }
__host__ __device__ __forceinline__ void stage_rc(int b, int& R, int& C) { const int st = b / 1024, sb = b % 1024, swz = sb ^ (((sb >> 9) & 1) << 5); R = (st >> 1) * 16 + swz / 64; C = (st & 1) * 32 + (swz % 64) / 2; }
__host__ __device__ __forceinline__ int perm32(int rho) { const int n = rho >> 4, i = rho & 15; return 8 * (i >> 2) + 4 * n + (i & 3); }

struct Unit { int pm, pn; };
struct Gemm { const bf16_t* A; const bf16_t* Bt; int M, N, K; };

struct StaticOrder {
    int nM, nN, nwg, G, c;
    __host__ __device__ void init(int M, int N, int G_, int c_) { nM = M / BM; nN = N / BM; nwg = nM * nN; G = G_; c = c_; }
    __host__ __device__ bool next(int i, Unit& u) const {
        const long L = (long)i * G + c; if (L >= nwg) return false;
        int wgid = (int)L; { const int q = nwg / NXCD, r = nwg % NXCD, xcd = wgid % NXCD, off = wgid / NXCD; wgid = (xcd < r ? xcd * (q + 1) : r * (q + 1) + (xcd - r) * q) + off; }
        const int nig = WGM * nN, gid = wgid / nig, fm = gid * WGM, gsz = (nM - fm) < WGM ? (nM - fm) : WGM;
        u.pm = fm + ((wgid % nig) % gsz); u.pn = (wgid % nig) / gsz; return true;
    }
    __device__ __forceinline__ void a_ready(const Unit&) const {}
    __device__ __forceinline__ void done(const Unit&) const {}
};
template <class Epi, class Sched, bool ALIGN_EPI = false, bool SP2 = false, bool NAT = false>
__device__ __forceinline__ void gemm_phase(PG8_LAS unsigned char* lds, const Gemm g, const Sched& S, const Epi& E) {
    int tid = threadIdx.x; asm volatile("" : "+v"(tid)); const int wid = __builtin_amdgcn_readfirstlane(tid >> 6), lane = tid & 63, wr = wid >> 2, wc = wid & 3, fr = lane & 15, fq = lane >> 4;
    const int K = g.K, nt = K / BK;
    unsigned voffA[2], voffB[2];
#pragma unroll
    for (int i = 0; i < 2; ++i) { int R, C; stage_rc(tid * 16 + i * 8192, R, C); const int Rb = Epi::PERM ? ((R & ~31) + perm32(R & 31)) : R;
        voffA[i] = (unsigned)(R * K + C) * 2u; voffB[i] = (unsigned)(Rb * K + C) * 2u; }
    const size_t kstep = (size_t)(BK * 2);
    const size_t hstep = (size_t)HALF * K * 2;
    const size_t tstep = 2 * hstep;
    const unsigned ldsw = (unsigned)wid * 1024u;
    const int aoff = lds_byte(wr * 64 + fr, fq * 8), boff = lds_byte(wc * 32 + fr, fq * 8);
#define PG8_SA(b, h) (((b) * 2 + (h)) * HTB)
#define PG8_SB(b, h) ((4 + (b) * 2 + (h)) * HTB)
#define PG8_STAGE(bufoff, gbase, voff) do { _Pragma("unroll") for (int _i = 0; _i < 2; ++_i) \
        __builtin_amdgcn_global_load_lds((const unsigned*)((const char*)(gbase) + (voff)[_i]), (PG8_LAS unsigned*)(lds + (bufoff) + ldsw + _i * 8192), 16, 0, 0); } while (0)
#define PG8_LDA(dst, b, h) do { _Pragma("unroll") for (int m = 0; m < 4; ++m) _Pragma("unroll") for (int k = 0; k < 2; ++k) dst[m][k] = *(const PG8_LAS bf16x8*)(lds + PG8_SA(b, h) + aoff + m * 2048 + k * 1024); } while (0)
#define PG8_LDB(dst, b, h) do { _Pragma("unroll") for (int n = 0; n < 2; ++n) _Pragma("unroll") for (int k = 0; k < 2; ++k) dst[n][k] = *(const PG8_LAS bf16x8*)(lds + PG8_SB(b, h) + boff + n * 2048 + k * 1024); } while (0)
#define PG8_MMA(ai, bj, At, Bt) do { __builtin_amdgcn_s_setprio(1); _Pragma("unroll") for (int m = 0; m < 4; ++m) _Pragma("unroll") for (int n = 0; n < 2; ++n) _Pragma("unroll") for (int k = 0; k < 2; ++k) \
        acc[ai][bj][m][n] = NAT ? __builtin_amdgcn_mfma_f32_16x16x32_bf16(At[m][k], Bt[n][k], acc[ai][bj][m][n], 0, 0, 0) : __builtin_amdgcn_mfma_f32_16x16x32_bf16(Bt[n][k], At[m][k], acc[ai][bj][m][n], 0, 0, 0); __builtin_amdgcn_s_setprio(0); } while (0)
#define PG8_WAIT_V(n) asm volatile("s_waitcnt vmcnt(" #n ")" ::: "memory")
#define PG8_WAIT_L(n) asm volatile("s_waitcnt lgkmcnt(" #n ")" ::: "memory")
#define PG8_BAR __builtin_amdgcn_s_barrier()
#define PG8_SCHED __builtin_amdgcn_sched_barrier(0)
    Unit cur, nxt; int ui = 0;
    if (!S.next(0, cur)) return;
    f32x4 acc[2][2][4][2];
#pragma unroll
    for (int a = 0; a < 2; ++a)
#pragma unroll
        for (int b = 0; b < 2; ++b)
#pragma unroll
            for (int m = 0; m < 4; ++m)
#pragma unroll
                for (int n = 0; n < 2; ++n) acc[a][b][m][n] = (f32x4){0.f, 0.f, 0.f, 0.f};
    bf16x8 At[4][2], B0[2][2], B1[2][2];
    const char* cA = (const char*)g.A + (size_t)cur.pm * tstep; const char* cB = (const char*)g.Bt + (size_t)cur.pn * tstep;
    S.a_ready(cur);
    if constexpr (SP2) {
        PG8_STAGE(PG8_SB(0, 0), cB, voffB); PG8_STAGE(PG8_SB(0, 1), cB + hstep, voffB); PG8_STAGE(PG8_SA(0, 0), cA, voffA); PG8_STAGE(PG8_SA(0, 1), cA + hstep, voffA);
        if (wr == 1) PG8_BAR;
        PG8_WAIT_V(2); PG8_BAR;
        PG8_STAGE(PG8_SB(1, 0), cB + kstep, voffB); PG8_STAGE(PG8_SA(1, 0), cA + kstep, voffA); PG8_STAGE(PG8_SB(1, 1), cB + hstep + kstep, voffB);
        PG8_WAIT_V(6); PG8_BAR;
    } else {
        PG8_STAGE(PG8_SB(0, 0), cB, voffB); PG8_STAGE(PG8_SA(0, 0), cA, voffA); PG8_STAGE(PG8_SB(0, 1), cB + hstep, voffB); PG8_STAGE(PG8_SA(0, 1), cA + hstep, voffA);
        if (wr == 1) PG8_BAR;
        PG8_WAIT_V(4); PG8_BAR;
        PG8_STAGE(PG8_SB(1, 0), cB + kstep, voffB); PG8_STAGE(PG8_SA(1, 0), cA + kstep, voffA); PG8_STAGE(PG8_SB(1, 1), cB + hstep + kstep, voffB);
        PG8_WAIT_V(6); PG8_BAR;
    }
    for (;;) {
        const bool has_next = S.next(ui + 1, nxt);
        const char* nA = has_next ? (const char*)g.A + (size_t)nxt.pm * tstep : cA; const char* nB = has_next ? (const char*)g.Bt + (size_t)nxt.pn * tstep : cB;
        for (int t = 0; t < nt; t += 2) {
            const bool last = (t == nt - 2);
            const char* a1 = cA + (size_t)(t + 1) * kstep;
            const char* a2 = last ? nA : cA + (size_t)(t + 2) * kstep; const char* b2 = last ? nB : cB + (size_t)(t + 2) * kstep;
            const char* a3 = a2 + kstep; const char* b3 = b2 + kstep;
            if (last && has_next) S.a_ready(nxt);
            if constexpr (SP2) {
            PG8_LDB(B0, 0, 0); PG8_LDB(B1, 0, 1); PG8_SCHED; PG8_LDA(At, 0, 0); PG8_STAGE(PG8_SA(1, 1), a1 + hstep, voffA);
            PG8_WAIT_V(8); PG8_WAIT_L(0); PG8_BAR; PG8_MMA(0, 0, At, B0); PG8_MMA(0, 1, At, B1); PG8_BAR; PG8_SCHED;
            PG8_LDA(At, 0, 1); PG8_STAGE(PG8_SB(0, 0), b2, voffB); PG8_STAGE(PG8_SB(0, 1), b2 + hstep, voffB); PG8_STAGE(PG8_SA(0, 0), a2, voffA);
            PG8_WAIT_V(8); PG8_WAIT_L(0); PG8_BAR; PG8_MMA(1, 0, At, B0); PG8_MMA(1, 1, At, B1); PG8_BAR; PG8_SCHED;
            PG8_LDB(B0, 1, 0); PG8_LDB(B1, 1, 1); PG8_SCHED; PG8_LDA(At, 1, 0); PG8_STAGE(PG8_SA(0, 1), a2 + hstep, voffA);
            PG8_WAIT_V(8); PG8_WAIT_L(0); PG8_BAR; PG8_MMA(0, 0, At, B0); PG8_MMA(0, 1, At, B1); PG8_BAR; PG8_SCHED;
            PG8_LDA(At, 1, 1); PG8_STAGE(PG8_SB(1, 0), b3, voffB); PG8_STAGE(PG8_SB(1, 1), b3 + hstep, voffB); PG8_STAGE(PG8_SA(1, 0), a3, voffA);
            PG8_WAIT_V(8); PG8_WAIT_L(0); PG8_BAR; PG8_MMA(1, 0, At, B0); PG8_MMA(1, 1, At, B1); PG8_BAR; PG8_SCHED;
            } else {
            PG8_LDB(B0, 0, 0); PG8_SCHED; PG8_LDA(At, 0, 0); PG8_STAGE(PG8_SA(1, 1), a1 + hstep, voffA);
            PG8_WAIT_L(8); PG8_BAR; PG8_WAIT_L(0); PG8_MMA(0, 0, At, B0); PG8_BAR; PG8_SCHED;
            PG8_LDB(B1, 0, 1); PG8_STAGE(PG8_SB(0, 0), b2, voffB);
            PG8_BAR; PG8_WAIT_L(0); PG8_MMA(0, 1, At, B1); PG8_BAR;
            PG8_LDA(At, 0, 1); PG8_STAGE(PG8_SA(0, 0), a2, voffA);
            PG8_BAR; PG8_WAIT_L(0); PG8_MMA(1, 0, At, B0); PG8_BAR; PG8_SCHED;
            PG8_STAGE(PG8_SB(0, 1), b2 + hstep, voffB);
            PG8_WAIT_V(6); PG8_BAR; PG8_MMA(1, 1, At, B1); PG8_BAR;
            PG8_LDB(B0, 1, 0); PG8_SCHED; PG8_LDA(At, 1, 0); PG8_STAGE(PG8_SA(0, 1), a2 + hstep, voffA);
            PG8_WAIT_L(8); PG8_BAR; PG8_WAIT_L(0); PG8_MMA(0, 0, At, B0); PG8_BAR; PG8_SCHED;
            PG8_LDB(B1, 1, 1); PG8_STAGE(PG8_SB(1, 0), b3, voffB);
            PG8_BAR; PG8_WAIT_L(0); PG8_MMA(0, 1, At, B1); PG8_BAR;
            PG8_LDA(At, 1, 1); PG8_STAGE(PG8_SA(1, 0), a3, voffA);
            PG8_BAR; PG8_WAIT_L(0); PG8_MMA(1, 0, At, B0); PG8_BAR; PG8_SCHED;
            PG8_STAGE(PG8_SB(1, 1), b3 + hstep, voffB);
            PG8_WAIT_V(6); PG8_BAR; PG8_MMA(1, 1, At, B1); PG8_BAR;
            }
        }
        if constexpr (ALIGN_EPI) { if (wr == 0) PG8_BAR; }
        if constexpr (!Epi::AFTER_DRAIN) { E(acc, cur, wr, wc, fr, fq); S.done(cur); }
        if (!has_next) break;
#pragma unroll
        for (int a = 0; a < 2; ++a)
#pragma unroll
            for (int b = 0; b < 2; ++b)
#pragma unroll
                for (int m = 0; m < 4; ++m)
#pragma unroll
                    for (int n = 0; n < 2; ++n) acc[a][b][m][n] = (f32x4){0.f, 0.f, 0.f, 0.f};
        cur = nxt; cA = nA; cB = nB; ++ui;
        if constexpr (ALIGN_EPI) { if (wr == 1) PG8_BAR; }
    }
    PG8_WAIT_V(0);
    if constexpr (!ALIGN_EPI) { if (wr == 0) PG8_BAR; }
    PG8_BAR;
    if constexpr (Epi::AFTER_DRAIN) { E.fused(acc, cur, wr, wc, fr, fq, lds, wid, lane); S.done(cur); }
#undef PG8_SA
#undef PG8_SB
#undef PG8_STAGE
#undef PG8_LDA
#undef PG8_LDB
#undef PG8_MMA
#undef PG8_WAIT_V
#undef PG8_WAIT_L
#undef PG8_BAR
#undef PG8_SCHED
}
}

constexpr int T_TOK = 32768;
constexpr int SEQ = 4096;
constexpr float LOG2E = 1.4426950408889634f;
constexpr float FOX_QS = 0.125f * 1.4426950408889634f;
constexpr float MLA_QS = 0.10206207261596575f * 1.4426950408889634f;
constexpr float EPS = 1e-6f;

constexpr size_t W_IN = 0, W_GATE = 4063232, W_UQ = 7208960, W_UKV = 7503872, W_OF = 7766016, W_OM = 8290304, W_OS = 8814592,
                 W_OUT = 9338880, W_FGU = 10387456, W_FD = 16154624, W_LAYER = 19038208;

constexpr int SMEM_BYTES = 2 * 74752 + 64 + 16;

struct Params {
    const float* x; const float* c; const int* pos;
    const float* g_mix; const float* w_ada; const float* b_ada; const float* w_in; const float* b_fox_f;
    const float* g_mla_q; const float* w_mla_uq; const float* g_mla_kv; const float* w_mla_ukv;
    const float* w_o_fox; const float* w_o_mla; const float* w_o_sb; const float* w_out;
    const float* g_ffn; const float* w_ffn_gate; const float* w_ffn_up; const float* w_ffn_down; const float* g_final;
    float* out;
    bf16_t* wt; float* mod; float* ropetab; float* logf; float* cum;
    bf16_t* u; bf16_t* qf; bf16_t* kf; bf16_t* vtf; bf16_t* qs; bf16_t* ks; bf16_t* vts;
    bf16_t* ql; bf16_t* kvl; bf16_t* kr; bf16_t* qn; bf16_t* qr; bf16_t* kn; bf16_t* vtm;
    bf16_t* merged; bf16_t* h;
    unsigned* bar;
};
typedef const __attribute__((address_space(4))) Params* KargPtr;
#if defined(__HIP_DEVICE_COMPILE__)
__device__ __forceinline__ KargPtr karg() { KargPtr pp = (KargPtr)__builtin_amdgcn_kernarg_segment_ptr(); asm volatile("" : "+s"(pp)); return pp; }
#else
__device__ __forceinline__ KargPtr karg() { return nullptr; }
#endif

__device__ const float ROPE_INV[16] = {1.0f, 0.5623413324356079f, 0.3162277638912201f, 0.17782793939113617f, 0.10000000149011612f, 0.05623413249850273f,
    0.03162277489900589f, 0.017782794311642647f, 0.009999999776482582f, 0.005623413249850273f, 0.003162277629598975f, 0.0017782794311642647f,
    0.0010000000474974513f, 0.000562341301701963f, 0.0003162277571391314f, 0.00017782794020604342f};

typedef __bf16 bf16x2_t __attribute__((ext_vector_type(2)));
typedef float f32x2_t __attribute__((ext_vector_type(2)));
DI unsigned pack_bf16(float lo, float hi) { const f32x2_t v = {lo, hi}; const bf16x2_t b = __builtin_convertvector(v, bf16x2_t); return __builtin_bit_cast(unsigned, b); }
DI bf16_t f2bf(float x) { return (bf16_t)(pack_bf16(x, 0.f) & 0xffffu); }
DI int vhalf() { return __builtin_amdgcn_readfirstlane((int)(threadIdx.x >> 8)); }
DI int tidx() { int t = threadIdx.x & 255; asm volatile("" : "+v"(t)); return t; }
DI int bidx() { int t = __builtin_amdgcn_readfirstlane((int)(blockIdx.x * 2 + (threadIdx.x >> 8))); asm volatile("" : "+s"(t)); return t; }
DI int gdim() { int t = gridDim.x * 2; asm volatile("" : "+s"(t)); return t; }
constexpr int VSMEM = 74752;
constexpr int FLAGS_OFF = 2 * VSMEM;
DI float fexp2(float x) { return __builtin_amdgcn_exp2f(x); }
DI float flog2(float x) { return __builtin_amdgcn_logf(x); }
DI float frcp(float x) { return __builtin_amdgcn_rcpf(x); }
DI float sigmoidf_(float x) { return frcp(1.0f + fexp2(-x * LOG2E)); }

DI bool next_tile(int it, int MT, int NT, int& mt, int& nt) {
    const int perx = gdim() >> 3, xcd = bidx() & 7, slot = bidx() >> 3;
    const long L = ((long)it * 8 + xcd) * perx + slot;
    if (L >= (long)MT * NT) return false;
    const int gsz = 8 * NT; const int grp = (int)(L / gsz), wi = (int)(L % gsz);
    mt = grp * 8 + (wi & 7); nt = wi >> 3; return true;
}

template <int BK>
DI void gemm_mainloop(const bf16_t* A, int lda, const bf16_t* B, int ldb, int K, f32x16 (&acc)[2][2], unsigned char* smem) {
    constexpr int CPR = BK / 8;
    constexpr int RPP = 256 / CPR;
    constexpr int NJ = 128 / RPP;
    constexpr int ROWB = BK * 2 + 16;
    constexpr int OPB = 128 * ROWB;
    constexpr int STB = 2 * OPB;
    constexpr int PASSB = RPP * ROWB;
    const int tid = tidx(), lane = tid & 63, w = tid >> 6, wm = w >> 1, wn = w & 1, r = lane & 31, hh = lane >> 5;
    const int lrow = tid / CPR, lcol = (tid % CPR) * 8;
    const bf16_t* ap = A + (size_t)lrow * lda + lcol;
    const bf16_t* bp = B + (size_t)lrow * ldb + lcol;
    const size_t astep = (size_t)RPP * lda, bstep = (size_t)RPP * ldb;
    const int st_off = lrow * ROWB + (tid % CPR) * 16;
    u32x4 ra0, ra1, ra2, ra3, rb0, rb1, rb2, rb3;
    ra0 = *(const u32x4*)(ap); rb0 = *(const u32x4*)(bp);
    ra1 = *(const u32x4*)(ap + astep); rb1 = *(const u32x4*)(bp + bstep);
    if constexpr (NJ == 4) { ra2 = *(const u32x4*)(ap + 2 * astep); rb2 = *(const u32x4*)(bp + 2 * bstep); ra3 = *(const u32x4*)(ap + 3 * astep); rb3 = *(const u32x4*)(bp + 3 * bstep); }
    else { ra2 = ra0; ra3 = ra0; rb2 = rb0; rb3 = rb0; }
#define GEMM_STAGE(D_) do { unsigned char* d_ = (D_); \
        *(u32x4*)(d_) = ra0; *(u32x4*)(d_ + OPB) = rb0; *(u32x4*)(d_ + PASSB) = ra1; *(u32x4*)(d_ + OPB + PASSB) = rb1; \
        if constexpr (NJ == 4) { *(u32x4*)(d_ + 2 * PASSB) = ra2; *(u32x4*)(d_ + OPB + 2 * PASSB) = rb2; *(u32x4*)(d_ + 3 * PASSB) = ra3; *(u32x4*)(d_ + OPB + 3 * PASSB) = rb3; } } while (0)
    GEMM_STAGE(smem + st_off);
    __syncthreads();
    const int nk = K / BK;
    const int rdA = (wm * 64 + r) * ROWB + hh * 16;
    const int rdB = OPB + (wn * 64 + r) * ROWB + hh * 16;
#define GEMM_FRAGS(KS_, A0_, A1_, B0_, B1_) do { \
        A0_ = *(const bf16x8*)(sa + (KS_) * 32); A1_ = *(const bf16x8*)(sa + 32 * ROWB + (KS_) * 32); \
        B0_ = *(const bf16x8*)(sb + (KS_) * 32); B1_ = *(const bf16x8*)(sb + 32 * ROWB + (KS_) * 32); } while (0)
#define GEMM_MFMA4(A0_, A1_, B0_, B1_) do { \
        acc[0][0] = MFMA(A0_, B0_, acc[0][0]); acc[0][1] = MFMA(A0_, B1_, acc[0][1]); \
        acc[1][0] = MFMA(A1_, B0_, acc[1][0]); acc[1][1] = MFMA(A1_, B1_, acc[1][1]); } while (0)
#define GEMM_COMPUTE(BUF_) do { \
        const unsigned char* sa = smem + (BUF_) * STB + rdA; \
        const unsigned char* sb = smem + (BUF_) * STB + rdB; \
        bf16x8 fa0, fa1, fb0, fb1, ga0, ga1, gb0, gb1; \
        GEMM_FRAGS(0, fa0, fa1, fb0, fb1); \
        GEMM_FRAGS(1, ga0, ga1, gb0, gb1); \
        __builtin_amdgcn_sched_barrier(0); \
        GEMM_MFMA4(fa0, fa1, fb0, fb1); \
        if constexpr (BK == 64) { \
            __builtin_amdgcn_sched_barrier(0); \
            GEMM_FRAGS(2, fa0, fa1, fb0, fb1); \
            __builtin_amdgcn_sched_barrier(0); \
            GEMM_MFMA4(ga0, ga1, gb0, gb1); \
            __builtin_amdgcn_sched_barrier(0); \
            GEMM_FRAGS(3, ga0, ga1, gb0, gb1); \
            __builtin_amdgcn_sched_barrier(0); \
            GEMM_MFMA4(fa0, fa1, fb0, fb1); \
        } \
        __builtin_amdgcn_sched_barrier(0); \
        GEMM_MFMA4(ga0, ga1, gb0, gb1); \
    } while (0)
    for (int kt = 0; kt < nk - 1; ++kt) {
        const int buf = kt & 1;
        ap += BK; bp += BK;
        GLOAD16(ra0, ap); GLOAD16(rb0, bp); GLOAD16(ra1, ap + astep); GLOAD16(rb1, bp + bstep);
        if constexpr (NJ == 4) { GLOAD16(ra2, ap + 2 * astep); GLOAD16(rb2, bp + 2 * bstep); GLOAD16(ra3, ap + 3 * astep); GLOAD16(rb3, bp + 3 * bstep); }
        __builtin_amdgcn_sched_barrier(0);
        GEMM_COMPUTE(buf);
        __builtin_amdgcn_sched_barrier(0);
        if constexpr (NJ == 4) asm volatile("s_waitcnt vmcnt(0)" : "+v"(ra0), "+v"(rb0), "+v"(ra1), "+v"(rb1), "+v"(ra2), "+v"(rb2), "+v"(ra3), "+v"(rb3));
        else asm volatile("s_waitcnt vmcnt(0)" : "+v"(ra0), "+v"(rb0), "+v"(ra1), "+v"(rb1));
        GEMM_STAGE(smem + (buf ^ 1) * STB + st_off);
        __syncthreads();
    }
    GEMM_COMPUTE((nk - 1) & 1);
    __syncthreads();
#undef GEMM_COMPUTE
#undef GEMM_MFMA4
#undef GEMM_FRAGS
#undef GEMM_STAGE
}


DI void gemm_big(const bf16_t* P, int ldp, const bf16_t* Q, int ldq, int K, f32x16 (&acc)[2][4], unsigned char* smem) {
    constexpr int ROWB = 80, PB = 128 * ROWB, STB = 384 * ROWB, PASSB = 64 * ROWB;
    const int tid = tidx(), lane = tid & 63, w = tid >> 6, wm = w >> 1, wn = w & 1, r = lane & 31, hh = lane >> 5;
    const int lrow = tid >> 2, lcol = (tid & 3) * 8;
    const bf16_t* pp = P + (size_t)lrow * ldp + lcol;
    const bf16_t* qp = Q + (size_t)lrow * ldq + lcol;
    const size_t pstep = (size_t)64 * ldp, qstep = (size_t)64 * ldq;
    const int st_off = lrow * ROWB + (tid & 3) * 16;
    u32x4 rp0, rp1, rq0, rq1, rq2, rq3;
    rp0 = *(const u32x4*)(pp); rp1 = *(const u32x4*)(pp + pstep);
    rq0 = *(const u32x4*)(qp); rq1 = *(const u32x4*)(qp + qstep); rq2 = *(const u32x4*)(qp + 2 * qstep); rq3 = *(const u32x4*)(qp + 3 * qstep);
#define BIG_STAGE(D_) do { unsigned char* d_ = (D_); \
        *(u32x4*)(d_) = rp0; *(u32x4*)(d_ + PASSB) = rp1; \
        *(u32x4*)(d_ + PB) = rq0; *(u32x4*)(d_ + PB + PASSB) = rq1; *(u32x4*)(d_ + PB + 2 * PASSB) = rq2; *(u32x4*)(d_ + PB + 3 * PASSB) = rq3; } while (0)
    BIG_STAGE(smem + st_off);
    __syncthreads();
    const int nk = K >> 5;
    const int rdP = (wm * 64 + r) * ROWB + hh * 16;
    const int rdQ = PB + (wn * 128 + r) * ROWB + hh * 16;
#define BIG_FRAGS(KS_, A0_, A1_, B0_, B1_, B2_, B3_) do { \
        A0_ = *(const bf16x8*)(sp + (KS_) * 32); A1_ = *(const bf16x8*)(sp + 32 * ROWB + (KS_) * 32); \
        B0_ = *(const bf16x8*)(sq + (KS_) * 32); B1_ = *(const bf16x8*)(sq + 32 * ROWB + (KS_) * 32); \
        B2_ = *(const bf16x8*)(sq + 64 * ROWB + (KS_) * 32); B3_ = *(const bf16x8*)(sq + 96 * ROWB + (KS_) * 32); } while (0)
#define BIG_MFMA8(A0_, A1_, B0_, B1_, B2_, B3_) do { \
        acc[0][0] = MFMA(A0_, B0_, acc[0][0]); acc[0][1] = MFMA(A0_, B1_, acc[0][1]); acc[0][2] = MFMA(A0_, B2_, acc[0][2]); acc[0][3] = MFMA(A0_, B3_, acc[0][3]); \
        acc[1][0] = MFMA(A1_, B0_, acc[1][0]); acc[1][1] = MFMA(A1_, B1_, acc[1][1]); acc[1][2] = MFMA(A1_, B2_, acc[1][2]); acc[1][3] = MFMA(A1_, B3_, acc[1][3]); } while (0)
#define BIG_COMPUTE(BUF_) do { \
        const unsigned char* sp = smem + (BUF_) * STB + rdP; \
        const unsigned char* sq = smem + (BUF_) * STB + rdQ; \
        bf16x8 fa0, fa1, fb0, fb1, fb2, fb3, ga0, ga1, gb0, gb1, gb2, gb3; \
        BIG_FRAGS(0, fa0, fa1, fb0, fb1, fb2, fb3); \
        BIG_FRAGS(1, ga0, ga1, gb0, gb1, gb2, gb3); \
        __builtin_amdgcn_sched_barrier(0); \
        BIG_MFMA8(fa0, fa1, fb0, fb1, fb2, fb3); \
        __builtin_amdgcn_sched_barrier(0); \
        BIG_MFMA8(ga0, ga1, gb0, gb1, gb2, gb3); \
    } while (0)
    for (int kt = 0; kt < nk - 1; ++kt) {
        const int buf = kt & 1;
        pp += 32; qp += 32;
        GLOAD16(rp0, pp); GLOAD16(rq0, qp); GLOAD16(rp1, pp + pstep); GLOAD16(rq1, qp + qstep); GLOAD16(rq2, qp + 2 * qstep); GLOAD16(rq3, qp + 3 * qstep);
        __builtin_amdgcn_sched_barrier(0);
        BIG_COMPUTE(buf);
        __builtin_amdgcn_sched_barrier(0);
        asm volatile("s_waitcnt vmcnt(0)" : "+v"(rp0), "+v"(rp1), "+v"(rq0), "+v"(rq1), "+v"(rq2), "+v"(rq3));
        BIG_STAGE(smem + (buf ^ 1) * STB + st_off);
        __syncthreads();
    }
    BIG_COMPUTE((nk - 1) & 1);
    __syncthreads();
#undef BIG_COMPUTE
#undef BIG_MFMA8
#undef BIG_FRAGS
#undef BIG_STAGE
}
DI void zero_big(f32x16 (&acc)[2][4]) {
#pragma unroll
    for (int a = 0; a < 2; ++a)
#pragma unroll
        for (int b = 0; b < 4; ++b)
#pragma unroll
            for (int i = 0; i < 16; ++i) acc[a][b][i] = 0.f;
}
DI void stage_store_big(const f32x16 (&acc)[2][4], bf16_t* dst, int ld, unsigned char* smem) {
    const int tid = tidx(), lane = tid & 63, w = tid >> 6, wm = w >> 1, wn = w & 1, r = lane & 31, hh = lane >> 5;
#pragma unroll
    for (int qi = 0; qi < 4; ++qi) {
        unsigned char* trow = smem + (wn * 128 + qi * 32 + r) * 272 + (wm * 64 + 4 * hh) * 2;
#pragma unroll
        for (int pi = 0; pi < 2; ++pi)
#pragma unroll
            for (int g = 0; g < 4; ++g) {
                u32x2 pk; pk.x = pack_bf16(acc[pi][qi][4 * g], acc[pi][qi][4 * g + 1]); pk.y = pack_bf16(acc[pi][qi][4 * g + 2], acc[pi][qi][4 * g + 3]);
                *(u32x2*)(trow + (pi * 32 + 8 * g) * 2) = pk;
            }
    }
    __syncthreads();
    const int q0 = tid >> 4, x = tid & 15;
#pragma unroll
    for (int j = 0; j < 16; ++j) {
        const uint4 v = *(const uint4*)(smem + (q0 + 16 * j) * 272 + x * 16);
        *(uint4*)(dst + (size_t)(q0 + 16 * j) * ld + x * 8) = v;
    }
    __syncthreads();
}
DI void scale_big(f32x16 (&acc)[2][4], float sc) {
#pragma unroll
    for (int a = 0; a < 2; ++a)
#pragma unroll
        for (int b = 0; b < 4; ++b)
#pragma unroll
            for (int i = 0; i < 16; ++i) acc[a][b][i] *= sc;
}
DI void scale_big_q(f32x16 (&acc)[2][4], const float* rs, float sc) {
    const int lane = tidx() & 63, wn = (tidx() >> 6) & 1, r = lane & 31;
#pragma unroll
    for (int qi = 0; qi < 4; ++qi) { const float f = rs[wn * 128 + qi * 32 + r] * sc;
#pragma unroll
        for (int pi = 0; pi < 2; ++pi)
#pragma unroll
            for (int i = 0; i < 16; ++i) acc[pi][qi][i] *= f; }
}
DI void scale_big_p(f32x16 (&acc)[2][4], const float* rs) {
    const int lane = tidx() & 63, wm = tidx() >> 7, hh = lane >> 5;
#pragma unroll
    for (int pi = 0; pi < 2; ++pi)
#pragma unroll
        for (int g = 0; g < 4; ++g) { const f32x4 f = *(const f32x4*)(rs + wm * 64 + pi * 32 + 8 * g + 4 * hh);
#pragma unroll
            for (int qi = 0; qi < 4; ++qi)
#pragma unroll
                for (int e = 0; e < 4; ++e) acc[pi][qi][4 * g + e] *= f[e]; }
}
DI long tile_linear(int it, long total) {
    const int perx = gdim() >> 3, xcd = bidx() & 7, slot = bidx() >> 3;
    const long L = ((long)it * 8 + xcd) * perx + slot;
    return L < total ? L : -1;
}
DI void tile_decode(int L, int NT, int& mt, int& nt) { const int gsz = 8 * NT; const int grp = L / gsz, wi = L % gsz; mt = grp * 8 + (wi & 7); nt = wi >> 3; }

DI void zero_acc(f32x16 (&acc)[2][2]) {
#pragma unroll
    for (int a = 0; a < 2; ++a)
#pragma unroll
        for (int b = 0; b < 2; ++b)
#pragma unroll
            for (int i = 0; i < 16; ++i) acc[a][b][i] = 0.f;
}

DI void stage_store_128(const f32x16 (&acc)[2][2], bf16_t* dst, int ld, unsigned char* smem) {
    const int tid = tidx(), lane = tid & 63, w = tid >> 6, wm = w >> 1, wn = w & 1, r = lane & 31, hh = lane >> 5;
#pragma unroll
    for (int qi = 0; qi < 2; ++qi) {
        unsigned char* trow = smem + (wn * 64 + qi * 32 + r) * 272 + (wm * 64 + 4 * hh) * 2;
#pragma unroll
        for (int pi = 0; pi < 2; ++pi)
#pragma unroll
            for (int g = 0; g < 4; ++g) {
                u32x2 pk; pk.x = pack_bf16(acc[pi][qi][4 * g], acc[pi][qi][4 * g + 1]); pk.y = pack_bf16(acc[pi][qi][4 * g + 2], acc[pi][qi][4 * g + 3]);
                *(u32x2*)(trow + (pi * 32 + 8 * g) * 2) = pk;
            }
    }
    __syncthreads();
    const int q0 = tid >> 4, x = tid & 15;
#pragma unroll
    for (int j = 0; j < 8; ++j) {
        const uint4 v = *(const uint4*)(smem + (q0 + 16 * j) * 272 + x * 16);
        *(uint4*)(dst + (size_t)(q0 + 16 * j) * ld + x * 8) = v;
    }
    __syncthreads();
}
DI void stage_store_vt(const f32x16 (&acc)[2][2], bf16_t* vt, int b, int cv0, int s0, unsigned char* smem) {
    const int tid = tidx(), lane = tid & 63, w = tid >> 6, wm = w >> 1, wn = w & 1, r = lane & 31, hh = lane >> 5;
#pragma unroll
    for (int qi = 0; qi < 2; ++qi) {
        unsigned char* trow = smem + (wn * 64 + qi * 32 + r) * 272 + (wm * 64 + 4 * hh) * 2;
#pragma unroll
        for (int pi = 0; pi < 2; ++pi)
#pragma unroll
            for (int g = 0; g < 4; ++g) {
                u32x2 pk; pk.x = pack_bf16(acc[pi][qi][4 * g], acc[pi][qi][4 * g + 1]); pk.y = pack_bf16(acc[pi][qi][4 * g + 2], acc[pi][qi][4 * g + 3]);
                *(u32x2*)(trow + (pi * 32 + 8 * g) * 2) = pk;
            }
    }
    __syncthreads();
    const int q0 = tid >> 4, x = tid & 15;
#pragma unroll
    for (int j = 0; j < 8; ++j) {
        const int cv = cv0 + q0 + 16 * j, sq = s0 + 8 * x;
        const uint4 v = *(const uint4*)(smem + (q0 + 16 * j) * 272 + x * 16);
        *(uint4*)(vt + (size_t)(b * 8 + (cv >> 6)) * SEQ * 64 + (size_t)(sq >> 6) * 4096 + (cv & 63) * 64 + (sq & 63)) = v;
    }
    __syncthreads();
}
DI void scale_acc(f32x16 (&acc)[2][2], float sc) {
#pragma unroll
    for (int a = 0; a < 2; ++a)
#pragma unroll
        for (int b = 0; b < 2; ++b)
#pragma unroll
            for (int i = 0; i < 16; ++i) acc[a][b][i] *= sc;
}
DI void scale_acc_q(f32x16 (&acc)[2][2], const float* rs, float sc) {
    const int lane = tidx() & 63, wn = (tidx() >> 6) & 1, r = lane & 31;
#pragma unroll
    for (int qi = 0; qi < 2; ++qi) { const float f = rs[wn * 64 + qi * 32 + r] * sc;
#pragma unroll
        for (int pi = 0; pi < 2; ++pi)
#pragma unroll
            for (int i = 0; i < 16; ++i) acc[pi][qi][i] *= f; }
}
DI void scale_acc_p(f32x16 (&acc)[2][2], const float* rs) {
    const int lane = tidx() & 63, wm = tidx() >> 7, hh = lane >> 5;
#pragma unroll
    for (int pi = 0; pi < 2; ++pi)
#pragma unroll
        for (int g = 0; g < 4; ++g) { const f32x4 f = *(const f32x4*)(rs + wm * 64 + pi * 32 + 8 * g + 4 * hh);
#pragma unroll
            for (int qi = 0; qi < 2; ++qi)
#pragma unroll
                for (int e = 0; e < 4; ++e) acc[pi][qi][4 * g + e] *= f[e]; }
}

DI int map_col(int map, int n) {
    switch (map) {
    case 1:
        if (n < 1024) return n;
        if (n < 2048) return 2216 + (n - 1024);
        if (n < 2432) return 1544 + (n - 2048);
        if (n < 2688) return 1928 + (n - 2432);
        if (n < 2816) { const int c = n - 2688; if (c < 16) return 2184 + c; if (c < 32) return 2200 + (c - 16); if (c < 40) return 1536 + (c - 32); return -1; }
        if (n < 3328) return 1024 + (n - 2816);
        if (n < 3840) return 3240 + (n - 3328);
        return -1;
    case 2: return 3752 + n;
    case 3:
        if (n < 512) return (n >> 6) * 96 + (n & 63);
        { const int cc = n - 512, tt = cc >> 7, c7 = cc & 127, wn = c7 >> 6, ni = (c7 >> 5) & 1, c = c7 & 31; const int head = tt * 4 + wn * 2 + (c >> 4); return head * 96 + 64 + ni * 16 + (c & 15); }
    case 4:
        if (n < 512) return (n >> 6) * 128 + (n & 63);
        { const int n2 = n - 512; return (n2 >> 6) * 128 + 64 + (n2 & 63); }
    case 5: return (n >> 5) * 16 + (n & 15);
    default: return n;
    }
}

DI void transpose_tile(const float* __restrict__ src, const float* __restrict__ src2, int ld, int K, bf16_t* __restrict__ dst, int map, const float* __restrict__ kscale, int n0, int k0, float* tile) {
    const int tid = tidx(), tx = tid & 63, ty = tid >> 6;
    const int sc = map_col(map, n0 + tx);
    if (map == 5 && (((n0 + tx) >> 4) & 1)) src = src2;
    const int scc = sc < 0 ? 0 : sc;
    const float* sp = src + (size_t)(k0 + ty) * ld + scc;
    float vals[16];
#pragma unroll
    for (int j = 0; j < 16; ++j) vals[j] = sp[(size_t)(4 * j) * ld];
    if (kscale) {
#pragma unroll
        for (int j = 0; j < 16; ++j) vals[j] *= kscale[k0 + ty + 4 * j];
    }
#pragma unroll
    for (int j = 0; j < 16; ++j) tile[(ty + 4 * j) * 65 + tx] = sc < 0 ? 0.f : vals[j];
    __syncthreads();
    const int n = tid >> 2, kq = (tid & 3) * 16;
    unsigned wv[8];
#pragma unroll
    for (int j = 0; j < 8; ++j) wv[j] = pack_bf16(tile[(kq + 2 * j) * 65 + n], tile[(kq + 2 * j + 1) * 65 + n]);
    uint4* d = (uint4*)(dst + (size_t)(n0 + n) * K + k0 + kq);
    d[0] = make_uint4(wv[0], wv[1], wv[2], wv[3]);
    d[1] = make_uint4(wv[4], wv[5], wv[6], wv[7]);
    __syncthreads();
}

DI void phase_prep(KargPtr p, unsigned char* smem) {
    const int tid = tidx();
    float* fs = (float*)smem;
    constexpr int NW = 9296, NMOD = 192, NROPE = 2048;
    for (int item = bidx(); item < NW + NMOD + NROPE; item += gdim()) {
        if (item < NW) {
            const int l = item / 4648; int ti = item % 4648;
            const float* src; const float* src2 = nullptr; int ld, K, Nd, map; size_t doff; const float* ksc = nullptr;
            if (ti < 992)       { src = p->w_in + (size_t)l * 1024 * 6824; ld = 6824; K = 1024; Nd = 3968; doff = W_IN; map = 1; }
            else if (ti < 1760) { ti -= 992;  src = p->w_in + (size_t)l * 1024 * 6824; ld = 6824; K = 1024; Nd = 3072; doff = W_GATE; map = 2; }
            else if (ti < 1832) { ti -= 1760; src = p->w_mla_uq + (size_t)l * 384 * 768; ld = 768; K = 384; Nd = 768; doff = W_UQ; map = 3; ksc = p->g_mla_q + l * 384; }
            else if (ti < 1896) { ti -= 1832; src = p->w_mla_ukv + (size_t)l * 256 * 1024; ld = 1024; K = 256; Nd = 1024; doff = W_UKV; map = 4; ksc = p->g_mla_kv + l * 256; }
            else if (ti < 2024) { ti -= 1896; src = p->w_o_fox + (size_t)l * 512 * 1024; ld = 1024; K = 512; Nd = 1024; doff = W_OF; map = 0; }
            else if (ti < 2152) { ti -= 2024; src = p->w_o_mla + (size_t)l * 512 * 1024; ld = 1024; K = 512; Nd = 1024; doff = W_OM; map = 0; }
            else if (ti < 2280) { ti -= 2152; src = p->w_o_sb + (size_t)l * 512 * 1024; ld = 1024; K = 512; Nd = 1024; doff = W_OS; map = 0; }
            else if (ti < 2536) { ti -= 2280; src = p->w_out + (size_t)l * 1024 * 1024; ld = 1024; K = 1024; Nd = 1024; doff = W_OUT; map = 0; }
            else if (ti < 3944) { ti -= 2536; src = p->w_ffn_gate + (size_t)l * 1024 * 2816; src2 = p->w_ffn_up + (size_t)l * 1024 * 2816; ld = 2816; K = 1024; Nd = 5632; doff = W_FGU; map = 5; }
            else                { ti -= 3944; src = p->w_ffn_down + (size_t)l * 2816 * 1024; ld = 1024; K = 2816; Nd = 1024; doff = W_FD; map = 0; }
            (void)Nd;
            const int kts = K >> 6; const int ntile = ti / kts, ktile = ti % kts;
            transpose_tile(src, src2, ld, K, p->wt + (size_t)l * W_LAYER + doff, map, ksc, ntile * 64, ktile * 64, fs);
        } else if (item < NW + NMOD) {
            const int mi = item - NW; const int l = mi / 96, c0 = (mi % 96) * 64;
            float* cond = fs;
            float* red = fs + 8192;
            for (int e = tid; e < 8192; e += 256) { const float cv = p->c[e]; cond[e] = cv * sigmoidf_(cv); }
            __syncthreads();
            const int tx = tid & 63, ty = tid >> 6;
            float a0 = 0, a1 = 0, a2 = 0, a3 = 0, a4 = 0, a5 = 0, a6 = 0, a7 = 0;
            const float* wsrc = p->w_ada + (size_t)l * 1024 * 6144 + c0 + tx;
#pragma unroll 8
            for (int k = ty * 256; k < ty * 256 + 256; ++k) {
                const float wv = wsrc[(size_t)k * 6144];
                a0 += cond[k] * wv; a1 += cond[1024 + k] * wv; a2 += cond[2048 + k] * wv; a3 += cond[3072 + k] * wv;
                a4 += cond[4096 + k] * wv; a5 += cond[5120 + k] * wv; a6 += cond[6144 + k] * wv; a7 += cond[7168 + k] * wv;
            }
            float* rr = red + ty * 512 + tx;
            rr[0] = a0; rr[64] = a1; rr[128] = a2; rr[192] = a3; rr[256] = a4; rr[320] = a5; rr[384] = a6; rr[448] = a7;
            __syncthreads();
            for (int o = tid; o < 512; o += 256) {
                const int b = o >> 6, xx = o & 63;
                const float s = red[o] + red[512 + o] + red[1024 + o] + red[1536 + o] + p->b_ada[l * 6144 + c0 + xx];
                p->mod[(size_t)(l * 8 + b) * 6144 + c0 + xx] = s;
            }
            __syncthreads();
        } else {
            const int e = (item - NW - NMOD) * 256 + tid;
            const int i = e & 15, tok = e >> 4;
            const float ang = (float)p->pos[tok] * ROPE_INV[i];
            const double a = (double)ang;
            const double kq = rint(a * 0.63661977236758134308);
            const double rr = fma(-kq, 1.57079632679489661923, a);
            const double r2 = rr * rr;
            const double sn = rr * (1.0 + r2 * (-1.0 / 6 + r2 * (1.0 / 120 + r2 * (-1.0 / 5040 + r2 * (1.0 / 362880 + r2 * (-1.0 / 39916800))))));
            const double cs = 1.0 + r2 * (-0.5 + r2 * (1.0 / 24 + r2 * (-1.0 / 720 + r2 * (1.0 / 40320 + r2 * (-1.0 / 3628800 + r2 * (1.0 / 479001600))))));
            const int q = ((int)(long long)kq) & 3;
            const double co = (q == 0) ? cs : (q == 1) ? -sn : (q == 2) ? -cs : sn;
            const double si = (q == 0) ? sn : (q == 1) ? cs : (q == 2) ? -sn : -cs;
            p->ropetab[2 * (size_t)e] = (float)co; p->ropetab[2 * (size_t)e + 1] = (float)si;
        }
    }
}

DI float wave_sum(float v) {
#pragma unroll
    for (int o = 32; o >= 1; o >>= 1) v += __shfl_xor(v, o);
    return v;
}
DI void phase_norm(const float* __restrict__ xin, const float* __restrict__ g, const float* __restrict__ modl, int sh_idx, int sc_idx, bf16_t* __restrict__ uout) {
    const int lane = tidx() & 63, w = tidx() >> 6;
    for (int row = bidx() * 4 + w; row < T_TOK; row += gdim() * 4) {
        const int b = row >> 12;
        const f32x4* xr = (const f32x4*)(xin + (size_t)row * 1024);
        f32x4 v[4]; float ss = 0.f;
#pragma unroll
        for (int j = 0; j < 4; ++j) { v[j] = xr[lane + 64 * j]; ss += v[j][0] * v[j][0] + v[j][1] * v[j][1] + v[j][2] * v[j][2] + v[j][3] * v[j][3]; }
        ss = wave_sum(ss);
        const float rstd = rsqrtf(ss * (1.0f / 1024.0f) + EPS);
        const float* mb = modl + (size_t)b * 6144;
#pragma unroll
        for (int j = 0; j < 4; ++j) {
            const int col = 4 * (lane + 64 * j);
            const f32x4 g4 = *(const f32x4*)(g + col), sc4 = *(const f32x4*)(mb + sc_idx * 1024 + col), sh4 = *(const f32x4*)(mb + sh_idx * 1024 + col);
            float y[4];
#pragma unroll
            for (int e = 0; e < 4; ++e) y[e] = (v[j][e] * rstd) * g4[e] * (1.0f + sc4[e]) + sh4[e];
            u32x2 pk; pk.x = pack_bf16(y[0], y[1]); pk.y = pack_bf16(y[2], y[3]);
            *(u32x2*)(uout + (size_t)row * 1024 + col) = pk;
        }
    }
}
DI void phase_final(KargPtr p) {
    const int lane = tidx() & 63, w = tidx() >> 6;
    for (int row = bidx() * 4 + w; row < T_TOK; row += gdim() * 4) {
        f32x4* xr = (f32x4*)(p->out + (size_t)row * 1024);
        f32x4 v[4]; float ss = 0.f;
#pragma unroll
        for (int j = 0; j < 4; ++j) { v[j] = xr[lane + 64 * j]; ss += v[j][0] * v[j][0] + v[j][1] * v[j][1] + v[j][2] * v[j][2] + v[j][3] * v[j][3]; }
        ss = wave_sum(ss);
        const float rstd = rsqrtf(ss * (1.0f / 1024.0f) + EPS);
#pragma unroll
        for (int j = 0; j < 4; ++j) {
            const f32x4 g4 = *(const f32x4*)(p->g_final + 4 * (lane + 64 * j));
            f32x4 o;
#pragma unroll
            for (int e = 0; e < 4; ++e) o[e] = (v[j][e] * rstd) * g4[e];
            xr[lane + 64 * j] = o;
        }
    }
}

struct EpiInprojA {
    static constexpr bool PERM = false, AFTER_DRAIN = false;
    bf16_t* qf; bf16_t* kf; bf16_t* qs; bf16_t* ks; bf16_t* ql; bf16_t* kvl; bf16_t* kr; float* logf; const float* ropetab; const float* bfox;
    __device__ __forceinline__ void operator()(const pg8::f32x4 (&acc)[2][2][4][2], const pg8::Unit& u, int wr, int wc, int fr, int fq) const {
        const int row0 = u.pm * 256 + wr * 64 + fr;
        const int cw = wc * 32 + fq * 4;
#pragma unroll
        for (int bj = 0; bj < 2; ++bj) {
            bf16_t* dst; int ld; float sc = 1.0f; bool special = false;
            if (u.pn < 8) { const int region = u.pn >> 1; dst = (region == 0 ? qf : region == 1 ? kf : region == 2 ? qs : ks) + (u.pn & 1) * 256 + bj * 128; ld = 512; if (region == 0 || region == 2) sc = FOX_QS; }
            else if (u.pn == 8) { dst = ql + bj * 128; ld = 384; }
            else if (u.pn == 9) { if (bj == 0) { dst = ql + 256; ld = 384; } else { dst = kvl; ld = 256; } }
            else { dst = kvl + 128; ld = 256; special = (bj == 1); }
            if (!special) {
#pragma unroll
                for (int ai = 0; ai < 2; ++ai)
#pragma unroll
                    for (int m = 0; m < 4; ++m) {
                        bf16_t* rowp = dst + (size_t)(row0 + ai * 128 + m * 16) * ld + cw;
#pragma unroll
                        for (int n = 0; n < 2; ++n) { const pg8::f32x4 v = acc[ai][bj][m][n] * sc; u32x2 pk; pk.x = pack_bf16(v[0], v[1]); pk.y = pack_bf16(v[2], v[3]); *(u32x2*)(rowp + n * 16) = pk; }
                    }
            } else if (wc == 0) {
#pragma unroll
                for (int ai = 0; ai < 2; ++ai)
#pragma unroll
                    for (int m = 0; m < 4; ++m) {
                        const int t = row0 + ai * 128 + m * 16;
                        const pg8::f32x4 x1 = acc[ai][1][m][0], x2 = acc[ai][1][m][1];
                        const pg8::f32x4 ca = *(const pg8::f32x4*)(ropetab + 2 * (t * 16 + fq * 4)), cb = *(const pg8::f32x4*)(ropetab + 2 * (t * 16 + fq * 4) + 4);
                        const float co[4] = {ca[0], ca[2], cb[0], cb[2]}, si[4] = {ca[1], ca[3], cb[1], cb[3]};
                        float o1[4], o2[4];
#pragma unroll
                        for (int j = 0; j < 4; ++j) { o1[j] = x1[j] * co[j] - x2[j] * si[j]; o2[j] = x1[j] * si[j] + x2[j] * co[j]; }
                        u32x2 p1, p2; p1.x = pack_bf16(o1[0], o1[1]); p1.y = pack_bf16(o1[2], o1[3]); p2.x = pack_bf16(o2[0], o2[1]); p2.y = pack_bf16(o2[2], o2[3]);
                        *(u32x2*)(kr + (size_t)t * 32 + fq * 4) = p1;
                        *(u32x2*)(kr + (size_t)t * 32 + 16 + fq * 4) = p2;
                    }
            } else if (wc == 1 && fq < 2) {
#pragma unroll
                for (int ai = 0; ai < 2; ++ai)
#pragma unroll
                    for (int m = 0; m < 4; ++m) {
                        const int t = row0 + ai * 128 + m * 16, b = t >> 12, sq = t & 4095;
#pragma unroll
                        for (int j = 0; j < 4; ++j) {
                            const int head = fq * 4 + j;
                            const float f = acc[ai][1][m][0][j] + bfox[head];
                            logf[(size_t)(b * 8 + head) * SEQ + sq] = fminf(f, 0.f) - log1pf(expf(-fabsf(f)));
                        }
                    }
            }
        }
    }
};
struct EpiInprojV {
    static constexpr bool PERM = false, AFTER_DRAIN = false;
    bf16_t* vtf; bf16_t* vts;
    __device__ __forceinline__ void operator()(const pg8::f32x4 (&acc)[2][2][4][2], const pg8::Unit& u, int wr, int wc, int fr, int fq) const {
        bf16_t* vt = u.pn < 2 ? vtf : vts;
        const int row0 = u.pm * 256 + wr * 64 + fq * 4, b = row0 >> 12, s0 = row0 & 4095;
        const int cv0 = (u.pn & 1) * 256 + wc * 32 + fr;
#pragma unroll
        for (int bj = 0; bj < 2; ++bj)
#pragma unroll
            for (int n = 0; n < 2; ++n) {
                const int cv = cv0 + bj * 128 + n * 16;
                bf16_t* vp = vt + (size_t)(b * 8 + (cv >> 6)) * SEQ * 64 + (cv & 63) * 64;
#pragma unroll
                for (int ai = 0; ai < 2; ++ai)
#pragma unroll
                    for (int m = 0; m < 4; ++m) { const int sq = s0 + ai * 128 + m * 16; const pg8::f32x4 v = acc[ai][bj][m][n]; u32x2 pk; pk.x = pack_bf16(v[0], v[1]); pk.y = pack_bf16(v[2], v[3]);
                        *(u32x2*)(vp + (size_t)(sq >> 6) * 4096 + (sq & 63)) = pk; }
            }
    }
};
struct EpiFfnUp {
    static constexpr bool PERM = false, AFTER_DRAIN = false;
    bf16_t* h;
    __device__ __forceinline__ void operator()(const pg8::f32x4 (&acc)[2][2][4][2], const pg8::Unit& u, int wr, int wc, int fr, int fq) const {
        const int row0 = u.pm * 256 + wr * 64 + fr;
#pragma unroll
        for (int ai = 0; ai < 2; ++ai)
#pragma unroll
            for (int m = 0; m < 4; ++m) {
                bf16_t* rowp = h + (size_t)(row0 + ai * 128 + m * 16) * 2816 + u.pn * 128 + wc * 16 + fq * 4;
#pragma unroll
                for (int bj = 0; bj < 2; ++bj) {
                    const pg8::f32x4 g = acc[ai][bj][m][0], up = acc[ai][bj][m][1];
                    float hv[4];
#pragma unroll
                    for (int j = 0; j < 4; ++j) hv[j] = g[j] * sigmoidf_(g[j]) * up[j];
                    u32x2 pk; pk.x = pack_bf16(hv[0], hv[1]); pk.y = pack_bf16(hv[2], hv[3]);
                    *(u32x2*)(rowp + bj * 64) = pk;
                }
            }
    }
};
struct EpiResidual {
    static constexpr bool PERM = false, AFTER_DRAIN = false;
    const float* xin; float* xout; const float* modl; int gidx;
    __device__ __forceinline__ void operator()(const pg8::f32x4 (&acc)[2][2][4][2], const pg8::Unit& u, int wr, int wc, int fr, int fq) const {
        const int row0 = u.pm * 256 + wr * 64 + fr, b = row0 >> 12;
        const float* gt = modl + (size_t)b * 6144 + gidx * 1024;
#pragma unroll
        for (int bj = 0; bj < 2; ++bj)
#pragma unroll
            for (int n = 0; n < 2; ++n) {
                const int col = u.pn * 256 + bj * 128 + wc * 32 + n * 16 + fq * 4;
                const pg8::f32x4 g4 = *(const pg8::f32x4*)(gt + col);
                pg8::f32x4 xv[2][4];
#pragma unroll
                for (int ai = 0; ai < 2; ++ai)
#pragma unroll
                    for (int m = 0; m < 4; ++m) xv[ai][m] = *(const pg8::f32x4*)(xin + (size_t)(row0 + ai * 128 + m * 16) * 1024 + col);
#pragma unroll
                for (int ai = 0; ai < 2; ++ai)
#pragma unroll
                    for (int m = 0; m < 4; ++m) *(pg8::f32x4*)(xout + (size_t)(row0 + ai * 128 + m * 16) * 1024 + col) = xv[ai][m] + g4 * acc[ai][bj][m][n];
            }
    }
};
template <class Epi, bool NAT = false>
DI void big_gemm(const bf16_t* A, const bf16_t* Bt, int N, int K, const Epi& E, unsigned char* smem) {
    __syncthreads();
    pg8::StaticOrder S; S.init(T_TOK, N, (int)gridDim.x, (int)blockIdx.x);
    pg8::Gemm g; g.A = A; g.Bt = Bt; g.M = T_TOK; g.N = N; g.K = K;
    pg8::gemm_phase<Epi, pg8::StaticOrder, true, true, NAT>((PG8_LAS unsigned char*)smem, g, S, E);
    __syncthreads();
}

DI void phase_inproj(KargPtr p, int l, unsigned char* smem_phys) {
    const bf16_t* W = p->wt + (size_t)l * W_LAYER + W_IN;
    { EpiInprojA E; E.qf = p->qf; E.kf = p->kf; E.qs = p->qs; E.ks = p->ks; E.ql = p->ql; E.kvl = p->kvl; E.kr = p->kr; E.logf = p->logf; E.ropetab = p->ropetab; E.bfox = p->b_fox_f + l * 8;
      big_gemm<EpiInprojA, false>(p->u, W, 2816, 1024, E, smem_phys); }
    { EpiInprojV E; E.vtf = p->vtf; E.vts = p->vts;
      big_gemm<EpiInprojV, true>(p->u, W + (size_t)2816 * 1024, 1024, 1024, E, smem_phys); }
}

DI void phase_mla_up(KargPtr p, int l, unsigned char* smem) {
    const int tid = tidx(), lane = tid & 63, w = tid >> 6, wm = w >> 1, wn = w & 1, r = lane & 31, hh = lane >> 5;
    float* rs = (float*)(smem + 73728);
    const bf16_t* WQ = p->wt + (size_t)l * W_LAYER + W_UQ;
    const bf16_t* WKV = p->wt + (size_t)l * W_LAYER + W_UKV;
    for (int it = 0;; ++it) {
        const int L = it * gdim() + bidx(); if (L >= 3584) break;
        int mt, nt; if (L < 1536) { mt = L / 6; nt = L % 6; } else { mt = (L - 1536) >> 3; nt = 6 + ((L - 1536) & 7); }
        const int m0 = mt * 128, b = m0 >> 12, s0 = m0 & 4095;
        const bool isq = nt < 6;
        const int K = isq ? 384 : 256;
        const bf16_t* A = (isq ? p->ql : p->kvl) + (size_t)m0 * K;
        __syncthreads();
        {
            const int row = tid >> 1, half = tid & 1; const int hk = K >> 1;
            const uint4* ar = (const uint4*)(A + (size_t)row * K + half * hk);
            float ss = 0.f;
#pragma unroll 8
            for (int j = 0; j < (hk >> 3); ++j) {
                const uint4 v = ar[j];
                const unsigned uu[4] = {v.x, v.y, v.z, v.w};
#pragma unroll
                for (int e = 0; e < 4; ++e) { const float lo = __uint_as_float(uu[e] << 16), hi = __uint_as_float(uu[e] & 0xffff0000u); ss += lo * lo + hi * hi; }
            }
            ss += __shfl_xor(ss, 1);
            if (half == 0) rs[row] = rsqrtf(ss / (float)K + EPS);
        }
        __syncthreads();
        f32x16 acc[2][2]; zero_acc(acc);
        if (isq) {
            const bf16_t* Bw = WQ + (size_t)nt * 128 * 384;
            if (nt < 4) {
                gemm_mainloop<64>(Bw, 384, A, 384, 384, acc, smem);
                scale_acc_q(acc, rs, MLA_QS);
                stage_store_128(acc, p->qn + (size_t)m0 * 512 + nt * 128, 512, smem);
            } else {
                gemm_mainloop<64>(A, 384, Bw, 384, 384, acc, smem);
                const int tt = nt - 4; const int head = tt * 4 + wn * 2 + (r >> 4), ii = r & 15;
                const float* __restrict__ rt = p->ropetab; bf16_t* __restrict__ qrp = p->qr;
#pragma unroll
                for (int mi = 0; mi < 2; ++mi) {
                    const int rbase = wm * 64 + mi * 32 + 4 * hh;
                    f32x2_t cs[16];
#pragma unroll
                    for (int i = 0; i < 16; ++i) cs[i] = *(const f32x2_t*)(rt + 2 * ((m0 + rbase + 8 * (i >> 2) + (i & 3)) * 16 + ii));
#pragma unroll
                    for (int i = 0; i < 16; ++i) {
                        const int row = rbase + 8 * (i >> 2) + (i & 3);
                        const int t = m0 + row; const float sc = rs[row] * MLA_QS;
                        const float x1 = acc[mi][0][i] * sc, x2 = acc[mi][1][i] * sc;
                        qrp[t * 256 + head * 32 + ii] = f2bf(x1 * cs[i][0] - x2 * cs[i][1]);
                        qrp[t * 256 + head * 32 + 16 + ii] = f2bf(x1 * cs[i][1] + x2 * cs[i][0]);
                    }
                }
                __syncthreads(); __syncthreads();
            }
        } else {
            const int n2 = nt - 6;
            const bf16_t* Bw = WKV + (size_t)n2 * 128 * 256;
            if (n2 < 4) {
                gemm_mainloop<64>(Bw, 256, A, 256, 256, acc, smem);
                scale_acc_q(acc, rs, 1.0f);
                stage_store_128(acc, p->kn + (size_t)m0 * 512 + n2 * 128, 512, smem);
            } else {
                gemm_mainloop<64>(A, 256, Bw, 256, 256, acc, smem);
                scale_acc_p(acc, rs);
                stage_store_vt(acc, p->vtm, b, (n2 - 4) * 128, s0, smem);
            }
        }
    }
    __syncthreads();
    float* fs = (float*)smem;
    for (int bh = bidx(); bh < 64; bh += gdim()) {
        const f32x4* src = (const f32x4*)(p->logf + (size_t)bh * SEQ + tid * 16);
        f32x4 v[4];
        float run = 0.f;
#pragma unroll
        for (int j = 0; j < 4; ++j) { v[j] = src[j];
#pragma unroll
            for (int e = 0; e < 4; ++e) { run += v[j][e]; v[j][e] = run; } }
        float incl = run;
#pragma unroll
        for (int o = 1; o < 64; o <<= 1) { const float tv = __shfl_up(incl, o); if (lane >= o) incl += tv; }
        if (lane == 63) fs[w] = incl;
        __syncthreads();
        float pre = incl - run;
        for (int ww = 0; ww < w; ++ww) pre += fs[ww];
        f32x4* dst = (f32x4*)(p->cum + (size_t)bh * SEQ + tid * 16);
#pragma unroll
        for (int j = 0; j < 4; ++j) { f32x4 o;
#pragma unroll
            for (int e = 0; e < 4; ++e) o[e] = v[j][e] + pre; dst[j] = o; }
        __syncthreads();
    }
}

template <int TYPE>
DI void attn_item(KargPtr p, int b, int h, int qb, unsigned char* smem) {
    constexpr int DK = (TYPE == 1) ? 96 : (TYPE == 0 ? 80 : 64), KS = DK / 16, KROWB = (DK + 8) * 2, VROWB = 144;
    constexpr int KBYTES = 64 * KROWB, VBYTES = 64 * VROWB, BUFB = KBYTES + VBYTES + 256;
    const int tid = tidx(), lane = tid & 63, w = tid >> 6, r = lane & 31, hh = lane >> 5;
    const int q0 = qb * 128, qw = q0 + 32 * w, myq = qw + r;
    const size_t tokq = (size_t)b * SEQ + myq;
    unsigned* flags = (unsigned*)(smem - vhalf() * VSMEM + FLAGS_OFF);
    const int w8 = vhalf() * 4 + w;

    bf16x8 qfrag[KS];
    if (TYPE == 1) {
#pragma unroll
        for (int ks = 0; ks < 4; ++ks) qfrag[ks] = *(const bf16x8*)(p->qn + tokq * 512 + h * 64 + ks * 16 + hh * 8);
#pragma unroll
        for (int ks = 4; ks < KS; ++ks) qfrag[ks] = *(const bf16x8*)(p->qr + tokq * 256 + h * 32 + (ks - 4) * 16 + hh * 8);
    } else {
        const bf16_t* qg = (TYPE == 0 ? p->qf : p->qs) + tokq * 512 + h * 64;
#pragma unroll
        for (int ks = 0; ks < 4; ++ks) qfrag[ks] = *(const bf16x8*)(qg + ks * 16 + hh * 8);
        if (TYPE == 0) { const u32x4 one3 = hh == 0 ? (u32x4){0x3F803F80u, 0x00003F80u, 0u, 0u} : (u32x4){0u, 0u, 0u, 0u}; qfrag[KS - 1] = __builtin_bit_cast(bf16x8, one3); }
    }
    const bf16_t* Kg = (TYPE == 0 ? p->kf : TYPE == 1 ? p->kn : p->ks) + (size_t)b * SEQ * 512 + h * 64;
    const bf16_t* Vg = (TYPE == 0 ? p->vtf : TYPE == 1 ? p->vtm : p->vts) + (size_t)(b * 8 + h) * 64 * SEQ;
    const bf16_t* Krg = p->kr + (size_t)b * SEQ * 32;
    const float* cumg = p->cum + (size_t)(b * 8 + h) * SEQ;

    const int ntiles = 2 * qb + 2;
    u32x4 rk0A, rk1A, rv0A, rv1A, rkrA, rk0B, rk1B, rv0B, rv1B, rkrB; float rckA = 0.f, rckB = 0.f;
    rkrA = (u32x4){0u, 0u, 0u, 0u}; rkrB = rkrA;
    const int ldrow = tid >> 3, ldch = tid & 7;
    const int vpos = 16 * (ldch >> 1) + 4 * (ldch & 1);
#define LOAD_TILE(S, KT_) do { \
        const int k0_ = (KT_) * 64; \
        GLOAD16(rk0##S, Kg + (size_t)(k0_ + ldrow) * 512 + ldch * 8); \
        GLOAD16(rk1##S, Kg + (size_t)(k0_ + 32 + ldrow) * 512 + ldch * 8); \
        GLOAD16(rv0##S, Vg + (size_t)k0_ * 64 + ldrow * 64 + ldch * 8); \
        GLOAD16(rv1##S, Vg + (size_t)k0_ * 64 + (32 + ldrow) * 64 + ldch * 8); \
        if (TYPE == 1) GLOAD16(rkr##S, Krg + (size_t)(k0_ + (tid >> 2)) * 32 + (tid & 3) * 8); \
        if (TYPE == 0) GLOAD4(rck##S, cumg + k0_ + (tid & 63)); \
    } while (0)
#define WAIT_ALL(S) asm volatile("s_waitcnt vmcnt(0)" : "+v"(rk0##S), "+v"(rk1##S), "+v"(rv0##S), "+v"(rv1##S), "+v"(rkr##S), "+v"(rck##S))
#define WAIT_OLD(S) do { if (TYPE == 2) asm volatile("s_waitcnt vmcnt(4)" : "+v"(rk0##S), "+v"(rk1##S), "+v"(rv0##S), "+v"(rv1##S), "+v"(rkr##S), "+v"(rck##S)); \
        else asm volatile("s_waitcnt vmcnt(5)" : "+v"(rk0##S), "+v"(rk1##S), "+v"(rv0##S), "+v"(rv1##S), "+v"(rkr##S), "+v"(rck##S)); } while (0)
#define STORE_TILE(S, BUF_) do { \
        unsigned char* kb_ = smem + (BUF_) * BUFB; unsigned char* vb_ = kb_ + KBYTES; \
        *(u32x4*)(kb_ + ldrow * KROWB + ldch * 16) = rk0##S; \
        *(u32x4*)(kb_ + (32 + ldrow) * KROWB + ldch * 16) = rk1##S; \
        { u32x2 lo, hi; lo.x = rv0##S.x; lo.y = rv0##S.y; hi.x = rv0##S.z; hi.y = rv0##S.w; \
          *(u32x2*)(vb_ + ldrow * VROWB + vpos * 2) = lo; *(u32x2*)(vb_ + ldrow * VROWB + (vpos + 8) * 2) = hi; } \
        { u32x2 lo, hi; lo.x = rv1##S.x; lo.y = rv1##S.y; hi.x = rv1##S.z; hi.y = rv1##S.w; \
          *(u32x2*)(vb_ + (32 + ldrow) * VROWB + vpos * 2) = lo; *(u32x2*)(vb_ + (32 + ldrow) * VROWB + (vpos + 8) * 2) = hi; } \
        if (TYPE == 1) *(u32x4*)(kb_ + (tid >> 2) * KROWB + 128 + (tid & 3) * 16) = rkr##S; \
        if (TYPE == 0) { if (tid < 64) { \
            const float c_ = -rck##S * LOG2E; \
            const unsigned h_ = pack_bf16(c_, 0.f) & 0xffffu; const float r1_ = c_ - __uint_as_float(h_ << 16); \
            const unsigned m_ = pack_bf16(r1_, 0.f) & 0xffffu; const float r2_ = r1_ - __uint_as_float(m_ << 16); \
            const unsigned l_ = pack_bf16(r2_, 0.f) & 0xffffu; \
            *(u32x4*)(kb_ + tid * KROWB + 128) = (u32x4){h_ | (m_ << 16), l_, 0u, 0u}; \
            *(u32x4*)(kb_ + tid * KROWB + 144) = (u32x4){0u, 0u, 0u, 0u}; } } \
    } while (0)
#define TILE_OF(J_) ((TYPE == 2) ? (ntiles - 1 - ((J_) < ntiles ? (J_) : ntiles - 1)) : ((J_) < ntiles ? (J_) : ntiles - 1))

    f32x16 o0, o1;
#pragma unroll
    for (int i = 0; i < 16; ++i) { o0[i] = 0.f; o1[i] = 0.f; }
    float m = -1e30f, lsum = 0.f, carry = 0.f;
    bool wdone = false;

    auto compute = [&](const int kt, const int buf) __attribute__((always_inline)) {
        const unsigned char* kb = smem + buf * BUFB; const unsigned char* vb = kb + KBYTES;
        const int k0 = kt * 64;
        bool need;
        if (TYPE == 0) need = (k0 <= qw + 31);
        else if (TYPE == 1) need = (k0 <= qw);
        else need = (k0 <= qw + 30) && !wdone;
        if (need) {
            f32x16 s0, s1;
#pragma unroll
            for (int i = 0; i < 16; ++i) { s0[i] = 0.f; s1[i] = 0.f; }
#pragma unroll
            for (int ks = 0; ks < KS; ++ks) {
                const bf16x8 a0 = *(const bf16x8*)(kb + r * KROWB + ks * 32 + hh * 16);
                const bf16x8 a1 = *(const bf16x8*)(kb + (32 + r) * KROWB + ks * 32 + hh * 16);
                s0 = MFMA(a0, qfrag[ks], s0); s1 = MFMA(a1, qfrag[ks], s1);
            }
            if (TYPE != 2) {
                if (TYPE == 0) {
                    if (k0 + 63 > qw) {
                        asm volatile("");
                        const int rel = myq - k0 - 4 * hh;
#pragma unroll
                        for (int i = 0; i < 16; ++i) {
                            const int off = 8 * (i >> 2) + (i & 3);
                            if (off > rel) s0[i] = -1e30f;
                            if (off + 32 > rel) s1[i] = -1e30f;
                        }
                    }
                }
                float mx = s0[0];
#pragma unroll
                for (int i = 1; i < 16; ++i) mx = fmaxf(mx, s0[i]);
#pragma unroll
                for (int i = 0; i < 16; ++i) mx = fmaxf(mx, s1[i]);
                mx = fmaxf(mx, __shfl_xor(mx, 32));
                const float mnew = fmaxf(m, mx);
                const float alpha = fexp2(m - mnew);
                m = mnew;
                float ps = 0.f;
#pragma unroll
                for (int i = 0; i < 16; ++i) { s0[i] = fexp2(s0[i] - mnew); s1[i] = fexp2(s1[i] - mnew); ps += s0[i] + s1[i]; }
                lsum = lsum * alpha + ps;
#pragma unroll
                for (int i = 0; i < 16; ++i) { o0[i] *= alpha; o1[i] *= alpha; }
            } else {
                float lk0[16], lk1[16];
#pragma unroll
                for (int i = 0; i < 16; ++i) {
                    {
                        const float z = s0[i]; const float sp = flog2(1.0f + fexp2(-fabsf(z)));
                        const float lb = fminf(z, 0.f) - sp;
                        s0[i] = lb; lk0[i] = lb - z;
                    }
                    {
                        const float z = s1[i]; const float sp = flog2(1.0f + fexp2(-fabsf(z)));
                        const float lb = fminf(z, 0.f) - sp;
                        s1[i] = lb; lk1[i] = lb - z;
                    }
                }
                if (k0 + 63 >= qw) {
                    asm volatile("");
                    const int rel = myq - k0 - 4 * hh;
#pragma unroll
                    for (int i = 0; i < 16; ++i) {
                        const int off = 8 * (i >> 2) + (i & 3);
                        if (off >= rel) { lk0[i] = 0.f; s0[i] = -1e30f; }
                        if (off + 32 >= rel) { lk1[i] = 0.f; s1[i] = -1e30f; }
                    }
                }
                float run = carry;
#pragma unroll
                for (int g = 3; g >= 0; --g) {
                    const float G = (lk1[4 * g] + lk1[4 * g + 1]) + (lk1[4 * g + 2] + lk1[4 * g + 3]);
                    const float Gp = __shfl_xor(G, 32);
                    const float base = run + (hh == 0 ? Gp : 0.f);
                    const float e3 = base, e2 = e3 + lk1[4 * g + 3], e1 = e2 + lk1[4 * g + 2], e0 = e1 + lk1[4 * g + 1];
                    s1[4 * g + 3] = fexp2(s1[4 * g + 3] + e3); s1[4 * g + 2] = fexp2(s1[4 * g + 2] + e2);
                    s1[4 * g + 1] = fexp2(s1[4 * g + 1] + e1); s1[4 * g] = fexp2(s1[4 * g] + e0);
                    run += G + Gp;
                }
#pragma unroll
                for (int g = 3; g >= 0; --g) {
                    const float G = (lk0[4 * g] + lk0[4 * g + 1]) + (lk0[4 * g + 2] + lk0[4 * g + 3]);
                    const float Gp = __shfl_xor(G, 32);
                    const float base = run + (hh == 0 ? Gp : 0.f);
                    const float e3 = base, e2 = e3 + lk0[4 * g + 3], e1 = e2 + lk0[4 * g + 2], e0 = e1 + lk0[4 * g + 1];
                    s0[4 * g + 3] = fexp2(s0[4 * g + 3] + e3); s0[4 * g + 2] = fexp2(s0[4 * g + 2] + e2);
                    s0[4 * g + 1] = fexp2(s0[4 * g + 1] + e1); s0[4 * g] = fexp2(s0[4 * g] + e0);
                    run += G + Gp;
                }
                carry = run;
            }
#pragma unroll
            for (int s2 = 0; s2 < 2; ++s2) {
                unsigned pk0[4], pk1[4];
#pragma unroll
                for (int j = 0; j < 4; ++j) { pk0[j] = pack_bf16(s0[8 * s2 + 2 * j], s0[8 * s2 + 2 * j + 1]); pk1[j] = pack_bf16(s1[8 * s2 + 2 * j], s1[8 * s2 + 2 * j + 1]); }
                const uint4 u0 = make_uint4(pk0[0], pk0[1], pk0[2], pk0[3]), u1 = make_uint4(pk1[0], pk1[1], pk1[2], pk1[3]);
                const bf16x8 pf0 = __builtin_bit_cast(bf16x8, u0), pf1 = __builtin_bit_cast(bf16x8, u1);
                const bf16x8 v00 = *(const bf16x8*)(vb + r * VROWB + (16 * s2 + 8 * hh) * 2);
                const bf16x8 v01 = *(const bf16x8*)(vb + (32 + r) * VROWB + (16 * s2 + 8 * hh) * 2);
                const bf16x8 v10 = *(const bf16x8*)(vb + r * VROWB + (32 + 16 * s2 + 8 * hh) * 2);
                const bf16x8 v11 = *(const bf16x8*)(vb + (32 + r) * VROWB + (32 + 16 * s2 + 8 * hh) * 2);
                o0 = MFMA(v00, pf0, o0); o1 = MFMA(v01, pf0, o1);
                o0 = MFMA(v10, pf1, o0); o1 = MFMA(v11, pf1, o1);
            }
        }
    };
#define SB_FLAGS(N_) do { if (TYPE == 2) { wdone = (__all(carry < -170.f) != 0); if (lane == 0) flags[((N_) & 1) * 8 + w8] = wdone ? 1u : 0u; } } while (0)
#define SB_DONE(N_) (TYPE == 2 && ((flags[((N_) & 1) * 8] & flags[((N_) & 1) * 8 + 1] & flags[((N_) & 1) * 8 + 2] & flags[((N_) & 1) * 8 + 3] & flags[((N_) & 1) * 8 + 4] & flags[((N_) & 1) * 8 + 5] & flags[((N_) & 1) * 8 + 6] & flags[((N_) & 1) * 8 + 7]) != 0u))
    __syncthreads();
    if (TYPE == 2 && tid < 16) flags[tid] = 0;
    LOAD_TILE(A, TILE_OF(0));
    WAIT_ALL(A);
    STORE_TILE(A, 0);
    LOAD_TILE(A, TILE_OF(1));
    __syncthreads();
    for (int n = 0; n < ntiles; n += 2) {
        LOAD_TILE(B, TILE_OF(n + 2));
        __builtin_amdgcn_sched_barrier(0);
        compute(TILE_OF(n), 0);
        __builtin_amdgcn_sched_barrier(0);
        WAIT_OLD(A);
        STORE_TILE(A, 1);
        SB_FLAGS(n);
        __syncthreads();
        if (SB_DONE(n)) break;
        if (n + 1 >= ntiles) break;
        LOAD_TILE(A, TILE_OF(n + 3));
        __builtin_amdgcn_sched_barrier(0);
        compute(TILE_OF(n + 1), 1);
        __builtin_amdgcn_sched_barrier(0);
        WAIT_OLD(B);
        STORE_TILE(B, 0);
        SB_FLAGS(n + 1);
        __syncthreads();
        if (SB_DONE(n + 1)) break;
    }
    asm volatile("s_waitcnt vmcnt(0)" : "+v"(rk0A), "+v"(rk1A), "+v"(rv0A), "+v"(rv1A), "+v"(rkrA), "+v"(rckA), "+v"(rk0B), "+v"(rk1B), "+v"(rv0B), "+v"(rv1B), "+v"(rkrB), "+v"(rckB));
    float inv = 1.0f;
    if (TYPE != 2) { const float lt = lsum + __shfl_xor(lsum, 32); inv = frcp(lt); }
    bf16_t* yg = (TYPE == 0 ? p->qf : TYPE == 1 ? p->qn : p->qs) + tokq * 512 + h * 64;
#pragma unroll
    for (int g = 0; g < 4; ++g) {
        u32x2 a, c2;
        a.x = pack_bf16(o0[4 * g] * inv, o0[4 * g + 1] * inv); a.y = pack_bf16(o0[4 * g + 2] * inv, o0[4 * g + 3] * inv);
        c2.x = pack_bf16(o1[4 * g] * inv, o1[4 * g + 1] * inv); c2.y = pack_bf16(o1[4 * g + 2] * inv, o1[4 * g + 3] * inv);
        *(u32x2*)(yg + 8 * g + 4 * hh) = a;
        *(u32x2*)(yg + 32 + 8 * g + 4 * hh) = c2;
    }
}

DI void phase_attn(KargPtr p, unsigned char* smem) {
    for (int idx = bidx(); idx < 6144; idx += gdim()) {
        if (idx < 4096) {
            const int j = idx >> 9, g = (idx >> 7) & 3, rem = idx & 127, bh = rem & 63;
            const int qb = 31 - 4 * j - ((j & 1) ? 3 - g : g);
            const int type = ((rem >> 6) + j) & 1;
            if (type == 0) attn_item<0>(p, bh >> 3, bh & 7, qb, smem);
            else attn_item<1>(p, bh >> 3, bh & 7, qb, smem);
        } else {
            const int j = idx - 4096; const int qb = 31 - (j >> 6), bh = j & 63;
            attn_item<2>(p, bh >> 3, bh & 7, qb, smem);
        }
    }
}

DI void phase_merge(KargPtr p, int l, unsigned char* smem) {
    const bf16_t* WL = p->wt + (size_t)l * W_LAYER;
    unsigned* park = (unsigned*)(smem + 40960) + tidx();
    for (int it = 0;; ++it) {
        int mt, nt; if (!next_tile(it, 256, 8, mt, nt)) break;
        const int m0 = mt * 128;
        f32x16 mer[2][2]; zero_acc(mer);
#pragma unroll 1
        for (int br = 0; br < 3; ++br) {
            f32x16 acc[2][2]; zero_acc(acc);
            gemm_mainloop<32>(WL + W_GATE + (size_t)(br * 1024 + nt * 128) * 1024, 1024, p->u + (size_t)m0 * 1024, 1024, 1024, acc, smem);
#pragma unroll
            for (int a = 0; a < 2; ++a)
#pragma unroll
                for (int c = 0; c < 2; ++c)
#pragma unroll
                    for (int j = 0; j < 8; ++j) park[((a * 2 + c) * 8 + j) * 256] = pack_bf16(sigmoidf_(acc[a][c][2 * j]), sigmoidf_(acc[a][c][2 * j + 1]));
            zero_acc(acc);
            const bf16_t* Y = (br == 0 ? p->qf : br == 1 ? p->qn : p->qs) + (size_t)m0 * 512;
            const bf16_t* WO = WL + (br == 0 ? W_OF : br == 1 ? W_OM : W_OS) + (size_t)nt * 128 * 512;
            gemm_mainloop<32>(WO, 512, Y, 512, 512, acc, smem);
#pragma unroll
            for (int a = 0; a < 2; ++a)
#pragma unroll
                for (int c = 0; c < 2; ++c)
#pragma unroll
                    for (int j = 0; j < 8; ++j) {
                        const unsigned gv = park[((a * 2 + c) * 8 + j) * 256];
                        const float g0 = __uint_as_float(gv << 16), g1 = __uint_as_float(gv & 0xffff0000u);
                        mer[a][c][2 * j] += g0 * acc[a][c][2 * j]; mer[a][c][2 * j + 1] += g1 * acc[a][c][2 * j + 1];
                    }
        }
        stage_store_128(mer, p->merged + (size_t)m0 * 1024 + nt * 128, 1024, smem);
    }
}

DI void phase_outproj(KargPtr p, int l, unsigned char* smem_phys) {
    EpiResidual E; E.xin = (l == 0) ? p->x : p->out; E.xout = p->out; E.modl = p->mod + (size_t)l * 8 * 6144; E.gidx = 2;
    big_gemm(p->merged, p->wt + (size_t)l * W_LAYER + W_OUT, 1024, 1024, E, smem_phys);
}
DI void phase_ffn_up(KargPtr p, int l, unsigned char* smem_phys) {
    EpiFfnUp E; E.h = p->h;
    big_gemm(p->u, p->wt + (size_t)l * W_LAYER + W_FGU, 5632, 1024, E, smem_phys);
}
DI void phase_ffn_down(KargPtr p, int l, unsigned char* smem_phys) {
    EpiResidual E; E.xin = p->out; E.xout = p->out; E.modl = p->mod + (size_t)l * 8 * 6144; E.gidx = 5;
    big_gemm(p->h, p->wt + (size_t)l * W_LAYER + W_FD, 1024, 2816, E, smem_phys);
}

DI void run_phase(int ph, int l, unsigned char* smem_phys) {
#ifdef ONLY_PH
    if (ph != ONLY_PH) return;
#endif
    KargPtr p = karg();
    unsigned char* smem = smem_phys + vhalf() * VSMEM;
    switch (ph) {
    case 0: phase_prep(p, smem); break;
    case 1: phase_norm((l == 0) ? p->x : p->out, p->g_mix + l * 1024, p->mod + (size_t)l * 8 * 6144, 0, 1, p->u); break;
    case 2: phase_inproj(p, l, smem_phys); break;
    case 3: phase_mla_up(p, l, smem); break;
    case 4: phase_attn(p, smem); break;
    case 5: phase_merge(p, l, smem); break;
    case 6: phase_outproj(p, l, smem_phys); break;
    case 7: phase_norm(p->out, p->g_ffn + l * 1024, p->mod + (size_t)l * 8 * 6144, 3, 4, p->u); break;
    case 8: phase_ffn_up(p, l, smem_phys); break;
    case 9: phase_ffn_down(p, l, smem_phys); break;
    default: phase_final(p); break;
    }
}

#define XB_TMO      128
#define XB_XCNT(j)  (256  + 64 * (j))
#define XB_XSUB(j)  (1280 + 64 * (j))
#define XB_XGEN(j)  (2304 + 64 * (j))
#define XB_TOP      3328
#define XB_TOPGEN   3392
#define XCD_BAR_WORDS 3456
#define XB_SPIN_CAP (1u << 20)
#define LAS __attribute__((address_space(3)))
DI unsigned xb_ld(unsigned* p)              { return __hip_atomic_load(p, __ATOMIC_RELAXED, __HIP_MEMORY_SCOPE_AGENT); }
DI unsigned xb_add(unsigned* p, unsigned v) { return __hip_atomic_fetch_add(p, v, __ATOMIC_RELAXED, __HIP_MEMORY_SCOPE_AGENT); }
DI unsigned xb_xcc_id() { return (unsigned)__builtin_amdgcn_s_getreg((3 << 11) | 20) & 0xFu; }
#define XB_SPIN(cond, bar) do { unsigned _sp = 0; while (cond) { __builtin_amdgcn_s_sleep(1); \
    if ((++_sp & 255u) == 0u) { if (xb_ld(&(bar)[XB_TMO])) break; if (_sp > XB_SPIN_CAP) { atomicAdd(&(bar)[XB_TMO], 1u); break; } } } } while (0)
struct XcdBarrier { unsigned* bar; unsigned x; volatile LAS unsigned* st; };
DI XcdBarrier xcd_barrier_post(unsigned* bar, volatile LAS unsigned* st) {
    XcdBarrier b; b.bar = bar; b.x = xb_xcc_id(); b.st = st;
    if (threadIdx.x == 0) (void)xb_add(&bar[XB_XCNT(b.x)], 1u);
    return b;
}
DI void xcd_barrier_complete(unsigned* bar, unsigned x, unsigned& nloc, unsigned& nx) {
    const unsigned G = gridDim.x * gridDim.y * gridDim.z;
    unsigned sum, cnt, mine, sp = 0u;
    for (;;) {
        sum = 0u; cnt = 0u; mine = 0u;
#pragma unroll
        for (unsigned j = 0; j < 16; ++j) { const unsigned c = xb_ld(&bar[XB_XCNT(j)]); sum += c; cnt += (c > 0u) ? 1u : 0u; mine = (j == x) ? c : mine; }
        if (sum == G) break;
        __builtin_amdgcn_s_sleep(1);
        if ((++sp & 255u) == 0u) { if (xb_ld(&bar[XB_TMO])) break; if (sp > XB_SPIN_CAP) { atomicAdd(&bar[XB_TMO], 1u); break; } }
    }
    nloc = mine > 0u ? mine : 1u; nx = cnt > 0u ? cnt : 1u;
}
DI void xcd_barrier(const XcdBarrier& b) {
    asm volatile("s_waitcnt vmcnt(0)" ::: "memory");
    __syncthreads();
    if (threadIdx.x == 0) {
        unsigned* bar = b.bar;
        __builtin_amdgcn_s_waitcnt(0);
        unsigned nloc = b.st[0], nx = b.st[1];
        if (nloc == 0u) { xcd_barrier_complete(bar, b.x, nloc, nx); b.st[0] = nloc; b.st[1] = nx; }
        const unsigned old = xb_add(&bar[XB_XSUB(b.x)], 1u);
        const unsigned gen = old / nloc;
        if (old + 1u == (gen + 1u) * nloc) {
            __builtin_amdgcn_fence(__ATOMIC_RELEASE, "agent");
            asm volatile("s_waitcnt vmcnt(0)" ::: "memory");
            const unsigned og = xb_add(&bar[XB_TOP], 1u);
            const unsigned tg = og / nx;
            if (og + 1u == (tg + 1u) * nx) xb_add(&bar[XB_TOPGEN], 1u);
            else XB_SPIN(xb_ld(&bar[XB_TOPGEN]) == tg, bar);
            __builtin_amdgcn_fence(__ATOMIC_ACQUIRE, "agent");
            xb_add(&bar[XB_XGEN(b.x)], 1u);
            asm volatile("s_waitcnt vmcnt(0)" ::: "memory");
        } else {
            XB_SPIN(xb_ld(&bar[XB_XGEN(b.x)]) == gen, bar);
            __builtin_amdgcn_fence(__ATOMIC_ACQUIRE, "agent");
            asm volatile("s_waitcnt vmcnt(0)" ::: "memory");
        }
    }
    __syncthreads();
}

#if MEGA
__global__ void __launch_bounds__(512, 2) __attribute__((amdgpu_waves_per_eu(2, 2))) mega_kernel(Params p) {
    extern __shared__ __attribute__((aligned(16))) unsigned char smem[];
    cg::grid_group grid = cg::this_grid();
    volatile LAS unsigned* st = (volatile LAS unsigned*)(smem + SMEM_BYTES - 16);
    if (threadIdx.x == 0) { st[0] = 0u; st[1] = 0u; }
    __syncthreads();
    const XcdBarrier xb = xcd_barrier_post(karg()->bar, st);
    run_phase(0, 0, smem);
    grid.sync();
#pragma unroll 1
    for (int l = 0; l < 2; ++l) {
#pragma unroll 1
        for (int ph = 1; ph <= 9; ++ph) {
            run_phase(ph, l, smem); xcd_barrier(xb);
#ifdef DBL_PH
            if (ph == DBL_PH) { run_phase(ph, l, smem); xcd_barrier(xb); }
#endif
        }
    }
    run_phase(10, 0, smem);
}
#else
__global__ void __launch_bounds__(512, 2) __attribute__((amdgpu_waves_per_eu(2, 2))) phase_kernel(Params p, int ph, int l) {
    extern __shared__ __attribute__((aligned(16))) unsigned char smem[];
    run_phase(ph, l, smem);
}
#endif

extern "C" void kernel_launch(void* const* d_in, const int* in_sizes, int n_in, void* d_out, int out_size, void* d_ws, size_t ws_size, hipStream_t stream) {
    (void)in_sizes; (void)n_in; (void)out_size;
    Params p{};
    p.x = (const float*)d_in[0]; p.c = (const float*)d_in[1]; p.pos = (const int*)d_in[2];
    p.g_mix = (const float*)d_in[3]; p.w_ada = (const float*)d_in[4]; p.b_ada = (const float*)d_in[5]; p.w_in = (const float*)d_in[6]; p.b_fox_f = (const float*)d_in[7];
    p.g_mla_q = (const float*)d_in[8]; p.w_mla_uq = (const float*)d_in[9]; p.g_mla_kv = (const float*)d_in[10]; p.w_mla_ukv = (const float*)d_in[11];
    p.w_o_fox = (const float*)d_in[12]; p.w_o_mla = (const float*)d_in[13]; p.w_o_sb = (const float*)d_in[14]; p.w_out = (const float*)d_in[15];
    p.g_ffn = (const float*)d_in[16]; p.w_ffn_gate = (const float*)d_in[17]; p.w_ffn_up = (const float*)d_in[18]; p.w_ffn_down = (const float*)d_in[19]; p.g_final = (const float*)d_in[20];
    p.out = (float*)d_out;
    unsigned char* ws = (unsigned char*)d_ws; size_t off = 0;
    auto take = [&](size_t bytes) { unsigned char* q = ws + off; off += (bytes + 255) & ~(size_t)255; return q; };
    p.bar = (unsigned*)take(16384);
    p.wt = (bf16_t*)take(2 * W_LAYER * 2);
    p.mod = (float*)take(2 * 8 * 6144 * 4);
    p.ropetab = (float*)take((size_t)T_TOK * 16 * 2 * 4);
    p.logf = (float*)take((size_t)64 * SEQ * 4);
    p.cum = (float*)take((size_t)64 * SEQ * 4);
    p.u = (bf16_t*)take((size_t)T_TOK * 1024 * 2);
    p.qf = (bf16_t*)take((size_t)T_TOK * 512 * 2);
    p.kf = (bf16_t*)take((size_t)T_TOK * 512 * 2);
    p.vtf = (bf16_t*)take((size_t)T_TOK * 512 * 2);
    p.qs = (bf16_t*)take((size_t)T_TOK * 512 * 2);
    p.ks = (bf16_t*)take((size_t)T_TOK * 512 * 2);
    p.vts = (bf16_t*)take((size_t)T_TOK * 512 * 2);
    p.ql = (bf16_t*)take((size_t)T_TOK * 384 * 2);
    p.kvl = (bf16_t*)take((size_t)T_TOK * 256 * 2);
    p.kr = (bf16_t*)take((size_t)T_TOK * 32 * 2);
    p.qn = (bf16_t*)take((size_t)T_TOK * 512 * 2);
    p.qr = (bf16_t*)take((size_t)T_TOK * 256 * 2);
    p.kn = (bf16_t*)take((size_t)T_TOK * 512 * 2);
    p.vtm = (bf16_t*)take((size_t)T_TOK * 512 * 2);
    p.merged = p.kf;
    p.h = p.qf;
    if (off > ws_size) { fprintf(stderr, "kernel_launch: workspace too small: need %zu, have %zu\n", off, ws_size); return; }

#if MEGA
    static int grid_blocks = 0;
    if (!grid_blocks) {
        int dev = 0, cus = 0, per_cu = 0;
        (void)hipGetDevice(&dev);
        (void)hipDeviceGetAttribute(&cus, hipDeviceAttributeMultiprocessorCount, dev);
        (void)hipFuncSetAttribute((const void*)mega_kernel, hipFuncAttributeMaxDynamicSharedMemorySize, SMEM_BYTES);
        (void)hipOccupancyMaxActiveBlocksPerMultiprocessor(&per_cu, (const void*)mega_kernel, 512, SMEM_BYTES);
        per_cu = 1;
        grid_blocks = cus * per_cu;
        grid_blocks &= ~7;
    }
    (void)hipMemsetAsync(p.bar, 0, 16384, stream);
    void* args[] = {&p};
    hipError_t e = hipLaunchCooperativeKernel((const void*)mega_kernel, dim3(grid_blocks), dim3(512), args, SMEM_BYTES, stream);
    if (e != hipSuccess) fprintf(stderr, "cooperative launch failed: %s (grid %d)\n", hipGetErrorString(e), grid_blocks);
#else
    static bool attr = false;
    if (!attr) { (void)hipFuncSetAttribute((const void*)phase_kernel, hipFuncAttributeMaxDynamicSharedMemorySize, SMEM_BYTES); attr = true; }
    const int G = 512;
    hipLaunchKernelGGL(phase_kernel, dim3(G), dim3(256), SMEM_BYTES, stream, p, 0, 0);
    for (int l = 0; l < 2; ++l)
        for (int ph = 1; ph <= 9; ++ph) hipLaunchKernelGGL(phase_kernel, dim3(G), dim3(256), SMEM_BYTES, stream, p, ph, l);
    hipLaunchKernelGGL(phase_kernel, dim3(G), dim3(256), SMEM_BYTES, stream, p, 10, 0);
#endif
}
```

```cpp
#include <hip/hip_runtime.h>
#include <hip/hip_cooperative_groups.h>
#include <cstdint>
#include <cstdio>
namespace cg = cooperative_groups;

#ifndef MEGA
#define MEGA 1
#endif

typedef unsigned short bf16_t;
typedef short bf16x8 __attribute__((ext_vector_type(8)));
typedef float f32x16 __attribute__((ext_vector_type(16)));
typedef float f32x4 __attribute__((ext_vector_type(4)));
typedef unsigned u32x2 __attribute__((ext_vector_type(2)));
#define DI __device__ __forceinline__
typedef unsigned u32x4 __attribute__((ext_vector_type(4)));
#define GLOAD16(dst, ptr) asm volatile("global_load_dwordx4 %0, %1, off" : "=v"(dst) : "v"(ptr))
#define GLOAD4(dst, ptr)  asm volatile("global_load_dword %0, %1, off" : "=v"(dst) : "v"(ptr))
#define MFMA(a, b, c) __builtin_amdgcn_mfma_f32_32x32x16_bf16((a), (b), (c), 0, 0, 0)

namespace pg8 {
#define PG8_LAS __attribute__((address_space(3)))
typedef unsigned short bf16_t;
typedef short bf16x8 __attribute__((ext_vector_type(8)));
typedef float f32x4 __attribute__((ext_vector_type(4)));
typedef unsigned u32x4 __attribute__((ext_vector_type(4)));
constexpr int BM = 256, BK = 64, HALF = 128, HTB = HALF * BK * 2  , STAGE_BYTES = 8 * HTB, NXCD = 8, WGM = 8;

__host__ __device__ __forceinline__ int lds_byte(int r, int c) { const int st = (r >> 4) * 2 + (c >> 5), rr = r & 15, cc = c & 31, ob = rr * 64 + cc * 2; return st * 1024 + (ob ^ (((ob >> 9) & 1) << 5)); }
__host__ __device__ __forceinline__ void stage_rc(int b, int& R, int& C) { const int st = b / 1024, sb = b % 1024, swz = sb ^ (((sb >> 9) & 1) << 5); R = (st >> 1) * 16 + swz / 64; C = (st & 1) * 32 + (swz % 64) / 2; }
__host__ __device__ __forceinline__ int perm32(int rho) { const int n = rho >> 4, i = rho & 15; return 8 * (i >> 2) + 4 * n + (i & 3); }

struct Unit { int pm, pn; };
struct Gemm { const bf16_t* A; const bf16_t* Bt; int M, N, K; };

struct StaticOrder {
    int nM, nN, nwg, G, c;
    __host__ __device__ void init(int M, int N, int G_, int c_) { nM = M / BM; nN = N / BM; nwg = nM * nN; G = G_; c = c_; }
    __host__ __device__ bool next(int i, Unit& u) const {
        const long L = (long)i * G + c; if (L >= nwg) return false;
        int wgid = (int)L; { const int q = nwg / NXCD, r = nwg % NXCD, xcd = wgid % NXCD, off = wgid / NXCD; wgid = (xcd < r ? xcd * (q + 1) : r * (q + 1) + (xcd - r) * q) + off; }
        const int nig = WGM * nN, gid = wgid / nig, fm = gid * WGM, gsz = (nM - fm) < WGM ? (nM - fm) : WGM;
        u.pm = fm + ((wgid % nig) % gsz); u.pn = (wgid % nig) / gsz; return true;
    }
    __device__ __forceinline__ void a_ready(const Unit&) const {}
    __device__ __forceinline__ void done(const Unit&) const {}
};
template <class Epi, class Sched, bool ALIGN_EPI = false, bool SP2 = false, bool NAT = false>
__device__ __forceinline__ void gemm_phase(PG8_LAS unsigned char* lds, const Gemm g, const Sched& S, const Epi& E) {
    int tid = threadIdx.x; asm volatile("" : "+v"(tid)); const int wid = __builtin_amdgcn_readfirstlane(tid >> 6), lane = tid & 63, wr = wid >> 2, wc = wid & 3, fr = lane & 15, fq = lane >> 4;
    const int K = g.K, nt = K / BK;
    unsigned voffA[2], voffB[2];
#pragma unroll
    for (int i = 0; i < 2; ++i) { int R, C; stage_rc(tid * 16 + i * 8192, R, C); const int Rb = Epi::PERM ? ((R & ~31) + perm32(R & 31)) : R;
        voffA[i] = (unsigned)(R * K + C) * 2u; voffB[i] = (unsigned)(Rb * K + C) * 2u; }
    const size_t kstep = (size_t)(BK * 2);
    const size_t hstep = (size_t)HALF * K * 2;
    const size_t tstep = 2 * hstep;
    const unsigned ldsw = (unsigned)wid * 1024u;
    const int aoff = lds_byte(wr * 64 + fr, fq * 8), boff = lds_byte(wc * 32 + fr, fq * 8);
#define PG8_SA(b, h) (((b) * 2 + (h)) * HTB)
#define PG8_SB(b, h) ((4 + (b) * 2 + (h)) * HTB)
#define PG8_STAGE(bufoff, gbase, voff) do { _Pragma("unroll") for (int _i = 0; _i < 2; ++_i) \
        __builtin_amdgcn_global_load_lds((const unsigned*)((const char*)(gbase) + (voff)[_i]), (PG8_LAS unsigned*)(lds + (bufoff) + ldsw + _i * 8192), 16, 0, 0); } while (0)
#define PG8_LDA(dst, b, h) do { _Pragma("unroll") for (int m = 0; m < 4; ++m) _Pragma("unroll") for (int k = 0; k < 2; ++k) dst[m][k] = *(const PG8_LAS bf16x8*)(lds + PG8_SA(b, h) + aoff + m * 2048 + k * 1024); } while (0)
#define PG8_LDB(dst, b, h) do { _Pragma("unroll") for (int n = 0; n < 2; ++n) _Pragma("unroll") for (int k = 0; k < 2; ++k) dst[n][k] = *(const PG8_LAS bf16x8*)(lds + PG8_SB(b, h) + boff + n * 2048 + k * 1024); } while (0)
#define PG8_MMA(ai, bj, At, Bt) do { __builtin_amdgcn_s_setprio(1); _Pragma("unroll") for (int m = 0; m < 4; ++m) _Pragma("unroll") for (int n = 0; n < 2; ++n) _Pragma("unroll") for (int k = 0; k < 2; ++k) \
        acc[ai][bj][m][n] = NAT ? __builtin_amdgcn_mfma_f32_16x16x32_bf16(At[m][k], Bt[n][k], acc[ai][bj][m][n], 0, 0, 0) : __builtin_amdgcn_mfma_f32_16x16x32_bf16(Bt[n][k], At[m][k], acc[ai][bj][m][n], 0, 0, 0); __builtin_amdgcn_s_setprio(0); } while (0)
#define PG8_WAIT_V(n) asm volatile("s_waitcnt vmcnt(" #n ")" ::: "memory")
#define PG8_WAIT_L(n) asm volatile("s_waitcnt lgkmcnt(" #n ")" ::: "memory")
#define PG8_BAR __builtin_amdgcn_s_barrier()
#define PG8_SCHED __builtin_amdgcn_sched_barrier(0)
    Unit cur, nxt; int ui = 0;
    if (!S.next(0, cur)) return;
    f32x4 acc[2][2][4][2];
#pragma unroll
    for (int a = 0; a < 2; ++a)
#pragma unroll
        for (int b = 0; b < 2; ++b)
#pragma unroll
            for (int m = 0; m < 4; ++m)
#pragma unroll
                for (int n = 0; n < 2; ++n) acc[a][b][m][n] = (f32x4){0.f, 0.f, 0.f, 0.f};
    bf16x8 At[4][2], B0[2][2], B1[2][2];
    const char* cA = (const char*)g.A + (size_t)cur.pm * tstep; const char* cB = (const char*)g.Bt + (size_t)cur.pn * tstep;
    S.a_ready(cur);
    if constexpr (SP2) {
        PG8_STAGE(PG8_SB(0, 0), cB, voffB); PG8_STAGE(PG8_SB(0, 1), cB + hstep, voffB); PG8_STAGE(PG8_SA(0, 0), cA, voffA); PG8_STAGE(PG8_SA(0, 1), cA + hstep, voffA);
        if (wr == 1) PG8_BAR;
        PG8_WAIT_V(2); PG8_BAR;
        PG8_STAGE(PG8_SB(1, 0), cB + kstep, voffB); PG8_STAGE(PG8_SA(1, 0), cA + kstep, voffA); PG8_STAGE(PG8_SB(1, 1), cB + hstep + kstep, voffB);
        PG8_WAIT_V(6); PG8_BAR;
    } else {
        PG8_STAGE(PG8_SB(0, 0), cB, voffB); PG8_STAGE(PG8_SA(0, 0), cA, voffA); PG8_STAGE(PG8_SB(0, 1), cB + hstep, voffB); PG8_STAGE(PG8_SA(0, 1), cA + hstep, voffA);
        if (wr == 1) PG8_BAR;
        PG8_WAIT_V(4); PG8_BAR;
        PG8_STAGE(PG8_SB(1, 0), cB + kstep, voffB); PG8_STAGE(PG8_SA(1, 0), cA + kstep, voffA); PG8_STAGE(PG8_SB(1, 1), cB + hstep + kstep, voffB);
        PG8_WAIT_V(6); PG8_BAR;
    }
    for (;;) {
        const bool has_next = S.next(ui + 1, nxt);
        const char* nA = has_next ? (const char*)g.A + (size_t)nxt.pm * tstep : cA; const char* nB = has_next ? (const char*)g.Bt + (size_t)nxt.pn * tstep : cB;
        for (int t = 0; t < nt; t += 2) {
            const bool last = (t == nt - 2);
            const char* a1 = cA + (size_t)(t + 1) * kstep;
            const char* a2 = last ? nA : cA + (size_t)(t + 2) * kstep; const char* b2 = last ? nB : cB + (size_t)(t + 2) * kstep;
            const char* a3 = a2 + kstep; const char* b3 = b2 + kstep;
            if (last && has_next) S.a_ready(nxt);
            if constexpr (SP2) {
            PG8_LDB(B0, 0, 0); PG8_LDB(B1, 0, 1); PG8_SCHED; PG8_LDA(At, 0, 0); PG8_STAGE(PG8_SA(1, 1), a1 + hstep, voffA);
            PG8_WAIT_V(8); PG8_WAIT_L(0); PG8_BAR; PG8_MMA(0, 0, At, B0); PG8_MMA(0, 1, At, B1); PG8_BAR; PG8_SCHED;
            PG8_LDA(At, 0, 1); PG8_STAGE(PG8_SB(0, 0), b2, voffB); PG8_STAGE(PG8_SB(0, 1), b2 + hstep, voffB); PG8_STAGE(PG8_SA(0, 0), a2, voffA);
            PG8_WAIT_V(8); PG8_WAIT_L(0); PG8_BAR; PG8_MMA(1, 0, At, B0); PG8_MMA(1, 1, At, B1); PG8_BAR; PG8_SCHED;
            PG8_LDB(B0, 1, 0); PG8_LDB(B1, 1, 1); PG8_SCHED; PG8_LDA(At, 1, 0); PG8_STAGE(PG8_SA(0, 1), a2 + hstep, voffA);
            PG8_WAIT_V(8); PG8_WAIT_L(0); PG8_BAR; PG8_MMA(0, 0, At, B0); PG8_MMA(0, 1, At, B1); PG8_BAR; PG8_SCHED;
            PG8_LDA(At, 1, 1); PG8_STAGE(PG8_SB(1, 0), b3, voffB); PG8_STAGE(PG8_SB(1, 1), b3 + hstep, voffB); PG8_STAGE(PG8_SA(1, 0), a3, voffA);
            PG8_WAIT_V(8); PG8_WAIT_L(0); PG8_BAR; PG8_MMA(1, 0, At, B0); PG8_MMA(1, 1, At, B1); PG8_BAR; PG8_SCHED;
            } else {
            PG8_LDB(B0, 0, 0); PG8_SCHED; PG8_LDA(At, 0, 0); PG8_STAGE(PG8_SA(1, 1), a1 + hstep, voffA);
            PG8_WAIT_L(8); PG8_BAR; PG8_WAIT_L(0); PG8_MMA(0, 0, At, B0); PG8_BAR; PG8_SCHED;
            PG8_LDB(B1, 0, 1); PG8_STAGE(PG8_SB(0, 0), b2, voffB);
            PG8_BAR; PG8_WAIT_L(0); PG8_MMA(0, 1, At, B1); PG8_BAR;
            PG8_LDA(At, 0, 1); PG8_STAGE(PG8_SA(0, 0), a2, voffA);
            PG8_BAR; PG8_WAIT_L(0); PG8_MMA(1, 0, At, B0); PG8_BAR; PG8_SCHED;
            PG8_STAGE(PG8_SB(0, 1), b2 + hstep, voffB);
            PG8_WAIT_V(6); PG8_BAR; PG8_MMA(1, 1, At, B1); PG8_BAR;
            PG8_LDB(B0, 1, 0); PG8_SCHED; PG8_LDA(At, 1, 0); PG8_STAGE(PG8_SA(0, 1), a2 + hstep, voffA);
            PG8_WAIT_L(8); PG8_BAR; PG8_WAIT_L(0); PG8_MMA(0, 0, At, B0); PG8_BAR; PG8_SCHED;
            PG8_LDB(B1, 1, 1); PG8_STAGE(PG8_SB(1, 0), b3, voffB);
            PG8_BAR; PG8_WAIT_L(0); PG8_MMA(0, 1, At, B1); PG8_BAR;
            PG8_LDA(At, 1, 1); PG8_STAGE(PG8_SA(1, 0), a3, voffA);
            PG8_BAR; PG8_WAIT_L(0); PG8_MMA(1, 0, At, B0); PG8_BAR; PG8_SCHED;
            PG8_STAGE(PG8_SB(1, 1), b3 + hstep, voffB);
            PG8_WAIT_V(6); PG8_BAR; PG8_MMA(1, 1, At, B1); PG8_BAR;
            }
        }
        if constexpr (ALIGN_EPI) { if (wr == 0) PG8_BAR; }
        if constexpr (!Epi::AFTER_DRAIN) { E(acc, cur, wr, wc, fr, fq); S.done(cur); }
        if (!has_next) break;
#pragma unroll
        for (int a = 0; a < 2; ++a)
#pragma unroll
            for (int b = 0; b < 2; ++b)
#pragma unroll
                for (int m = 0; m < 4; ++m)
#pragma unroll
                    for (int n = 0; n < 2; ++n) acc[a][b][m][n] = (f32x4){0.f, 0.f, 0.f, 0.f};
        cur = nxt; cA = nA; cB = nB; ++ui;
        if constexpr (ALIGN_EPI) { if (wr == 1) PG8_BAR; }
    }
    PG8_WAIT_V(0);
    if constexpr (!ALIGN_EPI) { if (wr == 0) PG8_BAR; }
    PG8_BAR;
    if constexpr (Epi::AFTER_DRAIN) { E.fused(acc, cur, wr, wc, fr, fq, lds, wid, lane); S.done(cur); }
#undef PG8_SA
#undef PG8_SB
#undef PG8_STAGE
#undef PG8_LDA
#undef PG8_LDB
#undef PG8_MMA
#undef PG8_WAIT_V
#undef PG8_WAIT_L
#undef PG8_BAR
#undef PG8_SCHED
}
}

constexpr int T_TOK = 32768;
constexpr int SEQ = 4096;
constexpr float LOG2E = 1.4426950408889634f;
constexpr float FOX_QS = 0.125f * 1.4426950408889634f;
constexpr float MLA_QS = 0.10206207261596575f * 1.4426950408889634f;
constexpr float EPS = 1e-6f;

constexpr size_t W_IN = 0, W_GATE = 4063232, W_UQ = 7208960, W_UKV = 7503872, W_OF = 7766016, W_OM = 8290304, W_OS = 8814592,
                 W_OUT = 9338880, W_FGU = 10387456, W_FD = 16154624, W_LAYER = 19038208;

constexpr int SMEM_BYTES = 2 * 74752 + 64 + 16;

struct Params {
    const float* x; const float* c; const int* pos;
    const float* g_mix; const float* w_ada; const float* b_ada; const float* w_in; const float* b_fox_f;
    const float* g_mla_q; const float* w_mla_uq; const float* g_mla_kv; const float* w_mla_ukv;
    const float* w_o_fox; const float* w_o_mla; const float* w_o_sb; const float* w_out;
    const float* g_ffn; const float* w_ffn_gate; const float* w_ffn_up; const float* w_ffn_down; const float* g_final;
    float* out;
    bf16_t* wt; float* mod; float* ropetab; float* logf; float* cum;
    bf16_t* u; bf16_t* qf; bf16_t* kf; bf16_t* vtf; bf16_t* qs; bf16_t* ks; bf16_t* vts;
    bf16_t* ql; bf16_t* kvl; bf16_t* kr; bf16_t* qn; bf16_t* qr; bf16_t* kn; bf16_t* vtm;
    bf16_t* merged; bf16_t* h;
    unsigned* bar; float* kmax;
};
typedef const __attribute__((address_space(4))) Params* KargPtr;
#if defined(__HIP_DEVICE_COMPILE__)
__device__ __forceinline__ KargPtr karg() { KargPtr pp = (KargPtr)__builtin_amdgcn_kernarg_segment_ptr(); asm volatile("" : "+s"(pp)); return pp; }
#else
__device__ __forceinline__ KargPtr karg() { return nullptr; }
#endif

__device__ const float ROPE_INV[16] = {1.0f, 0.5623413324356079f, 0.3162277638912201f, 0.17782793939113617f, 0.10000000149011612f, 0.05623413249850273f,
    0.03162277489900589f, 0.017782794311642647f, 0.009999999776482582f, 0.005623413249850273f, 0.003162277629598975f, 0.0017782794311642647f,
    0.0010000000474974513f, 0.000562341301701963f, 0.0003162277571391314f, 0.00017782794020604342f};

typedef __bf16 bf16x2_t __attribute__((ext_vector_type(2)));
typedef float f32x2_t __attribute__((ext_vector_type(2)));
DI unsigned pack_bf16(float lo, float hi) { const f32x2_t v = {lo, hi}; const bf16x2_t b = __builtin_convertvector(v, bf16x2_t); return __builtin_bit_cast(unsigned, b); }
DI bf16_t f2bf(float x) { return (bf16_t)(pack_bf16(x, 0.f) & 0xffffu); }
DI int vhalf() { return __builtin_amdgcn_readfirstlane((int)(threadIdx.x >> 8)); }
DI int tidx() { int t = threadIdx.x & 255; asm volatile("" : "+v"(t)); return t; }
DI int bidx() { int t = __builtin_amdgcn_readfirstlane((int)(blockIdx.x * 2 + (threadIdx.x >> 8))); asm volatile("" : "+s"(t)); return t; }
DI int gdim() { int t = gridDim.x * 2; asm volatile("" : "+s"(t)); return t; }
constexpr int VSMEM = 74752;
constexpr int FLAGS_OFF = 2 * VSMEM;
DI float fexp2(float x) { return __builtin_amdgcn_exp2f(x); }
DI float flog2(float x) { return __builtin_amdgcn_logf(x); }
DI float frcp(float x) { return __builtin_amdgcn_rcpf(x); }
DI float sigmoidf_(float x) { return frcp(1.0f + fexp2(-x * LOG2E)); }

DI bool next_tile(int it, int MT, int NT, int& mt, int& nt) {
    const int perx = gdim() >> 3, xcd = bidx() & 7, slot = bidx() >> 3;
    const long L = ((long)it * 8 + xcd) * perx + slot;
    if (L >= (long)MT * NT) return false;
    const int gsz = 8 * NT; const int grp = (int)(L / gsz), wi = (int)(L % gsz);
    mt = grp * 8 + (wi & 7); nt = wi >> 3; return true;
}

template <int BK>
DI void gemm_mainloop(const bf16_t* A, int lda, const bf16_t* B, int ldb, int K, f32x16 (&acc)[2][2], unsigned char* smem) {
    constexpr int CPR = BK / 8;
    constexpr int RPP = 256 / CPR;
    constexpr int NJ = 128 / RPP;
    constexpr int ROWB = BK * 2 + 16;
    constexpr int OPB = 128 * ROWB;
    constexpr int STB = 2 * OPB;
    constexpr int PASSB = RPP * ROWB;
    const int tid = tidx(), lane = tid & 63, w = tid >> 6, wm = w >> 1, wn = w & 1, r = lane & 31, hh = lane >> 5;
    const int lrow = tid / CPR, lcol = (tid % CPR) * 8;
    const bf16_t* ap = A + (size_t)lrow * lda + lcol;
    const bf16_t* bp = B + (size_t)lrow * ldb + lcol;
    const size_t astep = (size_t)RPP * lda, bstep = (size_t)RPP * ldb;
    const int st_off = lrow * ROWB + (tid % CPR) * 16;
    u32x4 ra0, ra1, ra2, ra3, rb0, rb1, rb2, rb3;
    ra0 = *(const u32x4*)(ap); rb0 = *(const u32x4*)(bp);
    ra1 = *(const u32x4*)(ap + astep); rb1 = *(const u32x4*)(bp + bstep);
    if constexpr (NJ == 4) { ra2 = *(const u32x4*)(ap + 2 * astep); rb2 = *(const u32x4*)(bp + 2 * bstep); ra3 = *(const u32x4*)(ap + 3 * astep); rb3 = *(const u32x4*)(bp + 3 * bstep); }
    else { ra2 = ra0; ra3 = ra0; rb2 = rb0; rb3 = rb0; }
#define GEMM_STAGE(D_) do { unsigned char* d_ = (D_); \
        *(u32x4*)(d_) = ra0; *(u32x4*)(d_ + OPB) = rb0; *(u32x4*)(d_ + PASSB) = ra1; *(u32x4*)(d_ + OPB + PASSB) = rb1; \
        if constexpr (NJ == 4) { *(u32x4*)(d_ + 2 * PASSB) = ra2; *(u32x4*)(d_ + OPB + 2 * PASSB) = rb2; *(u32x4*)(d_ + 3 * PASSB) = ra3; *(u32x4*)(d_ + OPB + 3 * PASSB) = rb3; } } while (0)
    GEMM_STAGE(smem + st_off);
    __syncthreads();
    const int nk = K / BK;
    const int rdA = (wm * 64 + r) * ROWB + hh * 16;
    const int rdB = OPB + (wn * 64 + r) * ROWB + hh * 16;
#define GEMM_FRAGS(KS_, A0_, A1_, B0_, B1_) do { \
        A0_ = *(const bf16x8*)(sa + (KS_) * 32); A1_ = *(const bf16x8*)(sa + 32 * ROWB + (KS_) * 32); \
        B0_ = *(const bf16x8*)(sb + (KS_) * 32); B1_ = *(const bf16x8*)(sb + 32 * ROWB + (KS_) * 32); } while (0)
#define GEMM_MFMA4(A0_, A1_, B0_, B1_) do { \
        acc[0][0] = MFMA(A0_, B0_, acc[0][0]); acc[0][1] = MFMA(A0_, B1_, acc[0][1]); \
        acc[1][0] = MFMA(A1_, B0_, acc[1][0]); acc[1][1] = MFMA(A1_, B1_, acc[1][1]); } while (0)
#define GEMM_COMPUTE(BUF_) do { \
        const unsigned char* sa = smem + (BUF_) * STB + rdA; \
        const unsigned char* sb = smem + (BUF_) * STB + rdB; \
        bf16x8 fa0, fa1, fb0, fb1, ga0, ga1, gb0, gb1; \
        GEMM_FRAGS(0, fa0, fa1, fb0, fb1); \
        GEMM_FRAGS(1, ga0, ga1, gb0, gb1); \
        __builtin_amdgcn_sched_barrier(0); \
        GEMM_MFMA4(fa0, fa1, fb0, fb1); \
        if constexpr (BK == 64) { \
            __builtin_amdgcn_sched_barrier(0); \
            GEMM_FRAGS(2, fa0, fa1, fb0, fb1); \
            __builtin_amdgcn_sched_barrier(0); \
            GEMM_MFMA4(ga0, ga1, gb0, gb1); \
            __builtin_amdgcn_sched_barrier(0); \
            GEMM_FRAGS(3, ga0, ga1, gb0, gb1); \
            __builtin_amdgcn_sched_barrier(0); \
            GEMM_MFMA4(fa0, fa1, fb0, fb1); \
        } \
        __builtin_amdgcn_sched_barrier(0); \
        GEMM_MFMA4(ga0, ga1, gb0, gb1); \
    } while (0)
    for (int kt = 0; kt < nk - 1; ++kt) {
        const int buf = kt & 1;
        ap += BK; bp += BK;
        GLOAD16(ra0, ap); GLOAD16(rb0, bp); GLOAD16(ra1, ap + astep); GLOAD16(rb1, bp + bstep);
        if constexpr (NJ == 4) { GLOAD16(ra2, ap + 2 * astep); GLOAD16(rb2, bp + 2 * bstep); GLOAD16(ra3, ap + 3 * astep); GLOAD16(rb3, bp + 3 * bstep); }
        __builtin_amdgcn_sched_barrier(0);
        GEMM_COMPUTE(buf);
        __builtin_amdgcn_sched_barrier(0);
        if constexpr (NJ == 4) asm volatile("s_waitcnt vmcnt(0)" : "+v"(ra0), "+v"(rb0), "+v"(ra1), "+v"(rb1), "+v"(ra2), "+v"(rb2), "+v"(ra3), "+v"(rb3));
        else asm volatile("s_waitcnt vmcnt(0)" : "+v"(ra0), "+v"(rb0), "+v"(ra1), "+v"(rb1));
        GEMM_STAGE(smem + (buf ^ 1) * STB + st_off);
        __syncthreads();
    }
    GEMM_COMPUTE((nk - 1) & 1);
    __syncthreads();
#undef GEMM_COMPUTE
#undef GEMM_MFMA4
#undef GEMM_FRAGS
#undef GEMM_STAGE
}


DI void gemm_big(const bf16_t* P, int ldp, const bf16_t* Q, int ldq, int K, f32x16 (&acc)[2][4], unsigned char* smem) {
    constexpr int ROWB = 80, PB = 128 * ROWB, STB = 384 * ROWB, PASSB = 64 * ROWB;
    const int tid = tidx(), lane = tid & 63, w = tid >> 6, wm = w >> 1, wn = w & 1, r = lane & 31, hh = lane >> 5;
    const int lrow = tid >> 2, lcol = (tid & 3) * 8;
    const bf16_t* pp = P + (size_t)lrow * ldp + lcol;
    const bf16_t* qp = Q + (size_t)lrow * ldq + lcol;
    const size_t pstep = (size_t)64 * ldp, qstep = (size_t)64 * ldq;
    const int st_off = lrow * ROWB + (tid & 3) * 16;
    u32x4 rp0, rp1, rq0, rq1, rq2, rq3;
    rp0 = *(const u32x4*)(pp); rp1 = *(const u32x4*)(pp + pstep);
    rq0 = *(const u32x4*)(qp); rq1 = *(const u32x4*)(qp + qstep); rq2 = *(const u32x4*)(qp + 2 * qstep); rq3 = *(const u32x4*)(qp + 3 * qstep);
#define BIG_STAGE(D_) do { unsigned char* d_ = (D_); \
        *(u32x4*)(d_) = rp0; *(u32x4*)(d_ + PASSB) = rp1; \
        *(u32x4*)(d_ + PB) = rq0; *(u32x4*)(d_ + PB + PASSB) = rq1; *(u32x4*)(d_ + PB + 2 * PASSB) = rq2; *(u32x4*)(d_ + PB + 3 * PASSB) = rq3; } while (0)
    BIG_STAGE(smem + st_off);
    __syncthreads();
    const int nk = K >> 5;
    const int rdP = (wm * 64 + r) * ROWB + hh * 16;
    const int rdQ = PB + (wn * 128 + r) * ROWB + hh * 16;
#define BIG_FRAGS(KS_, A0_, A1_, B0_, B1_, B2_, B3_) do { \
        A0_ = *(const bf16x8*)(sp + (KS_) * 32); A1_ = *(const bf16x8*)(sp + 32 * ROWB + (KS_) * 32); \
        B0_ = *(const bf16x8*)(sq + (KS_) * 32); B1_ = *(const bf16x8*)(sq + 32 * ROWB + (KS_) * 32); \
        B2_ = *(const bf16x8*)(sq + 64 * ROWB + (KS_) * 32); B3_ = *(const bf16x8*)(sq + 96 * ROWB + (KS_) * 32); } while (0)
#define BIG_MFMA8(A0_, A1_, B0_, B1_, B2_, B3_) do { \
        acc[0][0] = MFMA(A0_, B0_, acc[0][0]); acc[0][1] = MFMA(A0_, B1_, acc[0][1]); acc[0][2] = MFMA(A0_, B2_, acc[0][2]); acc[0][3] = MFMA(A0_, B3_, acc[0][3]); \
        acc[1][0] = MFMA(A1_, B0_, acc[1][0]); acc[1][1] = MFMA(A1_, B1_, acc[1][1]); acc[1][2] = MFMA(A1_, B2_, acc[1][2]); acc[1][3] = MFMA(A1_, B3_, acc[1][3]); } while (0)
#define BIG_COMPUTE(BUF_) do { \
        const unsigned char* sp = smem + (BUF_) * STB + rdP; \
        const unsigned char* sq = smem + (BUF_) * STB + rdQ; \
        bf16x8 fa0, fa1, fb0, fb1, fb2, fb3, ga0, ga1, gb0, gb1, gb2, gb3; \
        BIG_FRAGS(0, fa0, fa1, fb0, fb1, fb2, fb3); \
        BIG_FRAGS(1, ga0, ga1, gb0, gb1, gb2, gb3); \
        __builtin_amdgcn_sched_barrier(0); \
        BIG_MFMA8(fa0, fa1, fb0, fb1, fb2, fb3); \
        __builtin_amdgcn_sched_barrier(0); \
        BIG_MFMA8(ga0, ga1, gb0, gb1, gb2, gb3); \
    } while (0)
    for (int kt = 0; kt < nk - 1; ++kt) {
        const int buf = kt & 1;
        pp += 32; qp += 32;
        GLOAD16(rp0, pp); GLOAD16(rq0, qp); GLOAD16(rp1, pp + pstep); GLOAD16(rq1, qp + qstep); GLOAD16(rq2, qp + 2 * qstep); GLOAD16(rq3, qp + 3 * qstep);
        __builtin_amdgcn_sched_barrier(0);
        BIG_COMPUTE(buf);
        __builtin_amdgcn_sched_barrier(0);
        asm volatile("s_waitcnt vmcnt(0)" : "+v"(rp0), "+v"(rp1), "+v"(rq0), "+v"(rq1), "+v"(rq2), "+v"(rq3));
        BIG_STAGE(smem + (buf ^ 1) * STB + st_off);
        __syncthreads();
    }
    BIG_COMPUTE((nk - 1) & 1);
    __syncthreads();
#undef BIG_COMPUTE
#undef BIG_MFMA8
#undef BIG_FRAGS
#undef BIG_STAGE
}
DI void zero_big(f32x16 (&acc)[2][4]) {
#pragma unroll
    for (int a = 0; a < 2; ++a)
#pragma unroll
        for (int b = 0; b < 4; ++b)
#pragma unroll
            for (int i = 0; i < 16; ++i) acc[a][b][i] = 0.f;
}
DI void stage_store_big(const f32x16 (&acc)[2][4], bf16_t* dst, int ld, unsigned char* smem) {
    const int tid = tidx(), lane = tid & 63, w = tid >> 6, wm = w >> 1, wn = w & 1, r = lane & 31, hh = lane >> 5;
#pragma unroll
    for (int qi = 0; qi < 4; ++qi) {
        unsigned char* trow = smem + (wn * 128 + qi * 32 + r) * 272 + (wm * 64 + 4 * hh) * 2;
#pragma unroll
        for (int pi = 0; pi < 2; ++pi)
#pragma unroll
            for (int g = 0; g < 4; ++g) {
                u32x2 pk; pk.x = pack_bf16(acc[pi][qi][4 * g], acc[pi][qi][4 * g + 1]); pk.y = pack_bf16(acc[pi][qi][4 * g + 2], acc[pi][qi][4 * g + 3]);
                *(u32x2*)(trow + (pi * 32 + 8 * g) * 2) = pk;
            }
    }
    __syncthreads();
    const int q0 = tid >> 4, x = tid & 15;
#pragma unroll
    for (int j = 0; j < 16; ++j) {
        const uint4 v = *(const uint4*)(smem + (q0 + 16 * j) * 272 + x * 16);
        *(uint4*)(dst + (size_t)(q0 + 16 * j) * ld + x * 8) = v;
    }
    __syncthreads();
}
DI void scale_big(f32x16 (&acc)[2][4], float sc) {
#pragma unroll
    for (int a = 0; a < 2; ++a)
#pragma unroll
        for (int b = 0; b < 4; ++b)
#pragma unroll
            for (int i = 0; i < 16; ++i) acc[a][b][i] *= sc;
}
DI void scale_big_q(f32x16 (&acc)[2][4], const float* rs, float sc) {
    const int lane = tidx() & 63, wn = (tidx() >> 6) & 1, r = lane & 31;
#pragma unroll
    for (int qi = 0; qi < 4; ++qi) { const float f = rs[wn * 128 + qi * 32 + r] * sc;
#pragma unroll
        for (int pi = 0; pi < 2; ++pi)
#pragma unroll
            for (int i = 0; i < 16; ++i) acc[pi][qi][i] *= f; }
}
DI void scale_big_p(f32x16 (&acc)[2][4], const float* rs) {
    const int lane = tidx() & 63, wm = tidx() >> 7, hh = lane >> 5;
#pragma unroll
    for (int pi = 0; pi < 2; ++pi)
#pragma unroll
        for (int g = 0; g < 4; ++g) { const f32x4 f = *(const f32x4*)(rs + wm * 64 + pi * 32 + 8 * g + 4 * hh);
#pragma unroll
            for (int qi = 0; qi < 4; ++qi)
#pragma unroll
                for (int e = 0; e < 4; ++e) acc[pi][qi][4 * g + e] *= f[e]; }
}
DI long tile_linear(int it, long total) {
    const int perx = gdim() >> 3, xcd = bidx() & 7, slot = bidx() >> 3;
    const long L = ((long)it * 8 + xcd) * perx + slot;
    return L < total ? L : -1;
}
DI void tile_decode(int L, int NT, int& mt, int& nt) { const int gsz = 8 * NT; const int grp = L / gsz, wi = L % gsz; mt = grp * 8 + (wi & 7); nt = wi >> 3; }

DI void zero_acc(f32x16 (&acc)[2][2]) {
#pragma unroll
    for (int a = 0; a < 2; ++a)
#pragma unroll
        for (int b = 0; b < 2; ++b)
#pragma unroll
            for (int i = 0; i < 16; ++i) acc[a][b][i] = 0.f;
}

DI void stage_store_128(const f32x16 (&acc)[2][2], bf16_t* dst, int ld, unsigned char* smem) {
    const int tid = tidx(), lane = tid & 63, w = tid >> 6, wm = w >> 1, wn = w & 1, r = lane & 31, hh = lane >> 5;
#pragma unroll
    for (int qi = 0; qi < 2; ++qi) {
        unsigned char* trow = smem + (wn * 64 + qi * 32 + r) * 272 + (wm * 64 + 4 * hh) * 2;
#pragma unroll
        for (int pi = 0; pi < 2; ++pi)
#pragma unroll
            for (int g = 0; g < 4; ++g) {
                u32x2 pk; pk.x = pack_bf16(acc[pi][qi][4 * g], acc[pi][qi][4 * g + 1]); pk.y = pack_bf16(acc[pi][qi][4 * g + 2], acc[pi][qi][4 * g + 3]);
                *(u32x2*)(trow + (pi * 32 + 8 * g) * 2) = pk;
            }
    }
    __syncthreads();
    const int q0 = tid >> 4, x = tid & 15;
#pragma unroll
    for (int j = 0; j < 8; ++j) {
        const uint4 v = *(const uint4*)(smem + (q0 + 16 * j) * 272 + x * 16);
        *(uint4*)(dst + (size_t)(q0 + 16 * j) * ld + x * 8) = v;
    }
    __syncthreads();
}
DI void stage_store_vt(const f32x16 (&acc)[2][2], bf16_t* vt, int b, int cv0, int s0, unsigned char* smem) {
    const int tid = tidx(), lane = tid & 63, w = tid >> 6, wm = w >> 1, wn = w & 1, r = lane & 31, hh = lane >> 5;
#pragma unroll
    for (int qi = 0; qi < 2; ++qi) {
        unsigned char* trow = smem + (wn * 64 + qi * 32 + r) * 272 + (wm * 64 + 4 * hh) * 2;
#pragma unroll
        for (int pi = 0; pi < 2; ++pi)
#pragma unroll
            for (int g = 0; g < 4; ++g) {
                u32x2 pk; pk.x = pack_bf16(acc[pi][qi][4 * g], acc[pi][qi][4 * g + 1]); pk.y = pack_bf16(acc[pi][qi][4 * g + 2], acc[pi][qi][4 * g + 3]);
                *(u32x2*)(trow + (pi * 32 + 8 * g) * 2) = pk;
            }
    }
    __syncthreads();
    const int q0 = tid >> 4, x = tid & 15;
#pragma unroll
    for (int j = 0; j < 8; ++j) {
        const int cv = cv0 + q0 + 16 * j, sq = s0 + 8 * x;
        const uint4 v = *(const uint4*)(smem + (q0 + 16 * j) * 272 + x * 16);
        *(uint4*)(vt + (size_t)(b * 8 + (cv >> 6)) * SEQ * 64 + (size_t)(sq >> 6) * 4096 + (cv & 63) * 64 + (sq & 63)) = v;
    }
    __syncthreads();
}
DI void scale_acc(f32x16 (&acc)[2][2], float sc) {
#pragma unroll
    for (int a = 0; a < 2; ++a)
#pragma unroll
        for (int b = 0; b < 2; ++b)
#pragma unroll
            for (int i = 0; i < 16; ++i) acc[a][b][i] *= sc;
}
DI void scale_acc_q(f32x16 (&acc)[2][2], const float* rs, float sc) {
    const int lane = tidx() & 63, wn = (tidx() >> 6) & 1, r = lane & 31;
#pragma unroll
    for (int qi = 0; qi < 2; ++qi) { const float f = rs[wn * 64 + qi * 32 + r] * sc;
#pragma unroll
        for (int pi = 0; pi < 2; ++pi)
#pragma unroll
            for (int i = 0; i < 16; ++i) acc[pi][qi][i] *= f; }
}
DI void scale_acc_p(f32x16 (&acc)[2][2], const float* rs) {
    const int lane = tidx() & 63, wm = tidx() >> 7, hh = lane >> 5;
#pragma unroll
    for (int pi = 0; pi < 2; ++pi)
#pragma unroll
        for (int g = 0; g < 4; ++g) { const f32x4 f = *(const f32x4*)(rs + wm * 64 + pi * 32 + 8 * g + 4 * hh);
#pragma unroll
            for (int qi = 0; qi < 2; ++qi)
#pragma unroll
                for (int e = 0; e < 4; ++e) acc[pi][qi][4 * g + e] *= f[e]; }
}

DI int map_col(int map, int n) {
    switch (map) {
    case 1:
        if (n < 1024) return n;
        if (n < 2048) return 2216 + (n - 1024);
        if (n < 2432) return 1544 + (n - 2048);
        if (n < 2688) return 1928 + (n - 2432);
        if (n < 2816) { const int c = n - 2688; if (c < 16) return 2184 + c; if (c < 32) return 2200 + (c - 16); if (c < 40) return 1536 + (c - 32); return -1; }
        if (n < 3328) return 1024 + (n - 2816);
        if (n < 3840) return 3240 + (n - 3328);
        return -1;
    case 2: return 3752 + n;
    case 3:
        if (n < 512) return (n >> 6) * 96 + (n & 63);
        { const int cc = n - 512, tt = cc >> 7, c7 = cc & 127, wn = c7 >> 6, ni = (c7 >> 5) & 1, c = c7 & 31; const int head = tt * 4 + wn * 2 + (c >> 4); return head * 96 + 64 + ni * 16 + (c & 15); }
    case 4:
        if (n < 512) return (n >> 6) * 128 + (n & 63);
        { const int n2 = n - 512; return (n2 >> 6) * 128 + 64 + (n2 & 63); }
    case 5: return (n >> 5) * 16 + (n & 15);
    default: return n;
    }
}

DI void transpose_tile(const float* __restrict__ src, const float* __restrict__ src2, int ld, int K, bf16_t* __restrict__ dst, int map, const float* __restrict__ kscale, int n0, int k0, float* tile) {
    const int tid = tidx(), tx = tid & 63, ty = tid >> 6;
    const int sc = map_col(map, n0 + tx);
    if (map == 5 && (((n0 + tx) >> 4) & 1)) src = src2;
    const int scc = sc < 0 ? 0 : sc;
    const float* sp = src + (size_t)(k0 + ty) * ld + scc;
    float vals[16];
#pragma unroll
    for (int j = 0; j < 16; ++j) vals[j] = sp[(size_t)(4 * j) * ld];
    if (kscale) {
#pragma unroll
        for (int j = 0; j < 16; ++j) vals[j] *= kscale[k0 + ty + 4 * j];
    }
#pragma unroll
    for (int j = 0; j < 16; ++j) tile[(ty + 4 * j) * 65 + tx] = sc < 0 ? 0.f : vals[j];
    __syncthreads();
    const int n = tid >> 2, kq = (tid & 3) * 16;
    unsigned wv[8];
#pragma unroll
    for (int j = 0; j < 8; ++j) wv[j] = pack_bf16(tile[(kq + 2 * j) * 65 + n], tile[(kq + 2 * j + 1) * 65 + n]);
    uint4* d = (uint4*)(dst + (size_t)(n0 + n) * K + k0 + kq);
    d[0] = make_uint4(wv[0], wv[1], wv[2], wv[3]);
    d[1] = make_uint4(wv[4], wv[5], wv[6], wv[7]);
    __syncthreads();
}

DI void phase_prep(KargPtr p, unsigned char* smem) {
    const int tid = tidx();
    float* fs = (float*)smem;
    constexpr int NW = 9296, NMOD = 192, NROPE = 2048;
    for (int item = bidx(); item < NW + NMOD + NROPE; item += gdim()) {
        if (item < NW) {
            const int l = item / 4648; int ti = item % 4648;
            const float* src; const float* src2 = nullptr; int ld, K, Nd, map; size_t doff; const float* ksc = nullptr;
            if (ti < 992)       { src = p->w_in + (size_t)l * 1024 * 6824; ld = 6824; K = 1024; Nd = 3968; doff = W_IN; map = 1; }
            else if (ti < 1760) { ti -= 992;  src = p->w_in + (size_t)l * 1024 * 6824; ld = 6824; K = 1024; Nd = 3072; doff = W_GATE; map = 2; }
            else if (ti < 1832) { ti -= 1760; src = p->w_mla_uq + (size_t)l * 384 * 768; ld = 768; K = 384; Nd = 768; doff = W_UQ; map = 3; ksc = p->g_mla_q + l * 384; }
            else if (ti < 1896) { ti -= 1832; src = p->w_mla_ukv + (size_t)l * 256 * 1024; ld = 1024; K = 256; Nd = 1024; doff = W_UKV; map = 4; ksc = p->g_mla_kv + l * 256; }
            else if (ti < 2024) { ti -= 1896; src = p->w_o_fox + (size_t)l * 512 * 1024; ld = 1024; K = 512; Nd = 1024; doff = W_OF; map = 0; }
            else if (ti < 2152) { ti -= 2024; src = p->w_o_mla + (size_t)l * 512 * 1024; ld = 1024; K = 512; Nd = 1024; doff = W_OM; map = 0; }
            else if (ti < 2280) { ti -= 2152; src = p->w_o_sb + (size_t)l * 512 * 1024; ld = 1024; K = 512; Nd = 1024; doff = W_OS; map = 0; }
            else if (ti < 2536) { ti -= 2280; src = p->w_out + (size_t)l * 1024 * 1024; ld = 1024; K = 1024; Nd = 1024; doff = W_OUT; map = 0; }
            else if (ti < 3944) { ti -= 2536; src = p->w_ffn_gate + (size_t)l * 1024 * 2816; src2 = p->w_ffn_up + (size_t)l * 1024 * 2816; ld = 2816; K = 1024; Nd = 5632; doff = W_FGU; map = 5; }
            else                { ti -= 3944; src = p->w_ffn_down + (size_t)l * 2816 * 1024; ld = 1024; K = 2816; Nd = 1024; doff = W_FD; map = 0; }
            (void)Nd;
            const int kts = K >> 6; const int ntile = ti / kts, ktile = ti % kts;
            transpose_tile(src, src2, ld, K, p->wt + (size_t)l * W_LAYER + doff, map, ksc, ntile * 64, ktile * 64, fs);
        } else if (item < NW + NMOD) {
            const int mi = item - NW; const int l = mi / 96, c0 = (mi % 96) * 64;
            float* cond = fs;
            float* red = fs + 8192;
            for (int e = tid; e < 8192; e += 256) { const float cv = p->c[e]; cond[e] = cv * sigmoidf_(cv); }
            __syncthreads();
            const int tx = tid & 63, ty = tid >> 6;
            float a0 = 0, a1 = 0, a2 = 0, a3 = 0, a4 = 0, a5 = 0, a6 = 0, a7 = 0;
            const float* wsrc = p->w_ada + (size_t)l * 1024 * 6144 + c0 + tx;
#pragma unroll 8
            for (int k = ty * 256; k < ty * 256 + 256; ++k) {
                const float wv = wsrc[(size_t)k * 6144];
                a0 += cond[k] * wv; a1 += cond[1024 + k] * wv; a2 += cond[2048 + k] * wv; a3 += cond[3072 + k] * wv;
                a4 += cond[4096 + k] * wv; a5 += cond[5120 + k] * wv; a6 += cond[6144 + k] * wv; a7 += cond[7168 + k] * wv;
            }
            float* rr = red + ty * 512 + tx;
            rr[0] = a0; rr[64] = a1; rr[128] = a2; rr[192] = a3; rr[256] = a4; rr[320] = a5; rr[384] = a6; rr[448] = a7;
            __syncthreads();
            for (int o = tid; o < 512; o += 256) {
                const int b = o >> 6, xx = o & 63;
                const float s = red[o] + red[512 + o] + red[1024 + o] + red[1536 + o] + p->b_ada[l * 6144 + c0 + xx];
                p->mod[(size_t)(l * 8 + b) * 6144 + c0 + xx] = s;
            }
            __syncthreads();
        } else {
            const int e = (item - NW - NMOD) * 256 + tid;
            const int i = e & 15, tok = e >> 4;
            const float ang = (float)p->pos[tok] * ROPE_INV[i];
            const double a = (double)ang;
            const double kq = rint(a * 0.63661977236758134308);
            const double rr = fma(-kq, 1.57079632679489661923, a);
            const double r2 = rr * rr;
            const double sn = rr * (1.0 + r2 * (-1.0 / 6 + r2 * (1.0 / 120 + r2 * (-1.0 / 5040 + r2 * (1.0 / 362880 + r2 * (-1.0 / 39916800))))));
            const double cs = 1.0 + r2 * (-0.5 + r2 * (1.0 / 24 + r2 * (-1.0 / 720 + r2 * (1.0 / 40320 + r2 * (-1.0 / 3628800 + r2 * (1.0 / 479001600))))));
            const int q = ((int)(long long)kq) & 3;
            const double co = (q == 0) ? cs : (q == 1) ? -sn : (q == 2) ? -cs : sn;
            const double si = (q == 0) ? sn : (q == 1) ? cs : (q == 2) ? -sn : -cs;
            p->ropetab[2 * (size_t)e] = (float)co; p->ropetab[2 * (size_t)e + 1] = (float)si;
        }
    }
}

DI float wave_sum(float v) {
#pragma unroll
    for (int o = 32; o >= 1; o >>= 1) v += __shfl_xor(v, o);
    return v;
}
DI void phase_norm(const float* __restrict__ xin, const float* __restrict__ g, const float* __restrict__ modl, int sh_idx, int sc_idx, bf16_t* __restrict__ uout) {
    const int lane = tidx() & 63, w = tidx() >> 6;
    for (int row = bidx() * 4 + w; row < T_TOK; row += gdim() * 4) {
        const int b = row >> 12;
        const f32x4* xr = (const f32x4*)(xin + (size_t)row * 1024);
        f32x4 v[4]; float ss = 0.f;
#pragma unroll
        for (int j = 0; j < 4; ++j) { v[j] = xr[lane + 64 * j]; ss += v[j][0] * v[j][0] + v[j][1] * v[j][1] + v[j][2] * v[j][2] + v[j][3] * v[j][3]; }
        ss = wave_sum(ss);
        const float rstd = rsqrtf(ss * (1.0f / 1024.0f) + EPS);
        const float* mb = modl + (size_t)b * 6144;
#pragma unroll
        for (int j = 0; j < 4; ++j) {
            const int col = 4 * (lane + 64 * j);
            const f32x4 g4 = *(const f32x4*)(g + col), sc4 = *(const f32x4*)(mb + sc_idx * 1024 + col), sh4 = *(const f32x4*)(mb + sh_idx * 1024 + col);
            float y[4];
#pragma unroll
            for (int e = 0; e < 4; ++e) y[e] = (v[j][e] * rstd) * g4[e] * (1.0f + sc4[e]) + sh4[e];
            u32x2 pk; pk.x = pack_bf16(y[0], y[1]); pk.y = pack_bf16(y[2], y[3]);
            *(u32x2*)(uout + (size_t)row * 1024 + col) = pk;
        }
    }
}
DI void phase_final(KargPtr p) {
    const int lane = tidx() & 63, w = tidx() >> 6;
    for (int row = bidx() * 4 + w; row < T_TOK; row += gdim() * 4) {
        f32x4* xr = (f32x4*)(p->out + (size_t)row * 1024);
        f32x4 v[4]; float ss = 0.f;
#pragma unroll
        for (int j = 0; j < 4; ++j) { v[j] = xr[lane + 64 * j]; ss += v[j][0] * v[j][0] + v[j][1] * v[j][1] + v[j][2] * v[j][2] + v[j][3] * v[j][3]; }
        ss = wave_sum(ss);
        const float rstd = rsqrtf(ss * (1.0f / 1024.0f) + EPS);
#pragma unroll
        for (int j = 0; j < 4; ++j) {
            const f32x4 g4 = *(const f32x4*)(p->g_final + 4 * (lane + 64 * j));
            f32x4 o;
#pragma unroll
            for (int e = 0; e < 4; ++e) o[e] = (v[j][e] * rstd) * g4[e];
            xr[lane + 64 * j] = o;
        }
    }
}

struct EpiInprojA {
    static constexpr bool PERM = false, AFTER_DRAIN = false;
    bf16_t* qf; bf16_t* kf; bf16_t* qs; bf16_t* ks; bf16_t* ql; bf16_t* kvl; bf16_t* kr; float* logf; const float* ropetab; const float* bfox;
    __device__ __forceinline__ void operator()(const pg8::f32x4 (&acc)[2][2][4][2], const pg8::Unit& u, int wr, int wc, int fr, int fq) const {
        const int row0 = u.pm * 256 + wr * 64 + fr;
        const int cw = wc * 32 + fq * 4;
#pragma unroll
        for (int bj = 0; bj < 2; ++bj) {
            bf16_t* dst; int ld; float sc = 1.0f; bool special = false;
            if (u.pn < 8) { const int region = u.pn >> 1; dst = (region == 0 ? qf : region == 1 ? kf : region == 2 ? qs : ks) + (u.pn & 1) * 256 + bj * 128; ld = 512; if (region == 0 || region == 2) sc = FOX_QS; }
            else if (u.pn == 8) { dst = ql + bj * 128; ld = 384; }
            else if (u.pn == 9) { if (bj == 0) { dst = ql + 256; ld = 384; } else { dst = kvl; ld = 256; } }
            else { dst = kvl + 128; ld = 256; special = (bj == 1); }
            if (!special) {
#pragma unroll
                for (int ai = 0; ai < 2; ++ai)
#pragma unroll
                    for (int m = 0; m < 4; ++m) {
                        bf16_t* rowp = dst + (size_t)(row0 + ai * 128 + m * 16) * ld + cw;
#pragma unroll
                        for (int n = 0; n < 2; ++n) { const pg8::f32x4 v = acc[ai][bj][m][n] * sc; u32x2 pk; pk.x = pack_bf16(v[0], v[1]); pk.y = pack_bf16(v[2], v[3]); *(u32x2*)(rowp + n * 16) = pk; }
                    }
            } else if (wc == 0) {
#pragma unroll
                for (int ai = 0; ai < 2; ++ai)
#pragma unroll
                    for (int m = 0; m < 4; ++m) {
                        const int t = row0 + ai * 128 + m * 16;
                        const pg8::f32x4 x1 = acc[ai][1][m][0], x2 = acc[ai][1][m][1];
                        const pg8::f32x4 ca = *(const pg8::f32x4*)(ropetab + 2 * (t * 16 + fq * 4)), cb = *(const pg8::f32x4*)(ropetab + 2 * (t * 16 + fq * 4) + 4);
                        const float co[4] = {ca[0], ca[2], cb[0], cb[2]}, si[4] = {ca[1], ca[3], cb[1], cb[3]};
                        float o1[4], o2[4];
#pragma unroll
                        for (int j = 0; j < 4; ++j) { o1[j] = x1[j] * co[j] - x2[j] * si[j]; o2[j] = x1[j] * si[j] + x2[j] * co[j]; }
                        u32x2 p1, p2; p1.x = pack_bf16(o1[0], o1[1]); p1.y = pack_bf16(o1[2], o1[3]); p2.x = pack_bf16(o2[0], o2[1]); p2.y = pack_bf16(o2[2], o2[3]);
                        *(u32x2*)(kr + (size_t)t * 32 + fq * 4) = p1;
                        *(u32x2*)(kr + (size_t)t * 32 + 16 + fq * 4) = p2;
                    }
            } else if (wc == 1 && fq < 2) {
#pragma unroll
                for (int ai = 0; ai < 2; ++ai)
#pragma unroll
                    for (int m = 0; m < 4; ++m) {
                        const int t = row0 + ai * 128 + m * 16, b = t >> 12, sq = t & 4095;
#pragma unroll
                        for (int j = 0; j < 4; ++j) {
                            const int head = fq * 4 + j;
                            const float f = acc[ai][1][m][0][j] + bfox[head];
                            logf[(size_t)(b * 8 + head) * SEQ + sq] = fminf(f, 0.f) - log1pf(expf(-fabsf(f)));
                        }
                    }
            }
        }
    }
};
struct EpiInprojV {
    static constexpr bool PERM = false, AFTER_DRAIN = false;
    bf16_t* vtf; bf16_t* vts;
    __device__ __forceinline__ void operator()(const pg8::f32x4 (&acc)[2][2][4][2], const pg8::Unit& u, int wr, int wc, int fr, int fq) const {
        bf16_t* vt = u.pn < 2 ? vtf : vts;
        const int row0 = u.pm * 256 + wr * 64 + fq * 4, b = row0 >> 12, s0 = row0 & 4095;
        const int cv0 = (u.pn & 1) * 256 + wc * 32 + fr;
#pragma unroll
        for (int bj = 0; bj < 2; ++bj)
#pragma unroll
            for (int n = 0; n < 2; ++n) {
                const int cv = cv0 + bj * 128 + n * 16;
                bf16_t* vp = vt + (size_t)(b * 8 + (cv >> 6)) * SEQ * 64 + (cv & 63) * 64;
#pragma unroll
                for (int ai = 0; ai < 2; ++ai)
#pragma unroll
                    for (int m = 0; m < 4; ++m) { const int sq = s0 + ai * 128 + m * 16; const pg8::f32x4 v = acc[ai][bj][m][n]; u32x2 pk; pk.x = pack_bf16(v[0], v[1]); pk.y = pack_bf16(v[2], v[3]);
                        *(u32x2*)(vp + (size_t)(sq >> 6) * 4096 + (sq & 63)) = pk; }
            }
    }
};
struct EpiFfnUp {
    static constexpr bool PERM = false, AFTER_DRAIN = false;
    bf16_t* h;
    __device__ __forceinline__ void operator()(const pg8::f32x4 (&acc)[2][2][4][2], const pg8::Unit& u, int wr, int wc, int fr, int fq) const {
        const int row0 = u.pm * 256 + wr * 64 + fr;
#pragma unroll
        for (int ai = 0; ai < 2; ++ai)
#pragma unroll
            for (int m = 0; m < 4; ++m) {
                bf16_t* rowp = h + (size_t)(row0 + ai * 128 + m * 16) * 2816 + u.pn * 128 + wc * 16 + fq * 4;
#pragma unroll
                for (int bj = 0; bj < 2; ++bj) {
                    const pg8::f32x4 g = acc[ai][bj][m][0], up = acc[ai][bj][m][1];
                    float hv[4];
#pragma unroll
                    for (int j = 0; j < 4; ++j) hv[j] = g[j] * sigmoidf_(g[j]) * up[j];
                    u32x2 pk; pk.x = pack_bf16(hv[0], hv[1]); pk.y = pack_bf16(hv[2], hv[3]);
                    *(u32x2*)(rowp + bj * 64) = pk;
                }
            }
    }
};
struct EpiResidual {
    static constexpr bool PERM = false, AFTER_DRAIN = false;
    const float* xin; float* xout; const float* modl; int gidx;
    __device__ __forceinline__ void operator()(const pg8::f32x4 (&acc)[2][2][4][2], const pg8::Unit& u, int wr, int wc, int fr, int fq) const {
        const int row0 = u.pm * 256 + wr * 64 + fr, b = row0 >> 12;
        const float* gt = modl + (size_t)b * 6144 + gidx * 1024;
#pragma unroll
        for (int bj = 0; bj < 2; ++bj)
#pragma unroll
            for (int n = 0; n < 2; ++n) {
                const int col = u.pn * 256 + bj * 128 + wc * 32 + n * 16 + fq * 4;
                const pg8::f32x4 g4 = *(const pg8::f32x4*)(gt + col);
                pg8::f32x4 xv[2][4];
#pragma unroll
                for (int ai = 0; ai < 2; ++ai)
#pragma unroll
                    for (int m = 0; m < 4; ++m) xv[ai][m] = *(const pg8::f32x4*)(xin + (size_t)(row0 + ai * 128 + m * 16) * 1024 + col);
#pragma unroll
                for (int ai = 0; ai < 2; ++ai)
#pragma unroll
                    for (int m = 0; m < 4; ++m) *(pg8::f32x4*)(xout + (size_t)(row0 + ai * 128 + m * 16) * 1024 + col) = xv[ai][m] + g4 * acc[ai][bj][m][n];
            }
    }
};
template <class Epi, bool NAT = false>
DI void big_gemm(const bf16_t* A, const bf16_t* Bt, int N, int K, const Epi& E, unsigned char* smem) {
    __syncthreads();
    pg8::StaticOrder S; S.init(T_TOK, N, (int)gridDim.x, (int)blockIdx.x);
    pg8::Gemm g; g.A = A; g.Bt = Bt; g.M = T_TOK; g.N = N; g.K = K;
    pg8::gemm_phase<Epi, pg8::StaticOrder, true, true, NAT>((PG8_LAS unsigned char*)smem, g, S, E);
    __syncthreads();
}

DI void phase_inproj(KargPtr p, int l, unsigned char* smem_phys) {
    const bf16_t* W = p->wt + (size_t)l * W_LAYER + W_IN;
    { EpiInprojA E; E.qf = p->qf; E.kf = p->kf; E.qs = p->qs; E.ks = p->ks; E.ql = p->ql; E.kvl = p->kvl; E.kr = p->kr; E.logf = p->logf; E.ropetab = p->ropetab; E.bfox = p->b_fox_f + l * 8;
      big_gemm<EpiInprojA, false>(p->u, W, 2816, 1024, E, smem_phys); }
    { EpiInprojV E; E.vtf = p->vtf; E.vts = p->vts;
      big_gemm<EpiInprojV, true>(p->u, W + (size_t)2816 * 1024, 1024, 1024, E, smem_phys); }
}

DI void phase_mla_up(KargPtr p, int l, unsigned char* smem) {
    const int tid = tidx(), lane = tid & 63, w = tid >> 6, wm = w >> 1, wn = w & 1, r = lane & 31, hh = lane >> 5;
    float* rs = (float*)(smem + 73728);
    const bf16_t* WQ = p->wt + (size_t)l * W_LAYER + W_UQ;
    const bf16_t* WKV = p->wt + (size_t)l * W_LAYER + W_UKV;
    for (int it = 0;; ++it) {
        const int L = it * gdim() + bidx(); if (L >= 3584) break;
        int mt, nt; if (L < 1536) { mt = L / 6; nt = L % 6; } else { mt = (L - 1536) >> 3; nt = 6 + ((L - 1536) & 7); }
        const int m0 = mt * 128, b = m0 >> 12, s0 = m0 & 4095;
        const bool isq = nt < 6;
        const int K = isq ? 384 : 256;
        const bf16_t* A = (isq ? p->ql : p->kvl) + (size_t)m0 * K;
        __syncthreads();
        {
            const int row = tid >> 1, half = tid & 1; const int hk = K >> 1;
            const uint4* ar = (const uint4*)(A + (size_t)row * K + half * hk);
            float ss = 0.f;
#pragma unroll 8
            for (int j = 0; j < (hk >> 3); ++j) {
                const uint4 v = ar[j];
                const unsigned uu[4] = {v.x, v.y, v.z, v.w};
#pragma unroll
                for (int e = 0; e < 4; ++e) { const float lo = __uint_as_float(uu[e] << 16), hi = __uint_as_float(uu[e] & 0xffff0000u); ss += lo * lo + hi * hi; }
            }
            ss += __shfl_xor(ss, 1);
            if (half == 0) rs[row] = rsqrtf(ss / (float)K + EPS);
        }
        __syncthreads();
        f32x16 acc[2][2]; zero_acc(acc);
        if (isq) {
            const bf16_t* Bw = WQ + (size_t)nt * 128 * 384;
            if (nt < 4) {
                gemm_mainloop<64>(Bw, 384, A, 384, 384, acc, smem);
                scale_acc_q(acc, rs, MLA_QS);
                stage_store_128(acc, p->qn + (size_t)m0 * 512 + nt * 128, 512, smem);
            } else {
                gemm_mainloop<64>(A, 384, Bw, 384, 384, acc, smem);
                const int tt = nt - 4; const int head = tt * 4 + wn * 2 + (r >> 4), ii = r & 15;
                const float* __restrict__ rt = p->ropetab; bf16_t* __restrict__ qrp = p->qr;
#pragma unroll
                for (int mi = 0; mi < 2; ++mi) {
                    const int rbase = wm * 64 + mi * 32 + 4 * hh;
                    f32x2_t cs[16];
#pragma unroll
                    for (int i = 0; i < 16; ++i) cs[i] = *(const f32x2_t*)(rt + 2 * ((m0 + rbase + 8 * (i >> 2) + (i & 3)) * 16 + ii));
#pragma unroll
                    for (int i = 0; i < 16; ++i) {
                        const int row = rbase + 8 * (i >> 2) + (i & 3);
                        const int t = m0 + row; const float sc = rs[row] * MLA_QS;
                        const float x1 = acc[mi][0][i] * sc, x2 = acc[mi][1][i] * sc;
                        qrp[t * 256 + head * 32 + ii] = f2bf(x1 * cs[i][0] - x2 * cs[i][1]);
                        qrp[t * 256 + head * 32 + 16 + ii] = f2bf(x1 * cs[i][1] + x2 * cs[i][0]);
                    }
                }
                __syncthreads(); __syncthreads();
            }
        } else {
            const int n2 = nt - 6;
            const bf16_t* Bw = WKV + (size_t)n2 * 128 * 256;
            if (n2 < 4) {
                gemm_mainloop<64>(Bw, 256, A, 256, 256, acc, smem);
                scale_acc_q(acc, rs, 1.0f);
                stage_store_128(acc, p->kn + (size_t)m0 * 512 + n2 * 128, 512, smem);
            } else {
                gemm_mainloop<64>(A, 256, Bw, 256, 256, acc, smem);
                scale_acc_p(acc, rs);
                stage_store_vt(acc, p->vtm, b, (n2 - 4) * 128, s0, smem);
            }
        }
    }
    __syncthreads();
    float* fs = (float*)smem;
    for (int bh = bidx(); bh < 64; bh += gdim()) {
        const f32x4* src = (const f32x4*)(p->logf + (size_t)bh * SEQ + tid * 16);
        f32x4 v[4];
        float run = 0.f;
#pragma unroll
        for (int j = 0; j < 4; ++j) { v[j] = src[j];
#pragma unroll
            for (int e = 0; e < 4; ++e) { run += v[j][e]; v[j][e] = run; } }
        float incl = run;
#pragma unroll
        for (int o = 1; o < 64; o <<= 1) { const float tv = __shfl_up(incl, o); if (lane >= o) incl += tv; }
        if (lane == 63) fs[w] = incl;
        __syncthreads();
        float pre = incl - run;
        for (int ww = 0; ww < w; ++ww) pre += fs[ww];
        f32x4* dst = (f32x4*)(p->cum + (size_t)bh * SEQ + tid * 16);
#pragma unroll
        for (int j = 0; j < 4; ++j) { f32x4 o;
#pragma unroll
            for (int e = 0; e < 4; ++e) o[e] = v[j][e] + pre; dst[j] = o; }
        __syncthreads();
        {
            const bf16_t* kp = p->kf + (size_t)(bh >> 3) * SEQ * 512 + (bh & 7) * 64 + (size_t)tid * 16 * 512;
            float mx = 0.f;
            for (int rr = 0; rr < 16; ++rr) {
                const uint4* q4 = (const uint4*)(kp + (size_t)rr * 512);
                uint4 vv[8];
#pragma unroll
                for (int c = 0; c < 8; ++c) vv[c] = q4[c];
                float ss = 0.f;
#pragma unroll
                for (int c = 0; c < 8; ++c) { const unsigned uu[4] = {vv[c].x, vv[c].y, vv[c].z, vv[c].w};
#pragma unroll
                    for (int e = 0; e < 4; ++e) { const float lo = __uint_as_float(uu[e] << 16), hi = __uint_as_float(uu[e] & 0xffff0000u); ss += lo * lo + hi * hi; } }
                mx = fmaxf(mx, ss);
            }
#pragma unroll
            for (int o = 32; o >= 1; o >>= 1) mx = fmaxf(mx, __shfl_xor(mx, o));
            if (lane == 0) fs[16 + w] = mx;
            __syncthreads();
            if (tid == 0) p->kmax[bh] = sqrtf(fmaxf(fmaxf(fs[16], fs[17]), fmaxf(fs[18], fs[19]))) * 1.01f;
            __syncthreads();
        }
    }
}

template <int TYPE>
DI void attn_item(KargPtr p, int b, int h, int qb, unsigned char* smem) {
    constexpr int DK = (TYPE == 1) ? 96 : (TYPE == 0 ? 80 : 64), KS = DK / 16, KROWB = (DK + 8) * 2, VROWB = 144;
    constexpr int KBYTES = 64 * KROWB, VBYTES = 64 * VROWB, BUFB = KBYTES + VBYTES + 256;
    const int tid = tidx(), lane = tid & 63, w = tid >> 6, r = lane & 31, hh = lane >> 5;
    const int q0 = qb * 128, qw = q0 + 32 * w, myq = qw + r;
    const size_t tokq = (size_t)b * SEQ + myq;
    unsigned* flags = (unsigned*)(smem - vhalf() * VSMEM + FLAGS_OFF);
    const int w8 = vhalf() * 4 + w;

    bf16x8 qfrag[KS];
    if (TYPE == 1) {
#pragma unroll
        for (int ks = 0; ks < 4; ++ks) qfrag[ks] = *(const bf16x8*)(p->qn + tokq * 512 + h * 64 + ks * 16 + hh * 8);
#pragma unroll
        for (int ks = 4; ks < KS; ++ks) qfrag[ks] = *(const bf16x8*)(p->qr + tokq * 256 + h * 32 + (ks - 4) * 16 + hh * 8);
    } else {
        const bf16_t* qg = (TYPE == 0 ? p->qf : p->qs) + tokq * 512 + h * 64;
#pragma unroll
        for (int ks = 0; ks < 4; ++ks) qfrag[ks] = *(const bf16x8*)(qg + ks * 16 + hh * 8);
        if (TYPE == 0) { const u32x4 one3 = hh == 0 ? (u32x4){0x3F803F80u, 0x00003F80u, 0u, 0u} : (u32x4){0u, 0u, 0u, 0u}; qfrag[KS - 1] = __builtin_bit_cast(bf16x8, one3); }
    }
    const bf16_t* Kg = (TYPE == 0 ? p->kf : TYPE == 1 ? p->kn : p->ks) + (size_t)b * SEQ * 512 + h * 64;
    const bf16_t* Vg = (TYPE == 0 ? p->vtf : TYPE == 1 ? p->vtm : p->vts) + (size_t)(b * 8 + h) * 64 * SEQ;
    const bf16_t* Krg = p->kr + (size_t)b * SEQ * 32;
    const float* cumg = p->cum + (size_t)(b * 8 + h) * SEQ;

    const int ntiles = 2 * qb + 2;
    u32x4 rk0A, rk1A, rv0A, rv1A, rkrA, rk0B, rk1B, rv0B, rv1B, rkrB; float rckA = 0.f, rckB = 0.f;
    rkrA = (u32x4){0u, 0u, 0u, 0u}; rkrB = rkrA;
    const int ldrow = tid >> 3, ldch = tid & 7;
    const int vpos = 16 * (ldch >> 1) + 4 * (ldch & 1);
#define LOAD_TILE(S, KT_) do { \
        const int k0_ = (KT_) * 64; \
        GLOAD16(rk0##S, Kg + (size_t)(k0_ + ldrow) * 512 + ldch * 8); \
        GLOAD16(rk1##S, Kg + (size_t)(k0_ + 32 + ldrow) * 512 + ldch * 8); \
        GLOAD16(rv0##S, Vg + (size_t)k0_ * 64 + ldrow * 64 + ldch * 8); \
        GLOAD16(rv1##S, Vg + (size_t)k0_ * 64 + (32 + ldrow) * 64 + ldch * 8); \
        if (TYPE == 1) GLOAD16(rkr##S, Krg + (size_t)(k0_ + (tid >> 2)) * 32 + (tid & 3) * 8); \
        if (TYPE == 0) GLOAD4(rck##S, cumg + k0_ + (tid & 63)); \
    } while (0)
#define WAIT_ALL(S) asm volatile("s_waitcnt vmcnt(0)" : "+v"(rk0##S), "+v"(rk1##S), "+v"(rv0##S), "+v"(rv1##S), "+v"(rkr##S), "+v"(rck##S))
#define WAIT_OLD(S) do { if (TYPE == 2) asm volatile("s_waitcnt vmcnt(4)" : "+v"(rk0##S), "+v"(rk1##S), "+v"(rv0##S), "+v"(rv1##S), "+v"(rkr##S), "+v"(rck##S)); \
        else asm volatile("s_waitcnt vmcnt(5)" : "+v"(rk0##S), "+v"(rk1##S), "+v"(rv0##S), "+v"(rv1##S), "+v"(rkr##S), "+v"(rck##S)); } while (0)
#define STORE_TILE(S, BUF_) do { \
        unsigned char* kb_ = smem + (BUF_) * BUFB; unsigned char* vb_ = kb_ + KBYTES; \
        *(u32x4*)(kb_ + ldrow * KROWB + ldch * 16) = rk0##S; \
        *(u32x4*)(kb_ + (32 + ldrow) * KROWB + ldch * 16) = rk1##S; \
        { u32x2 lo, hi; lo.x = rv0##S.x; lo.y = rv0##S.y; hi.x = rv0##S.z; hi.y = rv0##S.w; \
          *(u32x2*)(vb_ + ldrow * VROWB + vpos * 2) = lo; *(u32x2*)(vb_ + ldrow * VROWB + (vpos + 8) * 2) = hi; } \
        { u32x2 lo, hi; lo.x = rv1##S.x; lo.y = rv1##S.y; hi.x = rv1##S.z; hi.y = rv1##S.w; \
          *(u32x2*)(vb_ + (32 + ldrow) * VROWB + vpos * 2) = lo; *(u32x2*)(vb_ + (32 + ldrow) * VROWB + (vpos + 8) * 2) = hi; } \
        if (TYPE == 1) *(u32x4*)(kb_ + (tid >> 2) * KROWB + 128 + (tid & 3) * 16) = rkr##S; \
        if (TYPE == 0) { if (tid < 64) { \
            const float c_ = -rck##S * LOG2E; \
            const unsigned h_ = pack_bf16(c_, 0.f) & 0xffffu; const float r1_ = c_ - __uint_as_float(h_ << 16); \
            const unsigned m_ = pack_bf16(r1_, 0.f) & 0xffffu; const float r2_ = r1_ - __uint_as_float(m_ << 16); \
            const unsigned l_ = pack_bf16(r2_, 0.f) & 0xffffu; \
            *(u32x4*)(kb_ + tid * KROWB + 128) = (u32x4){h_ | (m_ << 16), l_, 0u, 0u}; \
            *(u32x4*)(kb_ + tid * KROWB + 144) = (u32x4){0u, 0u, 0u, 0u}; \
            if (tid == 63) *(float*)(vb_ + VBYTES) = c_; } } \
    } while (0)
#define TILE_OF(J_) ((TYPE != 1) ? (ntiles - 1 - ((J_) < ntiles ? (J_) : ntiles - 1)) : ((J_) < ntiles ? (J_) : ntiles - 1))

    f32x16 o0, o1;
#pragma unroll
    for (int i = 0; i < 16; ++i) { o0[i] = 0.f; o1[i] = 0.f; }
    float m = -1e30f, lsum = 0.f, carry = 0.f;
    bool wdone = false;
    float qbound = 0.f;
    if (TYPE == 0) {
        float ss = 0.f;
#pragma unroll
        for (int ks = 0; ks < 4; ++ks) { const u32x4 qq = __builtin_bit_cast(u32x4, qfrag[ks]);
#pragma unroll
            for (int e = 0; e < 4; ++e) { const float lo = __uint_as_float(qq[e] << 16), hi = __uint_as_float(qq[e] & 0xffff0000u); ss += lo * lo + hi * hi; } }
        ss += __shfl_xor(ss, 32);
        qbound = sqrtf(ss) * 1.01f * p->kmax[b * 8 + h];
    }

    auto compute = [&](const int kt, const int buf) __attribute__((always_inline)) {
        const unsigned char* kb = smem + buf * BUFB; const unsigned char* vb = kb + KBYTES;
        const int k0 = kt * 64;
        bool need;
        if (TYPE == 0) {
            if (!wdone && k0 <= qw + 31) wdone = (__all(qbound + *(const float*)(vb + VBYTES) - m < -150.f) != 0);
            need = (k0 <= qw + 31) && !wdone;
        }
        else if (TYPE == 1) need = (k0 <= qw);
        else need = (k0 <= qw + 30) && !wdone;
        if (need) {
            f32x16 s0, s1;
#pragma unroll
            for (int i = 0; i < 16; ++i) { s0[i] = 0.f; s1[i] = 0.f; }
#pragma unroll
            for (int ks = 0; ks < KS; ++ks) {
                const bf16x8 a0 = *(const bf16x8*)(kb + r * KROWB + ks * 32 + hh * 16);
                const bf16x8 a1 = *(const bf16x8*)(kb + (32 + r) * KROWB + ks * 32 + hh * 16);
                s0 = MFMA(a0, qfrag[ks], s0); s1 = MFMA(a1, qfrag[ks], s1);
            }
            if (TYPE != 2) {
                if (TYPE == 0) {
                    if (k0 + 63 > qw) {
                        asm volatile("");
                        const int rel = myq - k0 - 4 * hh;
#pragma unroll
                        for (int i = 0; i < 16; ++i) {
                            const int off = 8 * (i >> 2) + (i & 3);
                            if (off > rel) s0[i] = -1e30f;
                            if (off + 32 > rel) s1[i] = -1e30f;
                        }
                    }
                }
                float mx = s0[0];
#pragma unroll
                for (int i = 1; i < 16; ++i) mx = fmaxf(mx, s0[i]);
#pragma unroll
                for (int i = 0; i < 16; ++i) mx = fmaxf(mx, s1[i]);
                mx = fmaxf(mx, __shfl_xor(mx, 32));
                const float mnew = fmaxf(m, mx);
                const float alpha = fexp2(m - mnew);
                m = mnew;
                float ps = 0.f;
#pragma unroll
                for (int i = 0; i < 16; ++i) { s0[i] = fexp2(s0[i] - mnew); s1[i] = fexp2(s1[i] - mnew); ps += s0[i] + s1[i]; }
                lsum = lsum * alpha + ps;
#pragma unroll
                for (int i = 0; i < 16; ++i) { o0[i] *= alpha; o1[i] *= alpha; }
            } else {
                float lk0[16], lk1[16];
#pragma unroll
                for (int i = 0; i < 16; ++i) {
                    {
                        const float z = s0[i]; const float sp = flog2(1.0f + fexp2(-fabsf(z)));
                        const float lb = fminf(z, 0.f) - sp;
                        s0[i] = lb; lk0[i] = lb - z;
                    }
                    {
                        const float z = s1[i]; const float sp = flog2(1.0f + fexp2(-fabsf(z)));
                        const float lb = fminf(z, 0.f) - sp;
                        s1[i] = lb; lk1[i] = lb - z;
                    }
                }
                if (k0 + 63 >= qw) {
                    asm volatile("");
                    const int rel = myq - k0 - 4 * hh;
#pragma unroll
                    for (int i = 0; i < 16; ++i) {
                        const int off = 8 * (i >> 2) + (i & 3);
                        if (off >= rel) { lk0[i] = 0.f; s0[i] = -1e30f; }
                        if (off + 32 >= rel) { lk1[i] = 0.f; s1[i] = -1e30f; }
                    }
                }
                float run = carry;
#pragma unroll
                for (int g = 3; g >= 0; --g) {
                    const float G = (lk1[4 * g] + lk1[4 * g + 1]) + (lk1[4 * g + 2] + lk1[4 * g + 3]);
                    const float Gp = __shfl_xor(G, 32);
                    const float base = run + (hh == 0 ? Gp : 0.f);
                    const float e3 = base, e2 = e3 + lk1[4 * g + 3], e1 = e2 + lk1[4 * g + 2], e0 = e1 + lk1[4 * g + 1];
                    s1[4 * g + 3] = fexp2(s1[4 * g + 3] + e3); s1[4 * g + 2] = fexp2(s1[4 * g + 2] + e2);
                    s1[4 * g + 1] = fexp2(s1[4 * g + 1] + e1); s1[4 * g] = fexp2(s1[4 * g] + e0);
                    run += G + Gp;
                }
#pragma unroll
                for (int g = 3; g >= 0; --g) {
                    const float G = (lk0[4 * g] + lk0[4 * g + 1]) + (lk0[4 * g + 2] + lk0[4 * g + 3]);
                    const float Gp = __shfl_xor(G, 32);
                    const float base = run + (hh == 0 ? Gp : 0.f);
                    const float e3 = base, e2 = e3 + lk0[4 * g + 3], e1 = e2 + lk0[4 * g + 2], e0 = e1 + lk0[4 * g + 1];
                    s0[4 * g + 3] = fexp2(s0[4 * g + 3] + e3); s0[4 * g + 2] = fexp2(s0[4 * g + 2] + e2);
                    s0[4 * g + 1] = fexp2(s0[4 * g + 1] + e1); s0[4 * g] = fexp2(s0[4 * g] + e0);
                    run += G + Gp;
                }
                carry = run;
            }
#pragma unroll
            for (int s2 = 0; s2 < 2; ++s2) {
                unsigned pk0[4], pk1[4];
#pragma unroll
                for (int j = 0; j < 4; ++j) { pk0[j] = pack_bf16(s0[8 * s2 + 2 * j], s0[8 * s2 + 2 * j + 1]); pk1[j] = pack_bf16(s1[8 * s2 + 2 * j], s1[8 * s2 + 2 * j + 1]); }
                const uint4 u0 = make_uint4(pk0[0], pk0[1], pk0[2], pk0[3]), u1 = make_uint4(pk1[0], pk1[1], pk1[2], pk1[3]);
                const bf16x8 pf0 = __builtin_bit_cast(bf16x8, u0), pf1 = __builtin_bit_cast(bf16x8, u1);
                const bf16x8 v00 = *(const bf16x8*)(vb + r * VROWB + (16 * s2 + 8 * hh) * 2);
                const bf16x8 v01 = *(const bf16x8*)(vb + (32 + r) * VROWB + (16 * s2 + 8 * hh) * 2);
                const bf16x8 v10 = *(const bf16x8*)(vb + r * VROWB + (32 + 16 * s2 + 8 * hh) * 2);
                const bf16x8 v11 = *(const bf16x8*)(vb + (32 + r) * VROWB + (32 + 16 * s2 + 8 * hh) * 2);
                o0 = MFMA(v00, pf0, o0); o1 = MFMA(v01, pf0, o1);
                o0 = MFMA(v10, pf1, o0); o1 = MFMA(v11, pf1, o1);
            }
        }
    };
#define SB_FLAGS(N_) do { if (TYPE != 1) { if (TYPE == 2) wdone = (__all(carry < -170.f) != 0); if (lane == 0) flags[((N_) & 1) * 8 + w8] = wdone ? 1u : 0u; } } while (0)
#define SB_DONE(N_) (TYPE != 1 && ((flags[((N_) & 1) * 8] & flags[((N_) & 1) * 8 + 1] & flags[((N_) & 1) * 8 + 2] & flags[((N_) & 1) * 8 + 3] & flags[((N_) & 1) * 8 + 4] & flags[((N_) & 1) * 8 + 5] & flags[((N_) & 1) * 8 + 6] & flags[((N_) & 1) * 8 + 7]) != 0u))
    __syncthreads();
    if (TYPE != 1 && tid < 16) flags[tid] = 0;
    LOAD_TILE(A, TILE_OF(0));
    WAIT_ALL(A);
    STORE_TILE(A, 0);
    LOAD_TILE(A, TILE_OF(1));
    __syncthreads();
    for (int n = 0; n < ntiles; n += 2) {
        LOAD_TILE(B, TILE_OF(n + 2));
        __builtin_amdgcn_sched_barrier(0);
        compute(TILE_OF(n), 0);
        __builtin_amdgcn_sched_barrier(0);
        WAIT_OLD(A);
        STORE_TILE(A, 1);
        SB_FLAGS(n);
        __syncthreads();
        if (SB_DONE(n)) break;
        if (n + 1 >= ntiles) break;
        LOAD_TILE(A, TILE_OF(n + 3));
        __builtin_amdgcn_sched_barrier(0);
        compute(TILE_OF(n + 1), 1);
        __builtin_amdgcn_sched_barrier(0);
        WAIT_OLD(B);
        STORE_TILE(B, 0);
        SB_FLAGS(n + 1);
        __syncthreads();
        if (SB_DONE(n + 1)) break;
    }
    asm volatile("s_waitcnt vmcnt(0)" : "+v"(rk0A), "+v"(rk1A), "+v"(rv0A), "+v"(rv1A), "+v"(rkrA), "+v"(rckA), "+v"(rk0B), "+v"(rk1B), "+v"(rv0B), "+v"(rv1B), "+v"(rkrB), "+v"(rckB));
    float inv = 1.0f;
    if (TYPE != 2) { const float lt = lsum + __shfl_xor(lsum, 32); inv = frcp(lt); }
    bf16_t* yg = (TYPE == 0 ? p->qf : TYPE == 1 ? p->qn : p->qs) + tokq * 512 + h * 64;
#pragma unroll
    for (int g = 0; g < 4; ++g) {
        u32x2 a, c2;
        a.x = pack_bf16(o0[4 * g] * inv, o0[4 * g + 1] * inv); a.y = pack_bf16(o0[4 * g + 2] * inv, o0[4 * g + 3] * inv);
        c2.x = pack_bf16(o1[4 * g] * inv, o1[4 * g + 1] * inv); c2.y = pack_bf16(o1[4 * g + 2] * inv, o1[4 * g + 3] * inv);
        *(u32x2*)(yg + 8 * g + 4 * hh) = a;
        *(u32x2*)(yg + 32 + 8 * g + 4 * hh) = c2;
    }
}

DI void phase_attn(KargPtr p, unsigned char* smem) {
    for (int idx = bidx(); idx < 6144; idx += gdim()) {
        if (idx < 4096) {
            const int j = idx >> 9, g = (idx >> 7) & 3, rem = idx & 127, bh = ((rem & 63) + 13 * j) & 63;
            const int qb = 31 - 4 * j - ((j & 1) ? 3 - g : g);
            const int type = ((rem >> 6) + j) & 1;
            if (type == 0) attn_item<0>(p, bh >> 3, bh & 7, qb, smem);
            else attn_item<1>(p, bh >> 3, bh & 7, qb, smem);
        } else {
            const int j = idx - 4096; const int qb = 31 - (j >> 6), bh = j & 63;
            attn_item<2>(p, bh >> 3, bh & 7, qb, smem);
        }
    }
}

DI void phase_merge(KargPtr p, int l, unsigned char* smem) {
    const bf16_t* WL = p->wt + (size_t)l * W_LAYER;
    unsigned* park = (unsigned*)(smem + 40960) + tidx();
    for (int it = 0;; ++it) {
        int mt, nt; if (!next_tile(it, 256, 8, mt, nt)) break;
        const int m0 = mt * 128;
        f32x16 mer[2][2]; zero_acc(mer);
#pragma unroll 1
        for (int br = 0; br < 3; ++br) {
            f32x16 acc[2][2]; zero_acc(acc);
            gemm_mainloop<32>(WL + W_GATE + (size_t)(br * 1024 + nt * 128) * 1024, 1024, p->u + (size_t)m0 * 1024, 1024, 1024, acc, smem);
#pragma unroll
            for (int a = 0; a < 2; ++a)
#pragma unroll
                for (int c = 0; c < 2; ++c)
#pragma unroll
                    for (int j = 0; j < 8; ++j) park[((a * 2 + c) * 8 + j) * 256] = pack_bf16(sigmoidf_(acc[a][c][2 * j]), sigmoidf_(acc[a][c][2 * j + 1]));
            zero_acc(acc);
            const bf16_t* Y = (br == 0 ? p->qf : br == 1 ? p->qn : p->qs) + (size_t)m0 * 512;
            const bf16_t* WO = WL + (br == 0 ? W_OF : br == 1 ? W_OM : W_OS) + (size_t)nt * 128 * 512;
            gemm_mainloop<32>(WO, 512, Y, 512, 512, acc, smem);
#pragma unroll
            for (int a = 0; a < 2; ++a)
#pragma unroll
                for (int c = 0; c < 2; ++c)
#pragma unroll
                    for (int j = 0; j < 8; ++j) {
                        const unsigned gv = park[((a * 2 + c) * 8 + j) * 256];
                        const float g0 = __uint_as_float(gv << 16), g1 = __uint_as_float(gv & 0xffff0000u);
                        mer[a][c][2 * j] += g0 * acc[a][c][2 * j]; mer[a][c][2 * j + 1] += g1 * acc[a][c][2 * j + 1];
                    }
        }
        stage_store_128(mer, p->merged + (size_t)m0 * 1024 + nt * 128, 1024, smem);
    }
}

DI void phase_outproj(KargPtr p, int l, unsigned char* smem_phys) {
    EpiResidual E; E.xin = (l == 0) ? p->x : p->out; E.xout = p->out; E.modl = p->mod + (size_t)l * 8 * 6144; E.gidx = 2;
    big_gemm(p->merged, p->wt + (size_t)l * W_LAYER + W_OUT, 1024, 1024, E, smem_phys);
}
DI void phase_ffn_up(KargPtr p, int l, unsigned char* smem_phys) {
    EpiFfnUp E; E.h = p->h;
    big_gemm(p->u, p->wt + (size_t)l * W_LAYER + W_FGU, 5632, 1024, E, smem_phys);
}
DI void phase_ffn_down(KargPtr p, int l, unsigned char* smem_phys) {
    EpiResidual E; E.xin = p->out; E.xout = p->out; E.modl = p->mod + (size_t)l * 8 * 6144; E.gidx = 5;
    big_gemm(p->h, p->wt + (size_t)l * W_LAYER + W_FD, 1024, 2816, E, smem_phys);
}

DI void run_phase(int ph, int l, unsigned char* smem_phys) {
#ifdef ONLY_PH
    if (ph != ONLY_PH) return;
#endif
    KargPtr p = karg();
    unsigned char* smem = smem_phys + vhalf() * VSMEM;
    switch (ph) {
    case 0: phase_prep(p, smem); break;
    case 1: phase_norm((l == 0) ? p->x : p->out, p->g_mix + l * 1024, p->mod + (size_t)l * 8 * 6144, 0, 1, p->u); break;
    case 2: phase_inproj(p, l, smem_phys); break;
    case 3: phase_mla_up(p, l, smem); break;
    case 4: phase_attn(p, smem); break;
    case 5: phase_merge(p, l, smem); break;
    case 6: phase_outproj(p, l, smem_phys); break;
    case 7: phase_norm(p->out, p->g_ffn + l * 1024, p->mod + (size_t)l * 8 * 6144, 3, 4, p->u); break;
    case 8: phase_ffn_up(p, l, smem_phys); break;
    case 9: phase_ffn_down(p, l, smem_phys); break;
    default: phase_final(p); break;
    }
}

#define XB_TMO      128
#define XB_XCNT(j)  (256  + 64 * (j))
#define XB_XSUB(j)  (1280 + 64 * (j))
#define XB_XGEN(j)  (2304 + 64 * (j))
#define XB_TOP      3328
#define XB_TOPGEN   3392
#define XCD_BAR_WORDS 3456
#define XB_SPIN_CAP (1u << 20)
#define LAS __attribute__((address_space(3)))
DI unsigned xb_ld(unsigned* p)              { return __hip_atomic_load(p, __ATOMIC_RELAXED, __HIP_MEMORY_SCOPE_AGENT); }
DI unsigned xb_add(unsigned* p, unsigned v) { return __hip_atomic_fetch_add(p, v, __ATOMIC_RELAXED, __HIP_MEMORY_SCOPE_AGENT); }
DI unsigned xb_xcc_id() { return (unsigned)__builtin_amdgcn_s_getreg((3 << 11) | 20) & 0xFu; }
#define XB_SPIN(cond, bar) do { unsigned _sp = 0; while (cond) { __builtin_amdgcn_s_sleep(1); \
    if ((++_sp & 255u) == 0u) { if (xb_ld(&(bar)[XB_TMO])) break; if (_sp > XB_SPIN_CAP) { atomicAdd(&(bar)[XB_TMO], 1u); break; } } } } while (0)
struct XcdBarrier { unsigned* bar; unsigned x; volatile LAS unsigned* st; };
DI XcdBarrier xcd_barrier_post(unsigned* bar, volatile LAS unsigned* st) {
    XcdBarrier b; b.bar = bar; b.x = xb_xcc_id(); b.st = st;
    if (threadIdx.x == 0) (void)xb_add(&bar[XB_XCNT(b.x)], 1u);
    return b;
}
DI void xcd_barrier_complete(unsigned* bar, unsigned x, unsigned& nloc, unsigned& nx) {
    const unsigned G = gridDim.x * gridDim.y * gridDim.z;
    unsigned sum, cnt, mine, sp = 0u;
    for (;;) {
        sum = 0u; cnt = 0u; mine = 0u;
#pragma unroll
        for (unsigned j = 0; j < 16; ++j) { const unsigned c = xb_ld(&bar[XB_XCNT(j)]); sum += c; cnt += (c > 0u) ? 1u : 0u; mine = (j == x) ? c : mine; }
        if (sum == G) break;
        __builtin_amdgcn_s_sleep(1);
        if ((++sp & 255u) == 0u) { if (xb_ld(&bar[XB_TMO])) break; if (sp > XB_SPIN_CAP) { atomicAdd(&bar[XB_TMO], 1u); break; } }
    }
    nloc = mine > 0u ? mine : 1u; nx = cnt > 0u ? cnt : 1u;
}
DI void xcd_barrier(const XcdBarrier& b) {
    asm volatile("s_waitcnt vmcnt(0)" ::: "memory");
    __syncthreads();
    if (threadIdx.x == 0) {
        unsigned* bar = b.bar;
        __builtin_amdgcn_s_waitcnt(0);
        unsigned nloc = b.st[0], nx = b.st[1];
        if (nloc == 0u) { xcd_barrier_complete(bar, b.x, nloc, nx); b.st[0] = nloc; b.st[1] = nx; }
        const unsigned old = xb_add(&bar[XB_XSUB(b.x)], 1u);
        const unsigned gen = old / nloc;
        if (old + 1u == (gen + 1u) * nloc) {
            __builtin_amdgcn_fence(__ATOMIC_RELEASE, "agent");
            asm volatile("s_waitcnt vmcnt(0)" ::: "memory");
            const unsigned og = xb_add(&bar[XB_TOP], 1u);
            const unsigned tg = og / nx;
            if (og + 1u == (tg + 1u) * nx) xb_add(&bar[XB_TOPGEN], 1u);
            else XB_SPIN(xb_ld(&bar[XB_TOPGEN]) == tg, bar);
            __builtin_amdgcn_fence(__ATOMIC_ACQUIRE, "agent");
            xb_add(&bar[XB_XGEN(b.x)], 1u);
            asm volatile("s_waitcnt vmcnt(0)" ::: "memory");
        } else {
            XB_SPIN(xb_ld(&bar[XB_XGEN(b.x)]) == gen, bar);
            __builtin_amdgcn_fence(__ATOMIC_ACQUIRE, "agent");
            asm volatile("s_waitcnt vmcnt(0)" ::: "memory");
        }
    }
    __syncthreads();
}

#if MEGA
__global__ void __launch_bounds__(512, 2) __attribute__((amdgpu_waves_per_eu(2, 2))) mega_kernel(Params p) {
    extern __shared__ __attribute__((aligned(16))) unsigned char smem[];
    cg::grid_group grid = cg::this_grid();
    volatile LAS unsigned* st = (volatile LAS unsigned*)(smem + SMEM_BYTES - 16);
    if (threadIdx.x == 0) { st[0] = 0u; st[1] = 0u; }
    __syncthreads();
    const XcdBarrier xb = xcd_barrier_post(karg()->bar, st);
    run_phase(0, 0, smem);
    grid.sync();
#pragma unroll 1
    for (int l = 0; l < 2; ++l) {
#pragma unroll 1
        for (int ph = 1; ph <= 9; ++ph) {
            run_phase(ph, l, smem); xcd_barrier(xb);
#ifdef DBL_PH
            if (ph == DBL_PH) { run_phase(ph, l, smem); xcd_barrier(xb); }
#endif
        }
    }
    run_phase(10, 0, smem);
}
#else
__global__ void __launch_bounds__(512, 2) __attribute__((amdgpu_waves_per_eu(2, 2))) phase_kernel(Params p, int ph, int l) {
    extern __shared__ __attribute__((aligned(16))) unsigned char smem[];
    run_phase(ph, l, smem);
}
#endif

extern "C" void kernel_launch(void* const* d_in, const int* in_sizes, int n_in, void* d_out, int out_size, void* d_ws, size_t ws_size, hipStream_t stream) {
    (void)in_sizes; (void)n_in; (void)out_size;
    Params p{};
    p.x = (const float*)d_in[0]; p.c = (const float*)d_in[1]; p.pos = (const int*)d_in[2];
    p.g_mix = (const float*)d_in[3]; p.w_ada = (const float*)d_in[4]; p.b_ada = (const float*)d_in[5]; p.w_in = (const float*)d_in[6]; p.b_fox_f = (const float*)d_in[7];
    p.g_mla_q = (const float*)d_in[8]; p.w_mla_uq = (const float*)d_in[9]; p.g_mla_kv = (const float*)d_in[10]; p.w_mla_ukv = (const float*)d_in[11];
    p.w_o_fox = (const float*)d_in[12]; p.w_o_mla = (const float*)d_in[13]; p.w_o_sb = (const float*)d_in[14]; p.w_out = (const float*)d_in[15];
    p.g_ffn = (const float*)d_in[16]; p.w_ffn_gate = (const float*)d_in[17]; p.w_ffn_up = (const float*)d_in[18]; p.w_ffn_down = (const float*)d_in[19]; p.g_final = (const float*)d_in[20];
    p.out = (float*)d_out;
    unsigned char* ws = (unsigned char*)d_ws; size_t off = 0;
    auto take = [&](size_t bytes) { unsigned char* q = ws + off; off += (bytes + 255) & ~(size_t)255; return q; };
    p.bar = (unsigned*)take(16384);
    p.kmax = (float*)take(256);
    p.wt = (bf16_t*)take(2 * W_LAYER * 2);
    p.mod = (float*)take(2 * 8 * 6144 * 4);
    p.ropetab = (float*)take((size_t)T_TOK * 16 * 2 * 4);
    p.logf = (float*)take((size_t)64 * SEQ * 4);
    p.cum = (float*)take((size_t)64 * SEQ * 4);
    p.u = (bf16_t*)take((size_t)T_TOK * 1024 * 2);
    p.qf = (bf16_t*)take((size_t)T_TOK * 512 * 2);
    p.kf = (bf16_t*)take((size_t)T_TOK * 512 * 2);
    p.vtf = (bf16_t*)take((size_t)T_TOK * 512 * 2);
    p.qs = (bf16_t*)take((size_t)T_TOK * 512 * 2);
    p.ks = (bf16_t*)take((size_t)T_TOK * 512 * 2);
    p.vts = (bf16_t*)take((size_t)T_TOK * 512 * 2);
    p.ql = (bf16_t*)take((size_t)T_TOK * 384 * 2);
    p.kvl = (bf16_t*)take((size_t)T_TOK * 256 * 2);
    p.kr = (bf16_t*)take((size_t)T_TOK * 32 * 2);
    p.qn = (bf16_t*)take((size_t)T_TOK * 512 * 2);
    p.qr = (bf16_t*)take((size_t)T_TOK * 256 * 2);
    p.kn = (bf16_t*)take((size_t)T_TOK * 512 * 2);
    p.vtm = (bf16_t*)take((size_t)T_TOK * 512 * 2);
    p.merged = p.kf;
    p.h = p.qf;
    if (off > ws_size) { fprintf(stderr, "kernel_launch: workspace too small: need %zu, have %zu\n", off, ws_size); return; }

#if MEGA
    static int grid_blocks = 0;
    if (!grid_blocks) {
        int dev = 0, cus = 0, per_cu = 0;
        (void)hipGetDevice(&dev);
        (void)hipDeviceGetAttribute(&cus, hipDeviceAttributeMultiprocessorCount, dev);
        (void)hipFuncSetAttribute((const void*)mega_kernel, hipFuncAttributeMaxDynamicSharedMemorySize, SMEM_BYTES);
        (void)hipOccupancyMaxActiveBlocksPerMultiprocessor(&per_cu, (const void*)mega_kernel, 512, SMEM_BYTES);
        per_cu = 1;
        grid_blocks = cus * per_cu;
        grid_blocks &= ~7;
    }
    (void)hipMemsetAsync(p.bar, 0, 16384, stream);
    void* args[] = {&p};
    hipError_t e = hipLaunchCooperativeKernel((const void*)mega_kernel, dim3(grid_blocks), dim3(512), args, SMEM_BYTES, stream);
    if (e != hipSuccess) fprintf(stderr, "cooperative launch failed: %s (grid %d)\n", hipGetErrorString(e), grid_blocks);
#else
    static bool attr = false;
    if (!attr) { (void)hipFuncSetAttribute((const void*)phase_kernel, hipFuncAttributeMaxDynamicSharedMemorySize, SMEM_BYTES); attr = true; }
    const int G = 512;
    hipLaunchKernelGGL(phase_kernel, dim3(G), dim3(256), SMEM_BYTES, stream, p, 0, 0);
    for (int l = 0; l < 2; ++l)
        for (int ph = 1; ph <= 9; ++ph) hipLaunchKernelGGL(phase_kernel, dim3(G), dim3(256), SMEM_BYTES, stream, p, ph, l);
    hipLaunchKernelGGL(phase_kernel, dim3(G), dim3(256), SMEM_BYTES, stream, p, 10, 0);
#endif
}
```

```cpp
#include <hip/hip_runtime.h>
#include <hip/hip_cooperative_groups.h>
#include <cstdint>
#include <cstdio>
namespace cg = cooperative_groups;

#ifndef MEGA
#define MEGA 1
#endif

typedef unsigned short bf16_t;
typedef short bf16x8 __attribute__((ext_vector_type(8)));
typedef float f32x16 __attribute__((ext_vector_type(16)));
typedef float f32x4 __attribute__((ext_vector_type(4)));
typedef unsigned u32x2 __attribute__((ext_vector_type(2)));
#define DI __device__ __forceinline__
typedef unsigned u32x4 __attribute__((ext_vector_type(4)));
#define GLOAD16(dst, ptr) asm volatile("global_load_dwordx4 %0, %1, off" : "=v"(dst) : "v"(ptr))
#define GLOAD4(dst, ptr)  asm volatile("global_load_dword %0, %1, off" : "=v"(dst) : "v"(ptr))
#define MFMA(a, b, c) __builtin_amdgcn_mfma_f32_32x32x16_bf16((a), (b), (c), 0, 0, 0)

namespace pg8 {
#define PG8_LAS __attribute__((address_space(3)))
typedef unsigned short bf16_t;
typedef short bf16x8 __attribute__((ext_vector_type(8)));
typedef float f32x4 __attribute__((ext_vector_type(4)));
typedef unsigned u32x4 __attribute__((ext_vector_type(4)));
constexpr int BM = 256, BK = 64, HALF = 128, HTB = HALF * BK * 2  , STAGE_BYTES = 8 * HTB, NXCD = 8, WGM = 8;

__host__ __device__ __forceinline__ int lds_byte(int r, int c) { const int st = (r >> 4) * 2 + (c >> 5), rr = r & 15, cc = c & 31, ob = rr * 64 + cc * 2; return st * 1024 + (ob ^ (((ob >> 9) & 1) << 5)); }
__host__ __device__ __forceinline__ void stage_rc(int b, int& R, int& C) { const int st = b / 1024, sb = b % 1024, swz = sb ^ (((sb >> 9) & 1) << 5); R = (st >> 1) * 16 + swz / 64; C = (st & 1) * 32 + (swz % 64) / 2; }
__host__ __device__ __forceinline__ int perm32(int rho) { const int n = rho >> 4, i = rho & 15; return 8 * (i >> 2) + 4 * n + (i & 3); }

struct Unit { int pm, pn; };
struct Gemm { const bf16_t* A; const bf16_t* Bt; int M, N, K; };

struct StaticOrder {
    int nM, nN, nwg, G, c;
    __host__ __device__ void init(int M, int N, int G_, int c_) { nM = M / BM; nN = N / BM; nwg = nM * nN; G = G_; c = c_; }
    __host__ __device__ bool next(int i, Unit& u) const {
        const long L = (long)i * G + c; if (L >= nwg) return false;
        int wgid = (int)L; { const int q = nwg / NXCD, r = nwg % NXCD, xcd = wgid % NXCD, off = wgid / NXCD; wgid = (xcd < r ? xcd * (q + 1) : r * (q + 1) + (xcd - r) * q) + off; }
        const int nig = WGM * nN, gid = wgid / nig, fm = gid * WGM, gsz = (nM - fm) < WGM ? (nM - fm) : WGM;
        u.pm = fm + ((wgid % nig) % gsz); u.pn = (wgid % nig) / gsz; return true;
    }
    __device__ __forceinline__ void a_ready(const Unit&) const {}
    __device__ __forceinline__ void done(const Unit&) const {}
};
template <class Epi, class Sched, bool ALIGN_EPI = false, bool SP2 = false, bool NAT = false>
__device__ __forceinline__ void gemm_phase(PG8_LAS unsigned char* lds, const Gemm g, const Sched& S, const Epi& E) {
    int tid = threadIdx.x; asm volatile("" : "+v"(tid)); const int wid = __builtin_amdgcn_readfirstlane(tid >> 6), lane = tid & 63, wr = wid >> 2, wc = wid & 3, fr = lane & 15, fq = lane >> 4;
    const int K = g.K, nt = K / BK;
    unsigned voffA[2], voffB[2];
#pragma unroll
    for (int i = 0; i < 2; ++i) { int R, C; stage_rc(tid * 16 + i * 8192, R, C); const int Rb = Epi::PERM ? ((R & ~31) + perm32(R & 31)) : R;
        voffA[i] = (unsigned)(R * K + C) * 2u; voffB[i] = (unsigned)(Rb * K + C) * 2u; }
    const size_t kstep = (size_t)(BK * 2);
    const size_t hstep = (size_t)HALF * K * 2;
    const size_t tstep = 2 * hstep;
    const unsigned ldsw = (unsigned)wid * 1024u;
    const int aoff = lds_byte(wr * 64 + fr, fq * 8), boff = lds_byte(wc * 32 + fr, fq * 8);
#define PG8_SA(b, h) (((b) * 2 + (h)) * HTB)
#define PG8_SB(b, h) ((4 + (b) * 2 + (h)) * HTB)
#define PG8_STAGE(bufoff, gbase, voff) do { _Pragma("unroll") for (int _i = 0; _i < 2; ++_i) \
        __builtin_amdgcn_global_load_lds((const unsigned*)((const char*)(gbase) + (voff)[_i]), (PG8_LAS unsigned*)(lds + (bufoff) + ldsw + _i * 8192), 16, 0, 0); } while (0)
#define PG8_LDA(dst, b, h) do { _Pragma("unroll") for (int m = 0; m < 4; ++m) _Pragma("unroll") for (int k = 0; k < 2; ++k) dst[m][k] = *(const PG8_LAS bf16x8*)(lds + PG8_SA(b, h) + aoff + m * 2048 + k * 1024); } while (0)
#define PG8_LDB(dst, b, h) do { _Pragma("unroll") for (int n = 0; n < 2; ++n) _Pragma("unroll") for (int k = 0; k < 2; ++k) dst[n][k] = *(const PG8_LAS bf16x8*)(lds + PG8_SB(b, h) + boff + n * 2048 + k * 1024); } while (0)
#define PG8_MMA(ai, bj, At, Bt) do { __builtin_amdgcn_s_setprio(1); _Pragma("unroll") for (int m = 0; m < 4; ++m) _Pragma("unroll") for (int n = 0; n < 2; ++n) _Pragma("unroll") for (int k = 0; k < 2; ++k) \
        acc[ai][bj][m][n] = NAT ? __builtin_amdgcn_mfma_f32_16x16x32_bf16(At[m][k], Bt[n][k], acc[ai][bj][m][n], 0, 0, 0) : __builtin_amdgcn_mfma_f32_16x16x32_bf16(Bt[n][k], At[m][k], acc[ai][bj][m][n], 0, 0, 0); __builtin_amdgcn_s_setprio(0); } while (0)
#define PG8_WAIT_V(n) asm volatile("s_waitcnt vmcnt(" #n ")" ::: "memory")
#define PG8_WAIT_L(n) asm volatile("s_waitcnt lgkmcnt(" #n ")" ::: "memory")
#define PG8_BAR __builtin_amdgcn_s_barrier()
#define PG8_SCHED __builtin_amdgcn_sched_barrier(0)
    Unit cur, nxt; int ui = 0;
    if (!S.next(0, cur)) return;
    f32x4 acc[2][2][4][2];
#pragma unroll
    for (int a = 0; a < 2; ++a)
#pragma unroll
        for (int b = 0; b < 2; ++b)
#pragma unroll
            for (int m = 0; m < 4; ++m)
#pragma unroll
                for (int n = 0; n < 2; ++n) acc[a][b][m][n] = (f32x4){0.f, 0.f, 0.f, 0.f};
    bf16x8 At[4][2], B0[2][2], B1[2][2];
    const char* cA = (const char*)g.A + (size_t)cur.pm * tstep; const char* cB = (const char*)g.Bt + (size_t)cur.pn * tstep;
    S.a_ready(cur);
    if constexpr (SP2) {
        PG8_STAGE(PG8_SB(0, 0), cB, voffB); PG8_STAGE(PG8_SB(0, 1), cB + hstep, voffB); PG8_STAGE(PG8_SA(0, 0), cA, voffA); PG8_STAGE(PG8_SA(0, 1), cA + hstep, voffA);
        if (wr == 1) PG8_BAR;
        PG8_WAIT_V(2); PG8_BAR;
        PG8_STAGE(PG8_SB(1, 0), cB + kstep, voffB); PG8_STAGE(PG8_SA(1, 0), cA + kstep, voffA); PG8_STAGE(PG8_SB(1, 1), cB + hstep + kstep, voffB);
        PG8_WAIT_V(6); PG8_BAR;
    } else {
        PG8_STAGE(PG8_SB(0, 0), cB, voffB); PG8_STAGE(PG8_SA(0, 0), cA, voffA); PG8_STAGE(PG8_SB(0, 1), cB + hstep, voffB); PG8_STAGE(PG8_SA(0, 1), cA + hstep, voffA);
        if (wr == 1) PG8_BAR;
        PG8_WAIT_V(4); PG8_BAR;
        PG8_STAGE(PG8_SB(1, 0), cB + kstep, voffB); PG8_STAGE(PG8_SA(1, 0), cA + kstep, voffA); PG8_STAGE(PG8_SB(1, 1), cB + hstep + kstep, voffB);
        PG8_WAIT_V(6); PG8_BAR;
    }
    for (;;) {
        const bool has_next = S.next(ui + 1, nxt);
        const char* nA = has_next ? (const char*)g.A + (size_t)nxt.pm * tstep : cA; const char* nB = has_next ? (const char*)g.Bt + (size_t)nxt.pn * tstep : cB;
        for (int t = 0; t < nt; t += 2) {
            const bool last = (t == nt - 2);
            const char* a1 = cA + (size_t)(t + 1) * kstep;
            const char* a2 = last ? nA : cA + (size_t)(t + 2) * kstep; const char* b2 = last ? nB : cB + (size_t)(t + 2) * kstep;
            const char* a3 = a2 + kstep; const char* b3 = b2 + kstep;
            if (last && has_next) S.a_ready(nxt);
            if constexpr (SP2) {
            PG8_LDB(B0, 0, 0); PG8_LDB(B1, 0, 1); PG8_SCHED; PG8_LDA(At, 0, 0); PG8_STAGE(PG8_SA(1, 1), a1 + hstep, voffA);
            PG8_WAIT_V(8); PG8_WAIT_L(0); PG8_BAR; PG8_MMA(0, 0, At, B0); PG8_MMA(0, 1, At, B1); PG8_BAR; PG8_SCHED;
            PG8_LDA(At, 0, 1); PG8_STAGE(PG8_SB(0, 0), b2, voffB); PG8_STAGE(PG8_SB(0, 1), b2 + hstep, voffB); PG8_STAGE(PG8_SA(0, 0), a2, voffA);
            PG8_WAIT_V(8); PG8_WAIT_L(0); PG8_BAR; PG8_MMA(1, 0, At, B0); PG8_MMA(1, 1, At, B1); PG8_BAR; PG8_SCHED;
            PG8_LDB(B0, 1, 0); PG8_LDB(B1, 1, 1); PG8_SCHED; PG8_LDA(At, 1, 0); PG8_STAGE(PG8_SA(0, 1), a2 + hstep, voffA);
            PG8_WAIT_V(8); PG8_WAIT_L(0); PG8_BAR; PG8_MMA(0, 0, At, B0); PG8_MMA(0, 1, At, B1); PG8_BAR; PG8_SCHED;
            PG8_LDA(At, 1, 1); PG8_STAGE(PG8_SB(1, 0), b3, voffB); PG8_STAGE(PG8_SB(1, 1), b3 + hstep, voffB); PG8_STAGE(PG8_SA(1, 0), a3, voffA);
            PG8_WAIT_V(8); PG8_WAIT_L(0); PG8_BAR; PG8_MMA(1, 0, At, B0); PG8_MMA(1, 1, At, B1); PG8_BAR; PG8_SCHED;
            } else {
            PG8_LDB(B0, 0, 0); PG8_SCHED; PG8_LDA(At, 0, 0); PG8_STAGE(PG8_SA(1, 1), a1 + hstep, voffA);
            PG8_WAIT_L(8); PG8_BAR; PG8_WAIT_L(0); PG8_MMA(0, 0, At, B0); PG8_BAR; PG8_SCHED;
            PG8_LDB(B1, 0, 1); PG8_STAGE(PG8_SB(0, 0), b2, voffB);
            PG8_BAR; PG8_WAIT_L(0); PG8_MMA(0, 1, At, B1); PG8_BAR;
            PG8_LDA(At, 0, 1); PG8_STAGE(PG8_SA(0, 0), a2, voffA);
            PG8_BAR; PG8_WAIT_L(0); PG8_MMA(1, 0, At, B0); PG8_BAR; PG8_SCHED;
            PG8_STAGE(PG8_SB(0, 1), b2 + hstep, voffB);
            PG8_WAIT_V(6); PG8_BAR; PG8_MMA(1, 1, At, B1); PG8_BAR;
            PG8_LDB(B0, 1, 0); PG8_SCHED; PG8_LDA(At, 1, 0); PG8_STAGE(PG8_SA(0, 1), a2 + hstep, voffA);
            PG8_WAIT_L(8); PG8_BAR; PG8_WAIT_L(0); PG8_MMA(0, 0, At, B0); PG8_BAR; PG8_SCHED;
            PG8_LDB(B1, 1, 1); PG8_STAGE(PG8_SB(1, 0), b3, voffB);
            PG8_BAR; PG8_WAIT_L(0); PG8_MMA(0, 1, At, B1); PG8_BAR;
            PG8_LDA(At, 1, 1); PG8_STAGE(PG8_SA(1, 0), a3, voffA);
            PG8_BAR; PG8_WAIT_L(0); PG8_MMA(1, 0, At, B0); PG8_BAR; PG8_SCHED;
            PG8_STAGE(PG8_SB(1, 1), b3 + hstep, voffB);
            PG8_WAIT_V(6); PG8_BAR; PG8_MMA(1, 1, At, B1); PG8_BAR;
            }
        }
        if constexpr (ALIGN_EPI) { if (wr == 0) PG8_BAR; }
        if constexpr (!Epi::AFTER_DRAIN) { E(acc, cur, wr, wc, fr, fq); S.done(cur); }
        if (!has_next) break;
#pragma unroll
        for (int a = 0; a < 2; ++a)
#pragma unroll
            for (int b = 0; b < 2; ++b)
#pragma unroll
                for (int m = 0; m < 4; ++m)
#pragma unroll
                    for (int n = 0; n < 2; ++n) acc[a][b][m][n] = (f32x4){0.f, 0.f, 0.f, 0.f};
        cur = nxt; cA = nA; cB = nB; ++ui;
        if constexpr (ALIGN_EPI) { if (wr == 1) PG8_BAR; }
    }
    PG8_WAIT_V(0);
    if constexpr (!ALIGN_EPI) { if (wr == 0) PG8_BAR; }
    PG8_BAR;
    if constexpr (Epi::AFTER_DRAIN) { E.fused(acc, cur, wr, wc, fr, fq, lds, wid, lane); S.done(cur); }
#undef PG8_SA
#undef PG8_SB
#undef PG8_STAGE
#undef PG8_LDA
#undef PG8_LDB
#undef PG8_MMA
#undef PG8_WAIT_V
#undef PG8_WAIT_L
#undef PG8_BAR
#undef PG8_SCHED
}
}

constexpr int T_TOK = 32768;
constexpr int SEQ = 4096;
constexpr float LOG2E = 1.4426950408889634f;
constexpr float FOX_QS = 0.125f * 1.4426950408889634f;
constexpr float MLA_QS = 0.10206207261596575f * 1.4426950408889634f;
constexpr float EPS = 1e-6f;

constexpr size_t W_IN = 0, W_GATE = 4063232, W_UQ = 7208960, W_UKV = 7503872, W_OF = 7766016, W_OM = 8290304, W_OS = 8814592,
                 W_OUT = 9338880, W_FGU = 10387456, W_FD = 16154624, W_LAYER = 19038208;

constexpr int SMEM_BYTES = 2 * 74752 + 64 + 16;

struct Params {
    const float* x; const float* c; const int* pos;
    const float* g_mix; const float* w_ada; const float* b_ada; const float* w_in; const float* b_fox_f;
    const float* g_mla_q; const float* w_mla_uq; const float* g_mla_kv; const float* w_mla_ukv;
    const float* w_o_fox; const float* w_o_mla; const float* w_o_sb; const float* w_out;
    const float* g_ffn; const float* w_ffn_gate; const float* w_ffn_up; const float* w_ffn_down; const float* g_final;
    float* out;
    bf16_t* wt; float* mod; float* ropetab; float* logf; float* cum;
    bf16_t* u; bf16_t* qf; bf16_t* kf; bf16_t* vtf; bf16_t* qs; bf16_t* ks; bf16_t* vts;
    bf16_t* ql; bf16_t* kvl; bf16_t* kr; bf16_t* qn; bf16_t* qr; bf16_t* kn; bf16_t* vtm;
    bf16_t* merged; bf16_t* h;
    unsigned* bar; float* kmax;
    bf16_t* gs0; bf16_t* gs1; bf16_t* gs2;
};
typedef const __attribute__((address_space(4))) Params* KargPtr;
#if defined(__HIP_DEVICE_COMPILE__)
__device__ __forceinline__ KargPtr karg() { KargPtr pp = (KargPtr)__builtin_amdgcn_kernarg_segment_ptr(); asm volatile("" : "+s"(pp)); return pp; }
#else
__device__ __forceinline__ KargPtr karg() { return nullptr; }
#endif

__device__ double ROPE_POLY[11] = {-1.0 / 6, 1.0 / 120, -1.0 / 5040, 1.0 / 362880, -1.0 / 39916800,
    -0.5, 1.0 / 24, -1.0 / 720, 1.0 / 40320, -1.0 / 3628800, 1.0 / 479001600};
__device__ const float ROPE_INV[16] = {1.0f, 0.5623413324356079f, 0.3162277638912201f, 0.17782793939113617f, 0.10000000149011612f, 0.05623413249850273f,
    0.03162277489900589f, 0.017782794311642647f, 0.009999999776482582f, 0.005623413249850273f, 0.003162277629598975f, 0.0017782794311642647f,
    0.0010000000474974513f, 0.000562341301701963f, 0.0003162277571391314f, 0.00017782794020604342f};

typedef __bf16 bf16x2_t __attribute__((ext_vector_type(2)));
typedef float f32x2_t __attribute__((ext_vector_type(2)));
DI unsigned pack_bf16(float lo, float hi) { const f32x2_t v = {lo, hi}; const bf16x2_t b = __builtin_convertvector(v, bf16x2_t); return __builtin_bit_cast(unsigned, b); }
DI bf16_t f2bf(float x) { return (bf16_t)(pack_bf16(x, 0.f) & 0xffffu); }
DI int vhalf() { return __builtin_amdgcn_readfirstlane((int)(threadIdx.x >> 8)); }
DI int tidx() { int t = threadIdx.x & 255; asm volatile("" : "+v"(t)); return t; }
DI int bidx() { int t = __builtin_amdgcn_readfirstlane((int)(blockIdx.x * 2 + (threadIdx.x >> 8))); asm volatile("" : "+s"(t)); return t; }
DI int gdim() { int t = gridDim.x * 2; asm volatile("" : "+s"(t)); return t; }
constexpr int VSMEM = 74752;
constexpr int FLAGS_OFF = 2 * VSMEM;
DI float fexp2(float x) { return __builtin_amdgcn_exp2f(x); }
DI float flog2(float x) { return __builtin_amdgcn_logf(x); }
DI float frcp(float x) { return __builtin_amdgcn_rcpf(x); }
DI float sigmoidf_(float x) { return frcp(1.0f + fexp2(-x * LOG2E)); }

DI bool next_tile(int it, int MT, int NT, int& mt, int& nt) {
    const int perx = gdim() >> 3, xcd = bidx() & 7, slot = bidx() >> 3;
    const long L = ((long)it * 8 + xcd) * perx + slot;
    if (L >= (long)MT * NT) return false;
    const int gsz = 8 * NT; const int grp = (int)(L / gsz), wi = (int)(L % gsz);
    mt = grp * 8 + (wi & 7); nt = wi >> 3; return true;
}

template <int BK>
DI void gemm_mainloop(const bf16_t* A, int lda, const bf16_t* B, int ldb, int K, f32x16 (&acc)[2][2], unsigned char* smem) {
    constexpr int CPR = BK / 8;
    constexpr int RPP = 256 / CPR;
    constexpr int NJ = 128 / RPP;
    constexpr int ROWB = BK * 2 + 16;
    constexpr int OPB = 128 * ROWB;
    constexpr int STB = 2 * OPB;
    constexpr int PASSB = RPP * ROWB;
    const int tid = tidx(), lane = tid & 63, w = tid >> 6, wm = w >> 1, wn = w & 1, r = lane & 31, hh = lane >> 5;
    const int lrow = tid / CPR, lcol = (tid % CPR) * 8;
    const bf16_t* ap = A + (size_t)lrow * lda + lcol;
    const bf16_t* bp = B + (size_t)lrow * ldb + lcol;
    const size_t astep = (size_t)RPP * lda, bstep = (size_t)RPP * ldb;
    const int st_off = lrow * ROWB + (tid % CPR) * 16;
    u32x4 ra0, ra1, ra2, ra3, rb0, rb1, rb2, rb3;
    ra0 = *(const u32x4*)(ap); rb0 = *(const u32x4*)(bp);
    ra1 = *(const u32x4*)(ap + astep); rb1 = *(const u32x4*)(bp + bstep);
    if constexpr (NJ == 4) { ra2 = *(const u32x4*)(ap + 2 * astep); rb2 = *(const u32x4*)(bp + 2 * bstep); ra3 = *(const u32x4*)(ap + 3 * astep); rb3 = *(const u32x4*)(bp + 3 * bstep); }
    else { ra2 = ra0; ra3 = ra0; rb2 = rb0; rb3 = rb0; }
#define GEMM_STAGE(D_) do { unsigned char* d_ = (D_); \
        *(u32x4*)(d_) = ra0; *(u32x4*)(d_ + OPB) = rb0; *(u32x4*)(d_ + PASSB) = ra1; *(u32x4*)(d_ + OPB + PASSB) = rb1; \
        if constexpr (NJ == 4) { *(u32x4*)(d_ + 2 * PASSB) = ra2; *(u32x4*)(d_ + OPB + 2 * PASSB) = rb2; *(u32x4*)(d_ + 3 * PASSB) = ra3; *(u32x4*)(d_ + OPB + 3 * PASSB) = rb3; } } while (0)
    GEMM_STAGE(smem + st_off);
    __syncthreads();
    const int nk = K / BK;
    const int rdA = (wm * 64 + r) * ROWB + hh * 16;
    const int rdB = OPB + (wn * 64 + r) * ROWB + hh * 16;
#define GEMM_FRAGS(KS_, A0_, A1_, B0_, B1_) do { \
        A0_ = *(const bf16x8*)(sa + (KS_) * 32); A1_ = *(const bf16x8*)(sa + 32 * ROWB + (KS_) * 32); \
        B0_ = *(const bf16x8*)(sb + (KS_) * 32); B1_ = *(const bf16x8*)(sb + 32 * ROWB + (KS_) * 32); } while (0)
#define GEMM_MFMA4(A0_, A1_, B0_, B1_) do { \
        acc[0][0] = MFMA(A0_, B0_, acc[0][0]); acc[0][1] = MFMA(A0_, B1_, acc[0][1]); \
        acc[1][0] = MFMA(A1_, B0_, acc[1][0]); acc[1][1] = MFMA(A1_, B1_, acc[1][1]); } while (0)
#define GEMM_COMPUTE(BUF_) do { \
        const unsigned char* sa = smem + (BUF_) * STB + rdA; \
        const unsigned char* sb = smem + (BUF_) * STB + rdB; \
        bf16x8 fa0, fa1, fb0, fb1, ga0, ga1, gb0, gb1; \
        GEMM_FRAGS(0, fa0, fa1, fb0, fb1); \
        GEMM_FRAGS(1, ga0, ga1, gb0, gb1); \
        __builtin_amdgcn_sched_barrier(0); \
        GEMM_MFMA4(fa0, fa1, fb0, fb1); \
        if constexpr (BK == 64) { \
            __builtin_amdgcn_sched_barrier(0); \
            GEMM_FRAGS(2, fa0, fa1, fb0, fb1); \
            __builtin_amdgcn_sched_barrier(0); \
            GEMM_MFMA4(ga0, ga1, gb0, gb1); \
            __builtin_amdgcn_sched_barrier(0); \
            GEMM_FRAGS(3, ga0, ga1, gb0, gb1); \
            __builtin_amdgcn_sched_barrier(0); \
            GEMM_MFMA4(fa0, fa1, fb0, fb1); \
        } \
        __builtin_amdgcn_sched_barrier(0); \
        GEMM_MFMA4(ga0, ga1, gb0, gb1); \
    } while (0)
    for (int kt = 0; kt < nk - 1; ++kt) {
        const int buf = kt & 1;
        ap += BK; bp += BK;
        GLOAD16(ra0, ap); GLOAD16(rb0, bp); GLOAD16(ra1, ap + astep); GLOAD16(rb1, bp + bstep);
        if constexpr (NJ == 4) { GLOAD16(ra2, ap + 2 * astep); GLOAD16(rb2, bp + 2 * bstep); GLOAD16(ra3, ap + 3 * astep); GLOAD16(rb3, bp + 3 * bstep); }
        __builtin_amdgcn_sched_barrier(0);
        GEMM_COMPUTE(buf);
        __builtin_amdgcn_sched_barrier(0);
        if constexpr (NJ == 4) asm volatile("s_waitcnt vmcnt(0)" : "+v"(ra0), "+v"(rb0), "+v"(ra1), "+v"(rb1), "+v"(ra2), "+v"(rb2), "+v"(ra3), "+v"(rb3));
        else asm volatile("s_waitcnt vmcnt(0)" : "+v"(ra0), "+v"(rb0), "+v"(ra1), "+v"(rb1));
        GEMM_STAGE(smem + (buf ^ 1) * STB + st_off);
        __syncthreads();
    }
    GEMM_COMPUTE((nk - 1) & 1);
    __syncthreads();
#undef GEMM_COMPUTE
#undef GEMM_MFMA4
#undef GEMM_FRAGS
#undef GEMM_STAGE
}


DI void gemm_big(const bf16_t* P, int ldp, const bf16_t* Q, int ldq, int K, f32x16 (&acc)[2][4], unsigned char* smem) {
    constexpr int ROWB = 80, PB = 128 * ROWB, STB = 384 * ROWB, PASSB = 64 * ROWB;
    const int tid = tidx(), lane = tid & 63, w = tid >> 6, wm = w >> 1, wn = w & 1, r = lane & 31, hh = lane >> 5;
    const int lrow = tid >> 2, lcol = (tid & 3) * 8;
    const bf16_t* pp = P + (size_t)lrow * ldp + lcol;
    const bf16_t* qp = Q + (size_t)lrow * ldq + lcol;
    const size_t pstep = (size_t)64 * ldp, qstep = (size_t)64 * ldq;
    const int st_off = lrow * ROWB + (tid & 3) * 16;
    u32x4 rp0, rp1, rq0, rq1, rq2, rq3;
    rp0 = *(const u32x4*)(pp); rp1 = *(const u32x4*)(pp + pstep);
    rq0 = *(const u32x4*)(qp); rq1 = *(const u32x4*)(qp + qstep); rq2 = *(const u32x4*)(qp + 2 * qstep); rq3 = *(const u32x4*)(qp + 3 * qstep);
#define BIG_STAGE(D_) do { unsigned char* d_ = (D_); \
        *(u32x4*)(d_) = rp0; *(u32x4*)(d_ + PASSB) = rp1; \
        *(u32x4*)(d_ + PB) = rq0; *(u32x4*)(d_ + PB + PASSB) = rq1; *(u32x4*)(d_ + PB + 2 * PASSB) = rq2; *(u32x4*)(d_ + PB + 3 * PASSB) = rq3; } while (0)
    BIG_STAGE(smem + st_off);
    __syncthreads();
    const int nk = K >> 5;
    const int rdP = (wm * 64 + r) * ROWB + hh * 16;
    const int rdQ = PB + (wn * 128 + r) * ROWB + hh * 16;
#define BIG_FRAGS(KS_, A0_, A1_, B0_, B1_, B2_, B3_) do { \
        A0_ = *(const bf16x8*)(sp + (KS_) * 32); A1_ = *(const bf16x8*)(sp + 32 * ROWB + (KS_) * 32); \
        B0_ = *(const bf16x8*)(sq + (KS_) * 32); B1_ = *(const bf16x8*)(sq + 32 * ROWB + (KS_) * 32); \
        B2_ = *(const bf16x8*)(sq + 64 * ROWB + (KS_) * 32); B3_ = *(const bf16x8*)(sq + 96 * ROWB + (KS_) * 32); } while (0)
#define BIG_MFMA8(A0_, A1_, B0_, B1_, B2_, B3_) do { \
        acc[0][0] = MFMA(A0_, B0_, acc[0][0]); acc[0][1] = MFMA(A0_, B1_, acc[0][1]); acc[0][2] = MFMA(A0_, B2_, acc[0][2]); acc[0][3] = MFMA(A0_, B3_, acc[0][3]); \
        acc[1][0] = MFMA(A1_, B0_, acc[1][0]); acc[1][1] = MFMA(A1_, B1_, acc[1][1]); acc[1][2] = MFMA(A1_, B2_, acc[1][2]); acc[1][3] = MFMA(A1_, B3_, acc[1][3]); } while (0)
#define BIG_COMPUTE(BUF_) do { \
        const unsigned char* sp = smem + (BUF_) * STB + rdP; \
        const unsigned char* sq = smem + (BUF_) * STB + rdQ; \
        bf16x8 fa0, fa1, fb0, fb1, fb2, fb3, ga0, ga1, gb0, gb1, gb2, gb3; \
        BIG_FRAGS(0, fa0, fa1, fb0, fb1, fb2, fb3); \
        BIG_FRAGS(1, ga0, ga1, gb0, gb1, gb2, gb3); \
        __builtin_amdgcn_sched_barrier(0); \
        BIG_MFMA8(fa0, fa1, fb0, fb1, fb2, fb3); \
        __builtin_amdgcn_sched_barrier(0); \
        BIG_MFMA8(ga0, ga1, gb0, gb1, gb2, gb3); \
    } while (0)
    for (int kt = 0; kt < nk - 1; ++kt) {
        const int buf = kt & 1;
        pp += 32; qp += 32;
        GLOAD16(rp0, pp); GLOAD16(rq0, qp); GLOAD16(rp1, pp + pstep); GLOAD16(rq1, qp + qstep); GLOAD16(rq2, qp + 2 * qstep); GLOAD16(rq3, qp + 3 * qstep);
        __builtin_amdgcn_sched_barrier(0);
        BIG_COMPUTE(buf);
        __builtin_amdgcn_sched_barrier(0);
        asm volatile("s_waitcnt vmcnt(0)" : "+v"(rp0), "+v"(rp1), "+v"(rq0), "+v"(rq1), "+v"(rq2), "+v"(rq3));
        BIG_STAGE(smem + (buf ^ 1) * STB + st_off);
        __syncthreads();
    }
    BIG_COMPUTE((nk - 1) & 1);
    __syncthreads();
#undef BIG_COMPUTE
#undef BIG_MFMA8
#undef BIG_FRAGS
#undef BIG_STAGE
}
DI void zero_big(f32x16 (&acc)[2][4]) {
#pragma unroll
    for (int a = 0; a < 2; ++a)
#pragma unroll
        for (int b = 0; b < 4; ++b)
#pragma unroll
            for (int i = 0; i < 16; ++i) acc[a][b][i] = 0.f;
}
DI void stage_store_big(const f32x16 (&acc)[2][4], bf16_t* dst, int ld, unsigned char* smem) {
    const int tid = tidx(), lane = tid & 63, w = tid >> 6, wm = w >> 1, wn = w & 1, r = lane & 31, hh = lane >> 5;
#pragma unroll
    for (int qi = 0; qi < 4; ++qi) {
        unsigned char* trow = smem + (wn * 128 + qi * 32 + r) * 272 + (wm * 64 + 4 * hh) * 2;
#pragma unroll
        for (int pi = 0; pi < 2; ++pi)
#pragma unroll
            for (int g = 0; g < 4; ++g) {
                u32x2 pk; pk.x = pack_bf16(acc[pi][qi][4 * g], acc[pi][qi][4 * g + 1]); pk.y = pack_bf16(acc[pi][qi][4 * g + 2], acc[pi][qi][4 * g + 3]);
                *(u32x2*)(trow + (pi * 32 + 8 * g) * 2) = pk;
            }
    }
    __syncthreads();
    const int q0 = tid >> 4, x = tid & 15;
#pragma unroll
    for (int j = 0; j < 16; ++j) {
        const uint4 v = *(const uint4*)(smem + (q0 + 16 * j) * 272 + x * 16);
        *(uint4*)(dst + (size_t)(q0 + 16 * j) * ld + x * 8) = v;
    }
    __syncthreads();
}
DI void scale_big(f32x16 (&acc)[2][4], float sc) {
#pragma unroll
    for (int a = 0; a < 2; ++a)
#pragma unroll
        for (int b = 0; b < 4; ++b)
#pragma unroll
            for (int i = 0; i < 16; ++i) acc[a][b][i] *= sc;
}
DI void scale_big_q(f32x16 (&acc)[2][4], const float* rs, float sc) {
    const int lane = tidx() & 63, wn = (tidx() >> 6) & 1, r = lane & 31;
#pragma unroll
    for (int qi = 0; qi < 4; ++qi) { const float f = rs[wn * 128 + qi * 32 + r] * sc;
#pragma unroll
        for (int pi = 0; pi < 2; ++pi)
#pragma unroll
            for (int i = 0; i < 16; ++i) acc[pi][qi][i] *= f; }
}
DI void scale_big_p(f32x16 (&acc)[2][4], const float* rs) {
    const int lane = tidx() & 63, wm = tidx() >> 7, hh = lane >> 5;
#pragma unroll
    for (int pi = 0; pi < 2; ++pi)
#pragma unroll
        for (int g = 0; g < 4; ++g) { const f32x4 f = *(const f32x4*)(rs + wm * 64 + pi * 32 + 8 * g + 4 * hh);
#pragma unroll
            for (int qi = 0; qi < 4; ++qi)
#pragma unroll
                for (int e = 0; e < 4; ++e) acc[pi][qi][4 * g + e] *= f[e]; }
}
DI long tile_linear(int it, long total) {
    const int perx = gdim() >> 3, xcd = bidx() & 7, slot = bidx() >> 3;
    const long L = ((long)it * 8 + xcd) * perx + slot;
    return L < total ? L : -1;
}
DI void tile_decode(int L, int NT, int& mt, int& nt) { const int gsz = 8 * NT; const int grp = L / gsz, wi = L % gsz; mt = grp * 8 + (wi & 7); nt = wi >> 3; }

DI void zero_acc(f32x16 (&acc)[2][2]) {
#pragma unroll
    for (int a = 0; a < 2; ++a)
#pragma unroll
        for (int b = 0; b < 2; ++b)
#pragma unroll
            for (int i = 0; i < 16; ++i) acc[a][b][i] = 0.f;
}

DI void stage_store_128(const f32x16 (&acc)[2][2], bf16_t* dst, int ld, unsigned char* smem) {
    const int tid = tidx(), lane = tid & 63, w = tid >> 6, wm = w >> 1, wn = w & 1, r = lane & 31, hh = lane >> 5;
#pragma unroll
    for (int qi = 0; qi < 2; ++qi) {
        unsigned char* trow = smem + (wn * 64 + qi * 32 + r) * 272 + (wm * 64 + 4 * hh) * 2;
#pragma unroll
        for (int pi = 0; pi < 2; ++pi)
#pragma unroll
            for (int g = 0; g < 4; ++g) {
                u32x2 pk; pk.x = pack_bf16(acc[pi][qi][4 * g], acc[pi][qi][4 * g + 1]); pk.y = pack_bf16(acc[pi][qi][4 * g + 2], acc[pi][qi][4 * g + 3]);
                *(u32x2*)(trow + (pi * 32 + 8 * g) * 2) = pk;
            }
    }
    __syncthreads();
    const int q0 = tid >> 4, x = tid & 15;
#pragma unroll
    for (int j = 0; j < 8; ++j) {
        const uint4 v = *(const uint4*)(smem + (q0 + 16 * j) * 272 + x * 16);
        *(uint4*)(dst + (size_t)(q0 + 16 * j) * ld + x * 8) = v;
    }
    __syncthreads();
}
DI void stage_store_vt(const f32x16 (&acc)[2][2], bf16_t* vt, int b, int cv0, int s0, unsigned char* smem) {
    const int tid = tidx(), lane = tid & 63, w = tid >> 6, wm = w >> 1, wn = w & 1, r = lane & 31, hh = lane >> 5;
#pragma unroll
    for (int qi = 0; qi < 2; ++qi) {
        unsigned char* trow = smem + (wn * 64 + qi * 32 + r) * 272 + (wm * 64 + 4 * hh) * 2;
#pragma unroll
        for (int pi = 0; pi < 2; ++pi)
#pragma unroll
            for (int g = 0; g < 4; ++g) {
                u32x2 pk; pk.x = pack_bf16(acc[pi][qi][4 * g], acc[pi][qi][4 * g + 1]); pk.y = pack_bf16(acc[pi][qi][4 * g + 2], acc[pi][qi][4 * g + 3]);
                *(u32x2*)(trow + (pi * 32 + 8 * g) * 2) = pk;
            }
    }
    __syncthreads();
    const int q0 = tid >> 4, x = tid & 15;
#pragma unroll
    for (int j = 0; j < 8; ++j) {
        const int cv = cv0 + q0 + 16 * j, sq = s0 + 8 * x;
        const uint4 v = *(const uint4*)(smem + (q0 + 16 * j) * 272 + x * 16);
        *(uint4*)(vt + (size_t)(b * 8 + (cv >> 6)) * SEQ * 64 + (size_t)(sq >> 6) * 4096 + (cv & 63) * 64 + (sq & 63)) = v;
    }
    __syncthreads();
}
DI void scale_acc(f32x16 (&acc)[2][2], float sc) {
#pragma unroll
    for (int a = 0; a < 2; ++a)
#pragma unroll
        for (int b = 0; b < 2; ++b)
#pragma unroll
            for (int i = 0; i < 16; ++i) acc[a][b][i] *= sc;
}
DI void scale_acc_q(f32x16 (&acc)[2][2], const float* rs, float sc) {
    const int lane = tidx() & 63, wn = (tidx() >> 6) & 1, r = lane & 31;
#pragma unroll
    for (int qi = 0; qi < 2; ++qi) { const float f = rs[wn * 64 + qi * 32 + r] * sc;
#pragma unroll
        for (int pi = 0; pi < 2; ++pi)
#pragma unroll
            for (int i = 0; i < 16; ++i) acc[pi][qi][i] *= f; }
}
DI void scale_acc_p(f32x16 (&acc)[2][2], const float* rs) {
    const int lane = tidx() & 63, wm = tidx() >> 7, hh = lane >> 5;
#pragma unroll
    for (int pi = 0; pi < 2; ++pi)
#pragma unroll
        for (int g = 0; g < 4; ++g) { const f32x4 f = *(const f32x4*)(rs + wm * 64 + pi * 32 + 8 * g + 4 * hh);
#pragma unroll
            for (int qi = 0; qi < 2; ++qi)
#pragma unroll
                for (int e = 0; e < 4; ++e) acc[pi][qi][4 * g + e] *= f[e]; }
}

DI int map_col(int map, int n) {
    switch (map) {
    case 1:
        if (n < 1024) return n;
        if (n < 2048) return 2216 + (n - 1024);
        if (n < 2432) return 1544 + (n - 2048);
        if (n < 2688) return 1928 + (n - 2432);
        if (n < 2816) { const int c = n - 2688; if (c < 16) return 2184 + c; if (c < 32) return 2200 + (c - 16); if (c < 40) return 1536 + (c - 32); return -1; }
        if (n < 3328) return 1024 + (n - 2816);
        if (n < 3840) return 3240 + (n - 3328);
        return -1;
    case 2: return 3752 + n;
    case 3:
        if (n < 512) return (n >> 6) * 96 + (n & 63);
        { const int cc = n - 512, tt = cc >> 7, c7 = cc & 127, wn = c7 >> 6, ni = (c7 >> 5) & 1, c = c7 & 31; const int head = tt * 4 + wn * 2 + (c >> 4); return head * 96 + 64 + ni * 16 + (c & 15); }
    case 4:
        if (n < 512) return (n >> 6) * 128 + (n & 63);
        { const int n2 = n - 512; return (n2 >> 6) * 128 + 64 + (n2 & 63); }
    case 5: return (n >> 5) * 16 + (n & 15);
    default: return n;
    }
}

DI void transpose_tile(const float* __restrict__ src, const float* __restrict__ src2, int ld, int K, bf16_t* __restrict__ dst, int map, const float* __restrict__ kscale, int n0, int k0, float* tile) {
    const int tid = tidx(), tx = tid & 63, ty = tid >> 6;
    const int sc = map_col(map, n0 + tx);
    if (map == 5 && (((n0 + tx) >> 4) & 1)) src = src2;
    const int scc = sc < 0 ? 0 : sc;
    const float* sp = src + (size_t)(k0 + ty) * ld + scc;
    float vals[16];
#pragma unroll
    for (int j = 0; j < 16; ++j) vals[j] = sp[(size_t)(4 * j) * ld];
    if (kscale) {
#pragma unroll
        for (int j = 0; j < 16; ++j) vals[j] *= kscale[k0 + ty + 4 * j];
    }
#pragma unroll
    for (int j = 0; j < 16; ++j) tile[(ty + 4 * j) * 65 + tx] = sc < 0 ? 0.f : vals[j];
    __syncthreads();
    const int n = tid >> 2, kq = (tid & 3) * 16;
    unsigned wv[8];
#pragma unroll
    for (int j = 0; j < 8; ++j) wv[j] = pack_bf16(tile[(kq + 2 * j) * 65 + n], tile[(kq + 2 * j + 1) * 65 + n]);
    uint4* d = (uint4*)(dst + (size_t)(n0 + n) * K + k0 + kq);
    d[0] = make_uint4(wv[0], wv[1], wv[2], wv[3]);
    d[1] = make_uint4(wv[4], wv[5], wv[6], wv[7]);
    __syncthreads();
}

DI void phase_prep(KargPtr p, unsigned char* smem) {
    const int tid = tidx();
    float* fs = (float*)smem;
    constexpr int NW = 9296, NMOD = 192, NROPE = 2048;
    for (int item = bidx(); item < NW + NMOD + NROPE; item += gdim()) {
        if (item < NW) {
            const int l = item / 4648; int ti = item % 4648;
            const float* src; const float* src2 = nullptr; int ld, K, Nd, map; size_t doff; const float* ksc = nullptr;
            if (ti < 992)       { src = p->w_in + (size_t)l * 1024 * 6824; ld = 6824; K = 1024; Nd = 3968; doff = W_IN; map = 1; }
            else if (ti < 1760) { ti -= 992;  src = p->w_in + (size_t)l * 1024 * 6824; ld = 6824; K = 1024; Nd = 3072; doff = W_GATE; map = 2; }
            else if (ti < 1832) { ti -= 1760; src = p->w_mla_uq + (size_t)l * 384 * 768; ld = 768; K = 384; Nd = 768; doff = W_UQ; map = 3; ksc = p->g_mla_q + l * 384; }
            else if (ti < 1896) { ti -= 1832; src = p->w_mla_ukv + (size_t)l * 256 * 1024; ld = 1024; K = 256; Nd = 1024; doff = W_UKV; map = 4; ksc = p->g_mla_kv + l * 256; }
            else if (ti < 2024) { ti -= 1896; src = p->w_o_fox + (size_t)l * 512 * 1024; ld = 1024; K = 512; Nd = 1024; doff = W_OF; map = 0; }
            else if (ti < 2152) { ti -= 2024; src = p->w_o_mla + (size_t)l * 512 * 1024; ld = 1024; K = 512; Nd = 1024; doff = W_OM; map = 0; }
            else if (ti < 2280) { ti -= 2152; src = p->w_o_sb + (size_t)l * 512 * 1024; ld = 1024; K = 512; Nd = 1024; doff = W_OS; map = 0; }
            else if (ti < 2536) { ti -= 2280; src = p->w_out + (size_t)l * 1024 * 1024; ld = 1024; K = 1024; Nd = 1024; doff = W_OUT; map = 0; }
            else if (ti < 3944) { ti -= 2536; src = p->w_ffn_gate + (size_t)l * 1024 * 2816; src2 = p->w_ffn_up + (size_t)l * 1024 * 2816; ld = 2816; K = 1024; Nd = 5632; doff = W_FGU; map = 5; }
            else                { ti -= 3944; src = p->w_ffn_down + (size_t)l * 2816 * 1024; ld = 1024; K = 2816; Nd = 1024; doff = W_FD; map = 0; }
            (void)Nd;
            const int kts = K >> 6; const int ntile = ti / kts, ktile = ti % kts;
            transpose_tile(src, src2, ld, K, p->wt + (size_t)l * W_LAYER + doff, map, ksc, ntile * 64, ktile * 64, fs);
        } else if (item < NW + NMOD) {
            const int mi = item - NW; const int l = mi / 96, c0 = (mi % 96) * 64;
            float* cond = fs;
            float* red = fs + 8192;
            for (int e = tid; e < 8192; e += 256) { const float cv = p->c[e]; cond[e] = cv * sigmoidf_(cv); }
            __syncthreads();
            const int tx = tid & 63, ty = tid >> 6;
            float a0 = 0, a1 = 0, a2 = 0, a3 = 0, a4 = 0, a5 = 0, a6 = 0, a7 = 0;
            const float* wsrc = p->w_ada + (size_t)l * 1024 * 6144 + c0 + tx;
#pragma unroll 8
            for (int k = ty * 256; k < ty * 256 + 256; ++k) {
                const float wv = wsrc[(size_t)k * 6144];
                a0 += cond[k] * wv; a1 += cond[1024 + k] * wv; a2 += cond[2048 + k] * wv; a3 += cond[3072 + k] * wv;
                a4 += cond[4096 + k] * wv; a5 += cond[5120 + k] * wv; a6 += cond[6144 + k] * wv; a7 += cond[7168 + k] * wv;
            }
            float* rr = red + ty * 512 + tx;
            rr[0] = a0; rr[64] = a1; rr[128] = a2; rr[192] = a3; rr[256] = a4; rr[320] = a5; rr[384] = a6; rr[448] = a7;
            __syncthreads();
            for (int o = tid; o < 512; o += 256) {
                const int b = o >> 6, xx = o & 63;
                const float s = red[o] + red[512 + o] + red[1024 + o] + red[1536 + o] + p->b_ada[l * 6144 + c0 + xx];
                p->mod[(size_t)(l * 8 + b) * 6144 + c0 + xx] = s;
            }
            __syncthreads();
        } else {
            const int e = (item - NW - NMOD) * 256 + tid;
            const int i = e & 15, tok = e >> 4;
            const float ang = (float)p->pos[tok] * ROPE_INV[i];
            const double a = (double)ang;
            const double kq = rint(a * 0.63661977236758134308);
            const double rr = fma(-kq, 1.57079632679489661923, a);
            const double r2 = rr * rr;
            const double* C = ROPE_POLY;
            const double sn = rr * (1.0 + r2 * (C[0] + r2 * (C[1] + r2 * (C[2] + r2 * (C[3] + r2 * C[4])))));
            const double cs = 1.0 + r2 * (C[5] + r2 * (C[6] + r2 * (C[7] + r2 * (C[8] + r2 * (C[9] + r2 * C[10])))));
            const int q = ((int)(long long)kq) & 3;
            const double co = (q == 0) ? cs : (q == 1) ? -sn : (q == 2) ? -cs : sn;
            const double si = (q == 0) ? sn : (q == 1) ? cs : (q == 2) ? -sn : -cs;
            p->ropetab[2 * (size_t)e] = (float)co; p->ropetab[2 * (size_t)e + 1] = (float)si;
        }
    }
}

DI float wave_sum(float v) {
#pragma unroll
    for (int o = 32; o >= 1; o >>= 1) v += __shfl_xor(v, o);
    return v;
}
DI void phase_norm(const float* __restrict__ xin, const float* __restrict__ g, const float* __restrict__ modl, int sh_idx, int sc_idx, bf16_t* __restrict__ uout) {
    const int lane = tidx() & 63, w = tidx() >> 6;
    for (int row = bidx() * 4 + w; row < T_TOK; row += gdim() * 4) {
        const int b = row >> 12;
        const f32x4* xr = (const f32x4*)(xin + (size_t)row * 1024);
        f32x4 v[4]; float ss = 0.f;
#pragma unroll
        for (int j = 0; j < 4; ++j) { v[j] = xr[lane + 64 * j]; ss += v[j][0] * v[j][0] + v[j][1] * v[j][1] + v[j][2] * v[j][2] + v[j][3] * v[j][3]; }
        ss = wave_sum(ss);
        const float rstd = rsqrtf(ss * (1.0f / 1024.0f) + EPS);
        const float* mb = modl + (size_t)b * 6144;
#pragma unroll
        for (int j = 0; j < 4; ++j) {
            const int col = 4 * (lane + 64 * j);
            const f32x4 g4 = *(const f32x4*)(g + col), sc4 = *(const f32x4*)(mb + sc_idx * 1024 + col), sh4 = *(const f32x4*)(mb + sh_idx * 1024 + col);
            float y[4];
#pragma unroll
            for (int e = 0; e < 4; ++e) y[e] = (v[j][e] * rstd) * g4[e] * (1.0f + sc4[e]) + sh4[e];
            u32x2 pk; pk.x = pack_bf16(y[0], y[1]); pk.y = pack_bf16(y[2], y[3]);
            *(u32x2*)(uout + (size_t)row * 1024 + col) = pk;
        }
    }
}
DI void phase_final(KargPtr p) {
    const int lane = tidx() & 63, w = tidx() >> 6;
    for (int row = bidx() * 4 + w; row < T_TOK; row += gdim() * 4) {
        f32x4* xr = (f32x4*)(p->out + (size_t)row * 1024);
        f32x4 v[4]; float ss = 0.f;
#pragma unroll
        for (int j = 0; j < 4; ++j) { v[j] = xr[lane + 64 * j]; ss += v[j][0] * v[j][0] + v[j][1] * v[j][1] + v[j][2] * v[j][2] + v[j][3] * v[j][3]; }
        ss = wave_sum(ss);
        const float rstd = rsqrtf(ss * (1.0f / 1024.0f) + EPS);
#pragma unroll
        for (int j = 0; j < 4; ++j) {
            const f32x4 g4 = *(const f32x4*)(p->g_final + 4 * (lane + 64 * j));
            f32x4 o;
#pragma unroll
            for (int e = 0; e < 4; ++e) o[e] = (v[j][e] * rstd) * g4[e];
            xr[lane + 64 * j] = o;
        }
    }
}

struct EpiInprojA {
    static constexpr bool PERM = false, AFTER_DRAIN = false;
    bf16_t* qf; bf16_t* kf; bf16_t* qs; bf16_t* ks; bf16_t* ql; bf16_t* kvl; bf16_t* kr; float* logf; const float* ropetab; const float* bfox;
    __device__ __forceinline__ void operator()(const pg8::f32x4 (&acc)[2][2][4][2], const pg8::Unit& u, int wr, int wc, int fr, int fq) const {
        const int row0 = u.pm * 256 + wr * 64 + fr;
        const int cw = wc * 32 + fq * 4;
#pragma unroll
        for (int bj = 0; bj < 2; ++bj) {
            bf16_t* dst; int ld; float sc = 1.0f; bool special = false;
            if (u.pn < 8) { const int region = u.pn >> 1; dst = (region == 0 ? qf : region == 1 ? kf : region == 2 ? qs : ks) + (u.pn & 1) * 256 + bj * 128; ld = 512; if (region == 0 || region == 2) sc = FOX_QS; }
            else if (u.pn == 8) { dst = ql + bj * 128; ld = 384; }
            else if (u.pn == 9) { if (bj == 0) { dst = ql + 256; ld = 384; } else { dst = kvl; ld = 256; } }
            else { dst = kvl + 128; ld = 256; special = (bj == 1); }
            if (!special) {
#pragma unroll
                for (int ai = 0; ai < 2; ++ai)
#pragma unroll
                    for (int m = 0; m < 4; ++m) {
                        bf16_t* rowp = dst + (size_t)(row0 + ai * 128 + m * 16) * ld + cw;
#pragma unroll
                        for (int n = 0; n < 2; ++n) { const pg8::f32x4 v = acc[ai][bj][m][n] * sc; u32x2 pk; pk.x = pack_bf16(v[0], v[1]); pk.y = pack_bf16(v[2], v[3]); *(u32x2*)(rowp + n * 16) = pk; }
                    }
            } else if (wc == 0) {
#pragma unroll
                for (int ai = 0; ai < 2; ++ai)
#pragma unroll
                    for (int m = 0; m < 4; ++m) {
                        const int t = row0 + ai * 128 + m * 16;
                        const pg8::f32x4 x1 = acc[ai][1][m][0], x2 = acc[ai][1][m][1];
                        const pg8::f32x4 ca = *(const pg8::f32x4*)(ropetab + 2 * (t * 16 + fq * 4)), cb = *(const pg8::f32x4*)(ropetab + 2 * (t * 16 + fq * 4) + 4);
                        const float co[4] = {ca[0], ca[2], cb[0], cb[2]}, si[4] = {ca[1], ca[3], cb[1], cb[3]};
                        float o1[4], o2[4];
#pragma unroll
                        for (int j = 0; j < 4; ++j) { o1[j] = x1[j] * co[j] - x2[j] * si[j]; o2[j] = x1[j] * si[j] + x2[j] * co[j]; }
                        u32x2 p1, p2; p1.x = pack_bf16(o1[0], o1[1]); p1.y = pack_bf16(o1[2], o1[3]); p2.x = pack_bf16(o2[0], o2[1]); p2.y = pack_bf16(o2[2], o2[3]);
                        *(u32x2*)(kr + (size_t)t * 32 + fq * 4) = p1;
                        *(u32x2*)(kr + (size_t)t * 32 + 16 + fq * 4) = p2;
                    }
            } else if (wc == 1 && fq < 2) {
#pragma unroll
                for (int ai = 0; ai < 2; ++ai)
#pragma unroll
                    for (int m = 0; m < 4; ++m) {
                        const int t = row0 + ai * 128 + m * 16, b = t >> 12, sq = t & 4095;
#pragma unroll
                        for (int j = 0; j < 4; ++j) {
                            const int head = fq * 4 + j;
                            const float f = acc[ai][1][m][0][j] + bfox[head];
                            logf[(size_t)(b * 8 + head) * SEQ + sq] = fminf(f, 0.f) - log1pf(expf(-fabsf(f)));
                        }
                    }
            }
        }
    }
};
struct EpiInprojV {
    static constexpr bool PERM = false, AFTER_DRAIN = false;
    bf16_t* vtf; bf16_t* vts;
    __device__ __forceinline__ void operator()(const pg8::f32x4 (&acc)[2][2][4][2], const pg8::Unit& u, int wr, int wc, int fr, int fq) const {
        bf16_t* vt = u.pn < 2 ? vtf : vts;
        const int row0 = u.pm * 256 + wr * 64 + fq * 4, b = row0 >> 12, s0 = row0 & 4095;
        const int cv0 = (u.pn & 1) * 256 + wc * 32 + fr;
#pragma unroll
        for (int bj = 0; bj < 2; ++bj)
#pragma unroll
            for (int n = 0; n < 2; ++n) {
                const int cv = cv0 + bj * 128 + n * 16;
                bf16_t* vp = vt + (size_t)(b * 8 + (cv >> 6)) * SEQ * 64 + (cv & 63) * 64;
#pragma unroll
                for (int ai = 0; ai < 2; ++ai)
#pragma unroll
                    for (int m = 0; m < 4; ++m) { const int sq = s0 + ai * 128 + m * 16; const pg8::f32x4 v = acc[ai][bj][m][n]; u32x2 pk; pk.x = pack_bf16(v[0], v[1]); pk.y = pack_bf16(v[2], v[3]);
                        *(u32x2*)(vp + (size_t)(sq >> 6) * 4096 + (sq & 63)) = pk; }
            }
    }
};
struct EpiFfnUp {
    static constexpr bool PERM = false, AFTER_DRAIN = false;
    bf16_t* h;
    __device__ __forceinline__ void operator()(const pg8::f32x4 (&acc)[2][2][4][2], const pg8::Unit& u, int wr, int wc, int fr, int fq) const {
        const int row0 = u.pm * 256 + wr * 64 + fr;
#pragma unroll
        for (int ai = 0; ai < 2; ++ai)
#pragma unroll
            for (int m = 0; m < 4; ++m) {
                bf16_t* rowp = h + (size_t)(row0 + ai * 128 + m * 16) * 2816 + u.pn * 128 + wc * 16 + fq * 4;
#pragma unroll
                for (int bj = 0; bj < 2; ++bj) {
                    const pg8::f32x4 g = acc[ai][bj][m][0], up = acc[ai][bj][m][1];
                    float hv[4];
#pragma unroll
                    for (int j = 0; j < 4; ++j) hv[j] = g[j] * sigmoidf_(g[j]) * up[j];
                    u32x2 pk; pk.x = pack_bf16(hv[0], hv[1]); pk.y = pack_bf16(hv[2], hv[3]);
                    *(u32x2*)(rowp + bj * 64) = pk;
                }
            }
    }
};
struct EpiResidual {
    static constexpr bool PERM = false, AFTER_DRAIN = false;
    const float* xin; float* xout; const float* modl; int gidx;
    __device__ __forceinline__ void operator()(const pg8::f32x4 (&acc)[2][2][4][2], const pg8::Unit& u, int wr, int wc, int fr, int fq) const {
        const int row0 = u.pm * 256 + wr * 64 + fr, b = row0 >> 12;
        const float* gt = modl + (size_t)b * 6144 + gidx * 1024;
#pragma unroll
        for (int bj = 0; bj < 2; ++bj)
#pragma unroll
            for (int n = 0; n < 2; ++n) {
                const int col = u.pn * 256 + bj * 128 + wc * 32 + n * 16 + fq * 4;
                const pg8::f32x4 g4 = *(const pg8::f32x4*)(gt + col);
                pg8::f32x4 xv[2][4];
#pragma unroll
                for (int ai = 0; ai < 2; ++ai)
#pragma unroll
                    for (int m = 0; m < 4; ++m) xv[ai][m] = *(const pg8::f32x4*)(xin + (size_t)(row0 + ai * 128 + m * 16) * 1024 + col);
#pragma unroll
                for (int ai = 0; ai < 2; ++ai)
#pragma unroll
                    for (int m = 0; m < 4; ++m) *(pg8::f32x4*)(xout + (size_t)(row0 + ai * 128 + m * 16) * 1024 + col) = xv[ai][m] + g4 * acc[ai][bj][m][n];
            }
    }
};
template <class Epi, bool NAT = false>
DI void big_gemm(const bf16_t* A, const bf16_t* Bt, int N, int K, const Epi& E, unsigned char* smem) {
    __syncthreads();
    pg8::StaticOrder S; S.init(T_TOK, N, (int)gridDim.x, (int)blockIdx.x);
    pg8::Gemm g; g.A = A; g.Bt = Bt; g.M = T_TOK; g.N = N; g.K = K;
    pg8::gemm_phase<Epi, pg8::StaticOrder, true, true, NAT>((PG8_LAS unsigned char*)smem, g, S, E);
    __syncthreads();
}

DI void phase_inproj(KargPtr p, int l, unsigned char* smem_phys) {
    const bf16_t* W = p->wt + (size_t)l * W_LAYER + W_IN;
    { EpiInprojA E; E.qf = p->qf; E.kf = p->kf; E.qs = p->qs; E.ks = p->ks; E.ql = p->ql; E.kvl = p->kvl; E.kr = p->kr; E.logf = p->logf; E.ropetab = p->ropetab; E.bfox = p->b_fox_f + l * 8;
      big_gemm<EpiInprojA, false>(p->u, W, 2816, 1024, E, smem_phys); }
    { EpiInprojV E; E.vtf = p->vtf; E.vts = p->vts;
      big_gemm<EpiInprojV, true>(p->u, W + (size_t)2816 * 1024, 1024, 1024, E, smem_phys); }
}

DI void phase_mla_up(KargPtr p, int l, unsigned char* smem) {
    const int tid = tidx(), lane = tid & 63, w = tid >> 6, wm = w >> 1, wn = w & 1, r = lane & 31, hh = lane >> 5;
    float* rs = (float*)(smem + 73728);
    const bf16_t* WQ = p->wt + (size_t)l * W_LAYER + W_UQ;
    const bf16_t* WKV = p->wt + (size_t)l * W_LAYER + W_UKV;
    for (int it = 0;; ++it) {
        const int L = it * gdim() + bidx(); if (L >= 3584) break;
        int mt, nt; if (L < 1536) { mt = L / 6; nt = L % 6; } else { mt = (L - 1536) >> 3; nt = 6 + ((L - 1536) & 7); }
        const int m0 = mt * 128, b = m0 >> 12, s0 = m0 & 4095;
        const bool isq = nt < 6;
        const int K = isq ? 384 : 256;
        const bf16_t* A = (isq ? p->ql : p->kvl) + (size_t)m0 * K;
        __syncthreads();
        {
            const int row = tid >> 1, half = tid & 1; const int hk = K >> 1;
            const uint4* ar = (const uint4*)(A + (size_t)row * K + half * hk);
            float ss = 0.f;
#pragma unroll 8
            for (int j = 0; j < (hk >> 3); ++j) {
                const uint4 v = ar[j];
                const unsigned uu[4] = {v.x, v.y, v.z, v.w};
#pragma unroll
                for (int e = 0; e < 4; ++e) { const float lo = __uint_as_float(uu[e] << 16), hi = __uint_as_float(uu[e] & 0xffff0000u); ss += lo * lo + hi * hi; }
            }
            ss += __shfl_xor(ss, 1);
            if (half == 0) rs[row] = rsqrtf(ss / (float)K + EPS);
        }
        __syncthreads();
        f32x16 acc[2][2]; zero_acc(acc);
        if (isq) {
            const bf16_t* Bw = WQ + (size_t)nt * 128 * 384;
            if (nt < 4) {
                gemm_mainloop<64>(Bw, 384, A, 384, 384, acc, smem);
                scale_acc_q(acc, rs, MLA_QS);
                stage_store_128(acc, p->qn + (size_t)m0 * 512 + nt * 128, 512, smem);
            } else {
                gemm_mainloop<64>(A, 384, Bw, 384, 384, acc, smem);
                const int tt = nt - 4; const int head = tt * 4 + wn * 2 + (r >> 4), ii = r & 15;
                const float* __restrict__ rt = p->ropetab; bf16_t* __restrict__ qrp = p->qr;
#pragma unroll
                for (int mi = 0; mi < 2; ++mi) {
                    const int rbase = wm * 64 + mi * 32 + 4 * hh;
                    f32x2_t cs[16];
#pragma unroll
                    for (int i = 0; i < 16; ++i) cs[i] = *(const f32x2_t*)(rt + 2 * ((m0 + rbase + 8 * (i >> 2) + (i & 3)) * 16 + ii));
#pragma unroll
                    for (int i = 0; i < 16; ++i) {
                        const int row = rbase + 8 * (i >> 2) + (i & 3);
                        const int t = m0 + row; const float sc = rs[row] * MLA_QS;
                        const float x1 = acc[mi][0][i] * sc, x2 = acc[mi][1][i] * sc;
                        qrp[t * 256 + head * 32 + ii] = f2bf(x1 * cs[i][0] - x2 * cs[i][1]);
                        qrp[t * 256 + head * 32 + 16 + ii] = f2bf(x1 * cs[i][1] + x2 * cs[i][0]);
                    }
                }
                __syncthreads(); __syncthreads();
            }
        } else {
            const int n2 = nt - 6;
            const bf16_t* Bw = WKV + (size_t)n2 * 128 * 256;
            if (n2 < 4) {
                gemm_mainloop<64>(Bw, 256, A, 256, 256, acc, smem);
                scale_acc_q(acc, rs, 1.0f);
                stage_store_128(acc, p->kn + (size_t)m0 * 512 + n2 * 128, 512, smem);
            } else {
                gemm_mainloop<64>(A, 256, Bw, 256, 256, acc, smem);
                scale_acc_p(acc, rs);
                stage_store_vt(acc, p->vtm, b, (n2 - 4) * 128, s0, smem);
            }
        }
    }
    __syncthreads();
    float* fs = (float*)smem;
    for (int bh = bidx(); bh < 64; bh += gdim()) {
        const f32x4* src = (const f32x4*)(p->logf + (size_t)bh * SEQ + tid * 16);
        f32x4 v[4];
        float run = 0.f;
#pragma unroll
        for (int j = 0; j < 4; ++j) { v[j] = src[j];
#pragma unroll
            for (int e = 0; e < 4; ++e) { run += v[j][e]; v[j][e] = run; } }
        float incl = run;
#pragma unroll
        for (int o = 1; o < 64; o <<= 1) { const float tv = __shfl_up(incl, o); if (lane >= o) incl += tv; }
        if (lane == 63) fs[w] = incl;
        __syncthreads();
        float pre = incl - run;
        for (int ww = 0; ww < w; ++ww) pre += fs[ww];
        f32x4* dst = (f32x4*)(p->cum + (size_t)bh * SEQ + tid * 16);
#pragma unroll
        for (int j = 0; j < 4; ++j) { f32x4 o;
#pragma unroll
            for (int e = 0; e < 4; ++e) o[e] = v[j][e] + pre; dst[j] = o; }
        __syncthreads();
        {
            const bf16_t* kp = p->kf + (size_t)(bh >> 3) * SEQ * 512 + (bh & 7) * 64 + (size_t)tid * 16 * 512;
            float mx = 0.f;
            for (int rr = 0; rr < 16; ++rr) {
                const uint4* q4 = (const uint4*)(kp + (size_t)rr * 512);
                uint4 vv[8];
#pragma unroll
                for (int c = 0; c < 8; ++c) vv[c] = q4[c];
                float ss = 0.f;
#pragma unroll
                for (int c = 0; c < 8; ++c) { const unsigned uu[4] = {vv[c].x, vv[c].y, vv[c].z, vv[c].w};
#pragma unroll
                    for (int e = 0; e < 4; ++e) { const float lo = __uint_as_float(uu[e] << 16), hi = __uint_as_float(uu[e] & 0xffff0000u); ss += lo * lo + hi * hi; } }
                mx = fmaxf(mx, ss);
            }
#pragma unroll
            for (int o = 32; o >= 1; o >>= 1) mx = fmaxf(mx, __shfl_xor(mx, o));
            if (lane == 0) fs[16 + w] = mx;
            __syncthreads();
            if (tid == 0) p->kmax[bh] = sqrtf(fmaxf(fmaxf(fs[16], fs[17]), fmaxf(fs[18], fs[19]))) * 1.01f;
            __syncthreads();
        }
    }
}

template <int TYPE>
DI void attn_item(KargPtr p, int b, int h, int qb, unsigned char* smem) {
    constexpr int DK = (TYPE == 1) ? 96 : (TYPE == 0 ? 80 : 64), KS = DK / 16, KROWB = (DK + 8) * 2, VROWB = 144;
    constexpr int KBYTES = 64 * KROWB, VBYTES = 64 * VROWB, BUFB = KBYTES + VBYTES + 256;
    const int tid = tidx(), lane = tid & 63, w = tid >> 6, r = lane & 31, hh = lane >> 5;
    const int q0 = qb * 128, qw = q0 + 32 * w, myq = qw + r;
    const size_t tokq = (size_t)b * SEQ + myq;
    unsigned* flags = (unsigned*)(smem - vhalf() * VSMEM + FLAGS_OFF);
    const int w8 = vhalf() * 4 + w;

    bf16x8 qfrag[KS];
    if (TYPE == 1) {
#pragma unroll
        for (int ks = 0; ks < 4; ++ks) qfrag[ks] = *(const bf16x8*)(p->qn + tokq * 512 + h * 64 + ks * 16 + hh * 8);
#pragma unroll
        for (int ks = 4; ks < KS; ++ks) qfrag[ks] = *(const bf16x8*)(p->qr + tokq * 256 + h * 32 + (ks - 4) * 16 + hh * 8);
    } else {
        const bf16_t* qg = (TYPE == 0 ? p->qf : p->qs) + tokq * 512 + h * 64;
#pragma unroll
        for (int ks = 0; ks < 4; ++ks) qfrag[ks] = *(const bf16x8*)(qg + ks * 16 + hh * 8);
        if (TYPE == 0) { const u32x4 one3 = hh == 0 ? (u32x4){0x3F803F80u, 0x00003F80u, 0u, 0u} : (u32x4){0u, 0u, 0u, 0u}; qfrag[KS - 1] = __builtin_bit_cast(bf16x8, one3); }
    }
    const bf16_t* Kg = (TYPE == 0 ? p->kf : TYPE == 1 ? p->kn : p->ks) + (size_t)b * SEQ * 512 + h * 64;
    const bf16_t* Vg = (TYPE == 0 ? p->vtf : TYPE == 1 ? p->vtm : p->vts) + (size_t)(b * 8 + h) * 64 * SEQ;
    const bf16_t* Krg = p->kr + (size_t)b * SEQ * 32;
    const float* cumg = p->cum + (size_t)(b * 8 + h) * SEQ;

    const int ntiles = 2 * qb + 2;
    u32x4 rk0A, rk1A, rv0A, rv1A, rkrA, rk0B, rk1B, rv0B, rv1B, rkrB; float rckA = 0.f, rckB = 0.f;
    rkrA = (u32x4){0u, 0u, 0u, 0u}; rkrB = rkrA;
    const int ldrow = tid >> 3, ldch = tid & 7;
    const int vpos = 16 * (ldch >> 1) + 4 * (ldch & 1);
#define LOAD_TILE(S, KT_) do { \
        const int k0_ = (KT_) * 64; \
        GLOAD16(rk0##S, Kg + (size_t)(k0_ + ldrow) * 512 + ldch * 8); \
        GLOAD16(rk1##S, Kg + (size_t)(k0_ + 32 + ldrow) * 512 + ldch * 8); \
        GLOAD16(rv0##S, Vg + (size_t)k0_ * 64 + ldrow * 64 + ldch * 8); \
        GLOAD16(rv1##S, Vg + (size_t)k0_ * 64 + (32 + ldrow) * 64 + ldch * 8); \
        if (TYPE == 1) GLOAD16(rkr##S, Krg + (size_t)(k0_ + (tid >> 2)) * 32 + (tid & 3) * 8); \
        if (TYPE == 0) GLOAD4(rck##S, cumg + k0_ + (tid & 63)); \
    } while (0)
#define WAIT_ALL(S) asm volatile("s_waitcnt vmcnt(0)" : "+v"(rk0##S), "+v"(rk1##S), "+v"(rv0##S), "+v"(rv1##S), "+v"(rkr##S), "+v"(rck##S))
#define WAIT_OLD(S) do { if (TYPE == 2) asm volatile("s_waitcnt vmcnt(4)" : "+v"(rk0##S), "+v"(rk1##S), "+v"(rv0##S), "+v"(rv1##S), "+v"(rkr##S), "+v"(rck##S)); \
        else asm volatile("s_waitcnt vmcnt(5)" : "+v"(rk0##S), "+v"(rk1##S), "+v"(rv0##S), "+v"(rv1##S), "+v"(rkr##S), "+v"(rck##S)); } while (0)
#define STORE_TILE(S, BUF_) do { \
        unsigned char* kb_ = smem + (BUF_) * BUFB; unsigned char* vb_ = kb_ + KBYTES; \
        *(u32x4*)(kb_ + ldrow * KROWB + ldch * 16) = rk0##S; \
        *(u32x4*)(kb_ + (32 + ldrow) * KROWB + ldch * 16) = rk1##S; \
        { u32x2 lo, hi; lo.x = rv0##S.x; lo.y = rv0##S.y; hi.x = rv0##S.z; hi.y = rv0##S.w; \
          *(u32x2*)(vb_ + ldrow * VROWB + vpos * 2) = lo; *(u32x2*)(vb_ + ldrow * VROWB + (vpos + 8) * 2) = hi; } \
        { u32x2 lo, hi; lo.x = rv1##S.x; lo.y = rv1##S.y; hi.x = rv1##S.z; hi.y = rv1##S.w; \
          *(u32x2*)(vb_ + (32 + ldrow) * VROWB + vpos * 2) = lo; *(u32x2*)(vb_ + (32 + ldrow) * VROWB + (vpos + 8) * 2) = hi; } \
        if (TYPE == 1) *(u32x4*)(kb_ + (tid >> 2) * KROWB + 128 + (tid & 3) * 16) = rkr##S; \
        if (TYPE == 0) { if (tid < 64) { \
            const float c_ = -rck##S * LOG2E; \
            const unsigned h_ = pack_bf16(c_, 0.f) & 0xffffu; const float r1_ = c_ - __uint_as_float(h_ << 16); \
            const unsigned m_ = pack_bf16(r1_, 0.f) & 0xffffu; const float r2_ = r1_ - __uint_as_float(m_ << 16); \
            const unsigned l_ = pack_bf16(r2_, 0.f) & 0xffffu; \
            *(u32x4*)(kb_ + tid * KROWB + 128) = (u32x4){h_ | (m_ << 16), l_, 0u, 0u}; \
            *(u32x4*)(kb_ + tid * KROWB + 144) = (u32x4){0u, 0u, 0u, 0u}; \
            if (tid == 63) *(float*)(vb_ + VBYTES) = c_; } } \
    } while (0)
#define TILE_OF(J_) ((TYPE != 1) ? (ntiles - 1 - ((J_) < ntiles ? (J_) : ntiles - 1)) : ((J_) < ntiles ? (J_) : ntiles - 1))

    f32x16 o0, o1;
#pragma unroll
    for (int i = 0; i < 16; ++i) { o0[i] = 0.f; o1[i] = 0.f; }
    float m = -1e30f, lsum = 0.f, carry = 0.f;
    bool wdone = false;
    float qbound = 0.f;
    if (TYPE == 0) {
        float ss = 0.f;
#pragma unroll
        for (int ks = 0; ks < 4; ++ks) { const u32x4 qq = __builtin_bit_cast(u32x4, qfrag[ks]);
#pragma unroll
            for (int e = 0; e < 4; ++e) { const float lo = __uint_as_float(qq[e] << 16), hi = __uint_as_float(qq[e] & 0xffff0000u); ss += lo * lo + hi * hi; } }
        ss += __shfl_xor(ss, 32);
        qbound = sqrtf(ss) * 1.01f * p->kmax[b * 8 + h];
    }

    auto compute = [&](const int kt, const int buf) __attribute__((always_inline)) {
        const unsigned char* kb = smem + buf * BUFB; const unsigned char* vb = kb + KBYTES;
        const int k0 = kt * 64;
        bool need;
        if (TYPE == 0) {
            if (!wdone && k0 <= qw + 31) wdone = (__all(qbound + *(const float*)(vb + VBYTES) - m < -150.f) != 0);
            need = (k0 <= qw + 31) && !wdone;
        }
        else if (TYPE == 1) need = (k0 <= qw);
        else need = (k0 <= qw + 30) && !wdone;
        if (need) {
            f32x16 s0, s1;
#pragma unroll
            for (int i = 0; i < 16; ++i) { s0[i] = 0.f; s1[i] = 0.f; }
#pragma unroll
            for (int ks = 0; ks < KS; ++ks) {
                const bf16x8 a0 = *(const bf16x8*)(kb + r * KROWB + ks * 32 + hh * 16);
                const bf16x8 a1 = *(const bf16x8*)(kb + (32 + r) * KROWB + ks * 32 + hh * 16);
                s0 = MFMA(a0, qfrag[ks], s0); s1 = MFMA(a1, qfrag[ks], s1);
            }
            if (TYPE != 2) {
                if (TYPE == 0) {
                    if (k0 + 63 > qw) {
                        asm volatile("");
                        const int rel = myq - k0 - 4 * hh;
#pragma unroll
                        for (int i = 0; i < 16; ++i) {
                            const int off = 8 * (i >> 2) + (i & 3);
                            if (off > rel) s0[i] = -1e30f;
                            if (off + 32 > rel) s1[i] = -1e30f;
                        }
                    }
                }
                float mx = s0[0];
#pragma unroll
                for (int i = 1; i < 16; ++i) mx = fmaxf(mx, s0[i]);
#pragma unroll
                for (int i = 0; i < 16; ++i) mx = fmaxf(mx, s1[i]);
                mx = fmaxf(mx, __shfl_xor(mx, 32));
                const float mnew = fmaxf(m, mx);
                const float alpha = fexp2(m - mnew);
                m = mnew;
                float ps = 0.f;
#pragma unroll
                for (int i = 0; i < 16; ++i) { s0[i] = fexp2(s0[i] - mnew); s1[i] = fexp2(s1[i] - mnew); ps += s0[i] + s1[i]; }
                lsum = lsum * alpha + ps;
#pragma unroll
                for (int i = 0; i < 16; ++i) { o0[i] *= alpha; o1[i] *= alpha; }
            } else {
                float lk0[16], lk1[16];
#pragma unroll
                for (int i = 0; i < 16; ++i) {
                    {
                        const float z = s0[i]; const float sp = flog2(1.0f + fexp2(-fabsf(z)));
                        const float lb = fminf(z, 0.f) - sp;
                        s0[i] = lb; lk0[i] = lb - z;
                    }
                    {
                        const float z = s1[i]; const float sp = flog2(1.0f + fexp2(-fabsf(z)));
                        const float lb = fminf(z, 0.f) - sp;
                        s1[i] = lb; lk1[i] = lb - z;
                    }
                }
                if (k0 + 63 >= qw) {
                    asm volatile("");
                    const int rel = myq - k0 - 4 * hh;
#pragma unroll
                    for (int i = 0; i < 16; ++i) {
                        const int off = 8 * (i >> 2) + (i & 3);
                        if (off >= rel) { lk0[i] = 0.f; s0[i] = -1e30f; }
                        if (off + 32 >= rel) { lk1[i] = 0.f; s1[i] = -1e30f; }
                    }
                }
                float run = carry;
#pragma unroll
                for (int g = 3; g >= 0; --g) {
                    const float G = (lk1[4 * g] + lk1[4 * g + 1]) + (lk1[4 * g + 2] + lk1[4 * g + 3]);
                    const float Gp = __shfl_xor(G, 32);
                    const float base = run + (hh == 0 ? Gp : 0.f);
                    const float e3 = base, e2 = e3 + lk1[4 * g + 3], e1 = e2 + lk1[4 * g + 2], e0 = e1 + lk1[4 * g + 1];
                    s1[4 * g + 3] = fexp2(s1[4 * g + 3] + e3); s1[4 * g + 2] = fexp2(s1[4 * g + 2] + e2);
                    s1[4 * g + 1] = fexp2(s1[4 * g + 1] + e1); s1[4 * g] = fexp2(s1[4 * g] + e0);
                    run += G + Gp;
                }
#pragma unroll
                for (int g = 3; g >= 0; --g) {
                    const float G = (lk0[4 * g] + lk0[4 * g + 1]) + (lk0[4 * g + 2] + lk0[4 * g + 3]);
                    const float Gp = __shfl_xor(G, 32);
                    const float base = run + (hh == 0 ? Gp : 0.f);
                    const float e3 = base, e2 = e3 + lk0[4 * g + 3], e1 = e2 + lk0[4 * g + 2], e0 = e1 + lk0[4 * g + 1];
                    s0[4 * g + 3] = fexp2(s0[4 * g + 3] + e3); s0[4 * g + 2] = fexp2(s0[4 * g + 2] + e2);
                    s0[4 * g + 1] = fexp2(s0[4 * g + 1] + e1); s0[4 * g] = fexp2(s0[4 * g] + e0);
                    run += G + Gp;
                }
                carry = run;
            }
#pragma unroll
            for (int s2 = 0; s2 < 2; ++s2) {
                unsigned pk0[4], pk1[4];
#pragma unroll
                for (int j = 0; j < 4; ++j) { pk0[j] = pack_bf16(s0[8 * s2 + 2 * j], s0[8 * s2 + 2 * j + 1]); pk1[j] = pack_bf16(s1[8 * s2 + 2 * j], s1[8 * s2 + 2 * j + 1]); }
                const uint4 u0 = make_uint4(pk0[0], pk0[1], pk0[2], pk0[3]), u1 = make_uint4(pk1[0], pk1[1], pk1[2], pk1[3]);
                const bf16x8 pf0 = __builtin_bit_cast(bf16x8, u0), pf1 = __builtin_bit_cast(bf16x8, u1);
                const bf16x8 v00 = *(const bf16x8*)(vb + r * VROWB + (16 * s2 + 8 * hh) * 2);
                const bf16x8 v01 = *(const bf16x8*)(vb + (32 + r) * VROWB + (16 * s2 + 8 * hh) * 2);
                const bf16x8 v10 = *(const bf16x8*)(vb + r * VROWB + (32 + 16 * s2 + 8 * hh) * 2);
                const bf16x8 v11 = *(const bf16x8*)(vb + (32 + r) * VROWB + (32 + 16 * s2 + 8 * hh) * 2);
                o0 = MFMA(v00, pf0, o0); o1 = MFMA(v01, pf0, o1);
                o0 = MFMA(v10, pf1, o0); o1 = MFMA(v11, pf1, o1);
            }
        }
    };
#define SB_FLAGS(N_) do { if (TYPE != 1) { if (TYPE == 2) wdone = (__all(carry < -170.f) != 0); if (lane == 0) flags[((N_) & 1) * 8 + w8] = wdone ? 1u : 0u; } } while (0)
#define SB_DONE(N_) (TYPE != 1 && ((flags[((N_) & 1) * 8] & flags[((N_) & 1) * 8 + 1] & flags[((N_) & 1) * 8 + 2] & flags[((N_) & 1) * 8 + 3] & flags[((N_) & 1) * 8 + 4] & flags[((N_) & 1) * 8 + 5] & flags[((N_) & 1) * 8 + 6] & flags[((N_) & 1) * 8 + 7]) != 0u))
    __syncthreads();
    if (TYPE != 1 && tid < 16) flags[tid] = 0;
    LOAD_TILE(A, TILE_OF(0));
    WAIT_ALL(A);
    STORE_TILE(A, 0);
    LOAD_TILE(A, TILE_OF(1));
    __syncthreads();
    for (int n = 0; n < ntiles; n += 2) {
        LOAD_TILE(B, TILE_OF(n + 2));
        __builtin_amdgcn_sched_barrier(0);
        compute(TILE_OF(n), 0);
        __builtin_amdgcn_sched_barrier(0);
        WAIT_OLD(A);
        STORE_TILE(A, 1);
        SB_FLAGS(n);
        __syncthreads();
        if (SB_DONE(n)) break;
        if (n + 1 >= ntiles) break;
        LOAD_TILE(A, TILE_OF(n + 3));
        __builtin_amdgcn_sched_barrier(0);
        compute(TILE_OF(n + 1), 1);
        __builtin_amdgcn_sched_barrier(0);
        WAIT_OLD(B);
        STORE_TILE(B, 0);
        SB_FLAGS(n + 1);
        __syncthreads();
        if (SB_DONE(n + 1)) break;
    }
    asm volatile("s_waitcnt vmcnt(0)" : "+v"(rk0A), "+v"(rk1A), "+v"(rv0A), "+v"(rv1A), "+v"(rkrA), "+v"(rckA), "+v"(rk0B), "+v"(rk1B), "+v"(rv0B), "+v"(rv1B), "+v"(rkrB), "+v"(rckB));
    float inv = 1.0f;
    if (TYPE != 2) { const float lt = lsum + __shfl_xor(lsum, 32); inv = frcp(lt); }
    bf16_t* yg = (TYPE == 0 ? p->qf : TYPE == 1 ? p->qn : p->qs) + tokq * 512 + h * 64;
#pragma unroll
    for (int g = 0; g < 4; ++g) {
        u32x2 a, c2;
        a.x = pack_bf16(o0[4 * g] * inv, o0[4 * g + 1] * inv); a.y = pack_bf16(o0[4 * g + 2] * inv, o0[4 * g + 3] * inv);
        c2.x = pack_bf16(o1[4 * g] * inv, o1[4 * g + 1] * inv); c2.y = pack_bf16(o1[4 * g + 2] * inv, o1[4 * g + 3] * inv);
        *(u32x2*)(yg + 8 * g + 4 * hh) = a;
        *(u32x2*)(yg + 32 + 8 * g + 4 * hh) = c2;
    }
}

DI void phase_attn(KargPtr p, unsigned char* smem) {
    for (int idx = bidx(); idx < 6144; idx += gdim()) {
        if (idx < 4096) {
            const int j = idx >> 9, g = (idx >> 7) & 3, rem = idx & 127, bh = ((rem & 63) + 13 * j) & 63;
            const int qb = 31 - 4 * j - ((j & 1) ? 3 - g : g);
            const int type = ((rem >> 6) + j) & 1;
            if (type == 0) attn_item<0>(p, bh >> 3, bh & 7, qb, smem);
            else attn_item<1>(p, bh >> 3, bh & 7, qb, smem);
        } else {
            const int j = idx - 4096; const int qb = 31 - (j >> 6), bh = j & 63;
            attn_item<2>(p, bh >> 3, bh & 7, qb, smem);
        }
    }
}

struct EpiGate {
    static constexpr bool PERM = false, AFTER_DRAIN = false;
    bf16_t* gs0; bf16_t* gs1;
    __device__ __forceinline__ void operator()(const pg8::f32x4 (&acc)[2][2][4][2], const pg8::Unit& u, int wr, int wc, int fr, int fq) const {
        const int br = u.pn >> 2;
        bf16_t* dst = (br == 0 ? gs0 : gs1 + (size_t)(br - 1) * T_TOK * 1024) + (u.pn & 3) * 256 + wc * 32 + fq * 4;
        const int row0 = u.pm * 256 + wr * 64 + fr;
#pragma unroll
        for (int ai = 0; ai < 2; ++ai)
#pragma unroll
            for (int m = 0; m < 4; ++m) {
                bf16_t* rowp = dst + (size_t)(row0 + ai * 128 + m * 16) * 1024;
#pragma unroll
                for (int bj = 0; bj < 2; ++bj)
#pragma unroll
                    for (int n = 0; n < 2; ++n) { const pg8::f32x4 v = acc[ai][bj][m][n]; u32x2 pk; pk.x = pack_bf16(sigmoidf_(v[0]), sigmoidf_(v[1])); pk.y = pack_bf16(sigmoidf_(v[2]), sigmoidf_(v[3])); *(u32x2*)(rowp + bj * 128 + n * 16) = pk; }
            }
    }
};
DI void phase_gate(KargPtr p, int l, unsigned char* smem_phys) {
    EpiGate E; E.gs0 = p->gs0; E.gs1 = p->gs1;
    big_gemm<EpiGate, false>(p->u, p->wt + (size_t)l * W_LAYER + W_GATE, 3072, 1024, E, smem_phys);
}
DI void phase_merge(KargPtr p, int l, unsigned char* smem) {
    const int tid = tidx(), lane = tid & 63, w = tid >> 6, wm = w >> 1, wn = w & 1, r = lane & 31, hh = lane >> 5;
    const bf16_t* WL = p->wt + (size_t)l * W_LAYER;
    for (int it = 0;; ++it) {
        int mt, nt; if (!next_tile(it, 256, 8, mt, nt)) break;
        const int m0 = mt * 128;
        f32x16 mer[2][2]; zero_acc(mer);
#pragma unroll 1
        for (int br = 0; br < 3; ++br) {
            f32x16 acc[2][2]; zero_acc(acc);
            const bf16_t* Y = (br == 0 ? p->qf : br == 1 ? p->qn : p->qs) + (size_t)m0 * 512;
            const bf16_t* WO = WL + (br == 0 ? W_OF : br == 1 ? W_OM : W_OS) + (size_t)nt * 128 * 512;
            gemm_mainloop<64>(WO, 512, Y, 512, 512, acc, smem);
            const bf16_t* G = (br == 0 ? p->gs0 : p->gs1 + (size_t)(br - 1) * T_TOK * 1024) + (size_t)(m0 + wn * 64 + r) * 1024 + nt * 128 + wm * 64 + 4 * hh;
            u32x2 gv[2][2][4];
#pragma unroll
            for (int a = 0; a < 2; ++a)
#pragma unroll
                for (int c = 0; c < 2; ++c)
#pragma unroll
                    for (int g = 0; g < 4; ++g) gv[a][c][g] = *(const u32x2*)(G + (size_t)c * 32 * 1024 + a * 32 + 8 * g);
#pragma unroll
            for (int a = 0; a < 2; ++a)
#pragma unroll
                for (int c = 0; c < 2; ++c)
#pragma unroll
                    for (int g = 0; g < 4; ++g) {
                        const unsigned x0 = gv[a][c][g].x, x1 = gv[a][c][g].y;
                        mer[a][c][4 * g]     += __uint_as_float(x0 << 16) * acc[a][c][4 * g];
                        mer[a][c][4 * g + 1] += __uint_as_float(x0 & 0xffff0000u) * acc[a][c][4 * g + 1];
                        mer[a][c][4 * g + 2] += __uint_as_float(x1 << 16) * acc[a][c][4 * g + 2];
                        mer[a][c][4 * g + 3] += __uint_as_float(x1 & 0xffff0000u) * acc[a][c][4 * g + 3];
                    }
        }
        stage_store_128(mer, p->merged + (size_t)m0 * 1024 + nt * 128, 1024, smem);
    }
}

DI void phase_outproj(KargPtr p, int l, unsigned char* smem_phys) {
    EpiResidual E; E.xin = (l == 0) ? p->x : p->out; E.xout = p->out; E.modl = p->mod + (size_t)l * 8 * 6144; E.gidx = 2;
    big_gemm(p->merged, p->wt + (size_t)l * W_LAYER + W_OUT, 1024, 1024, E, smem_phys);
}
DI void phase_ffn_up(KargPtr p, int l, unsigned char* smem_phys) {
    EpiFfnUp E; E.h = p->h;
    big_gemm(p->u, p->wt + (size_t)l * W_LAYER + W_FGU, 5632, 1024, E, smem_phys);
}
DI void phase_ffn_down(KargPtr p, int l, unsigned char* smem_phys) {
    EpiResidual E; E.xin = p->out; E.xout = p->out; E.modl = p->mod + (size_t)l * 8 * 6144; E.gidx = 5;
    big_gemm(p->h, p->wt + (size_t)l * W_LAYER + W_FD, 1024, 2816, E, smem_phys);
}

DI void run_phase(int ph, int l, unsigned char* smem_phys) {
#ifdef ONLY_PH
    if (ph != ONLY_PH) return;
#endif
    KargPtr p = karg();
    unsigned char* smem = smem_phys + vhalf() * VSMEM;
    switch (ph) {
    case 0: phase_prep(p, smem); break;
    case 1: phase_norm((l == 0) ? p->x : p->out, p->g_mix + l * 1024, p->mod + (size_t)l * 8 * 6144, 0, 1, p->u); break;
    case 2: phase_inproj(p, l, smem_phys); break;
    case 3: phase_mla_up(p, l, smem); break;
    case 4: phase_attn(p, smem); break;
    case 5: phase_merge(p, l, smem); break;
    case 12: phase_gate(p, l, smem_phys); break;
    case 6: phase_outproj(p, l, smem_phys); break;
    case 7: phase_norm(p->out, p->g_ffn + l * 1024, p->mod + (size_t)l * 8 * 6144, 3, 4, p->u); break;
    case 8: phase_ffn_up(p, l, smem_phys); break;
    case 9: phase_ffn_down(p, l, smem_phys); break;
    default: phase_final(p); break;
    }
}

#define XB_TMO      128
#define XB_XCNT(j)  (256  + 64 * (j))
#define XB_XSUB(j)  (1280 + 64 * (j))
#define XB_XGEN(j)  (2304 + 64 * (j))
#define XB_TOP      3328
#define XB_TOPGEN   3392
#define XCD_BAR_WORDS 3456
#define XB_SPIN_CAP (1u << 20)
#define LAS __attribute__((address_space(3)))
DI unsigned xb_ld(unsigned* p)              { return __hip_atomic_load(p, __ATOMIC_RELAXED, __HIP_MEMORY_SCOPE_AGENT); }
DI unsigned xb_add(unsigned* p, unsigned v) { return __hip_atomic_fetch_add(p, v, __ATOMIC_RELAXED, __HIP_MEMORY_SCOPE_AGENT); }
DI unsigned xb_xcc_id() { return (unsigned)__builtin_amdgcn_s_getreg((3 << 11) | 20) & 0xFu; }
#define XB_SPIN(cond, bar) do { unsigned _sp = 0; while (cond) { __builtin_amdgcn_s_sleep(1); \
    if ((++_sp & 255u) == 0u) { if (xb_ld(&(bar)[XB_TMO])) break; if (_sp > XB_SPIN_CAP) { atomicAdd(&(bar)[XB_TMO], 1u); break; } } } } while (0)
struct XcdBarrier { unsigned* bar; unsigned x; volatile LAS unsigned* st; };
DI XcdBarrier xcd_barrier_post(unsigned* bar, volatile LAS unsigned* st) {
    XcdBarrier b; b.bar = bar; b.x = xb_xcc_id(); b.st = st;
    if (threadIdx.x == 0) (void)xb_add(&bar[XB_XCNT(b.x)], 1u);
    return b;
}
DI void xcd_barrier_complete(unsigned* bar, unsigned x, unsigned& nloc, unsigned& nx) {
    const unsigned G = gridDim.x * gridDim.y * gridDim.z;
    unsigned sum, cnt, mine, sp = 0u;
    for (;;) {
        sum = 0u; cnt = 0u; mine = 0u;
#pragma unroll
        for (unsigned j = 0; j < 16; ++j) { const unsigned c = xb_ld(&bar[XB_XCNT(j)]); sum += c; cnt += (c > 0u) ? 1u : 0u; mine = (j == x) ? c : mine; }
        if (sum == G) break;
        __builtin_amdgcn_s_sleep(1);
        if ((++sp & 255u) == 0u) { if (xb_ld(&bar[XB_TMO])) break; if (sp > XB_SPIN_CAP) { atomicAdd(&bar[XB_TMO], 1u); break; } }
    }
    nloc = mine > 0u ? mine : 1u; nx = cnt > 0u ? cnt : 1u;
}
DI void xcd_barrier(const XcdBarrier& b) {
    asm volatile("s_waitcnt vmcnt(0)" ::: "memory");
    __syncthreads();
    if (threadIdx.x == 0) {
        unsigned* bar = b.bar;
        __builtin_amdgcn_s_waitcnt(0);
        unsigned nloc = b.st[0], nx = b.st[1];
        if (nloc == 0u) { xcd_barrier_complete(bar, b.x, nloc, nx); b.st[0] = nloc; b.st[1] = nx; }
        const unsigned old = xb_add(&bar[XB_XSUB(b.x)], 1u);
        const unsigned gen = old / nloc;
        if (old + 1u == (gen + 1u) * nloc) {
            __builtin_amdgcn_fence(__ATOMIC_RELEASE, "agent");
            asm volatile("s_waitcnt vmcnt(0)" ::: "memory");
            const unsigned og = xb_add(&bar[XB_TOP], 1u);
            const unsigned tg = og / nx;
            if (og + 1u == (tg + 1u) * nx) xb_add(&bar[XB_TOPGEN], 1u);
            else XB_SPIN(xb_ld(&bar[XB_TOPGEN]) == tg, bar);
            __builtin_amdgcn_fence(__ATOMIC_ACQUIRE, "agent");
            xb_add(&bar[XB_XGEN(b.x)], 1u);
            asm volatile("s_waitcnt vmcnt(0)" ::: "memory");
        } else {
            XB_SPIN(xb_ld(&bar[XB_XGEN(b.x)]) == gen, bar);
            __builtin_amdgcn_fence(__ATOMIC_ACQUIRE, "agent");
            asm volatile("s_waitcnt vmcnt(0)" ::: "memory");
        }
    }
    __syncthreads();
}

#if MEGA
__global__ void __launch_bounds__(512, 2) __attribute__((amdgpu_waves_per_eu(2, 2))) mega_kernel(Params p) {
    extern __shared__ __attribute__((aligned(16))) unsigned char smem[];
    cg::grid_group grid = cg::this_grid();
    volatile LAS unsigned* st = (volatile LAS unsigned*)(smem + SMEM_BYTES - 16);
    if (threadIdx.x == 0) { st[0] = 0u; st[1] = 0u; }
    __syncthreads();
    const XcdBarrier xb = xcd_barrier_post(karg()->bar, st);
    run_phase(0, 0, smem);
    grid.sync();
#pragma unroll 1
    for (int l = 0; l < 2; ++l) {
#pragma unroll 1
        for (int ph = 1; ph <= 9; ++ph) {
            if (ph == 5) { run_phase(12, l, smem); xcd_barrier(xb); }
            run_phase(ph, l, smem); xcd_barrier(xb);
#ifdef DBL_PH
            if (ph == DBL_PH) { run_phase(ph, l, smem); xcd_barrier(xb); }
#endif
        }
    }
    run_phase(10, 0, smem);
}
#else
__global__ void __launch_bounds__(512, 2) __attribute__((amdgpu_waves_per_eu(2, 2))) phase_kernel(Params p, int ph, int l) {
    extern __shared__ __attribute__((aligned(16))) unsigned char smem[];
    run_phase(ph, l, smem);
}
#endif

extern "C" void kernel_launch(void* const* d_in, const int* in_sizes, int n_in, void* d_out, int out_size, void* d_ws, size_t ws_size, hipStream_t stream) {
    (void)in_sizes; (void)n_in; (void)out_size;
    Params p{};
    p.x = (const float*)d_in[0]; p.c = (const float*)d_in[1]; p.pos = (const int*)d_in[2];
    p.g_mix = (const float*)d_in[3]; p.w_ada = (const float*)d_in[4]; p.b_ada = (const float*)d_in[5]; p.w_in = (const float*)d_in[6]; p.b_fox_f = (const float*)d_in[7];
    p.g_mla_q = (const float*)d_in[8]; p.w_mla_uq = (const float*)d_in[9]; p.g_mla_kv = (const float*)d_in[10]; p.w_mla_ukv = (const float*)d_in[11];
    p.w_o_fox = (const float*)d_in[12]; p.w_o_mla = (const float*)d_in[13]; p.w_o_sb = (const float*)d_in[14]; p.w_out = (const float*)d_in[15];
    p.g_ffn = (const float*)d_in[16]; p.w_ffn_gate = (const float*)d_in[17]; p.w_ffn_up = (const float*)d_in[18]; p.w_ffn_down = (const float*)d_in[19]; p.g_final = (const float*)d_in[20];
    p.out = (float*)d_out;
    unsigned char* ws = (unsigned char*)d_ws; size_t off = 0;
    auto take = [&](size_t bytes) { unsigned char* q = ws + off; off += (bytes + 255) & ~(size_t)255; return q; };
    p.bar = (unsigned*)take(16384);
    p.kmax = (float*)take(256);
    p.wt = (bf16_t*)take(2 * W_LAYER * 2);
    p.mod = (float*)take(2 * 8 * 6144 * 4);
    p.ropetab = (float*)take((size_t)T_TOK * 16 * 2 * 4);
    p.logf = (float*)take((size_t)64 * SEQ * 4);
    p.cum = (float*)take((size_t)64 * SEQ * 4);
    p.u = (bf16_t*)take((size_t)T_TOK * 1024 * 2);
    p.qf = (bf16_t*)take((size_t)T_TOK * 512 * 2);
    p.kf = (bf16_t*)take((size_t)T_TOK * 512 * 2);
    p.vtf = (bf16_t*)take((size_t)T_TOK * 512 * 2);
    p.qs = (bf16_t*)take((size_t)T_TOK * 512 * 2);
    p.ks = (bf16_t*)take((size_t)T_TOK * 512 * 2);
    p.vts = (bf16_t*)take((size_t)T_TOK * 512 * 2);
    p.qn = (bf16_t*)take((size_t)T_TOK * 512 * 2);
    p.ql = (bf16_t*)take((size_t)T_TOK * 384 * 2);
    p.kvl = (bf16_t*)take((size_t)T_TOK * 256 * 2);
    p.kr = (bf16_t*)take((size_t)T_TOK * 32 * 2);
    p.qr = (bf16_t*)take((size_t)T_TOK * 256 * 2);
    p.kn = (bf16_t*)take((size_t)T_TOK * 512 * 2);
    p.vtm = (bf16_t*)take((size_t)T_TOK * 512 * 2);
    (void)take((size_t)8 << 20);
    p.gs0 = p.ks;
    p.gs1 = p.ql;
    p.gs2 = p.ql + (size_t)T_TOK * 1024;
    p.merged = p.kf;
    p.h = p.qf;
    if (off > ws_size) { fprintf(stderr, "kernel_launch: workspace too small: need %zu, have %zu\n", off, ws_size); return; }

#if MEGA
    static int grid_blocks = 0;
    if (!grid_blocks) {
        int dev = 0, cus = 0, per_cu = 0;
        (void)hipGetDevice(&dev);
        (void)hipDeviceGetAttribute(&cus, hipDeviceAttributeMultiprocessorCount, dev);
        (void)hipFuncSetAttribute((const void*)mega_kernel, hipFuncAttributeMaxDynamicSharedMemorySize, SMEM_BYTES);
        (void)hipOccupancyMaxActiveBlocksPerMultiprocessor(&per_cu, (const void*)mega_kernel, 512, SMEM_BYTES);
        per_cu = 1;
        grid_blocks = cus * per_cu;
        grid_blocks &= ~7;
    }
    (void)hipMemsetAsync(p.bar, 0, 16384, stream);
    void* args[] = {&p};
    hipError_t e = hipLaunchCooperativeKernel((const void*)mega_kernel, dim3(grid_blocks), dim3(512), args, SMEM_BYTES, stream);
    if (e != hipSuccess) fprintf(stderr, "cooperative launch failed: %s (grid %d)\n", hipGetErrorString(e), grid_blocks);
#else
    static bool attr = false;
    if (!attr) { (void)hipFuncSetAttribute((const void*)phase_kernel, hipFuncAttributeMaxDynamicSharedMemorySize, SMEM_BYTES); attr = true; }
    const int G = 512;
    hipLaunchKernelGGL(phase_kernel, dim3(G), dim3(256), SMEM_BYTES, stream, p, 0, 0);
    for (int l = 0; l < 2; ++l)
        for (int ph = 1; ph <= 9; ++ph) hipLaunchKernelGGL(phase_kernel, dim3(G), dim3(256), SMEM_BYTES, stream, p, ph, l);
    hipLaunchKernelGGL(phase_kernel, dim3(G), dim3(256), SMEM_BYTES, stream, p, 10, 0);
#endif
}
```

```cpp
#include <hip/hip_runtime.h>
#include <hip/hip_cooperative_groups.h>
#include <cstdint>
#include <cstdio>
namespace cg = cooperative_groups;

#ifndef MEGA
#define MEGA 1
#endif

typedef unsigned short bf16_t;
typedef short bf16x8 __attribute__((ext_vector_type(8)));
typedef float f32x16 __attribute__((ext_vector_type(16)));
typedef float f32x4 __attribute__((ext_vector_type(4)));
typedef unsigned u32x2 __attribute__((ext_vector_type(2)));
#define DI __device__ __forceinline__
typedef unsigned u32x4 __attribute__((ext_vector_type(4)));
#define GLOAD16(dst, ptr) asm volatile("global_load_dwordx4 %0, %1, off" : "=v"(dst) : "v"(ptr))
#define GLOAD4(dst, ptr)  asm volatile("global_load_dword %0, %1, off" : "=v"(dst) : "v"(ptr))
#define MFMA(a, b, c) __builtin_amdgcn_mfma_f32_32x32x16_bf16((a), (b), (c), 0, 0, 0)

namespace pg8 {
#define PG8_LAS __attribute__((address_space(3)))
typedef unsigned short bf16_t;
typedef short bf16x8 __attribute__((ext_vector_type(8)));
typedef float f32x4 __attribute__((ext_vector_type(4)));
typedef unsigned u32x4 __attribute__((ext_vector_type(4)));
constexpr int BM = 256, BK = 64, HALF = 128, HTB = HALF * BK * 2  , STAGE_BYTES = 8 * HTB, NXCD = 8, WGM = 8;

__host__ __device__ __forceinline__ int lds_byte(int r, int c) { const int st = (r >> 4) * 2 + (c >> 5), rr = r & 15, cc = c & 31, ob = rr * 64 + cc * 2; return st * 1024 + (ob ^ (((ob >> 9) & 1) << 5)); }
__host__ __device__ __forceinline__ void stage_rc(int b, int& R, int& C) { const int st = b / 1024, sb = b % 1024, swz = sb ^ (((sb >> 9) & 1) << 5); R = (st >> 1) * 16 + swz / 64; C = (st & 1) * 32 + (swz % 64) / 2; }
__host__ __device__ __forceinline__ int perm32(int rho) { const int n = rho >> 4, i = rho & 15; return 8 * (i >> 2) + 4 * n + (i & 3); }

struct Unit { int pm, pn; };
struct Gemm { const bf16_t* A; const bf16_t* Bt; int M, N, K; };

struct StaticOrder {
    int nM, nN, nwg, G, c;
    __host__ __device__ void init(int M, int N, int G_, int c_) { nM = M / BM; nN = N / BM; nwg = nM * nN; G = G_; c = c_; }
    __host__ __device__ bool next(int i, Unit& u) const {
        const long L = (long)i * G + c; if (L >= nwg) return false;
        int wgid = (int)L; { const int q = nwg / NXCD, r = nwg % NXCD, xcd = wgid % NXCD, off = wgid / NXCD; wgid = (xcd < r ? xcd * (q + 1) : r * (q + 1) + (xcd - r) * q) + off; }
        const int nig = WGM * nN, gid = wgid / nig, fm = gid * WGM, gsz = (nM - fm) < WGM ? (nM - fm) : WGM;
        u.pm = fm + ((wgid % nig) % gsz); u.pn = (wgid % nig) / gsz; return true;
    }
    __device__ __forceinline__ void a_ready(const Unit&) const {}
    __device__ __forceinline__ void done(const Unit&) const {}
};
template <class Epi, class Sched, bool ALIGN_EPI = false, bool SP2 = false, bool NAT = false>
__device__ __forceinline__ void gemm_phase(PG8_LAS unsigned char* lds, const Gemm g, const Sched& S, const Epi& E) {
    int tid = threadIdx.x; asm volatile("" : "+v"(tid)); const int wid = __builtin_amdgcn_readfirstlane(tid >> 6), lane = tid & 63, wr = wid >> 2, wc = wid & 3, fr = lane & 15, fq = lane >> 4;
    const int K = g.K, nt = K / BK;
    unsigned voffA[2], voffB[2];
#pragma unroll
    for (int i = 0; i < 2; ++i) { int R, C; stage_rc(tid * 16 + i * 8192, R, C); const int Rb = Epi::PERM ? ((R & ~31) + perm32(R & 31)) : R;
        voffA[i] = (unsigned)(R * K + C) * 2u; voffB[i] = (unsigned)(Rb * K + C) * 2u; }
    const size_t kstep = (size_t)(BK * 2);
    const size_t hstep = (size_t)HALF * K * 2;
    const size_t tstep = 2 * hstep;
    const unsigned ldsw = (unsigned)wid * 1024u;
    const int aoff = lds_byte(wr * 64 + fr, fq * 8), boff = lds_byte(wc * 32 + fr, fq * 8);
#define PG8_SA(b, h) (((b) * 2 + (h)) * HTB)
#define PG8_SB(b, h) ((4 + (b) * 2 + (h)) * HTB)
#define PG8_STAGE(bufoff, gbase, voff) do { _Pragma("unroll") for (int _i = 0; _i < 2; ++_i) \
        __builtin_amdgcn_global_load_lds((const unsigned*)((const char*)(gbase) + (voff)[_i]), (PG8_LAS unsigned*)(lds + (bufoff) + ldsw + _i * 8192), 16, 0, 0); } while (0)
#define PG8_LDA(dst, b, h) do { _Pragma("unroll") for (int m = 0; m < 4; ++m) _Pragma("unroll") for (int k = 0; k < 2; ++k) dst[m][k] = *(const PG8_LAS bf16x8*)(lds + PG8_SA(b, h) + aoff + m * 2048 + k * 1024); } while (0)
#define PG8_LDB(dst, b, h) do { _Pragma("unroll") for (int n = 0; n < 2; ++n) _Pragma("unroll") for (int k = 0; k < 2; ++k) dst[n][k] = *(const PG8_LAS bf16x8*)(lds + PG8_SB(b, h) + boff + n * 2048 + k * 1024); } while (0)
#define PG8_MMA(ai, bj, At, Bt) do { __builtin_amdgcn_s_setprio(1); _Pragma("unroll") for (int m = 0; m < 4; ++m) _Pragma("unroll") for (int n = 0; n < 2; ++n) _Pragma("unroll") for (int k = 0; k < 2; ++k) \
        acc[ai][bj][m][n] = NAT ? __builtin_amdgcn_mfma_f32_16x16x32_bf16(At[m][k], Bt[n][k], acc[ai][bj][m][n], 0, 0, 0) : __builtin_amdgcn_mfma_f32_16x16x32_bf16(Bt[n][k], At[m][k], acc[ai][bj][m][n], 0, 0, 0); __builtin_amdgcn_s_setprio(0); } while (0)
#define PG8_WAIT_V(n) asm volatile("s_waitcnt vmcnt(" #n ")" ::: "memory")
#define PG8_WAIT_L(n) asm volatile("s_waitcnt lgkmcnt(" #n ")" ::: "memory")
#define PG8_BAR __builtin_amdgcn_s_barrier()
#define PG8_SCHED __builtin_amdgcn_sched_barrier(0)
    Unit cur, nxt; int ui = 0;
    if (!S.next(0, cur)) return;
    f32x4 acc[2][2][4][2];
#pragma unroll
    for (int a = 0; a < 2; ++a)
#pragma unroll
        for (int b = 0; b < 2; ++b)
#pragma unroll
            for (int m = 0; m < 4; ++m)
#pragma unroll
                for (int n = 0; n < 2; ++n) acc[a][b][m][n] = (f32x4){0.f, 0.f, 0.f, 0.f};
    bf16x8 At[4][2], B0[2][2], B1[2][2];
    const char* cA = (const char*)g.A + (size_t)cur.pm * tstep; const char* cB = (const char*)g.Bt + (size_t)cur.pn * tstep;
    S.a_ready(cur);
    if constexpr (SP2) {
        PG8_STAGE(PG8_SB(0, 0), cB, voffB); PG8_STAGE(PG8_SB(0, 1), cB + hstep, voffB); PG8_STAGE(PG8_SA(0, 0), cA, voffA); PG8_STAGE(PG8_SA(0, 1), cA + hstep, voffA);
        if (wr == 1) PG8_BAR;
        PG8_WAIT_V(2); PG8_BAR;
        PG8_STAGE(PG8_SB(1, 0), cB + kstep, voffB); PG8_STAGE(PG8_SA(1, 0), cA + kstep, voffA); PG8_STAGE(PG8_SB(1, 1), cB + hstep + kstep, voffB);
        PG8_WAIT_V(6); PG8_BAR;
    } else {
        PG8_STAGE(PG8_SB(0, 0), cB, voffB); PG8_STAGE(PG8_SA(0, 0), cA, voffA); PG8_STAGE(PG8_SB(0, 1), cB + hstep, voffB); PG8_STAGE(PG8_SA(0, 1), cA + hstep, voffA);
        if (wr == 1) PG8_BAR;
        PG8_WAIT_V(4); PG8_BAR;
        PG8_STAGE(PG8_SB(1, 0), cB + kstep, voffB); PG8_STAGE(PG8_SA(1, 0), cA + kstep, voffA); PG8_STAGE(PG8_SB(1, 1), cB + hstep + kstep, voffB);
        PG8_WAIT_V(6); PG8_BAR;
    }
    for (;;) {
        const bool has_next = S.next(ui + 1, nxt);
        const char* nA = has_next ? (const char*)g.A + (size_t)nxt.pm * tstep : cA; const char* nB = has_next ? (const char*)g.Bt + (size_t)nxt.pn * tstep : cB;
        for (int t = 0; t < nt; t += 2) {
            const bool last = (t == nt - 2);
            const char* a1 = cA + (size_t)(t + 1) * kstep;
            const char* a2 = last ? nA : cA + (size_t)(t + 2) * kstep; const char* b2 = last ? nB : cB + (size_t)(t + 2) * kstep;
            const char* a3 = a2 + kstep; const char* b3 = b2 + kstep;
            if (last && has_next) S.a_ready(nxt);
            if constexpr (SP2) {
            PG8_LDB(B0, 0, 0); PG8_LDB(B1, 0, 1); PG8_SCHED; PG8_LDA(At, 0, 0); PG8_STAGE(PG8_SA(1, 1), a1 + hstep, voffA);
            PG8_WAIT_V(8); PG8_WAIT_L(0); PG8_BAR; PG8_MMA(0, 0, At, B0); PG8_MMA(0, 1, At, B1); PG8_BAR; PG8_SCHED;
            PG8_LDA(At, 0, 1); PG8_STAGE(PG8_SB(0, 0), b2, voffB); PG8_STAGE(PG8_SB(0, 1), b2 + hstep, voffB); PG8_STAGE(PG8_SA(0, 0), a2, voffA);
            PG8_WAIT_V(8); PG8_WAIT_L(0); PG8_BAR; PG8_MMA(1, 0, At, B0); PG8_MMA(1, 1, At, B1); PG8_BAR; PG8_SCHED;
            PG8_LDB(B0, 1, 0); PG8_LDB(B1, 1, 1); PG8_SCHED; PG8_LDA(At, 1, 0); PG8_STAGE(PG8_SA(0, 1), a2 + hstep, voffA);
            PG8_WAIT_V(8); PG8_WAIT_L(0); PG8_BAR; PG8_MMA(0, 0, At, B0); PG8_MMA(0, 1, At, B1); PG8_BAR; PG8_SCHED;
            PG8_LDA(At, 1, 1); PG8_STAGE(PG8_SB(1, 0), b3, voffB); PG8_STAGE(PG8_SB(1, 1), b3 + hstep, voffB); PG8_STAGE(PG8_SA(1, 0), a3, voffA);
            PG8_WAIT_V(8); PG8_WAIT_L(0); PG8_BAR; PG8_MMA(1, 0, At, B0); PG8_MMA(1, 1, At, B1); PG8_BAR; PG8_SCHED;
            } else {
            PG8_LDB(B0, 0, 0); PG8_SCHED; PG8_LDA(At, 0, 0); PG8_STAGE(PG8_SA(1, 1), a1 + hstep, voffA);
            PG8_WAIT_L(8); PG8_BAR; PG8_WAIT_L(0); PG8_MMA(0, 0, At, B0); PG8_BAR; PG8_SCHED;
            PG8_LDB(B1, 0, 1); PG8_STAGE(PG8_SB(0, 0), b2, voffB);
            PG8_BAR; PG8_WAIT_L(0); PG8_MMA(0, 1, At, B1); PG8_BAR;
            PG8_LDA(At, 0, 1); PG8_STAGE(PG8_SA(0, 0), a2, voffA);
            PG8_BAR; PG8_WAIT_L(0); PG8_MMA(1, 0, At, B0); PG8_BAR; PG8_SCHED;
            PG8_STAGE(PG8_SB(0, 1), b2 + hstep, voffB);
            PG8_WAIT_V(6); PG8_BAR; PG8_MMA(1, 1, At, B1); PG8_BAR;
            PG8_LDB(B0, 1, 0); PG8_SCHED; PG8_LDA(At, 1, 0); PG8_STAGE(PG8_SA(0, 1), a2 + hstep, voffA);
            PG8_WAIT_L(8); PG8_BAR; PG8_WAIT_L(0); PG8_MMA(0, 0, At, B0); PG8_BAR; PG8_SCHED;
            PG8_LDB(B1, 1, 1); PG8_STAGE(PG8_SB(1, 0), b3, voffB);
            PG8_BAR; PG8_WAIT_L(0); PG8_MMA(0, 1, At, B1); PG8_BAR;
            PG8_LDA(At, 1, 1); PG8_STAGE(PG8_SA(1, 0), a3, voffA);
            PG8_BAR; PG8_WAIT_L(0); PG8_MMA(1, 0, At, B0); PG8_BAR; PG8_SCHED;
            PG8_STAGE(PG8_SB(1, 1), b3 + hstep, voffB);
            PG8_WAIT_V(6); PG8_BAR; PG8_MMA(1, 1, At, B1); PG8_BAR;
            }
        }
        if constexpr (ALIGN_EPI) { if (wr == 0) PG8_BAR; }
        if constexpr (!Epi::AFTER_DRAIN) { E(acc, cur, wr, wc, fr, fq); S.done(cur); }
        if (!has_next) break;
#pragma unroll
        for (int a = 0; a < 2; ++a)
#pragma unroll
            for (int b = 0; b < 2; ++b)
#pragma unroll
                for (int m = 0; m < 4; ++m)
#pragma unroll
                    for (int n = 0; n < 2; ++n) acc[a][b][m][n] = (f32x4){0.f, 0.f, 0.f, 0.f};
        cur = nxt; cA = nA; cB = nB; ++ui;
        if constexpr (ALIGN_EPI) { if (wr == 1) PG8_BAR; }
    }
    PG8_WAIT_V(0);
    if constexpr (!ALIGN_EPI) { if (wr == 0) PG8_BAR; }
    PG8_BAR;
    if constexpr (Epi::AFTER_DRAIN) { E.fused(acc, cur, wr, wc, fr, fq, lds, wid, lane); S.done(cur); }
#undef PG8_SA
#undef PG8_SB
#undef PG8_STAGE
#undef PG8_LDA
#undef PG8_LDB
#undef PG8_MMA
#undef PG8_WAIT_V
#undef PG8_WAIT_L
#undef PG8_BAR
#undef PG8_SCHED
}
}

constexpr int T_TOK = 32768;
constexpr int SEQ = 4096;
constexpr float LOG2E = 1.4426950408889634f;
constexpr float FOX_QS = 0.125f * 1.4426950408889634f;
constexpr float MLA_QS = 0.10206207261596575f * 1.4426950408889634f;
constexpr float EPS = 1e-6f;

constexpr size_t W_IN = 0, W_GATE = 4063232, W_UQ = 7208960, W_UKV = 7503872, W_OF = 7766016, W_OM = 8290304, W_OS = 8814592,
                 W_OUT = 9338880, W_FGU = 10387456, W_FD = 16154624, W_LAYER = 19038208;

constexpr int SMEM_BYTES = 2 * 74752 + 64 + 16;

struct Params {
    const float* x; const float* c; const int* pos;
    const float* g_mix; const float* w_ada; const float* b_ada; const float* w_in; const float* b_fox_f;
    const float* g_mla_q; const float* w_mla_uq; const float* g_mla_kv; const float* w_mla_ukv;
    const float* w_o_fox; const float* w_o_mla; const float* w_o_sb; const float* w_out;
    const float* g_ffn; const float* w_ffn_gate; const float* w_ffn_up; const float* w_ffn_down; const float* g_final;
    float* out;
    bf16_t* wt; float* mod; float* ropetab; float* logf; float* cum;
    bf16_t* u; bf16_t* qf; bf16_t* kf; bf16_t* vtf; bf16_t* qs; bf16_t* ks; bf16_t* vts;
    bf16_t* ql; bf16_t* kvl; bf16_t* kr; bf16_t* qn; bf16_t* qr; bf16_t* kn; bf16_t* vtm;
    bf16_t* merged; bf16_t* h;
    unsigned* bar; float* kmax;
    bf16_t* gs0; bf16_t* gs1; bf16_t* gs2;
};
typedef const __attribute__((address_space(4))) Params* KargPtr;
#if defined(__HIP_DEVICE_COMPILE__)
__device__ __forceinline__ KargPtr karg() { KargPtr pp = (KargPtr)__builtin_amdgcn_kernarg_segment_ptr(); asm volatile("" : "+s"(pp)); return pp; }
#else
__device__ __forceinline__ KargPtr karg() { return nullptr; }
#endif

__device__ double ROPE_POLY[11] = {-1.0 / 6, 1.0 / 120, -1.0 / 5040, 1.0 / 362880, -1.0 / 39916800,
    -0.5, 1.0 / 24, -1.0 / 720, 1.0 / 40320, -1.0 / 3628800, 1.0 / 479001600};
__device__ const float ROPE_INV[16] = {1.0f, 0.5623413324356079f, 0.3162277638912201f, 0.17782793939113617f, 0.10000000149011612f, 0.05623413249850273f,
    0.03162277489900589f, 0.017782794311642647f, 0.009999999776482582f, 0.005623413249850273f, 0.003162277629598975f, 0.0017782794311642647f,
    0.0010000000474974513f, 0.000562341301701963f, 0.0003162277571391314f, 0.00017782794020604342f};

typedef __bf16 bf16x2_t __attribute__((ext_vector_type(2)));
typedef float f32x2_t __attribute__((ext_vector_type(2)));
DI unsigned pack_bf16(float lo, float hi) { const f32x2_t v = {lo, hi}; const bf16x2_t b = __builtin_convertvector(v, bf16x2_t); return __builtin_bit_cast(unsigned, b); }
DI bf16_t f2bf(float x) { return (bf16_t)(pack_bf16(x, 0.f) & 0xffffu); }
DI int vhalf() { return __builtin_amdgcn_readfirstlane((int)(threadIdx.x >> 8)); }
DI int tidx() { int t = threadIdx.x & 255; asm volatile("" : "+v"(t)); return t; }
DI int bidx() { int t = __builtin_amdgcn_readfirstlane((int)(blockIdx.x * 2 + (threadIdx.x >> 8))); asm volatile("" : "+s"(t)); return t; }
DI int gdim() { int t = gridDim.x * 2; asm volatile("" : "+s"(t)); return t; }
constexpr int VSMEM = 74752;
constexpr int FLAGS_OFF = 2 * VSMEM;
DI float fexp2(float x) { return __builtin_amdgcn_exp2f(x); }
DI float flog2(float x) { return __builtin_amdgcn_logf(x); }
DI float frcp(float x) { return __builtin_amdgcn_rcpf(x); }
DI float sigmoidf_(float x) { return frcp(1.0f + fexp2(-x * LOG2E)); }

DI bool next_tile(int it, int MT, int NT, int& mt, int& nt) {
    const int perx = gdim() >> 3, xcd = bidx() & 7, slot = bidx() >> 3;
    const long L = ((long)it * 8 + xcd) * perx + slot;
    if (L >= (long)MT * NT) return false;
    const int gsz = 8 * NT; const int grp = (int)(L / gsz), wi = (int)(L % gsz);
    mt = grp * 8 + (wi & 7); nt = wi >> 3; return true;
}

template <int BK>
DI void gemm_mainloop(const bf16_t* A, int lda, const bf16_t* B, int ldb, int K, f32x16 (&acc)[2][2], unsigned char* smem) {
    constexpr int CPR = BK / 8;
    constexpr int RPP = 256 / CPR;
    constexpr int NJ = 128 / RPP;
    constexpr int ROWB = BK * 2 + 16;
    constexpr int OPB = 128 * ROWB;
    constexpr int STB = 2 * OPB;
    constexpr int PASSB = RPP * ROWB;
    const int tid = tidx(), lane = tid & 63, w = tid >> 6, wm = w >> 1, wn = w & 1, r = lane & 31, hh = lane >> 5;
    const int lrow = tid / CPR, lcol = (tid % CPR) * 8;
    const bf16_t* ap = A + (size_t)lrow * lda + lcol;
    const bf16_t* bp = B + (size_t)lrow * ldb + lcol;
    const size_t astep = (size_t)RPP * lda, bstep = (size_t)RPP * ldb;
    const int st_off = lrow * ROWB + (tid % CPR) * 16;
    u32x4 ra0, ra1, ra2, ra3, rb0, rb1, rb2, rb3;
    ra0 = *(const u32x4*)(ap); rb0 = *(const u32x4*)(bp);
    ra1 = *(const u32x4*)(ap + astep); rb1 = *(const u32x4*)(bp + bstep);
    if constexpr (NJ == 4) { ra2 = *(const u32x4*)(ap + 2 * astep); rb2 = *(const u32x4*)(bp + 2 * bstep); ra3 = *(const u32x4*)(ap + 3 * astep); rb3 = *(const u32x4*)(bp + 3 * bstep); }
    else { ra2 = ra0; ra3 = ra0; rb2 = rb0; rb3 = rb0; }
#define GEMM_STAGE(D_) do { unsigned char* d_ = (D_); \
        *(u32x4*)(d_) = ra0; *(u32x4*)(d_ + OPB) = rb0; *(u32x4*)(d_ + PASSB) = ra1; *(u32x4*)(d_ + OPB + PASSB) = rb1; \
        if constexpr (NJ == 4) { *(u32x4*)(d_ + 2 * PASSB) = ra2; *(u32x4*)(d_ + OPB + 2 * PASSB) = rb2; *(u32x4*)(d_ + 3 * PASSB) = ra3; *(u32x4*)(d_ + OPB + 3 * PASSB) = rb3; } } while (0)
    GEMM_STAGE(smem + st_off);
    __syncthreads();
    const int nk = K / BK;
    const int rdA = (wm * 64 + r) * ROWB + hh * 16;
    const int rdB = OPB + (wn * 64 + r) * ROWB + hh * 16;
#define GEMM_FRAGS(KS_, A0_, A1_, B0_, B1_) do { \
        A0_ = *(const bf16x8*)(sa + (KS_) * 32); A1_ = *(const bf16x8*)(sa + 32 * ROWB + (KS_) * 32); \
        B0_ = *(const bf16x8*)(sb + (KS_) * 32); B1_ = *(const bf16x8*)(sb + 32 * ROWB + (KS_) * 32); } while (0)
#define GEMM_MFMA4(A0_, A1_, B0_, B1_) do { \
        acc[0][0] = MFMA(A0_, B0_, acc[0][0]); acc[0][1] = MFMA(A0_, B1_, acc[0][1]); \
        acc[1][0] = MFMA(A1_, B0_, acc[1][0]); acc[1][1] = MFMA(A1_, B1_, acc[1][1]); } while (0)
#define GEMM_COMPUTE(BUF_) do { \
        const unsigned char* sa = smem + (BUF_) * STB + rdA; \
        const unsigned char* sb = smem + (BUF_) * STB + rdB; \
        bf16x8 fa0, fa1, fb0, fb1, ga0, ga1, gb0, gb1; \
        GEMM_FRAGS(0, fa0, fa1, fb0, fb1); \
        GEMM_FRAGS(1, ga0, ga1, gb0, gb1); \
        __builtin_amdgcn_sched_barrier(0); \
        GEMM_MFMA4(fa0, fa1, fb0, fb1); \
        if constexpr (BK == 64) { \
            __builtin_amdgcn_sched_barrier(0); \
            GEMM_FRAGS(2, fa0, fa1, fb0, fb1); \
            __builtin_amdgcn_sched_barrier(0); \
            GEMM_MFMA4(ga0, ga1, gb0, gb1); \
            __builtin_amdgcn_sched_barrier(0); \
            GEMM_FRAGS(3, ga0, ga1, gb0, gb1); \
            __builtin_amdgcn_sched_barrier(0); \
            GEMM_MFMA4(fa0, fa1, fb0, fb1); \
        } \
        __builtin_amdgcn_sched_barrier(0); \
        GEMM_MFMA4(ga0, ga1, gb0, gb1); \
    } while (0)
    for (int kt = 0; kt < nk - 1; ++kt) {
        const int buf = kt & 1;
        ap += BK; bp += BK;
        GLOAD16(ra0, ap); GLOAD16(rb0, bp); GLOAD16(ra1, ap + astep); GLOAD16(rb1, bp + bstep);
        if constexpr (NJ == 4) { GLOAD16(ra2, ap + 2 * astep); GLOAD16(rb2, bp + 2 * bstep); GLOAD16(ra3, ap + 3 * astep); GLOAD16(rb3, bp + 3 * bstep); }
        __builtin_amdgcn_sched_barrier(0);
        GEMM_COMPUTE(buf);
        __builtin_amdgcn_sched_barrier(0);
        if constexpr (NJ == 4) asm volatile("s_waitcnt vmcnt(0)" : "+v"(ra0), "+v"(rb0), "+v"(ra1), "+v"(rb1), "+v"(ra2), "+v"(rb2), "+v"(ra3), "+v"(rb3));
        else asm volatile("s_waitcnt vmcnt(0)" : "+v"(ra0), "+v"(rb0), "+v"(ra1), "+v"(rb1));
        GEMM_STAGE(smem + (buf ^ 1) * STB + st_off);
        __syncthreads();
    }
    GEMM_COMPUTE((nk - 1) & 1);
    __syncthreads();
#undef GEMM_COMPUTE
#undef GEMM_MFMA4
#undef GEMM_FRAGS
#undef GEMM_STAGE
}


DI void gemm_big(const bf16_t* P, int ldp, const bf16_t* Q, int ldq, int K, f32x16 (&acc)[2][4], unsigned char* smem) {
    constexpr int ROWB = 80, PB = 128 * ROWB, STB = 384 * ROWB, PASSB = 64 * ROWB;
    const int tid = tidx(), lane = tid & 63, w = tid >> 6, wm = w >> 1, wn = w & 1, r = lane & 31, hh = lane >> 5;
    const int lrow = tid >> 2, lcol = (tid & 3) * 8;
    const bf16_t* pp = P + (size_t)lrow * ldp + lcol;
    const bf16_t* qp = Q + (size_t)lrow * ldq + lcol;
    const size_t pstep = (size_t)64 * ldp, qstep = (size_t)64 * ldq;
    const int st_off = lrow * ROWB + (tid & 3) * 16;
    u32x4 rp0, rp1, rq0, rq1, rq2, rq3;
    rp0 = *(const u32x4*)(pp); rp1 = *(const u32x4*)(pp + pstep);
    rq0 = *(const u32x4*)(qp); rq1 = *(const u32x4*)(qp + qstep); rq2 = *(const u32x4*)(qp + 2 * qstep); rq3 = *(const u32x4*)(qp + 3 * qstep);
#define BIG_STAGE(D_) do { unsigned char* d_ = (D_); \
        *(u32x4*)(d_) = rp0; *(u32x4*)(d_ + PASSB) = rp1; \
        *(u32x4*)(d_ + PB) = rq0; *(u32x4*)(d_ + PB + PASSB) = rq1; *(u32x4*)(d_ + PB + 2 * PASSB) = rq2; *(u32x4*)(d_ + PB + 3 * PASSB) = rq3; } while (0)
    BIG_STAGE(smem + st_off);
    __syncthreads();
    const int nk = K >> 5;
    const int rdP = (wm * 64 + r) * ROWB + hh * 16;
    const int rdQ = PB + (wn * 128 + r) * ROWB + hh * 16;
#define BIG_FRAGS(KS_, A0_, A1_, B0_, B1_, B2_, B3_) do { \
        A0_ = *(const bf16x8*)(sp + (KS_) * 32); A1_ = *(const bf16x8*)(sp + 32 * ROWB + (KS_) * 32); \
        B0_ = *(const bf16x8*)(sq + (KS_) * 32); B1_ = *(const bf16x8*)(sq + 32 * ROWB + (KS_) * 32); \
        B2_ = *(const bf16x8*)(sq + 64 * ROWB + (KS_) * 32); B3_ = *(const bf16x8*)(sq + 96 * ROWB + (KS_) * 32); } while (0)
#define BIG_MFMA8(A0_, A1_, B0_, B1_, B2_, B3_) do { \
        acc[0][0] = MFMA(A0_, B0_, acc[0][0]); acc[0][1] = MFMA(A0_, B1_, acc[0][1]); acc[0][2] = MFMA(A0_, B2_, acc[0][2]); acc[0][3] = MFMA(A0_, B3_, acc[0][3]); \
        acc[1][0] = MFMA(A1_, B0_, acc[1][0]); acc[1][1] = MFMA(A1_, B1_, acc[1][1]); acc[1][2] = MFMA(A1_, B2_, acc[1][2]); acc[1][3] = MFMA(A1_, B3_, acc[1][3]); } while (0)
#define BIG_COMPUTE(BUF_) do { \
        const unsigned char* sp = smem + (BUF_) * STB + rdP; \
        const unsigned char* sq = smem + (BUF_) * STB + rdQ; \
        bf16x8 fa0, fa1, fb0, fb1, fb2, fb3, ga0, ga1, gb0, gb1, gb2, gb3; \
        BIG_FRAGS(0, fa0, fa1, fb0, fb1, fb2, fb3); \
        BIG_FRAGS(1, ga0, ga1, gb0, gb1, gb2, gb3); \
        __builtin_amdgcn_sched_barrier(0); \
        BIG_MFMA8(fa0, fa1, fb0, fb1, fb2, fb3); \
        __builtin_amdgcn_sched_barrier(0); \
        BIG_MFMA8(ga0, ga1, gb0, gb1, gb2, gb3); \
    } while (0)
    for (int kt = 0; kt < nk - 1; ++kt) {
        const int buf = kt & 1;
        pp += 32; qp += 32;
        GLOAD16(rp0, pp); GLOAD16(rq0, qp); GLOAD16(rp1, pp + pstep); GLOAD16(rq1, qp + qstep); GLOAD16(rq2, qp + 2 * qstep); GLOAD16(rq3, qp + 3 * qstep);
        __builtin_amdgcn_sched_barrier(0);
        BIG_COMPUTE(buf);
        __builtin_amdgcn_sched_barrier(0);
        asm volatile("s_waitcnt vmcnt(0)" : "+v"(rp0), "+v"(rp1), "+v"(rq0), "+v"(rq1), "+v"(rq2), "+v"(rq3));
        BIG_STAGE(smem + (buf ^ 1) * STB + st_off);
        __syncthreads();
    }
    BIG_COMPUTE((nk - 1) & 1);
    __syncthreads();
#undef BIG_COMPUTE
#undef BIG_MFMA8
#undef BIG_FRAGS
#undef BIG_STAGE
}
DI void zero_big(f32x16 (&acc)[2][4]) {
#pragma unroll
    for (int a = 0; a < 2; ++a)
#pragma unroll
        for (int b = 0; b < 4; ++b)
#pragma unroll
            for (int i = 0; i < 16; ++i) acc[a][b][i] = 0.f;
}
DI void stage_store_big(const f32x16 (&acc)[2][4], bf16_t* dst, int ld, unsigned char* smem) {
    const int tid = tidx(), lane = tid & 63, w = tid >> 6, wm = w >> 1, wn = w & 1, r = lane & 31, hh = lane >> 5;
#pragma unroll
    for (int qi = 0; qi < 4; ++qi) {
        unsigned char* trow = smem + (wn * 128 + qi * 32 + r) * 272 + (wm * 64 + 4 * hh) * 2;
#pragma unroll
        for (int pi = 0; pi < 2; ++pi)
#pragma unroll
            for (int g = 0; g < 4; ++g) {
                u32x2 pk; pk.x = pack_bf16(acc[pi][qi][4 * g], acc[pi][qi][4 * g + 1]); pk.y = pack_bf16(acc[pi][qi][4 * g + 2], acc[pi][qi][4 * g + 3]);
                *(u32x2*)(trow + (pi * 32 + 8 * g) * 2) = pk;
            }
    }
    __syncthreads();
    const int q0 = tid >> 4, x = tid & 15;
#pragma unroll
    for (int j = 0; j < 16; ++j) {
        const uint4 v = *(const uint4*)(smem + (q0 + 16 * j) * 272 + x * 16);
        *(uint4*)(dst + (size_t)(q0 + 16 * j) * ld + x * 8) = v;
    }
    __syncthreads();
}
DI void scale_big(f32x16 (&acc)[2][4], float sc) {
#pragma unroll
    for (int a = 0; a < 2; ++a)
#pragma unroll
        for (int b = 0; b < 4; ++b)
#pragma unroll
            for (int i = 0; i < 16; ++i) acc[a][b][i] *= sc;
}
DI void scale_big_q(f32x16 (&acc)[2][4], const float* rs, float sc) {
    const int lane = tidx() & 63, wn = (tidx() >> 6) & 1, r = lane & 31;
#pragma unroll
    for (int qi = 0; qi < 4; ++qi) { const float f = rs[wn * 128 + qi * 32 + r] * sc;
#pragma unroll
        for (int pi = 0; pi < 2; ++pi)
#pragma unroll
            for (int i = 0; i < 16; ++i) acc[pi][qi][i] *= f; }
}
DI void scale_big_p(f32x16 (&acc)[2][4], const float* rs) {
    const int lane = tidx() & 63, wm = tidx() >> 7, hh = lane >> 5;
#pragma unroll
    for (int pi = 0; pi < 2; ++pi)
#pragma unroll
        for (int g = 0; g < 4; ++g) { const f32x4 f = *(const f32x4*)(rs + wm * 64 + pi * 32 + 8 * g + 4 * hh);
#pragma unroll
            for (int qi = 0; qi < 4; ++qi)
#pragma unroll
                for (int e = 0; e < 4; ++e) acc[pi][qi][4 * g + e] *= f[e]; }
}
DI long tile_linear(int it, long total) {
    const int perx = gdim() >> 3, xcd = bidx() & 7, slot = bidx() >> 3;
    const long L = ((long)it * 8 + xcd) * perx + slot;
    return L < total ? L : -1;
}
DI void tile_decode(int L, int NT, int& mt, int& nt) { const int gsz = 8 * NT; const int grp = L / gsz, wi = L % gsz; mt = grp * 8 + (wi & 7); nt = wi >> 3; }

DI void zero_acc(f32x16 (&acc)[2][2]) {
#pragma unroll
    for (int a = 0; a < 2; ++a)
#pragma unroll
        for (int b = 0; b < 2; ++b)
#pragma unroll
            for (int i = 0; i < 16; ++i) acc[a][b][i] = 0.f;
}

DI void stage_store_128(const f32x16 (&acc)[2][2], bf16_t* dst, int ld, unsigned char* smem) {
    const int tid = tidx(), lane = tid & 63, w = tid >> 6, wm = w >> 1, wn = w & 1, r = lane & 31, hh = lane >> 5;
#pragma unroll
    for (int qi = 0; qi < 2; ++qi) {
        unsigned char* trow = smem + (wn * 64 + qi * 32 + r) * 272 + (wm * 64 + 4 * hh) * 2;
#pragma unroll
        for (int pi = 0; pi < 2; ++pi)
#pragma unroll
            for (int g = 0; g < 4; ++g) {
                u32x2 pk; pk.x = pack_bf16(acc[pi][qi][4 * g], acc[pi][qi][4 * g + 1]); pk.y = pack_bf16(acc[pi][qi][4 * g + 2], acc[pi][qi][4 * g + 3]);
                *(u32x2*)(trow + (pi * 32 + 8 * g) * 2) = pk;
            }
    }
    __syncthreads();
    const int q0 = tid >> 4, x = tid & 15;
#pragma unroll
    for (int j = 0; j < 8; ++j) {
        const uint4 v = *(const uint4*)(smem + (q0 + 16 * j) * 272 + x * 16);
        *(uint4*)(dst + (size_t)(q0 + 16 * j) * ld + x * 8) = v;
    }
    __syncthreads();
}
DI void stage_store_vt(const f32x16 (&acc)[2][2], bf16_t* vt, int b, int cv0, int s0, unsigned char* smem) {
    const int tid = tidx(), lane = tid & 63, w = tid >> 6, wm = w >> 1, wn = w & 1, r = lane & 31, hh = lane >> 5;
#pragma unroll
    for (int qi = 0; qi < 2; ++qi) {
        unsigned char* trow = smem + (wn * 64 + qi * 32 + r) * 272 + (wm * 64 + 4 * hh) * 2;
#pragma unroll
        for (int pi = 0; pi < 2; ++pi)
#pragma unroll
            for (int g = 0; g < 4; ++g) {
                u32x2 pk; pk.x = pack_bf16(acc[pi][qi][4 * g], acc[pi][qi][4 * g + 1]); pk.y = pack_bf16(acc[pi][qi][4 * g + 2], acc[pi][qi][4 * g + 3]);
                *(u32x2*)(trow + (pi * 32 + 8 * g) * 2) = pk;
            }
    }
    __syncthreads();
    const int q0 = tid >> 4, x = tid & 15;
#pragma unroll
    for (int j = 0; j < 8; ++j) {
        const int cv = cv0 + q0 + 16 * j, sq = s0 + 8 * x;
        const uint4 v = *(const uint4*)(smem + (q0 + 16 * j) * 272 + x * 16);
        *(uint4*)(vt + (size_t)(b * 8 + (cv >> 6)) * SEQ * 64 + (size_t)(sq >> 6) * 4096 + (cv & 63) * 64 + (sq & 63)) = v;
    }
    __syncthreads();
}
DI void scale_acc(f32x16 (&acc)[2][2], float sc) {
#pragma unroll
    for (int a = 0; a < 2; ++a)
#pragma unroll
        for (int b = 0; b < 2; ++b)
#pragma unroll
            for (int i = 0; i < 16; ++i) acc[a][b][i] *= sc;
}
DI void scale_acc_q(f32x16 (&acc)[2][2], const float* rs, float sc) {
    const int lane = tidx() & 63, wn = (tidx() >> 6) & 1, r = lane & 31;
#pragma unroll
    for (int qi = 0; qi < 2; ++qi) { const float f = rs[wn * 64 + qi * 32 + r] * sc;
#pragma unroll
        for (int pi = 0; pi < 2; ++pi)
#pragma unroll
            for (int i = 0; i < 16; ++i) acc[pi][qi][i] *= f; }
}
DI void scale_acc_p(f32x16 (&acc)[2][2], const float* rs) {
    const int lane = tidx() & 63, wm = tidx() >> 7, hh = lane >> 5;
#pragma unroll
    for (int pi = 0; pi < 2; ++pi)
#pragma unroll
        for (int g = 0; g < 4; ++g) { const f32x4 f = *(const f32x4*)(rs + wm * 64 + pi * 32 + 8 * g + 4 * hh);
#pragma unroll
            for (int qi = 0; qi < 2; ++qi)
#pragma unroll
                for (int e = 0; e < 4; ++e) acc[pi][qi][4 * g + e] *= f[e]; }
}

DI int map_col(int map, int n) {
    switch (map) {
    case 1:
        if (n < 1024) return n;
        if (n < 2048) return 2216 + (n - 1024);
        if (n < 2432) return 1544 + (n - 2048);
        if (n < 2688) return 1928 + (n - 2432);
        if (n < 2816) { const int c = n - 2688; if (c < 16) return 2184 + c; if (c < 32) return 2200 + (c - 16); if (c < 40) return 1536 + (c - 32); return -1; }
        if (n < 3328) return 1024 + (n - 2816);
        if (n < 3840) return 3240 + (n - 3328);
        return -1;
    case 2: return 3752 + n;
    case 3:
        if (n < 512) return (n >> 6) * 96 + (n & 63);
        { const int cc = n - 512, tt = cc >> 7, c7 = cc & 127, wn = c7 >> 6, ni = (c7 >> 5) & 1, c = c7 & 31; const int head = tt * 4 + wn * 2 + (c >> 4); return head * 96 + 64 + ni * 16 + (c & 15); }
    case 4:
        if (n < 512) return (n >> 6) * 128 + (n & 63);
        { const int n2 = n - 512; return (n2 >> 6) * 128 + 64 + (n2 & 63); }
    case 5: return (n >> 5) * 16 + (n & 15);
    default: return n;
    }
}

DI void transpose_tile(const float* __restrict__ src, const float* __restrict__ src2, int ld, int K, bf16_t* __restrict__ dst, int map, const float* __restrict__ kscale, int n0, int k0, float* tile) {
    const int tid = tidx(), tx = tid & 63, ty = tid >> 6;
    const int sc = map_col(map, n0 + tx);
    if (map == 5 && (((n0 + tx) >> 4) & 1)) src = src2;
    const int scc = sc < 0 ? 0 : sc;
    const float* sp = src + (size_t)(k0 + ty) * ld + scc;
    float vals[16];
#pragma unroll
    for (int j = 0; j < 16; ++j) vals[j] = sp[(size_t)(4 * j) * ld];
    if (kscale) {
#pragma unroll
        for (int j = 0; j < 16; ++j) vals[j] *= kscale[k0 + ty + 4 * j];
    }
#pragma unroll
    for (int j = 0; j < 16; ++j) tile[(ty + 4 * j) * 65 + tx] = sc < 0 ? 0.f : vals[j];
    __syncthreads();
    const int n = tid >> 2, kq = (tid & 3) * 16;
    unsigned wv[8];
#pragma unroll
    for (int j = 0; j < 8; ++j) wv[j] = pack_bf16(tile[(kq + 2 * j) * 65 + n], tile[(kq + 2 * j + 1) * 65 + n]);
    uint4* d = (uint4*)(dst + (size_t)(n0 + n) * K + k0 + kq);
    d[0] = make_uint4(wv[0], wv[1], wv[2], wv[3]);
    d[1] = make_uint4(wv[4], wv[5], wv[6], wv[7]);
    __syncthreads();
}

DI void phase_prep(KargPtr p, unsigned char* smem) {
    const int tid = tidx();
    float* fs = (float*)smem;
    constexpr int NW = 9296, NMOD = 192, NROPE = 2048;
    for (int item = bidx(); item < NW + NMOD + NROPE; item += gdim()) {
        if (item < NW) {
            const int l = item / 4648; int ti = item % 4648;
            const float* src; const float* src2 = nullptr; int ld, K, Nd, map; size_t doff; const float* ksc = nullptr;
            if (ti < 992)       { src = p->w_in + (size_t)l * 1024 * 6824; ld = 6824; K = 1024; Nd = 3968; doff = W_IN; map = 1; }
            else if (ti < 1760) { ti -= 992;  src = p->w_in + (size_t)l * 1024 * 6824; ld = 6824; K = 1024; Nd = 3072; doff = W_GATE; map = 2; }
            else if (ti < 1832) { ti -= 1760; src = p->w_mla_uq + (size_t)l * 384 * 768; ld = 768; K = 384; Nd = 768; doff = W_UQ; map = 3; ksc = p->g_mla_q + l * 384; }
            else if (ti < 1896) { ti -= 1832; src = p->w_mla_ukv + (size_t)l * 256 * 1024; ld = 1024; K = 256; Nd = 1024; doff = W_UKV; map = 4; ksc = p->g_mla_kv + l * 256; }
            else if (ti < 2024) { ti -= 1896; src = p->w_o_fox + (size_t)l * 512 * 1024; ld = 1024; K = 512; Nd = 1024; doff = W_OF; map = 0; }
            else if (ti < 2152) { ti -= 2024; src = p->w_o_mla + (size_t)l * 512 * 1024; ld = 1024; K = 512; Nd = 1024; doff = W_OM; map = 0; }
            else if (ti < 2280) { ti -= 2152; src = p->w_o_sb + (size_t)l * 512 * 1024; ld = 1024; K = 512; Nd = 1024; doff = W_OS; map = 0; }
            else if (ti < 2536) { ti -= 2280; src = p->w_out + (size_t)l * 1024 * 1024; ld = 1024; K = 1024; Nd = 1024; doff = W_OUT; map = 0; }
            else if (ti < 3944) { ti -= 2536; src = p->w_ffn_gate + (size_t)l * 1024 * 2816; src2 = p->w_ffn_up + (size_t)l * 1024 * 2816; ld = 2816; K = 1024; Nd = 5632; doff = W_FGU; map = 5; }
            else                { ti -= 3944; src = p->w_ffn_down + (size_t)l * 2816 * 1024; ld = 1024; K = 2816; Nd = 1024; doff = W_FD; map = 0; }
            (void)Nd;
            const int kts = K >> 6; const int ntile = ti / kts, ktile = ti % kts;
            transpose_tile(src, src2, ld, K, p->wt + (size_t)l * W_LAYER + doff, map, ksc, ntile * 64, ktile * 64, fs);
        } else if (item < NW + NMOD) {
            const int mi = item - NW; const int l = mi / 96, c0 = (mi % 96) * 64;
            float* cond = fs;
            float* red = fs + 8192;
            for (int e = tid; e < 8192; e += 256) { const float cv = p->c[e]; cond[e] = cv * sigmoidf_(cv); }
            __syncthreads();
            const int tx = tid & 63, ty = tid >> 6;
            float a0 = 0, a1 = 0, a2 = 0, a3 = 0, a4 = 0, a5 = 0, a6 = 0, a7 = 0;
            const float* wsrc = p->w_ada + (size_t)l * 1024 * 6144 + c0 + tx;
#pragma unroll 8
            for (int k = ty * 256; k < ty * 256 + 256; ++k) {
                const float wv = wsrc[(size_t)k * 6144];
                a0 += cond[k] * wv; a1 += cond[1024 + k] * wv; a2 += cond[2048 + k] * wv; a3 += cond[3072 + k] * wv;
                a4 += cond[4096 + k] * wv; a5 += cond[5120 + k] * wv; a6 += cond[6144 + k] * wv; a7 += cond[7168 + k] * wv;
            }
            float* rr = red + ty * 512 + tx;
            rr[0] = a0; rr[64] = a1; rr[128] = a2; rr[192] = a3; rr[256] = a4; rr[320] = a5; rr[384] = a6; rr[448] = a7;
            __syncthreads();
            for (int o = tid; o < 512; o += 256) {
                const int b = o >> 6, xx = o & 63;
                const float s = red[o] + red[512 + o] + red[1024 + o] + red[1536 + o] + p->b_ada[l * 6144 + c0 + xx];
                p->mod[(size_t)(l * 8 + b) * 6144 + c0 + xx] = s;
            }
            __syncthreads();
        } else {
            const int e = (item - NW - NMOD) * 256 + tid;
            const int i = e & 15, tok = e >> 4;
            const float ang = (float)p->pos[tok] * ROPE_INV[i];
            const double a = (double)ang;
            const double kq = rint(a * 0.63661977236758134308);
            const double rr = fma(-kq, 1.57079632679489661923, a);
            const double r2 = rr * rr;
            const double* C = ROPE_POLY;
            const double sn = rr * (1.0 + r2 * (C[0] + r2 * (C[1] + r2 * (C[2] + r2 * (C[3] + r2 * C[4])))));
            const double cs = 1.0 + r2 * (C[5] + r2 * (C[6] + r2 * (C[7] + r2 * (C[8] + r2 * (C[9] + r2 * C[10])))));
            const int q = ((int)(long long)kq) & 3;
            const double co = (q == 0) ? cs : (q == 1) ? -sn : (q == 2) ? -cs : sn;
            const double si = (q == 0) ? sn : (q == 1) ? cs : (q == 2) ? -sn : -cs;
            p->ropetab[2 * (size_t)e] = (float)co; p->ropetab[2 * (size_t)e + 1] = (float)si;
        }
    }
}

DI float wave_sum(float v) {
#pragma unroll
    for (int o = 32; o >= 1; o >>= 1) v += __shfl_xor(v, o);
    return v;
}
DI void phase_norm(const float* __restrict__ xin, const float* __restrict__ g, const float* __restrict__ modl, int sh_idx, int sc_idx, bf16_t* __restrict__ uout) {
    const int lane = tidx() & 63, w = tidx() >> 6;
    for (int row = bidx() * 4 + w; row < T_TOK; row += gdim() * 4) {
        const int b = row >> 12;
        const f32x4* xr = (const f32x4*)(xin + (size_t)row * 1024);
        f32x4 v[4]; float ss = 0.f;
#pragma unroll
        for (int j = 0; j < 4; ++j) { v[j] = xr[lane + 64 * j]; ss += v[j][0] * v[j][0] + v[j][1] * v[j][1] + v[j][2] * v[j][2] + v[j][3] * v[j][3]; }
        ss = wave_sum(ss);
        const float rstd = rsqrtf(ss * (1.0f / 1024.0f) + EPS);
        const float* mb = modl + (size_t)b * 6144;
#pragma unroll
        for (int j = 0; j < 4; ++j) {
            const int col = 4 * (lane + 64 * j);
            const f32x4 g4 = *(const f32x4*)(g + col), sc4 = *(const f32x4*)(mb + sc_idx * 1024 + col), sh4 = *(const f32x4*)(mb + sh_idx * 1024 + col);
            float y[4];
#pragma unroll
            for (int e = 0; e < 4; ++e) y[e] = (v[j][e] * rstd) * g4[e] * (1.0f + sc4[e]) + sh4[e];
            u32x2 pk; pk.x = pack_bf16(y[0], y[1]); pk.y = pack_bf16(y[2], y[3]);
            *(u32x2*)(uout + (size_t)row * 1024 + col) = pk;
        }
    }
}
DI void phase_final(KargPtr p) {
    const int lane = tidx() & 63, w = tidx() >> 6;
    for (int row = bidx() * 4 + w; row < T_TOK; row += gdim() * 4) {
        f32x4* xr = (f32x4*)(p->out + (size_t)row * 1024);
        f32x4 v[4]; float ss = 0.f;
#pragma unroll
        for (int j = 0; j < 4; ++j) { v[j] = xr[lane + 64 * j]; ss += v[j][0] * v[j][0] + v[j][1] * v[j][1] + v[j][2] * v[j][2] + v[j][3] * v[j][3]; }
        ss = wave_sum(ss);
        const float rstd = rsqrtf(ss * (1.0f / 1024.0f) + EPS);
#pragma unroll
        for (int j = 0; j < 4; ++j) {
            const f32x4 g4 = *(const f32x4*)(p->g_final + 4 * (lane + 64 * j));
            f32x4 o;
#pragma unroll
            for (int e = 0; e < 4; ++e) o[e] = (v[j][e] * rstd) * g4[e];
            xr[lane + 64 * j] = o;
        }
    }
}

struct EpiInprojA {
    static constexpr bool PERM = false, AFTER_DRAIN = false;
    bf16_t* qf; bf16_t* kf; bf16_t* qs; bf16_t* ks; bf16_t* ql; bf16_t* kvl; bf16_t* kr; float* logf; const float* ropetab; const float* bfox;
    __device__ __forceinline__ void operator()(const pg8::f32x4 (&acc)[2][2][4][2], const pg8::Unit& u, int wr, int wc, int fr, int fq) const {
        const int row0 = u.pm * 256 + wr * 64 + fr;
        const int cw = wc * 32 + fq * 4;
#pragma unroll
        for (int bj = 0; bj < 2; ++bj) {
            bf16_t* dst; int ld; float sc = 1.0f; bool special = false;
            if (u.pn < 8) { const int region = u.pn >> 1; dst = (region == 0 ? qf : region == 1 ? kf : region == 2 ? qs : ks) + (u.pn & 1) * 256 + bj * 128; ld = 512; if (region == 0 || region == 2) sc = FOX_QS; }
            else if (u.pn == 8) { dst = ql + bj * 128; ld = 384; }
            else if (u.pn == 9) { if (bj == 0) { dst = ql + 256; ld = 384; } else { dst = kvl; ld = 256; } }
            else { dst = kvl + 128; ld = 256; special = (bj == 1); }
            if (!special) {
#pragma unroll
                for (int ai = 0; ai < 2; ++ai)
#pragma unroll
                    for (int m = 0; m < 4; ++m) {
                        bf16_t* rowp = dst + (size_t)(row0 + ai * 128 + m * 16) * ld + cw;
#pragma unroll
                        for (int n = 0; n < 2; ++n) { const pg8::f32x4 v = acc[ai][bj][m][n] * sc; u32x2 pk; pk.x = pack_bf16(v[0], v[1]); pk.y = pack_bf16(v[2], v[3]); *(u32x2*)(rowp + n * 16) = pk; }
                    }
            } else if (wc == 0) {
#pragma unroll
                for (int ai = 0; ai < 2; ++ai)
#pragma unroll
                    for (int m = 0; m < 4; ++m) {
                        const int t = row0 + ai * 128 + m * 16;
                        const pg8::f32x4 x1 = acc[ai][1][m][0], x2 = acc[ai][1][m][1];
                        const pg8::f32x4 ca = *(const pg8::f32x4*)(ropetab + 2 * (t * 16 + fq * 4)), cb = *(const pg8::f32x4*)(ropetab + 2 * (t * 16 + fq * 4) + 4);
                        const float co[4] = {ca[0], ca[2], cb[0], cb[2]}, si[4] = {ca[1], ca[3], cb[1], cb[3]};
                        float o1[4], o2[4];
#pragma unroll
                        for (int j = 0; j < 4; ++j) { o1[j] = x1[j] * co[j] - x2[j] * si[j]; o2[j] = x1[j] * si[j] + x2[j] * co[j]; }
                        u32x2 p1, p2; p1.x = pack_bf16(o1[0], o1[1]); p1.y = pack_bf16(o1[2], o1[3]); p2.x = pack_bf16(o2[0], o2[1]); p2.y = pack_bf16(o2[2], o2[3]);
                        *(u32x2*)(kr + (size_t)t * 32 + fq * 4) = p1;
                        *(u32x2*)(kr + (size_t)t * 32 + 16 + fq * 4) = p2;
                    }
            } else if (wc == 1 && fq < 2) {
#pragma unroll
                for (int ai = 0; ai < 2; ++ai)
#pragma unroll
                    for (int m = 0; m < 4; ++m) {
                        const int t = row0 + ai * 128 + m * 16, b = t >> 12, sq = t & 4095;
#pragma unroll
                        for (int j = 0; j < 4; ++j) {
                            const int head = fq * 4 + j;
                            const float f = acc[ai][1][m][0][j] + bfox[head];
                            logf[(size_t)(b * 8 + head) * SEQ + sq] = fminf(f, 0.f) - log1pf(expf(-fabsf(f)));
                        }
                    }
            }
        }
    }
};
struct EpiInprojV {
    static constexpr bool PERM = false, AFTER_DRAIN = false;
    bf16_t* vtf; bf16_t* vts;
    __device__ __forceinline__ void operator()(const pg8::f32x4 (&acc)[2][2][4][2], const pg8::Unit& u, int wr, int wc, int fr, int fq) const {
        bf16_t* vt = u.pn < 2 ? vtf : vts;
        const int row0 = u.pm * 256 + wr * 64 + fq * 4, b = row0 >> 12, s0 = row0 & 4095;
        const int cv0 = (u.pn & 1) * 256 + wc * 32 + fr;
#pragma unroll
        for (int bj = 0; bj < 2; ++bj)
#pragma unroll
            for (int n = 0; n < 2; ++n) {
                const int cv = cv0 + bj * 128 + n * 16;
                bf16_t* vp = vt + (size_t)(b * 8 + (cv >> 6)) * SEQ * 64 + (cv & 63) * 64;
#pragma unroll
                for (int ai = 0; ai < 2; ++ai)
#pragma unroll
                    for (int m = 0; m < 4; ++m) { const int sq = s0 + ai * 128 + m * 16; const pg8::f32x4 v = acc[ai][bj][m][n]; u32x2 pk; pk.x = pack_bf16(v[0], v[1]); pk.y = pack_bf16(v[2], v[3]);
                        *(u32x2*)(vp + (size_t)(sq >> 6) * 4096 + (sq & 63)) = pk; }
            }
    }
};
struct EpiFfnUp {
    static constexpr bool PERM = false, AFTER_DRAIN = false;
    bf16_t* h;
    __device__ __forceinline__ void operator()(const pg8::f32x4 (&acc)[2][2][4][2], const pg8::Unit& u, int wr, int wc, int fr, int fq) const {
        const int row0 = u.pm * 256 + wr * 64 + fr;
#pragma unroll
        for (int ai = 0; ai < 2; ++ai)
#pragma unroll
            for (int m = 0; m < 4; ++m) {
                bf16_t* rowp = h + (size_t)(row0 + ai * 128 + m * 16) * 2816 + u.pn * 128 + wc * 16 + fq * 4;
#pragma unroll
                for (int bj = 0; bj < 2; ++bj) {
                    const pg8::f32x4 g = acc[ai][bj][m][0], up = acc[ai][bj][m][1];
                    float hv[4];
#pragma unroll
                    for (int j = 0; j < 4; ++j) hv[j] = g[j] * sigmoidf_(g[j]) * up[j];
                    u32x2 pk; pk.x = pack_bf16(hv[0], hv[1]); pk.y = pack_bf16(hv[2], hv[3]);
                    *(u32x2*)(rowp + bj * 64) = pk;
                }
            }
    }
};
struct EpiResidual {
    static constexpr bool PERM = false, AFTER_DRAIN = false;
    const float* xin; float* xout; const float* modl; int gidx;
    __device__ __forceinline__ void operator()(const pg8::f32x4 (&acc)[2][2][4][2], const pg8::Unit& u, int wr, int wc, int fr, int fq) const {
        const int row0 = u.pm * 256 + wr * 64 + fr, b = row0 >> 12;
        const float* gt = modl + (size_t)b * 6144 + gidx * 1024;
#pragma unroll
        for (int bj = 0; bj < 2; ++bj)
#pragma unroll
            for (int n = 0; n < 2; ++n) {
                const int col = u.pn * 256 + bj * 128 + wc * 32 + n * 16 + fq * 4;
                const pg8::f32x4 g4 = *(const pg8::f32x4*)(gt + col);
                pg8::f32x4 xv[2][4];
#pragma unroll
                for (int ai = 0; ai < 2; ++ai)
#pragma unroll
                    for (int m = 0; m < 4; ++m) xv[ai][m] = *(const pg8::f32x4*)(xin + (size_t)(row0 + ai * 128 + m * 16) * 1024 + col);
#pragma unroll
                for (int ai = 0; ai < 2; ++ai)
#pragma unroll
                    for (int m = 0; m < 4; ++m) *(pg8::f32x4*)(xout + (size_t)(row0 + ai * 128 + m * 16) * 1024 + col) = xv[ai][m] + g4 * acc[ai][bj][m][n];
            }
    }
};
template <class Epi, bool NAT = false>
DI void big_gemm(const bf16_t* A, const bf16_t* Bt, int N, int K, const Epi& E, unsigned char* smem) {
    __syncthreads();
    pg8::StaticOrder S; S.init(T_TOK, N, (int)gridDim.x, (int)blockIdx.x);
    pg8::Gemm g; g.A = A; g.Bt = Bt; g.M = T_TOK; g.N = N; g.K = K;
    pg8::gemm_phase<Epi, pg8::StaticOrder, true, true, NAT>((PG8_LAS unsigned char*)smem, g, S, E);
    __syncthreads();
}

DI void phase_inproj(KargPtr p, int l, unsigned char* smem_phys) {
    const bf16_t* W = p->wt + (size_t)l * W_LAYER + W_IN;
    { EpiInprojA E; E.qf = p->qf; E.kf = p->kf; E.qs = p->qs; E.ks = p->ks; E.ql = p->ql; E.kvl = p->kvl; E.kr = p->kr; E.logf = p->logf; E.ropetab = p->ropetab; E.bfox = p->b_fox_f + l * 8;
      big_gemm<EpiInprojA, false>(p->u, W, 2816, 1024, E, smem_phys); }
    { EpiInprojV E; E.vtf = p->vtf; E.vts = p->vts;
      big_gemm<EpiInprojV, true>(p->u, W + (size_t)2816 * 1024, 1024, 1024, E, smem_phys); }
}

DI void phase_mla_up(KargPtr p, int l, unsigned char* smem) {
    const int tid = tidx(), lane = tid & 63, w = tid >> 6, wm = w >> 1, wn = w & 1, r = lane & 31, hh = lane >> 5;
    float* rs = (float*)(smem + 73728);
    const bf16_t* WQ = p->wt + (size_t)l * W_LAYER + W_UQ;
    const bf16_t* WKV = p->wt + (size_t)l * W_LAYER + W_UKV;
    for (int it = 0;; ++it) {
        const int L = it * gdim() + bidx(); if (L >= 3584) break;
        int mt, nt; if (L < 1536) { mt = L / 6; nt = L % 6; } else { mt = (L - 1536) >> 3; nt = 6 + ((L - 1536) & 7); }
        const int m0 = mt * 128, b = m0 >> 12, s0 = m0 & 4095;
        const bool isq = nt < 6;
        const int K = isq ? 384 : 256;
        const bf16_t* A = (isq ? p->ql : p->kvl) + (size_t)m0 * K;
        __syncthreads();
        {
            const int row = tid >> 1, half = tid & 1; const int hk = K >> 1;
            const uint4* ar = (const uint4*)(A + (size_t)row * K + half * hk);
            float ss = 0.f;
#pragma unroll 8
            for (int j = 0; j < (hk >> 3); ++j) {
                const uint4 v = ar[j];
                const unsigned uu[4] = {v.x, v.y, v.z, v.w};
#pragma unroll
                for (int e = 0; e < 4; ++e) { const float lo = __uint_as_float(uu[e] << 16), hi = __uint_as_float(uu[e] & 0xffff0000u); ss += lo * lo + hi * hi; }
            }
            ss += __shfl_xor(ss, 1);
            if (half == 0) rs[row] = rsqrtf(ss / (float)K + EPS);
        }
        __syncthreads();
        f32x16 acc[2][2]; zero_acc(acc);
        if (isq) {
            const bf16_t* Bw = WQ + (size_t)nt * 128 * 384;
            if (nt < 4) {
                gemm_mainloop<64>(Bw, 384, A, 384, 384, acc, smem);
                scale_acc_q(acc, rs, MLA_QS);
                stage_store_128(acc, p->qn + (size_t)m0 * 512 + nt * 128, 512, smem);
            } else {
                gemm_mainloop<64>(A, 384, Bw, 384, 384, acc, smem);
                const int tt = nt - 4; const int head = tt * 4 + wn * 2 + (r >> 4), ii = r & 15;
                const float* __restrict__ rt = p->ropetab; bf16_t* __restrict__ qrp = p->qr;
#pragma unroll
                for (int mi = 0; mi < 2; ++mi) {
                    const int rbase = wm * 64 + mi * 32 + 4 * hh;
                    f32x2_t cs[16];
#pragma unroll
                    for (int i = 0; i < 16; ++i) cs[i] = *(const f32x2_t*)(rt + 2 * ((m0 + rbase + 8 * (i >> 2) + (i & 3)) * 16 + ii));
#pragma unroll
                    for (int i = 0; i < 16; ++i) {
                        const int row = rbase + 8 * (i >> 2) + (i & 3);
                        const int t = m0 + row; const float sc = rs[row] * MLA_QS;
                        const float x1 = acc[mi][0][i] * sc, x2 = acc[mi][1][i] * sc;
                        qrp[t * 256 + head * 32 + ii] = f2bf(x1 * cs[i][0] - x2 * cs[i][1]);
                        qrp[t * 256 + head * 32 + 16 + ii] = f2bf(x1 * cs[i][1] + x2 * cs[i][0]);
                    }
                }
                __syncthreads(); __syncthreads();
            }
        } else {
            const int n2 = nt - 6;
            const bf16_t* Bw = WKV + (size_t)n2 * 128 * 256;
            if (n2 < 4) {
                gemm_mainloop<64>(Bw, 256, A, 256, 256, acc, smem);
                scale_acc_q(acc, rs, 1.0f);
                stage_store_128(acc, p->kn + (size_t)m0 * 512 + n2 * 128, 512, smem);
            } else {
                gemm_mainloop<64>(A, 256, Bw, 256, 256, acc, smem);
                scale_acc_p(acc, rs);
                stage_store_vt(acc, p->vtm, b, (n2 - 4) * 128, s0, smem);
            }
        }
    }
    __syncthreads();
    float* fs = (float*)smem;
    for (int bh = bidx(); bh < 64; bh += gdim()) {
        const f32x4* src = (const f32x4*)(p->logf + (size_t)bh * SEQ + tid * 16);
        f32x4 v[4];
        float run = 0.f;
#pragma unroll
        for (int j = 0; j < 4; ++j) { v[j] = src[j];
#pragma unroll
            for (int e = 0; e < 4; ++e) { run += v[j][e]; v[j][e] = run; } }
        float incl = run;
#pragma unroll
        for (int o = 1; o < 64; o <<= 1) { const float tv = __shfl_up(incl, o); if (lane >= o) incl += tv; }
        if (lane == 63) fs[w] = incl;
        __syncthreads();
        float pre = incl - run;
        for (int ww = 0; ww < w; ++ww) pre += fs[ww];
        f32x4* dst = (f32x4*)(p->cum + (size_t)bh * SEQ + tid * 16);
#pragma unroll
        for (int j = 0; j < 4; ++j) { f32x4 o;
#pragma unroll
            for (int e = 0; e < 4; ++e) o[e] = v[j][e] + pre; dst[j] = o; }
        __syncthreads();
        {
            const bf16_t* kp = p->kf + (size_t)(bh >> 3) * SEQ * 512 + (bh & 7) * 64 + (size_t)tid * 16 * 512;
            float mx = 0.f;
            for (int rr = 0; rr < 16; ++rr) {
                const uint4* q4 = (const uint4*)(kp + (size_t)rr * 512);
                uint4 vv[8];
#pragma unroll
                for (int c = 0; c < 8; ++c) vv[c] = q4[c];
                float ss = 0.f;
#pragma unroll
                for (int c = 0; c < 8; ++c) { const unsigned uu[4] = {vv[c].x, vv[c].y, vv[c].z, vv[c].w};
#pragma unroll
                    for (int e = 0; e < 4; ++e) { const float lo = __uint_as_float(uu[e] << 16), hi = __uint_as_float(uu[e] & 0xffff0000u); ss += lo * lo + hi * hi; } }
                mx = fmaxf(mx, ss);
            }
#pragma unroll
            for (int o = 32; o >= 1; o >>= 1) mx = fmaxf(mx, __shfl_xor(mx, o));
            if (lane == 0) fs[16 + w] = mx;
            __syncthreads();
            if (tid == 0) p->kmax[bh] = sqrtf(fmaxf(fmaxf(fs[16], fs[17]), fmaxf(fs[18], fs[19]))) * 1.01f;
            __syncthreads();
        }
    }
}

template <int TYPE>
DI void attn_item(KargPtr p, int b, int h, int qb, unsigned char* smem) {
    constexpr int DK = (TYPE == 1) ? 96 : (TYPE == 0 ? 80 : 64), KS = DK / 16, KROWB = (DK + 8) * 2, VROWB = 144;
    constexpr int KBYTES = 64 * KROWB, VBYTES = 64 * VROWB, BUFB = KBYTES + VBYTES + 256;
    const int tid = tidx(), lane = tid & 63, w = tid >> 6, r = lane & 31, hh = lane >> 5;
    const int q0 = qb * 128, qw = q0 + 32 * w, myq = qw + r;
    const size_t tokq = (size_t)b * SEQ + myq;
    unsigned* flags = (unsigned*)(smem - vhalf() * VSMEM + FLAGS_OFF);
    const int w8 = vhalf() * 4 + w;

    bf16x8 qfrag[KS];
    if (TYPE == 1) {
#pragma unroll
        for (int ks = 0; ks < 4; ++ks) qfrag[ks] = *(const bf16x8*)(p->qn + tokq * 512 + h * 64 + ks * 16 + hh * 8);
#pragma unroll
        for (int ks = 4; ks < KS; ++ks) qfrag[ks] = *(const bf16x8*)(p->qr + tokq * 256 + h * 32 + (ks - 4) * 16 + hh * 8);
    } else {
        const bf16_t* qg = (TYPE == 0 ? p->qf : p->qs) + tokq * 512 + h * 64;
#pragma unroll
        for (int ks = 0; ks < 4; ++ks) qfrag[ks] = *(const bf16x8*)(qg + ks * 16 + hh * 8);
        if (TYPE == 0) { const u32x4 one3 = hh == 0 ? (u32x4){0x3F803F80u, 0x00003F80u, 0u, 0u} : (u32x4){0u, 0u, 0u, 0u}; qfrag[KS - 1] = __builtin_bit_cast(bf16x8, one3); }
    }
    const bf16_t* Kg = (TYPE == 0 ? p->kf : TYPE == 1 ? p->kn : p->ks) + (size_t)b * SEQ * 512 + h * 64;
    const bf16_t* Vg = (TYPE == 0 ? p->vtf : TYPE == 1 ? p->vtm : p->vts) + (size_t)(b * 8 + h) * 64 * SEQ;
    const bf16_t* Krg = p->kr + (size_t)b * SEQ * 32;
    const float* cumg = p->cum + (size_t)(b * 8 + h) * SEQ;

    const int ntiles = 2 * qb + 2;
    u32x4 rk0A, rk1A, rv0A, rv1A, rkrA, rk0B, rk1B, rv0B, rv1B, rkrB; float rckA = 0.f, rckB = 0.f;
    rkrA = (u32x4){0u, 0u, 0u, 0u}; rkrB = rkrA;
    const int ldrow = tid >> 3, ldch = tid & 7;
    const int vpos = 16 * (ldch >> 1) + 4 * (ldch & 1);
#define LOAD_TILE(S, KT_) do { \
        const int k0_ = (KT_) * 64; \
        GLOAD16(rk0##S, Kg + (size_t)(k0_ + ldrow) * 512 + ldch * 8); \
        GLOAD16(rk1##S, Kg + (size_t)(k0_ + 32 + ldrow) * 512 + ldch * 8); \
        GLOAD16(rv0##S, Vg + (size_t)k0_ * 64 + ldrow * 64 + ldch * 8); \
        GLOAD16(rv1##S, Vg + (size_t)k0_ * 64 + (32 + ldrow) * 64 + ldch * 8); \
        if (TYPE == 1) GLOAD16(rkr##S, Krg + (size_t)(k0_ + (tid >> 2)) * 32 + (tid & 3) * 8); \
        if (TYPE == 0) GLOAD4(rck##S, cumg + k0_ + (tid & 63)); \
    } while (0)
#define WAIT_ALL(S) asm volatile("s_waitcnt vmcnt(0)" : "+v"(rk0##S), "+v"(rk1##S), "+v"(rv0##S), "+v"(rv1##S), "+v"(rkr##S), "+v"(rck##S))
#define WAIT_OLD(S) do { if (TYPE == 2) asm volatile("s_waitcnt vmcnt(4)" : "+v"(rk0##S), "+v"(rk1##S), "+v"(rv0##S), "+v"(rv1##S), "+v"(rkr##S), "+v"(rck##S)); \
        else asm volatile("s_waitcnt vmcnt(5)" : "+v"(rk0##S), "+v"(rk1##S), "+v"(rv0##S), "+v"(rv1##S), "+v"(rkr##S), "+v"(rck##S)); } while (0)
#define STORE_TILE(S, BUF_) do { \
        unsigned char* kb_ = smem + (BUF_) * BUFB; unsigned char* vb_ = kb_ + KBYTES; \
        *(u32x4*)(kb_ + ldrow * KROWB + ldch * 16) = rk0##S; \
        *(u32x4*)(kb_ + (32 + ldrow) * KROWB + ldch * 16) = rk1##S; \
        { u32x2 lo, hi; lo.x = rv0##S.x; lo.y = rv0##S.y; hi.x = rv0##S.z; hi.y = rv0##S.w; \
          *(u32x2*)(vb_ + ldrow * VROWB + vpos * 2) = lo; *(u32x2*)(vb_ + ldrow * VROWB + (vpos + 8) * 2) = hi; } \
        { u32x2 lo, hi; lo.x = rv1##S.x; lo.y = rv1##S.y; hi.x = rv1##S.z; hi.y = rv1##S.w; \
          *(u32x2*)(vb_ + (32 + ldrow) * VROWB + vpos * 2) = lo; *(u32x2*)(vb_ + (32 + ldrow) * VROWB + (vpos + 8) * 2) = hi; } \
        if (TYPE == 1) *(u32x4*)(kb_ + (tid >> 2) * KROWB + 128 + (tid & 3) * 16) = rkr##S; \
        if (TYPE == 0) { if (tid < 64) { \
            const float c_ = -rck##S * LOG2E; \
            const unsigned h_ = pack_bf16(c_, 0.f) & 0xffffu; const float r1_ = c_ - __uint_as_float(h_ << 16); \
            const unsigned m_ = pack_bf16(r1_, 0.f) & 0xffffu; const float r2_ = r1_ - __uint_as_float(m_ << 16); \
            const unsigned l_ = pack_bf16(r2_, 0.f) & 0xffffu; \
            *(u32x4*)(kb_ + tid * KROWB + 128) = (u32x4){h_ | (m_ << 16), l_, 0u, 0u}; \
            *(u32x4*)(kb_ + tid * KROWB + 144) = (u32x4){0u, 0u, 0u, 0u}; \
            if (tid == 63) *(float*)(vb_ + VBYTES) = c_; } } \
    } while (0)
#define TILE_OF(J_) ((TYPE != 1) ? (ntiles - 1 - ((J_) < ntiles ? (J_) : ntiles - 1)) : ((J_) < ntiles ? (J_) : ntiles - 1))

    f32x16 o0, o1;
#pragma unroll
    for (int i = 0; i < 16; ++i) { o0[i] = 0.f; o1[i] = 0.f; }
    float m = -1e30f, lsum = 0.f, carry = 0.f;
    bool wdone = false;
    float qbound = 0.f;
    if (TYPE == 0) {
        float ss = 0.f;
#pragma unroll
        for (int ks = 0; ks < 4; ++ks) { const u32x4 qq = __builtin_bit_cast(u32x4, qfrag[ks]);
#pragma unroll
            for (int e = 0; e < 4; ++e) { const float lo = __uint_as_float(qq[e] << 16), hi = __uint_as_float(qq[e] & 0xffff0000u); ss += lo * lo + hi * hi; } }
        ss += __shfl_xor(ss, 32);
        qbound = sqrtf(ss) * 1.01f * p->kmax[b * 8 + h];
    }

    auto compute = [&](const int kt, const int buf) __attribute__((always_inline)) {
        const unsigned char* kb = smem + buf * BUFB; const unsigned char* vb = kb + KBYTES;
        const int k0 = kt * 64;
        bool need;
        if (TYPE == 0) {
            if (!wdone && k0 <= qw + 31) wdone = (__all(qbound + *(const float*)(vb + VBYTES) - m < -150.f) != 0);
            need = (k0 <= qw + 31) && !wdone;
        }
        else if (TYPE == 1) need = (k0 <= qw);
        else need = (k0 <= qw + 30) && !wdone;
        if (need) {
            f32x16 s0, s1;
#pragma unroll
            for (int i = 0; i < 16; ++i) { s0[i] = 0.f; s1[i] = 0.f; }
#pragma unroll
            for (int ks = 0; ks < KS; ++ks) {
                const bf16x8 a0 = *(const bf16x8*)(kb + r * KROWB + ks * 32 + hh * 16);
                const bf16x8 a1 = *(const bf16x8*)(kb + (32 + r) * KROWB + ks * 32 + hh * 16);
                s0 = MFMA(a0, qfrag[ks], s0); s1 = MFMA(a1, qfrag[ks], s1);
            }
            if (TYPE != 2) {
                if (TYPE == 0) {
                    if (k0 + 63 > qw) {
                        asm volatile("");
                        const int rel = myq - k0 - 4 * hh;
#pragma unroll
                        for (int i = 0; i < 16; ++i) {
                            const int off = 8 * (i >> 2) + (i & 3);
                            if (off > rel) s0[i] = -1e30f;
                            if (off + 32 > rel) s1[i] = -1e30f;
                        }
                    }
                }
                float mx = s0[0];
#pragma unroll
                for (int i = 1; i < 16; ++i) mx = fmaxf(mx, s0[i]);
#pragma unroll
                for (int i = 0; i < 16; ++i) mx = fmaxf(mx, s1[i]);
                mx = fmaxf(mx, __shfl_xor(mx, 32));
                const float mnew = fmaxf(m, mx);
                const float alpha = fexp2(m - mnew);
                m = mnew;
                float ps = 0.f;
#pragma unroll
                for (int i = 0; i < 16; i += 2) {
                    const f32x2_t mm = {mnew, mnew};
                    const f32x2_t d0 = (f32x2_t){s0[i], s0[i + 1]} - mm, d1 = (f32x2_t){s1[i], s1[i + 1]} - mm;
                    s0[i] = fexp2(d0[0]); s0[i + 1] = fexp2(d0[1]); s1[i] = fexp2(d1[0]); s1[i + 1] = fexp2(d1[1]);
                    ps += (s0[i] + s0[i + 1]) + (s1[i] + s1[i + 1]);
                }
                lsum = lsum * alpha + ps;
#pragma unroll
                for (int i = 0; i < 16; ++i) { o0[i] *= alpha; o1[i] *= alpha; }
            } else {
                float lk0[16], lk1[16];
#pragma unroll
                for (int i = 0; i < 16; ++i) {
                    {
                        const float z = s0[i]; const float sp = flog2(1.0f + fexp2(-fabsf(z)));
                        const float lb = fminf(z, 0.f) - sp;
                        s0[i] = lb; lk0[i] = lb - z;
                    }
                    {
                        const float z = s1[i]; const float sp = flog2(1.0f + fexp2(-fabsf(z)));
                        const float lb = fminf(z, 0.f) - sp;
                        s1[i] = lb; lk1[i] = lb - z;
                    }
                }
                if (k0 + 63 >= qw) {
                    asm volatile("");
                    const int rel = myq - k0 - 4 * hh;
#pragma unroll
                    for (int i = 0; i < 16; ++i) {
                        const int off = 8 * (i >> 2) + (i & 3);
                        if (off >= rel) { lk0[i] = 0.f; s0[i] = -1e30f; }
                        if (off + 32 >= rel) { lk1[i] = 0.f; s1[i] = -1e30f; }
                    }
                }
                float run = carry;
#pragma unroll
                for (int g = 3; g >= 0; --g) {
                    const float G = (lk1[4 * g] + lk1[4 * g + 1]) + (lk1[4 * g + 2] + lk1[4 * g + 3]);
                    const float Gp = __shfl_xor(G, 32);
                    const float base = run + (hh == 0 ? Gp : 0.f);
                    const float e3 = base, e2 = e3 + lk1[4 * g + 3], e1 = e2 + lk1[4 * g + 2], e0 = e1 + lk1[4 * g + 1];
                    s1[4 * g + 3] = fexp2(s1[4 * g + 3] + e3); s1[4 * g + 2] = fexp2(s1[4 * g + 2] + e2);
                    s1[4 * g + 1] = fexp2(s1[4 * g + 1] + e1); s1[4 * g] = fexp2(s1[4 * g] + e0);
                    run += G + Gp;
                }
#pragma unroll
                for (int g = 3; g >= 0; --g) {
                    const float G = (lk0[4 * g] + lk0[4 * g + 1]) + (lk0[4 * g + 2] + lk0[4 * g + 3]);
                    const float Gp = __shfl_xor(G, 32);
                    const float base = run + (hh == 0 ? Gp : 0.f);
                    const float e3 = base, e2 = e3 + lk0[4 * g + 3], e1 = e2 + lk0[4 * g + 2], e0 = e1 + lk0[4 * g + 1];
                    s0[4 * g + 3] = fexp2(s0[4 * g + 3] + e3); s0[4 * g + 2] = fexp2(s0[4 * g + 2] + e2);
                    s0[4 * g + 1] = fexp2(s0[4 * g + 1] + e1); s0[4 * g] = fexp2(s0[4 * g] + e0);
                    run += G + Gp;
                }
                carry = run;
            }
#pragma unroll
            for (int s2 = 0; s2 < 2; ++s2) {
                unsigned pk0[4], pk1[4];
#pragma unroll
                for (int j = 0; j < 4; ++j) { pk0[j] = pack_bf16(s0[8 * s2 + 2 * j], s0[8 * s2 + 2 * j + 1]); pk1[j] = pack_bf16(s1[8 * s2 + 2 * j], s1[8 * s2 + 2 * j + 1]); }
                const uint4 u0 = make_uint4(pk0[0], pk0[1], pk0[2], pk0[3]), u1 = make_uint4(pk1[0], pk1[1], pk1[2], pk1[3]);
                const bf16x8 pf0 = __builtin_bit_cast(bf16x8, u0), pf1 = __builtin_bit_cast(bf16x8, u1);
                const bf16x8 v00 = *(const bf16x8*)(vb + r * VROWB + (16 * s2 + 8 * hh) * 2);
                const bf16x8 v01 = *(const bf16x8*)(vb + (32 + r) * VROWB + (16 * s2 + 8 * hh) * 2);
                const bf16x8 v10 = *(const bf16x8*)(vb + r * VROWB + (32 + 16 * s2 + 8 * hh) * 2);
                const bf16x8 v11 = *(const bf16x8*)(vb + (32 + r) * VROWB + (32 + 16 * s2 + 8 * hh) * 2);
                o0 = MFMA(v00, pf0, o0); o1 = MFMA(v01, pf0, o1);
                o0 = MFMA(v10, pf1, o0); o1 = MFMA(v11, pf1, o1);
            }
        }
    };
#define SB_FLAGS(N_) do { if (TYPE != 1) { if (TYPE == 2) wdone = (__all(carry < -170.f) != 0); if (lane == 0) flags[((N_) & 1) * 8 + w8] = wdone ? 1u : 0u; } } while (0)
#define SB_DONE(N_) (TYPE != 1 && ((flags[((N_) & 1) * 8] & flags[((N_) & 1) * 8 + 1] & flags[((N_) & 1) * 8 + 2] & flags[((N_) & 1) * 8 + 3] & flags[((N_) & 1) * 8 + 4] & flags[((N_) & 1) * 8 + 5] & flags[((N_) & 1) * 8 + 6] & flags[((N_) & 1) * 8 + 7]) != 0u))
    __syncthreads();
    if (TYPE != 1 && tid < 16) flags[tid] = 0;
    LOAD_TILE(A, TILE_OF(0));
    WAIT_ALL(A);
    STORE_TILE(A, 0);
    LOAD_TILE(A, TILE_OF(1));
    __syncthreads();
    for (int n = 0; n < ntiles; n += 2) {
        LOAD_TILE(B, TILE_OF(n + 2));
        __builtin_amdgcn_sched_barrier(0);
        compute(TILE_OF(n), 0);
        __builtin_amdgcn_sched_barrier(0);
        WAIT_OLD(A);
        STORE_TILE(A, 1);
        SB_FLAGS(n);
        __syncthreads();
        if (SB_DONE(n)) break;
        if (n + 1 >= ntiles) break;
        LOAD_TILE(A, TILE_OF(n + 3));
        __builtin_amdgcn_sched_barrier(0);
        compute(TILE_OF(n + 1), 1);
        __builtin_amdgcn_sched_barrier(0);
        WAIT_OLD(B);
        STORE_TILE(B, 0);
        SB_FLAGS(n + 1);
        __syncthreads();
        if (SB_DONE(n + 1)) break;
    }
    asm volatile("s_waitcnt vmcnt(0)" : "+v"(rk0A), "+v"(rk1A), "+v"(rv0A), "+v"(rv1A), "+v"(rkrA), "+v"(rckA), "+v"(rk0B), "+v"(rk1B), "+v"(rv0B), "+v"(rv1B), "+v"(rkrB), "+v"(rckB));
    float inv = 1.0f;
    if (TYPE != 2) { const float lt = lsum + __shfl_xor(lsum, 32); inv = frcp(lt); }
    bf16_t* yg = (TYPE == 0 ? p->qf : TYPE == 1 ? p->qn : p->qs) + tokq * 512 + h * 64;
#pragma unroll
    for (int g = 0; g < 4; ++g) {
        u32x2 a, c2;
        a.x = pack_bf16(o0[4 * g] * inv, o0[4 * g + 1] * inv); a.y = pack_bf16(o0[4 * g + 2] * inv, o0[4 * g + 3] * inv);
        c2.x = pack_bf16(o1[4 * g] * inv, o1[4 * g + 1] * inv); c2.y = pack_bf16(o1[4 * g + 2] * inv, o1[4 * g + 3] * inv);
        *(u32x2*)(yg + 8 * g + 4 * hh) = a;
        *(u32x2*)(yg + 32 + 8 * g + 4 * hh) = c2;
    }
}

DI void phase_attn(KargPtr p, unsigned char* smem) {
    for (int idx = bidx(); idx < 6144; idx += gdim()) {
        if (idx < 4096) {
            const int j = idx >> 9, g = (idx >> 7) & 3, rem = idx & 127, bh = ((rem & 63) + 13 * j) & 63;
            const int qb = 31 - 4 * j - ((j & 1) ? 3 - g : g);
            const int type = ((rem >> 6) + j) & 1;
            if (type == 0) attn_item<0>(p, bh >> 3, bh & 7, qb, smem);
            else attn_item<1>(p, bh >> 3, bh & 7, qb, smem);
        } else {
            const int j = idx - 4096; const int qb = 31 - (j >> 6), bh = j & 63;
            attn_item<2>(p, bh >> 3, bh & 7, qb, smem);
        }
    }
}

struct EpiGate {
    static constexpr bool PERM = false, AFTER_DRAIN = false;
    bf16_t* gs0; bf16_t* gs1;
    __device__ __forceinline__ void operator()(const pg8::f32x4 (&acc)[2][2][4][2], const pg8::Unit& u, int wr, int wc, int fr, int fq) const {
        const int br = u.pn >> 2;
        bf16_t* dst = (br == 0 ? gs0 : gs1 + (size_t)(br - 1) * T_TOK * 1024) + (u.pn & 3) * 256 + wc * 32 + fq * 4;
        const int row0 = u.pm * 256 + wr * 64 + fr;
#pragma unroll
        for (int ai = 0; ai < 2; ++ai)
#pragma unroll
            for (int m = 0; m < 4; ++m) {
                bf16_t* rowp = dst + (size_t)(row0 + ai * 128 + m * 16) * 1024;
#pragma unroll
                for (int bj = 0; bj < 2; ++bj)
#pragma unroll
                    for (int n = 0; n < 2; ++n) { const pg8::f32x4 v = acc[ai][bj][m][n]; u32x2 pk; pk.x = pack_bf16(sigmoidf_(v[0]), sigmoidf_(v[1])); pk.y = pack_bf16(sigmoidf_(v[2]), sigmoidf_(v[3])); *(u32x2*)(rowp + bj * 128 + n * 16) = pk; }
            }
    }
};
DI void phase_gate(KargPtr p, int l, unsigned char* smem_phys) {
    EpiGate E; E.gs0 = p->gs0; E.gs1 = p->gs1;
    big_gemm<EpiGate, false>(p->u, p->wt + (size_t)l * W_LAYER + W_GATE, 3072, 1024, E, smem_phys);
}
DI void phase_merge(KargPtr p, int l, unsigned char* smem) {
    const int tid = tidx(), lane = tid & 63, w = tid >> 6, wm = w >> 1, wn = w & 1, r = lane & 31, hh = lane >> 5;
    const bf16_t* WL = p->wt + (size_t)l * W_LAYER;
    for (int it = 0;; ++it) {
        int mt, nt; if (!next_tile(it, 256, 8, mt, nt)) break;
        const int m0 = mt * 128;
        f32x16 mer[2][2]; zero_acc(mer);
#pragma unroll 1
        for (int br = 0; br < 3; ++br) {
            f32x16 acc[2][2]; zero_acc(acc);
            const bf16_t* Y = (br == 0 ? p->qf : br == 1 ? p->qn : p->qs) + (size_t)m0 * 512;
            const bf16_t* WO = WL + (br == 0 ? W_OF : br == 1 ? W_OM : W_OS) + (size_t)nt * 128 * 512;
            gemm_mainloop<64>(WO, 512, Y, 512, 512, acc, smem);
            const bf16_t* G = (br == 0 ? p->gs0 : p->gs1 + (size_t)(br - 1) * T_TOK * 1024) + (size_t)(m0 + wn * 64 + r) * 1024 + nt * 128 + wm * 64 + 4 * hh;
            u32x2 gv[2][2][4];
#pragma unroll
            for (int a = 0; a < 2; ++a)
#pragma unroll
                for (int c = 0; c < 2; ++c)
#pragma unroll
                    for (int g = 0; g < 4; ++g) gv[a][c][g] = *(const u32x2*)(G + (size_t)c * 32 * 1024 + a * 32 + 8 * g);
#pragma unroll
            for (int a = 0; a < 2; ++a)
#pragma unroll
                for (int c = 0; c < 2; ++c)
#pragma unroll
                    for (int g = 0; g < 4; ++g) {
                        const unsigned x0 = gv[a][c][g].x, x1 = gv[a][c][g].y;
                        mer[a][c][4 * g]     += __uint_as_float(x0 << 16) * acc[a][c][4 * g];
                        mer[a][c][4 * g + 1] += __uint_as_float(x0 & 0xffff0000u) * acc[a][c][4 * g + 1];
                        mer[a][c][4 * g + 2] += __uint_as_float(x1 << 16) * acc[a][c][4 * g + 2];
                        mer[a][c][4 * g + 3] += __uint_as_float(x1 & 0xffff0000u) * acc[a][c][4 * g + 3];
                    }
        }
        stage_store_128(mer, p->merged + (size_t)m0 * 1024 + nt * 128, 1024, smem);
    }
}

DI void phase_outproj(KargPtr p, int l, unsigned char* smem_phys) {
    EpiResidual E; E.xin = (l == 0) ? p->x : p->out; E.xout = p->out; E.modl = p->mod + (size_t)l * 8 * 6144; E.gidx = 2;
    big_gemm(p->merged, p->wt + (size_t)l * W_LAYER + W_OUT, 1024, 1024, E, smem_phys);
}
DI void phase_ffn_up(KargPtr p, int l, unsigned char* smem_phys) {
    EpiFfnUp E; E.h = p->h;
    big_gemm(p->u, p->wt + (size_t)l * W_LAYER + W_FGU, 5632, 1024, E, smem_phys);
}
DI void phase_ffn_down(KargPtr p, int l, unsigned char* smem_phys) {
    EpiResidual E; E.xin = p->out; E.xout = p->out; E.modl = p->mod + (size_t)l * 8 * 6144; E.gidx = 5;
    big_gemm(p->h, p->wt + (size_t)l * W_LAYER + W_FD, 1024, 2816, E, smem_phys);
}

DI void run_phase(int ph, int l, unsigned char* smem_phys) {
#ifdef ONLY_PH
    if (ph != ONLY_PH) return;
#endif
    KargPtr p = karg();
    unsigned char* smem = smem_phys + vhalf() * VSMEM;
    switch (ph) {
    case 0: phase_prep(p, smem); break;
    case 1: phase_norm((l == 0) ? p->x : p->out, p->g_mix + l * 1024, p->mod + (size_t)l * 8 * 6144, 0, 1, p->u); break;
    case 2: phase_inproj(p, l, smem_phys); break;
    case 3: phase_mla_up(p, l, smem); break;
    case 4: phase_attn(p, smem); break;
    case 5: phase_merge(p, l, smem); break;
    case 12: phase_gate(p, l, smem_phys); break;
    case 6: phase_outproj(p, l, smem_phys); break;
    case 7: phase_norm(p->out, p->g_ffn + l * 1024, p->mod + (size_t)l * 8 * 6144, 3, 4, p->u); break;
    case 8: phase_ffn_up(p, l, smem_phys); break;
    case 9: phase_ffn_down(p, l, smem_phys); break;
    default: phase_final(p); break;
    }
}

#define XB_TMO      128
#define XB_XCNT(j)  (256  + 64 * (j))
#define XB_XSUB(j)  (1280 + 64 * (j))
#define XB_XGEN(j)  (2304 + 64 * (j))
#define XB_TOP      3328
#define XB_TOPGEN   3392
#define XCD_BAR_WORDS 3456
#define XB_SPIN_CAP (1u << 20)
#define LAS __attribute__((address_space(3)))
DI unsigned xb_ld(unsigned* p)              { return __hip_atomic_load(p, __ATOMIC_RELAXED, __HIP_MEMORY_SCOPE_AGENT); }
DI unsigned xb_add(unsigned* p, unsigned v) { return __hip_atomic_fetch_add(p, v, __ATOMIC_RELAXED, __HIP_MEMORY_SCOPE_AGENT); }
DI unsigned xb_xcc_id() { return (unsigned)__builtin_amdgcn_s_getreg((3 << 11) | 20) & 0xFu; }
#define XB_SPIN(cond, bar) do { unsigned _sp = 0; while (cond) { __builtin_amdgcn_s_sleep(1); \
    if ((++_sp & 255u) == 0u) { if (xb_ld(&(bar)[XB_TMO])) break; if (_sp > XB_SPIN_CAP) { atomicAdd(&(bar)[XB_TMO], 1u); break; } } } } while (0)
struct XcdBarrier { unsigned* bar; unsigned x; volatile LAS unsigned* st; };
DI XcdBarrier xcd_barrier_post(unsigned* bar, volatile LAS unsigned* st) {
    XcdBarrier b; b.bar = bar; b.x = xb_xcc_id(); b.st = st;
    if (threadIdx.x == 0) (void)xb_add(&bar[XB_XCNT(b.x)], 1u);
    return b;
}
DI void xcd_barrier_complete(unsigned* bar, unsigned x, unsigned& nloc, unsigned& nx) {
    const unsigned G = gridDim.x * gridDim.y * gridDim.z;
    unsigned sum, cnt, mine, sp = 0u;
    for (;;) {
        sum = 0u; cnt = 0u; mine = 0u;
#pragma unroll
        for (unsigned j = 0; j < 16; ++j) { const unsigned c = xb_ld(&bar[XB_XCNT(j)]); sum += c; cnt += (c > 0u) ? 1u : 0u; mine = (j == x) ? c : mine; }
        if (sum == G) break;
        __builtin_amdgcn_s_sleep(1);
        if ((++sp & 255u) == 0u) { if (xb_ld(&bar[XB_TMO])) break; if (sp > XB_SPIN_CAP) { atomicAdd(&bar[XB_TMO], 1u); break; } }
    }
    nloc = mine > 0u ? mine : 1u; nx = cnt > 0u ? cnt : 1u;
}
DI void xcd_barrier(const XcdBarrier& b) {
    asm volatile("s_waitcnt vmcnt(0)" ::: "memory");
    __syncthreads();
    if (threadIdx.x == 0) {
        unsigned* bar = b.bar;
        __builtin_amdgcn_s_waitcnt(0);
        unsigned nloc = b.st[0], nx = b.st[1];
        if (nloc == 0u) { xcd_barrier_complete(bar, b.x, nloc, nx); b.st[0] = nloc; b.st[1] = nx; }
        const unsigned old = xb_add(&bar[XB_XSUB(b.x)], 1u);
        const unsigned gen = old / nloc;
        if (old + 1u == (gen + 1u) * nloc) {
            __builtin_amdgcn_fence(__ATOMIC_RELEASE, "agent");
            asm volatile("s_waitcnt vmcnt(0)" ::: "memory");
            const unsigned og = xb_add(&bar[XB_TOP], 1u);
            const unsigned tg = og / nx;
            if (og + 1u == (tg + 1u) * nx) xb_add(&bar[XB_TOPGEN], 1u);
            else XB_SPIN(xb_ld(&bar[XB_TOPGEN]) == tg, bar);
            __builtin_amdgcn_fence(__ATOMIC_ACQUIRE, "agent");
            xb_add(&bar[XB_XGEN(b.x)], 1u);
            asm volatile("s_waitcnt vmcnt(0)" ::: "memory");
        } else {
            XB_SPIN(xb_ld(&bar[XB_XGEN(b.x)]) == gen, bar);
            __builtin_amdgcn_fence(__ATOMIC_ACQUIRE, "agent");
            asm volatile("s_waitcnt vmcnt(0)" ::: "memory");
        }
    }
    __syncthreads();
}

#if MEGA
__global__ void __launch_bounds__(512, 2) __attribute__((amdgpu_waves_per_eu(2, 2))) mega_kernel(Params p) {
    extern __shared__ __attribute__((aligned(16))) unsigned char smem[];
    cg::grid_group grid = cg::this_grid();
    volatile LAS unsigned* st = (volatile LAS unsigned*)(smem + SMEM_BYTES - 16);
    if (threadIdx.x == 0) { st[0] = 0u; st[1] = 0u; }
    __syncthreads();
    const XcdBarrier xb = xcd_barrier_post(karg()->bar, st);
    run_phase(0, 0, smem);
    grid.sync();
#pragma unroll 1
    for (int l = 0; l < 2; ++l) {
#pragma unroll 1
        for (int ph = 1; ph <= 9; ++ph) {
            if (ph == 5) { run_phase(12, l, smem); xcd_barrier(xb); }
            run_phase(ph, l, smem); xcd_barrier(xb);
#ifdef DBL_PH
            if (ph == DBL_PH) { run_phase(ph, l, smem); xcd_barrier(xb); }
#endif
        }
    }
    run_phase(10, 0, smem);
}
#else
__global__ void __launch_bounds__(512, 2) __attribute__((amdgpu_waves_per_eu(2, 2))) phase_kernel(Params p, int ph, int l) {
    extern __shared__ __attribute__((aligned(16))) unsigned char smem[];
    run_phase(ph, l, smem);
}
#endif

extern "C" void kernel_launch(void* const* d_in, const int* in_sizes, int n_in, void* d_out, int out_size, void* d_ws, size_t ws_size, hipStream_t stream) {
    (void)in_sizes; (void)n_in; (void)out_size;
    Params p{};
    p.x = (const float*)d_in[0]; p.c = (const float*)d_in[1]; p.pos = (const int*)d_in[2];
    p.g_mix = (const float*)d_in[3]; p.w_ada = (const float*)d_in[4]; p.b_ada = (const float*)d_in[5]; p.w_in = (const float*)d_in[6]; p.b_fox_f = (const float*)d_in[7];
    p.g_mla_q = (const float*)d_in[8]; p.w_mla_uq = (const float*)d_in[9]; p.g_mla_kv = (const float*)d_in[10]; p.w_mla_ukv = (const float*)d_in[11];
    p.w_o_fox = (const float*)d_in[12]; p.w_o_mla = (const float*)d_in[13]; p.w_o_sb = (const float*)d_in[14]; p.w_out = (const float*)d_in[15];
    p.g_ffn = (const float*)d_in[16]; p.w_ffn_gate = (const float*)d_in[17]; p.w_ffn_up = (const float*)d_in[18]; p.w_ffn_down = (const float*)d_in[19]; p.g_final = (const float*)d_in[20];
    p.out = (float*)d_out;
    unsigned char* ws = (unsigned char*)d_ws; size_t off = 0;
    auto take = [&](size_t bytes) { unsigned char* q = ws + off; off += (bytes + 255) & ~(size_t)255; return q; };
    p.bar = (unsigned*)take(16384);
    p.kmax = (float*)take(256);
    p.wt = (bf16_t*)take(2 * W_LAYER * 2);
    p.mod = (float*)take(2 * 8 * 6144 * 4);
    p.ropetab = (float*)take((size_t)T_TOK * 16 * 2 * 4);
    p.logf = (float*)take((size_t)64 * SEQ * 4);
    p.cum = (float*)take((size_t)64 * SEQ * 4);
    p.u = (bf16_t*)take((size_t)T_TOK * 1024 * 2);
    p.qf = (bf16_t*)take((size_t)T_TOK * 512 * 2);
    p.kf = (bf16_t*)take((size_t)T_TOK * 512 * 2);
    p.vtf = (bf16_t*)take((size_t)T_TOK * 512 * 2);
    p.qs = (bf16_t*)take((size_t)T_TOK * 512 * 2);
    p.ks = (bf16_t*)take((size_t)T_TOK * 512 * 2);
    p.vts = (bf16_t*)take((size_t)T_TOK * 512 * 2);
    p.qn = (bf16_t*)take((size_t)T_TOK * 512 * 2);
    p.ql = (bf16_t*)take((size_t)T_TOK * 384 * 2);
    p.kvl = (bf16_t*)take((size_t)T_TOK * 256 * 2);
    p.kr = (bf16_t*)take((size_t)T_TOK * 32 * 2);
    p.qr = (bf16_t*)take((size_t)T_TOK * 256 * 2);
    p.kn = (bf16_t*)take((size_t)T_TOK * 512 * 2);
    p.vtm = (bf16_t*)take((size_t)T_TOK * 512 * 2);
    (void)take((size_t)8 << 20);
    p.gs0 = p.ks;
    p.gs1 = p.ql;
    p.gs2 = p.ql + (size_t)T_TOK * 1024;
    p.merged = p.kf;
    p.h = p.qf;
    if (off > ws_size) { fprintf(stderr, "kernel_launch: workspace too small: need %zu, have %zu\n", off, ws_size); return; }

#if MEGA
    static int grid_blocks = 0;
    if (!grid_blocks) {
        int dev = 0, cus = 0, per_cu = 0;
        (void)hipGetDevice(&dev);
        (void)hipDeviceGetAttribute(&cus, hipDeviceAttributeMultiprocessorCount, dev);
        (void)hipFuncSetAttribute((const void*)mega_kernel, hipFuncAttributeMaxDynamicSharedMemorySize, SMEM_BYTES);
        (void)hipOccupancyMaxActiveBlocksPerMultiprocessor(&per_cu, (const void*)mega_kernel, 512, SMEM_BYTES);
        per_cu = 1;
        grid_blocks = cus * per_cu;
        grid_blocks &= ~7;
    }
    (void)hipMemsetAsync(p.bar, 0, 16384, stream);
    void* args[] = {&p};
    hipError_t e = hipLaunchCooperativeKernel((const void*)mega_kernel, dim3(grid_blocks), dim3(512), args, SMEM_BYTES, stream);
    if (e != hipSuccess) fprintf(stderr, "cooperative launch failed: %s (grid %d)\n", hipGetErrorString(e), grid_blocks);
#else
    static bool attr = false;
    if (!attr) { (void)hipFuncSetAttribute((const void*)phase_kernel, hipFuncAttributeMaxDynamicSharedMemorySize, SMEM_BYTES); attr = true; }
    const int G = 512;
    hipLaunchKernelGGL(phase_kernel, dim3(G), dim3(256), SMEM_BYTES, stream, p, 0, 0);
    for (int l = 0; l < 2; ++l)
        for (int ph = 1; ph <= 9; ++ph) hipLaunchKernelGGL(phase_kernel, dim3(G), dim3(256), SMEM_BYTES, stream, p, ph, l);
    hipLaunchKernelGGL(phase_kernel, dim3(G), dim3(256), SMEM_BYTES, stream, p, 10, 0);
#endif
}
```

```cpp
#include <hip/hip_runtime.h>
#include <hip/hip_cooperative_groups.h>
#include <cstdint>
#include <cstdio>
namespace cg = cooperative_groups;

#ifndef MEGA
#define MEGA 1
#endif

typedef unsigned short bf16_t;
typedef short bf16x8 __attribute__((ext_vector_type(8)));
typedef float f32x16 __attribute__((ext_vector_type(16)));
typedef float f32x4 __attribute__((ext_vector_type(4)));
typedef unsigned u32x2 __attribute__((ext_vector_type(2)));
#define DI __device__ __forceinline__
typedef unsigned u32x4 __attribute__((ext_vector_type(4)));
#define GLOAD16(dst, ptr) asm volatile("global_load_dwordx4 %0, %1, off" : "=v"(dst) : "v"(ptr))
#define GLOAD4(dst, ptr)  asm volatile("global_load_dword %0, %1, off" : "=v"(dst) : "v"(ptr))
#define MFMA(a, b, c) __builtin_amdgcn_mfma_f32_32x32x16_bf16((a), (b), (c), 0, 0, 0)

namespace pg8 {
#define PG8_LAS __attribute__((address_space(3)))
typedef unsigned short bf16_t;
typedef short bf16x8 __attribute__((ext_vector_type(8)));
typedef float f32x4 __attribute__((ext_vector_type(4)));
typedef unsigned u32x4 __attribute__((ext_vector_type(4)));
constexpr int BM = 256, BK = 64, HALF = 128, HTB = HALF * BK * 2  , STAGE_BYTES = 8 * HTB, NXCD = 8, WGM = 8;

__host__ __device__ __forceinline__ int lds_byte(int r, int c) { const int st = (r >> 4) * 2 + (c >> 5), rr = r & 15, cc = c & 31, ob = rr * 64 + cc * 2; return st * 1024 + (ob ^ (((ob >> 9) & 1) << 5)); }
__host__ __device__ __forceinline__ void stage_rc(int b, int& R, int& C) { const int st = b / 1024, sb = b % 1024, swz = sb ^ (((sb >> 9) & 1) << 5); R = (st >> 1) * 16 + swz / 64; C = (st & 1) * 32 + (swz % 64) / 2; }
__host__ __device__ __forceinline__ int perm32(int rho) { const int n = rho >> 4, i = rho & 15; return 8 * (i >> 2) + 4 * n + (i & 3); }

struct Unit { int pm, pn; };
struct Gemm { const bf16_t* A; const bf16_t* Bt; int M, N, K; };

struct StaticOrder {
    int nM, nN, nwg, G, c;
    __host__ __device__ void init(int M, int N, int G_, int c_) { nM = M / BM; nN = N / BM; nwg = nM * nN; G = G_; c = c_; }
    __host__ __device__ bool next(int i, Unit& u) const {
        const long L = (long)i * G + c; if (L >= nwg) return false;
        int wgid = (int)L; { const int q = nwg / NXCD, r = nwg % NXCD, xcd = wgid % NXCD, off = wgid / NXCD; wgid = (xcd < r ? xcd * (q + 1) : r * (q + 1) + (xcd - r) * q) + off; }
        const int nig = WGM * nN, gid = wgid / nig, fm = gid * WGM, gsz = (nM - fm) < WGM ? (nM - fm) : WGM;
        u.pm = fm + ((wgid % nig) % gsz); u.pn = (wgid % nig) / gsz; return true;
    }
    __device__ __forceinline__ void a_ready(const Unit&) const {}
    __device__ __forceinline__ void done(const Unit&) const {}
};
template <class Epi, class Sched, bool ALIGN_EPI = false, bool SP2 = false, bool NAT = false>
__device__ __forceinline__ void gemm_phase(PG8_LAS unsigned char* lds, const Gemm g, const Sched& S, const Epi& E) {
    int tid = threadIdx.x; asm volatile("" : "+v"(tid)); const int wid = __builtin_amdgcn_readfirstlane(tid >> 6), lane = tid & 63, wr = wid >> 2, wc = wid & 3, fr = lane & 15, fq = lane >> 4;
    const int K = g.K, nt = K / BK;
    unsigned voffA[2], voffB[2];
#pragma unroll
    for (int i = 0; i < 2; ++i) { int R, C; stage_rc(tid * 16 + i * 8192, R, C); const int Rb = Epi::PERM ? ((R & ~31) + perm32(R & 31)) : R;
        voffA[i] = (unsigned)(R * K + C) * 2u; voffB[i] = (unsigned)(Rb * K + C) * 2u; }
    const size_t kstep = (size_t)(BK * 2);
    const size_t hstep = (size_t)HALF * K * 2;
    const size_t tstep = 2 * hstep;
    const unsigned ldsw = (unsigned)wid * 1024u;
    const int aoff = lds_byte(wr * 64 + fr, fq * 8), boff = lds_byte(wc * 32 + fr, fq * 8);
#define PG8_SA(b, h) (((b) * 2 + (h)) * HTB)
#define PG8_SB(b, h) ((4 + (b) * 2 + (h)) * HTB)
#define PG8_STAGE(bufoff, gbase, voff) do { _Pragma("unroll") for (int _i = 0; _i < 2; ++_i) \
        __builtin_amdgcn_global_load_lds((const unsigned*)((const char*)(gbase) + (voff)[_i]), (PG8_LAS unsigned*)(lds + (bufoff) + ldsw + _i * 8192), 16, 0, 0); } while (0)
#define PG8_LDA(dst, b, h) do { _Pragma("unroll") for (int m = 0; m < 4; ++m) _Pragma("unroll") for (int k = 0; k < 2; ++k) dst[m][k] = *(const PG8_LAS bf16x8*)(lds + PG8_SA(b, h) + aoff + m * 2048 + k * 1024); } while (0)
#define PG8_LDB(dst, b, h) do { _Pragma("unroll") for (int n = 0; n < 2; ++n) _Pragma("unroll") for (int k = 0; k < 2; ++k) dst[n][k] = *(const PG8_LAS bf16x8*)(lds + PG8_SB(b, h) + boff + n * 2048 + k * 1024); } while (0)
#define PG8_MMA(ai, bj, At, Bt) do { __builtin_amdgcn_s_setprio(1); _Pragma("unroll") for (int m = 0; m < 4; ++m) _Pragma("unroll") for (int n = 0; n < 2; ++n) _Pragma("unroll") for (int k = 0; k < 2; ++k) \
        acc[ai][bj][m][n] = NAT ? __builtin_amdgcn_mfma_f32_16x16x32_bf16(At[m][k], Bt[n][k], acc[ai][bj][m][n], 0, 0, 0) : __builtin_amdgcn_mfma_f32_16x16x32_bf16(Bt[n][k], At[m][k], acc[ai][bj][m][n], 0, 0, 0); __builtin_amdgcn_s_setprio(0); } while (0)
#define PG8_WAIT_V(n) asm volatile("s_waitcnt vmcnt(" #n ")" ::: "memory")
#define PG8_WAIT_L(n) asm volatile("s_waitcnt lgkmcnt(" #n ")" ::: "memory")
#define PG8_BAR __builtin_amdgcn_s_barrier()
#define PG8_SCHED __builtin_amdgcn_sched_barrier(0)
    Unit cur, nxt; int ui = 0;
    if (!S.next(0, cur)) return;
    f32x4 acc[2][2][4][2];
#pragma unroll
    for (int a = 0; a < 2; ++a)
#pragma unroll
        for (int b = 0; b < 2; ++b)
#pragma unroll
            for (int m = 0; m < 4; ++m)
#pragma unroll
                for (int n = 0; n < 2; ++n) acc[a][b][m][n] = (f32x4){0.f, 0.f, 0.f, 0.f};
    bf16x8 At[4][2], B0[2][2], B1[2][2];
    const char* cA = (const char*)g.A + (size_t)cur.pm * tstep; const char* cB = (const char*)g.Bt + (size_t)cur.pn * tstep;
    S.a_ready(cur);
    if constexpr (SP2) {
        PG8_STAGE(PG8_SB(0, 0), cB, voffB); PG8_STAGE(PG8_SB(0, 1), cB + hstep, voffB); PG8_STAGE(PG8_SA(0, 0), cA, voffA); PG8_STAGE(PG8_SA(0, 1), cA + hstep, voffA);
        if (wr == 1) PG8_BAR;
        PG8_WAIT_V(2); PG8_BAR;
        PG8_STAGE(PG8_SB(1, 0), cB + kstep, voffB); PG8_STAGE(PG8_SA(1, 0), cA + kstep, voffA); PG8_STAGE(PG8_SB(1, 1), cB + hstep + kstep, voffB);
        PG8_WAIT_V(6); PG8_BAR;
    } else {
        PG8_STAGE(PG8_SB(0, 0), cB, voffB); PG8_STAGE(PG8_SA(0, 0), cA, voffA); PG8_STAGE(PG8_SB(0, 1), cB + hstep, voffB); PG8_STAGE(PG8_SA(0, 1), cA + hstep, voffA);
        if (wr == 1) PG8_BAR;
        PG8_WAIT_V(4); PG8_BAR;
        PG8_STAGE(PG8_SB(1, 0), cB + kstep, voffB); PG8_STAGE(PG8_SA(1, 0), cA + kstep, voffA); PG8_STAGE(PG8_SB(1, 1), cB + hstep + kstep, voffB);
        PG8_WAIT_V(6); PG8_BAR;
    }
    for (;;) {
        const bool has_next = S.next(ui + 1, nxt);
        const char* nA = has_next ? (const char*)g.A + (size_t)nxt.pm * tstep : cA; const char* nB = has_next ? (const char*)g.Bt + (size_t)nxt.pn * tstep : cB;
        for (int t = 0; t < nt; t += 2) {
            const bool last = (t == nt - 2);
            const char* a1 = cA + (size_t)(t + 1) * kstep;
            const char* a2 = last ? nA : cA + (size_t)(t + 2) * kstep; const char* b2 = last ? nB : cB + (size_t)(t + 2) * kstep;
            const char* a3 = a2 + kstep; const char* b3 = b2 + kstep;
            if (last && has_next) S.a_ready(nxt);
            if constexpr (SP2) {
            PG8_LDB(B0, 0, 0); PG8_LDB(B1, 0, 1); PG8_SCHED; PG8_LDA(At, 0, 0); PG8_STAGE(PG8_SA(1, 1), a1 + hstep, voffA);
            PG8_WAIT_V(8); PG8_WAIT_L(0); PG8_BAR; PG8_MMA(0, 0, At, B0); PG8_MMA(0, 1, At, B1); PG8_BAR; PG8_SCHED;
            PG8_LDA(At, 0, 1); PG8_STAGE(PG8_SB(0, 0), b2, voffB); PG8_STAGE(PG8_SB(0, 1), b2 + hstep, voffB); PG8_STAGE(PG8_SA(0, 0), a2, voffA);
            PG8_WAIT_V(8); PG8_WAIT_L(0); PG8_BAR; PG8_MMA(1, 0, At, B0); PG8_MMA(1, 1, At, B1); PG8_BAR; PG8_SCHED;
            PG8_LDB(B0, 1, 0); PG8_LDB(B1, 1, 1); PG8_SCHED; PG8_LDA(At, 1, 0); PG8_STAGE(PG8_SA(0, 1), a2 + hstep, voffA);
            PG8_WAIT_V(8); PG8_WAIT_L(0); PG8_BAR; PG8_MMA(0, 0, At, B0); PG8_MMA(0, 1, At, B1); PG8_BAR; PG8_SCHED;
            PG8_LDA(At, 1, 1); PG8_STAGE(PG8_SB(1, 0), b3, voffB); PG8_STAGE(PG8_SB(1, 1), b3 + hstep, voffB); PG8_STAGE(PG8_SA(1, 0), a3, voffA);
            PG8_WAIT_V(8); PG8_WAIT_L(0); PG8_BAR; PG8_MMA(1, 0, At, B0); PG8_MMA(1, 1, At, B1); PG8_BAR; PG8_SCHED;
            } else {
            PG8_LDB(B0, 0, 0); PG8_SCHED; PG8_LDA(At, 0, 0); PG8_STAGE(PG8_SA(1, 1), a1 + hstep, voffA);
            PG8_WAIT_L(8); PG8_BAR; PG8_WAIT_L(0); PG8_MMA(0, 0, At, B0); PG8_BAR; PG8_SCHED;
            PG8_LDB(B1, 0, 1); PG8_STAGE(PG8_SB(0, 0), b2, voffB);
            PG8_BAR; PG8_WAIT_L(0); PG8_MMA(0, 1, At, B1); PG8_BAR;
            PG8_LDA(At, 0, 1); PG8_STAGE(PG8_SA(0, 0), a2, voffA);
            PG8_BAR; PG8_WAIT_L(0); PG8_MMA(1, 0, At, B0); PG8_BAR; PG8_SCHED;
            PG8_STAGE(PG8_SB(0, 1), b2 + hstep, voffB);
            PG8_WAIT_V(6); PG8_BAR; PG8_MMA(1, 1, At, B1); PG8_BAR;
            PG8_LDB(B0, 1, 0); PG8_SCHED; PG8_LDA(At, 1, 0); PG8_STAGE(PG8_SA(0, 1), a2 + hstep, voffA);
            PG8_WAIT_L(8); PG8_BAR; PG8_WAIT_L(0); PG8_MMA(0, 0, At, B0); PG8_BAR; PG8_SCHED;
            PG8_LDB(B1, 1, 1); PG8_STAGE(PG8_SB(1, 0), b3, voffB);
            PG8_BAR; PG8_WAIT_L(0); PG8_MMA(0, 1, At, B1); PG8_BAR;
            PG8_LDA(At, 1, 1); PG8_STAGE(PG8_SA(1, 0), a3, voffA);
            PG8_BAR; PG8_WAIT_L(0); PG8_MMA(1, 0, At, B0); PG8_BAR; PG8_SCHED;
            PG8_STAGE(PG8_SB(1, 1), b3 + hstep, voffB);
            PG8_WAIT_V(6); PG8_BAR; PG8_MMA(1, 1, At, B1); PG8_BAR;
            }
        }
        if constexpr (ALIGN_EPI) { if (wr == 0) PG8_BAR; }
        if constexpr (!Epi::AFTER_DRAIN) { E(acc, cur, wr, wc, fr, fq); S.done(cur); }
        if (!has_next) break;
#pragma unroll
        for (int a = 0; a < 2; ++a)
#pragma unroll
            for (int b = 0; b < 2; ++b)
#pragma unroll
                for (int m = 0; m < 4; ++m)
#pragma unroll
                    for (int n = 0; n < 2; ++n) acc[a][b][m][n] = (f32x4){0.f, 0.f, 0.f, 0.f};
        cur = nxt; cA = nA; cB = nB; ++ui;
        if constexpr (ALIGN_EPI) { if (wr == 1) PG8_BAR; }
    }
    PG8_WAIT_V(0);
    if constexpr (!ALIGN_EPI) { if (wr == 0) PG8_BAR; }
    PG8_BAR;
    if constexpr (Epi::AFTER_DRAIN) { E.fused(acc, cur, wr, wc, fr, fq, lds, wid, lane); S.done(cur); }
#undef PG8_SA
#undef PG8_SB
#undef PG8_STAGE
#undef PG8_LDA
#undef PG8_LDB
#undef PG8_MMA
#undef PG8_WAIT_V
#undef PG8_WAIT_L
#undef PG8_BAR
#undef PG8_SCHED
}
}

constexpr int T_TOK = 32768;
constexpr int SEQ = 4096;
constexpr float LOG2E = 1.4426950408889634f;
constexpr float FOX_QS = 0.125f * 1.4426950408889634f;
constexpr float MLA_QS = 0.10206207261596575f * 1.4426950408889634f;
constexpr float EPS = 1e-6f;

constexpr size_t W_IN = 0, W_GATE = 4063232, W_UQ = 7208960, W_UKV = 7503872, W_OF = 7766016, W_OM = 8290304, W_OS = 8814592,
                 W_OUT = 9338880, W_FGU = 10387456, W_FD = 16154624, W_LAYER = 19038208;

constexpr int SMEM_BYTES = 2 * 74752 + 64 + 16;

struct Params {
    const float* x; const float* c; const int* pos;
    const float* g_mix; const float* w_ada; const float* b_ada; const float* w_in; const float* b_fox_f;
    const float* g_mla_q; const float* w_mla_uq; const float* g_mla_kv; const float* w_mla_ukv;
    const float* w_o_fox; const float* w_o_mla; const float* w_o_sb; const float* w_out;
    const float* g_ffn; const float* w_ffn_gate; const float* w_ffn_up; const float* w_ffn_down; const float* g_final;
    float* out;
    bf16_t* wt; float* mod; float* ropetab; float* logf; float* cum;
    bf16_t* u; bf16_t* qf; bf16_t* kf; bf16_t* vtf; bf16_t* qs; bf16_t* ks; bf16_t* vts;
    bf16_t* ql; bf16_t* kvl; bf16_t* kr; bf16_t* qn; bf16_t* qr; bf16_t* kn; bf16_t* vtm;
    bf16_t* merged; bf16_t* h;
    unsigned* bar; float* kmax;
    bf16_t* gs0; bf16_t* gs1; bf16_t* gs2;
    float* rsq; float* rskv;
};
typedef const __attribute__((address_space(4))) Params* KargPtr;
#if defined(__HIP_DEVICE_COMPILE__)
__device__ __forceinline__ KargPtr karg() { KargPtr pp = (KargPtr)__builtin_amdgcn_kernarg_segment_ptr(); asm volatile("" : "+s"(pp)); return pp; }
#else
__device__ __forceinline__ KargPtr karg() { return nullptr; }
#endif

__device__ double ROPE_POLY[11] = {-1.0 / 6, 1.0 / 120, -1.0 / 5040, 1.0 / 362880, -1.0 / 39916800,
    -0.5, 1.0 / 24, -1.0 / 720, 1.0 / 40320, -1.0 / 3628800, 1.0 / 479001600};
__device__ const float ROPE_INV[16] = {1.0f, 0.5623413324356079f, 0.3162277638912201f, 0.17782793939113617f, 0.10000000149011612f, 0.05623413249850273f,
    0.03162277489900589f, 0.017782794311642647f, 0.009999999776482582f, 0.005623413249850273f, 0.003162277629598975f, 0.0017782794311642647f,
    0.0010000000474974513f, 0.000562341301701963f, 0.0003162277571391314f, 0.00017782794020604342f};

typedef __bf16 bf16x2_t __attribute__((ext_vector_type(2)));
typedef float f32x2_t __attribute__((ext_vector_type(2)));
DI unsigned pack_bf16(float lo, float hi) { const f32x2_t v = {lo, hi}; const bf16x2_t b = __builtin_convertvector(v, bf16x2_t); return __builtin_bit_cast(unsigned, b); }
DI bf16_t f2bf(float x) { return (bf16_t)(pack_bf16(x, 0.f) & 0xffffu); }
DI int vhalf() { return __builtin_amdgcn_readfirstlane((int)(threadIdx.x >> 8)); }
DI int tidx() { int t = threadIdx.x & 255; asm volatile("" : "+v"(t)); return t; }
DI int bidx() { int t = __builtin_amdgcn_readfirstlane((int)(blockIdx.x * 2 + (threadIdx.x >> 8))); asm volatile("" : "+s"(t)); return t; }
DI int gdim() { int t = gridDim.x * 2; asm volatile("" : "+s"(t)); return t; }
constexpr int VSMEM = 74752;
constexpr int FLAGS_OFF = 2 * VSMEM;
DI float fexp2(float x) { return __builtin_amdgcn_exp2f(x); }
DI float flog2(float x) { return __builtin_amdgcn_logf(x); }
DI float frcp(float x) { return __builtin_amdgcn_rcpf(x); }
DI float sigmoidf_(float x) { return frcp(1.0f + fexp2(-x * LOG2E)); }

DI bool next_tile(int it, int MT, int NT, int& mt, int& nt) {
    const int perx = gdim() >> 3, xcd = bidx() & 7, slot = bidx() >> 3;
    const long L = ((long)it * 8 + xcd) * perx + slot;
    if (L >= (long)MT * NT) return false;
    const int gsz = 8 * NT; const int grp = (int)(L / gsz), wi = (int)(L % gsz);
    mt = grp * 8 + (wi & 7); nt = wi >> 3; return true;
}

template <int BK>
DI void gemm_mainloop(const bf16_t* A, int lda, const bf16_t* B, int ldb, int K, f32x16 (&acc)[2][2], unsigned char* smem) {
    constexpr int CPR = BK / 8;
    constexpr int RPP = 256 / CPR;
    constexpr int NJ = 128 / RPP;
    constexpr int ROWB = BK * 2 + 16;
    constexpr int OPB = 128 * ROWB;
    constexpr int STB = 2 * OPB;
    constexpr int PASSB = RPP * ROWB;
    const int tid = tidx(), lane = tid & 63, w = tid >> 6, wm = w >> 1, wn = w & 1, r = lane & 31, hh = lane >> 5;
    const int lrow = tid / CPR, lcol = (tid % CPR) * 8;
    const bf16_t* ap = A + (size_t)lrow * lda + lcol;
    const bf16_t* bp = B + (size_t)lrow * ldb + lcol;
    const size_t astep = (size_t)RPP * lda, bstep = (size_t)RPP * ldb;
    const int st_off = lrow * ROWB + (tid % CPR) * 16;
    u32x4 ra0, ra1, ra2, ra3, rb0, rb1, rb2, rb3;
    ra0 = *(const u32x4*)(ap); rb0 = *(const u32x4*)(bp);
    ra1 = *(const u32x4*)(ap + astep); rb1 = *(const u32x4*)(bp + bstep);
    if constexpr (NJ == 4) { ra2 = *(const u32x4*)(ap + 2 * astep); rb2 = *(const u32x4*)(bp + 2 * bstep); ra3 = *(const u32x4*)(ap + 3 * astep); rb3 = *(const u32x4*)(bp + 3 * bstep); }
    else { ra2 = ra0; ra3 = ra0; rb2 = rb0; rb3 = rb0; }
#define GEMM_STAGE(D_) do { unsigned char* d_ = (D_); \
        *(u32x4*)(d_) = ra0; *(u32x4*)(d_ + OPB) = rb0; *(u32x4*)(d_ + PASSB) = ra1; *(u32x4*)(d_ + OPB + PASSB) = rb1; \
        if constexpr (NJ == 4) { *(u32x4*)(d_ + 2 * PASSB) = ra2; *(u32x4*)(d_ + OPB + 2 * PASSB) = rb2; *(u32x4*)(d_ + 3 * PASSB) = ra3; *(u32x4*)(d_ + OPB + 3 * PASSB) = rb3; } } while (0)
    GEMM_STAGE(smem + st_off);
    __syncthreads();
    const int nk = K / BK;
    const int rdA = (wm * 64 + r) * ROWB + hh * 16;
    const int rdB = OPB + (wn * 64 + r) * ROWB + hh * 16;
#define GEMM_FRAGS(KS_, A0_, A1_, B0_, B1_) do { \
        A0_ = *(const bf16x8*)(sa + (KS_) * 32); A1_ = *(const bf16x8*)(sa + 32 * ROWB + (KS_) * 32); \
        B0_ = *(const bf16x8*)(sb + (KS_) * 32); B1_ = *(const bf16x8*)(sb + 32 * ROWB + (KS_) * 32); } while (0)
#define GEMM_MFMA4(A0_, A1_, B0_, B1_) do { \
        acc[0][0] = MFMA(A0_, B0_, acc[0][0]); acc[0][1] = MFMA(A0_, B1_, acc[0][1]); \
        acc[1][0] = MFMA(A1_, B0_, acc[1][0]); acc[1][1] = MFMA(A1_, B1_, acc[1][1]); } while (0)
#define GEMM_COMPUTE(BUF_) do { \
        const unsigned char* sa = smem + (BUF_) * STB + rdA; \
        const unsigned char* sb = smem + (BUF_) * STB + rdB; \
        bf16x8 fa0, fa1, fb0, fb1, ga0, ga1, gb0, gb1; \
        GEMM_FRAGS(0, fa0, fa1, fb0, fb1); \
        GEMM_FRAGS(1, ga0, ga1, gb0, gb1); \
        __builtin_amdgcn_sched_barrier(0); \
        GEMM_MFMA4(fa0, fa1, fb0, fb1); \
        if constexpr (BK == 64) { \
            __builtin_amdgcn_sched_barrier(0); \
            GEMM_FRAGS(2, fa0, fa1, fb0, fb1); \
            __builtin_amdgcn_sched_barrier(0); \
            GEMM_MFMA4(ga0, ga1, gb0, gb1); \
            __builtin_amdgcn_sched_barrier(0); \
            GEMM_FRAGS(3, ga0, ga1, gb0, gb1); \
            __builtin_amdgcn_sched_barrier(0); \
            GEMM_MFMA4(fa0, fa1, fb0, fb1); \
        } \
        __builtin_amdgcn_sched_barrier(0); \
        GEMM_MFMA4(ga0, ga1, gb0, gb1); \
    } while (0)
    for (int kt = 0; kt < nk - 1; ++kt) {
        const int buf = kt & 1;
        ap += BK; bp += BK;
        GLOAD16(ra0, ap); GLOAD16(rb0, bp); GLOAD16(ra1, ap + astep); GLOAD16(rb1, bp + bstep);
        if constexpr (NJ == 4) { GLOAD16(ra2, ap + 2 * astep); GLOAD16(rb2, bp + 2 * bstep); GLOAD16(ra3, ap + 3 * astep); GLOAD16(rb3, bp + 3 * bstep); }
        __builtin_amdgcn_sched_barrier(0);
        GEMM_COMPUTE(buf);
        __builtin_amdgcn_sched_barrier(0);
        if constexpr (NJ == 4) asm volatile("s_waitcnt vmcnt(0)" : "+v"(ra0), "+v"(rb0), "+v"(ra1), "+v"(rb1), "+v"(ra2), "+v"(rb2), "+v"(ra3), "+v"(rb3));
        else asm volatile("s_waitcnt vmcnt(0)" : "+v"(ra0), "+v"(rb0), "+v"(ra1), "+v"(rb1));
        GEMM_STAGE(smem + (buf ^ 1) * STB + st_off);
        __syncthreads();
    }
    GEMM_COMPUTE((nk - 1) & 1);
    __syncthreads();
#undef GEMM_COMPUTE
#undef GEMM_MFMA4
#undef GEMM_FRAGS
#undef GEMM_STAGE
}


DI void gemm_big(const bf16_t* P, int ldp, const bf16_t* Q, int ldq, int K, f32x16 (&acc)[2][4], unsigned char* smem) {
    constexpr int ROWB = 80, PB = 128 * ROWB, STB = 384 * ROWB, PASSB = 64 * ROWB;
    const int tid = tidx(), lane = tid & 63, w = tid >> 6, wm = w >> 1, wn = w & 1, r = lane & 31, hh = lane >> 5;
    const int lrow = tid >> 2, lcol = (tid & 3) * 8;
    const bf16_t* pp = P + (size_t)lrow * ldp + lcol;
    const bf16_t* qp = Q + (size_t)lrow * ldq + lcol;
    const size_t pstep = (size_t)64 * ldp, qstep = (size_t)64 * ldq;
    const int st_off = lrow * ROWB + (tid & 3) * 16;
    u32x4 rp0, rp1, rq0, rq1, rq2, rq3;
    rp0 = *(const u32x4*)(pp); rp1 = *(const u32x4*)(pp + pstep);
    rq0 = *(const u32x4*)(qp); rq1 = *(const u32x4*)(qp + qstep); rq2 = *(const u32x4*)(qp + 2 * qstep); rq3 = *(const u32x4*)(qp + 3 * qstep);
#define BIG_STAGE(D_) do { unsigned char* d_ = (D_); \
        *(u32x4*)(d_) = rp0; *(u32x4*)(d_ + PASSB) = rp1; \
        *(u32x4*)(d_ + PB) = rq0; *(u32x4*)(d_ + PB + PASSB) = rq1; *(u32x4*)(d_ + PB + 2 * PASSB) = rq2; *(u32x4*)(d_ + PB + 3 * PASSB) = rq3; } while (0)
    BIG_STAGE(smem + st_off);
    __syncthreads();
    const int nk = K >> 5;
    const int rdP = (wm * 64 + r) * ROWB + hh * 16;
    const int rdQ = PB + (wn * 128 + r) * ROWB + hh * 16;
#define BIG_FRAGS(KS_, A0_, A1_, B0_, B1_, B2_, B3_) do { \
        A0_ = *(const bf16x8*)(sp + (KS_) * 32); A1_ = *(const bf16x8*)(sp + 32 * ROWB + (KS_) * 32); \
        B0_ = *(const bf16x8*)(sq + (KS_) * 32); B1_ = *(const bf16x8*)(sq + 32 * ROWB + (KS_) * 32); \
        B2_ = *(const bf16x8*)(sq + 64 * ROWB + (KS_) * 32); B3_ = *(const bf16x8*)(sq + 96 * ROWB + (KS_) * 32); } while (0)
#define BIG_MFMA8(A0_, A1_, B0_, B1_, B2_, B3_) do { \
        acc[0][0] = MFMA(A0_, B0_, acc[0][0]); acc[0][1] = MFMA(A0_, B1_, acc[0][1]); acc[0][2] = MFMA(A0_, B2_, acc[0][2]); acc[0][3] = MFMA(A0_, B3_, acc[0][3]); \
        acc[1][0] = MFMA(A1_, B0_, acc[1][0]); acc[1][1] = MFMA(A1_, B1_, acc[1][1]); acc[1][2] = MFMA(A1_, B2_, acc[1][2]); acc[1][3] = MFMA(A1_, B3_, acc[1][3]); } while (0)
#define BIG_COMPUTE(BUF_) do { \
        const unsigned char* sp = smem + (BUF_) * STB + rdP; \
        const unsigned char* sq = smem + (BUF_) * STB + rdQ; \
        bf16x8 fa0, fa1, fb0, fb1, fb2, fb3, ga0, ga1, gb0, gb1, gb2, gb3; \
        BIG_FRAGS(0, fa0, fa1, fb0, fb1, fb2, fb3); \
        BIG_FRAGS(1, ga0, ga1, gb0, gb1, gb2, gb3); \
        __builtin_amdgcn_sched_barrier(0); \
        BIG_MFMA8(fa0, fa1, fb0, fb1, fb2, fb3); \
        __builtin_amdgcn_sched_barrier(0); \
        BIG_MFMA8(ga0, ga1, gb0, gb1, gb2, gb3); \
    } while (0)
    for (int kt = 0; kt < nk - 1; ++kt) {
        const int buf = kt & 1;
        pp += 32; qp += 32;
        GLOAD16(rp0, pp); GLOAD16(rq0, qp); GLOAD16(rp1, pp + pstep); GLOAD16(rq1, qp + qstep); GLOAD16(rq2, qp + 2 * qstep); GLOAD16(rq3, qp + 3 * qstep);
        __builtin_amdgcn_sched_barrier(0);
        BIG_COMPUTE(buf);
        __builtin_amdgcn_sched_barrier(0);
        asm volatile("s_waitcnt vmcnt(0)" : "+v"(rp0), "+v"(rp1), "+v"(rq0), "+v"(rq1), "+v"(rq2), "+v"(rq3));
        BIG_STAGE(smem + (buf ^ 1) * STB + st_off);
        __syncthreads();
    }
    BIG_COMPUTE((nk - 1) & 1);
    __syncthreads();
#undef BIG_COMPUTE
#undef BIG_MFMA8
#undef BIG_FRAGS
#undef BIG_STAGE
}
DI void zero_big(f32x16 (&acc)[2][4]) {
#pragma unroll
    for (int a = 0; a < 2; ++a)
#pragma unroll
        for (int b = 0; b < 4; ++b)
#pragma unroll
            for (int i = 0; i < 16; ++i) acc[a][b][i] = 0.f;
}
DI void stage_store_big(const f32x16 (&acc)[2][4], bf16_t* dst, int ld, unsigned char* smem) {
    const int tid = tidx(), lane = tid & 63, w = tid >> 6, wm = w >> 1, wn = w & 1, r = lane & 31, hh = lane >> 5;
#pragma unroll
    for (int qi = 0; qi < 4; ++qi) {
        unsigned char* trow = smem + (wn * 128 + qi * 32 + r) * 272 + (wm * 64 + 4 * hh) * 2;
#pragma unroll
        for (int pi = 0; pi < 2; ++pi)
#pragma unroll
            for (int g = 0; g < 4; ++g) {
                u32x2 pk; pk.x = pack_bf16(acc[pi][qi][4 * g], acc[pi][qi][4 * g + 1]); pk.y = pack_bf16(acc[pi][qi][4 * g + 2], acc[pi][qi][4 * g + 3]);
                *(u32x2*)(trow + (pi * 32 + 8 * g) * 2) = pk;
            }
    }
    __syncthreads();
    const int q0 = tid >> 4, x = tid & 15;
#pragma unroll
    for (int j = 0; j < 16; ++j) {
        const uint4 v = *(const uint4*)(smem + (q0 + 16 * j) * 272 + x * 16);
        *(uint4*)(dst + (size_t)(q0 + 16 * j) * ld + x * 8) = v;
    }
    __syncthreads();
}
DI void scale_big(f32x16 (&acc)[2][4], float sc) {
#pragma unroll
    for (int a = 0; a < 2; ++a)
#pragma unroll
        for (int b = 0; b < 4; ++b)
#pragma unroll
            for (int i = 0; i < 16; ++i) acc[a][b][i] *= sc;
}
DI void scale_big_q(f32x16 (&acc)[2][4], const float* rs, float sc) {
    const int lane = tidx() & 63, wn = (tidx() >> 6) & 1, r = lane & 31;
#pragma unroll
    for (int qi = 0; qi < 4; ++qi) { const float f = rs[wn * 128 + qi * 32 + r] * sc;
#pragma unroll
        for (int pi = 0; pi < 2; ++pi)
#pragma unroll
            for (int i = 0; i < 16; ++i) acc[pi][qi][i] *= f; }
}
DI void scale_big_p(f32x16 (&acc)[2][4], const float* rs) {
    const int lane = tidx() & 63, wm = tidx() >> 7, hh = lane >> 5;
#pragma unroll
    for (int pi = 0; pi < 2; ++pi)
#pragma unroll
        for (int g = 0; g < 4; ++g) { const f32x4 f = *(const f32x4*)(rs + wm * 64 + pi * 32 + 8 * g + 4 * hh);
#pragma unroll
            for (int qi = 0; qi < 4; ++qi)
#pragma unroll
                for (int e = 0; e < 4; ++e) acc[pi][qi][4 * g + e] *= f[e]; }
}
DI long tile_linear(int it, long total) {
    const int perx = gdim() >> 3, xcd = bidx() & 7, slot = bidx() >> 3;
    const long L = ((long)it * 8 + xcd) * perx + slot;
    return L < total ? L : -1;
}
DI void tile_decode(int L, int NT, int& mt, int& nt) { const int gsz = 8 * NT; const int grp = L / gsz, wi = L % gsz; mt = grp * 8 + (wi & 7); nt = wi >> 3; }

DI void zero_acc(f32x16 (&acc)[2][2]) {
#pragma unroll
    for (int a = 0; a < 2; ++a)
#pragma unroll
        for (int b = 0; b < 2; ++b)
#pragma unroll
            for (int i = 0; i < 16; ++i) acc[a][b][i] = 0.f;
}

DI void stage_store_128(const f32x16 (&acc)[2][2], bf16_t* dst, int ld, unsigned char* smem) {
    const int tid = tidx(), lane = tid & 63, w = tid >> 6, wm = w >> 1, wn = w & 1, r = lane & 31, hh = lane >> 5;
#pragma unroll
    for (int qi = 0; qi < 2; ++qi) {
        unsigned char* trow = smem + (wn * 64 + qi * 32 + r) * 272 + (wm * 64 + 4 * hh) * 2;
#pragma unroll
        for (int pi = 0; pi < 2; ++pi)
#pragma unroll
            for (int g = 0; g < 4; ++g) {
                u32x2 pk; pk.x = pack_bf16(acc[pi][qi][4 * g], acc[pi][qi][4 * g + 1]); pk.y = pack_bf16(acc[pi][qi][4 * g + 2], acc[pi][qi][4 * g + 3]);
                *(u32x2*)(trow + (pi * 32 + 8 * g) * 2) = pk;
            }
    }
    __syncthreads();
    const int q0 = tid >> 4, x = tid & 15;
#pragma unroll
    for (int j = 0; j < 8; ++j) {
        const uint4 v = *(const uint4*)(smem + (q0 + 16 * j) * 272 + x * 16);
        *(uint4*)(dst + (size_t)(q0 + 16 * j) * ld + x * 8) = v;
    }
    __syncthreads();
}
DI void stage_store_vt(const f32x16 (&acc)[2][2], bf16_t* vt, int b, int cv0, int s0, unsigned char* smem) {
    const int tid = tidx(), lane = tid & 63, w = tid >> 6, wm = w >> 1, wn = w & 1, r = lane & 31, hh = lane >> 5;
#pragma unroll
    for (int qi = 0; qi < 2; ++qi) {
        unsigned char* trow = smem + (wn * 64 + qi * 32 + r) * 272 + (wm * 64 + 4 * hh) * 2;
#pragma unroll
        for (int pi = 0; pi < 2; ++pi)
#pragma unroll
            for (int g = 0; g < 4; ++g) {
                u32x2 pk; pk.x = pack_bf16(acc[pi][qi][4 * g], acc[pi][qi][4 * g + 1]); pk.y = pack_bf16(acc[pi][qi][4 * g + 2], acc[pi][qi][4 * g + 3]);
                *(u32x2*)(trow + (pi * 32 + 8 * g) * 2) = pk;
            }
    }
    __syncthreads();
    const int q0 = tid >> 4, x = tid & 15;
#pragma unroll
    for (int j = 0; j < 8; ++j) {
        const int cv = cv0 + q0 + 16 * j, sq = s0 + 8 * x;
        const uint4 v = *(const uint4*)(smem + (q0 + 16 * j) * 272 + x * 16);
        *(uint4*)(vt + (size_t)(b * 8 + (cv >> 6)) * SEQ * 64 + (size_t)(sq >> 6) * 4096 + (cv & 63) * 64 + (sq & 63)) = v;
    }
    __syncthreads();
}
DI void scale_acc(f32x16 (&acc)[2][2], float sc) {
#pragma unroll
    for (int a = 0; a < 2; ++a)
#pragma unroll
        for (int b = 0; b < 2; ++b)
#pragma unroll
            for (int i = 0; i < 16; ++i) acc[a][b][i] *= sc;
}
DI void scale_acc_q(f32x16 (&acc)[2][2], const float* rs, float sc) {
    const int lane = tidx() & 63, wn = (tidx() >> 6) & 1, r = lane & 31;
#pragma unroll
    for (int qi = 0; qi < 2; ++qi) { const float f = rs[wn * 64 + qi * 32 + r] * sc;
#pragma unroll
        for (int pi = 0; pi < 2; ++pi)
#pragma unroll
            for (int i = 0; i < 16; ++i) acc[pi][qi][i] *= f; }
}
DI void scale_acc_p(f32x16 (&acc)[2][2], const float* rs) {
    const int lane = tidx() & 63, wm = tidx() >> 7, hh = lane >> 5;
#pragma unroll
    for (int pi = 0; pi < 2; ++pi)
#pragma unroll
        for (int g = 0; g < 4; ++g) { const f32x4 f = *(const f32x4*)(rs + wm * 64 + pi * 32 + 8 * g + 4 * hh);
#pragma unroll
            for (int qi = 0; qi < 2; ++qi)
#pragma unroll
                for (int e = 0; e < 4; ++e) acc[pi][qi][4 * g + e] *= f[e]; }
}

DI int map_col(int map, int n) {
    switch (map) {
    case 1:
        if (n < 1024) return n;
        if (n < 2048) return 2216 + (n - 1024);
        if (n < 2432) return 1544 + (n - 2048);
        if (n < 2688) return 1928 + (n - 2432);
        if (n < 2816) { const int c = n - 2688; if (c < 16) return 2184 + c; if (c < 32) return 2200 + (c - 16); if (c < 40) return 1536 + (c - 32); return -1; }
        if (n < 3328) return 1024 + (n - 2816);
        if (n < 3840) return 3240 + (n - 3328);
        return -1;
    case 2: return 3752 + n;
    case 3:
        if (n < 512) return (n >> 6) * 96 + (n & 63);
        { const int n2 = n - 512; return (n2 >> 5) * 96 + 64 + (n2 & 31); }
    case 4:
        if (n < 512) return (n >> 6) * 128 + (n & 63);
        { const int n2 = n - 512; return (n2 >> 6) * 128 + 64 + (n2 & 63); }
    case 5: return (n >> 5) * 16 + (n & 15);
    default: return n;
    }
}

DI void transpose_tile(const float* __restrict__ src, const float* __restrict__ src2, int ld, int K, bf16_t* __restrict__ dst, int map, const float* __restrict__ kscale, int n0, int k0, float* tile) {
    const int tid = tidx(), tx = tid & 63, ty = tid >> 6;
    const int sc = map_col(map, n0 + tx);
    if (map == 5 && (((n0 + tx) >> 4) & 1)) src = src2;
    const int scc = sc < 0 ? 0 : sc;
    const float* sp = src + (size_t)(k0 + ty) * ld + scc;
    float vals[16];
#pragma unroll
    for (int j = 0; j < 16; ++j) vals[j] = sp[(size_t)(4 * j) * ld];
    if (kscale) {
#pragma unroll
        for (int j = 0; j < 16; ++j) vals[j] *= kscale[k0 + ty + 4 * j];
    }
#pragma unroll
    for (int j = 0; j < 16; ++j) tile[(ty + 4 * j) * 65 + tx] = sc < 0 ? 0.f : vals[j];
    __syncthreads();
    const int n = tid >> 2, kq = (tid & 3) * 16;
    unsigned wv[8];
#pragma unroll
    for (int j = 0; j < 8; ++j) wv[j] = pack_bf16(tile[(kq + 2 * j) * 65 + n], tile[(kq + 2 * j + 1) * 65 + n]);
    uint4* d = (uint4*)(dst + (size_t)(n0 + n) * K + k0 + kq);
    d[0] = make_uint4(wv[0], wv[1], wv[2], wv[3]);
    d[1] = make_uint4(wv[4], wv[5], wv[6], wv[7]);
    __syncthreads();
}

DI void phase_prep(KargPtr p, unsigned char* smem) {
    const int tid = tidx();
    float* fs = (float*)smem;
    constexpr int NW = 9296, NMOD = 192, NROPE = 2048;
    for (int item = bidx(); item < NW + NMOD + NROPE; item += gdim()) {
        if (item < NW) {
            const int l = item / 4648; int ti = item % 4648;
            const float* src; const float* src2 = nullptr; int ld, K, Nd, map; size_t doff; const float* ksc = nullptr;
            if (ti < 992)       { src = p->w_in + (size_t)l * 1024 * 6824; ld = 6824; K = 1024; Nd = 3968; doff = W_IN; map = 1; }
            else if (ti < 1760) { ti -= 992;  src = p->w_in + (size_t)l * 1024 * 6824; ld = 6824; K = 1024; Nd = 3072; doff = W_GATE; map = 2; }
            else if (ti < 1832) { ti -= 1760; src = p->w_mla_uq + (size_t)l * 384 * 768; ld = 768; K = 384; Nd = 768; doff = W_UQ; map = 3; ksc = p->g_mla_q + l * 384; }
            else if (ti < 1896) { ti -= 1832; src = p->w_mla_ukv + (size_t)l * 256 * 1024; ld = 1024; K = 256; Nd = 1024; doff = W_UKV; map = 4; ksc = p->g_mla_kv + l * 256; }
            else if (ti < 2024) { ti -= 1896; src = p->w_o_fox + (size_t)l * 512 * 1024; ld = 1024; K = 512; Nd = 1024; doff = W_OF; map = 0; }
            else if (ti < 2152) { ti -= 2024; src = p->w_o_mla + (size_t)l * 512 * 1024; ld = 1024; K = 512; Nd = 1024; doff = W_OM; map = 0; }
            else if (ti < 2280) { ti -= 2152; src = p->w_o_sb + (size_t)l * 512 * 1024; ld = 1024; K = 512; Nd = 1024; doff = W_OS; map = 0; }
            else if (ti < 2536) { ti -= 2280; src = p->w_out + (size_t)l * 1024 * 1024; ld = 1024; K = 1024; Nd = 1024; doff = W_OUT; map = 0; }
            else if (ti < 3944) { ti -= 2536; src = p->w_ffn_gate + (size_t)l * 1024 * 2816; src2 = p->w_ffn_up + (size_t)l * 1024 * 2816; ld = 2816; K = 1024; Nd = 5632; doff = W_FGU; map = 5; }
            else                { ti -= 3944; src = p->w_ffn_down + (size_t)l * 2816 * 1024; ld = 1024; K = 2816; Nd = 1024; doff = W_FD; map = 0; }
            (void)Nd;
            const int kts = K >> 6; const int ntile = ti / kts, ktile = ti % kts;
            transpose_tile(src, src2, ld, K, p->wt + (size_t)l * W_LAYER + doff, map, ksc, ntile * 64, ktile * 64, fs);
        } else if (item < NW + NMOD) {
            const int mi = item - NW; const int l = mi / 96, c0 = (mi % 96) * 64;
            float* cond = fs;
            float* red = fs + 8192;
            for (int e = tid; e < 8192; e += 256) { const float cv = p->c[e]; cond[e] = cv * sigmoidf_(cv); }
            __syncthreads();
            const int tx = tid & 63, ty = tid >> 6;
            float a0 = 0, a1 = 0, a2 = 0, a3 = 0, a4 = 0, a5 = 0, a6 = 0, a7 = 0;
            const float* wsrc = p->w_ada + (size_t)l * 1024 * 6144 + c0 + tx;
#pragma unroll 8
            for (int k = ty * 256; k < ty * 256 + 256; ++k) {
                const float wv = wsrc[(size_t)k * 6144];
                a0 += cond[k] * wv; a1 += cond[1024 + k] * wv; a2 += cond[2048 + k] * wv; a3 += cond[3072 + k] * wv;
                a4 += cond[4096 + k] * wv; a5 += cond[5120 + k] * wv; a6 += cond[6144 + k] * wv; a7 += cond[7168 + k] * wv;
            }
            float* rr = red + ty * 512 + tx;
            rr[0] = a0; rr[64] = a1; rr[128] = a2; rr[192] = a3; rr[256] = a4; rr[320] = a5; rr[384] = a6; rr[448] = a7;
            __syncthreads();
            for (int o = tid; o < 512; o += 256) {
                const int b = o >> 6, xx = o & 63;
                const float s = red[o] + red[512 + o] + red[1024 + o] + red[1536 + o] + p->b_ada[l * 6144 + c0 + xx];
                p->mod[(size_t)(l * 8 + b) * 6144 + c0 + xx] = s;
            }
            __syncthreads();
        } else {
            const int e = (item - NW - NMOD) * 256 + tid;
            const int i = e & 15, tok = e >> 4;
            const float ang = (float)p->pos[tok] * ROPE_INV[i];
            const double a = (double)ang;
            const double kq = rint(a * 0.63661977236758134308);
            const double rr = fma(-kq, 1.57079632679489661923, a);
            const double r2 = rr * rr;
            const double* C = ROPE_POLY;
            const double sn = rr * (1.0 + r2 * (C[0] + r2 * (C[1] + r2 * (C[2] + r2 * (C[3] + r2 * C[4])))));
            const double cs = 1.0 + r2 * (C[5] + r2 * (C[6] + r2 * (C[7] + r2 * (C[8] + r2 * (C[9] + r2 * C[10])))));
            const int q = ((int)(long long)kq) & 3;
            const double co = (q == 0) ? cs : (q == 1) ? -sn : (q == 2) ? -cs : sn;
            const double si = (q == 0) ? sn : (q == 1) ? cs : (q == 2) ? -sn : -cs;
            p->ropetab[2 * (size_t)e] = (float)co; p->ropetab[2 * (size_t)e + 1] = (float)si;
        }
    }
}

DI float wave_sum(float v) {
#pragma unroll
    for (int o = 32; o >= 1; o >>= 1) v += __shfl_xor(v, o);
    return v;
}
DI void phase_norm(const float* __restrict__ xin, const float* __restrict__ g, const float* __restrict__ modl, int sh_idx, int sc_idx, bf16_t* __restrict__ uout) {
    const int lane = tidx() & 63, w = tidx() >> 6;
    for (int row = bidx() * 4 + w; row < T_TOK; row += gdim() * 4) {
        const int b = row >> 12;
        const f32x4* xr = (const f32x4*)(xin + (size_t)row * 1024);
        f32x4 v[4]; float ss = 0.f;
#pragma unroll
        for (int j = 0; j < 4; ++j) { v[j] = xr[lane + 64 * j]; ss += v[j][0] * v[j][0] + v[j][1] * v[j][1] + v[j][2] * v[j][2] + v[j][3] * v[j][3]; }
        ss = wave_sum(ss);
        const float rstd = rsqrtf(ss * (1.0f / 1024.0f) + EPS);
        const float* mb = modl + (size_t)b * 6144;
#pragma unroll
        for (int j = 0; j < 4; ++j) {
            const int col = 4 * (lane + 64 * j);
            const f32x4 g4 = *(const f32x4*)(g + col), sc4 = *(const f32x4*)(mb + sc_idx * 1024 + col), sh4 = *(const f32x4*)(mb + sh_idx * 1024 + col);
            float y[4];
#pragma unroll
            for (int e = 0; e < 4; ++e) y[e] = (v[j][e] * rstd) * g4[e] * (1.0f + sc4[e]) + sh4[e];
            u32x2 pk; pk.x = pack_bf16(y[0], y[1]); pk.y = pack_bf16(y[2], y[3]);
            *(u32x2*)(uout + (size_t)row * 1024 + col) = pk;
        }
    }
}
DI void phase_final(KargPtr p) {
    const int lane = tidx() & 63, w = tidx() >> 6;
    for (int row = bidx() * 4 + w; row < T_TOK; row += gdim() * 4) {
        f32x4* xr = (f32x4*)(p->out + (size_t)row * 1024);
        f32x4 v[4]; float ss = 0.f;
#pragma unroll
        for (int j = 0; j < 4; ++j) { v[j] = xr[lane + 64 * j]; ss += v[j][0] * v[j][0] + v[j][1] * v[j][1] + v[j][2] * v[j][2] + v[j][3] * v[j][3]; }
        ss = wave_sum(ss);
        const float rstd = rsqrtf(ss * (1.0f / 1024.0f) + EPS);
#pragma unroll
        for (int j = 0; j < 4; ++j) {
            const f32x4 g4 = *(const f32x4*)(p->g_final + 4 * (lane + 64 * j));
            f32x4 o;
#pragma unroll
            for (int e = 0; e < 4; ++e) o[e] = (v[j][e] * rstd) * g4[e];
            xr[lane + 64 * j] = o;
        }
    }
}

struct EpiInprojA {
    static constexpr bool PERM = false, AFTER_DRAIN = false;
    bf16_t* qf; bf16_t* kf; bf16_t* qs; bf16_t* ks; bf16_t* ql; bf16_t* kvl; bf16_t* kr; float* logf; const float* ropetab; const float* bfox;
    __device__ __forceinline__ void operator()(const pg8::f32x4 (&acc)[2][2][4][2], const pg8::Unit& u, int wr, int wc, int fr, int fq) const {
        const int row0 = u.pm * 256 + wr * 64 + fr;
        const int cw = wc * 32 + fq * 4;
#pragma unroll
        for (int bj = 0; bj < 2; ++bj) {
            bf16_t* dst; int ld; float sc = 1.0f; bool special = false;
            if (u.pn < 8) { const int region = u.pn >> 1; dst = (region == 0 ? qf : region == 1 ? kf : region == 2 ? qs : ks) + (u.pn & 1) * 256 + bj * 128; ld = 512; if (region == 0 || region == 2) sc = FOX_QS; }
            else if (u.pn == 8) { dst = ql + bj * 128; ld = 384; }
            else if (u.pn == 9) { if (bj == 0) { dst = ql + 256; ld = 384; } else { dst = kvl; ld = 256; } }
            else { dst = kvl + 128; ld = 256; special = (bj == 1); }
            if (!special) {
#pragma unroll
                for (int ai = 0; ai < 2; ++ai)
#pragma unroll
                    for (int m = 0; m < 4; ++m) {
                        bf16_t* rowp = dst + (size_t)(row0 + ai * 128 + m * 16) * ld + cw;
#pragma unroll
                        for (int n = 0; n < 2; ++n) { const pg8::f32x4 v = acc[ai][bj][m][n] * sc; u32x2 pk; pk.x = pack_bf16(v[0], v[1]); pk.y = pack_bf16(v[2], v[3]); *(u32x2*)(rowp + n * 16) = pk; }
                    }
            } else if (wc == 0) {
#pragma unroll
                for (int ai = 0; ai < 2; ++ai)
#pragma unroll
                    for (int m = 0; m < 4; ++m) {
                        const int t = row0 + ai * 128 + m * 16;
                        const pg8::f32x4 x1 = acc[ai][1][m][0], x2 = acc[ai][1][m][1];
                        const pg8::f32x4 ca = *(const pg8::f32x4*)(ropetab + 2 * (t * 16 + fq * 4)), cb = *(const pg8::f32x4*)(ropetab + 2 * (t * 16 + fq * 4) + 4);
                        const float co[4] = {ca[0], ca[2], cb[0], cb[2]}, si[4] = {ca[1], ca[3], cb[1], cb[3]};
                        float o1[4], o2[4];
#pragma unroll
                        for (int j = 0; j < 4; ++j) { o1[j] = x1[j] * co[j] - x2[j] * si[j]; o2[j] = x1[j] * si[j] + x2[j] * co[j]; }
                        u32x2 p1, p2; p1.x = pack_bf16(o1[0], o1[1]); p1.y = pack_bf16(o1[2], o1[3]); p2.x = pack_bf16(o2[0], o2[1]); p2.y = pack_bf16(o2[2], o2[3]);
                        *(u32x2*)(kr + (size_t)t * 32 + fq * 4) = p1;
                        *(u32x2*)(kr + (size_t)t * 32 + 16 + fq * 4) = p2;
                    }
            } else if (wc == 1 && fq < 2) {
#pragma unroll
                for (int ai = 0; ai < 2; ++ai)
#pragma unroll
                    for (int m = 0; m < 4; ++m) {
                        const int t = row0 + ai * 128 + m * 16, b = t >> 12, sq = t & 4095;
#pragma unroll
                        for (int j = 0; j < 4; ++j) {
                            const int head = fq * 4 + j;
                            const float f = acc[ai][1][m][0][j] + bfox[head];
                            logf[(size_t)(b * 8 + head) * SEQ + sq] = fminf(f, 0.f) - log1pf(expf(-fabsf(f)));
                        }
                    }
            }
        }
    }
};
struct EpiInprojV {
    static constexpr bool PERM = false, AFTER_DRAIN = false;
    bf16_t* vtf; bf16_t* vts;
    __device__ __forceinline__ void operator()(const pg8::f32x4 (&acc)[2][2][4][2], const pg8::Unit& u, int wr, int wc, int fr, int fq) const {
        bf16_t* vt = u.pn < 2 ? vtf : vts;
        const int row0 = u.pm * 256 + wr * 64 + fq * 4, b = row0 >> 12, s0 = row0 & 4095;
        const int cv0 = (u.pn & 1) * 256 + wc * 32 + fr;
#pragma unroll
        for (int bj = 0; bj < 2; ++bj)
#pragma unroll
            for (int n = 0; n < 2; ++n) {
                const int cv = cv0 + bj * 128 + n * 16;
                bf16_t* vp = vt + (size_t)(b * 8 + (cv >> 6)) * SEQ * 64 + (cv & 63) * 64;
#pragma unroll
                for (int ai = 0; ai < 2; ++ai)
#pragma unroll
                    for (int m = 0; m < 4; ++m) { const int sq = s0 + ai * 128 + m * 16; const pg8::f32x4 v = acc[ai][bj][m][n]; u32x2 pk; pk.x = pack_bf16(v[0], v[1]); pk.y = pack_bf16(v[2], v[3]);
                        *(u32x2*)(vp + (size_t)(sq >> 6) * 4096 + (sq & 63)) = pk; }
            }
    }
};
struct EpiFfnUp {
    static constexpr bool PERM = false, AFTER_DRAIN = false;
    bf16_t* h;
    __device__ __forceinline__ void operator()(const pg8::f32x4 (&acc)[2][2][4][2], const pg8::Unit& u, int wr, int wc, int fr, int fq) const {
        const int row0 = u.pm * 256 + wr * 64 + fr;
#pragma unroll
        for (int ai = 0; ai < 2; ++ai)
#pragma unroll
            for (int m = 0; m < 4; ++m) {
                bf16_t* rowp = h + (size_t)(row0 + ai * 128 + m * 16) * 2816 + u.pn * 128 + wc * 16 + fq * 4;
#pragma unroll
                for (int bj = 0; bj < 2; ++bj) {
                    const pg8::f32x4 g = acc[ai][bj][m][0], up = acc[ai][bj][m][1];
                    float hv[4];
#pragma unroll
                    for (int j = 0; j < 4; ++j) hv[j] = g[j] * sigmoidf_(g[j]) * up[j];
                    u32x2 pk; pk.x = pack_bf16(hv[0], hv[1]); pk.y = pack_bf16(hv[2], hv[3]);
                    *(u32x2*)(rowp + bj * 64) = pk;
                }
            }
    }
};
struct EpiResidual {
    static constexpr bool PERM = false, AFTER_DRAIN = false;
    const float* xin; float* xout; const float* modl; int gidx;
    __device__ __forceinline__ void operator()(const pg8::f32x4 (&acc)[2][2][4][2], const pg8::Unit& u, int wr, int wc, int fr, int fq) const {
        const int row0 = u.pm * 256 + wr * 64 + fr, b = row0 >> 12;
        const float* gt = modl + (size_t)b * 6144 + gidx * 1024;
#pragma unroll
        for (int bj = 0; bj < 2; ++bj)
#pragma unroll
            for (int n = 0; n < 2; ++n) {
                const int col = u.pn * 256 + bj * 128 + wc * 32 + n * 16 + fq * 4;
                const pg8::f32x4 g4 = *(const pg8::f32x4*)(gt + col);
                pg8::f32x4 xv[2][4];
#pragma unroll
                for (int ai = 0; ai < 2; ++ai)
#pragma unroll
                    for (int m = 0; m < 4; ++m) xv[ai][m] = *(const pg8::f32x4*)(xin + (size_t)(row0 + ai * 128 + m * 16) * 1024 + col);
#pragma unroll
                for (int ai = 0; ai < 2; ++ai)
#pragma unroll
                    for (int m = 0; m < 4; ++m) *(pg8::f32x4*)(xout + (size_t)(row0 + ai * 128 + m * 16) * 1024 + col) = xv[ai][m] + g4 * acc[ai][bj][m][n];
            }
    }
};
template <class Epi, bool NAT = false>
DI void big_gemm(const bf16_t* A, const bf16_t* Bt, int N, int K, const Epi& E, unsigned char* smem) {
    __syncthreads();
    pg8::StaticOrder S; S.init(T_TOK, N, (int)gridDim.x, (int)blockIdx.x);
    pg8::Gemm g; g.A = A; g.Bt = Bt; g.M = T_TOK; g.N = N; g.K = K;
    pg8::gemm_phase<Epi, pg8::StaticOrder, true, true, NAT>((PG8_LAS unsigned char*)smem, g, S, E);
    __syncthreads();
}

DI void phase_inproj(KargPtr p, int l, unsigned char* smem_phys) {
    const bf16_t* W = p->wt + (size_t)l * W_LAYER + W_IN;
    { EpiInprojA E; E.qf = p->qf; E.kf = p->kf; E.qs = p->qs; E.ks = p->ks; E.ql = p->ql; E.kvl = p->kvl; E.kr = p->kr; E.logf = p->logf; E.ropetab = p->ropetab; E.bfox = p->b_fox_f + l * 8;
      big_gemm<EpiInprojA, false>(p->u, W, 2816, 1024, E, smem_phys); }
    { EpiInprojV E; E.vtf = p->vtf; E.vts = p->vts;
      big_gemm<EpiInprojV, true>(p->u, W + (size_t)2816 * 1024, 1024, 1024, E, smem_phys); }
}

DI void phase_mla_up(KargPtr p, int l, unsigned char* smem) {
    const int tid = tidx(), lane = tid & 63, w = tid >> 6;
    (void)l;
    for (int row = (bidx() * 4 + w) * 2; row < T_TOK; row += gdim() * 8) {
        float sq[2], skv[2];
#pragma unroll
        for (int k = 0; k < 2; ++k) {
            uint4 a = make_uint4(0, 0, 0, 0), c = make_uint4(0, 0, 0, 0);
            if (lane < 48) a = *(const uint4*)(p->ql + (size_t)(row + k) * 384 + lane * 8);
            if (lane < 32) c = *(const uint4*)(p->kvl + (size_t)(row + k) * 256 + lane * 8);
            const unsigned ua[4] = {a.x, a.y, a.z, a.w}, uc[4] = {c.x, c.y, c.z, c.w};
            float s1 = 0.f, s2 = 0.f;
#pragma unroll
            for (int e = 0; e < 4; ++e) { float lo = __uint_as_float(ua[e] << 16), hi = __uint_as_float(ua[e] & 0xffff0000u); s1 += lo * lo + hi * hi;
                                          lo = __uint_as_float(uc[e] << 16); hi = __uint_as_float(uc[e] & 0xffff0000u); s2 += lo * lo + hi * hi; }
            sq[k] = wave_sum(s1); skv[k] = wave_sum(s2);
        }
        if (lane == 0) { p->rsq[row] = rsqrtf(sq[0] * (1.0f / 384.0f) + EPS); p->rsq[row + 1] = rsqrtf(sq[1] * (1.0f / 384.0f) + EPS);
                         p->rskv[row] = rsqrtf(skv[0] * (1.0f / 256.0f) + EPS); p->rskv[row + 1] = rsqrtf(skv[1] * (1.0f / 256.0f) + EPS); }
    }
    __syncthreads();
    float* fs = (float*)smem;
    for (int bh = bidx(); bh < 64; bh += gdim()) {
        const f32x4* src = (const f32x4*)(p->logf + (size_t)bh * SEQ + tid * 16);
        f32x4 v[4];
        float run = 0.f;
#pragma unroll
        for (int j = 0; j < 4; ++j) { v[j] = src[j];
#pragma unroll
            for (int e = 0; e < 4; ++e) { run += v[j][e]; v[j][e] = run; } }
        float incl = run;
#pragma unroll
        for (int o = 1; o < 64; o <<= 1) { const float tv = __shfl_up(incl, o); if (lane >= o) incl += tv; }
        if (lane == 63) fs[w] = incl;
        __syncthreads();
        float pre = incl - run;
        for (int ww = 0; ww < w; ++ww) pre += fs[ww];
        f32x4* dst = (f32x4*)(p->cum + (size_t)bh * SEQ + tid * 16);
#pragma unroll
        for (int j = 0; j < 4; ++j) { f32x4 o;
#pragma unroll
            for (int e = 0; e < 4; ++e) o[e] = v[j][e] + pre; dst[j] = o; }
        __syncthreads();
        {
            const bf16_t* kp = p->kf + (size_t)(bh >> 3) * SEQ * 512 + (bh & 7) * 64 + (size_t)tid * 16 * 512;
            float mx = 0.f;
            for (int rr = 0; rr < 16; ++rr) {
                const uint4* q4 = (const uint4*)(kp + (size_t)rr * 512);
                uint4 vv[8];
#pragma unroll
                for (int c = 0; c < 8; ++c) vv[c] = q4[c];
                float ss = 0.f;
#pragma unroll
                for (int c = 0; c < 8; ++c) { const unsigned uu[4] = {vv[c].x, vv[c].y, vv[c].z, vv[c].w};
#pragma unroll
                    for (int e = 0; e < 4; ++e) { const float lo = __uint_as_float(uu[e] << 16), hi = __uint_as_float(uu[e] & 0xffff0000u); ss += lo * lo + hi * hi; } }
                mx = fmaxf(mx, ss);
            }
#pragma unroll
            for (int o = 32; o >= 1; o >>= 1) mx = fmaxf(mx, __shfl_xor(mx, o));
            if (lane == 0) fs[16 + w] = mx;
            __syncthreads();
            if (tid == 0) p->kmax[bh] = sqrtf(fmaxf(fmaxf(fs[16], fs[17]), fmaxf(fs[18], fs[19]))) * 1.01f;
            __syncthreads();
        }
    }
}

template <int TYPE>
DI void attn_item(KargPtr p, int b, int h, int qb, unsigned char* smem) {
    constexpr int DK = (TYPE == 1) ? 96 : (TYPE == 0 ? 80 : 64), KS = DK / 16, KROWB = (DK + 8) * 2, VROWB = 144;
    constexpr int KBYTES = 64 * KROWB, VBYTES = 64 * VROWB, BUFB = KBYTES + VBYTES + 256;
    const int tid = tidx(), lane = tid & 63, w = tid >> 6, r = lane & 31, hh = lane >> 5;
    const int q0 = qb * 128, qw = q0 + 32 * w, myq = qw + r;
    const size_t tokq = (size_t)b * SEQ + myq;
    unsigned* flags = (unsigned*)(smem - vhalf() * VSMEM + FLAGS_OFF);
    const int w8 = vhalf() * 4 + w;

    bf16x8 qfrag[KS];
    if (TYPE == 1) {
#pragma unroll
        for (int ks = 0; ks < 4; ++ks) qfrag[ks] = *(const bf16x8*)(p->qn + tokq * 512 + h * 64 + ks * 16 + hh * 8);
#pragma unroll
        for (int ks = 4; ks < KS; ++ks) qfrag[ks] = *(const bf16x8*)(p->qr + tokq * 256 + h * 32 + (ks - 4) * 16 + hh * 8);
    } else {
        const bf16_t* qg = (TYPE == 0 ? p->qf : p->qs) + tokq * 512 + h * 64;
#pragma unroll
        for (int ks = 0; ks < 4; ++ks) qfrag[ks] = *(const bf16x8*)(qg + ks * 16 + hh * 8);
        if (TYPE == 0) { const u32x4 one3 = hh == 0 ? (u32x4){0x3F803F80u, 0x00003F80u, 0u, 0u} : (u32x4){0u, 0u, 0u, 0u}; qfrag[KS - 1] = __builtin_bit_cast(bf16x8, one3); }
    }
    const bf16_t* Kg = (TYPE == 0 ? p->kf : TYPE == 1 ? p->kn : p->ks) + (size_t)b * SEQ * 512 + h * 64;
    const bf16_t* Vg = (TYPE == 0 ? p->vtf : TYPE == 1 ? p->vtm : p->vts) + (size_t)(b * 8 + h) * 64 * SEQ;
    const bf16_t* Krg = p->kr + (size_t)b * SEQ * 32;
    const float* cumg = p->cum + (size_t)(b * 8 + h) * SEQ;

    const int ntiles = 2 * qb + 2;
    u32x4 rk0A, rk1A, rv0A, rv1A, rkrA, rk0B, rk1B, rv0B, rv1B, rkrB; float rckA = 0.f, rckB = 0.f;
    { unsigned z_ = 0u; asm volatile("" : "+v"(z_)); rkrA = (u32x4){z_, z_, z_, z_}; rkrB = rkrA; }
    const int ldrow = tid >> 3, ldch = tid & 7;
    const int vpos = 16 * (ldch >> 1) + 4 * (ldch & 1);
#define LOAD_TILE(S, KT_) do { \
        const int k0_ = (KT_) * 64; \
        GLOAD16(rk0##S, Kg + (size_t)(k0_ + ldrow) * 512 + ldch * 8); \
        GLOAD16(rk1##S, Kg + (size_t)(k0_ + 32 + ldrow) * 512 + ldch * 8); \
        GLOAD16(rv0##S, Vg + (size_t)k0_ * 64 + ldrow * 64 + ldch * 8); \
        GLOAD16(rv1##S, Vg + (size_t)k0_ * 64 + (32 + ldrow) * 64 + ldch * 8); \
        if (TYPE == 1) GLOAD16(rkr##S, Krg + (size_t)(k0_ + (tid >> 2)) * 32 + (tid & 3) * 8); \
        if (TYPE == 0) GLOAD4(rck##S, cumg + k0_ + (tid & 63)); \
    } while (0)
#define WAIT_ALL(S) asm volatile("s_waitcnt vmcnt(0)" : "+v"(rk0##S), "+v"(rk1##S), "+v"(rv0##S), "+v"(rv1##S), "+v"(rkr##S), "+v"(rck##S))
#define WAIT_OLD(S) do { if (TYPE == 2) asm volatile("s_waitcnt vmcnt(4)" : "+v"(rk0##S), "+v"(rk1##S), "+v"(rv0##S), "+v"(rv1##S), "+v"(rkr##S), "+v"(rck##S)); \
        else asm volatile("s_waitcnt vmcnt(5)" : "+v"(rk0##S), "+v"(rk1##S), "+v"(rv0##S), "+v"(rv1##S), "+v"(rkr##S), "+v"(rck##S)); } while (0)
#define STORE_TILE(S, BUF_) do { \
        unsigned char* kb_ = smem + (BUF_) * BUFB; unsigned char* vb_ = kb_ + KBYTES; \
        *(u32x4*)(kb_ + ldrow * KROWB + ldch * 16) = rk0##S; \
        *(u32x4*)(kb_ + (32 + ldrow) * KROWB + ldch * 16) = rk1##S; \
        { u32x2 lo, hi; lo.x = rv0##S.x; lo.y = rv0##S.y; hi.x = rv0##S.z; hi.y = rv0##S.w; \
          *(u32x2*)(vb_ + ldrow * VROWB + vpos * 2) = lo; *(u32x2*)(vb_ + ldrow * VROWB + (vpos + 8) * 2) = hi; } \
        { u32x2 lo, hi; lo.x = rv1##S.x; lo.y = rv1##S.y; hi.x = rv1##S.z; hi.y = rv1##S.w; \
          *(u32x2*)(vb_ + (32 + ldrow) * VROWB + vpos * 2) = lo; *(u32x2*)(vb_ + (32 + ldrow) * VROWB + (vpos + 8) * 2) = hi; } \
        if (TYPE == 1) *(u32x4*)(kb_ + (tid >> 2) * KROWB + 128 + (tid & 3) * 16) = rkr##S; \
        if (TYPE == 0) { if (tid < 64) { \
            const float c_ = -rck##S * LOG2E; \
            const unsigned h_ = pack_bf16(c_, 0.f) & 0xffffu; const float r1_ = c_ - __uint_as_float(h_ << 16); \
            const unsigned m_ = pack_bf16(r1_, 0.f) & 0xffffu; const float r2_ = r1_ - __uint_as_float(m_ << 16); \
            const unsigned l_ = pack_bf16(r2_, 0.f) & 0xffffu; \
            *(u32x4*)(kb_ + tid * KROWB + 128) = (u32x4){h_ | (m_ << 16), l_, 0u, 0u}; \
            { unsigned z_ = 0u; asm volatile("" : "+v"(z_)); *(u32x4*)(kb_ + tid * KROWB + 144) = (u32x4){z_, z_, z_, z_}; }        \
            if (tid == 63) *(float*)(vb_ + VBYTES) = c_; } } \
    } while (0)
#define TILE_OF(J_) ((TYPE != 1) ? (ntiles - 1 - ((J_) < ntiles ? (J_) : ntiles - 1)) : ((J_) < ntiles ? (J_) : ntiles - 1))

    f32x16 o0, o1;
#pragma unroll
    for (int i = 0; i < 16; ++i) { o0[i] = 0.f; o1[i] = 0.f; }
    float m = -1e30f, lsum = 0.f, carry = 0.f;
    bool wdone = false;
    float qbound = 0.f;
    if (TYPE == 0) {
        float ss = 0.f;
#pragma unroll
        for (int ks = 0; ks < 4; ++ks) { const u32x4 qq = __builtin_bit_cast(u32x4, qfrag[ks]);
#pragma unroll
            for (int e = 0; e < 4; ++e) { const float lo = __uint_as_float(qq[e] << 16), hi = __uint_as_float(qq[e] & 0xffff0000u); ss += lo * lo + hi * hi; } }
        ss += __shfl_xor(ss, 32);
        qbound = sqrtf(ss) * 1.01f * p->kmax[b * 8 + h];
    }

    auto compute = [&](const int kt, const int buf) __attribute__((always_inline)) {
        const unsigned char* kb = smem + buf * BUFB; const unsigned char* vb = kb + KBYTES;
        const int k0 = kt * 64;
        bool need;
        if (TYPE == 0) {
            if (!wdone && k0 <= qw + 31) wdone = (__all(qbound + *(const float*)(vb + VBYTES) - m < -150.f) != 0);
            need = (k0 <= qw + 31) && !wdone;
        }
        else if (TYPE == 1) need = (k0 <= qw);
        else need = (k0 <= qw + 30) && !wdone;
        if (need) {
            f32x16 s0, s1;
#pragma unroll
            for (int i = 0; i < 16; ++i) { s0[i] = 0.f; s1[i] = 0.f; }
#pragma unroll
            for (int ks = 0; ks < KS; ++ks) {
                const bf16x8 a0 = *(const bf16x8*)(kb + r * KROWB + ks * 32 + hh * 16);
                const bf16x8 a1 = *(const bf16x8*)(kb + (32 + r) * KROWB + ks * 32 + hh * 16);
                s0 = MFMA(a0, qfrag[ks], s0); s1 = MFMA(a1, qfrag[ks], s1);
            }
            if (TYPE != 2) {
                if (TYPE == 0) {
                    if (k0 + 63 > qw) {
                        asm volatile("");
                        const int rel = myq - k0 - 4 * hh;
#pragma unroll
                        for (int i = 0; i < 16; ++i) {
                            const int off = 8 * (i >> 2) + (i & 3);
                            if (off > rel) s0[i] = -1e30f;
                            if (off + 32 > rel) s1[i] = -1e30f;
                        }
                    }
                }
                float mx = s0[0];
#pragma unroll
                for (int i = 1; i < 16; ++i) mx = fmaxf(mx, s0[i]);
#pragma unroll
                for (int i = 0; i < 16; ++i) mx = fmaxf(mx, s1[i]);
                mx = fmaxf(mx, __shfl_xor(mx, 32));
                const float mnew = fmaxf(m, mx);
                const float alpha = fexp2(m - mnew);
                m = mnew;
                float ps = 0.f;
#pragma unroll
                for (int i = 0; i < 16; i += 2) {
                    const f32x2_t mm = {mnew, mnew};
                    const f32x2_t d0 = (f32x2_t){s0[i], s0[i + 1]} - mm, d1 = (f32x2_t){s1[i], s1[i + 1]} - mm;
                    s0[i] = fexp2(d0[0]); s0[i + 1] = fexp2(d0[1]); s1[i] = fexp2(d1[0]); s1[i + 1] = fexp2(d1[1]);
                    ps += (s0[i] + s0[i + 1]) + (s1[i] + s1[i + 1]);
                }
                lsum = lsum * alpha + ps;
#pragma unroll
                for (int i = 0; i < 16; ++i) { o0[i] *= alpha; o1[i] *= alpha; }
            } else {
                float lk0[16], lk1[16];
#pragma unroll
                for (int i = 0; i < 16; ++i) {
                    {
                        const float z = s0[i]; const float sp = flog2(1.0f + fexp2(-fabsf(z)));
                        const float lb = fminf(z, 0.f) - sp;
                        s0[i] = lb; lk0[i] = lb - z;
                    }
                    {
                        const float z = s1[i]; const float sp = flog2(1.0f + fexp2(-fabsf(z)));
                        const float lb = fminf(z, 0.f) - sp;
                        s1[i] = lb; lk1[i] = lb - z;
                    }
                }
                if (k0 + 63 >= qw) {
                    asm volatile("");
                    const int rel = myq - k0 - 4 * hh;
#pragma unroll
                    for (int i = 0; i < 16; ++i) {
                        const int off = 8 * (i >> 2) + (i & 3);
                        if (off >= rel) { lk0[i] = 0.f; s0[i] = -1e30f; }
                        if (off + 32 >= rel) { lk1[i] = 0.f; s1[i] = -1e30f; }
                    }
                }
                float run = carry;
#pragma unroll
                for (int g = 3; g >= 0; --g) {
                    const float G = (lk1[4 * g] + lk1[4 * g + 1]) + (lk1[4 * g + 2] + lk1[4 * g + 3]);
                    const float Gp = __shfl_xor(G, 32);
                    const float base = run + (hh == 0 ? Gp : 0.f);
                    const float e3 = base, e2 = e3 + lk1[4 * g + 3], e1 = e2 + lk1[4 * g + 2], e0 = e1 + lk1[4 * g + 1];
                    s1[4 * g + 3] = fexp2(s1[4 * g + 3] + e3); s1[4 * g + 2] = fexp2(s1[4 * g + 2] + e2);
                    s1[4 * g + 1] = fexp2(s1[4 * g + 1] + e1); s1[4 * g] = fexp2(s1[4 * g] + e0);
                    run += G + Gp;
                }
#pragma unroll
                for (int g = 3; g >= 0; --g) {
                    const float G = (lk0[4 * g] + lk0[4 * g + 1]) + (lk0[4 * g + 2] + lk0[4 * g + 3]);
                    const float Gp = __shfl_xor(G, 32);
                    const float base = run + (hh == 0 ? Gp : 0.f);
                    const float e3 = base, e2 = e3 + lk0[4 * g + 3], e1 = e2 + lk0[4 * g + 2], e0 = e1 + lk0[4 * g + 1];
                    s0[4 * g + 3] = fexp2(s0[4 * g + 3] + e3); s0[4 * g + 2] = fexp2(s0[4 * g + 2] + e2);
                    s0[4 * g + 1] = fexp2(s0[4 * g + 1] + e1); s0[4 * g] = fexp2(s0[4 * g] + e0);
                    run += G + Gp;
                }
                carry = run;
            }
#pragma unroll
            for (int s2 = 0; s2 < 2; ++s2) {
                unsigned pk0[4], pk1[4];
#pragma unroll
                for (int j = 0; j < 4; ++j) { pk0[j] = pack_bf16(s0[8 * s2 + 2 * j], s0[8 * s2 + 2 * j + 1]); pk1[j] = pack_bf16(s1[8 * s2 + 2 * j], s1[8 * s2 + 2 * j + 1]); }
                const uint4 u0 = make_uint4(pk0[0], pk0[1], pk0[2], pk0[3]), u1 = make_uint4(pk1[0], pk1[1], pk1[2], pk1[3]);
                const bf16x8 pf0 = __builtin_bit_cast(bf16x8, u0), pf1 = __builtin_bit_cast(bf16x8, u1);
                const bf16x8 v00 = *(const bf16x8*)(vb + r * VROWB + (16 * s2 + 8 * hh) * 2);
                const bf16x8 v01 = *(const bf16x8*)(vb + (32 + r) * VROWB + (16 * s2 + 8 * hh) * 2);
                const bf16x8 v10 = *(const bf16x8*)(vb + r * VROWB + (32 + 16 * s2 + 8 * hh) * 2);
                const bf16x8 v11 = *(const bf16x8*)(vb + (32 + r) * VROWB + (32 + 16 * s2 + 8 * hh) * 2);
                o0 = MFMA(v00, pf0, o0); o1 = MFMA(v01, pf0, o1);
                o0 = MFMA(v10, pf1, o0); o1 = MFMA(v11, pf1, o1);
            }
        }
    };
#define SB_FLAGS(N_) do { if (TYPE != 1) { if (TYPE == 2) wdone = (__all(carry < -170.f) != 0); if (lane == 0) flags[((N_) & 1) * 8 + w8] = wdone ? 1u : 0u; } } while (0)
#define SB_DONE(N_) (TYPE != 1 && ((flags[((N_) & 1) * 8] & flags[((N_) & 1) * 8 + 1] & flags[((N_) & 1) * 8 + 2] & flags[((N_) & 1) * 8 + 3] & flags[((N_) & 1) * 8 + 4] & flags[((N_) & 1) * 8 + 5] & flags[((N_) & 1) * 8 + 6] & flags[((N_) & 1) * 8 + 7]) != 0u))
    __syncthreads();
    if (TYPE != 1 && tid < 16) flags[tid] = 0;
    LOAD_TILE(A, TILE_OF(0));
    WAIT_ALL(A);
    STORE_TILE(A, 0);
    LOAD_TILE(A, TILE_OF(1));
    __syncthreads();
    for (int n = 0; n < ntiles; n += 2) {
        LOAD_TILE(B, TILE_OF(n + 2));
        __builtin_amdgcn_sched_barrier(0);
        compute(TILE_OF(n), 0);
        __builtin_amdgcn_sched_barrier(0);
        WAIT_OLD(A);
        STORE_TILE(A, 1);
        SB_FLAGS(n);
        __syncthreads();
        if (SB_DONE(n)) break;
        if (n + 1 >= ntiles) break;
        LOAD_TILE(A, TILE_OF(n + 3));
        __builtin_amdgcn_sched_barrier(0);
        compute(TILE_OF(n + 1), 1);
        __builtin_amdgcn_sched_barrier(0);
        WAIT_OLD(B);
        STORE_TILE(B, 0);
        SB_FLAGS(n + 1);
        __syncthreads();
        if (SB_DONE(n + 1)) break;
    }
    asm volatile("s_waitcnt vmcnt(0)" : "+v"(rk0A), "+v"(rk1A), "+v"(rv0A), "+v"(rv1A), "+v"(rkrA), "+v"(rckA), "+v"(rk0B), "+v"(rk1B), "+v"(rv0B), "+v"(rv1B), "+v"(rkrB), "+v"(rckB));
    float inv = 1.0f;
    if (TYPE != 2) { const float lt = lsum + __shfl_xor(lsum, 32); inv = frcp(lt); }
    bf16_t* yg = (TYPE == 0 ? p->qf : TYPE == 1 ? p->qn : p->qs) + tokq * 512 + h * 64;
#pragma unroll
    for (int g = 0; g < 4; ++g) {
        u32x2 a, c2;
        a.x = pack_bf16(o0[4 * g] * inv, o0[4 * g + 1] * inv); a.y = pack_bf16(o0[4 * g + 2] * inv, o0[4 * g + 3] * inv);
        c2.x = pack_bf16(o1[4 * g] * inv, o1[4 * g + 1] * inv); c2.y = pack_bf16(o1[4 * g + 2] * inv, o1[4 * g + 3] * inv);
        *(u32x2*)(yg + 8 * g + 4 * hh) = a;
        *(u32x2*)(yg + 32 + 8 * g + 4 * hh) = c2;
    }
}

DI void phase_attn(KargPtr p, unsigned char* smem) {
    for (int idx = bidx(); idx < 6144; idx += gdim()) {
        if (idx < 4096) {
            const int j = idx >> 9, g = (idx >> 7) & 3, rem = idx & 127, bh = ((rem & 63) + 13 * j) & 63;
            const int qb = 31 - 4 * j - ((j & 1) ? 3 - g : g);
            const int type = ((rem >> 6) + j) & 1;
            if (type == 0) attn_item<0>(p, bh >> 3, bh & 7, qb, smem);
            else attn_item<1>(p, bh >> 3, bh & 7, qb, smem);
        } else {
            const int j = idx - 4096; const int qb = 31 - (j >> 6), bh = j & 63;
            attn_item<2>(p, bh >> 3, bh & 7, qb, smem);
        }
    }
}

struct EpiUq {
    static constexpr bool PERM = false, AFTER_DRAIN = false;
    bf16_t* qn; bf16_t* qr; const float* rs; const float* ropetab;
    __device__ __forceinline__ void operator()(const pg8::f32x4 (&acc)[2][2][4][2], const pg8::Unit& u, int wr, int wc, int fr, int fq) const {
        const int row0 = u.pm * 256 + wr * 64 + fr;
#pragma unroll
        for (int ai = 0; ai < 2; ++ai)
#pragma unroll
            for (int m = 0; m < 4; ++m) {
                const int t = row0 + ai * 128 + m * 16;
                const float sc = rs[t] * MLA_QS;
                if (u.pn < 2) {
                    bf16_t* rowp = qn + (size_t)t * 512 + u.pn * 256 + wc * 32 + fq * 4;
#pragma unroll
                    for (int bj = 0; bj < 2; ++bj)
#pragma unroll
                        for (int n = 0; n < 2; ++n) { const pg8::f32x4 v = acc[ai][bj][m][n] * sc; u32x2 pk; pk.x = pack_bf16(v[0], v[1]); pk.y = pack_bf16(v[2], v[3]); *(u32x2*)(rowp + bj * 128 + n * 16) = pk; }
                } else {
                    const pg8::f32x4 ca = *(const pg8::f32x4*)(ropetab + 2 * (t * 16 + fq * 4)), cb = *(const pg8::f32x4*)(ropetab + 2 * (t * 16 + fq * 4) + 4);
                    const float co[4] = {ca[0], ca[2], cb[0], cb[2]}, si[4] = {ca[1], ca[3], cb[1], cb[3]};
#pragma unroll
                    for (int bj = 0; bj < 2; ++bj) {
                        const pg8::f32x4 x1 = acc[ai][bj][m][0] * sc, x2 = acc[ai][bj][m][1] * sc;
                        float o1[4], o2[4];
#pragma unroll
                        for (int j = 0; j < 4; ++j) { o1[j] = x1[j] * co[j] - x2[j] * si[j]; o2[j] = x1[j] * si[j] + x2[j] * co[j]; }
                        u32x2 p1, p2; p1.x = pack_bf16(o1[0], o1[1]); p1.y = pack_bf16(o1[2], o1[3]); p2.x = pack_bf16(o2[0], o2[1]); p2.y = pack_bf16(o2[2], o2[3]);
                        bf16_t* hp = qr + (size_t)t * 256 + (bj * 4 + wc) * 32 + fq * 4;
                        *(u32x2*)hp = p1; *(u32x2*)(hp + 16) = p2;
                    }
                }
            }
    }
};
struct EpiUkvK {
    static constexpr bool PERM = false, AFTER_DRAIN = false;
    bf16_t* kn; const float* rs;
    __device__ __forceinline__ void operator()(const pg8::f32x4 (&acc)[2][2][4][2], const pg8::Unit& u, int wr, int wc, int fr, int fq) const {
        const int row0 = u.pm * 256 + wr * 64 + fr;
#pragma unroll
        for (int ai = 0; ai < 2; ++ai)
#pragma unroll
            for (int m = 0; m < 4; ++m) {
                const int t = row0 + ai * 128 + m * 16;
                const float sc = rs[t];
                bf16_t* rowp = kn + (size_t)t * 512 + u.pn * 256 + wc * 32 + fq * 4;
#pragma unroll
                for (int bj = 0; bj < 2; ++bj)
#pragma unroll
                    for (int n = 0; n < 2; ++n) { const pg8::f32x4 v = acc[ai][bj][m][n] * sc; u32x2 pk; pk.x = pack_bf16(v[0], v[1]); pk.y = pack_bf16(v[2], v[3]); *(u32x2*)(rowp + bj * 128 + n * 16) = pk; }
            }
    }
};
struct EpiUkvV {
    static constexpr bool PERM = false, AFTER_DRAIN = false;
    bf16_t* vtm; const float* rs;
    __device__ __forceinline__ void operator()(const pg8::f32x4 (&acc)[2][2][4][2], const pg8::Unit& u, int wr, int wc, int fr, int fq) const {
        const int row0 = u.pm * 256 + wr * 64 + fq * 4, b = row0 >> 12, s0 = row0 & 4095;
        const int cv0 = u.pn * 256 + wc * 32 + fr;
#pragma unroll
        for (int ai = 0; ai < 2; ++ai)
#pragma unroll
            for (int m = 0; m < 4; ++m) {
                const int sq = s0 + ai * 128 + m * 16;
                const pg8::f32x4 sc4 = *(const pg8::f32x4*)(rs + row0 + ai * 128 + m * 16);
#pragma unroll
                for (int bj = 0; bj < 2; ++bj)
#pragma unroll
                    for (int n = 0; n < 2; ++n) {
                        const int cv = cv0 + bj * 128 + n * 16;
                        const pg8::f32x4 v = acc[ai][bj][m][n] * sc4; u32x2 pk; pk.x = pack_bf16(v[0], v[1]); pk.y = pack_bf16(v[2], v[3]);
                        *(u32x2*)(vtm + (size_t)(b * 8 + (cv >> 6)) * SEQ * 64 + (cv & 63) * 64 + (size_t)(sq >> 6) * 4096 + (sq & 63)) = pk;
                    }
            }
    }
};
DI void phase_mla_gemm(KargPtr p, int l, unsigned char* smem_phys) {
    const bf16_t* WQ = p->wt + (size_t)l * W_LAYER + W_UQ;
    const bf16_t* WKV = p->wt + (size_t)l * W_LAYER + W_UKV;
    { EpiUq E; E.qn = p->qn; E.qr = p->qr; E.rs = p->rsq; E.ropetab = p->ropetab; big_gemm<EpiUq, false>(p->ql, WQ, 768, 384, E, smem_phys); }
    { EpiUkvK E; E.kn = p->kn; E.rs = p->rskv; big_gemm<EpiUkvK, false>(p->kvl, WKV, 512, 256, E, smem_phys); }
    { EpiUkvV E; E.vtm = p->vtm; E.rs = p->rskv; big_gemm<EpiUkvV, true>(p->kvl, WKV + (size_t)512 * 256, 512, 256, E, smem_phys); }
}

struct EpiGate {
    static constexpr bool PERM = false, AFTER_DRAIN = false;
    bf16_t* gs0; bf16_t* gs1;
    __device__ __forceinline__ void operator()(const pg8::f32x4 (&acc)[2][2][4][2], const pg8::Unit& u, int wr, int wc, int fr, int fq) const {
        const int br = u.pn >> 2;
        bf16_t* dst = (br == 0 ? gs0 : gs1 + (size_t)(br - 1) * T_TOK * 1024) + (u.pn & 3) * 256 + wc * 32 + fq * 4;
        const int row0 = u.pm * 256 + wr * 64 + fr;
#pragma unroll
        for (int ai = 0; ai < 2; ++ai)
#pragma unroll
            for (int m = 0; m < 4; ++m) {
                bf16_t* rowp = dst + (size_t)(row0 + ai * 128 + m * 16) * 1024;
#pragma unroll
                for (int bj = 0; bj < 2; ++bj)
#pragma unroll
                    for (int n = 0; n < 2; ++n) { const pg8::f32x4 v = acc[ai][bj][m][n]; u32x2 pk; pk.x = pack_bf16(sigmoidf_(v[0]), sigmoidf_(v[1])); pk.y = pack_bf16(sigmoidf_(v[2]), sigmoidf_(v[3])); *(u32x2*)(rowp + bj * 128 + n * 16) = pk; }
            }
    }
};
DI void phase_gate(KargPtr p, int l, unsigned char* smem_phys) {
    EpiGate E; E.gs0 = p->gs0; E.gs1 = p->gs1;
    big_gemm<EpiGate, false>(p->u, p->wt + (size_t)l * W_LAYER + W_GATE, 3072, 1024, E, smem_phys);
}
DI void phase_merge(KargPtr p, int l, unsigned char* smem) {
    const int tid = tidx(), lane = tid & 63, w = tid >> 6, wm = w >> 1, wn = w & 1, r = lane & 31, hh = lane >> 5;
    const bf16_t* WL = p->wt + (size_t)l * W_LAYER;
    for (int it = 0;; ++it) {
        int mt, nt; if (!next_tile(it, 256, 8, mt, nt)) break;
        const int m0 = mt * 128;
        f32x16 mer[2][2]; zero_acc(mer);
#pragma unroll 1
        for (int br = 0; br < 3; ++br) {
            f32x16 acc[2][2]; zero_acc(acc);
            const bf16_t* Y = (br == 0 ? p->qf : br == 1 ? p->qn : p->qs) + (size_t)m0 * 512;
            const bf16_t* WO = WL + (br == 0 ? W_OF : br == 1 ? W_OM : W_OS) + (size_t)nt * 128 * 512;
            gemm_mainloop<64>(WO, 512, Y, 512, 512, acc, smem);
            const bf16_t* G = (br == 0 ? p->gs0 : p->gs1 + (size_t)(br - 1) * T_TOK * 1024) + (size_t)(m0 + wn * 64 + r) * 1024 + nt * 128 + wm * 64 + 4 * hh;
            u32x2 gv[2][2][4];
#pragma unroll
            for (int a = 0; a < 2; ++a)
#pragma unroll
                for (int c = 0; c < 2; ++c)
#pragma unroll
                    for (int g = 0; g < 4; ++g) gv[a][c][g] = *(const u32x2*)(G + (size_t)c * 32 * 1024 + a * 32 + 8 * g);
#pragma unroll
            for (int a = 0; a < 2; ++a)
#pragma unroll
                for (int c = 0; c < 2; ++c)
#pragma unroll
                    for (int g = 0; g < 4; ++g) {
                        const unsigned x0 = gv[a][c][g].x, x1 = gv[a][c][g].y;
                        mer[a][c][4 * g]     += __uint_as_float(x0 << 16) * acc[a][c][4 * g];
                        mer[a][c][4 * g + 1] += __uint_as_float(x0 & 0xffff0000u) * acc[a][c][4 * g + 1];
                        mer[a][c][4 * g + 2] += __uint_as_float(x1 << 16) * acc[a][c][4 * g + 2];
                        mer[a][c][4 * g + 3] += __uint_as_float(x1 & 0xffff0000u) * acc[a][c][4 * g + 3];
                    }
        }
        stage_store_128(mer, p->merged + (size_t)m0 * 1024 + nt * 128, 1024, smem);
    }
}

DI void phase_outproj(KargPtr p, int l, unsigned char* smem_phys) {
    EpiResidual E; E.xin = (l == 0) ? p->x : p->out; E.xout = p->out; E.modl = p->mod + (size_t)l * 8 * 6144; E.gidx = 2;
    big_gemm(p->merged, p->wt + (size_t)l * W_LAYER + W_OUT, 1024, 1024, E, smem_phys);
}
DI void phase_ffn_up(KargPtr p, int l, unsigned char* smem_phys) {
    EpiFfnUp E; E.h = p->h;
    big_gemm(p->u, p->wt + (size_t)l * W_LAYER + W_FGU, 5632, 1024, E, smem_phys);
}
DI void phase_ffn_down(KargPtr p, int l, unsigned char* smem_phys) {
    EpiResidual E; E.xin = p->out; E.xout = p->out; E.modl = p->mod + (size_t)l * 8 * 6144; E.gidx = 5;
    big_gemm(p->h, p->wt + (size_t)l * W_LAYER + W_FD, 1024, 2816, E, smem_phys);
}

DI void run_phase(int ph, int l, unsigned char* smem_phys) {
#ifdef ONLY_PH
    if (ph != ONLY_PH) return;
#endif
    KargPtr p = karg();
    unsigned char* smem = smem_phys + vhalf() * VSMEM;
    switch (ph) {
    case 0: phase_prep(p, smem); break;
    case 1: phase_norm((l == 0) ? p->x : p->out, p->g_mix + l * 1024, p->mod + (size_t)l * 8 * 6144, 0, 1, p->u); break;
    case 2: phase_inproj(p, l, smem_phys); break;
    case 3: phase_mla_up(p, l, smem); break;
    case 4: phase_attn(p, smem); break;
    case 5: phase_merge(p, l, smem); break;
    case 12: phase_gate(p, l, smem_phys); break;
    case 13: phase_mla_gemm(p, l, smem_phys); break;
    case 6: phase_outproj(p, l, smem_phys); break;
    case 7: phase_norm(p->out, p->g_ffn + l * 1024, p->mod + (size_t)l * 8 * 6144, 3, 4, p->u); break;
    case 8: phase_ffn_up(p, l, smem_phys); break;
    case 9: phase_ffn_down(p, l, smem_phys); break;
    default: phase_final(p); break;
    }
}

#define XB_TMO      128
#define XB_XCNT(j)  (256  + 64 * (j))
#define XB_XSUB(j)  (1280 + 64 * (j))
#define XB_XGEN(j)  (2304 + 64 * (j))
#define XB_TOP      3328
#define XB_TOPGEN   3392
#define XCD_BAR_WORDS 3456
#define XB_SPIN_CAP (1u << 20)
#define LAS __attribute__((address_space(3)))
DI unsigned xb_ld(unsigned* p)              { return __hip_atomic_load(p, __ATOMIC_RELAXED, __HIP_MEMORY_SCOPE_AGENT); }
DI unsigned xb_add(unsigned* p, unsigned v) { return __hip_atomic_fetch_add(p, v, __ATOMIC_RELAXED, __HIP_MEMORY_SCOPE_AGENT); }
DI unsigned xb_xcc_id() { return (unsigned)__builtin_amdgcn_s_getreg((3 << 11) | 20) & 0xFu; }
#define XB_SPIN(cond, bar) do { unsigned _sp = 0; while (cond) { __builtin_amdgcn_s_sleep(1); \
    if ((++_sp & 255u) == 0u) { if (xb_ld(&(bar)[XB_TMO])) break; if (_sp > XB_SPIN_CAP) { atomicAdd(&(bar)[XB_TMO], 1u); break; } } } } while (0)
struct XcdBarrier { unsigned* bar; unsigned x; volatile LAS unsigned* st; };
DI XcdBarrier xcd_barrier_post(unsigned* bar, volatile LAS unsigned* st) {
    XcdBarrier b; b.bar = bar; b.x = xb_xcc_id(); b.st = st;
    if (threadIdx.x == 0) (void)xb_add(&bar[XB_XCNT(b.x)], 1u);
    return b;
}
DI void xcd_barrier_complete(unsigned* bar, unsigned x, unsigned& nloc, unsigned& nx) {
    const unsigned G = gridDim.x * gridDim.y * gridDim.z;
    unsigned sum, cnt, mine, sp = 0u;
    for (;;) {
        sum = 0u; cnt = 0u; mine = 0u;
#pragma unroll
        for (unsigned j = 0; j < 16; ++j) { const unsigned c = xb_ld(&bar[XB_XCNT(j)]); sum += c; cnt += (c > 0u) ? 1u : 0u; mine = (j == x) ? c : mine; }
        if (sum == G) break;
        __builtin_amdgcn_s_sleep(1);
        if ((++sp & 255u) == 0u) { if (xb_ld(&bar[XB_TMO])) break; if (sp > XB_SPIN_CAP) { atomicAdd(&bar[XB_TMO], 1u); break; } }
    }
    nloc = mine > 0u ? mine : 1u; nx = cnt > 0u ? cnt : 1u;
}
DI void xcd_barrier(const XcdBarrier& b) {
    asm volatile("s_waitcnt vmcnt(0)" ::: "memory");
    __syncthreads();
    if (threadIdx.x == 0) {
        unsigned* bar = b.bar;
        __builtin_amdgcn_s_waitcnt(0);
        unsigned nloc = b.st[0], nx = b.st[1];
        if (nloc == 0u) { xcd_barrier_complete(bar, b.x, nloc, nx); b.st[0] = nloc; b.st[1] = nx; }
        const unsigned old = xb_add(&bar[XB_XSUB(b.x)], 1u);
        const unsigned gen = old / nloc;
        if (old + 1u == (gen + 1u) * nloc) {
            __builtin_amdgcn_fence(__ATOMIC_RELEASE, "agent");
            asm volatile("s_waitcnt vmcnt(0)" ::: "memory");
            const unsigned og = xb_add(&bar[XB_TOP], 1u);
            const unsigned tg = og / nx;
            if (og + 1u == (tg + 1u) * nx) xb_add(&bar[XB_TOPGEN], 1u);
            else XB_SPIN(xb_ld(&bar[XB_TOPGEN]) == tg, bar);
            __builtin_amdgcn_fence(__ATOMIC_ACQUIRE, "agent");
            xb_add(&bar[XB_XGEN(b.x)], 1u);
            asm volatile("s_waitcnt vmcnt(0)" ::: "memory");
        } else {
            XB_SPIN(xb_ld(&bar[XB_XGEN(b.x)]) == gen, bar);
            __builtin_amdgcn_fence(__ATOMIC_ACQUIRE, "agent");
            asm volatile("s_waitcnt vmcnt(0)" ::: "memory");
        }
    }
    __syncthreads();
}

#if MEGA
__global__ void __launch_bounds__(512, 2) __attribute__((amdgpu_waves_per_eu(2, 2))) mega_kernel(Params p) {
    extern __shared__ __attribute__((aligned(16))) unsigned char smem[];
    cg::grid_group grid = cg::this_grid();
    volatile LAS unsigned* st = (volatile LAS unsigned*)(smem + SMEM_BYTES - 16);
    if (threadIdx.x == 0) { st[0] = 0u; st[1] = 0u; }
    __syncthreads();
    (void)xcd_barrier_post(karg()->bar, st);
#define xb (XcdBarrier{karg()->bar, xb_xcc_id(), (volatile LAS unsigned*)(smem + SMEM_BYTES - 16)})
    run_phase(0, 0, smem);
    grid.sync();
#pragma unroll 1
    for (int l = 0; l < 2; ++l) {
#pragma unroll 1
        for (int ph = 1; ph <= 9; ++ph) {
            if (ph == 4) { run_phase(13, l, smem); xcd_barrier(xb); }
            if (ph == 5) { run_phase(12, l, smem); xcd_barrier(xb); }
            run_phase(ph, l, smem); xcd_barrier(xb);
#ifdef DBL_PH
            if (ph == DBL_PH) { run_phase(ph, l, smem); xcd_barrier(xb); }
#endif
        }
    }
    run_phase(10, 0, smem);
}
#else
__global__ void __launch_bounds__(512, 2) __attribute__((amdgpu_waves_per_eu(2, 2))) phase_kernel(Params p, int ph, int l) {
    extern __shared__ __attribute__((aligned(16))) unsigned char smem[];
    run_phase(ph, l, smem);
}
#endif

extern "C" void kernel_launch(void* const* d_in, const int* in_sizes, int n_in, void* d_out, int out_size, void* d_ws, size_t ws_size, hipStream_t stream) {
    (void)in_sizes; (void)n_in; (void)out_size;
    Params p{};
    p.x = (const float*)d_in[0]; p.c = (const float*)d_in[1]; p.pos = (const int*)d_in[2];
    p.g_mix = (const float*)d_in[3]; p.w_ada = (const float*)d_in[4]; p.b_ada = (const float*)d_in[5]; p.w_in = (const float*)d_in[6]; p.b_fox_f = (const float*)d_in[7];
    p.g_mla_q = (const float*)d_in[8]; p.w_mla_uq = (const float*)d_in[9]; p.g_mla_kv = (const float*)d_in[10]; p.w_mla_ukv = (const float*)d_in[11];
    p.w_o_fox = (const float*)d_in[12]; p.w_o_mla = (const float*)d_in[13]; p.w_o_sb = (const float*)d_in[14]; p.w_out = (const float*)d_in[15];
    p.g_ffn = (const float*)d_in[16]; p.w_ffn_gate = (const float*)d_in[17]; p.w_ffn_up = (const float*)d_in[18]; p.w_ffn_down = (const float*)d_in[19]; p.g_final = (const float*)d_in[20];
    p.out = (float*)d_out;
    unsigned char* ws = (unsigned char*)d_ws; size_t off = 0;
    auto take = [&](size_t bytes) { unsigned char* q = ws + off; off += (bytes + 255) & ~(size_t)255; return q; };
    p.bar = (unsigned*)take(16384);
    p.kmax = (float*)take(256);
    p.rsq = (float*)take((size_t)T_TOK * 4);
    p.rskv = (float*)take((size_t)T_TOK * 4);
    p.wt = (bf16_t*)take(2 * W_LAYER * 2);
    p.mod = (float*)take(2 * 8 * 6144 * 4);
    p.ropetab = (float*)take((size_t)T_TOK * 16 * 2 * 4);
    p.logf = (float*)take((size_t)64 * SEQ * 4);
    p.cum = (float*)take((size_t)64 * SEQ * 4);
    p.u = (bf16_t*)take((size_t)T_TOK * 1024 * 2);
    p.qf = (bf16_t*)take((size_t)T_TOK * 512 * 2);
    p.kf = (bf16_t*)take((size_t)T_TOK * 512 * 2);
    p.vtf = (bf16_t*)take((size_t)T_TOK * 512 * 2);
    p.qs = (bf16_t*)take((size_t)T_TOK * 512 * 2);
    p.ks = (bf16_t*)take((size_t)T_TOK * 512 * 2);
    p.vts = (bf16_t*)take((size_t)T_TOK * 512 * 2);
    p.qn = (bf16_t*)take((size_t)T_TOK * 512 * 2);
    p.ql = (bf16_t*)take((size_t)T_TOK * 384 * 2);
    p.kvl = (bf16_t*)take((size_t)T_TOK * 256 * 2);
    p.kr = (bf16_t*)take((size_t)T_TOK * 32 * 2);
    p.qr = (bf16_t*)take((size_t)T_TOK * 256 * 2);
    p.kn = (bf16_t*)take((size_t)T_TOK * 512 * 2);
    p.vtm = (bf16_t*)take((size_t)T_TOK * 512 * 2);
    (void)take((size_t)8 << 20);
    p.gs0 = p.ks;
    p.gs1 = p.ql;
    p.gs2 = p.ql + (size_t)T_TOK * 1024;
    p.merged = p.kf;
    p.h = p.qf;
    if (off > ws_size) { fprintf(stderr, "kernel_launch: workspace too small: need %zu, have %zu\n", off, ws_size); return; }

#if MEGA
    static int grid_blocks = 0;
    if (!grid_blocks) {
        int dev = 0, cus = 0, per_cu = 0;
        (void)hipGetDevice(&dev);
        (void)hipDeviceGetAttribute(&cus, hipDeviceAttributeMultiprocessorCount, dev);
        (void)hipFuncSetAttribute((const void*)mega_kernel, hipFuncAttributeMaxDynamicSharedMemorySize, SMEM_BYTES);
        (void)hipOccupancyMaxActiveBlocksPerMultiprocessor(&per_cu, (const void*)mega_kernel, 512, SMEM_BYTES);
        per_cu = 1;
        grid_blocks = cus * per_cu;
        grid_blocks &= ~7;
    }
    (void)hipMemsetAsync(p.bar, 0, 16384, stream);
    void* args[] = {&p};
    hipError_t e = hipLaunchCooperativeKernel((const void*)mega_kernel, dim3(grid_blocks), dim3(512), args, SMEM_BYTES, stream);
    if (e != hipSuccess) fprintf(stderr, "cooperative launch failed: %s (grid %d)\n", hipGetErrorString(e), grid_blocks);
#else
    static bool attr = false;
    if (!attr) { (void)hipFuncSetAttribute((const void*)phase_kernel, hipFuncAttributeMaxDynamicSharedMemorySize, SMEM_BYTES); attr = true; }
    const int G = 512;
    hipLaunchKernelGGL(phase_kernel, dim3(G), dim3(256), SMEM_BYTES, stream, p, 0, 0);
    for (int l = 0; l < 2; ++l)
        for (int ph = 1; ph <= 9; ++ph) hipLaunchKernelGGL(phase_kernel, dim3(G), dim3(256), SMEM_BYTES, stream, p, ph, l);
    hipLaunchKernelGGL(phase_kernel, dim3(G), dim3(256), SMEM_BYTES, stream, p, 10, 0);
#endif
}
```

```cpp
#include <hip/hip_runtime.h>
#include <hip/hip_cooperative_groups.h>
#include <cstdint>
#include <cstdio>
namespace cg = cooperative_groups;

#ifndef MEGA
#define MEGA 1
#endif

typedef unsigned short bf16_t;
typedef short bf16x8 __attribute__((ext_vector_type(8)));
typedef float f32x16 __attribute__((ext_vector_type(16)));
typedef float f32x4 __attribute__((ext_vector_type(4)));
typedef unsigned u32x2 __attribute__((ext_vector_type(2)));
#define DI __device__ __forceinline__
typedef unsigned u32x4 __attribute__((ext_vector_type(4)));
#define GLOAD16(dst, ptr) asm volatile("global_load_dwordx4 %0, %1, off" : "=v"(dst) : "v"(ptr))
#define GLOAD4(dst, ptr)  asm volatile("global_load_dword %0, %1, off" : "=v"(dst) : "v"(ptr))
#define MFMA(a, b, c) __builtin_amdgcn_mfma_f32_32x32x16_bf16((a), (b), (c), 0, 0, 0)

namespace pg8 {
#define PG8_LAS __attribute__((address_space(3)))
typedef unsigned short bf16_t;
typedef short bf16x8 __attribute__((ext_vector_type(8)));
typedef float f32x4 __attribute__((ext_vector_type(4)));
typedef unsigned u32x4 __attribute__((ext_vector_type(4)));
constexpr int BM = 256, BK = 64, HALF = 128, HTB = HALF * BK * 2  , STAGE_BYTES = 8 * HTB, NXCD = 8, WGM = 8;

__host__ __device__ __forceinline__ int lds_byte(int r, int c) { const int st = (r >> 4) * 2 + (c >> 5), rr = r & 15, cc = c & 31, ob = rr * 64 + cc * 2; return st * 1024 + (ob ^ (((ob >> 9) & 1) << 5)); }
__host__ __device__ __forceinline__ void stage_rc(int b, int& R, int& C) { const int st = b / 1024, sb = b % 1024, swz = sb ^ (((sb >> 9) & 1) << 5); R = (st >> 1) * 16 + swz / 64; C = (st & 1) * 32 + (swz % 64) / 2; }
__host__ __device__ __forceinline__ int perm32(int rho) { const int n = rho >> 4, i = rho & 15; return 8 * (i >> 2) + 4 * n + (i & 3); }

struct Unit { int pm, pn; };
struct Gemm { const bf16_t* A; const bf16_t* Bt; int M, N, K; };

struct StaticOrder {
    int nM, nN, nwg, G, c;
    __host__ __device__ void init(int M, int N, int G_, int c_) { nM = M / BM; nN = N / BM; nwg = nM * nN; G = G_; c = c_; }
    __host__ __device__ bool next(int i, Unit& u) const {
        const long L = (long)i * G + c; if (L >= nwg) return false;
        int wgid = (int)L; { const int q = nwg / NXCD, r = nwg % NXCD, xcd = wgid % NXCD, off = wgid / NXCD; wgid = (xcd < r ? xcd * (q + 1) : r * (q + 1) + (xcd - r) * q) + off; }
        const int nig = WGM * nN, gid = wgid / nig, fm = gid * WGM, gsz = (nM - fm) < WGM ? (nM - fm) : WGM;
        u.pm = fm + ((wgid % nig) % gsz); u.pn = (wgid % nig) / gsz; return true;
    }
    __device__ __forceinline__ void a_ready(const Unit&) const {}
    __device__ __forceinline__ void done(const Unit&) const {}
};
template <class Epi, class Sched, bool ALIGN_EPI = false, bool SP2 = false, bool NAT = false>
__device__ __forceinline__ void gemm_phase(PG8_LAS unsigned char* lds, const Gemm g, const Sched& S, const Epi& E) {
    int tid = threadIdx.x; asm volatile("" : "+v"(tid)); const int wid = __builtin_amdgcn_readfirstlane(tid >> 6), lane = tid & 63, wr = wid >> 2, wc = wid & 3, fr = lane & 15, fq = lane >> 4;
    const int K = g.K, nt = K / BK;
    unsigned voffA[2], voffB[2];
#pragma unroll
    for (int i = 0; i < 2; ++i) { int R, C; stage_rc(tid * 16 + i * 8192, R, C); const int Rb = Epi::PERM ? ((R & ~31) + perm32(R & 31)) : R;
        voffA[i] = (unsigned)(R * K + C) * 2u; voffB[i] = (unsigned)(Rb * K + C) * 2u; }
    const size_t kstep = (size_t)(BK * 2);
    const size_t hstep = (size_t)HALF * K * 2;
    const size_t tstep = 2 * hstep;
    const unsigned ldsw = (unsigned)wid * 1024u;
    const int aoff = lds_byte(wr * 64 + fr, fq * 8), boff = lds_byte(wc * 32 + fr, fq * 8);
#define PG8_SA(b, h) (((b) * 2 + (h)) * HTB)
#define PG8_SB(b, h) ((4 + (b) * 2 + (h)) * HTB)
#define PG8_STAGE(bufoff, gbase, voff) do { _Pragma("unroll") for (int _i = 0; _i < 2; ++_i) \
        __builtin_amdgcn_global_load_lds((const unsigned*)((const char*)(gbase) + (voff)[_i]), (PG8_LAS unsigned*)(lds + (bufoff) + ldsw + _i * 8192), 16, 0, 0); } while (0)
#define PG8_LDA(dst, b, h) do { _Pragma("unroll") for (int m = 0; m < 4; ++m) _Pragma("unroll") for (int k = 0; k < 2; ++k) dst[m][k] = *(const PG8_LAS bf16x8*)(lds + PG8_SA(b, h) + aoff + m * 2048 + k * 1024); } while (0)
#define PG8_LDB(dst, b, h) do { _Pragma("unroll") for (int n = 0; n < 2; ++n) _Pragma("unroll") for (int k = 0; k < 2; ++k) dst[n][k] = *(const PG8_LAS bf16x8*)(lds + PG8_SB(b, h) + boff + n * 2048 + k * 1024); } while (0)
#define PG8_MMA(ai, bj, At, Bt) do { __builtin_amdgcn_s_setprio(1); _Pragma("unroll") for (int m = 0; m < 4; ++m) _Pragma("unroll") for (int n = 0; n < 2; ++n) _Pragma("unroll") for (int k = 0; k < 2; ++k) \
        acc[ai][bj][m][n] = NAT ? __builtin_amdgcn_mfma_f32_16x16x32_bf16(At[m][k], Bt[n][k], acc[ai][bj][m][n], 0, 0, 0) : __builtin_amdgcn_mfma_f32_16x16x32_bf16(Bt[n][k], At[m][k], acc[ai][bj][m][n], 0, 0, 0); __builtin_amdgcn_s_setprio(0); } while (0)
#define PG8_WAIT_V(n) asm volatile("s_waitcnt vmcnt(" #n ")" ::: "memory")
#define PG8_WAIT_L(n) asm volatile("s_waitcnt lgkmcnt(" #n ")" ::: "memory")
#define PG8_BAR __builtin_amdgcn_s_barrier()
#define PG8_SCHED __builtin_amdgcn_sched_barrier(0)
    Unit cur, nxt; int ui = 0;
    if (!S.next(0, cur)) return;
    f32x4 acc[2][2][4][2];
#pragma unroll
    for (int a = 0; a < 2; ++a)
#pragma unroll
        for (int b = 0; b < 2; ++b)
#pragma unroll
            for (int m = 0; m < 4; ++m)
#pragma unroll
                for (int n = 0; n < 2; ++n) acc[a][b][m][n] = (f32x4){0.f, 0.f, 0.f, 0.f};
    bf16x8 At[4][2], B0[2][2], B1[2][2];
    const char* cA = (const char*)g.A + (size_t)cur.pm * tstep; const char* cB = (const char*)g.Bt + (size_t)cur.pn * tstep;
    S.a_ready(cur);
    if constexpr (SP2) {
        PG8_STAGE(PG8_SB(0, 0), cB, voffB); PG8_STAGE(PG8_SB(0, 1), cB + hstep, voffB); PG8_STAGE(PG8_SA(0, 0), cA, voffA); PG8_STAGE(PG8_SA(0, 1), cA + hstep, voffA);
        if (wr == 1) PG8_BAR;
        PG8_WAIT_V(2); PG8_BAR;
        PG8_STAGE(PG8_SB(1, 0), cB + kstep, voffB); PG8_STAGE(PG8_SA(1, 0), cA + kstep, voffA); PG8_STAGE(PG8_SB(1, 1), cB + hstep + kstep, voffB);
        PG8_WAIT_V(6); PG8_BAR;
    } else {
        PG8_STAGE(PG8_SB(0, 0), cB, voffB); PG8_STAGE(PG8_SA(0, 0), cA, voffA); PG8_STAGE(PG8_SB(0, 1), cB + hstep, voffB); PG8_STAGE(PG8_SA(0, 1), cA + hstep, voffA);
        if (wr == 1) PG8_BAR;
        PG8_WAIT_V(4); PG8_BAR;
        PG8_STAGE(PG8_SB(1, 0), cB + kstep, voffB); PG8_STAGE(PG8_SA(1, 0), cA + kstep, voffA); PG8_STAGE(PG8_SB(1, 1), cB + hstep + kstep, voffB);
        PG8_WAIT_V(6); PG8_BAR;
    }
    for (;;) {
        const bool has_next = S.next(ui + 1, nxt);
        const char* nA = has_next ? (const char*)g.A + (size_t)nxt.pm * tstep : cA; const char* nB = has_next ? (const char*)g.Bt + (size_t)nxt.pn * tstep : cB;
        for (int t = 0; t < nt; t += 2) {
            const bool last = (t == nt - 2);
            const char* a1 = cA + (size_t)(t + 1) * kstep;
            const char* a2 = last ? nA : cA + (size_t)(t + 2) * kstep; const char* b2 = last ? nB : cB + (size_t)(t + 2) * kstep;
            const char* a3 = a2 + kstep; const char* b3 = b2 + kstep;
            if (last && has_next) S.a_ready(nxt);
            if constexpr (SP2) {
            PG8_LDB(B0, 0, 0); PG8_LDB(B1, 0, 1); PG8_SCHED; PG8_LDA(At, 0, 0); PG8_STAGE(PG8_SA(1, 1), a1 + hstep, voffA);
            PG8_WAIT_V(8); PG8_WAIT_L(0); PG8_BAR; PG8_MMA(0, 0, At, B0); PG8_MMA(0, 1, At, B1); PG8_BAR; PG8_SCHED;
            PG8_LDA(At, 0, 1); PG8_STAGE(PG8_SB(0, 0), b2, voffB); PG8_STAGE(PG8_SB(0, 1), b2 + hstep, voffB); PG8_STAGE(PG8_SA(0, 0), a2, voffA);
            PG8_WAIT_V(8); PG8_WAIT_L(0); PG8_BAR; PG8_MMA(1, 0, At, B0); PG8_MMA(1, 1, At, B1); PG8_BAR; PG8_SCHED;
            PG8_LDB(B0, 1, 0); PG8_LDB(B1, 1, 1); PG8_SCHED; PG8_LDA(At, 1, 0); PG8_STAGE(PG8_SA(0, 1), a2 + hstep, voffA);
            PG8_WAIT_V(8); PG8_WAIT_L(0); PG8_BAR; PG8_MMA(0, 0, At, B0); PG8_MMA(0, 1, At, B1); PG8_BAR; PG8_SCHED;
            PG8_LDA(At, 1, 1); PG8_STAGE(PG8_SB(1, 0), b3, voffB); PG8_STAGE(PG8_SB(1, 1), b3 + hstep, voffB); PG8_STAGE(PG8_SA(1, 0), a3, voffA);
            PG8_WAIT_V(8); PG8_WAIT_L(0); PG8_BAR; PG8_MMA(1, 0, At, B0); PG8_MMA(1, 1, At, B1); PG8_BAR; PG8_SCHED;
            } else {
            PG8_LDB(B0, 0, 0); PG8_SCHED; PG8_LDA(At, 0, 0); PG8_STAGE(PG8_SA(1, 1), a1 + hstep, voffA);
            PG8_WAIT_L(8); PG8_BAR; PG8_WAIT_L(0); PG8_MMA(0, 0, At, B0); PG8_BAR; PG8_SCHED;
            PG8_LDB(B1, 0, 1); PG8_STAGE(PG8_SB(0, 0), b2, voffB);
            PG8_BAR; PG8_WAIT_L(0); PG8_MMA(0, 1, At, B1); PG8_BAR;
            PG8_LDA(At, 0, 1); PG8_STAGE(PG8_SA(0, 0), a2, voffA);
            PG8_BAR; PG8_WAIT_L(0); PG8_MMA(1, 0, At, B0); PG8_BAR; PG8_SCHED;
            PG8_STAGE(PG8_SB(0, 1), b2 + hstep, voffB);
            PG8_WAIT_V(6); PG8_BAR; PG8_MMA(1, 1, At, B1); PG8_BAR;
            PG8_LDB(B0, 1, 0); PG8_SCHED; PG8_LDA(At, 1, 0); PG8_STAGE(PG8_SA(0, 1), a2 + hstep, voffA);
            PG8_WAIT_L(8); PG8_BAR; PG8_WAIT_L(0); PG8_MMA(0, 0, At, B0); PG8_BAR; PG8_SCHED;
            PG8_LDB(B1, 1, 1); PG8_STAGE(PG8_SB(1, 0), b3, voffB);
            PG8_BAR; PG8_WAIT_L(0); PG8_MMA(0, 1, At, B1); PG8_BAR;
            PG8_LDA(At, 1, 1); PG8_STAGE(PG8_SA(1, 0), a3, voffA);
            PG8_BAR; PG8_WAIT_L(0); PG8_MMA(1, 0, At, B0); PG8_BAR; PG8_SCHED;
            PG8_STAGE(PG8_SB(1, 1), b3 + hstep, voffB);
            PG8_WAIT_V(6); PG8_BAR; PG8_MMA(1, 1, At, B1); PG8_BAR;
            }
        }
        if constexpr (ALIGN_EPI) { if (wr == 0) PG8_BAR; }
        if constexpr (!Epi::AFTER_DRAIN) { E(acc, cur, wr, wc, fr, fq); S.done(cur); }
        if (!has_next) break;
#pragma unroll
        for (int a = 0; a < 2; ++a)
#pragma unroll
            for (int b = 0; b < 2; ++b)
#pragma unroll
                for (int m = 0; m < 4; ++m)
#pragma unroll
                    for (int n = 0; n < 2; ++n) acc[a][b][m][n] = (f32x4){0.f, 0.f, 0.f, 0.f};
        cur = nxt; cA = nA; cB = nB; ++ui;
        if constexpr (ALIGN_EPI) { if (wr == 1) PG8_BAR; }
    }
    PG8_WAIT_V(0);
    if constexpr (!ALIGN_EPI) { if (wr == 0) PG8_BAR; }
    PG8_BAR;
    if constexpr (Epi::AFTER_DRAIN) { E.fused(acc, cur, wr, wc, fr, fq, lds, wid, lane); S.done(cur); }
#undef PG8_SA
#undef PG8_SB
#undef PG8_STAGE
#undef PG8_LDA
#undef PG8_LDB
#undef PG8_MMA
#undef PG8_WAIT_V
#undef PG8_WAIT_L
#undef PG8_BAR
#undef PG8_SCHED
}
}

constexpr int T_TOK = 32768;
constexpr int SEQ = 4096;
constexpr float LOG2E = 1.4426950408889634f;
constexpr float FOX_QS = 0.125f * 1.4426950408889634f;
constexpr float MLA_QS = 0.10206207261596575f * 1.4426950408889634f;
constexpr float EPS = 1e-6f;

constexpr size_t W_IN = 0, W_GATE = 4063232, W_UQ = 7208960, W_UKV = 7503872, W_OF = 7766016, W_OM = 8290304, W_OS = 8814592,
                 W_OUT = 9338880, W_FGU = 10387456, W_FD = 16154624, W_LAYER = 19038208;

constexpr int SMEM_BYTES = 2 * 74752 + 64 + 16;

struct Params {
    const float* x; const float* c; const int* pos;
    const float* g_mix; const float* w_ada; const float* b_ada; const float* w_in; const float* b_fox_f;
    const float* g_mla_q; const float* w_mla_uq; const float* g_mla_kv; const float* w_mla_ukv;
    const float* w_o_fox; const float* w_o_mla; const float* w_o_sb; const float* w_out;
    const float* g_ffn; const float* w_ffn_gate; const float* w_ffn_up; const float* w_ffn_down; const float* g_final;
    float* out;
    bf16_t* wt; float* mod; float* ropetab; float* logf; float* cum;
    bf16_t* u; bf16_t* qf; bf16_t* kf; bf16_t* vtf; bf16_t* qs; bf16_t* ks; bf16_t* vts;
    bf16_t* ql; bf16_t* kvl; bf16_t* kr; bf16_t* qn; bf16_t* qr; bf16_t* kn; bf16_t* vtm;
    bf16_t* merged; bf16_t* h;
    unsigned* bar; float* kmax;
    bf16_t* gs0; bf16_t* gs1; bf16_t* gs2;
    float* rsq; float* rskv;
};
typedef const __attribute__((address_space(4))) Params* KargPtr;
#if defined(__HIP_DEVICE_COMPILE__)
__device__ __forceinline__ KargPtr karg() { KargPtr pp = (KargPtr)__builtin_amdgcn_kernarg_segment_ptr(); asm volatile("" : "+s"(pp)); return pp; }
#else
__device__ __forceinline__ KargPtr karg() { return nullptr; }
#endif

__device__ double ROPE_POLY[11] = {-1.0 / 6, 1.0 / 120, -1.0 / 5040, 1.0 / 362880, -1.0 / 39916800,
    -0.5, 1.0 / 24, -1.0 / 720, 1.0 / 40320, -1.0 / 3628800, 1.0 / 479001600};
__device__ const float ROPE_INV[16] = {1.0f, 0.5623413324356079f, 0.3162277638912201f, 0.17782793939113617f, 0.10000000149011612f, 0.05623413249850273f,
    0.03162277489900589f, 0.017782794311642647f, 0.009999999776482582f, 0.005623413249850273f, 0.003162277629598975f, 0.0017782794311642647f,
    0.0010000000474974513f, 0.000562341301701963f, 0.0003162277571391314f, 0.00017782794020604342f};

typedef __bf16 bf16x2_t __attribute__((ext_vector_type(2)));
typedef float f32x2_t __attribute__((ext_vector_type(2)));
DI unsigned pack_bf16(float lo, float hi) { const f32x2_t v = {lo, hi}; const bf16x2_t b = __builtin_convertvector(v, bf16x2_t); return __builtin_bit_cast(unsigned, b); }
DI bf16_t f2bf(float x) { return (bf16_t)(pack_bf16(x, 0.f) & 0xffffu); }
DI int vhalf() { return __builtin_amdgcn_readfirstlane((int)(threadIdx.x >> 8)); }
DI int tidx() { int t = threadIdx.x & 255; asm volatile("" : "+v"(t)); return t; }
DI int bidx() { int t = __builtin_amdgcn_readfirstlane((int)(blockIdx.x * 2 + (threadIdx.x >> 8))); asm volatile("" : "+s"(t)); return t; }
DI int gdim() { int t = gridDim.x * 2; asm volatile("" : "+s"(t)); return t; }
constexpr int VSMEM = 74752;
constexpr int FLAGS_OFF = 2 * VSMEM;
DI float fexp2(float x) { return __builtin_amdgcn_exp2f(x); }
DI float flog2(float x) { return __builtin_amdgcn_logf(x); }
DI float frcp(float x) { return __builtin_amdgcn_rcpf(x); }
DI float sigmoidf_(float x) { return frcp(1.0f + fexp2(-x * LOG2E)); }

DI bool next_tile(int it, int MT, int NT, int& mt, int& nt) {
    const int perx = gdim() >> 3, xcd = bidx() & 7, slot = bidx() >> 3;
    const long L = ((long)it * 8 + xcd) * perx + slot;
    if (L >= (long)MT * NT) return false;
    const int gsz = 8 * NT; const int grp = (int)(L / gsz), wi = (int)(L % gsz);
    mt = grp * 8 + (wi & 7); nt = wi >> 3; return true;
}

template <int BK>
DI void gemm_mainloop(const bf16_t* A, int lda, const bf16_t* B, int ldb, int K, f32x16 (&acc)[2][2], unsigned char* smem) {
    constexpr int CPR = BK / 8;
    constexpr int RPP = 256 / CPR;
    constexpr int NJ = 128 / RPP;
    constexpr int ROWB = BK * 2 + 16;
    constexpr int OPB = 128 * ROWB;
    constexpr int STB = 2 * OPB;
    constexpr int PASSB = RPP * ROWB;
    const int tid = tidx(), lane = tid & 63, w = tid >> 6, wm = w >> 1, wn = w & 1, r = lane & 31, hh = lane >> 5;
    const int lrow = tid / CPR, lcol = (tid % CPR) * 8;
    const bf16_t* ap = A + (size_t)lrow * lda + lcol;
    const bf16_t* bp = B + (size_t)lrow * ldb + lcol;
    const size_t astep = (size_t)RPP * lda, bstep = (size_t)RPP * ldb;
    const int st_off = lrow * ROWB + (tid % CPR) * 16;
    u32x4 ra0, ra1, ra2, ra3, rb0, rb1, rb2, rb3;
    ra0 = *(const u32x4*)(ap); rb0 = *(const u32x4*)(bp);
    ra1 = *(const u32x4*)(ap + astep); rb1 = *(const u32x4*)(bp + bstep);
    if constexpr (NJ == 4) { ra2 = *(const u32x4*)(ap + 2 * astep); rb2 = *(const u32x4*)(bp + 2 * bstep); ra3 = *(const u32x4*)(ap + 3 * astep); rb3 = *(const u32x4*)(bp + 3 * bstep); }
    else { ra2 = ra0; ra3 = ra0; rb2 = rb0; rb3 = rb0; }
#define GEMM_STAGE(D_) do { unsigned char* d_ = (D_); \
        *(u32x4*)(d_) = ra0; *(u32x4*)(d_ + OPB) = rb0; *(u32x4*)(d_ + PASSB) = ra1; *(u32x4*)(d_ + OPB + PASSB) = rb1; \
        if constexpr (NJ == 4) { *(u32x4*)(d_ + 2 * PASSB) = ra2; *(u32x4*)(d_ + OPB + 2 * PASSB) = rb2; *(u32x4*)(d_ + 3 * PASSB) = ra3; *(u32x4*)(d_ + OPB + 3 * PASSB) = rb3; } } while (0)
    GEMM_STAGE(smem + st_off);
    __syncthreads();
    const int nk = K / BK;
    const int rdA = (wm * 64 + r) * ROWB + hh * 16;
    const int rdB = OPB + (wn * 64 + r) * ROWB + hh * 16;
#define GEMM_FRAGS(KS_, A0_, A1_, B0_, B1_) do { \
        A0_ = *(const bf16x8*)(sa + (KS_) * 32); A1_ = *(const bf16x8*)(sa + 32 * ROWB + (KS_) * 32); \
        B0_ = *(const bf16x8*)(sb + (KS_) * 32); B1_ = *(const bf16x8*)(sb + 32 * ROWB + (KS_) * 32); } while (0)
#define GEMM_MFMA4(A0_, A1_, B0_, B1_) do { \
        acc[0][0] = MFMA(A0_, B0_, acc[0][0]); acc[0][1] = MFMA(A0_, B1_, acc[0][1]); \
        acc[1][0] = MFMA(A1_, B0_, acc[1][0]); acc[1][1] = MFMA(A1_, B1_, acc[1][1]); } while (0)
#define GEMM_COMPUTE(BUF_) do { \
        const unsigned char* sa = smem + (BUF_) * STB + rdA; \
        const unsigned char* sb = smem + (BUF_) * STB + rdB; \
        bf16x8 fa0, fa1, fb0, fb1, ga0, ga1, gb0, gb1; \
        GEMM_FRAGS(0, fa0, fa1, fb0, fb1); \
        GEMM_FRAGS(1, ga0, ga1, gb0, gb1); \
        __builtin_amdgcn_sched_barrier(0); \
        GEMM_MFMA4(fa0, fa1, fb0, fb1); \
        if constexpr (BK == 64) { \
            __builtin_amdgcn_sched_barrier(0); \
            GEMM_FRAGS(2, fa0, fa1, fb0, fb1); \
            __builtin_amdgcn_sched_barrier(0); \
            GEMM_MFMA4(ga0, ga1, gb0, gb1); \
            __builtin_amdgcn_sched_barrier(0); \
            GEMM_FRAGS(3, ga0, ga1, gb0, gb1); \
            __builtin_amdgcn_sched_barrier(0); \
            GEMM_MFMA4(fa0, fa1, fb0, fb1); \
        } \
        __builtin_amdgcn_sched_barrier(0); \
        GEMM_MFMA4(ga0, ga1, gb0, gb1); \
    } while (0)
    for (int kt = 0; kt < nk - 1; ++kt) {
        const int buf = kt & 1;
        ap += BK; bp += BK;
        GLOAD16(ra0, ap); GLOAD16(rb0, bp); GLOAD16(ra1, ap + astep); GLOAD16(rb1, bp + bstep);
        if constexpr (NJ == 4) { GLOAD16(ra2, ap + 2 * astep); GLOAD16(rb2, bp + 2 * bstep); GLOAD16(ra3, ap + 3 * astep); GLOAD16(rb3, bp + 3 * bstep); }
        __builtin_amdgcn_sched_barrier(0);
        GEMM_COMPUTE(buf);
        __builtin_amdgcn_sched_barrier(0);
        if constexpr (NJ == 4) asm volatile("s_waitcnt vmcnt(0)" : "+v"(ra0), "+v"(rb0), "+v"(ra1), "+v"(rb1), "+v"(ra2), "+v"(rb2), "+v"(ra3), "+v"(rb3));
        else asm volatile("s_waitcnt vmcnt(0)" : "+v"(ra0), "+v"(rb0), "+v"(ra1), "+v"(rb1));
        GEMM_STAGE(smem + (buf ^ 1) * STB + st_off);
        __syncthreads();
    }
    GEMM_COMPUTE((nk - 1) & 1);
    __syncthreads();
#undef GEMM_COMPUTE
#undef GEMM_MFMA4
#undef GEMM_FRAGS
#undef GEMM_STAGE
}


DI void gemm_big(const bf16_t* P, int ldp, const bf16_t* Q, int ldq, int K, f32x16 (&acc)[2][4], unsigned char* smem) {
    constexpr int ROWB = 80, PB = 128 * ROWB, STB = 384 * ROWB, PASSB = 64 * ROWB;
    const int tid = tidx(), lane = tid & 63, w = tid >> 6, wm = w >> 1, wn = w & 1, r = lane & 31, hh = lane >> 5;
    const int lrow = tid >> 2, lcol = (tid & 3) * 8;
    const bf16_t* pp = P + (size_t)lrow * ldp + lcol;
    const bf16_t* qp = Q + (size_t)lrow * ldq + lcol;
    const size_t pstep = (size_t)64 * ldp, qstep = (size_t)64 * ldq;
    const int st_off = lrow * ROWB + (tid & 3) * 16;
    u32x4 rp0, rp1, rq0, rq1, rq2, rq3;
    rp0 = *(const u32x4*)(pp); rp1 = *(const u32x4*)(pp + pstep);
    rq0 = *(const u32x4*)(qp); rq1 = *(const u32x4*)(qp + qstep); rq2 = *(const u32x4*)(qp + 2 * qstep); rq3 = *(const u32x4*)(qp + 3 * qstep);
#define BIG_STAGE(D_) do { unsigned char* d_ = (D_); \
        *(u32x4*)(d_) = rp0; *(u32x4*)(d_ + PASSB) = rp1; \
        *(u32x4*)(d_ + PB) = rq0; *(u32x4*)(d_ + PB + PASSB) = rq1; *(u32x4*)(d_ + PB + 2 * PASSB) = rq2; *(u32x4*)(d_ + PB + 3 * PASSB) = rq3; } while (0)
    BIG_STAGE(smem + st_off);
    __syncthreads();
    const int nk = K >> 5;
    const int rdP = (wm * 64 + r) * ROWB + hh * 16;
    const int rdQ = PB + (wn * 128 + r) * ROWB + hh * 16;
#define BIG_FRAGS(KS_, A0_, A1_, B0_, B1_, B2_, B3_) do { \
        A0_ = *(const bf16x8*)(sp + (KS_) * 32); A1_ = *(const bf16x8*)(sp + 32 * ROWB + (KS_) * 32); \
        B0_ = *(const bf16x8*)(sq + (KS_) * 32); B1_ = *(const bf16x8*)(sq + 32 * ROWB + (KS_) * 32); \
        B2_ = *(const bf16x8*)(sq + 64 * ROWB + (KS_) * 32); B3_ = *(const bf16x8*)(sq + 96 * ROWB + (KS_) * 32); } while (0)
#define BIG_MFMA8(A0_, A1_, B0_, B1_, B2_, B3_) do { \
        acc[0][0] = MFMA(A0_, B0_, acc[0][0]); acc[0][1] = MFMA(A0_, B1_, acc[0][1]); acc[0][2] = MFMA(A0_, B2_, acc[0][2]); acc[0][3] = MFMA(A0_, B3_, acc[0][3]); \
        acc[1][0] = MFMA(A1_, B0_, acc[1][0]); acc[1][1] = MFMA(A1_, B1_, acc[1][1]); acc[1][2] = MFMA(A1_, B2_, acc[1][2]); acc[1][3] = MFMA(A1_, B3_, acc[1][3]); } while (0)
#define BIG_COMPUTE(BUF_) do { \
        const unsigned char* sp = smem + (BUF_) * STB + rdP; \
        const unsigned char* sq = smem + (BUF_) * STB + rdQ; \
        bf16x8 fa0, fa1, fb0, fb1, fb2, fb3, ga0, ga1, gb0, gb1, gb2, gb3; \
        BIG_FRAGS(0, fa0, fa1, fb0, fb1, fb2, fb3); \
        BIG_FRAGS(1, ga0, ga1, gb0, gb1, gb2, gb3); \
        __builtin_amdgcn_sched_barrier(0); \
        BIG_MFMA8(fa0, fa1, fb0, fb1, fb2, fb3); \
        __builtin_amdgcn_sched_barrier(0); \
        BIG_MFMA8(ga0, ga1, gb0, gb1, gb2, gb3); \
    } while (0)
    for (int kt = 0; kt < nk - 1; ++kt) {
        const int buf = kt & 1;
        pp += 32; qp += 32;
        GLOAD16(rp0, pp); GLOAD16(rq0, qp); GLOAD16(rp1, pp + pstep); GLOAD16(rq1, qp + qstep); GLOAD16(rq2, qp + 2 * qstep); GLOAD16(rq3, qp + 3 * qstep);
        __builtin_amdgcn_sched_barrier(0);
        BIG_COMPUTE(buf);
        __builtin_amdgcn_sched_barrier(0);
        asm volatile("s_waitcnt vmcnt(0)" : "+v"(rp0), "+v"(rp1), "+v"(rq0), "+v"(rq1), "+v"(rq2), "+v"(rq3));
        BIG_STAGE(smem + (buf ^ 1) * STB + st_off);
        __syncthreads();
    }
    BIG_COMPUTE((nk - 1) & 1);
    __syncthreads();
#undef BIG_COMPUTE
#undef BIG_MFMA8
#undef BIG_FRAGS
#undef BIG_STAGE
}
DI void zero_big(f32x16 (&acc)[2][4]) {
#pragma unroll
    for (int a = 0; a < 2; ++a)
#pragma unroll
        for (int b = 0; b < 4; ++b)
#pragma unroll
            for (int i = 0; i < 16; ++i) acc[a][b][i] = 0.f;
}
DI void stage_store_big(const f32x16 (&acc)[2][4], bf16_t* dst, int ld, unsigned char* smem) {
    const int tid = tidx(), lane = tid & 63, w = tid >> 6, wm = w >> 1, wn = w & 1, r = lane & 31, hh = lane >> 5;
#pragma unroll
    for (int qi = 0; qi < 4; ++qi) {
        unsigned char* trow = smem + (wn * 128 + qi * 32 + r) * 272 + (wm * 64 + 4 * hh) * 2;
#pragma unroll
        for (int pi = 0; pi < 2; ++pi)
#pragma unroll
            for (int g = 0; g < 4; ++g) {
                u32x2 pk; pk.x = pack_bf16(acc[pi][qi][4 * g], acc[pi][qi][4 * g + 1]); pk.y = pack_bf16(acc[pi][qi][4 * g + 2], acc[pi][qi][4 * g + 3]);
                *(u32x2*)(trow + (pi * 32 + 8 * g) * 2) = pk;
            }
    }
    __syncthreads();
    const int q0 = tid >> 4, x = tid & 15;
#pragma unroll
    for (int j = 0; j < 16; ++j) {
        const uint4 v = *(const uint4*)(smem + (q0 + 16 * j) * 272 + x * 16);
        *(uint4*)(dst + (size_t)(q0 + 16 * j) * ld + x * 8) = v;
    }
    __syncthreads();
}
DI void scale_big(f32x16 (&acc)[2][4], float sc) {
#pragma unroll
    for (int a = 0; a < 2; ++a)
#pragma unroll
        for (int b = 0; b < 4; ++b)
#pragma unroll
            for (int i = 0; i < 16; ++i) acc[a][b][i] *= sc;
}
DI void scale_big_q(f32x16 (&acc)[2][4], const float* rs, float sc) {
    const int lane = tidx() & 63, wn = (tidx() >> 6) & 1, r = lane & 31;
#pragma unroll
    for (int qi = 0; qi < 4; ++qi) { const float f = rs[wn * 128 + qi * 32 + r] * sc;
#pragma unroll
        for (int pi = 0; pi < 2; ++pi)
#pragma unroll
            for (int i = 0; i < 16; ++i) acc[pi][qi][i] *= f; }
}
DI void scale_big_p(f32x16 (&acc)[2][4], const float* rs) {
    const int lane = tidx() & 63, wm = tidx() >> 7, hh = lane >> 5;
#pragma unroll
    for (int pi = 0; pi < 2; ++pi)
#pragma unroll
        for (int g = 0; g < 4; ++g) { const f32x4 f = *(const f32x4*)(rs + wm * 64 + pi * 32 + 8 * g + 4 * hh);
#pragma unroll
            for (int qi = 0; qi < 4; ++qi)
#pragma unroll
                for (int e = 0; e < 4; ++e) acc[pi][qi][4 * g + e] *= f[e]; }
}
DI long tile_linear(int it, long total) {
    const int perx = gdim() >> 3, xcd = bidx() & 7, slot = bidx() >> 3;
    const long L = ((long)it * 8 + xcd) * perx + slot;
    return L < total ? L : -1;
}
DI void tile_decode(int L, int NT, int& mt, int& nt) { const int gsz = 8 * NT; const int grp = L / gsz, wi = L % gsz; mt = grp * 8 + (wi & 7); nt = wi >> 3; }

DI void zero_acc(f32x16 (&acc)[2][2]) {
#pragma unroll
    for (int a = 0; a < 2; ++a)
#pragma unroll
        for (int b = 0; b < 2; ++b)
#pragma unroll
            for (int i = 0; i < 16; ++i) acc[a][b][i] = 0.f;
}

DI void stage_store_128(const f32x16 (&acc)[2][2], bf16_t* dst, int ld, unsigned char* smem) {
    const int tid = tidx(), lane = tid & 63, w = tid >> 6, wm = w >> 1, wn = w & 1, r = lane & 31, hh = lane >> 5;
#pragma unroll
    for (int qi = 0; qi < 2; ++qi) {
        unsigned char* trow = smem + (wn * 64 + qi * 32 + r) * 272 + (wm * 64 + 4 * hh) * 2;
#pragma unroll
        for (int pi = 0; pi < 2; ++pi)
#pragma unroll
            for (int g = 0; g < 4; ++g) {
                u32x2 pk; pk.x = pack_bf16(acc[pi][qi][4 * g], acc[pi][qi][4 * g + 1]); pk.y = pack_bf16(acc[pi][qi][4 * g + 2], acc[pi][qi][4 * g + 3]);
                *(u32x2*)(trow + (pi * 32 + 8 * g) * 2) = pk;
            }
    }
    __syncthreads();
    const int q0 = tid >> 4, x = tid & 15;
#pragma unroll
    for (int j = 0; j < 8; ++j) {
        const uint4 v = *(const uint4*)(smem + (q0 + 16 * j) * 272 + x * 16);
        *(uint4*)(dst + (size_t)(q0 + 16 * j) * ld + x * 8) = v;
    }
    __syncthreads();
}
DI void stage_store_vt(const f32x16 (&acc)[2][2], bf16_t* vt, int b, int cv0, int s0, unsigned char* smem) {
    const int tid = tidx(), lane = tid & 63, w = tid >> 6, wm = w >> 1, wn = w & 1, r = lane & 31, hh = lane >> 5;
#pragma unroll
    for (int qi = 0; qi < 2; ++qi) {
        unsigned char* trow = smem + (wn * 64 + qi * 32 + r) * 272 + (wm * 64 + 4 * hh) * 2;
#pragma unroll
        for (int pi = 0; pi < 2; ++pi)
#pragma unroll
            for (int g = 0; g < 4; ++g) {
                u32x2 pk; pk.x = pack_bf16(acc[pi][qi][4 * g], acc[pi][qi][4 * g + 1]); pk.y = pack_bf16(acc[pi][qi][4 * g + 2], acc[pi][qi][4 * g + 3]);
                *(u32x2*)(trow + (pi * 32 + 8 * g) * 2) = pk;
            }
    }
    __syncthreads();
    const int q0 = tid >> 4, x = tid & 15;
#pragma unroll
    for (int j = 0; j < 8; ++j) {
        const int cv = cv0 + q0 + 16 * j, sq = s0 + 8 * x;
        const uint4 v = *(const uint4*)(smem + (q0 + 16 * j) * 272 + x * 16);
        *(uint4*)(vt + (size_t)(b * 8 + (cv >> 6)) * SEQ * 64 + (size_t)(sq >> 6) * 4096 + (cv & 63) * 64 + (sq & 63)) = v;
    }
    __syncthreads();
}
DI void scale_acc(f32x16 (&acc)[2][2], float sc) {
#pragma unroll
    for (int a = 0; a < 2; ++a)
#pragma unroll
        for (int b = 0; b < 2; ++b)
#pragma unroll
            for (int i = 0; i < 16; ++i) acc[a][b][i] *= sc;
}
DI void scale_acc_q(f32x16 (&acc)[2][2], const float* rs, float sc) {
    const int lane = tidx() & 63, wn = (tidx() >> 6) & 1, r = lane & 31;
#pragma unroll
    for (int qi = 0; qi < 2; ++qi) { const float f = rs[wn * 64 + qi * 32 + r] * sc;
#pragma unroll
        for (int pi = 0; pi < 2; ++pi)
#pragma unroll
            for (int i = 0; i < 16; ++i) acc[pi][qi][i] *= f; }
}
DI void scale_acc_p(f32x16 (&acc)[2][2], const float* rs) {
    const int lane = tidx() & 63, wm = tidx() >> 7, hh = lane >> 5;
#pragma unroll
    for (int pi = 0; pi < 2; ++pi)
#pragma unroll
        for (int g = 0; g < 4; ++g) { const f32x4 f = *(const f32x4*)(rs + wm * 64 + pi * 32 + 8 * g + 4 * hh);
#pragma unroll
            for (int qi = 0; qi < 2; ++qi)
#pragma unroll
                for (int e = 0; e < 4; ++e) acc[pi][qi][4 * g + e] *= f[e]; }
}

DI int map_col(int map, int n) {
    switch (map) {
    case 1:
        if (n < 1024) return n;
        if (n < 2048) return 2216 + (n - 1024);
        if (n < 2432) return 1544 + (n - 2048);
        if (n < 2688) return 1928 + (n - 2432);
        if (n < 2816) { const int c = n - 2688; if (c < 16) return 2184 + c; if (c < 32) return 2200 + (c - 16); if (c < 40) return 1536 + (c - 32); return -1; }
        if (n < 3328) return 1024 + (n - 2816);
        if (n < 3840) return 3240 + (n - 3328);
        return -1;
    case 2: return 3752 + n;
    case 3:
        if (n < 512) return (n >> 6) * 96 + (n & 63);
        { const int n2 = n - 512; return (n2 >> 5) * 96 + 64 + (n2 & 31); }
    case 4:
        if (n < 512) return (n >> 6) * 128 + (n & 63);
        { const int n2 = n - 512; return (n2 >> 6) * 128 + 64 + (n2 & 63); }
    case 5: return (n >> 5) * 16 + (n & 15);
    default: return n;
    }
}

DI void transpose_tile(const float* __restrict__ src, const float* __restrict__ src2, int ld, int K, bf16_t* __restrict__ dst, int map, const float* __restrict__ kscale, int n0, int k0, float* tile) {
    const int tid = tidx(), tx = tid & 63, ty = tid >> 6;
    const int sc = map_col(map, n0 + tx);
    if (map == 5 && (((n0 + tx) >> 4) & 1)) src = src2;
    const int scc = sc < 0 ? 0 : sc;
    const float* sp = src + (size_t)(k0 + ty) * ld + scc;
    float vals[16];
#pragma unroll
    for (int j = 0; j < 16; ++j) vals[j] = sp[(size_t)(4 * j) * ld];
    if (kscale) {
#pragma unroll
        for (int j = 0; j < 16; ++j) vals[j] *= kscale[k0 + ty + 4 * j];
    }
#pragma unroll
    for (int j = 0; j < 16; ++j) tile[(ty + 4 * j) * 65 + tx] = sc < 0 ? 0.f : vals[j];
    __syncthreads();
    const int n = tid >> 2, kq = (tid & 3) * 16;
    unsigned wv[8];
#pragma unroll
    for (int j = 0; j < 8; ++j) wv[j] = pack_bf16(tile[(kq + 2 * j) * 65 + n], tile[(kq + 2 * j + 1) * 65 + n]);
    uint4* d = (uint4*)(dst + (size_t)(n0 + n) * K + k0 + kq);
    d[0] = make_uint4(wv[0], wv[1], wv[2], wv[3]);
    d[1] = make_uint4(wv[4], wv[5], wv[6], wv[7]);
    __syncthreads();
}

DI void phase_prep(KargPtr p, unsigned char* smem) {
    const int tid = tidx();
    float* fs = (float*)smem;
    constexpr int NW = 9296, NMOD = 192, NROPE = 2048;
    for (int item = bidx(); item < NW + NMOD + NROPE; item += gdim()) {
        if (item < NW) {
            const int l = item / 4648; int ti = item % 4648;
            const float* src; const float* src2 = nullptr; int ld, K, Nd, map; size_t doff; const float* ksc = nullptr;
            if (ti < 992)       { src = p->w_in + (size_t)l * 1024 * 6824; ld = 6824; K = 1024; Nd = 3968; doff = W_IN; map = 1; }
            else if (ti < 1760) { ti -= 992;  src = p->w_in + (size_t)l * 1024 * 6824; ld = 6824; K = 1024; Nd = 3072; doff = W_GATE; map = 2; }
            else if (ti < 1832) { ti -= 1760; src = p->w_mla_uq + (size_t)l * 384 * 768; ld = 768; K = 384; Nd = 768; doff = W_UQ; map = 3; ksc = p->g_mla_q + l * 384; }
            else if (ti < 1896) { ti -= 1832; src = p->w_mla_ukv + (size_t)l * 256 * 1024; ld = 1024; K = 256; Nd = 1024; doff = W_UKV; map = 4; ksc = p->g_mla_kv + l * 256; }
            else if (ti < 2024) { ti -= 1896; src = p->w_o_fox + (size_t)l * 512 * 1024; ld = 1024; K = 512; Nd = 1024; doff = W_OF; map = 0; }
            else if (ti < 2152) { ti -= 2024; src = p->w_o_mla + (size_t)l * 512 * 1024; ld = 1024; K = 512; Nd = 1024; doff = W_OM; map = 0; }
            else if (ti < 2280) { ti -= 2152; src = p->w_o_sb + (size_t)l * 512 * 1024; ld = 1024; K = 512; Nd = 1024; doff = W_OS; map = 0; }
            else if (ti < 2536) { ti -= 2280; src = p->w_out + (size_t)l * 1024 * 1024; ld = 1024; K = 1024; Nd = 1024; doff = W_OUT; map = 0; }
            else if (ti < 3944) { ti -= 2536; src = p->w_ffn_gate + (size_t)l * 1024 * 2816; src2 = p->w_ffn_up + (size_t)l * 1024 * 2816; ld = 2816; K = 1024; Nd = 5632; doff = W_FGU; map = 5; }
            else                { ti -= 3944; src = p->w_ffn_down + (size_t)l * 2816 * 1024; ld = 1024; K = 2816; Nd = 1024; doff = W_FD; map = 0; }
            (void)Nd;
            const int kts = K >> 6; const int ntile = ti / kts, ktile = ti % kts;
            transpose_tile(src, src2, ld, K, p->wt + (size_t)l * W_LAYER + doff, map, ksc, ntile * 64, ktile * 64, fs);
        } else if (item < NW + NMOD) {
            const int mi = item - NW; const int l = mi / 96, c0 = (mi % 96) * 64;
            float* cond = fs;
            float* red = fs + 8192;
            for (int e = tid; e < 8192; e += 256) { const float cv = p->c[e]; cond[e] = cv * sigmoidf_(cv); }
            __syncthreads();
            const int tx = tid & 63, ty = tid >> 6;
            float a0 = 0, a1 = 0, a2 = 0, a3 = 0, a4 = 0, a5 = 0, a6 = 0, a7 = 0;
            const float* wsrc = p->w_ada + (size_t)l * 1024 * 6144 + c0 + tx;
#pragma unroll 8
            for (int k = ty * 256; k < ty * 256 + 256; ++k) {
                const float wv = wsrc[(size_t)k * 6144];
                a0 += cond[k] * wv; a1 += cond[1024 + k] * wv; a2 += cond[2048 + k] * wv; a3 += cond[3072 + k] * wv;
                a4 += cond[4096 + k] * wv; a5 += cond[5120 + k] * wv; a6 += cond[6144 + k] * wv; a7 += cond[7168 + k] * wv;
            }
            float* rr = red + ty * 512 + tx;
            rr[0] = a0; rr[64] = a1; rr[128] = a2; rr[192] = a3; rr[256] = a4; rr[320] = a5; rr[384] = a6; rr[448] = a7;
            __syncthreads();
            for (int o = tid; o < 512; o += 256) {
                const int b = o >> 6, xx = o & 63;
                const float s = red[o] + red[512 + o] + red[1024 + o] + red[1536 + o] + p->b_ada[l * 6144 + c0 + xx];
                p->mod[(size_t)(l * 8 + b) * 6144 + c0 + xx] = s;
            }
            __syncthreads();
        } else {
            const int e = (item - NW - NMOD) * 256 + tid;
            const int i = e & 15, tok = e >> 4;
            const float ang = (float)p->pos[tok] * ROPE_INV[i];
            const double a = (double)ang;
            const double kq = rint(a * 0.63661977236758134308);
            const double rr = fma(-kq, 1.57079632679489661923, a);
            const double r2 = rr * rr;
            const double* C = ROPE_POLY;
            const double sn = rr * (1.0 + r2 * (C[0] + r2 * (C[1] + r2 * (C[2] + r2 * (C[3] + r2 * C[4])))));
            const double cs = 1.0 + r2 * (C[5] + r2 * (C[6] + r2 * (C[7] + r2 * (C[8] + r2 * (C[9] + r2 * C[10])))));
            const int q = ((int)(long long)kq) & 3;
            const double co = (q == 0) ? cs : (q == 1) ? -sn : (q == 2) ? -cs : sn;
            const double si = (q == 0) ? sn : (q == 1) ? cs : (q == 2) ? -sn : -cs;
            p->ropetab[2 * (size_t)e] = (float)co; p->ropetab[2 * (size_t)e + 1] = (float)si;
        }
    }
}

DI float wave_sum(float v) {
#pragma unroll
    for (int o = 32; o >= 1; o >>= 1) v += __shfl_xor(v, o);
    return v;
}
DI void phase_norm(const float* __restrict__ xin, const float* __restrict__ g, const float* __restrict__ modl, int sh_idx, int sc_idx, bf16_t* __restrict__ uout) {
    const int lane = tidx() & 63, w = tidx() >> 6;
    for (int row = bidx() * 4 + w; row < T_TOK; row += gdim() * 4) {
        const int b = row >> 12;
        const f32x4* xr = (const f32x4*)(xin + (size_t)row * 1024);
        f32x4 v[4]; float ss = 0.f;
#pragma unroll
        for (int j = 0; j < 4; ++j) { v[j] = xr[lane + 64 * j]; ss += v[j][0] * v[j][0] + v[j][1] * v[j][1] + v[j][2] * v[j][2] + v[j][3] * v[j][3]; }
        ss = wave_sum(ss);
        const float rstd = rsqrtf(ss * (1.0f / 1024.0f) + EPS);
        const float* mb = modl + (size_t)b * 6144;
#pragma unroll
        for (int j = 0; j < 4; ++j) {
            const int col = 4 * (lane + 64 * j);
            const f32x4 g4 = *(const f32x4*)(g + col), sc4 = *(const f32x4*)(mb + sc_idx * 1024 + col), sh4 = *(const f32x4*)(mb + sh_idx * 1024 + col);
            float y[4];
#pragma unroll
            for (int e = 0; e < 4; ++e) y[e] = (v[j][e] * rstd) * g4[e] * (1.0f + sc4[e]) + sh4[e];
            u32x2 pk; pk.x = pack_bf16(y[0], y[1]); pk.y = pack_bf16(y[2], y[3]);
            *(u32x2*)(uout + (size_t)row * 1024 + col) = pk;
        }
    }
}
DI void phase_final(KargPtr p) {
    const int lane = tidx() & 63, w = tidx() >> 6;
    for (int row = bidx() * 4 + w; row < T_TOK; row += gdim() * 4) {
        f32x4* xr = (f32x4*)(p->out + (size_t)row * 1024);
        f32x4 v[4]; float ss = 0.f;
#pragma unroll
        for (int j = 0; j < 4; ++j) { v[j] = xr[lane + 64 * j]; ss += v[j][0] * v[j][0] + v[j][1] * v[j][1] + v[j][2] * v[j][2] + v[j][3] * v[j][3]; }
        ss = wave_sum(ss);
        const float rstd = rsqrtf(ss * (1.0f / 1024.0f) + EPS);
#pragma unroll
        for (int j = 0; j < 4; ++j) {
            const f32x4 g4 = *(const f32x4*)(p->g_final + 4 * (lane + 64 * j));
            f32x4 o;
#pragma unroll
            for (int e = 0; e < 4; ++e) o[e] = (v[j][e] * rstd) * g4[e];
            xr[lane + 64 * j] = o;
        }
    }
}

struct EpiInprojA {
    static constexpr bool PERM = false, AFTER_DRAIN = false;
    bf16_t* qf; bf16_t* kf; bf16_t* qs; bf16_t* ks; bf16_t* ql; bf16_t* kvl; bf16_t* kr; float* logf; const float* ropetab; const float* bfox;
    __device__ __forceinline__ void operator()(const pg8::f32x4 (&acc)[2][2][4][2], const pg8::Unit& u, int wr, int wc, int fr, int fq) const {
        const int row0 = u.pm * 256 + wr * 64 + fr;
        const int cw = wc * 32 + fq * 4;
#pragma unroll
        for (int bj = 0; bj < 2; ++bj) {
            bf16_t* dst; int ld; float sc = 1.0f; bool special = false;
            if (u.pn < 8) { const int region = u.pn >> 1; dst = (region == 0 ? qf : region == 1 ? kf : region == 2 ? qs : ks) + (u.pn & 1) * 256 + bj * 128; ld = 512; if (region == 0 || region == 2) sc = FOX_QS; }
            else if (u.pn == 8) { dst = ql + bj * 128; ld = 384; }
            else if (u.pn == 9) { if (bj == 0) { dst = ql + 256; ld = 384; } else { dst = kvl; ld = 256; } }
            else { dst = kvl + 128; ld = 256; special = (bj == 1); }
            if (!special) {
#pragma unroll
                for (int ai = 0; ai < 2; ++ai)
#pragma unroll
                    for (int m = 0; m < 4; ++m) {
                        bf16_t* rowp = dst + (size_t)(row0 + ai * 128 + m * 16) * ld + cw;
#pragma unroll
                        for (int n = 0; n < 2; ++n) { const pg8::f32x4 v = acc[ai][bj][m][n] * sc; u32x2 pk; pk.x = pack_bf16(v[0], v[1]); pk.y = pack_bf16(v[2], v[3]); *(u32x2*)(rowp + n * 16) = pk; }
                    }
            } else if (wc == 0) {
#pragma unroll
                for (int ai = 0; ai < 2; ++ai)
#pragma unroll
                    for (int m = 0; m < 4; ++m) {
                        const int t = row0 + ai * 128 + m * 16;
                        const pg8::f32x4 x1 = acc[ai][1][m][0], x2 = acc[ai][1][m][1];
                        const pg8::f32x4 ca = *(const pg8::f32x4*)(ropetab + 2 * (t * 16 + fq * 4)), cb = *(const pg8::f32x4*)(ropetab + 2 * (t * 16 + fq * 4) + 4);
                        const float co[4] = {ca[0], ca[2], cb[0], cb[2]}, si[4] = {ca[1], ca[3], cb[1], cb[3]};
                        float o1[4], o2[4];
#pragma unroll
                        for (int j = 0; j < 4; ++j) { o1[j] = x1[j] * co[j] - x2[j] * si[j]; o2[j] = x1[j] * si[j] + x2[j] * co[j]; }
                        u32x2 p1, p2; p1.x = pack_bf16(o1[0], o1[1]); p1.y = pack_bf16(o1[2], o1[3]); p2.x = pack_bf16(o2[0], o2[1]); p2.y = pack_bf16(o2[2], o2[3]);
                        *(u32x2*)(kr + (size_t)t * 32 + fq * 4) = p1;
                        *(u32x2*)(kr + (size_t)t * 32 + 16 + fq * 4) = p2;
                    }
            } else if (wc == 1 && fq < 2) {
#pragma unroll
                for (int ai = 0; ai < 2; ++ai)
#pragma unroll
                    for (int m = 0; m < 4; ++m) {
                        const int t = row0 + ai * 128 + m * 16, b = t >> 12, sq = t & 4095;
#pragma unroll
                        for (int j = 0; j < 4; ++j) {
                            const int head = fq * 4 + j;
                            const float f = acc[ai][1][m][0][j] + bfox[head];
                            logf[(size_t)(b * 8 + head) * SEQ + sq] = fminf(f, 0.f) - log1pf(expf(-fabsf(f)));
                        }
                    }
            }
        }
    }
};
struct EpiInprojV {
    static constexpr bool PERM = false, AFTER_DRAIN = false;
    bf16_t* vtf; bf16_t* vts;
    __device__ __forceinline__ void operator()(const pg8::f32x4 (&acc)[2][2][4][2], const pg8::Unit& u, int wr, int wc, int fr, int fq) const {
        bf16_t* vt = u.pn < 2 ? vtf : vts;
        const int row0 = u.pm * 256 + wr * 64 + fq * 4, b = row0 >> 12, s0 = row0 & 4095;
        const int cv0 = (u.pn & 1) * 256 + wc * 32 + fr;
#pragma unroll
        for (int bj = 0; bj < 2; ++bj)
#pragma unroll
            for (int n = 0; n < 2; ++n) {
                const int cv = cv0 + bj * 128 + n * 16;
                bf16_t* vp = vt + (size_t)(b * 8 + (cv >> 6)) * SEQ * 64 + (cv & 63) * 64;
#pragma unroll
                for (int ai = 0; ai < 2; ++ai)
#pragma unroll
                    for (int m = 0; m < 4; ++m) { const int sq = s0 + ai * 128 + m * 16; const pg8::f32x4 v = acc[ai][bj][m][n]; u32x2 pk; pk.x = pack_bf16(v[0], v[1]); pk.y = pack_bf16(v[2], v[3]);
                        *(u32x2*)(vp + (size_t)(sq >> 6) * 4096 + (sq & 63)) = pk; }
            }
    }
};
struct EpiFfnUp {
    static constexpr bool PERM = false, AFTER_DRAIN = false;
    bf16_t* h;
    __device__ __forceinline__ void operator()(const pg8::f32x4 (&acc)[2][2][4][2], const pg8::Unit& u, int wr, int wc, int fr, int fq) const {
        const int row0 = u.pm * 256 + wr * 64 + fr;
#pragma unroll
        for (int ai = 0; ai < 2; ++ai)
#pragma unroll
            for (int m = 0; m < 4; ++m) {
                bf16_t* rowp = h + (size_t)(row0 + ai * 128 + m * 16) * 2816 + u.pn * 128 + wc * 16 + fq * 4;
#pragma unroll
                for (int bj = 0; bj < 2; ++bj) {
                    const pg8::f32x4 g = acc[ai][bj][m][0], up = acc[ai][bj][m][1];
                    float hv[4];
#pragma unroll
                    for (int j = 0; j < 4; ++j) hv[j] = g[j] * sigmoidf_(g[j]) * up[j];
                    u32x2 pk; pk.x = pack_bf16(hv[0], hv[1]); pk.y = pack_bf16(hv[2], hv[3]);
                    *(u32x2*)(rowp + bj * 64) = pk;
                }
            }
    }
};
struct EpiResidual {
    static constexpr bool PERM = false, AFTER_DRAIN = false;
    const float* xin; float* xout; const float* modl; int gidx;
    __device__ __forceinline__ void operator()(const pg8::f32x4 (&acc)[2][2][4][2], const pg8::Unit& u, int wr, int wc, int fr, int fq) const {
        const int row0 = u.pm * 256 + wr * 64 + fr, b = row0 >> 12;
        const float* gt = modl + (size_t)b * 6144 + gidx * 1024;
#pragma unroll
        for (int bj = 0; bj < 2; ++bj)
#pragma unroll
            for (int n = 0; n < 2; ++n) {
                const int col = u.pn * 256 + bj * 128 + wc * 32 + n * 16 + fq * 4;
                const pg8::f32x4 g4 = *(const pg8::f32x4*)(gt + col);
                pg8::f32x4 xv[2][4];
#pragma unroll
                for (int ai = 0; ai < 2; ++ai)
#pragma unroll
                    for (int m = 0; m < 4; ++m) xv[ai][m] = *(const pg8::f32x4*)(xin + (size_t)(row0 + ai * 128 + m * 16) * 1024 + col);
#pragma unroll
                for (int ai = 0; ai < 2; ++ai)
#pragma unroll
                    for (int m = 0; m < 4; ++m) *(pg8::f32x4*)(xout + (size_t)(row0 + ai * 128 + m * 16) * 1024 + col) = xv[ai][m] + g4 * acc[ai][bj][m][n];
            }
    }
};
template <class Epi, bool NAT = false>
DI void big_gemm(const bf16_t* A, const bf16_t* Bt, int N, int K, const Epi& E, unsigned char* smem) {
    __syncthreads();
    pg8::StaticOrder S; S.init(T_TOK, N, (int)gridDim.x, (int)blockIdx.x);
    pg8::Gemm g; g.A = A; g.Bt = Bt; g.M = T_TOK; g.N = N; g.K = K;
    pg8::gemm_phase<Epi, pg8::StaticOrder, true, true, NAT>((PG8_LAS unsigned char*)smem, g, S, E);
    __syncthreads();
}

DI void phase_inproj(KargPtr p, int l, unsigned char* smem_phys) {
    const bf16_t* W = p->wt + (size_t)l * W_LAYER + W_IN;
    { EpiInprojA E; E.qf = p->qf; E.kf = p->kf; E.qs = p->qs; E.ks = p->ks; E.ql = p->ql; E.kvl = p->kvl; E.kr = p->kr; E.logf = p->logf; E.ropetab = p->ropetab; E.bfox = p->b_fox_f + l * 8;
      big_gemm<EpiInprojA, false>(p->u, W, 2816, 1024, E, smem_phys); }
    { EpiInprojV E; E.vtf = p->vtf; E.vts = p->vts;
      big_gemm<EpiInprojV, true>(p->u, W + (size_t)2816 * 1024, 1024, 1024, E, smem_phys); }
}

DI void phase_mla_up(KargPtr p, int l, unsigned char* smem) {
    const int tid = tidx(), lane = tid & 63, w = tid >> 6;
    (void)l;
    for (int row = (bidx() * 4 + w) * 2; row < T_TOK; row += gdim() * 8) {
        float sq[2], skv[2];
#pragma unroll
        for (int k = 0; k < 2; ++k) {
            uint4 a = make_uint4(0, 0, 0, 0), c = make_uint4(0, 0, 0, 0);
            if (lane < 48) a = *(const uint4*)(p->ql + (size_t)(row + k) * 384 + lane * 8);
            if (lane < 32) c = *(const uint4*)(p->kvl + (size_t)(row + k) * 256 + lane * 8);
            const unsigned ua[4] = {a.x, a.y, a.z, a.w}, uc[4] = {c.x, c.y, c.z, c.w};
            float s1 = 0.f, s2 = 0.f;
#pragma unroll
            for (int e = 0; e < 4; ++e) { float lo = __uint_as_float(ua[e] << 16), hi = __uint_as_float(ua[e] & 0xffff0000u); s1 += lo * lo + hi * hi;
                                          lo = __uint_as_float(uc[e] << 16); hi = __uint_as_float(uc[e] & 0xffff0000u); s2 += lo * lo + hi * hi; }
            sq[k] = wave_sum(s1); skv[k] = wave_sum(s2);
        }
        if (lane == 0) { p->rsq[row] = rsqrtf(sq[0] * (1.0f / 384.0f) + EPS); p->rsq[row + 1] = rsqrtf(sq[1] * (1.0f / 384.0f) + EPS);
                         p->rskv[row] = rsqrtf(skv[0] * (1.0f / 256.0f) + EPS); p->rskv[row + 1] = rsqrtf(skv[1] * (1.0f / 256.0f) + EPS); }
    }
    __syncthreads();
    float* fs = (float*)smem;
    for (int bh = bidx(); bh < 64; bh += gdim()) {
        const f32x4* src = (const f32x4*)(p->logf + (size_t)bh * SEQ + tid * 16);
        f32x4 v[4];
        float run = 0.f;
#pragma unroll
        for (int j = 0; j < 4; ++j) { v[j] = src[j];
#pragma unroll
            for (int e = 0; e < 4; ++e) { run += v[j][e]; v[j][e] = run; } }
        float incl = run;
#pragma unroll
        for (int o = 1; o < 64; o <<= 1) { const float tv = __shfl_up(incl, o); if (lane >= o) incl += tv; }
        if (lane == 63) fs[w] = incl;
        __syncthreads();
        float pre = incl - run;
        for (int ww = 0; ww < w; ++ww) pre += fs[ww];
        f32x4* dst = (f32x4*)(p->cum + (size_t)bh * SEQ + tid * 16);
#pragma unroll
        for (int j = 0; j < 4; ++j) { f32x4 o;
#pragma unroll
            for (int e = 0; e < 4; ++e) o[e] = v[j][e] + pre; dst[j] = o; }
        __syncthreads();
    }
    {
        const int v = bidx();
        if (v < 512) {
            const int bh = v >> 3, part = v & 7;
            const bf16_t* kp = p->kf + (size_t)(bh >> 3) * SEQ * 512 + (bh & 7) * 64 + (size_t)(part * 512 + tid * 2) * 512;
            float mx = 0.f;
#pragma unroll
            for (int rr = 0; rr < 2; ++rr) {
                const uint4* q4 = (const uint4*)(kp + (size_t)rr * 512);
                uint4 vv[8];
#pragma unroll
                for (int c = 0; c < 8; ++c) vv[c] = q4[c];
                float ss = 0.f;
#pragma unroll
                for (int c = 0; c < 8; ++c) { const unsigned uu[4] = {vv[c].x, vv[c].y, vv[c].z, vv[c].w};
#pragma unroll
                    for (int e = 0; e < 4; ++e) { const float lo = __uint_as_float(uu[e] << 16), hi = __uint_as_float(uu[e] & 0xffff0000u); ss += lo * lo + hi * hi; } }
                mx = fmaxf(mx, ss);
            }
#pragma unroll
            for (int o = 32; o >= 1; o >>= 1) mx = fmaxf(mx, __shfl_xor(mx, o));
            if (lane == 0) atomicMax((unsigned*)p->kmax + bh, __float_as_uint(mx));
        }
    }
}

template <int TYPE>
DI void attn_item(KargPtr p, int b, int h, int qb, unsigned char* smem) {
    constexpr int DK = (TYPE == 1) ? 96 : (TYPE == 0 ? 80 : 64), KS = DK / 16, KROWB = (DK + 8) * 2, VROWB = 144;
    constexpr int KBYTES = 64 * KROWB, VBYTES = 64 * VROWB, BUFB = KBYTES + VBYTES + 256;
    const int tid = tidx(), lane = tid & 63, w = tid >> 6, r = lane & 31, hh = lane >> 5;
    const int q0 = qb * 128, qw = q0 + 32 * w, myq = qw + r;
    const size_t tokq = (size_t)b * SEQ + myq;
    unsigned* flags = (unsigned*)(smem - vhalf() * VSMEM + FLAGS_OFF);
    const int w8 = vhalf() * 4 + w;

    bf16x8 qfrag[KS];
    if (TYPE == 1) {
#pragma unroll
        for (int ks = 0; ks < 4; ++ks) qfrag[ks] = *(const bf16x8*)(p->qn + tokq * 512 + h * 64 + ks * 16 + hh * 8);
#pragma unroll
        for (int ks = 4; ks < KS; ++ks) qfrag[ks] = *(const bf16x8*)(p->qr + tokq * 256 + h * 32 + (ks - 4) * 16 + hh * 8);
    } else {
        const bf16_t* qg = (TYPE == 0 ? p->qf : p->qs) + tokq * 512 + h * 64;
#pragma unroll
        for (int ks = 0; ks < 4; ++ks) qfrag[ks] = *(const bf16x8*)(qg + ks * 16 + hh * 8);
        if (TYPE == 0) { const u32x4 one3 = hh == 0 ? (u32x4){0x3F803F80u, 0x00003F80u, 0u, 0u} : (u32x4){0u, 0u, 0u, 0u}; qfrag[KS - 1] = __builtin_bit_cast(bf16x8, one3); }
    }
    const bf16_t* Kg = (TYPE == 0 ? p->kf : TYPE == 1 ? p->kn : p->ks) + (size_t)b * SEQ * 512 + h * 64;
    const bf16_t* Vg = (TYPE == 0 ? p->vtf : TYPE == 1 ? p->vtm : p->vts) + (size_t)(b * 8 + h) * 64 * SEQ;
    const bf16_t* Krg = p->kr + (size_t)b * SEQ * 32;
    const float* cumg = p->cum + (size_t)(b * 8 + h) * SEQ;

    const int ntiles = 2 * qb + 2;
    u32x4 rk0A, rk1A, rv0A, rv1A, rkrA, rk0B, rk1B, rv0B, rv1B, rkrB; float rckA = 0.f, rckB = 0.f;
    { unsigned z_ = 0u; asm volatile("" : "+v"(z_)); rkrA = (u32x4){z_, z_, z_, z_}; rkrB = rkrA; }
    const int ldrow = tid >> 3, ldch = tid & 7;
    const int vpos = 16 * (ldch >> 1) + 4 * (ldch & 1);
#define LOAD_TILE(S, KT_) do { \
        const int k0_ = (KT_) * 64; \
        GLOAD16(rk0##S, Kg + (size_t)(k0_ + ldrow) * 512 + ldch * 8); \
        GLOAD16(rk1##S, Kg + (size_t)(k0_ + 32 + ldrow) * 512 + ldch * 8); \
        GLOAD16(rv0##S, Vg + (size_t)k0_ * 64 + ldrow * 64 + ldch * 8); \
        GLOAD16(rv1##S, Vg + (size_t)k0_ * 64 + (32 + ldrow) * 64 + ldch * 8); \
        if (TYPE == 1) GLOAD16(rkr##S, Krg + (size_t)(k0_ + (tid >> 2)) * 32 + (tid & 3) * 8); \
        if (TYPE == 0) GLOAD4(rck##S, cumg + k0_ + (tid & 63)); \
    } while (0)
#define WAIT_ALL(S) asm volatile("s_waitcnt vmcnt(0)" : "+v"(rk0##S), "+v"(rk1##S), "+v"(rv0##S), "+v"(rv1##S), "+v"(rkr##S), "+v"(rck##S))
#define WAIT_OLD(S) do { if (TYPE == 2) asm volatile("s_waitcnt vmcnt(4)" : "+v"(rk0##S), "+v"(rk1##S), "+v"(rv0##S), "+v"(rv1##S), "+v"(rkr##S), "+v"(rck##S)); \
        else asm volatile("s_waitcnt vmcnt(5)" : "+v"(rk0##S), "+v"(rk1##S), "+v"(rv0##S), "+v"(rv1##S), "+v"(rkr##S), "+v"(rck##S)); } while (0)
#define STORE_TILE(S, BUF_) do { \
        unsigned char* kb_ = smem + (BUF_) * BUFB; unsigned char* vb_ = kb_ + KBYTES; \
        *(u32x4*)(kb_ + ldrow * KROWB + ldch * 16) = rk0##S; \
        *(u32x4*)(kb_ + (32 + ldrow) * KROWB + ldch * 16) = rk1##S; \
        { u32x2 lo, hi; lo.x = rv0##S.x; lo.y = rv0##S.y; hi.x = rv0##S.z; hi.y = rv0##S.w; \
          *(u32x2*)(vb_ + ldrow * VROWB + vpos * 2) = lo; *(u32x2*)(vb_ + ldrow * VROWB + (vpos + 8) * 2) = hi; } \
        { u32x2 lo, hi; lo.x = rv1##S.x; lo.y = rv1##S.y; hi.x = rv1##S.z; hi.y = rv1##S.w; \
          *(u32x2*)(vb_ + (32 + ldrow) * VROWB + vpos * 2) = lo; *(u32x2*)(vb_ + (32 + ldrow) * VROWB + (vpos + 8) * 2) = hi; } \
        if (TYPE == 1) *(u32x4*)(kb_ + (tid >> 2) * KROWB + 128 + (tid & 3) * 16) = rkr##S; \
        if (TYPE == 0) { if (tid < 64) { \
            const float c_ = -rck##S * LOG2E; \
            const unsigned h_ = pack_bf16(c_, 0.f) & 0xffffu; const float r1_ = c_ - __uint_as_float(h_ << 16); \
            const unsigned m_ = pack_bf16(r1_, 0.f) & 0xffffu; const float r2_ = r1_ - __uint_as_float(m_ << 16); \
            const unsigned l_ = pack_bf16(r2_, 0.f) & 0xffffu; \
            *(u32x4*)(kb_ + tid * KROWB + 128) = (u32x4){h_ | (m_ << 16), l_, 0u, 0u}; \
            { unsigned z_ = 0u; asm volatile("" : "+v"(z_)); *(u32x4*)(kb_ + tid * KROWB + 144) = (u32x4){z_, z_, z_, z_}; }        \
            if (tid == 63) *(float*)(vb_ + VBYTES) = c_; } } \
    } while (0)
#define TILE_OF(J_) ((TYPE != 1) ? (ntiles - 1 - ((J_) < ntiles ? (J_) : ntiles - 1)) : ((J_) < ntiles ? (J_) : ntiles - 1))

    f32x16 o0, o1;
#pragma unroll
    for (int i = 0; i < 16; ++i) { o0[i] = 0.f; o1[i] = 0.f; }
    float m = -1e30f, lsum = 0.f, carry = 0.f;
    bool wdone = false;
    float qbound = 0.f;
    if (TYPE == 0) {
        float ss = 0.f;
#pragma unroll
        for (int ks = 0; ks < 4; ++ks) { const u32x4 qq = __builtin_bit_cast(u32x4, qfrag[ks]);
#pragma unroll
            for (int e = 0; e < 4; ++e) { const float lo = __uint_as_float(qq[e] << 16), hi = __uint_as_float(qq[e] & 0xffff0000u); ss += lo * lo + hi * hi; } }
        ss += __shfl_xor(ss, 32);
        qbound = sqrtf(ss * p->kmax[b * 8 + h]) * 1.0201f;
    }

    auto compute = [&](const int kt, const int buf) __attribute__((always_inline)) {
        const unsigned char* kb = smem + buf * BUFB; const unsigned char* vb = kb + KBYTES;
        const int k0 = kt * 64;
        bool need;
        if (TYPE == 0) {
            if (!wdone && k0 <= qw + 31) wdone = (__all(qbound + *(const float*)(vb + VBYTES) - m < -150.f) != 0);
            need = (k0 <= qw + 31) && !wdone;
        }
        else if (TYPE == 1) need = (k0 <= qw);
        else need = (k0 <= qw + 30) && !wdone;
        if (need) {
            f32x16 s0, s1;
#pragma unroll
            for (int i = 0; i < 16; ++i) { s0[i] = 0.f; s1[i] = 0.f; }
#pragma unroll
            for (int ks = 0; ks < KS; ++ks) {
                const bf16x8 a0 = *(const bf16x8*)(kb + r * KROWB + ks * 32 + hh * 16);
                const bf16x8 a1 = *(const bf16x8*)(kb + (32 + r) * KROWB + ks * 32 + hh * 16);
                s0 = MFMA(a0, qfrag[ks], s0); s1 = MFMA(a1, qfrag[ks], s1);
            }
            if (TYPE != 2) {
                if (TYPE == 0) {
                    if (k0 + 63 > qw) {
                        asm volatile("");
                        const int rel = myq - k0 - 4 * hh;
#pragma unroll
                        for (int i = 0; i < 16; ++i) {
                            const int off = 8 * (i >> 2) + (i & 3);
                            if (off > rel) s0[i] = -1e30f;
                            if (off + 32 > rel) s1[i] = -1e30f;
                        }
                    }
                }
                float mx = s0[0];
#pragma unroll
                for (int i = 1; i < 16; ++i) mx = fmaxf(mx, s0[i]);
#pragma unroll
                for (int i = 0; i < 16; ++i) mx = fmaxf(mx, s1[i]);
                mx = fmaxf(mx, __shfl_xor(mx, 32));
                const float mnew = fmaxf(m, mx);
                const float alpha = fexp2(m - mnew);
                m = mnew;
                float ps = 0.f;
#pragma unroll
                for (int i = 0; i < 16; i += 2) {
                    const f32x2_t mm = {mnew, mnew};
                    const f32x2_t d0 = (f32x2_t){s0[i], s0[i + 1]} - mm, d1 = (f32x2_t){s1[i], s1[i + 1]} - mm;
                    s0[i] = fexp2(d0[0]); s0[i + 1] = fexp2(d0[1]); s1[i] = fexp2(d1[0]); s1[i + 1] = fexp2(d1[1]);
                    ps += (s0[i] + s0[i + 1]) + (s1[i] + s1[i + 1]);
                }
                lsum = lsum * alpha + ps;
#pragma unroll
                for (int i = 0; i < 16; ++i) { o0[i] *= alpha; o1[i] *= alpha; }
            } else {
                float lk0[16], lk1[16];
#pragma unroll
                for (int i = 0; i < 16; ++i) {
                    {
                        const float z = s0[i]; const float sp = flog2(1.0f + fexp2(-fabsf(z)));
                        const float lb = fminf(z, 0.f) - sp;
                        s0[i] = lb; lk0[i] = lb - z;
                    }
                    {
                        const float z = s1[i]; const float sp = flog2(1.0f + fexp2(-fabsf(z)));
                        const float lb = fminf(z, 0.f) - sp;
                        s1[i] = lb; lk1[i] = lb - z;
                    }
                }
                if (k0 + 63 >= qw) {
                    asm volatile("");
                    const int rel = myq - k0 - 4 * hh;
#pragma unroll
                    for (int i = 0; i < 16; ++i) {
                        const int off = 8 * (i >> 2) + (i & 3);
                        if (off >= rel) { lk0[i] = 0.f; s0[i] = -1e30f; }
                        if (off + 32 >= rel) { lk1[i] = 0.f; s1[i] = -1e30f; }
                    }
                }
                float run = carry;
#pragma unroll
                for (int g = 3; g >= 0; --g) {
                    const float G = (lk1[4 * g] + lk1[4 * g + 1]) + (lk1[4 * g + 2] + lk1[4 * g + 3]);
                    const float Gp = __shfl_xor(G, 32);
                    const float base = run + (hh == 0 ? Gp : 0.f);
                    const float e3 = base, e2 = e3 + lk1[4 * g + 3], e1 = e2 + lk1[4 * g + 2], e0 = e1 + lk1[4 * g + 1];
                    s1[4 * g + 3] = fexp2(s1[4 * g + 3] + e3); s1[4 * g + 2] = fexp2(s1[4 * g + 2] + e2);
                    s1[4 * g + 1] = fexp2(s1[4 * g + 1] + e1); s1[4 * g] = fexp2(s1[4 * g] + e0);
                    run += G + Gp;
                }
#pragma unroll
                for (int g = 3; g >= 0; --g) {
                    const float G = (lk0[4 * g] + lk0[4 * g + 1]) + (lk0[4 * g + 2] + lk0[4 * g + 3]);
                    const float Gp = __shfl_xor(G, 32);
                    const float base = run + (hh == 0 ? Gp : 0.f);
                    const float e3 = base, e2 = e3 + lk0[4 * g + 3], e1 = e2 + lk0[4 * g + 2], e0 = e1 + lk0[4 * g + 1];
                    s0[4 * g + 3] = fexp2(s0[4 * g + 3] + e3); s0[4 * g + 2] = fexp2(s0[4 * g + 2] + e2);
                    s0[4 * g + 1] = fexp2(s0[4 * g + 1] + e1); s0[4 * g] = fexp2(s0[4 * g] + e0);
                    run += G + Gp;
                }
                carry = run;
            }
#pragma unroll
            for (int s2 = 0; s2 < 2; ++s2) {
                unsigned pk0[4], pk1[4];
#pragma unroll
                for (int j = 0; j < 4; ++j) { pk0[j] = pack_bf16(s0[8 * s2 + 2 * j], s0[8 * s2 + 2 * j + 1]); pk1[j] = pack_bf16(s1[8 * s2 + 2 * j], s1[8 * s2 + 2 * j + 1]); }
                const uint4 u0 = make_uint4(pk0[0], pk0[1], pk0[2], pk0[3]), u1 = make_uint4(pk1[0], pk1[1], pk1[2], pk1[3]);
                const bf16x8 pf0 = __builtin_bit_cast(bf16x8, u0), pf1 = __builtin_bit_cast(bf16x8, u1);
                const bf16x8 v00 = *(const bf16x8*)(vb + r * VROWB + (16 * s2 + 8 * hh) * 2);
                const bf16x8 v01 = *(const bf16x8*)(vb + (32 + r) * VROWB + (16 * s2 + 8 * hh) * 2);
                const bf16x8 v10 = *(const bf16x8*)(vb + r * VROWB + (32 + 16 * s2 + 8 * hh) * 2);
                const bf16x8 v11 = *(const bf16x8*)(vb + (32 + r) * VROWB + (32 + 16 * s2 + 8 * hh) * 2);
                o0 = MFMA(v00, pf0, o0); o1 = MFMA(v01, pf0, o1);
                o0 = MFMA(v10, pf1, o0); o1 = MFMA(v11, pf1, o1);
            }
        }
    };
#define SB_FLAGS(N_) do { if (TYPE != 1) { if (TYPE == 2) wdone = (__all(carry < -170.f) != 0); if (lane == 0) flags[((N_) & 1) * 8 + w8] = wdone ? 1u : 0u; } } while (0)
#define SB_DONE(N_) (TYPE != 1 && ((flags[((N_) & 1) * 8] & flags[((N_) & 1) * 8 + 1] & flags[((N_) & 1) * 8 + 2] & flags[((N_) & 1) * 8 + 3] & flags[((N_) & 1) * 8 + 4] & flags[((N_) & 1) * 8 + 5] & flags[((N_) & 1) * 8 + 6] & flags[((N_) & 1) * 8 + 7]) != 0u))
    __syncthreads();
    if (TYPE != 1 && tid < 16) flags[tid] = 0;
    LOAD_TILE(A, TILE_OF(0));
    WAIT_ALL(A);
    STORE_TILE(A, 0);
    LOAD_TILE(A, TILE_OF(1));
    __syncthreads();
    for (int n = 0; n < ntiles; n += 2) {
        LOAD_TILE(B, TILE_OF(n + 2));
        __builtin_amdgcn_sched_barrier(0);
        compute(TILE_OF(n), 0);
        __builtin_amdgcn_sched_barrier(0);
        WAIT_OLD(A);
        STORE_TILE(A, 1);
        SB_FLAGS(n);
        __syncthreads();
        if (SB_DONE(n)) break;
        if (n + 1 >= ntiles) break;
        LOAD_TILE(A, TILE_OF(n + 3));
        __builtin_amdgcn_sched_barrier(0);
        compute(TILE_OF(n + 1), 1);
        __builtin_amdgcn_sched_barrier(0);
        WAIT_OLD(B);
        STORE_TILE(B, 0);
        SB_FLAGS(n + 1);
        __syncthreads();
        if (SB_DONE(n + 1)) break;
    }
    asm volatile("s_waitcnt vmcnt(0)" : "+v"(rk0A), "+v"(rk1A), "+v"(rv0A), "+v"(rv1A), "+v"(rkrA), "+v"(rckA), "+v"(rk0B), "+v"(rk1B), "+v"(rv0B), "+v"(rv1B), "+v"(rkrB), "+v"(rckB));
    float inv = 1.0f;
    if (TYPE != 2) { const float lt = lsum + __shfl_xor(lsum, 32); inv = frcp(lt); }
    bf16_t* yg = (TYPE == 0 ? p->qf : TYPE == 1 ? p->qn : p->qs) + tokq * 512 + h * 64;
#pragma unroll
    for (int g = 0; g < 4; ++g) {
        u32x2 a, c2;
        a.x = pack_bf16(o0[4 * g] * inv, o0[4 * g + 1] * inv); a.y = pack_bf16(o0[4 * g + 2] * inv, o0[4 * g + 3] * inv);
        c2.x = pack_bf16(o1[4 * g] * inv, o1[4 * g + 1] * inv); c2.y = pack_bf16(o1[4 * g + 2] * inv, o1[4 * g + 3] * inv);
        *(u32x2*)(yg + 8 * g + 4 * hh) = a;
        *(u32x2*)(yg + 32 + 8 * g + 4 * hh) = c2;
    }
}

DI void phase_attn(KargPtr p, unsigned char* smem) {
    for (int idx = bidx(); idx < 6144; idx += gdim()) {
        if (idx < 4096) {
            const int j = idx >> 9, g = (idx >> 7) & 3, rem = idx & 127, bh = ((rem & 63) + 13 * j) & 63;
            const int qb = 31 - 4 * j - ((j & 1) ? 3 - g : g);
            const int type = ((rem >> 6) + j) & 1;
            if (type == 0) attn_item<0>(p, bh >> 3, bh & 7, qb, smem);
            else attn_item<1>(p, bh >> 3, bh & 7, qb, smem);
        } else {
            const int j = idx - 4096; const int qb = 31 - (j >> 6), bh = j & 63;
            attn_item<2>(p, bh >> 3, bh & 7, qb, smem);
        }
    }
}

struct EpiUq {
    static constexpr bool PERM = false, AFTER_DRAIN = false;
    bf16_t* qn; bf16_t* qr; const float* rs; const float* ropetab;
    __device__ __forceinline__ void operator()(const pg8::f32x4 (&acc)[2][2][4][2], const pg8::Unit& u, int wr, int wc, int fr, int fq) const {
        const int row0 = u.pm * 256 + wr * 64 + fr;
#pragma unroll
        for (int ai = 0; ai < 2; ++ai)
#pragma unroll
            for (int m = 0; m < 4; ++m) {
                const int t = row0 + ai * 128 + m * 16;
                const float sc = rs[t] * MLA_QS;
                if (u.pn < 2) {
                    bf16_t* rowp = qn + (size_t)t * 512 + u.pn * 256 + wc * 32 + fq * 4;
#pragma unroll
                    for (int bj = 0; bj < 2; ++bj)
#pragma unroll
                        for (int n = 0; n < 2; ++n) { const pg8::f32x4 v = acc[ai][bj][m][n] * sc; u32x2 pk; pk.x = pack_bf16(v[0], v[1]); pk.y = pack_bf16(v[2], v[3]); *(u32x2*)(rowp + bj * 128 + n * 16) = pk; }
                } else {
                    const pg8::f32x4 ca = *(const pg8::f32x4*)(ropetab + 2 * (t * 16 + fq * 4)), cb = *(const pg8::f32x4*)(ropetab + 2 * (t * 16 + fq * 4) + 4);
                    const float co[4] = {ca[0], ca[2], cb[0], cb[2]}, si[4] = {ca[1], ca[3], cb[1], cb[3]};
#pragma unroll
                    for (int bj = 0; bj < 2; ++bj) {
                        const pg8::f32x4 x1 = acc[ai][bj][m][0] * sc, x2 = acc[ai][bj][m][1] * sc;
                        float o1[4], o2[4];
#pragma unroll
                        for (int j = 0; j < 4; ++j) { o1[j] = x1[j] * co[j] - x2[j] * si[j]; o2[j] = x1[j] * si[j] + x2[j] * co[j]; }
                        u32x2 p1, p2; p1.x = pack_bf16(o1[0], o1[1]); p1.y = pack_bf16(o1[2], o1[3]); p2.x = pack_bf16(o2[0], o2[1]); p2.y = pack_bf16(o2[2], o2[3]);
                        bf16_t* hp = qr + (size_t)t * 256 + (bj * 4 + wc) * 32 + fq * 4;
                        *(u32x2*)hp = p1; *(u32x2*)(hp + 16) = p2;
                    }
                }
            }
    }
};
struct EpiUkvK {
    static constexpr bool PERM = false, AFTER_DRAIN = false;
    bf16_t* kn; const float* rs;
    __device__ __forceinline__ void operator()(const pg8::f32x4 (&acc)[2][2][4][2], const pg8::Unit& u, int wr, int wc, int fr, int fq) const {
        const int row0 = u.pm * 256 + wr * 64 + fr;
#pragma unroll
        for (int ai = 0; ai < 2; ++ai)
#pragma unroll
            for (int m = 0; m < 4; ++m) {
                const int t = row0 + ai * 128 + m * 16;
                const float sc = rs[t];
                bf16_t* rowp = kn + (size_t)t * 512 + u.pn * 256 + wc * 32 + fq * 4;
#pragma unroll
                for (int bj = 0; bj < 2; ++bj)
#pragma unroll
                    for (int n = 0; n < 2; ++n) { const pg8::f32x4 v = acc[ai][bj][m][n] * sc; u32x2 pk; pk.x = pack_bf16(v[0], v[1]); pk.y = pack_bf16(v[2], v[3]); *(u32x2*)(rowp + bj * 128 + n * 16) = pk; }
            }
    }
};
struct EpiUkvV {
    static constexpr bool PERM = false, AFTER_DRAIN = false;
    bf16_t* vtm; const float* rs;
    __device__ __forceinline__ void operator()(const pg8::f32x4 (&acc)[2][2][4][2], const pg8::Unit& u, int wr, int wc, int fr, int fq) const {
        const int row0 = u.pm * 256 + wr * 64 + fq * 4, b = row0 >> 12, s0 = row0 & 4095;
        const int cv0 = u.pn * 256 + wc * 32 + fr;
#pragma unroll
        for (int ai = 0; ai < 2; ++ai)
#pragma unroll
            for (int m = 0; m < 4; ++m) {
                const int sq = s0 + ai * 128 + m * 16;
                const pg8::f32x4 sc4 = *(const pg8::f32x4*)(rs + row0 + ai * 128 + m * 16);
#pragma unroll
                for (int bj = 0; bj < 2; ++bj)
#pragma unroll
                    for (int n = 0; n < 2; ++n) {
                        const int cv = cv0 + bj * 128 + n * 16;
                        const pg8::f32x4 v = acc[ai][bj][m][n] * sc4; u32x2 pk; pk.x = pack_bf16(v[0], v[1]); pk.y = pack_bf16(v[2], v[3]);
                        *(u32x2*)(vtm + (size_t)(b * 8 + (cv >> 6)) * SEQ * 64 + (cv & 63) * 64 + (size_t)(sq >> 6) * 4096 + (sq & 63)) = pk;
                    }
            }
    }
};
DI void phase_mla_gemm(KargPtr p, int l, unsigned char* smem_phys) {
    const bf16_t* WQ = p->wt + (size_t)l * W_LAYER + W_UQ;
    const bf16_t* WKV = p->wt + (size_t)l * W_LAYER + W_UKV;
    { EpiUq E; E.qn = p->qn; E.qr = p->qr; E.rs = p->rsq; E.ropetab = p->ropetab; big_gemm<EpiUq, false>(p->ql, WQ, 768, 384, E, smem_phys); }
    { EpiUkvK E; E.kn = p->kn; E.rs = p->rskv; big_gemm<EpiUkvK, false>(p->kvl, WKV, 512, 256, E, smem_phys); }
    { EpiUkvV E; E.vtm = p->vtm; E.rs = p->rskv; big_gemm<EpiUkvV, true>(p->kvl, WKV + (size_t)512 * 256, 512, 256, E, smem_phys); }
}

struct EpiGate {
    static constexpr bool PERM = false, AFTER_DRAIN = false;
    bf16_t* gs0; bf16_t* gs1;
    __device__ __forceinline__ void operator()(const pg8::f32x4 (&acc)[2][2][4][2], const pg8::Unit& u, int wr, int wc, int fr, int fq) const {
        const int br = u.pn >> 2;
        bf16_t* dst = (br == 0 ? gs0 : gs1 + (size_t)(br - 1) * T_TOK * 1024) + (u.pn & 3) * 256 + wc * 32 + fq * 4;
        const int row0 = u.pm * 256 + wr * 64 + fr;
#pragma unroll
        for (int ai = 0; ai < 2; ++ai)
#pragma unroll
            for (int m = 0; m < 4; ++m) {
                bf16_t* rowp = dst + (size_t)(row0 + ai * 128 + m * 16) * 1024;
#pragma unroll
                for (int bj = 0; bj < 2; ++bj)
#pragma unroll
                    for (int n = 0; n < 2; ++n) { const pg8::f32x4 v = acc[ai][bj][m][n]; u32x2 pk; pk.x = pack_bf16(sigmoidf_(v[0]), sigmoidf_(v[1])); pk.y = pack_bf16(sigmoidf_(v[2]), sigmoidf_(v[3])); *(u32x2*)(rowp + bj * 128 + n * 16) = pk; }
            }
    }
};
DI void phase_gate(KargPtr p, int l, unsigned char* smem_phys) {
    EpiGate E; E.gs0 = p->gs0; E.gs1 = p->gs1;
    big_gemm<EpiGate, false>(p->u, p->wt + (size_t)l * W_LAYER + W_GATE, 3072, 1024, E, smem_phys);
}
DI void phase_merge(KargPtr p, int l, unsigned char* smem) {
    const int tid = tidx(), lane = tid & 63, w = tid >> 6, wm = w >> 1, wn = w & 1, r = lane & 31, hh = lane >> 5;
    const bf16_t* WL = p->wt + (size_t)l * W_LAYER;
    for (int it = 0;; ++it) {
        int mt, nt; if (!next_tile(it, 256, 8, mt, nt)) break;
        const int m0 = mt * 128;
        f32x16 mer[2][2]; zero_acc(mer);
#pragma unroll 1
        for (int br = 0; br < 3; ++br) {
            f32x16 acc[2][2]; zero_acc(acc);
            const bf16_t* Y = (br == 0 ? p->qf : br == 1 ? p->qn : p->qs) + (size_t)m0 * 512;
            const bf16_t* WO = WL + (br == 0 ? W_OF : br == 1 ? W_OM : W_OS) + (size_t)nt * 128 * 512;
            gemm_mainloop<64>(WO, 512, Y, 512, 512, acc, smem);
            const bf16_t* G = (br == 0 ? p->gs0 : p->gs1 + (size_t)(br - 1) * T_TOK * 1024) + (size_t)(m0 + wn * 64 + r) * 1024 + nt * 128 + wm * 64 + 4 * hh;
            u32x2 gv[2][2][4];
#pragma unroll
            for (int a = 0; a < 2; ++a)
#pragma unroll
                for (int c = 0; c < 2; ++c)
#pragma unroll
                    for (int g = 0; g < 4; ++g) gv[a][c][g] = *(const u32x2*)(G + (size_t)c * 32 * 1024 + a * 32 + 8 * g);
#pragma unroll
            for (int a = 0; a < 2; ++a)
#pragma unroll
                for (int c = 0; c < 2; ++c)
#pragma unroll
                    for (int g = 0; g < 4; ++g) {
                        const unsigned x0 = gv[a][c][g].x, x1 = gv[a][c][g].y;
                        mer[a][c][4 * g]     += __uint_as_float(x0 << 16) * acc[a][c][4 * g];
                        mer[a][c][4 * g + 1] += __uint_as_float(x0 & 0xffff0000u) * acc[a][c][4 * g + 1];
                        mer[a][c][4 * g + 2] += __uint_as_float(x1 << 16) * acc[a][c][4 * g + 2];
                        mer[a][c][4 * g + 3] += __uint_as_float(x1 & 0xffff0000u) * acc[a][c][4 * g + 3];
                    }
        }
        stage_store_128(mer, p->merged + (size_t)m0 * 1024 + nt * 128, 1024, smem);
    }
}

DI void phase_outproj(KargPtr p, int l, unsigned char* smem_phys) {
    EpiResidual E; E.xin = (l == 0) ? p->x : p->out; E.xout = p->out; E.modl = p->mod + (size_t)l * 8 * 6144; E.gidx = 2;
    big_gemm(p->merged, p->wt + (size_t)l * W_LAYER + W_OUT, 1024, 1024, E, smem_phys);
}
DI void phase_ffn_up(KargPtr p, int l, unsigned char* smem_phys) {
    EpiFfnUp E; E.h = p->h;
    big_gemm(p->u, p->wt + (size_t)l * W_LAYER + W_FGU, 5632, 1024, E, smem_phys);
}
DI void phase_ffn_down(KargPtr p, int l, unsigned char* smem_phys) {
    EpiResidual E; E.xin = p->out; E.xout = p->out; E.modl = p->mod + (size_t)l * 8 * 6144; E.gidx = 5;
    big_gemm(p->h, p->wt + (size_t)l * W_LAYER + W_FD, 1024, 2816, E, smem_phys);
}

DI void run_phase(int ph, int l, unsigned char* smem_phys) {
#ifdef ONLY_PH
    if (ph != ONLY_PH) return;
#endif
    KargPtr p = karg();
    unsigned char* smem = smem_phys + vhalf() * VSMEM;
    switch (ph) {
    case 0: phase_prep(p, smem); break;
    case 1: if (bidx() == 0 && tidx() < 64) __hip_atomic_store((unsigned*)p->kmax + tidx(), 0u, __ATOMIC_RELAXED, __HIP_MEMORY_SCOPE_AGENT);
            phase_norm((l == 0) ? p->x : p->out, p->g_mix + l * 1024, p->mod + (size_t)l * 8 * 6144, 0, 1, p->u); break;
    case 2: phase_inproj(p, l, smem_phys); break;
    case 3: phase_mla_up(p, l, smem); break;
    case 4: phase_attn(p, smem); break;
    case 5: phase_merge(p, l, smem); break;
    case 12: phase_gate(p, l, smem_phys); break;
    case 13: phase_mla_gemm(p, l, smem_phys); break;
    case 6: phase_outproj(p, l, smem_phys); break;
    case 7: phase_norm(p->out, p->g_ffn + l * 1024, p->mod + (size_t)l * 8 * 6144, 3, 4, p->u); break;
    case 8: phase_ffn_up(p, l, smem_phys); break;
    case 9: phase_ffn_down(p, l, smem_phys); break;
    default: phase_final(p); break;
    }
}

#define XB_TMO      128
#define XB_XCNT(j)  (256  + 64 * (j))
#define XB_XSUB(j)  (1280 + 64 * (j))
#define XB_XGEN(j)  (2304 + 64 * (j))
#define XB_TOP      3328
#define XB_TOPGEN   3392
#define XCD_BAR_WORDS 3456
#define XB_SPIN_CAP (1u << 20)
#define LAS __attribute__((address_space(3)))
DI unsigned xb_ld(unsigned* p)              { return __hip_atomic_load(p, __ATOMIC_RELAXED, __HIP_MEMORY_SCOPE_AGENT); }
DI unsigned xb_add(unsigned* p, unsigned v) { return __hip_atomic_fetch_add(p, v, __ATOMIC_RELAXED, __HIP_MEMORY_SCOPE_AGENT); }
DI unsigned xb_xcc_id() { return (unsigned)__builtin_amdgcn_s_getreg((3 << 11) | 20) & 0xFu; }
#define XB_SPIN(cond, bar) do { unsigned _sp = 0; while (cond) { __builtin_amdgcn_s_sleep(1); \
    if ((++_sp & 255u) == 0u) { if (xb_ld(&(bar)[XB_TMO])) break; if (_sp > XB_SPIN_CAP) { atomicAdd(&(bar)[XB_TMO], 1u); break; } } } } while (0)
struct XcdBarrier { unsigned* bar; unsigned x; volatile LAS unsigned* st; };
DI XcdBarrier xcd_barrier_post(unsigned* bar, volatile LAS unsigned* st) {
    XcdBarrier b; b.bar = bar; b.x = xb_xcc_id(); b.st = st;
    if (threadIdx.x == 0) (void)xb_add(&bar[XB_XCNT(b.x)], 1u);
    return b;
}
DI void xcd_barrier_complete(unsigned* bar, unsigned x, unsigned& nloc, unsigned& nx) {
    const unsigned G = gridDim.x * gridDim.y * gridDim.z;
    unsigned sum, cnt, mine, sp = 0u;
    for (;;) {
        sum = 0u; cnt = 0u; mine = 0u;
#pragma unroll
        for (unsigned j = 0; j < 16; ++j) { const unsigned c = xb_ld(&bar[XB_XCNT(j)]); sum += c; cnt += (c > 0u) ? 1u : 0u; mine = (j == x) ? c : mine; }
        if (sum == G) break;
        __builtin_amdgcn_s_sleep(1);
        if ((++sp & 255u) == 0u) { if (xb_ld(&bar[XB_TMO])) break; if (sp > XB_SPIN_CAP) { atomicAdd(&bar[XB_TMO], 1u); break; } }
    }
    nloc = mine > 0u ? mine : 1u; nx = cnt > 0u ? cnt : 1u;
}
DI void xcd_barrier(const XcdBarrier& b) {
    asm volatile("s_waitcnt vmcnt(0)" ::: "memory");
    __syncthreads();
    if (threadIdx.x == 0) {
        unsigned* bar = b.bar;
        __builtin_amdgcn_s_waitcnt(0);
        unsigned nloc = b.st[0], nx = b.st[1];
        if (nloc == 0u) { xcd_barrier_complete(bar, b.x, nloc, nx); b.st[0] = nloc; b.st[1] = nx; }
        const unsigned old = xb_add(&bar[XB_XSUB(b.x)], 1u);
        const unsigned gen = old / nloc;
        if (old + 1u == (gen + 1u) * nloc) {
            __builtin_amdgcn_fence(__ATOMIC_RELEASE, "agent");
            asm volatile("s_waitcnt vmcnt(0)" ::: "memory");
            const unsigned og = xb_add(&bar[XB_TOP], 1u);
            const unsigned tg = og / nx;
            if (og + 1u == (tg + 1u) * nx) xb_add(&bar[XB_TOPGEN], 1u);
            else XB_SPIN(xb_ld(&bar[XB_TOPGEN]) == tg, bar);
            __builtin_amdgcn_fence(__ATOMIC_ACQUIRE, "agent");
            xb_add(&bar[XB_XGEN(b.x)], 1u);
            asm volatile("s_waitcnt vmcnt(0)" ::: "memory");
        } else {
            XB_SPIN(xb_ld(&bar[XB_XGEN(b.x)]) == gen, bar);
            __builtin_amdgcn_fence(__ATOMIC_ACQUIRE, "agent");
            asm volatile("s_waitcnt vmcnt(0)" ::: "memory");
        }
    }
    __syncthreads();
}

#if MEGA
__global__ void __launch_bounds__(512, 2) __attribute__((amdgpu_waves_per_eu(2, 2))) mega_kernel(Params p) {
    extern __shared__ __attribute__((aligned(16))) unsigned char smem[];
    cg::grid_group grid = cg::this_grid();
    volatile LAS unsigned* st = (volatile LAS unsigned*)(smem + SMEM_BYTES - 16);
    if (threadIdx.x == 0) { st[0] = 0u; st[1] = 0u; }
    __syncthreads();
    (void)xcd_barrier_post(karg()->bar, st);
#define xb (XcdBarrier{karg()->bar, xb_xcc_id(), (volatile LAS unsigned*)(smem + SMEM_BYTES - 16)})
    run_phase(0, 0, smem);
    grid.sync();
#pragma unroll 1
    for (int l = 0; l < 2; ++l) {
#pragma unroll 1
        for (int ph = 1; ph <= 9; ++ph) {
            if (ph == 4) { run_phase(13, l, smem); xcd_barrier(xb); }
            if (ph == 5) { run_phase(12, l, smem); xcd_barrier(xb); }
            run_phase(ph, l, smem); xcd_barrier(xb);
#ifdef DBL_PH
            if (ph == DBL_PH) { run_phase(ph, l, smem); xcd_barrier(xb); }
#endif
        }
    }
    run_phase(10, 0, smem);
}
#else
__global__ void __launch_bounds__(512, 2) __attribute__((amdgpu_waves_per_eu(2, 2))) phase_kernel(Params p, int ph, int l) {
    extern __shared__ __attribute__((aligned(16))) unsigned char smem[];
    run_phase(ph, l, smem);
}
#endif

extern "C" void kernel_launch(void* const* d_in, const int* in_sizes, int n_in, void* d_out, int out_size, void* d_ws, size_t ws_size, hipStream_t stream) {
    (void)in_sizes; (void)n_in; (void)out_size;
    Params p{};
    p.x = (const float*)d_in[0]; p.c = (const float*)d_in[1]; p.pos = (const int*)d_in[2];
    p.g_mix = (const float*)d_in[3]; p.w_ada = (const float*)d_in[4]; p.b_ada = (const float*)d_in[5]; p.w_in = (const float*)d_in[6]; p.b_fox_f = (const float*)d_in[7];
    p.g_mla_q = (const float*)d_in[8]; p.w_mla_uq = (const float*)d_in[9]; p.g_mla_kv = (const float*)d_in[10]; p.w_mla_ukv = (const float*)d_in[11];
    p.w_o_fox = (const float*)d_in[12]; p.w_o_mla = (const float*)d_in[13]; p.w_o_sb = (const float*)d_in[14]; p.w_out = (const float*)d_in[15];
    p.g_ffn = (const float*)d_in[16]; p.w_ffn_gate = (const float*)d_in[17]; p.w_ffn_up = (const float*)d_in[18]; p.w_ffn_down = (const float*)d_in[19]; p.g_final = (const float*)d_in[20];
    p.out = (float*)d_out;
    unsigned char* ws = (unsigned char*)d_ws; size_t off = 0;
    auto take = [&](size_t bytes) { unsigned char* q = ws + off; off += (bytes + 255) & ~(size_t)255; return q; };
    p.bar = (unsigned*)take(16384);
    p.kmax = (float*)take(256);
    p.rsq = (float*)take((size_t)T_TOK * 4);
    p.rskv = (float*)take((size_t)T_TOK * 4);
    p.wt = (bf16_t*)take(2 * W_LAYER * 2);
    p.mod = (float*)take(2 * 8 * 6144 * 4);
    p.ropetab = (float*)take((size_t)T_TOK * 16 * 2 * 4);
    p.logf = (float*)take((size_t)64 * SEQ * 4);
    p.cum = (float*)take((size_t)64 * SEQ * 4);
    p.u = (bf16_t*)take((size_t)T_TOK * 1024 * 2);
    p.qf = (bf16_t*)take((size_t)T_TOK * 512 * 2);
    p.kf = (bf16_t*)take((size_t)T_TOK * 512 * 2);
    p.vtf = (bf16_t*)take((size_t)T_TOK * 512 * 2);
    p.qs = (bf16_t*)take((size_t)T_TOK * 512 * 2);
    p.ks = (bf16_t*)take((size_t)T_TOK * 512 * 2);
    p.vts = (bf16_t*)take((size_t)T_TOK * 512 * 2);
    p.qn = (bf16_t*)take((size_t)T_TOK * 512 * 2);
    p.ql = (bf16_t*)take((size_t)T_TOK * 384 * 2);
    p.kvl = (bf16_t*)take((size_t)T_TOK * 256 * 2);
    p.kr = (bf16_t*)take((size_t)T_TOK * 32 * 2);
    p.qr = (bf16_t*)take((size_t)T_TOK * 256 * 2);
    p.kn = (bf16_t*)take((size_t)T_TOK * 512 * 2);
    p.vtm = (bf16_t*)take((size_t)T_TOK * 512 * 2);
    (void)take((size_t)8 << 20);
    p.gs0 = p.ks;
    p.gs1 = p.ql;
    p.gs2 = p.ql + (size_t)T_TOK * 1024;
    p.merged = p.kf;
    p.h = p.qf;
    if (off > ws_size) { fprintf(stderr, "kernel_launch: workspace too small: need %zu, have %zu\n", off, ws_size); return; }

#if MEGA
    static int grid_blocks = 0;
    if (!grid_blocks) {
        int dev = 0, cus = 0, per_cu = 0;
        (void)hipGetDevice(&dev);
        (void)hipDeviceGetAttribute(&cus, hipDeviceAttributeMultiprocessorCount, dev);
        (void)hipFuncSetAttribute((const void*)mega_kernel, hipFuncAttributeMaxDynamicSharedMemorySize, SMEM_BYTES);
        (void)hipOccupancyMaxActiveBlocksPerMultiprocessor(&per_cu, (const void*)mega_kernel, 512, SMEM_BYTES);
        per_cu = 1;
        grid_blocks = cus * per_cu;
        grid_blocks &= ~7;
    }
    (void)hipMemsetAsync(p.bar, 0, 16384, stream);
    void* args[] = {&p};
    hipError_t e = hipLaunchCooperativeKernel((const void*)mega_kernel, dim3(grid_blocks), dim3(512), args, SMEM_BYTES, stream);
    if (e != hipSuccess) fprintf(stderr, "cooperative launch failed: %s (grid %d)\n", hipGetErrorString(e), grid_blocks);
#else
    static bool attr = false;
    if (!attr) { (void)hipFuncSetAttribute((const void*)phase_kernel, hipFuncAttributeMaxDynamicSharedMemorySize, SMEM_BYTES); attr = true; }
    const int G = 512;
    hipLaunchKernelGGL(phase_kernel, dim3(G), dim3(256), SMEM_BYTES, stream, p, 0, 0);
    for (int l = 0; l < 2; ++l)
        for (int ph = 1; ph <= 9; ++ph) hipLaunchKernelGGL(phase_kernel, dim3(G), dim3(256), SMEM_BYTES, stream, p, ph, l);
    hipLaunchKernelGGL(phase_kernel, dim3(G), dim3(256), SMEM_BYTES, stream, p, 10, 0);
#endif
}
```

```cpp
#include <hip/hip_runtime.h>
#include <hip/hip_cooperative_groups.h>
#include <cstdint>
#include <cstdio>
namespace cg = cooperative_groups;

#ifndef MEGA
#define MEGA 1
#endif

typedef unsigned short bf16_t;
typedef short bf16x8 __attribute__((ext_vector_type(8)));
typedef float f32x16 __attribute__((ext_vector_type(16)));
typedef float f32x4 __attribute__((ext_vector_type(4)));
typedef unsigned u32x2 __attribute__((ext_vector_type(2)));
#define DI __device__ __forceinline__
typedef unsigned u32x4 __attribute__((ext_vector_type(4)));
#define GLOAD16(dst, ptr) asm volatile("global_load_dwordx4 %0, %1, off" : "=v"(dst) : "v"(ptr))
#define GLOAD4(dst, ptr)  asm volatile("global_load_dword %0, %1, off" : "=v"(dst) : "v"(ptr))
#define MFMA(a, b, c) __builtin_amdgcn_mfma_f32_32x32x16_bf16((a), (b), (c), 0, 0, 0)

namespace pg8 {
#define PG8_LAS __attribute__((address_space(3)))
typedef unsigned short bf16_t;
typedef short bf16x8 __attribute__((ext_vector_type(8)));
typedef float f32x4 __attribute__((ext_vector_type(4)));
typedef unsigned u32x4 __attribute__((ext_vector_type(4)));
constexpr int BM = 256, BK = 64, HALF = 128, HTB = HALF * BK * 2  , STAGE_BYTES = 8 * HTB, NXCD = 8, WGM = 8;

__host__ __device__ __forceinline__ int lds_byte(int r, int c) { const int st = (r >> 4) * 2 + (c >> 5), rr = r & 15, cc = c & 31, ob = rr * 64 + cc * 2; return st * 1024 + (ob ^ (((ob >> 9) & 1) << 5)); }
__host__ __device__ __forceinline__ void stage_rc(int b, int& R, int& C) { const int st = b / 1024, sb = b % 1024, swz = sb ^ (((sb >> 9) & 1) << 5); R = (st >> 1) * 16 + swz / 64; C = (st & 1) * 32 + (swz % 64) / 2; }
__host__ __device__ __forceinline__ int perm32(int rho) { const int n = rho >> 4, i = rho & 15; return 8 * (i >> 2) + 4 * n + (i & 3); }

struct Unit { int pm, pn; };
struct Gemm { const bf16_t* A; const bf16_t* Bt; int M, N, K; };

struct StaticOrder {
    int nM, nN, nwg, G, c;
    __host__ __device__ void init(int M, int N, int G_, int c_) { nM = M / BM; nN = N / BM; nwg = nM * nN; G = G_; c = c_; }
    __host__ __device__ bool next(int i, Unit& u) const {
        const long L = (long)i * G + c; if (L >= nwg) return false;
        int wgid = (int)L; { const int q = nwg / NXCD, r = nwg % NXCD, xcd = wgid % NXCD, off = wgid / NXCD; wgid = (xcd < r ? xcd * (q + 1) : r * (q + 1) + (xcd - r) * q) + off; }
        const int nig = WGM * nN, gid = wgid / nig, fm = gid * WGM, gsz = (nM - fm) < WGM ? (nM - fm) : WGM;
        u.pm = fm + ((wgid % nig) % gsz); u.pn = (wgid % nig) / gsz; return true;
    }
    __device__ __forceinline__ void a_ready(const Unit&) const {}
    __device__ __forceinline__ void done(const Unit&) const {}
};
template <class Epi, class Sched, bool ALIGN_EPI = false, bool SP2 = false, bool NAT = false>
__device__ __forceinline__ void gemm_phase(PG8_LAS unsigned char* lds, const Gemm g, const Sched& S, const Epi& E) {
    int tid = threadIdx.x; asm volatile("" : "+v"(tid)); const int wid = __builtin_amdgcn_readfirstlane(tid >> 6), lane = tid & 63, wr = wid >> 2, wc = wid & 3, fr = lane & 15, fq = lane >> 4;
    const int K = g.K, nt = K / BK;
    unsigned voffA[2], voffB[2];
#pragma unroll
    for (int i = 0; i < 2; ++i) { int R, C; stage_rc(tid * 16 + i * 8192, R, C); const int Rb = Epi::PERM ? ((R & ~31) + perm32(R & 31)) : R;
        voffA[i] = (unsigned)(R * K + C) * 2u; voffB[i] = (unsigned)(Rb * K + C) * 2u; }
    const size_t kstep = (size_t)(BK * 2);
    const size_t hstep = (size_t)HALF * K * 2;
    const size_t tstep = 2 * hstep;
    const unsigned ldsw = (unsigned)wid * 1024u;
    const int aoff = lds_byte(wr * 64 + fr, fq * 8), boff = lds_byte(wc * 32 + fr, fq * 8);
#define PG8_SA(b, h) (((b) * 2 + (h)) * HTB)
#define PG8_SB(b, h) ((4 + (b) * 2 + (h)) * HTB)
#define PG8_STAGE(bufoff, gbase, voff) do { _Pragma("unroll") for (int _i = 0; _i < 2; ++_i) \
        __builtin_amdgcn_global_load_lds((const unsigned*)((const char*)(gbase) + (voff)[_i]), (PG8_LAS unsigned*)(lds + (bufoff) + ldsw + _i * 8192), 16, 0, 0); } while (0)
#define PG8_LDA(dst, b, h) do { _Pragma("unroll") for (int m = 0; m < 4; ++m) _Pragma("unroll") for (int k = 0; k < 2; ++k) dst[m][k] = *(const PG8_LAS bf16x8*)(lds + PG8_SA(b, h) + aoff + m * 2048 + k * 1024); } while (0)
#define PG8_LDB(dst, b, h) do { _Pragma("unroll") for (int n = 0; n < 2; ++n) _Pragma("unroll") for (int k = 0; k < 2; ++k) dst[n][k] = *(const PG8_LAS bf16x8*)(lds + PG8_SB(b, h) + boff + n * 2048 + k * 1024); } while (0)
#define PG8_MMA(ai, bj, At, Bt) do { __builtin_amdgcn_s_setprio(1); _Pragma("unroll") for (int m = 0; m < 4; ++m) _Pragma("unroll") for (int n = 0; n < 2; ++n) _Pragma("unroll") for (int k = 0; k < 2; ++k) \
        acc[ai][bj][m][n] = NAT ? __builtin_amdgcn_mfma_f32_16x16x32_bf16(At[m][k], Bt[n][k], acc[ai][bj][m][n], 0, 0, 0) : __builtin_amdgcn_mfma_f32_16x16x32_bf16(Bt[n][k], At[m][k], acc[ai][bj][m][n], 0, 0, 0); __builtin_amdgcn_s_setprio(0); } while (0)
#define PG8_WAIT_V(n) asm volatile("s_waitcnt vmcnt(" #n ")" ::: "memory")
#define PG8_WAIT_L(n) asm volatile("s_waitcnt lgkmcnt(" #n ")" ::: "memory")
#define PG8_BAR __builtin_amdgcn_s_barrier()
#define PG8_SCHED __builtin_amdgcn_sched_barrier(0)
    Unit cur, nxt; int ui = 0;
    if (!S.next(0, cur)) return;
    f32x4 acc[2][2][4][2];
#pragma unroll
    for (int a = 0; a < 2; ++a)
#pragma unroll
        for (int b = 0; b < 2; ++b)
#pragma unroll
            for (int m = 0; m < 4; ++m)
#pragma unroll
                for (int n = 0; n < 2; ++n) acc[a][b][m][n] = (f32x4){0.f, 0.f, 0.f, 0.f};
    bf16x8 At[4][2], B0[2][2], B1[2][2];
    const char* cA = (const char*)g.A + (size_t)cur.pm * tstep; const char* cB = (const char*)g.Bt + (size_t)cur.pn * tstep;
    S.a_ready(cur);
    if constexpr (SP2) {
        PG8_STAGE(PG8_SB(0, 0), cB, voffB); PG8_STAGE(PG8_SB(0, 1), cB + hstep, voffB); PG8_STAGE(PG8_SA(0, 0), cA, voffA); PG8_STAGE(PG8_SA(0, 1), cA + hstep, voffA);
        if (wr == 1) PG8_BAR;
        PG8_WAIT_V(2); PG8_BAR;
        PG8_STAGE(PG8_SB(1, 0), cB + kstep, voffB); PG8_STAGE(PG8_SA(1, 0), cA + kstep, voffA); PG8_STAGE(PG8_SB(1, 1), cB + hstep + kstep, voffB);
        PG8_WAIT_V(6); PG8_BAR;
    } else {
        PG8_STAGE(PG8_SB(0, 0), cB, voffB); PG8_STAGE(PG8_SA(0, 0), cA, voffA); PG8_STAGE(PG8_SB(0, 1), cB + hstep, voffB); PG8_STAGE(PG8_SA(0, 1), cA + hstep, voffA);
        if (wr == 1) PG8_BAR;
        PG8_WAIT_V(4); PG8_BAR;
        PG8_STAGE(PG8_SB(1, 0), cB + kstep, voffB); PG8_STAGE(PG8_SA(1, 0), cA + kstep, voffA); PG8_STAGE(PG8_SB(1, 1), cB + hstep + kstep, voffB);
        PG8_WAIT_V(6); PG8_BAR;
    }
    for (;;) {
        const bool has_next = S.next(ui + 1, nxt);
        const char* nA = has_next ? (const char*)g.A + (size_t)nxt.pm * tstep : cA; const char* nB = has_next ? (const char*)g.Bt + (size_t)nxt.pn * tstep : cB;
        for (int t = 0; t < nt; t += 2) {
            const bool last = (t == nt - 2);
            const char* a1 = cA + (size_t)(t + 1) * kstep;
            const char* a2 = last ? nA : cA + (size_t)(t + 2) * kstep; const char* b2 = last ? nB : cB + (size_t)(t + 2) * kstep;
            const char* a3 = a2 + kstep; const char* b3 = b2 + kstep;
            if (last && has_next) S.a_ready(nxt);
            if constexpr (SP2) {
            PG8_LDB(B0, 0, 0); PG8_LDB(B1, 0, 1); PG8_SCHED; PG8_LDA(At, 0, 0); PG8_STAGE(PG8_SA(1, 1), a1 + hstep, voffA);
            PG8_WAIT_V(8); PG8_WAIT_L(0); PG8_BAR; PG8_MMA(0, 0, At, B0); PG8_MMA(0, 1, At, B1); PG8_BAR; PG8_SCHED;
            PG8_LDA(At, 0, 1); PG8_STAGE(PG8_SB(0, 0), b2, voffB); PG8_STAGE(PG8_SB(0, 1), b2 + hstep, voffB); PG8_STAGE(PG8_SA(0, 0), a2, voffA);
            PG8_WAIT_V(8); PG8_WAIT_L(0); PG8_BAR; PG8_MMA(1, 0, At, B0); PG8_MMA(1, 1, At, B1); PG8_BAR; PG8_SCHED;
            PG8_LDB(B0, 1, 0); PG8_LDB(B1, 1, 1); PG8_SCHED; PG8_LDA(At, 1, 0); PG8_STAGE(PG8_SA(0, 1), a2 + hstep, voffA);
            PG8_WAIT_V(8); PG8_WAIT_L(0); PG8_BAR; PG8_MMA(0, 0, At, B0); PG8_MMA(0, 1, At, B1); PG8_BAR; PG8_SCHED;
            PG8_LDA(At, 1, 1); PG8_STAGE(PG8_SB(1, 0), b3, voffB); PG8_STAGE(PG8_SB(1, 1), b3 + hstep, voffB); PG8_STAGE(PG8_SA(1, 0), a3, voffA);
            PG8_WAIT_V(8); PG8_WAIT_L(0); PG8_BAR; PG8_MMA(1, 0, At, B0); PG8_MMA(1, 1, At, B1); PG8_BAR; PG8_SCHED;
            } else {
            PG8_LDB(B0, 0, 0); PG8_SCHED; PG8_LDA(At, 0, 0); PG8_STAGE(PG8_SA(1, 1), a1 + hstep, voffA);
            PG8_WAIT_L(8); PG8_BAR; PG8_WAIT_L(0); PG8_MMA(0, 0, At, B0); PG8_BAR; PG8_SCHED;
            PG8_LDB(B1, 0, 1); PG8_STAGE(PG8_SB(0, 0), b2, voffB);
            PG8_BAR; PG8_WAIT_L(0); PG8_MMA(0, 1, At, B1); PG8_BAR;
            PG8_LDA(At, 0, 1); PG8_STAGE(PG8_SA(0, 0), a2, voffA);
            PG8_BAR; PG8_WAIT_L(0); PG8_MMA(1, 0, At, B0); PG8_BAR; PG8_SCHED;
            PG8_STAGE(PG8_SB(0, 1), b2 + hstep, voffB);
            PG8_WAIT_V(6); PG8_BAR; PG8_MMA(1, 1, At, B1); PG8_BAR;
            PG8_LDB(B0, 1, 0); PG8_SCHED; PG8_LDA(At, 1, 0); PG8_STAGE(PG8_SA(0, 1), a2 + hstep, voffA);
            PG8_WAIT_L(8); PG8_BAR; PG8_WAIT_L(0); PG8_MMA(0, 0, At, B0); PG8_BAR; PG8_SCHED;
            PG8_LDB(B1, 1, 1); PG8_STAGE(PG8_SB(1, 0), b3, voffB);
            PG8_BAR; PG8_WAIT_L(0); PG8_MMA(0, 1, At, B1); PG8_BAR;
            PG8_LDA(At, 1, 1); PG8_STAGE(PG8_SA(1, 0), a3, voffA);
            PG8_BAR; PG8_WAIT_L(0); PG8_MMA(1, 0, At, B0); PG8_BAR; PG8_SCHED;
            PG8_STAGE(PG8_SB(1, 1), b3 + hstep, voffB);
            PG8_WAIT_V(6); PG8_BAR; PG8_MMA(1, 1, At, B1); PG8_BAR;
            }
        }
        if constexpr (ALIGN_EPI) { if (wr == 0) PG8_BAR; }
        if constexpr (!Epi::AFTER_DRAIN) { E(acc, cur, wr, wc, fr, fq); S.done(cur); }
        if (!has_next) break;
#pragma unroll
        for (int a = 0; a < 2; ++a)
#pragma unroll
            for (int b = 0; b < 2; ++b)
#pragma unroll
                for (int m = 0; m < 4; ++m)
#pragma unroll
                    for (int n = 0; n < 2; ++n) acc[a][b][m][n] = (f32x4){0.f, 0.f, 0.f, 0.f};
        cur = nxt; cA = nA; cB = nB; ++ui;
        if constexpr (ALIGN_EPI) { if (wr == 1) PG8_BAR; }
    }
    PG8_WAIT_V(0);
    if constexpr (!ALIGN_EPI) { if (wr == 0) PG8_BAR; }
    PG8_BAR;
    if constexpr (Epi::AFTER_DRAIN) { E.fused(acc, cur, wr, wc, fr, fq, lds, wid, lane); S.done(cur); }
#undef PG8_SA
#undef PG8_SB
#undef PG8_STAGE
#undef PG8_LDA
#undef PG8_LDB
#undef PG8_MMA
#undef PG8_WAIT_V
#undef PG8_WAIT_L
#undef PG8_BAR
#undef PG8_SCHED
}
}

constexpr int T_TOK = 32768;
constexpr int SEQ = 4096;
constexpr float LOG2E = 1.4426950408889634f;
constexpr float FOX_QS = 0.125f * 1.4426950408889634f;
constexpr float MLA_QS = 0.10206207261596575f * 1.4426950408889634f;
constexpr float EPS = 1e-6f;

constexpr size_t W_IN = 0, W_GATE = 4063232, W_UQ = 7208960, W_UKV = 7503872, W_OF = 7766016, W_OM = 8290304, W_OS = 8814592,
                 W_OUT = 9338880, W_FGU = 10387456, W_FD = 16154624, W_LAYER = 19038208;

constexpr int SMEM_BYTES = 2 * 74752 + 64 + 16;

struct Params {
    const float* x; const float* c; const int* pos;
    const float* g_mix; const float* w_ada; const float* b_ada; const float* w_in; const float* b_fox_f;
    const float* g_mla_q; const float* w_mla_uq; const float* g_mla_kv; const float* w_mla_ukv;
    const float* w_o_fox; const float* w_o_mla; const float* w_o_sb; const float* w_out;
    const float* g_ffn; const float* w_ffn_gate; const float* w_ffn_up; const float* w_ffn_down; const float* g_final;
    float* out;
    bf16_t* wt; float* mod; float* ropetab; float* logf; float* cum;
    bf16_t* u; bf16_t* qf; bf16_t* kf; bf16_t* vtf; bf16_t* qs; bf16_t* ks; bf16_t* vts;
    bf16_t* ql; bf16_t* kvl; bf16_t* kr; bf16_t* qn; bf16_t* qr; bf16_t* kn; bf16_t* vtm;
    bf16_t* merged; bf16_t* h;
    unsigned* bar; float* kmax;
    bf16_t* gs0; bf16_t* gs1; bf16_t* gs2;
    float* rsq; float* rskv;
};
typedef const __attribute__((address_space(4))) Params* KargPtr;
#if defined(__HIP_DEVICE_COMPILE__)
__device__ __forceinline__ KargPtr karg() { KargPtr pp = (KargPtr)__builtin_amdgcn_kernarg_segment_ptr(); asm volatile("" : "+s"(pp)); return pp; }
#else
__device__ __forceinline__ KargPtr karg() { return nullptr; }
#endif

__device__ double ROPE_POLY[11] = {-1.0 / 6, 1.0 / 120, -1.0 / 5040, 1.0 / 362880, -1.0 / 39916800,
    -0.5, 1.0 / 24, -1.0 / 720, 1.0 / 40320, -1.0 / 3628800, 1.0 / 479001600};
__device__ const float ROPE_INV[16] = {1.0f, 0.5623413324356079f, 0.3162277638912201f, 0.17782793939113617f, 0.10000000149011612f, 0.05623413249850273f,
    0.03162277489900589f, 0.017782794311642647f, 0.009999999776482582f, 0.005623413249850273f, 0.003162277629598975f, 0.0017782794311642647f,
    0.0010000000474974513f, 0.000562341301701963f, 0.0003162277571391314f, 0.00017782794020604342f};

typedef __bf16 bf16x2_t __attribute__((ext_vector_type(2)));
typedef float f32x2_t __attribute__((ext_vector_type(2)));
DI unsigned pack_bf16(float lo, float hi) { const f32x2_t v = {lo, hi}; const bf16x2_t b = __builtin_convertvector(v, bf16x2_t); return __builtin_bit_cast(unsigned, b); }
DI bf16_t f2bf(float x) { return (bf16_t)(pack_bf16(x, 0.f) & 0xffffu); }
DI int vhalf() { return __builtin_amdgcn_readfirstlane((int)(threadIdx.x >> 8)); }
DI int tidx() { int t = threadIdx.x & 255; asm volatile("" : "+v"(t)); return t; }
DI int bidx() { int t = __builtin_amdgcn_readfirstlane((int)(blockIdx.x * 2 + (threadIdx.x >> 8))); asm volatile("" : "+s"(t)); return t; }
DI int gdim() { int t = gridDim.x * 2; asm volatile("" : "+s"(t)); return t; }
constexpr int VSMEM = 74752;
constexpr int FLAGS_OFF = 2 * VSMEM;
DI float fexp2(float x) { return __builtin_amdgcn_exp2f(x); }
DI float flog2(float x) { return __builtin_amdgcn_logf(x); }
DI float frcp(float x) { return __builtin_amdgcn_rcpf(x); }
DI float sigmoidf_(float x) { return frcp(1.0f + fexp2(-x * LOG2E)); }

DI bool next_tile(int it, int MT, int NT, int& mt, int& nt) {
    const int perx = gdim() >> 3, xcd = bidx() & 7, slot = bidx() >> 3;
    const long L = ((long)it * 8 + xcd) * perx + slot;
    if (L >= (long)MT * NT) return false;
    const int gsz = 8 * NT; const int grp = (int)(L / gsz), wi = (int)(L % gsz);
    mt = grp * 8 + (wi & 7); nt = wi >> 3; return true;
}

template <int BK>
DI void gemm_mainloop(const bf16_t* A, int lda, const bf16_t* B, int ldb, int K, f32x16 (&acc)[2][2], unsigned char* smem) {
    constexpr int CPR = BK / 8;
    constexpr int RPP = 256 / CPR;
    constexpr int NJ = 128 / RPP;
    constexpr int ROWB = BK * 2 + 16;
    constexpr int OPB = 128 * ROWB;
    constexpr int STB = 2 * OPB;
    constexpr int PASSB = RPP * ROWB;
    const int tid = tidx(), lane = tid & 63, w = tid >> 6, wm = w >> 1, wn = w & 1, r = lane & 31, hh = lane >> 5;
    const int lrow = tid / CPR, lcol = (tid % CPR) * 8;
    const bf16_t* ap = A + (size_t)lrow * lda + lcol;
    const bf16_t* bp = B + (size_t)lrow * ldb + lcol;
    const size_t astep = (size_t)RPP * lda, bstep = (size_t)RPP * ldb;
    const int st_off = lrow * ROWB + (tid % CPR) * 16;
    u32x4 ra0, ra1, ra2, ra3, rb0, rb1, rb2, rb3;
    ra0 = *(const u32x4*)(ap); rb0 = *(const u32x4*)(bp);
    ra1 = *(const u32x4*)(ap + astep); rb1 = *(const u32x4*)(bp + bstep);
    if constexpr (NJ == 4) { ra2 = *(const u32x4*)(ap + 2 * astep); rb2 = *(const u32x4*)(bp + 2 * bstep); ra3 = *(const u32x4*)(ap + 3 * astep); rb3 = *(const u32x4*)(bp + 3 * bstep); }
    else { ra2 = ra0; ra3 = ra0; rb2 = rb0; rb3 = rb0; }
#define GEMM_STAGE(D_) do { unsigned char* d_ = (D_); \
        *(u32x4*)(d_) = ra0; *(u32x4*)(d_ + OPB) = rb0; *(u32x4*)(d_ + PASSB) = ra1; *(u32x4*)(d_ + OPB + PASSB) = rb1; \
        if constexpr (NJ == 4) { *(u32x4*)(d_ + 2 * PASSB) = ra2; *(u32x4*)(d_ + OPB + 2 * PASSB) = rb2; *(u32x4*)(d_ + 3 * PASSB) = ra3; *(u32x4*)(d_ + OPB + 3 * PASSB) = rb3; } } while (0)
    GEMM_STAGE(smem + st_off);
    __syncthreads();
    const int nk = K / BK;
    const int rdA = (wm * 64 + r) * ROWB + hh * 16;
    const int rdB = OPB + (wn * 64 + r) * ROWB + hh * 16;
#define GEMM_FRAGS(KS_, A0_, A1_, B0_, B1_) do { \
        A0_ = *(const bf16x8*)(sa + (KS_) * 32); A1_ = *(const bf16x8*)(sa + 32 * ROWB + (KS_) * 32); \
        B0_ = *(const bf16x8*)(sb + (KS_) * 32); B1_ = *(const bf16x8*)(sb + 32 * ROWB + (KS_) * 32); } while (0)
#define GEMM_MFMA4(A0_, A1_, B0_, B1_) do { \
        acc[0][0] = MFMA(A0_, B0_, acc[0][0]); acc[0][1] = MFMA(A0_, B1_, acc[0][1]); \
        acc[1][0] = MFMA(A1_, B0_, acc[1][0]); acc[1][1] = MFMA(A1_, B1_, acc[1][1]); } while (0)
#define GEMM_COMPUTE(BUF_) do { \
        const unsigned char* sa = smem + (BUF_) * STB + rdA; \
        const unsigned char* sb = smem + (BUF_) * STB + rdB; \
        bf16x8 fa0, fa1, fb0, fb1, ga0, ga1, gb0, gb1; \
        GEMM_FRAGS(0, fa0, fa1, fb0, fb1); \
        GEMM_FRAGS(1, ga0, ga1, gb0, gb1); \
        __builtin_amdgcn_sched_barrier(0); \
        GEMM_MFMA4(fa0, fa1, fb0, fb1); \
        if constexpr (BK == 64) { \
            __builtin_amdgcn_sched_barrier(0); \
            GEMM_FRAGS(2, fa0, fa1, fb0, fb1); \
            __builtin_amdgcn_sched_barrier(0); \
            GEMM_MFMA4(ga0, ga1, gb0, gb1); \
            __builtin_amdgcn_sched_barrier(0); \
            GEMM_FRAGS(3, ga0, ga1, gb0, gb1); \
            __builtin_amdgcn_sched_barrier(0); \
            GEMM_MFMA4(fa0, fa1, fb0, fb1); \
        } \
        __builtin_amdgcn_sched_barrier(0); \
        GEMM_MFMA4(ga0, ga1, gb0, gb1); \
    } while (0)
    for (int kt = 0; kt < nk - 1; ++kt) {
        const int buf = kt & 1;
        ap += BK; bp += BK;
        GLOAD16(ra0, ap); GLOAD16(rb0, bp); GLOAD16(ra1, ap + astep); GLOAD16(rb1, bp + bstep);
        if constexpr (NJ == 4) { GLOAD16(ra2, ap + 2 * astep); GLOAD16(rb2, bp + 2 * bstep); GLOAD16(ra3, ap + 3 * astep); GLOAD16(rb3, bp + 3 * bstep); }
        __builtin_amdgcn_sched_barrier(0);
        GEMM_COMPUTE(buf);
        __builtin_amdgcn_sched_barrier(0);
        if constexpr (NJ == 4) asm volatile("s_waitcnt vmcnt(0)" : "+v"(ra0), "+v"(rb0), "+v"(ra1), "+v"(rb1), "+v"(ra2), "+v"(rb2), "+v"(ra3), "+v"(rb3));
        else asm volatile("s_waitcnt vmcnt(0)" : "+v"(ra0), "+v"(rb0), "+v"(ra1), "+v"(rb1));
        GEMM_STAGE(smem + (buf ^ 1) * STB + st_off);
        __syncthreads();
    }
    GEMM_COMPUTE((nk - 1) & 1);
    __syncthreads();
#undef GEMM_COMPUTE
#undef GEMM_MFMA4
#undef GEMM_FRAGS
#undef GEMM_STAGE
}


DI void gemm_big(const bf16_t* P, int ldp, const bf16_t* Q, int ldq, int K, f32x16 (&acc)[2][4], unsigned char* smem) {
    constexpr int ROWB = 80, PB = 128 * ROWB, STB = 384 * ROWB, PASSB = 64 * ROWB;
    const int tid = tidx(), lane = tid & 63, w = tid >> 6, wm = w >> 1, wn = w & 1, r = lane & 31, hh = lane >> 5;
    const int lrow = tid >> 2, lcol = (tid & 3) * 8;
    const bf16_t* pp = P + (size_t)lrow * ldp + lcol;
    const bf16_t* qp = Q + (size_t)lrow * ldq + lcol;
    const size_t pstep = (size_t)64 * ldp, qstep = (size_t)64 * ldq;
    const int st_off = lrow * ROWB + (tid & 3) * 16;
    u32x4 rp0, rp1, rq0, rq1, rq2, rq3;
    rp0 = *(const u32x4*)(pp); rp1 = *(const u32x4*)(pp + pstep);
    rq0 = *(const u32x4*)(qp); rq1 = *(const u32x4*)(qp + qstep); rq2 = *(const u32x4*)(qp + 2 * qstep); rq3 = *(const u32x4*)(qp + 3 * qstep);
#define BIG_STAGE(D_) do { unsigned char* d_ = (D_); \
        *(u32x4*)(d_) = rp0; *(u32x4*)(d_ + PASSB) = rp1; \
        *(u32x4*)(d_ + PB) = rq0; *(u32x4*)(d_ + PB + PASSB) = rq1; *(u32x4*)(d_ + PB + 2 * PASSB) = rq2; *(u32x4*)(d_ + PB + 3 * PASSB) = rq3; } while (0)
    BIG_STAGE(smem + st_off);
    __syncthreads();
    const int nk = K >> 5;
    const int rdP = (wm * 64 + r) * ROWB + hh * 16;
    const int rdQ = PB + (wn * 128 + r) * ROWB + hh * 16;
#define BIG_FRAGS(KS_, A0_, A1_, B0_, B1_, B2_, B3_) do { \
        A0_ = *(const bf16x8*)(sp + (KS_) * 32); A1_ = *(const bf16x8*)(sp + 32 * ROWB + (KS_) * 32); \
        B0_ = *(const bf16x8*)(sq + (KS_) * 32); B1_ = *(const bf16x8*)(sq + 32 * ROWB + (KS_) * 32); \
        B2_ = *(const bf16x8*)(sq + 64 * ROWB + (KS_) * 32); B3_ = *(const bf16x8*)(sq + 96 * ROWB + (KS_) * 32); } while (0)
#define BIG_MFMA8(A0_, A1_, B0_, B1_, B2_, B3_) do { \
        acc[0][0] = MFMA(A0_, B0_, acc[0][0]); acc[0][1] = MFMA(A0_, B1_, acc[0][1]); acc[0][2] = MFMA(A0_, B2_, acc[0][2]); acc[0][3] = MFMA(A0_, B3_, acc[0][3]); \
        acc[1][0] = MFMA(A1_, B0_, acc[1][0]); acc[1][1] = MFMA(A1_, B1_, acc[1][1]); acc[1][2] = MFMA(A1_, B2_, acc[1][2]); acc[1][3] = MFMA(A1_, B3_, acc[1][3]); } while (0)
#define BIG_COMPUTE(BUF_) do { \
        const unsigned char* sp = smem + (BUF_) * STB + rdP; \
        const unsigned char* sq = smem + (BUF_) * STB + rdQ; \
        bf16x8 fa0, fa1, fb0, fb1, fb2, fb3, ga0, ga1, gb0, gb1, gb2, gb3; \
        BIG_FRAGS(0, fa0, fa1, fb0, fb1, fb2, fb3); \
        BIG_FRAGS(1, ga0, ga1, gb0, gb1, gb2, gb3); \
        __builtin_amdgcn_sched_barrier(0); \
        BIG_MFMA8(fa0, fa1, fb0, fb1, fb2, fb3); \
        __builtin_amdgcn_sched_barrier(0); \
        BIG_MFMA8(ga0, ga1, gb0, gb1, gb2, gb3); \
    } while (0)
    for (int kt = 0; kt < nk - 1; ++kt) {
        const int buf = kt & 1;
        pp += 32; qp += 32;
        GLOAD16(rp0, pp); GLOAD16(rq0, qp); GLOAD16(rp1, pp + pstep); GLOAD16(rq1, qp + qstep); GLOAD16(rq2, qp + 2 * qstep); GLOAD16(rq3, qp + 3 * qstep);
        __builtin_amdgcn_sched_barrier(0);
        BIG_COMPUTE(buf);
        __builtin_amdgcn_sched_barrier(0);
        asm volatile("s_waitcnt vmcnt(0)" : "+v"(rp0), "+v"(rp1), "+v"(rq0), "+v"(rq1), "+v"(rq2), "+v"(rq3));
        BIG_STAGE(smem + (buf ^ 1) * STB + st_off);
        __syncthreads();
    }
    BIG_COMPUTE((nk - 1) & 1);
    __syncthreads();
#undef BIG_COMPUTE
#undef BIG_MFMA8
#undef BIG_FRAGS
#undef BIG_STAGE
}
DI void zero_big(f32x16 (&acc)[2][4]) {
#pragma unroll
    for (int a = 0; a < 2; ++a)
#pragma unroll
        for (int b = 0; b < 4; ++b)
#pragma unroll
            for (int i = 0; i < 16; ++i) acc[a][b][i] = 0.f;
}
DI void stage_store_big(const f32x16 (&acc)[2][4], bf16_t* dst, int ld, unsigned char* smem) {
    const int tid = tidx(), lane = tid & 63, w = tid >> 6, wm = w >> 1, wn = w & 1, r = lane & 31, hh = lane >> 5;
#pragma unroll
    for (int qi = 0; qi < 4; ++qi) {
        unsigned char* trow = smem + (wn * 128 + qi * 32 + r) * 272 + (wm * 64 + 4 * hh) * 2;
#pragma unroll
        for (int pi = 0; pi < 2; ++pi)
#pragma unroll
            for (int g = 0; g < 4; ++g) {
                u32x2 pk; pk.x = pack_bf16(acc[pi][qi][4 * g], acc[pi][qi][4 * g + 1]); pk.y = pack_bf16(acc[pi][qi][4 * g + 2], acc[pi][qi][4 * g + 3]);
                *(u32x2*)(trow + (pi * 32 + 8 * g) * 2) = pk;
            }
    }
    __syncthreads();
    const int q0 = tid >> 4, x = tid & 15;
#pragma unroll
    for (int j = 0; j < 16; ++j) {
        const uint4 v = *(const uint4*)(smem + (q0 + 16 * j) * 272 + x * 16);
        *(uint4*)(dst + (size_t)(q0 + 16 * j) * ld + x * 8) = v;
    }
    __syncthreads();
}
DI void scale_big(f32x16 (&acc)[2][4], float sc) {
#pragma unroll
    for (int a = 0; a < 2; ++a)
#pragma unroll
        for (int b = 0; b < 4; ++b)
#pragma unroll
            for (int i = 0; i < 16; ++i) acc[a][b][i] *= sc;
}
DI void scale_big_q(f32x16 (&acc)[2][4], const float* rs, float sc) {
    const int lane = tidx() & 63, wn = (tidx() >> 6) & 1, r = lane & 31;
#pragma unroll
    for (int qi = 0; qi < 4; ++qi) { const float f = rs[wn * 128 + qi * 32 + r] * sc;
#pragma unroll
        for (int pi = 0; pi < 2; ++pi)
#pragma unroll
            for (int i = 0; i < 16; ++i) acc[pi][qi][i] *= f; }
}
DI void scale_big_p(f32x16 (&acc)[2][4], const float* rs) {
    const int lane = tidx() & 63, wm = tidx() >> 7, hh = lane >> 5;
#pragma unroll
    for (int pi = 0; pi < 2; ++pi)
#pragma unroll
        for (int g = 0; g < 4; ++g) { const f32x4 f = *(const f32x4*)(rs + wm * 64 + pi * 32 + 8 * g + 4 * hh);
#pragma unroll
            for (int qi = 0; qi < 4; ++qi)
#pragma unroll
                for (int e = 0; e < 4; ++e) acc[pi][qi][4 * g + e] *= f[e]; }
}
DI long tile_linear(int it, long total) {
    const int perx = gdim() >> 3, xcd = bidx() & 7, slot = bidx() >> 3;
    const long L = ((long)it * 8 + xcd) * perx + slot;
    return L < total ? L : -1;
}
DI void tile_decode(int L, int NT, int& mt, int& nt) { const int gsz = 8 * NT; const int grp = L / gsz, wi = L % gsz; mt = grp * 8 + (wi & 7); nt = wi >> 3; }

DI void zero_acc(f32x16 (&acc)[2][2]) {
#pragma unroll
    for (int a = 0; a < 2; ++a)
#pragma unroll
        for (int b = 0; b < 2; ++b)
#pragma unroll
            for (int i = 0; i < 16; ++i) acc[a][b][i] = 0.f;
}

DI void stage_store_128(const f32x16 (&acc)[2][2], bf16_t* dst, int ld, unsigned char* smem) {
    const int tid = tidx(), lane = tid & 63, w = tid >> 6, wm = w >> 1, wn = w & 1, r = lane & 31, hh = lane >> 5;
#pragma unroll
    for (int qi = 0; qi < 2; ++qi) {
        unsigned char* trow = smem + (wn * 64 + qi * 32 + r) * 272 + (wm * 64 + 4 * hh) * 2;
#pragma unroll
        for (int pi = 0; pi < 2; ++pi)
#pragma unroll
            for (int g = 0; g < 4; ++g) {
                u32x2 pk; pk.x = pack_bf16(acc[pi][qi][4 * g], acc[pi][qi][4 * g + 1]); pk.y = pack_bf16(acc[pi][qi][4 * g + 2], acc[pi][qi][4 * g + 3]);
                *(u32x2*)(trow + (pi * 32 + 8 * g) * 2) = pk;
            }
    }
    __syncthreads();
    const int q0 = tid >> 4, x = tid & 15;
#pragma unroll
    for (int j = 0; j < 8; ++j) {
        const uint4 v = *(const uint4*)(smem + (q0 + 16 * j) * 272 + x * 16);
        *(uint4*)(dst + (size_t)(q0 + 16 * j) * ld + x * 8) = v;
    }
    __syncthreads();
}
DI void stage_store_vt(const f32x16 (&acc)[2][2], bf16_t* vt, int b, int cv0, int s0, unsigned char* smem) {
    const int tid = tidx(), lane = tid & 63, w = tid >> 6, wm = w >> 1, wn = w & 1, r = lane & 31, hh = lane >> 5;
#pragma unroll
    for (int qi = 0; qi < 2; ++qi) {
        unsigned char* trow = smem + (wn * 64 + qi * 32 + r) * 272 + (wm * 64 + 4 * hh) * 2;
#pragma unroll
        for (int pi = 0; pi < 2; ++pi)
#pragma unroll
            for (int g = 0; g < 4; ++g) {
                u32x2 pk; pk.x = pack_bf16(acc[pi][qi][4 * g], acc[pi][qi][4 * g + 1]); pk.y = pack_bf16(acc[pi][qi][4 * g + 2], acc[pi][qi][4 * g + 3]);
                *(u32x2*)(trow + (pi * 32 + 8 * g) * 2) = pk;
            }
    }
    __syncthreads();
    const int q0 = tid >> 4, x = tid & 15;
#pragma unroll
    for (int j = 0; j < 8; ++j) {
        const int cv = cv0 + q0 + 16 * j, sq = s0 + 8 * x;
        const uint4 v = *(const uint4*)(smem + (q0 + 16 * j) * 272 + x * 16);
        *(uint4*)(vt + (size_t)(b * 8 + (cv >> 6)) * SEQ * 64 + (size_t)(sq >> 6) * 4096 + (cv & 63) * 64 + (sq & 63)) = v;
    }
    __syncthreads();
}
DI void scale_acc(f32x16 (&acc)[2][2], float sc) {
#pragma unroll
    for (int a = 0; a < 2; ++a)
#pragma unroll
        for (int b = 0; b < 2; ++b)
#pragma unroll
            for (int i = 0; i < 16; ++i) acc[a][b][i] *= sc;
}
DI void scale_acc_q(f32x16 (&acc)[2][2], const float* rs, float sc) {
    const int lane = tidx() & 63, wn = (tidx() >> 6) & 1, r = lane & 31;
#pragma unroll
    for (int qi = 0; qi < 2; ++qi) { const float f = rs[wn * 64 + qi * 32 + r] * sc;
#pragma unroll
        for (int pi = 0; pi < 2; ++pi)
#pragma unroll
            for (int i = 0; i < 16; ++i) acc[pi][qi][i] *= f; }
}
DI void scale_acc_p(f32x16 (&acc)[2][2], const float* rs) {
    const int lane = tidx() & 63, wm = tidx() >> 7, hh = lane >> 5;
#pragma unroll
    for (int pi = 0; pi < 2; ++pi)
#pragma unroll
        for (int g = 0; g < 4; ++g) { const f32x4 f = *(const f32x4*)(rs + wm * 64 + pi * 32 + 8 * g + 4 * hh);
#pragma unroll
            for (int qi = 0; qi < 2; ++qi)
#pragma unroll
                for (int e = 0; e < 4; ++e) acc[pi][qi][4 * g + e] *= f[e]; }
}

DI int map_col(int map, int n) {
    switch (map) {
    case 1:
        if (n < 1024) return n;
        if (n < 2048) return 2216 + (n - 1024);
        if (n < 2432) return 1544 + (n - 2048);
        if (n < 2688) return 1928 + (n - 2432);
        if (n < 2816) { const int c = n - 2688; if (c < 16) return 2184 + c; if (c < 32) return 2200 + (c - 16); if (c < 40) return 1536 + (c - 32); return -1; }
        if (n < 3328) return 1024 + (n - 2816);
        if (n < 3840) return 3240 + (n - 3328);
        return -1;
    case 2: return 3752 + n;
    case 3:
        if (n < 512) return (n >> 6) * 96 + (n & 63);
        { const int n2 = n - 512; return (n2 >> 5) * 96 + 64 + (n2 & 31); }
    case 4:
        if (n < 512) return (n >> 6) * 128 + (n & 63);
        { const int n2 = n - 512; return (n2 >> 6) * 128 + 64 + (n2 & 63); }
    case 5: return (n >> 5) * 16 + (n & 15);
    default: return n;
    }
}

DI void transpose_tile(const float* __restrict__ src, const float* __restrict__ src2, int ld, int K, bf16_t* __restrict__ dst, int map, const float* __restrict__ kscale, int n0, int k0, float* tile) {
    const int tid = tidx(), tx = tid & 63, ty = tid >> 6;
    const int sc = map_col(map, n0 + tx);
    if (map == 5 && (((n0 + tx) >> 4) & 1)) src = src2;
    const int scc = sc < 0 ? 0 : sc;
    const float* sp = src + (size_t)(k0 + ty) * ld + scc;
    float vals[16];
#pragma unroll
    for (int j = 0; j < 16; ++j) vals[j] = sp[(size_t)(4 * j) * ld];
    if (kscale) {
#pragma unroll
        for (int j = 0; j < 16; ++j) vals[j] *= kscale[k0 + ty + 4 * j];
    }
#pragma unroll
    for (int j = 0; j < 16; ++j) tile[(ty + 4 * j) * 65 + tx] = sc < 0 ? 0.f : vals[j];
    __syncthreads();
    const int n = tid >> 2, kq = (tid & 3) * 16;
    unsigned wv[8];
#pragma unroll
    for (int j = 0; j < 8; ++j) wv[j] = pack_bf16(tile[(kq + 2 * j) * 65 + n], tile[(kq + 2 * j + 1) * 65 + n]);
    uint4* d = (uint4*)(dst + (size_t)(n0 + n) * K + k0 + kq);
    d[0] = make_uint4(wv[0], wv[1], wv[2], wv[3]);
    d[1] = make_uint4(wv[4], wv[5], wv[6], wv[7]);
    __syncthreads();
}

DI void phase_prep(KargPtr p, unsigned char* smem) {
    const int tid = tidx();
    float* fs = (float*)smem;
    constexpr int NW = 9296, NMOD = 192, NROPE = 2048;
    for (int item = bidx(); item < NW + NMOD + NROPE; item += gdim()) {
        if (item < NW) {
            const int l = item / 4648; int ti = item % 4648;
            const float* src; const float* src2 = nullptr; int ld, K, Nd, map; size_t doff; const float* ksc = nullptr;
            if (ti < 992)       { src = p->w_in + (size_t)l * 1024 * 6824; ld = 6824; K = 1024; Nd = 3968; doff = W_IN; map = 1; }
            else if (ti < 1760) { ti -= 992;  src = p->w_in + (size_t)l * 1024 * 6824; ld = 6824; K = 1024; Nd = 3072; doff = W_GATE; map = 2; }
            else if (ti < 1832) { ti -= 1760; src = p->w_mla_uq + (size_t)l * 384 * 768; ld = 768; K = 384; Nd = 768; doff = W_UQ; map = 3; ksc = p->g_mla_q + l * 384; }
            else if (ti < 1896) { ti -= 1832; src = p->w_mla_ukv + (size_t)l * 256 * 1024; ld = 1024; K = 256; Nd = 1024; doff = W_UKV; map = 4; ksc = p->g_mla_kv + l * 256; }
            else if (ti < 2024) { ti -= 1896; src = p->w_o_fox + (size_t)l * 512 * 1024; ld = 1024; K = 512; Nd = 1024; doff = W_OF; map = 0; }
            else if (ti < 2152) { ti -= 2024; src = p->w_o_mla + (size_t)l * 512 * 1024; ld = 1024; K = 512; Nd = 1024; doff = W_OM; map = 0; }
            else if (ti < 2280) { ti -= 2152; src = p->w_o_sb + (size_t)l * 512 * 1024; ld = 1024; K = 512; Nd = 1024; doff = W_OS; map = 0; }
            else if (ti < 2536) { ti -= 2280; src = p->w_out + (size_t)l * 1024 * 1024; ld = 1024; K = 1024; Nd = 1024; doff = W_OUT; map = 0; }
            else if (ti < 3944) { ti -= 2536; src = p->w_ffn_gate + (size_t)l * 1024 * 2816; src2 = p->w_ffn_up + (size_t)l * 1024 * 2816; ld = 2816; K = 1024; Nd = 5632; doff = W_FGU; map = 5; }
            else                { ti -= 3944; src = p->w_ffn_down + (size_t)l * 2816 * 1024; ld = 1024; K = 2816; Nd = 1024; doff = W_FD; map = 0; }
            (void)Nd;
            const int kts = K >> 6; const int ntile = ti / kts, ktile = ti % kts;
            transpose_tile(src, src2, ld, K, p->wt + (size_t)l * W_LAYER + doff, map, ksc, ntile * 64, ktile * 64, fs);
        } else if (item < NW + NMOD) {
            const int mi = item - NW; const int l = mi / 96, c0 = (mi % 96) * 64;
            float* cond = fs;
            float* red = fs + 8192;
            for (int e = tid; e < 8192; e += 256) { const float cv = p->c[e]; cond[e] = cv * sigmoidf_(cv); }
            __syncthreads();
            const int tx = tid & 63, ty = tid >> 6;
            float a0 = 0, a1 = 0, a2 = 0, a3 = 0, a4 = 0, a5 = 0, a6 = 0, a7 = 0;
            const float* wsrc = p->w_ada + (size_t)l * 1024 * 6144 + c0 + tx;
#pragma unroll 8
            for (int k = ty * 256; k < ty * 256 + 256; ++k) {
                const float wv = wsrc[(size_t)k * 6144];
                a0 += cond[k] * wv; a1 += cond[1024 + k] * wv; a2 += cond[2048 + k] * wv; a3 += cond[3072 + k] * wv;
                a4 += cond[4096 + k] * wv; a5 += cond[5120 + k] * wv; a6 += cond[6144 + k] * wv; a7 += cond[7168 + k] * wv;
            }
            float* rr = red + ty * 512 + tx;
            rr[0] = a0; rr[64] = a1; rr[128] = a2; rr[192] = a3; rr[256] = a4; rr[320] = a5; rr[384] = a6; rr[448] = a7;
            __syncthreads();
            for (int o = tid; o < 512; o += 256) {
                const int b = o >> 6, xx = o & 63;
                const float s = red[o] + red[512 + o] + red[1024 + o] + red[1536 + o] + p->b_ada[l * 6144 + c0 + xx];
                p->mod[(size_t)(l * 8 + b) * 6144 + c0 + xx] = s;
            }
            __syncthreads();
        } else {
            const int e = (item - NW - NMOD) * 256 + tid;
            const int i = e & 15, tok = e >> 4;
            const float ang = (float)p->pos[tok] * ROPE_INV[i];
            const double a = (double)ang;
            const double kq = rint(a * 0.63661977236758134308);
            const double rr = fma(-kq, 1.57079632679489661923, a);
            const double r2 = rr * rr;
            const double* C = ROPE_POLY;
            const double sn = rr * (1.0 + r2 * (C[0] + r2 * (C[1] + r2 * (C[2] + r2 * (C[3] + r2 * C[4])))));
            const double cs = 1.0 + r2 * (C[5] + r2 * (C[6] + r2 * (C[7] + r2 * (C[8] + r2 * (C[9] + r2 * C[10])))));
            const int q = ((int)(long long)kq) & 3;
            const double co = (q == 0) ? cs : (q == 1) ? -sn : (q == 2) ? -cs : sn;
            const double si = (q == 0) ? sn : (q == 1) ? cs : (q == 2) ? -sn : -cs;
            p->ropetab[2 * (size_t)e] = (float)co; p->ropetab[2 * (size_t)e + 1] = (float)si;
        }
    }
}

DI float wave_sum(float v) {
#pragma unroll
    for (int o = 32; o >= 1; o >>= 1) v += __shfl_xor(v, o);
    return v;
}
DI void phase_norm(const float* __restrict__ xin, const float* __restrict__ g, const float* __restrict__ modl, int sh_idx, int sc_idx, bf16_t* __restrict__ uout) {
    const int lane = tidx() & 63, w = tidx() >> 6;
    for (int rg = bidx() * 4 + w; rg < T_TOK / 4; rg += gdim() * 4) {
        const int row = rg * 4, b = row >> 12;
        f32x4 v[4][4]; float ss[4];
#pragma unroll
        for (int k = 0; k < 4; ++k) { const f32x4* xr = (const f32x4*)(xin + (size_t)(row + k) * 1024);
#pragma unroll
            for (int j = 0; j < 4; ++j) v[k][j] = xr[lane + 64 * j]; }
#pragma unroll
        for (int k = 0; k < 4; ++k) { float t = 0.f;
#pragma unroll
            for (int j = 0; j < 4; ++j) t += v[k][j][0] * v[k][j][0] + v[k][j][1] * v[k][j][1] + v[k][j][2] * v[k][j][2] + v[k][j][3] * v[k][j][3];
            ss[k] = rsqrtf(wave_sum(t) * (1.0f / 1024.0f) + EPS); }
        const float* mb = modl + (size_t)b * 6144;
#pragma unroll
        for (int j = 0; j < 4; ++j) {
            const int col = 4 * (lane + 64 * j);
            const f32x4 g4 = *(const f32x4*)(g + col), sc4 = *(const f32x4*)(mb + sc_idx * 1024 + col), sh4 = *(const f32x4*)(mb + sh_idx * 1024 + col);
#pragma unroll
            for (int k = 0; k < 4; ++k) {
                float y[4];
#pragma unroll
                for (int e = 0; e < 4; ++e) y[e] = (v[k][j][e] * ss[k]) * g4[e] * (1.0f + sc4[e]) + sh4[e];
                u32x2 pk; pk.x = pack_bf16(y[0], y[1]); pk.y = pack_bf16(y[2], y[3]);
                *(u32x2*)(uout + (size_t)(row + k) * 1024 + col) = pk;
            }
        }
    }
}
DI void phase_final(KargPtr p) {
    const int lane = tidx() & 63, w = tidx() >> 6;
    for (int row = bidx() * 4 + w; row < T_TOK; row += gdim() * 4) {
        f32x4* xr = (f32x4*)(p->out + (size_t)row * 1024);
        f32x4 v[4]; float ss = 0.f;
#pragma unroll
        for (int j = 0; j < 4; ++j) { v[j] = xr[lane + 64 * j]; ss += v[j][0] * v[j][0] + v[j][1] * v[j][1] + v[j][2] * v[j][2] + v[j][3] * v[j][3]; }
        ss = wave_sum(ss);
        const float rstd = rsqrtf(ss * (1.0f / 1024.0f) + EPS);
#pragma unroll
        for (int j = 0; j < 4; ++j) {
            const f32x4 g4 = *(const f32x4*)(p->g_final + 4 * (lane + 64 * j));
            f32x4 o;
#pragma unroll
            for (int e = 0; e < 4; ++e) o[e] = (v[j][e] * rstd) * g4[e];
            xr[lane + 64 * j] = o;
        }
    }
}

struct EpiInprojA {
    static constexpr bool PERM = false, AFTER_DRAIN = false;
    bf16_t* qf; bf16_t* kf; bf16_t* qs; bf16_t* ks; bf16_t* ql; bf16_t* kvl; bf16_t* kr; float* logf; const float* ropetab; const float* bfox;
    __device__ __forceinline__ void operator()(const pg8::f32x4 (&acc)[2][2][4][2], const pg8::Unit& u, int wr, int wc, int fr, int fq) const {
        const int row0 = u.pm * 256 + wr * 64 + fr;
        const int cw = wc * 32 + fq * 4;
#pragma unroll
        for (int bj = 0; bj < 2; ++bj) {
            bf16_t* dst; int ld; float sc = 1.0f; bool special = false;
            if (u.pn < 8) { const int region = u.pn >> 1; dst = (region == 0 ? qf : region == 1 ? kf : region == 2 ? qs : ks) + (u.pn & 1) * 256 + bj * 128; ld = 512; if (region == 0 || region == 2) sc = FOX_QS; }
            else if (u.pn == 8) { dst = ql + bj * 128; ld = 384; }
            else if (u.pn == 9) { if (bj == 0) { dst = ql + 256; ld = 384; } else { dst = kvl; ld = 256; } }
            else { dst = kvl + 128; ld = 256; special = (bj == 1); }
            if (!special) {
#pragma unroll
                for (int ai = 0; ai < 2; ++ai)
#pragma unroll
                    for (int m = 0; m < 4; ++m) {
                        bf16_t* rowp = dst + (size_t)(row0 + ai * 128 + m * 16) * ld + cw;
#pragma unroll
                        for (int n = 0; n < 2; ++n) { const pg8::f32x4 v = acc[ai][bj][m][n] * sc; u32x2 pk; pk.x = pack_bf16(v[0], v[1]); pk.y = pack_bf16(v[2], v[3]); *(u32x2*)(rowp + n * 16) = pk; }
                    }
            } else if (wc == 0) {
#pragma unroll
                for (int ai = 0; ai < 2; ++ai)
#pragma unroll
                    for (int m = 0; m < 4; ++m) {
                        const int t = row0 + ai * 128 + m * 16;
                        const pg8::f32x4 x1 = acc[ai][1][m][0], x2 = acc[ai][1][m][1];
                        const pg8::f32x4 ca = *(const pg8::f32x4*)(ropetab + 2 * (t * 16 + fq * 4)), cb = *(const pg8::f32x4*)(ropetab + 2 * (t * 16 + fq * 4) + 4);
                        const float co[4] = {ca[0], ca[2], cb[0], cb[2]}, si[4] = {ca[1], ca[3], cb[1], cb[3]};
                        float o1[4], o2[4];
#pragma unroll
                        for (int j = 0; j < 4; ++j) { o1[j] = x1[j] * co[j] - x2[j] * si[j]; o2[j] = x1[j] * si[j] + x2[j] * co[j]; }
                        u32x2 p1, p2; p1.x = pack_bf16(o1[0], o1[1]); p1.y = pack_bf16(o1[2], o1[3]); p2.x = pack_bf16(o2[0], o2[1]); p2.y = pack_bf16(o2[2], o2[3]);
                        *(u32x2*)(kr + (size_t)t * 32 + fq * 4) = p1;
                        *(u32x2*)(kr + (size_t)t * 32 + 16 + fq * 4) = p2;
                    }
            } else if (wc == 1 && fq < 2) {
#pragma unroll
                for (int ai = 0; ai < 2; ++ai)
#pragma unroll
                    for (int m = 0; m < 4; ++m) {
                        const int t = row0 + ai * 128 + m * 16, b = t >> 12, sq = t & 4095;
#pragma unroll
                        for (int j = 0; j < 4; ++j) {
                            const int head = fq * 4 + j;
                            const float f = acc[ai][1][m][0][j] + bfox[head];
                            logf[(size_t)(b * 8 + head) * SEQ + sq] = fminf(f, 0.f) - log1pf(expf(-fabsf(f)));
                        }
                    }
            }
        }
    }
};
struct EpiInprojV {
    static constexpr bool PERM = false, AFTER_DRAIN = false;
    bf16_t* vtf; bf16_t* vts;
    __device__ __forceinline__ void operator()(const pg8::f32x4 (&acc)[2][2][4][2], const pg8::Unit& u, int wr, int wc, int fr, int fq) const {
        bf16_t* vt = u.pn < 2 ? vtf : vts;
        const int row0 = u.pm * 256 + wr * 64 + fq * 4, b = row0 >> 12, s0 = row0 & 4095;
        const int cv0 = (u.pn & 1) * 256 + wc * 32 + fr;
#pragma unroll
        for (int bj = 0; bj < 2; ++bj)
#pragma unroll
            for (int n = 0; n < 2; ++n) {
                const int cv = cv0 + bj * 128 + n * 16;
                bf16_t* vp = vt + (size_t)(b * 8 + (cv >> 6)) * SEQ * 64 + (cv & 63) * 64;
#pragma unroll
                for (int ai = 0; ai < 2; ++ai)
#pragma unroll
                    for (int m = 0; m < 4; ++m) { const int sq = s0 + ai * 128 + m * 16; const pg8::f32x4 v = acc[ai][bj][m][n]; u32x2 pk; pk.x = pack_bf16(v[0], v[1]); pk.y = pack_bf16(v[2], v[3]);
                        *(u32x2*)(vp + (size_t)(sq >> 6) * 4096 + (sq & 63)) = pk; }
            }
    }
};
struct EpiFfnUp {
    static constexpr bool PERM = false, AFTER_DRAIN = false;
    bf16_t* h;
    __device__ __forceinline__ void operator()(const pg8::f32x4 (&acc)[2][2][4][2], const pg8::Unit& u, int wr, int wc, int fr, int fq) const {
        const int row0 = u.pm * 256 + wr * 64 + fr;
#pragma unroll
        for (int ai = 0; ai < 2; ++ai)
#pragma unroll
            for (int m = 0; m < 4; ++m) {
                bf16_t* rowp = h + (size_t)(row0 + ai * 128 + m * 16) * 2816 + u.pn * 128 + wc * 16 + fq * 4;
#pragma unroll
                for (int bj = 0; bj < 2; ++bj) {
                    const pg8::f32x4 g = acc[ai][bj][m][0], up = acc[ai][bj][m][1];
                    float hv[4];
#pragma unroll
                    for (int j = 0; j < 4; ++j) hv[j] = g[j] * sigmoidf_(g[j]) * up[j];
                    u32x2 pk; pk.x = pack_bf16(hv[0], hv[1]); pk.y = pack_bf16(hv[2], hv[3]);
                    *(u32x2*)(rowp + bj * 64) = pk;
                }
            }
    }
};
struct EpiResidual {
    static constexpr bool PERM = false, AFTER_DRAIN = false;
    const float* xin; float* xout; const float* modl; int gidx;
    __device__ __forceinline__ void operator()(const pg8::f32x4 (&acc)[2][2][4][2], const pg8::Unit& u, int wr, int wc, int fr, int fq) const {
        const int row0 = u.pm * 256 + wr * 64 + fr, b = row0 >> 12;
        const float* gt = modl + (size_t)b * 6144 + gidx * 1024;
#pragma unroll
        for (int bj = 0; bj < 2; ++bj)
#pragma unroll
            for (int n = 0; n < 2; ++n) {
                const int col = u.pn * 256 + bj * 128 + wc * 32 + n * 16 + fq * 4;
                const pg8::f32x4 g4 = *(const pg8::f32x4*)(gt + col);
                pg8::f32x4 xv[2][4];
#pragma unroll
                for (int ai = 0; ai < 2; ++ai)
#pragma unroll
                    for (int m = 0; m < 4; ++m) xv[ai][m] = *(const pg8::f32x4*)(xin + (size_t)(row0 + ai * 128 + m * 16) * 1024 + col);
#pragma unroll
                for (int ai = 0; ai < 2; ++ai)
#pragma unroll
                    for (int m = 0; m < 4; ++m) *(pg8::f32x4*)(xout + (size_t)(row0 + ai * 128 + m * 16) * 1024 + col) = xv[ai][m] + g4 * acc[ai][bj][m][n];
            }
    }
};
template <class Epi, bool NAT = false>
DI void big_gemm(const bf16_t* A, const bf16_t* Bt, int N, int K, const Epi& E, unsigned char* smem) {
    __syncthreads();
    pg8::StaticOrder S; S.init(T_TOK, N, (int)gridDim.x, (int)blockIdx.x);
    pg8::Gemm g; g.A = A; g.Bt = Bt; g.M = T_TOK; g.N = N; g.K = K;
    pg8::gemm_phase<Epi, pg8::StaticOrder, true, true, NAT>((PG8_LAS unsigned char*)smem, g, S, E);
    __syncthreads();
}

DI void phase_inproj(KargPtr p, int l, unsigned char* smem_phys) {
    const bf16_t* W = p->wt + (size_t)l * W_LAYER + W_IN;
    { EpiInprojA E; E.qf = p->qf; E.kf = p->kf; E.qs = p->qs; E.ks = p->ks; E.ql = p->ql; E.kvl = p->kvl; E.kr = p->kr; E.logf = p->logf; E.ropetab = p->ropetab; E.bfox = p->b_fox_f + l * 8;
      big_gemm<EpiInprojA, false>(p->u, W, 2816, 1024, E, smem_phys); }
    { EpiInprojV E; E.vtf = p->vtf; E.vts = p->vts;
      big_gemm<EpiInprojV, true>(p->u, W + (size_t)2816 * 1024, 1024, 1024, E, smem_phys); }
}

DI void phase_mla_up(KargPtr p, int l, unsigned char* smem) {
    const int tid = tidx(), lane = tid & 63, w = tid >> 6;
    (void)l;
    for (int row = (bidx() * 4 + w) * 2; row < T_TOK; row += gdim() * 8) {
        float sq[2], skv[2];
#pragma unroll
        for (int k = 0; k < 2; ++k) {
            uint4 a = make_uint4(0, 0, 0, 0), c = make_uint4(0, 0, 0, 0);
            if (lane < 48) a = *(const uint4*)(p->ql + (size_t)(row + k) * 384 + lane * 8);
            if (lane < 32) c = *(const uint4*)(p->kvl + (size_t)(row + k) * 256 + lane * 8);
            const unsigned ua[4] = {a.x, a.y, a.z, a.w}, uc[4] = {c.x, c.y, c.z, c.w};
            float s1 = 0.f, s2 = 0.f;
#pragma unroll
            for (int e = 0; e < 4; ++e) { float lo = __uint_as_float(ua[e] << 16), hi = __uint_as_float(ua[e] & 0xffff0000u); s1 += lo * lo + hi * hi;
                                          lo = __uint_as_float(uc[e] << 16); hi = __uint_as_float(uc[e] & 0xffff0000u); s2 += lo * lo + hi * hi; }
            sq[k] = wave_sum(s1); skv[k] = wave_sum(s2);
        }
        if (lane == 0) { p->rsq[row] = rsqrtf(sq[0] * (1.0f / 384.0f) + EPS); p->rsq[row + 1] = rsqrtf(sq[1] * (1.0f / 384.0f) + EPS);
                         p->rskv[row] = rsqrtf(skv[0] * (1.0f / 256.0f) + EPS); p->rskv[row + 1] = rsqrtf(skv[1] * (1.0f / 256.0f) + EPS); }
    }
    __syncthreads();
    float* fs = (float*)smem;
    for (int bh = bidx(); bh < 64; bh += gdim()) {
        const f32x4* src = (const f32x4*)(p->logf + (size_t)bh * SEQ + tid * 16);
        f32x4 v[4];
        float run = 0.f;
#pragma unroll
        for (int j = 0; j < 4; ++j) { v[j] = src[j];
#pragma unroll
            for (int e = 0; e < 4; ++e) { run += v[j][e]; v[j][e] = run; } }
        float incl = run;
#pragma unroll
        for (int o = 1; o < 64; o <<= 1) { const float tv = __shfl_up(incl, o); if (lane >= o) incl += tv; }
        if (lane == 63) fs[w] = incl;
        __syncthreads();
        float pre = incl - run;
        for (int ww = 0; ww < w; ++ww) pre += fs[ww];
        f32x4* dst = (f32x4*)(p->cum + (size_t)bh * SEQ + tid * 16);
#pragma unroll
        for (int j = 0; j < 4; ++j) { f32x4 o;
#pragma unroll
            for (int e = 0; e < 4; ++e) o[e] = v[j][e] + pre; dst[j] = o; }
        __syncthreads();
    }
    {
        const int v = bidx();
        if (v < 512) {
            const int bh = v >> 3, part = v & 7;
            const bf16_t* kp = p->kf + (size_t)(bh >> 3) * SEQ * 512 + (bh & 7) * 64 + (size_t)(part * 512 + tid * 2) * 512;
            float mx = 0.f;
#pragma unroll
            for (int rr = 0; rr < 2; ++rr) {
                const uint4* q4 = (const uint4*)(kp + (size_t)rr * 512);
                uint4 vv[8];
#pragma unroll
                for (int c = 0; c < 8; ++c) vv[c] = q4[c];
                float ss = 0.f;
#pragma unroll
                for (int c = 0; c < 8; ++c) { const unsigned uu[4] = {vv[c].x, vv[c].y, vv[c].z, vv[c].w};
#pragma unroll
                    for (int e = 0; e < 4; ++e) { const float lo = __uint_as_float(uu[e] << 16), hi = __uint_as_float(uu[e] & 0xffff0000u); ss += lo * lo + hi * hi; } }
                mx = fmaxf(mx, ss);
            }
#pragma unroll
            for (int o = 32; o >= 1; o >>= 1) mx = fmaxf(mx, __shfl_xor(mx, o));
            if (lane == 0) atomicMax((unsigned*)p->kmax + bh, __float_as_uint(mx));
        }
    }
}

template <int TYPE>
DI void attn_item(KargPtr p, int b, int h, int qb, unsigned char* smem) {
    constexpr int DK = (TYPE == 1) ? 96 : (TYPE == 0 ? 80 : 64), KS = DK / 16, KROWB = (DK + 8) * 2, VROWB = 144;
    constexpr int KBYTES = 64 * KROWB, VBYTES = 64 * VROWB, BUFB = KBYTES + VBYTES + 256;
    const int tid = tidx(), lane = tid & 63, w = tid >> 6, r = lane & 31, hh = lane >> 5;
    const int q0 = qb * 128, qw = q0 + 32 * w, myq = qw + r;
    const size_t tokq = (size_t)b * SEQ + myq;
    unsigned* flags = (unsigned*)(smem - vhalf() * VSMEM + FLAGS_OFF);
    const int w8 = vhalf() * 4 + w;

    bf16x8 qfrag[KS];
    if (TYPE == 1) {
#pragma unroll
        for (int ks = 0; ks < 4; ++ks) qfrag[ks] = *(const bf16x8*)(p->qn + tokq * 512 + h * 64 + ks * 16 + hh * 8);
#pragma unroll
        for (int ks = 4; ks < KS; ++ks) qfrag[ks] = *(const bf16x8*)(p->qr + tokq * 256 + h * 32 + (ks - 4) * 16 + hh * 8);
    } else {
        const bf16_t* qg = (TYPE == 0 ? p->qf : p->qs) + tokq * 512 + h * 64;
#pragma unroll
        for (int ks = 0; ks < 4; ++ks) qfrag[ks] = *(const bf16x8*)(qg + ks * 16 + hh * 8);
        if (TYPE == 0) { const u32x4 one3 = hh == 0 ? (u32x4){0x3F803F80u, 0x00003F80u, 0u, 0u} : (u32x4){0u, 0u, 0u, 0u}; qfrag[KS - 1] = __builtin_bit_cast(bf16x8, one3); }
    }
    const bf16_t* Kg = (TYPE == 0 ? p->kf : TYPE == 1 ? p->kn : p->ks) + (size_t)b * SEQ * 512 + h * 64;
    const bf16_t* Vg = (TYPE == 0 ? p->vtf : TYPE == 1 ? p->vtm : p->vts) + (size_t)(b * 8 + h) * 64 * SEQ;
    const bf16_t* Krg = p->kr + (size_t)b * SEQ * 32;
    const float* cumg = p->cum + (size_t)(b * 8 + h) * SEQ;

    const int ntiles = 2 * qb + 2;
    u32x4 rk0A, rk1A, rv0A, rv1A, rkrA, rk0B, rk1B, rv0B, rv1B, rkrB; float rckA = 0.f, rckB = 0.f;
    { unsigned z_ = 0u; asm volatile("" : "+v"(z_)); rkrA = (u32x4){z_, z_, z_, z_}; rkrB = rkrA; }
    const int ldrow = tid >> 3, ldch = tid & 7;
    const int vpos = 16 * (ldch >> 1) + 4 * (ldch & 1);
#define LOAD_TILE(S, KT_) do { \
        const int k0_ = (KT_) * 64; \
        GLOAD16(rk0##S, Kg + (size_t)(k0_ + ldrow) * 512 + ldch * 8); \
        GLOAD16(rk1##S, Kg + (size_t)(k0_ + 32 + ldrow) * 512 + ldch * 8); \
        GLOAD16(rv0##S, Vg + (size_t)k0_ * 64 + ldrow * 64 + ldch * 8); \
        GLOAD16(rv1##S, Vg + (size_t)k0_ * 64 + (32 + ldrow) * 64 + ldch * 8); \
        if (TYPE == 1) GLOAD16(rkr##S, Krg + (size_t)(k0_ + (tid >> 2)) * 32 + (tid & 3) * 8); \
        if (TYPE == 0) GLOAD4(rck##S, cumg + k0_ + (tid & 63)); \
    } while (0)
#define WAIT_ALL(S) asm volatile("s_waitcnt vmcnt(0)" : "+v"(rk0##S), "+v"(rk1##S), "+v"(rv0##S), "+v"(rv1##S), "+v"(rkr##S), "+v"(rck##S))
#define WAIT_OLD(S) do { if (TYPE == 2) asm volatile("s_waitcnt vmcnt(4)" : "+v"(rk0##S), "+v"(rk1##S), "+v"(rv0##S), "+v"(rv1##S), "+v"(rkr##S), "+v"(rck##S)); \
        else asm volatile("s_waitcnt vmcnt(5)" : "+v"(rk0##S), "+v"(rk1##S), "+v"(rv0##S), "+v"(rv1##S), "+v"(rkr##S), "+v"(rck##S)); } while (0)
#define STORE_TILE(S, BUF_) do { \
        unsigned char* kb_ = smem + (BUF_) * BUFB; unsigned char* vb_ = kb_ + KBYTES; \
        *(u32x4*)(kb_ + ldrow * KROWB + ldch * 16) = rk0##S; \
        *(u32x4*)(kb_ + (32 + ldrow) * KROWB + ldch * 16) = rk1##S; \
        { u32x2 lo, hi; lo.x = rv0##S.x; lo.y = rv0##S.y; hi.x = rv0##S.z; hi.y = rv0##S.w; \
          *(u32x2*)(vb_ + ldrow * VROWB + vpos * 2) = lo; *(u32x2*)(vb_ + ldrow * VROWB + (vpos + 8) * 2) = hi; } \
        { u32x2 lo, hi; lo.x = rv1##S.x; lo.y = rv1##S.y; hi.x = rv1##S.z; hi.y = rv1##S.w; \
          *(u32x2*)(vb_ + (32 + ldrow) * VROWB + vpos * 2) = lo; *(u32x2*)(vb_ + (32 + ldrow) * VROWB + (vpos + 8) * 2) = hi; } \
        if (TYPE == 1) *(u32x4*)(kb_ + (tid >> 2) * KROWB + 128 + (tid & 3) * 16) = rkr##S; \
        if (TYPE == 0) { if (tid < 64) { \
            const float c_ = -rck##S * LOG2E; \
            const unsigned h_ = pack_bf16(c_, 0.f) & 0xffffu; const float r1_ = c_ - __uint_as_float(h_ << 16); \
            const unsigned m_ = pack_bf16(r1_, 0.f) & 0xffffu; const float r2_ = r1_ - __uint_as_float(m_ << 16); \
            const unsigned l_ = pack_bf16(r2_, 0.f) & 0xffffu; \
            *(u32x4*)(kb_ + tid * KROWB + 128) = (u32x4){h_ | (m_ << 16), l_, 0u, 0u}; \
            { unsigned z_ = 0u; asm volatile("" : "+v"(z_)); *(u32x4*)(kb_ + tid * KROWB + 144) = (u32x4){z_, z_, z_, z_}; }        \
            if (tid == 63) *(float*)(vb_ + VBYTES) = c_; } } \
    } while (0)
#define TILE_OF(J_) ((TYPE != 1) ? (ntiles - 1 - ((J_) < ntiles ? (J_) : ntiles - 1)) : ((J_) < ntiles ? (J_) : ntiles - 1))

    f32x16 o0, o1;
#pragma unroll
    for (int i = 0; i < 16; ++i) { o0[i] = 0.f; o1[i] = 0.f; }
    float m = -1e30f, lsum = 0.f, carry = 0.f;
    bool wdone = false;
    float qbound = 0.f;
    if (TYPE == 0) {
        float ss = 0.f;
#pragma unroll
        for (int ks = 0; ks < 4; ++ks) { const u32x4 qq = __builtin_bit_cast(u32x4, qfrag[ks]);
#pragma unroll
            for (int e = 0; e < 4; ++e) { const float lo = __uint_as_float(qq[e] << 16), hi = __uint_as_float(qq[e] & 0xffff0000u); ss += lo * lo + hi * hi; } }
        ss += __shfl_xor(ss, 32);
        qbound = sqrtf(ss * p->kmax[b * 8 + h]) * 1.0201f;
    }

    auto compute = [&](const int kt, const int buf) __attribute__((always_inline)) {
        const unsigned char* kb = smem + buf * BUFB; const unsigned char* vb = kb + KBYTES;
        const int k0 = kt * 64;
        bool need;
        if (TYPE == 0) {
            if (!wdone && k0 <= qw + 31) wdone = (__all(qbound + *(const float*)(vb + VBYTES) - m < -150.f) != 0);
            need = (k0 <= qw + 31) && !wdone;
        }
        else if (TYPE == 1) need = (k0 <= qw);
        else need = (k0 <= qw + 30) && !wdone;
        if (need) {
            f32x16 s0, s1;
#pragma unroll
            for (int i = 0; i < 16; ++i) { s0[i] = 0.f; s1[i] = 0.f; }
#pragma unroll
            for (int ks = 0; ks < KS; ++ks) {
                const bf16x8 a0 = *(const bf16x8*)(kb + r * KROWB + ks * 32 + hh * 16);
                const bf16x8 a1 = *(const bf16x8*)(kb + (32 + r) * KROWB + ks * 32 + hh * 16);
                s0 = MFMA(a0, qfrag[ks], s0); s1 = MFMA(a1, qfrag[ks], s1);
            }
            if (TYPE != 2) {
                if (TYPE == 0) {
                    if (k0 + 63 > qw) {
                        asm volatile("");
                        const int rel = myq - k0 - 4 * hh;
#pragma unroll
                        for (int i = 0; i < 16; ++i) {
                            const int off = 8 * (i >> 2) + (i & 3);
                            if (off > rel) s0[i] = -1e30f;
                            if (off + 32 > rel) s1[i] = -1e30f;
                        }
                    }
                }
                float mx = s0[0];
#pragma unroll
                for (int i = 1; i < 16; ++i) mx = fmaxf(mx, s0[i]);
#pragma unroll
                for (int i = 0; i < 16; ++i) mx = fmaxf(mx, s1[i]);
                mx = fmaxf(mx, __shfl_xor(mx, 32));
                const float mnew = fmaxf(m, mx);
                const float alpha = fexp2(m - mnew);
                m = mnew;
                float ps = 0.f;
#pragma unroll
                for (int i = 0; i < 16; i += 2) {
                    const f32x2_t mm = {mnew, mnew};
                    const f32x2_t d0 = (f32x2_t){s0[i], s0[i + 1]} - mm, d1 = (f32x2_t){s1[i], s1[i + 1]} - mm;
                    s0[i] = fexp2(d0[0]); s0[i + 1] = fexp2(d0[1]); s1[i] = fexp2(d1[0]); s1[i + 1] = fexp2(d1[1]);
                    ps += (s0[i] + s0[i + 1]) + (s1[i] + s1[i + 1]);
                }
                lsum = lsum * alpha + ps;
#pragma unroll
                for (int i = 0; i < 16; ++i) { o0[i] *= alpha; o1[i] *= alpha; }
            } else {
                float lk0[16], lk1[16];
#pragma unroll
                for (int i = 0; i < 16; ++i) {
                    {
                        const float z = s0[i]; const float sp = flog2(1.0f + fexp2(-fabsf(z)));
                        const float lb = fminf(z, 0.f) - sp;
                        s0[i] = lb; lk0[i] = lb - z;
                    }
                    {
                        const float z = s1[i]; const float sp = flog2(1.0f + fexp2(-fabsf(z)));
                        const float lb = fminf(z, 0.f) - sp;
                        s1[i] = lb; lk1[i] = lb - z;
                    }
                }
                if (k0 + 63 >= qw) {
                    asm volatile("");
                    const int rel = myq - k0 - 4 * hh;
#pragma unroll
                    for (int i = 0; i < 16; ++i) {
                        const int off = 8 * (i >> 2) + (i & 3);
                        if (off >= rel) { lk0[i] = 0.f; s0[i] = -1e30f; }
                        if (off + 32 >= rel) { lk1[i] = 0.f; s1[i] = -1e30f; }
                    }
                }
                float run = carry;
#pragma unroll
                for (int g = 3; g >= 0; --g) {
                    const float G = (lk1[4 * g] + lk1[4 * g + 1]) + (lk1[4 * g + 2] + lk1[4 * g + 3]);
                    const float Gp = __shfl_xor(G, 32);
                    const float base = run + (hh == 0 ? Gp : 0.f);
                    const float e3 = base, e2 = e3 + lk1[4 * g + 3], e1 = e2 + lk1[4 * g + 2], e0 = e1 + lk1[4 * g + 1];
                    s1[4 * g + 3] = fexp2(s1[4 * g + 3] + e3); s1[4 * g + 2] = fexp2(s1[4 * g + 2] + e2);
                    s1[4 * g + 1] = fexp2(s1[4 * g + 1] + e1); s1[4 * g] = fexp2(s1[4 * g] + e0);
                    run += G + Gp;
                }
#pragma unroll
                for (int g = 3; g >= 0; --g) {
                    const float G = (lk0[4 * g] + lk0[4 * g + 1]) + (lk0[4 * g + 2] + lk0[4 * g + 3]);
                    const float Gp = __shfl_xor(G, 32);
                    const float base = run + (hh == 0 ? Gp : 0.f);
                    const float e3 = base, e2 = e3 + lk0[4 * g + 3], e1 = e2 + lk0[4 * g + 2], e0 = e1 + lk0[4 * g + 1];
                    s0[4 * g + 3] = fexp2(s0[4 * g + 3] + e3); s0[4 * g + 2] = fexp2(s0[4 * g + 2] + e2);
                    s0[4 * g + 1] = fexp2(s0[4 * g + 1] + e1); s0[4 * g] = fexp2(s0[4 * g] + e0);
                    run += G + Gp;
                }
                carry = run;
            }
#pragma unroll
            for (int s2 = 0; s2 < 2; ++s2) {
                unsigned pk0[4], pk1[4];
#pragma unroll
                for (int j = 0; j < 4; ++j) { pk0[j] = pack_bf16(s0[8 * s2 + 2 * j], s0[8 * s2 + 2 * j + 1]); pk1[j] = pack_bf16(s1[8 * s2 + 2 * j], s1[8 * s2 + 2 * j + 1]); }
                const uint4 u0 = make_uint4(pk0[0], pk0[1], pk0[2], pk0[3]), u1 = make_uint4(pk1[0], pk1[1], pk1[2], pk1[3]);
                const bf16x8 pf0 = __builtin_bit_cast(bf16x8, u0), pf1 = __builtin_bit_cast(bf16x8, u1);
                const bf16x8 v00 = *(const bf16x8*)(vb + r * VROWB + (16 * s2 + 8 * hh) * 2);
                const bf16x8 v01 = *(const bf16x8*)(vb + (32 + r) * VROWB + (16 * s2 + 8 * hh) * 2);
                const bf16x8 v10 = *(const bf16x8*)(vb + r * VROWB + (32 + 16 * s2 + 8 * hh) * 2);
                const bf16x8 v11 = *(const bf16x8*)(vb + (32 + r) * VROWB + (32 + 16 * s2 + 8 * hh) * 2);
                o0 = MFMA(v00, pf0, o0); o1 = MFMA(v01, pf0, o1);
                o0 = MFMA(v10, pf1, o0); o1 = MFMA(v11, pf1, o1);
            }
        }
    };
#define SB_FLAGS(N_) do { if (TYPE != 1) { if (TYPE == 2) wdone = (__all(carry < -170.f) != 0); if (lane == 0) flags[((N_) & 1) * 8 + w8] = wdone ? 1u : 0u; } } while (0)
#define SB_DONE(N_) (TYPE != 1 && ((flags[((N_) & 1) * 8] & flags[((N_) & 1) * 8 + 1] & flags[((N_) & 1) * 8 + 2] & flags[((N_) & 1) * 8 + 3] & flags[((N_) & 1) * 8 + 4] & flags[((N_) & 1) * 8 + 5] & flags[((N_) & 1) * 8 + 6] & flags[((N_) & 1) * 8 + 7]) != 0u))
    __syncthreads();
    if (TYPE != 1 && tid < 16) flags[tid] = 0;
    LOAD_TILE(A, TILE_OF(0));
    WAIT_ALL(A);
    STORE_TILE(A, 0);
    LOAD_TILE(A, TILE_OF(1));
    __syncthreads();
    for (int n = 0; n < ntiles; n += 2) {
        LOAD_TILE(B, TILE_OF(n + 2));
        __builtin_amdgcn_sched_barrier(0);
        compute(TILE_OF(n), 0);
        __builtin_amdgcn_sched_barrier(0);
        WAIT_OLD(A);
        STORE_TILE(A, 1);
        SB_FLAGS(n);
        __syncthreads();
        if (SB_DONE(n)) break;
        if (n + 1 >= ntiles) break;
        LOAD_TILE(A, TILE_OF(n + 3));
        __builtin_amdgcn_sched_barrier(0);
        compute(TILE_OF(n + 1), 1);
        __builtin_amdgcn_sched_barrier(0);
        WAIT_OLD(B);
        STORE_TILE(B, 0);
        SB_FLAGS(n + 1);
        __syncthreads();
        if (SB_DONE(n + 1)) break;
    }
    asm volatile("s_waitcnt vmcnt(0)" : "+v"(rk0A), "+v"(rk1A), "+v"(rv0A), "+v"(rv1A), "+v"(rkrA), "+v"(rckA), "+v"(rk0B), "+v"(rk1B), "+v"(rv0B), "+v"(rv1B), "+v"(rkrB), "+v"(rckB));
    float inv = 1.0f;
    if (TYPE != 2) { const float lt = lsum + __shfl_xor(lsum, 32); inv = frcp(lt); }
    bf16_t* yg = (TYPE == 0 ? p->qf : TYPE == 1 ? p->qn : p->qs) + tokq * 512 + h * 64;
#pragma unroll
    for (int g = 0; g < 4; ++g) {
        u32x2 a, c2;
        a.x = pack_bf16(o0[4 * g] * inv, o0[4 * g + 1] * inv); a.y = pack_bf16(o0[4 * g + 2] * inv, o0[4 * g + 3] * inv);
        c2.x = pack_bf16(o1[4 * g] * inv, o1[4 * g + 1] * inv); c2.y = pack_bf16(o1[4 * g + 2] * inv, o1[4 * g + 3] * inv);
        *(u32x2*)(yg + 8 * g + 4 * hh) = a;
        *(u32x2*)(yg + 32 + 8 * g + 4 * hh) = c2;
    }
}

DI void phase_attn(KargPtr p, unsigned char* smem) {
    for (int idx = bidx(); idx < 6144; idx += gdim()) {
        if (idx < 4096) {
            const int j = idx >> 9, g = (idx >> 7) & 3, rem = idx & 127, bh = ((rem & 63) + 13 * j) & 63;
            const int qb = 31 - 4 * j - ((j & 1) ? 3 - g : g);
            const int type = ((rem >> 6) + j) & 1;
            if (type == 0) attn_item<0>(p, bh >> 3, bh & 7, qb, smem);
            else attn_item<1>(p, bh >> 3, bh & 7, qb, smem);
        } else {
            const int j = idx - 4096; const int qb = 31 - (j >> 6), bh = j & 63;
            attn_item<2>(p, bh >> 3, bh & 7, qb, smem);
        }
    }
}

struct EpiUq {
    static constexpr bool PERM = false, AFTER_DRAIN = false;
    bf16_t* qn; bf16_t* qr; const float* rs; const float* ropetab;
    __device__ __forceinline__ void operator()(const pg8::f32x4 (&acc)[2][2][4][2], const pg8::Unit& u, int wr, int wc, int fr, int fq) const {
        const int row0 = u.pm * 256 + wr * 64 + fr;
#pragma unroll
        for (int ai = 0; ai < 2; ++ai)
#pragma unroll
            for (int m = 0; m < 4; ++m) {
                const int t = row0 + ai * 128 + m * 16;
                const float sc = rs[t] * MLA_QS;
                if (u.pn < 2) {
                    bf16_t* rowp = qn + (size_t)t * 512 + u.pn * 256 + wc * 32 + fq * 4;
#pragma unroll
                    for (int bj = 0; bj < 2; ++bj)
#pragma unroll
                        for (int n = 0; n < 2; ++n) { const pg8::f32x4 v = acc[ai][bj][m][n] * sc; u32x2 pk; pk.x = pack_bf16(v[0], v[1]); pk.y = pack_bf16(v[2], v[3]); *(u32x2*)(rowp + bj * 128 + n * 16) = pk; }
                } else {
                    const pg8::f32x4 ca = *(const pg8::f32x4*)(ropetab + 2 * (t * 16 + fq * 4)), cb = *(const pg8::f32x4*)(ropetab + 2 * (t * 16 + fq * 4) + 4);
                    const float co[4] = {ca[0], ca[2], cb[0], cb[2]}, si[4] = {ca[1], ca[3], cb[1], cb[3]};
#pragma unroll
                    for (int bj = 0; bj < 2; ++bj) {
                        const pg8::f32x4 x1 = acc[ai][bj][m][0] * sc, x2 = acc[ai][bj][m][1] * sc;
                        float o1[4], o2[4];
#pragma unroll
                        for (int j = 0; j < 4; ++j) { o1[j] = x1[j] * co[j] - x2[j] * si[j]; o2[j] = x1[j] * si[j] + x2[j] * co[j]; }
                        u32x2 p1, p2; p1.x = pack_bf16(o1[0], o1[1]); p1.y = pack_bf16(o1[2], o1[3]); p2.x = pack_bf16(o2[0], o2[1]); p2.y = pack_bf16(o2[2], o2[3]);
                        bf16_t* hp = qr + (size_t)t * 256 + (bj * 4 + wc) * 32 + fq * 4;
                        *(u32x2*)hp = p1; *(u32x2*)(hp + 16) = p2;
                    }
                }
            }
    }
};
struct EpiUkvK {
    static constexpr bool PERM = false, AFTER_DRAIN = false;
    bf16_t* kn; const float* rs;
    __device__ __forceinline__ void operator()(const pg8::f32x4 (&acc)[2][2][4][2], const pg8::Unit& u, int wr, int wc, int fr, int fq) const {
        const int row0 = u.pm * 256 + wr * 64 + fr;
#pragma unroll
        for (int ai = 0; ai < 2; ++ai)
#pragma unroll
            for (int m = 0; m < 4; ++m) {
                const int t = row0 + ai * 128 + m * 16;
                const float sc = rs[t];
                bf16_t* rowp = kn + (size_t)t * 512 + u.pn * 256 + wc * 32 + fq * 4;
#pragma unroll
                for (int bj = 0; bj < 2; ++bj)
#pragma unroll
                    for (int n = 0; n < 2; ++n) { const pg8::f32x4 v = acc[ai][bj][m][n] * sc; u32x2 pk; pk.x = pack_bf16(v[0], v[1]); pk.y = pack_bf16(v[2], v[3]); *(u32x2*)(rowp + bj * 128 + n * 16) = pk; }
            }
    }
};
struct EpiUkvV {
    static constexpr bool PERM = false, AFTER_DRAIN = false;
    bf16_t* vtm; const float* rs;
    __device__ __forceinline__ void operator()(const pg8::f32x4 (&acc)[2][2][4][2], const pg8::Unit& u, int wr, int wc, int fr, int fq) const {
        const int row0 = u.pm * 256 + wr * 64 + fq * 4, b = row0 >> 12, s0 = row0 & 4095;
        const int cv0 = u.pn * 256 + wc * 32 + fr;
#pragma unroll
        for (int ai = 0; ai < 2; ++ai)
#pragma unroll
            for (int m = 0; m < 4; ++m) {
                const int sq = s0 + ai * 128 + m * 16;
                const pg8::f32x4 sc4 = *(const pg8::f32x4*)(rs + row0 + ai * 128 + m * 16);
#pragma unroll
                for (int bj = 0; bj < 2; ++bj)
#pragma unroll
                    for (int n = 0; n < 2; ++n) {
                        const int cv = cv0 + bj * 128 + n * 16;
                        const pg8::f32x4 v = acc[ai][bj][m][n] * sc4; u32x2 pk; pk.x = pack_bf16(v[0], v[1]); pk.y = pack_bf16(v[2], v[3]);
                        *(u32x2*)(vtm + (size_t)(b * 8 + (cv >> 6)) * SEQ * 64 + (cv & 63) * 64 + (size_t)(sq >> 6) * 4096 + (sq & 63)) = pk;
                    }
            }
    }
};
DI void phase_mla_gemm(KargPtr p, int l, unsigned char* smem_phys) {
    const bf16_t* WQ = p->wt + (size_t)l * W_LAYER + W_UQ;
    const bf16_t* WKV = p->wt + (size_t)l * W_LAYER + W_UKV;
    { EpiUq E; E.qn = p->qn; E.qr = p->qr; E.rs = p->rsq; E.ropetab = p->ropetab; big_gemm<EpiUq, false>(p->ql, WQ, 768, 384, E, smem_phys); }
    { EpiUkvK E; E.kn = p->kn; E.rs = p->rskv; big_gemm<EpiUkvK, false>(p->kvl, WKV, 512, 256, E, smem_phys); }
    { EpiUkvV E; E.vtm = p->vtm; E.rs = p->rskv; big_gemm<EpiUkvV, true>(p->kvl, WKV + (size_t)512 * 256, 512, 256, E, smem_phys); }
}

struct EpiGate {
    static constexpr bool PERM = false, AFTER_DRAIN = false;
    bf16_t* gs0; bf16_t* gs1;
    __device__ __forceinline__ void operator()(const pg8::f32x4 (&acc)[2][2][4][2], const pg8::Unit& u, int wr, int wc, int fr, int fq) const {
        const int br = u.pn >> 2;
        bf16_t* dst = (br == 0 ? gs0 : gs1 + (size_t)(br - 1) * T_TOK * 1024) + (u.pn & 3) * 256 + wc * 32 + fq * 4;
        const int row0 = u.pm * 256 + wr * 64 + fr;
#pragma unroll
        for (int ai = 0; ai < 2; ++ai)
#pragma unroll
            for (int m = 0; m < 4; ++m) {
                bf16_t* rowp = dst + (size_t)(row0 + ai * 128 + m * 16) * 1024;
#pragma unroll
                for (int bj = 0; bj < 2; ++bj)
#pragma unroll
                    for (int n = 0; n < 2; ++n) { const pg8::f32x4 v = acc[ai][bj][m][n]; u32x2 pk; pk.x = pack_bf16(sigmoidf_(v[0]), sigmoidf_(v[1])); pk.y = pack_bf16(sigmoidf_(v[2]), sigmoidf_(v[3])); *(u32x2*)(rowp + bj * 128 + n * 16) = pk; }
            }
    }
};
DI void phase_gate(KargPtr p, int l, unsigned char* smem_phys) {
    EpiGate E; E.gs0 = p->gs0; E.gs1 = p->gs1;
    big_gemm<EpiGate, false>(p->u, p->wt + (size_t)l * W_LAYER + W_GATE, 3072, 1024, E, smem_phys);
}
DI void phase_merge(KargPtr p, int l, unsigned char* smem) {
    const int tid = tidx(), lane = tid & 63, w = tid >> 6, wm = w >> 1, wn = w & 1, r = lane & 31, hh = lane >> 5;
    const bf16_t* WL = p->wt + (size_t)l * W_LAYER;
    for (int it = 0;; ++it) {
        int mt, nt; if (!next_tile(it, 256, 8, mt, nt)) break;
        const int m0 = mt * 128;
        f32x16 mer[2][2]; zero_acc(mer);
#pragma unroll 1
        for (int br = 0; br < 3; ++br) {
            f32x16 acc[2][2]; zero_acc(acc);
            const bf16_t* Y = (br == 0 ? p->qf : br == 1 ? p->qn : p->qs) + (size_t)m0 * 512;
            const bf16_t* WO = WL + (br == 0 ? W_OF : br == 1 ? W_OM : W_OS) + (size_t)nt * 128 * 512;
            gemm_mainloop<64>(WO, 512, Y, 512, 512, acc, smem);
            const bf16_t* G = (br == 0 ? p->gs0 : p->gs1 + (size_t)(br - 1) * T_TOK * 1024) + (size_t)(m0 + wn * 64 + r) * 1024 + nt * 128 + wm * 64 + 4 * hh;
            u32x2 gv[2][2][4];
#pragma unroll
            for (int a = 0; a < 2; ++a)
#pragma unroll
                for (int c = 0; c < 2; ++c)
#pragma unroll
                    for (int g = 0; g < 4; ++g) gv[a][c][g] = *(const u32x2*)(G + (size_t)c * 32 * 1024 + a * 32 + 8 * g);
#pragma unroll
            for (int a = 0; a < 2; ++a)
#pragma unroll
                for (int c = 0; c < 2; ++c)
#pragma unroll
                    for (int g = 0; g < 4; ++g) {
                        const unsigned x0 = gv[a][c][g].x, x1 = gv[a][c][g].y;
                        mer[a][c][4 * g]     += __uint_as_float(x0 << 16) * acc[a][c][4 * g];
                        mer[a][c][4 * g + 1] += __uint_as_float(x0 & 0xffff0000u) * acc[a][c][4 * g + 1];
                        mer[a][c][4 * g + 2] += __uint_as_float(x1 << 16) * acc[a][c][4 * g + 2];
                        mer[a][c][4 * g + 3] += __uint_as_float(x1 & 0xffff0000u) * acc[a][c][4 * g + 3];
                    }
        }
        stage_store_128(mer, p->merged + (size_t)m0 * 1024 + nt * 128, 1024, smem);
    }
}

DI void phase_outproj(KargPtr p, int l, unsigned char* smem_phys) {
    EpiResidual E; E.xin = (l == 0) ? p->x : p->out; E.xout = p->out; E.modl = p->mod + (size_t)l * 8 * 6144; E.gidx = 2;
    big_gemm(p->merged, p->wt + (size_t)l * W_LAYER + W_OUT, 1024, 1024, E, smem_phys);
}
DI void phase_ffn_up(KargPtr p, int l, unsigned char* smem_phys) {
    EpiFfnUp E; E.h = p->h;
    big_gemm(p->u, p->wt + (size_t)l * W_LAYER + W_FGU, 5632, 1024, E, smem_phys);
}
DI void phase_ffn_down(KargPtr p, int l, unsigned char* smem_phys) {
    EpiResidual E; E.xin = p->out; E.xout = p->out; E.modl = p->mod + (size_t)l * 8 * 6144; E.gidx = 5;
    big_gemm(p->h, p->wt + (size_t)l * W_LAYER + W_FD, 1024, 2816, E, smem_phys);
}

DI void run_phase(int ph, int l, unsigned char* smem_phys) {
#ifdef ONLY_PH
    if (ph != ONLY_PH) return;
#endif
    KargPtr p = karg();
    unsigned char* smem = smem_phys + vhalf() * VSMEM;
    switch (ph) {
    case 0: phase_prep(p, smem); break;
    case 1: if (bidx() == 0 && tidx() < 64) __hip_atomic_store((unsigned*)p->kmax + tidx(), 0u, __ATOMIC_RELAXED, __HIP_MEMORY_SCOPE_AGENT);
            phase_norm((l == 0) ? p->x : p->out, p->g_mix + l * 1024, p->mod + (size_t)l * 8 * 6144, 0, 1, p->u); break;
    case 2: phase_inproj(p, l, smem_phys); break;
    case 3: phase_mla_up(p, l, smem); break;
    case 4: phase_attn(p, smem); break;
    case 5: phase_merge(p, l, smem); break;
    case 12: phase_gate(p, l, smem_phys); break;
    case 13: phase_mla_gemm(p, l, smem_phys); break;
    case 6: phase_outproj(p, l, smem_phys); break;
    case 7: phase_norm(p->out, p->g_ffn + l * 1024, p->mod + (size_t)l * 8 * 6144, 3, 4, p->u); break;
    case 8: phase_ffn_up(p, l, smem_phys); break;
    case 9: phase_ffn_down(p, l, smem_phys); break;
    default: phase_final(p); break;
    }
}

#define XB_TMO      128
#define XB_XCNT(j)  (256  + 64 * (j))
#define XB_XSUB(j)  (1280 + 64 * (j))
#define XB_XGEN(j)  (2304 + 64 * (j))
#define XB_TOP      3328
#define XB_TOPGEN   3392
#define XCD_BAR_WORDS 3456
#define XB_SPIN_CAP (1u << 20)
#define LAS __attribute__((address_space(3)))
DI unsigned xb_ld(unsigned* p)              { return __hip_atomic_load(p, __ATOMIC_RELAXED, __HIP_MEMORY_SCOPE_AGENT); }
DI unsigned xb_add(unsigned* p, unsigned v) { return __hip_atomic_fetch_add(p, v, __ATOMIC_RELAXED, __HIP_MEMORY_SCOPE_AGENT); }
DI unsigned xb_xcc_id() { return (unsigned)__builtin_amdgcn_s_getreg((3 << 11) | 20) & 0xFu; }
#define XB_SPIN(cond, bar) do { unsigned _sp = 0; while (cond) { __builtin_amdgcn_s_sleep(1); \
    if ((++_sp & 255u) == 0u) { if (xb_ld(&(bar)[XB_TMO])) break; if (_sp > XB_SPIN_CAP) { atomicAdd(&(bar)[XB_TMO], 1u); break; } } } } while (0)
struct XcdBarrier { unsigned* bar; unsigned x; volatile LAS unsigned* st; };
DI XcdBarrier xcd_barrier_post(unsigned* bar, volatile LAS unsigned* st) {
    XcdBarrier b; b.bar = bar; b.x = xb_xcc_id(); b.st = st;
    if (threadIdx.x == 0) (void)xb_add(&bar[XB_XCNT(b.x)], 1u);
    return b;
}
DI void xcd_barrier_complete(unsigned* bar, unsigned x, unsigned& nloc, unsigned& nx) {
    const unsigned G = gridDim.x * gridDim.y * gridDim.z;
    unsigned sum, cnt, mine, sp = 0u;
    for (;;) {
        sum = 0u; cnt = 0u; mine = 0u;
#pragma unroll
        for (unsigned j = 0; j < 16; ++j) { const unsigned c = xb_ld(&bar[XB_XCNT(j)]); sum += c; cnt += (c > 0u) ? 1u : 0u; mine = (j == x) ? c : mine; }
        if (sum == G) break;
        __builtin_amdgcn_s_sleep(1);
        if ((++sp & 255u) == 0u) { if (xb_ld(&bar[XB_TMO])) break; if (sp > XB_SPIN_CAP) { atomicAdd(&bar[XB_TMO], 1u); break; } }
    }
    nloc = mine > 0u ? mine : 1u; nx = cnt > 0u ? cnt : 1u;
}
DI void xcd_barrier(const XcdBarrier& b) {
    asm volatile("s_waitcnt vmcnt(0)" ::: "memory");
    __syncthreads();
    if (threadIdx.x == 0) {
        unsigned* bar = b.bar;
        __builtin_amdgcn_s_waitcnt(0);
        unsigned nloc = b.st[0], nx = b.st[1];
        if (nloc == 0u) { xcd_barrier_complete(bar, b.x, nloc, nx); b.st[0] = nloc; b.st[1] = nx; }
        const unsigned old = xb_add(&bar[XB_XSUB(b.x)], 1u);
        const unsigned gen = old / nloc;
        if (old + 1u == (gen + 1u) * nloc) {
            __builtin_amdgcn_fence(__ATOMIC_RELEASE, "agent");
            asm volatile("s_waitcnt vmcnt(0)" ::: "memory");
            const unsigned og = xb_add(&bar[XB_TOP], 1u);
            const unsigned tg = og / nx;
            if (og + 1u == (tg + 1u) * nx) xb_add(&bar[XB_TOPGEN], 1u);
            else XB_SPIN(xb_ld(&bar[XB_TOPGEN]) == tg, bar);
            __builtin_amdgcn_fence(__ATOMIC_ACQUIRE, "agent");
            xb_add(&bar[XB_XGEN(b.x)], 1u);
            asm volatile("s_waitcnt vmcnt(0)" ::: "memory");
        } else {
            XB_SPIN(xb_ld(&bar[XB_XGEN(b.x)]) == gen, bar);
            __builtin_amdgcn_fence(__ATOMIC_ACQUIRE, "agent");
            asm volatile("s_waitcnt vmcnt(0)" ::: "memory");
        }
    }
    __syncthreads();
}

#if MEGA
__global__ void __launch_bounds__(512, 2) __attribute__((amdgpu_waves_per_eu(2, 2))) mega_kernel(Params p) {
    extern __shared__ __attribute__((aligned(16))) unsigned char smem[];
    cg::grid_group grid = cg::this_grid();
    volatile LAS unsigned* st = (volatile LAS unsigned*)(smem + SMEM_BYTES - 16);
    if (threadIdx.x == 0) { st[0] = 0u; st[1] = 0u; }
    __syncthreads();
    (void)xcd_barrier_post(karg()->bar, st);
#define xb (XcdBarrier{karg()->bar, xb_xcc_id(), (volatile LAS unsigned*)(smem + SMEM_BYTES - 16)})
    run_phase(0, 0, smem);
    grid.sync();
#pragma unroll 1
    for (int l = 0; l < 2; ++l) {
#pragma unroll 1
        for (int ph = 1; ph <= 9; ++ph) {
            if (ph == 4) { run_phase(13, l, smem); xcd_barrier(xb); }
            if (ph == 5) { run_phase(12, l, smem); xcd_barrier(xb); }
            run_phase(ph, l, smem); xcd_barrier(xb);
#ifdef DBL_PH
            if (ph == DBL_PH) { run_phase(ph, l, smem); xcd_barrier(xb); }
#endif
        }
    }
    run_phase(10, 0, smem);
}
#else
__global__ void __launch_bounds__(512, 2) __attribute__((amdgpu_waves_per_eu(2, 2))) phase_kernel(Params p, int ph, int l) {
    extern __shared__ __attribute__((aligned(16))) unsigned char smem[];
    run_phase(ph, l, smem);
}
#endif

extern "C" void kernel_launch(void* const* d_in, const int* in_sizes, int n_in, void* d_out, int out_size, void* d_ws, size_t ws_size, hipStream_t stream) {
    (void)in_sizes; (void)n_in; (void)out_size;
    Params p{};
    p.x = (const float*)d_in[0]; p.c = (const float*)d_in[1]; p.pos = (const int*)d_in[2];
    p.g_mix = (const float*)d_in[3]; p.w_ada = (const float*)d_in[4]; p.b_ada = (const float*)d_in[5]; p.w_in = (const float*)d_in[6]; p.b_fox_f = (const float*)d_in[7];
    p.g_mla_q = (const float*)d_in[8]; p.w_mla_uq = (const float*)d_in[9]; p.g_mla_kv = (const float*)d_in[10]; p.w_mla_ukv = (const float*)d_in[11];
    p.w_o_fox = (const float*)d_in[12]; p.w_o_mla = (const float*)d_in[13]; p.w_o_sb = (const float*)d_in[14]; p.w_out = (const float*)d_in[15];
    p.g_ffn = (const float*)d_in[16]; p.w_ffn_gate = (const float*)d_in[17]; p.w_ffn_up = (const float*)d_in[18]; p.w_ffn_down = (const float*)d_in[19]; p.g_final = (const float*)d_in[20];
    p.out = (float*)d_out;
    unsigned char* ws = (unsigned char*)d_ws; size_t off = 0;
    auto take = [&](size_t bytes) { unsigned char* q = ws + off; off += (bytes + 255) & ~(size_t)255; return q; };
    p.bar = (unsigned*)take(16384);
    p.kmax = (float*)take(256);
    p.rsq = (float*)take((size_t)T_TOK * 4);
    p.rskv = (float*)take((size_t)T_TOK * 4);
    p.wt = (bf16_t*)take(2 * W_LAYER * 2);
    p.mod = (float*)take(2 * 8 * 6144 * 4);
    p.ropetab = (float*)take((size_t)T_TOK * 16 * 2 * 4);
    p.logf = (float*)take((size_t)64 * SEQ * 4);
    p.cum = (float*)take((size_t)64 * SEQ * 4);
    p.u = (bf16_t*)take((size_t)T_TOK * 1024 * 2);
    p.qf = (bf16_t*)take((size_t)T_TOK * 512 * 2);
    p.kf = (bf16_t*)take((size_t)T_TOK * 512 * 2);
    p.vtf = (bf16_t*)take((size_t)T_TOK * 512 * 2);
    p.qs = (bf16_t*)take((size_t)T_TOK * 512 * 2);
    p.ks = (bf16_t*)take((size_t)T_TOK * 512 * 2);
    p.vts = (bf16_t*)take((size_t)T_TOK * 512 * 2);
    p.qn = (bf16_t*)take((size_t)T_TOK * 512 * 2);
    p.ql = (bf16_t*)take((size_t)T_TOK * 384 * 2);
    p.kvl = (bf16_t*)take((size_t)T_TOK * 256 * 2);
    p.kr = (bf16_t*)take((size_t)T_TOK * 32 * 2);
    p.qr = (bf16_t*)take((size_t)T_TOK * 256 * 2);
    p.kn = (bf16_t*)take((size_t)T_TOK * 512 * 2);
    p.vtm = (bf16_t*)take((size_t)T_TOK * 512 * 2);
    (void)take((size_t)8 << 20);
    p.gs0 = p.ks;
    p.gs1 = p.ql;
    p.gs2 = p.ql + (size_t)T_TOK * 1024;
    p.merged = p.kf;
    p.h = p.qf;
    if (off > ws_size) { fprintf(stderr, "kernel_launch: workspace too small: need %zu, have %zu\n", off, ws_size); return; }

#if MEGA
    static int grid_blocks = 0;
    if (!grid_blocks) {
        int dev = 0, cus = 0, per_cu = 0;
        (void)hipGetDevice(&dev);
        (void)hipDeviceGetAttribute(&cus, hipDeviceAttributeMultiprocessorCount, dev);
        (void)hipFuncSetAttribute((const void*)mega_kernel, hipFuncAttributeMaxDynamicSharedMemorySize, SMEM_BYTES);
        (void)hipOccupancyMaxActiveBlocksPerMultiprocessor(&per_cu, (const void*)mega_kernel, 512, SMEM_BYTES);
        per_cu = 1;
        grid_blocks = cus * per_cu;
        grid_blocks &= ~7;
    }
    (void)hipMemsetAsync(p.bar, 0, 16384, stream);
    void* args[] = {&p};
    hipError_t e = hipLaunchCooperativeKernel((const void*)mega_kernel, dim3(grid_blocks), dim3(512), args, SMEM_BYTES, stream);
    if (e != hipSuccess) fprintf(stderr, "cooperative launch failed: %s (grid %d)\n", hipGetErrorString(e), grid_blocks);
#else
    static bool attr = false;
    if (!attr) { (void)hipFuncSetAttribute((const void*)phase_kernel, hipFuncAttributeMaxDynamicSharedMemorySize, SMEM_BYTES); attr = true; }
    const int G = 512;
    hipLaunchKernelGGL(phase_kernel, dim3(G), dim3(256), SMEM_BYTES, stream, p, 0, 0);
    for (int l = 0; l < 2; ++l)
        for (int ph = 1; ph <= 9; ++ph) hipLaunchKernelGGL(phase_kernel, dim3(G), dim3(256), SMEM_BYTES, stream, p, ph, l);
    hipLaunchKernelGGL(phase_kernel, dim3(G), dim3(256), SMEM_BYTES, stream, p, 10, 0);
#endif
}
```

```cpp
#include <hip/hip_runtime.h>
#include <hip/hip_cooperative_groups.h>
#include <cstdint>
#include <cstdio>
namespace cg = cooperative_groups;

#ifndef MEGA
#define MEGA 1
#endif

typedef unsigned short bf16_t;
typedef short bf16x8 __attribute__((ext_vector_type(8)));
typedef float f32x16 __attribute__((ext_vector_type(16)));
typedef float f32x4 __attribute__((ext_vector_type(4)));
typedef unsigned u32x2 __attribute__((ext_vector_type(2)));
#define DI __device__ __forceinline__
typedef unsigned u32x4 __attribute__((ext_vector_type(4)));
#define GLOAD16(dst, ptr) asm volatile("global_load_dwordx4 %0, %1, off" : "=v"(dst) : "v"(ptr))
#define GLOAD4(dst, ptr)  asm volatile("global_load_dword %0, %1, off" : "=v"(dst) : "v"(ptr))
#define MFMA(a, b, c) __builtin_amdgcn_mfma_f32_32x32x16_bf16((a), (b), (c), 0, 0, 0)

namespace pg8 {
#define PG8_LAS __attribute__((address_space(3)))
typedef unsigned short bf16_t;
typedef short bf16x8 __attribute__((ext_vector_type(8)));
typedef float f32x4 __attribute__((ext_vector_type(4)));
typedef unsigned u32x4 __attribute__((ext_vector_type(4)));
constexpr int BM = 256, BK = 64, HALF = 128, HTB = HALF * BK * 2  , STAGE_BYTES = 8 * HTB, NXCD = 8, WGM = 8;

__host__ __device__ __forceinline__ int lds_byte(int r, int c) { const int st = (r >> 4) * 2 + (c >> 5), rr = r & 15, cc = c & 31, ob = rr * 64 + cc * 2; return st * 1024 + (ob ^ (((ob >> 9) & 1) << 5)); }
__host__ __device__ __forceinline__ void stage_rc(int b, int& R, int& C) { const int st = b / 1024, sb = b % 1024, swz = sb ^ (((sb >> 9) & 1) << 5); R = (st >> 1) * 16 + swz / 64; C = (st & 1) * 32 + (swz % 64) / 2; }
__host__ __device__ __forceinline__ int perm32(int rho) { const int n = rho >> 4, i = rho & 15; return 8 * (i >> 2) + 4 * n + (i & 3); }

struct Unit { int pm, pn; };
struct Gemm { const bf16_t* A; const bf16_t* Bt; int M, N, K; };

struct StaticOrder {
    int nM, nN, nwg, G, c;
    __host__ __device__ void init(int M, int N, int G_, int c_) { nM = M / BM; nN = N / BM; nwg = nM * nN; G = G_; c = c_; }
    __host__ __device__ bool next(int i, Unit& u) const {
        const long L = (long)i * G + c; if (L >= nwg) return false;
        int wgid = (int)L; { const int q = nwg / NXCD, r = nwg % NXCD, xcd = wgid % NXCD, off = wgid / NXCD; wgid = (xcd < r ? xcd * (q + 1) : r * (q + 1) + (xcd - r) * q) + off; }
        const int nig = WGM * nN, gid = wgid / nig, fm = gid * WGM, gsz = (nM - fm) < WGM ? (nM - fm) : WGM;
        u.pm = fm + ((wgid % nig) % gsz); u.pn = (wgid % nig) / gsz; return true;
    }
    __device__ __forceinline__ void a_ready(const Unit&) const {}
    __device__ __forceinline__ void done(const Unit&) const {}
};
template <class Epi, class Sched, bool ALIGN_EPI = false, bool SP2 = false, bool NAT = false>
__device__ __forceinline__ void gemm_phase(PG8_LAS unsigned char* lds, const Gemm g, const Sched& S, const Epi& E) {
    int tid = threadIdx.x; asm volatile("" : "+v"(tid)); const int wid = __builtin_amdgcn_readfirstlane(tid >> 6), lane = tid & 63, wr = wid >> 2, wc = wid & 3, fr = lane & 15, fq = lane >> 4;
    const int K = g.K, nt = K / BK;
    unsigned voffA[2], voffB[2];
#pragma unroll
    for (int i = 0; i < 2; ++i) { int R, C; stage_rc(tid * 16 + i * 8192, R, C); const int Rb = Epi::PERM ? ((R & ~31) + perm32(R & 31)) : R;
        voffA[i] = (unsigned)(R * K + C) * 2u; voffB[i] = (unsigned)(Rb * K + C) * 2u; }
    const size_t kstep = (size_t)(BK * 2);
    const size_t hstep = (size_t)HALF * K * 2;
    const size_t tstep = 2 * hstep;
    const unsigned ldsw = (unsigned)wid * 1024u;
    const int aoff = lds_byte(wr * 64 + fr, fq * 8), boff = lds_byte(wc * 32 + fr, fq * 8);
#define PG8_SA(b, h) (((b) * 2 + (h)) * HTB)
#define PG8_SB(b, h) ((4 + (b) * 2 + (h)) * HTB)
#define PG8_STAGE(bufoff, gbase, voff) do { _Pragma("unroll") for (int _i = 0; _i < 2; ++_i) \
        __builtin_amdgcn_global_load_lds((const unsigned*)((const char*)(gbase) + (voff)[_i]), (PG8_LAS unsigned*)(lds + (bufoff) + ldsw + _i * 8192), 16, 0, 0); } while (0)
#define PG8_LDA(dst, b, h) do { _Pragma("unroll") for (int m = 0; m < 4; ++m) _Pragma("unroll") for (int k = 0; k < 2; ++k) dst[m][k] = *(const PG8_LAS bf16x8*)(lds + PG8_SA(b, h) + aoff + m * 2048 + k * 1024); } while (0)
#define PG8_LDB(dst, b, h) do { _Pragma("unroll") for (int n = 0; n < 2; ++n) _Pragma("unroll") for (int k = 0; k < 2; ++k) dst[n][k] = *(const PG8_LAS bf16x8*)(lds + PG8_SB(b, h) + boff + n * 2048 + k * 1024); } while (0)
#define PG8_MMA(ai, bj, At, Bt) do { __builtin_amdgcn_s_setprio(1); _Pragma("unroll") for (int m = 0; m < 4; ++m) _Pragma("unroll") for (int n = 0; n < 2; ++n) _Pragma("unroll") for (int k = 0; k < 2; ++k) \
        acc[ai][bj][m][n] = NAT ? __builtin_amdgcn_mfma_f32_16x16x32_bf16(At[m][k], Bt[n][k], acc[ai][bj][m][n], 0, 0, 0) : __builtin_amdgcn_mfma_f32_16x16x32_bf16(Bt[n][k], At[m][k], acc[ai][bj][m][n], 0, 0, 0); __builtin_amdgcn_s_setprio(0); } while (0)
#define PG8_WAIT_V(n) asm volatile("s_waitcnt vmcnt(" #n ")" ::: "memory")
#define PG8_WAIT_L(n) asm volatile("s_waitcnt lgkmcnt(" #n ")" ::: "memory")
#define PG8_BAR __builtin_amdgcn_s_barrier()
#define PG8_SCHED __builtin_amdgcn_sched_barrier(0)
    Unit cur, nxt; int ui = 0;
    if (!S.next(0, cur)) return;
    f32x4 acc[2][2][4][2];
#pragma unroll
    for (int a = 0; a < 2; ++a)
#pragma unroll
        for (int b = 0; b < 2; ++b)
#pragma unroll
            for (int m = 0; m < 4; ++m)
#pragma unroll
                for (int n = 0; n < 2; ++n) acc[a][b][m][n] = (f32x4){0.f, 0.f, 0.f, 0.f};
    bf16x8 At[4][2], B0[2][2], B1[2][2];
    const char* cA = (const char*)g.A + (size_t)cur.pm * tstep; const char* cB = (const char*)g.Bt + (size_t)cur.pn * tstep;
    S.a_ready(cur);
    if constexpr (SP2) {
        PG8_STAGE(PG8_SB(0, 0), cB, voffB); PG8_STAGE(PG8_SB(0, 1), cB + hstep, voffB); PG8_STAGE(PG8_SA(0, 0), cA, voffA); PG8_STAGE(PG8_SA(0, 1), cA + hstep, voffA);
        if (wr == 1) PG8_BAR;
        PG8_WAIT_V(2); PG8_BAR;
        PG8_STAGE(PG8_SB(1, 0), cB + kstep, voffB); PG8_STAGE(PG8_SA(1, 0), cA + kstep, voffA); PG8_STAGE(PG8_SB(1, 1), cB + hstep + kstep, voffB);
        PG8_WAIT_V(6); PG8_BAR;
    } else {
        PG8_STAGE(PG8_SB(0, 0), cB, voffB); PG8_STAGE(PG8_SA(0, 0), cA, voffA); PG8_STAGE(PG8_SB(0, 1), cB + hstep, voffB); PG8_STAGE(PG8_SA(0, 1), cA + hstep, voffA);
        if (wr == 1) PG8_BAR;
        PG8_WAIT_V(4); PG8_BAR;
        PG8_STAGE(PG8_SB(1, 0), cB + kstep, voffB); PG8_STAGE(PG8_SA(1, 0), cA + kstep, voffA); PG8_STAGE(PG8_SB(1, 1), cB + hstep + kstep, voffB);
        PG8_WAIT_V(6); PG8_BAR;
    }
    for (;;) {
        const bool has_next = S.next(ui + 1, nxt);
        const char* nA = has_next ? (const char*)g.A + (size_t)nxt.pm * tstep : cA; const char* nB = has_next ? (const char*)g.Bt + (size_t)nxt.pn * tstep : cB;
        for (int t = 0; t < nt; t += 2) {
            const bool last = (t == nt - 2);
            const char* a1 = cA + (size_t)(t + 1) * kstep;
            const char* a2 = last ? nA : cA + (size_t)(t + 2) * kstep; const char* b2 = last ? nB : cB + (size_t)(t + 2) * kstep;
            const char* a3 = a2 + kstep; const char* b3 = b2 + kstep;
            if (last && has_next) S.a_ready(nxt);
            if constexpr (SP2) {
            PG8_LDB(B0, 0, 0); PG8_LDB(B1, 0, 1); PG8_SCHED; PG8_LDA(At, 0, 0); PG8_STAGE(PG8_SA(1, 1), a1 + hstep, voffA);
            PG8_WAIT_V(8); PG8_WAIT_L(0); PG8_BAR; PG8_MMA(0, 0, At, B0); PG8_MMA(0, 1, At, B1); PG8_BAR; PG8_SCHED;
            PG8_LDA(At, 0, 1); PG8_STAGE(PG8_SB(0, 0), b2, voffB); PG8_STAGE(PG8_SB(0, 1), b2 + hstep, voffB); PG8_STAGE(PG8_SA(0, 0), a2, voffA);
            PG8_WAIT_V(8); PG8_WAIT_L(0); PG8_BAR; PG8_MMA(1, 0, At, B0); PG8_MMA(1, 1, At, B1); PG8_BAR; PG8_SCHED;
            PG8_LDB(B0, 1, 0); PG8_LDB(B1, 1, 1); PG8_SCHED; PG8_LDA(At, 1, 0); PG8_STAGE(PG8_SA(0, 1), a2 + hstep, voffA);
            PG8_WAIT_V(8); PG8_WAIT_L(0); PG8_BAR; PG8_MMA(0, 0, At, B0); PG8_MMA(0, 1, At, B1); PG8_BAR; PG8_SCHED;
            PG8_LDA(At, 1, 1); PG8_STAGE(PG8_SB(1, 0), b3, voffB); PG8_STAGE(PG8_SB(1, 1), b3 + hstep, voffB); PG8_STAGE(PG8_SA(1, 0), a3, voffA);
            PG8_WAIT_V(8); PG8_WAIT_L(0); PG8_BAR; PG8_MMA(1, 0, At, B0); PG8_MMA(1, 1, At, B1); PG8_BAR; PG8_SCHED;
            } else {
            PG8_LDB(B0, 0, 0); PG8_SCHED; PG8_LDA(At, 0, 0); PG8_STAGE(PG8_SA(1, 1), a1 + hstep, voffA);
            PG8_WAIT_L(8); PG8_BAR; PG8_WAIT_L(0); PG8_MMA(0, 0, At, B0); PG8_BAR; PG8_SCHED;
            PG8_LDB(B1, 0, 1); PG8_STAGE(PG8_SB(0, 0), b2, voffB);
            PG8_BAR; PG8_WAIT_L(0); PG8_MMA(0, 1, At, B1); PG8_BAR;
            PG8_LDA(At, 0, 1); PG8_STAGE(PG8_SA(0, 0), a2, voffA);
            PG8_BAR; PG8_WAIT_L(0); PG8_MMA(1, 0, At, B0); PG8_BAR; PG8_SCHED;
            PG8_STAGE(PG8_SB(0, 1), b2 + hstep, voffB);
            PG8_WAIT_V(6); PG8_BAR; PG8_MMA(1, 1, At, B1); PG8_BAR;
            PG8_LDB(B0, 1, 0); PG8_SCHED; PG8_LDA(At, 1, 0); PG8_STAGE(PG8_SA(0, 1), a2 + hstep, voffA);
            PG8_WAIT_L(8); PG8_BAR; PG8_WAIT_L(0); PG8_MMA(0, 0, At, B0); PG8_BAR; PG8_SCHED;
            PG8_LDB(B1, 1, 1); PG8_STAGE(PG8_SB(1, 0), b3, voffB);
            PG8_BAR; PG8_WAIT_L(0); PG8_MMA(0, 1, At, B1); PG8_BAR;
            PG8_LDA(At, 1, 1); PG8_STAGE(PG8_SA(1, 0), a3, voffA);
            PG8_BAR; PG8_WAIT_L(0); PG8_MMA(1, 0, At, B0); PG8_BAR; PG8_SCHED;
            PG8_STAGE(PG8_SB(1, 1), b3 + hstep, voffB);
            PG8_WAIT_V(6); PG8_BAR; PG8_MMA(1, 1, At, B1); PG8_BAR;
            }
        }
        if constexpr (ALIGN_EPI) { if (wr == 0) PG8_BAR; }
        if constexpr (!Epi::AFTER_DRAIN) { E(acc, cur, wr, wc, fr, fq); S.done(cur); }
        if (!has_next) break;
#pragma unroll
        for (int a = 0; a < 2; ++a)
#pragma unroll
            for (int b = 0; b < 2; ++b)
#pragma unroll
                for (int m = 0; m < 4; ++m)
#pragma unroll
                    for (int n = 0; n < 2; ++n) acc[a][b][m][n] = (f32x4){0.f, 0.f, 0.f, 0.f};
        cur = nxt; cA = nA; cB = nB; ++ui;
        if constexpr (ALIGN_EPI) { if (wr == 1) PG8_BAR; }
    }
    PG8_WAIT_V(0);
    if constexpr (!ALIGN_EPI) { if (wr == 0) PG8_BAR; }
    PG8_BAR;
    if constexpr (Epi::AFTER_DRAIN) { E.fused(acc, cur, wr, wc, fr, fq, lds, wid, lane); S.done(cur); }
#undef PG8_SA
#undef PG8_SB
#undef PG8_STAGE
#undef PG8_LDA
#undef PG8_LDB
#undef PG8_MMA
#undef PG8_WAIT_V
#undef PG8_WAIT_L
#undef PG8_BAR
#undef PG8_SCHED
}
}

constexpr int T_TOK = 32768;
constexpr int SEQ = 4096;
constexpr float LOG2E = 1.4426950408889634f;
constexpr float FOX_QS = 0.125f * 1.4426950408889634f;
constexpr float MLA_QS = 0.10206207261596575f * 1.4426950408889634f;
constexpr float EPS = 1e-6f;

constexpr size_t W_IN = 0, W_GATE = 4063232, W_UQ = 7208960, W_UKV = 7503872, W_OF = 7766016, W_OM = 8290304, W_OS = 8814592,
                 W_OUT = 9338880, W_FGU = 10387456, W_FD = 16154624, W_LAYER = 19038208;

constexpr int SMEM_BYTES = 2 * 74752 + 64 + 16;

struct Params {
    const float* x; const float* c; const int* pos;
    const float* g_mix; const float* w_ada; const float* b_ada; const float* w_in; const float* b_fox_f;
    const float* g_mla_q; const float* w_mla_uq; const float* g_mla_kv; const float* w_mla_ukv;
    const float* w_o_fox; const float* w_o_mla; const float* w_o_sb; const float* w_out;
    const float* g_ffn; const float* w_ffn_gate; const float* w_ffn_up; const float* w_ffn_down; const float* g_final;
    float* out;
    bf16_t* wt; float* mod; float* ropetab; float* logf; float* cum;
    bf16_t* u; bf16_t* qf; bf16_t* kf; bf16_t* vtf; bf16_t* qs; bf16_t* ks; bf16_t* vts;
    bf16_t* ql; bf16_t* kvl; bf16_t* kr; bf16_t* qn; bf16_t* qr; bf16_t* kn; bf16_t* vtm;
    bf16_t* merged; bf16_t* h;
    unsigned* bar; float* kmax;
    bf16_t* gs0; bf16_t* gs1; bf16_t* gs2;
    float* rsq; float* rskv;
};
typedef const __attribute__((address_space(4))) Params* KargPtr;
#if defined(__HIP_DEVICE_COMPILE__)
__device__ __forceinline__ KargPtr karg() { KargPtr pp = (KargPtr)__builtin_amdgcn_kernarg_segment_ptr(); asm volatile("" : "+s"(pp)); return pp; }
#else
__device__ __forceinline__ KargPtr karg() { return nullptr; }
#endif

__device__ double ROPE_POLY[11] = {-1.0 / 6, 1.0 / 120, -1.0 / 5040, 1.0 / 362880, -1.0 / 39916800,
    -0.5, 1.0 / 24, -1.0 / 720, 1.0 / 40320, -1.0 / 3628800, 1.0 / 479001600};
__device__ const float ROPE_INV[16] = {1.0f, 0.5623413324356079f, 0.3162277638912201f, 0.17782793939113617f, 0.10000000149011612f, 0.05623413249850273f,
    0.03162277489900589f, 0.017782794311642647f, 0.009999999776482582f, 0.005623413249850273f, 0.003162277629598975f, 0.0017782794311642647f,
    0.0010000000474974513f, 0.000562341301701963f, 0.0003162277571391314f, 0.00017782794020604342f};

typedef __bf16 bf16x2_t __attribute__((ext_vector_type(2)));
typedef float f32x2_t __attribute__((ext_vector_type(2)));
DI unsigned pack_bf16(float lo, float hi) { const f32x2_t v = {lo, hi}; const bf16x2_t b = __builtin_convertvector(v, bf16x2_t); return __builtin_bit_cast(unsigned, b); }
DI bf16_t f2bf(float x) { return (bf16_t)(pack_bf16(x, 0.f) & 0xffffu); }
DI int vhalf() { return __builtin_amdgcn_readfirstlane((int)(threadIdx.x >> 8)); }
DI int tidx() { int t = threadIdx.x & 255; asm volatile("" : "+v"(t)); return t; }
DI int bidx() { int t = __builtin_amdgcn_readfirstlane((int)(blockIdx.x * 2 + (threadIdx.x >> 8))); asm volatile("" : "+s"(t)); return t; }
DI int gdim() { int t = gridDim.x * 2; asm volatile("" : "+s"(t)); return t; }
constexpr int VSMEM = 74752;
constexpr int FLAGS_OFF = 2 * VSMEM;
DI float fexp2(float x) { return __builtin_amdgcn_exp2f(x); }
DI float flog2(float x) { return __builtin_amdgcn_logf(x); }
DI float frcp(float x) { return __builtin_amdgcn_rcpf(x); }
DI float sigmoidf_(float x) { return frcp(1.0f + fexp2(-x * LOG2E)); }

DI bool next_tile(int it, int MT, int NT, int& mt, int& nt) {
    const int perx = gdim() >> 3, xcd = bidx() & 7, slot = bidx() >> 3;
    const long L = ((long)it * 8 + xcd) * perx + slot;
    if (L >= (long)MT * NT) return false;
    const int gsz = 8 * NT; const int grp = (int)(L / gsz), wi = (int)(L % gsz);
    mt = grp * 8 + (wi & 7); nt = wi >> 3; return true;
}

template <int BK>
DI void gemm_mainloop(const bf16_t* A, int lda, const bf16_t* B, int ldb, int K, f32x16 (&acc)[2][2], unsigned char* smem) {
    constexpr int CPR = BK / 8;
    constexpr int RPP = 256 / CPR;
    constexpr int NJ = 128 / RPP;
    constexpr int ROWB = BK * 2 + 16;
    constexpr int OPB = 128 * ROWB;
    constexpr int STB = 2 * OPB;
    constexpr int PASSB = RPP * ROWB;
    const int tid = tidx(), lane = tid & 63, w = tid >> 6, wm = w >> 1, wn = w & 1, r = lane & 31, hh = lane >> 5;
    const int lrow = tid / CPR, lcol = (tid % CPR) * 8;
    const bf16_t* ap = A + (size_t)lrow * lda + lcol;
    const bf16_t* bp = B + (size_t)lrow * ldb + lcol;
    const size_t astep = (size_t)RPP * lda, bstep = (size_t)RPP * ldb;
    const int st_off = lrow * ROWB + (tid % CPR) * 16;
    u32x4 ra0, ra1, ra2, ra3, rb0, rb1, rb2, rb3;
    ra0 = *(const u32x4*)(ap); rb0 = *(const u32x4*)(bp);
    ra1 = *(const u32x4*)(ap + astep); rb1 = *(const u32x4*)(bp + bstep);
    if constexpr (NJ == 4) { ra2 = *(const u32x4*)(ap + 2 * astep); rb2 = *(const u32x4*)(bp + 2 * bstep); ra3 = *(const u32x4*)(ap + 3 * astep); rb3 = *(const u32x4*)(bp + 3 * bstep); }
    else { ra2 = ra0; ra3 = ra0; rb2 = rb0; rb3 = rb0; }
#define GEMM_STAGE(D_) do { unsigned char* d_ = (D_); \
        *(u32x4*)(d_) = ra0; *(u32x4*)(d_ + OPB) = rb0; *(u32x4*)(d_ + PASSB) = ra1; *(u32x4*)(d_ + OPB + PASSB) = rb1; \
        if constexpr (NJ == 4) { *(u32x4*)(d_ + 2 * PASSB) = ra2; *(u32x4*)(d_ + OPB + 2 * PASSB) = rb2; *(u32x4*)(d_ + 3 * PASSB) = ra3; *(u32x4*)(d_ + OPB + 3 * PASSB) = rb3; } } while (0)
    GEMM_STAGE(smem + st_off);
    __syncthreads();
    const int nk = K / BK;
    const int rdA = (wm * 64 + r) * ROWB + hh * 16;
    const int rdB = OPB + (wn * 64 + r) * ROWB + hh * 16;
#define GEMM_FRAGS(KS_, A0_, A1_, B0_, B1_) do { \
        A0_ = *(const bf16x8*)(sa + (KS_) * 32); A1_ = *(const bf16x8*)(sa + 32 * ROWB + (KS_) * 32); \
        B0_ = *(const bf16x8*)(sb + (KS_) * 32); B1_ = *(const bf16x8*)(sb + 32 * ROWB + (KS_) * 32); } while (0)
#define GEMM_MFMA4(A0_, A1_, B0_, B1_) do { \
        acc[0][0] = MFMA(A0_, B0_, acc[0][0]); acc[0][1] = MFMA(A0_, B1_, acc[0][1]); \
        acc[1][0] = MFMA(A1_, B0_, acc[1][0]); acc[1][1] = MFMA(A1_, B1_, acc[1][1]); } while (0)
#define GEMM_COMPUTE(BUF_) do { \
        const unsigned char* sa = smem + (BUF_) * STB + rdA; \
        const unsigned char* sb = smem + (BUF_) * STB + rdB; \
        bf16x8 fa0, fa1, fb0, fb1, ga0, ga1, gb0, gb1; \
        GEMM_FRAGS(0, fa0, fa1, fb0, fb1); \
        GEMM_FRAGS(1, ga0, ga1, gb0, gb1); \
        __builtin_amdgcn_sched_barrier(0); \
        GEMM_MFMA4(fa0, fa1, fb0, fb1); \
        if constexpr (BK == 64) { \
            __builtin_amdgcn_sched_barrier(0); \
            GEMM_FRAGS(2, fa0, fa1, fb0, fb1); \
            __builtin_amdgcn_sched_barrier(0); \
            GEMM_MFMA4(ga0, ga1, gb0, gb1); \
            __builtin_amdgcn_sched_barrier(0); \
            GEMM_FRAGS(3, ga0, ga1, gb0, gb1); \
            __builtin_amdgcn_sched_barrier(0); \
            GEMM_MFMA4(fa0, fa1, fb0, fb1); \
        } \
        __builtin_amdgcn_sched_barrier(0); \
        GEMM_MFMA4(ga0, ga1, gb0, gb1); \
    } while (0)
    for (int kt = 0; kt < nk - 1; ++kt) {
        const int buf = kt & 1;
        ap += BK; bp += BK;
        GLOAD16(ra0, ap); GLOAD16(rb0, bp); GLOAD16(ra1, ap + astep); GLOAD16(rb1, bp + bstep);
        if constexpr (NJ == 4) { GLOAD16(ra2, ap + 2 * astep); GLOAD16(rb2, bp + 2 * bstep); GLOAD16(ra3, ap + 3 * astep); GLOAD16(rb3, bp + 3 * bstep); }
        __builtin_amdgcn_sched_barrier(0);
        GEMM_COMPUTE(buf);
        __builtin_amdgcn_sched_barrier(0);
        if constexpr (NJ == 4) asm volatile("s_waitcnt vmcnt(0)" : "+v"(ra0), "+v"(rb0), "+v"(ra1), "+v"(rb1), "+v"(ra2), "+v"(rb2), "+v"(ra3), "+v"(rb3));
        else asm volatile("s_waitcnt vmcnt(0)" : "+v"(ra0), "+v"(rb0), "+v"(ra1), "+v"(rb1));
        GEMM_STAGE(smem + (buf ^ 1) * STB + st_off);
        __syncthreads();
    }
    GEMM_COMPUTE((nk - 1) & 1);
    __syncthreads();
#undef GEMM_COMPUTE
#undef GEMM_MFMA4
#undef GEMM_FRAGS
#undef GEMM_STAGE
}


DI void gemm_big(const bf16_t* P, int ldp, const bf16_t* Q, int ldq, int K, f32x16 (&acc)[2][4], unsigned char* smem) {
    constexpr int ROWB = 80, PB = 128 * ROWB, STB = 384 * ROWB, PASSB = 64 * ROWB;
    const int tid = tidx(), lane = tid & 63, w = tid >> 6, wm = w >> 1, wn = w & 1, r = lane & 31, hh = lane >> 5;
    const int lrow = tid >> 2, lcol = (tid & 3) * 8;
    const bf16_t* pp = P + (size_t)lrow * ldp + lcol;
    const bf16_t* qp = Q + (size_t)lrow * ldq + lcol;
    const size_t pstep = (size_t)64 * ldp, qstep = (size_t)64 * ldq;
    const int st_off = lrow * ROWB + (tid & 3) * 16;
    u32x4 rp0, rp1, rq0, rq1, rq2, rq3;
    rp0 = *(const u32x4*)(pp); rp1 = *(const u32x4*)(pp + pstep);
    rq0 = *(const u32x4*)(qp); rq1 = *(const u32x4*)(qp + qstep); rq2 = *(const u32x4*)(qp + 2 * qstep); rq3 = *(const u32x4*)(qp + 3 * qstep);
#define BIG_STAGE(D_) do { unsigned char* d_ = (D_); \
        *(u32x4*)(d_) = rp0; *(u32x4*)(d_ + PASSB) = rp1; \
        *(u32x4*)(d_ + PB) = rq0; *(u32x4*)(d_ + PB + PASSB) = rq1; *(u32x4*)(d_ + PB + 2 * PASSB) = rq2; *(u32x4*)(d_ + PB + 3 * PASSB) = rq3; } while (0)
    BIG_STAGE(smem + st_off);
    __syncthreads();
    const int nk = K >> 5;
    const int rdP = (wm * 64 + r) * ROWB + hh * 16;
    const int rdQ = PB + (wn * 128 + r) * ROWB + hh * 16;
#define BIG_FRAGS(KS_, A0_, A1_, B0_, B1_, B2_, B3_) do { \
        A0_ = *(const bf16x8*)(sp + (KS_) * 32); A1_ = *(const bf16x8*)(sp + 32 * ROWB + (KS_) * 32); \
        B0_ = *(const bf16x8*)(sq + (KS_) * 32); B1_ = *(const bf16x8*)(sq + 32 * ROWB + (KS_) * 32); \
        B2_ = *(const bf16x8*)(sq + 64 * ROWB + (KS_) * 32); B3_ = *(const bf16x8*)(sq + 96 * ROWB + (KS_) * 32); } while (0)
#define BIG_MFMA8(A0_, A1_, B0_, B1_, B2_, B3_) do { \
        acc[0][0] = MFMA(A0_, B0_, acc[0][0]); acc[0][1] = MFMA(A0_, B1_, acc[0][1]); acc[0][2] = MFMA(A0_, B2_, acc[0][2]); acc[0][3] = MFMA(A0_, B3_, acc[0][3]); \
        acc[1][0] = MFMA(A1_, B0_, acc[1][0]); acc[1][1] = MFMA(A1_, B1_, acc[1][1]); acc[1][2] = MFMA(A1_, B2_, acc[1][2]); acc[1][3] = MFMA(A1_, B3_, acc[1][3]); } while (0)
#define BIG_COMPUTE(BUF_) do { \
        const unsigned char* sp = smem + (BUF_) * STB + rdP; \
        const unsigned char* sq = smem + (BUF_) * STB + rdQ; \
        bf16x8 fa0, fa1, fb0, fb1, fb2, fb3, ga0, ga1, gb0, gb1, gb2, gb3; \
        BIG_FRAGS(0, fa0, fa1, fb0, fb1, fb2, fb3); \
        BIG_FRAGS(1, ga0, ga1, gb0, gb1, gb2, gb3); \
        __builtin_amdgcn_sched_barrier(0); \
        BIG_MFMA8(fa0, fa1, fb0, fb1, fb2, fb3); \
        __builtin_amdgcn_sched_barrier(0); \
        BIG_MFMA8(ga0, ga1, gb0, gb1, gb2, gb3); \
    } while (0)
    for (int kt = 0; kt < nk - 1; ++kt) {
        const int buf = kt & 1;
        pp += 32; qp += 32;
        GLOAD16(rp0, pp); GLOAD16(rq0, qp); GLOAD16(rp1, pp + pstep); GLOAD16(rq1, qp + qstep); GLOAD16(rq2, qp + 2 * qstep); GLOAD16(rq3, qp + 3 * qstep);
        __builtin_amdgcn_sched_barrier(0);
        BIG_COMPUTE(buf);
        __builtin_amdgcn_sched_barrier(0);
        asm volatile("s_waitcnt vmcnt(0)" : "+v"(rp0), "+v"(rp1), "+v"(rq0), "+v"(rq1), "+v"(rq2), "+v"(rq3));
        BIG_STAGE(smem + (buf ^ 1) * STB + st_off);
        __syncthreads();
    }
    BIG_COMPUTE((nk - 1) & 1);
    __syncthreads();
#undef BIG_COMPUTE
#undef BIG_MFMA8
#undef BIG_FRAGS
#undef BIG_STAGE
}
DI void zero_big(f32x16 (&acc)[2][4]) {
#pragma unroll
    for (int a = 0; a < 2; ++a)
#pragma unroll
        for (int b = 0; b < 4; ++b)
#pragma unroll
            for (int i = 0; i < 16; ++i) acc[a][b][i] = 0.f;
}
DI void stage_store_big(const f32x16 (&acc)[2][4], bf16_t* dst, int ld, unsigned char* smem) {
    const int tid = tidx(), lane = tid & 63, w = tid >> 6, wm = w >> 1, wn = w & 1, r = lane & 31, hh = lane >> 5;
#pragma unroll
    for (int qi = 0; qi < 4; ++qi) {
        unsigned char* trow = smem + (wn * 128 + qi * 32 + r) * 272 + (wm * 64 + 4 * hh) * 2;
#pragma unroll
        for (int pi = 0; pi < 2; ++pi)
#pragma unroll
            for (int g = 0; g < 4; ++g) {
                u32x2 pk; pk.x = pack_bf16(acc[pi][qi][4 * g], acc[pi][qi][4 * g + 1]); pk.y = pack_bf16(acc[pi][qi][4 * g + 2], acc[pi][qi][4 * g + 3]);
                *(u32x2*)(trow + (pi * 32 + 8 * g) * 2) = pk;
            }
    }
    __syncthreads();
    const int q0 = tid >> 4, x = tid & 15;
#pragma unroll
    for (int j = 0; j < 16; ++j) {
        const uint4 v = *(const uint4*)(smem + (q0 + 16 * j) * 272 + x * 16);
        *(uint4*)(dst + (size_t)(q0 + 16 * j) * ld + x * 8) = v;
    }
    __syncthreads();
}
DI void scale_big(f32x16 (&acc)[2][4], float sc) {
#pragma unroll
    for (int a = 0; a < 2; ++a)
#pragma unroll
        for (int b = 0; b < 4; ++b)
#pragma unroll
            for (int i = 0; i < 16; ++i) acc[a][b][i] *= sc;
}
DI void scale_big_q(f32x16 (&acc)[2][4], const float* rs, float sc) {
    const int lane = tidx() & 63, wn = (tidx() >> 6) & 1, r = lane & 31;
#pragma unroll
    for (int qi = 0; qi < 4; ++qi) { const float f = rs[wn * 128 + qi * 32 + r] * sc;
#pragma unroll
        for (int pi = 0; pi < 2; ++pi)
#pragma unroll
            for (int i = 0; i < 16; ++i) acc[pi][qi][i] *= f; }
}
DI void scale_big_p(f32x16 (&acc)[2][4], const float* rs) {
    const int lane = tidx() & 63, wm = tidx() >> 7, hh = lane >> 5;
#pragma unroll
    for (int pi = 0; pi < 2; ++pi)
#pragma unroll
        for (int g = 0; g < 4; ++g) { const f32x4 f = *(const f32x4*)(rs + wm * 64 + pi * 32 + 8 * g + 4 * hh);
#pragma unroll
            for (int qi = 0; qi < 4; ++qi)
#pragma unroll
                for (int e = 0; e < 4; ++e) acc[pi][qi][4 * g + e] *= f[e]; }
}
DI long tile_linear(int it, long total) {
    const int perx = gdim() >> 3, xcd = bidx() & 7, slot = bidx() >> 3;
    const long L = ((long)it * 8 + xcd) * perx + slot;
    return L < total ? L : -1;
}
DI void tile_decode(int L, int NT, int& mt, int& nt) { const int gsz = 8 * NT; const int grp = L / gsz, wi = L % gsz; mt = grp * 8 + (wi & 7); nt = wi >> 3; }

DI void zero_acc(f32x16 (&acc)[2][2]) {
#pragma unroll
    for (int a = 0; a < 2; ++a)
#pragma unroll
        for (int b = 0; b < 2; ++b)
#pragma unroll
            for (int i = 0; i < 16; ++i) acc[a][b][i] = 0.f;
}

DI void stage_store_128(const f32x16 (&acc)[2][2], bf16_t* dst, int ld, unsigned char* smem) {
    const int tid = tidx(), lane = tid & 63, w = tid >> 6, wm = w >> 1, wn = w & 1, r = lane & 31, hh = lane >> 5;
#pragma unroll
    for (int qi = 0; qi < 2; ++qi) {
        unsigned char* trow = smem + (wn * 64 + qi * 32 + r) * 272 + (wm * 64 + 4 * hh) * 2;
#pragma unroll
        for (int pi = 0; pi < 2; ++pi)
#pragma unroll
            for (int g = 0; g < 4; ++g) {
                u32x2 pk; pk.x = pack_bf16(acc[pi][qi][4 * g], acc[pi][qi][4 * g + 1]); pk.y = pack_bf16(acc[pi][qi][4 * g + 2], acc[pi][qi][4 * g + 3]);
                *(u32x2*)(trow + (pi * 32 + 8 * g) * 2) = pk;
            }
    }
    __syncthreads();
    const int q0 = tid >> 4, x = tid & 15;
#pragma unroll
    for (int j = 0; j < 8; ++j) {
        const uint4 v = *(const uint4*)(smem + (q0 + 16 * j) * 272 + x * 16);
        *(uint4*)(dst + (size_t)(q0 + 16 * j) * ld + x * 8) = v;
    }
    __syncthreads();
}
DI void stage_store_vt(const f32x16 (&acc)[2][2], bf16_t* vt, int b, int cv0, int s0, unsigned char* smem) {
    const int tid = tidx(), lane = tid & 63, w = tid >> 6, wm = w >> 1, wn = w & 1, r = lane & 31, hh = lane >> 5;
#pragma unroll
    for (int qi = 0; qi < 2; ++qi) {
        unsigned char* trow = smem + (wn * 64 + qi * 32 + r) * 272 + (wm * 64 + 4 * hh) * 2;
#pragma unroll
        for (int pi = 0; pi < 2; ++pi)
#pragma unroll
            for (int g = 0; g < 4; ++g) {
                u32x2 pk; pk.x = pack_bf16(acc[pi][qi][4 * g], acc[pi][qi][4 * g + 1]); pk.y = pack_bf16(acc[pi][qi][4 * g + 2], acc[pi][qi][4 * g + 3]);
                *(u32x2*)(trow + (pi * 32 + 8 * g) * 2) = pk;
            }
    }
    __syncthreads();
    const int q0 = tid >> 4, x = tid & 15;
#pragma unroll
    for (int j = 0; j < 8; ++j) {
        const int cv = cv0 + q0 + 16 * j, sq = s0 + 8 * x;
        const uint4 v = *(const uint4*)(smem + (q0 + 16 * j) * 272 + x * 16);
        *(uint4*)(vt + (size_t)(b * 8 + (cv >> 6)) * SEQ * 64 + (size_t)(sq >> 6) * 4096 + (cv & 63) * 64 + (sq & 63)) = v;
    }
    __syncthreads();
}
DI void scale_acc(f32x16 (&acc)[2][2], float sc) {
#pragma unroll
    for (int a = 0; a < 2; ++a)
#pragma unroll
        for (int b = 0; b < 2; ++b)
#pragma unroll
            for (int i = 0; i < 16; ++i) acc[a][b][i] *= sc;
}
DI void scale_acc_q(f32x16 (&acc)[2][2], const float* rs, float sc) {
    const int lane = tidx() & 63, wn = (tidx() >> 6) & 1, r = lane & 31;
#pragma unroll
    for (int qi = 0; qi < 2; ++qi) { const float f = rs[wn * 64 + qi * 32 + r] * sc;
#pragma unroll
        for (int pi = 0; pi < 2; ++pi)
#pragma unroll
            for (int i = 0; i < 16; ++i) acc[pi][qi][i] *= f; }
}
DI void scale_acc_p(f32x16 (&acc)[2][2], const float* rs) {
    const int lane = tidx() & 63, wm = tidx() >> 7, hh = lane >> 5;
#pragma unroll
    for (int pi = 0; pi < 2; ++pi)
#pragma unroll
        for (int g = 0; g < 4; ++g) { const f32x4 f = *(const f32x4*)(rs + wm * 64 + pi * 32 + 8 * g + 4 * hh);
#pragma unroll
            for (int qi = 0; qi < 2; ++qi)
#pragma unroll
                for (int e = 0; e < 4; ++e) acc[pi][qi][4 * g + e] *= f[e]; }
}

DI int map_col(int map, int n) {
    switch (map) {
    case 1:
        if (n < 1024) return n;
        if (n < 2048) return 2216 + (n - 1024);
        if (n < 2432) return 1544 + (n - 2048);
        if (n < 2688) return 1928 + (n - 2432);
        if (n < 2816) { const int c = n - 2688; if (c < 16) return 2184 + c; if (c < 32) return 2200 + (c - 16); if (c < 40) return 1536 + (c - 32); return -1; }
        if (n < 3328) return 1024 + (n - 2816);
        if (n < 3840) return 3240 + (n - 3328);
        return -1;
    case 2: return 3752 + n;
    case 3:
        if (n < 512) return (n >> 6) * 96 + (n & 63);
        { const int n2 = n - 512; return (n2 >> 5) * 96 + 64 + (n2 & 31); }
    case 4:
        if (n < 512) return (n >> 6) * 128 + (n & 63);
        { const int n2 = n - 512; return (n2 >> 6) * 128 + 64 + (n2 & 63); }
    case 5: return (n >> 5) * 16 + (n & 15);
    default: return n;
    }
}

DI void transpose_tile(const float* __restrict__ src, const float* __restrict__ src2, int ld, int K, bf16_t* __restrict__ dst, int map, const float* __restrict__ kscale, int n0, int k0, float* tile) {
    const int tid = tidx(), tx = tid & 63, ty = tid >> 6;
    const int sc = map_col(map, n0 + tx);
    if (map == 5 && (((n0 + tx) >> 4) & 1)) src = src2;
    const int scc = sc < 0 ? 0 : sc;
    const float* sp = src + (size_t)(k0 + ty) * ld + scc;
    float vals[16];
#pragma unroll
    for (int j = 0; j < 16; ++j) vals[j] = sp[(size_t)(4 * j) * ld];
    if (kscale) {
#pragma unroll
        for (int j = 0; j < 16; ++j) vals[j] *= kscale[k0 + ty + 4 * j];
    }
#pragma unroll
    for (int j = 0; j < 16; ++j) tile[(ty + 4 * j) * 65 + tx] = sc < 0 ? 0.f : vals[j];
    __syncthreads();
    const int n = tid >> 2, kq = (tid & 3) * 16;
    unsigned wv[8];
#pragma unroll
    for (int j = 0; j < 8; ++j) wv[j] = pack_bf16(tile[(kq + 2 * j) * 65 + n], tile[(kq + 2 * j + 1) * 65 + n]);
    uint4* d = (uint4*)(dst + (size_t)(n0 + n) * K + k0 + kq);
    d[0] = make_uint4(wv[0], wv[1], wv[2], wv[3]);
    d[1] = make_uint4(wv[4], wv[5], wv[6], wv[7]);
    __syncthreads();
}

DI void phase_prep(KargPtr p, unsigned char* smem) {
    const int tid = tidx();
    float* fs = (float*)smem;
    constexpr int NW = 9296, NMOD = 192, NROPE = 2048;
    for (int item = bidx(); item < NW + NMOD + NROPE; item += gdim()) {
        if (item < NW) {
            const int l = item / 4648; int ti = item % 4648;
            const float* src; const float* src2 = nullptr; int ld, K, Nd, map; size_t doff; const float* ksc = nullptr;
            if (ti < 992)       { src = p->w_in + (size_t)l * 1024 * 6824; ld = 6824; K = 1024; Nd = 3968; doff = W_IN; map = 1; }
            else if (ti < 1760) { ti -= 992;  src = p->w_in + (size_t)l * 1024 * 6824; ld = 6824; K = 1024; Nd = 3072; doff = W_GATE; map = 2; }
            else if (ti < 1832) { ti -= 1760; src = p->w_mla_uq + (size_t)l * 384 * 768; ld = 768; K = 384; Nd = 768; doff = W_UQ; map = 3; ksc = p->g_mla_q + l * 384; }
            else if (ti < 1896) { ti -= 1832; src = p->w_mla_ukv + (size_t)l * 256 * 1024; ld = 1024; K = 256; Nd = 1024; doff = W_UKV; map = 4; ksc = p->g_mla_kv + l * 256; }
            else if (ti < 2024) { ti -= 1896; src = p->w_o_fox + (size_t)l * 512 * 1024; ld = 1024; K = 512; Nd = 1024; doff = W_OF; map = 0; }
            else if (ti < 2152) { ti -= 2024; src = p->w_o_mla + (size_t)l * 512 * 1024; ld = 1024; K = 512; Nd = 1024; doff = W_OM; map = 0; }
            else if (ti < 2280) { ti -= 2152; src = p->w_o_sb + (size_t)l * 512 * 1024; ld = 1024; K = 512; Nd = 1024; doff = W_OS; map = 0; }
            else if (ti < 2536) { ti -= 2280; src = p->w_out + (size_t)l * 1024 * 1024; ld = 1024; K = 1024; Nd = 1024; doff = W_OUT; map = 0; }
            else if (ti < 3944) { ti -= 2536; src = p->w_ffn_gate + (size_t)l * 1024 * 2816; src2 = p->w_ffn_up + (size_t)l * 1024 * 2816; ld = 2816; K = 1024; Nd = 5632; doff = W_FGU; map = 5; }
            else                { ti -= 3944; src = p->w_ffn_down + (size_t)l * 2816 * 1024; ld = 1024; K = 2816; Nd = 1024; doff = W_FD; map = 0; }
            (void)Nd;
            const int kts = K >> 6; const int ntile = ti / kts, ktile = ti % kts;
            transpose_tile(src, src2, ld, K, p->wt + (size_t)l * W_LAYER + doff, map, ksc, ntile * 64, ktile * 64, fs);
        } else if (item < NW + NMOD) {
            const int mi = item - NW; const int l = mi / 96, c0 = (mi % 96) * 64;
            float* cond = fs;
            float* red = fs + 8192;
            for (int e = tid; e < 8192; e += 256) { const float cv = p->c[e]; cond[e] = cv * sigmoidf_(cv); }
            __syncthreads();
            const int tx = tid & 63, ty = tid >> 6;
            float a0 = 0, a1 = 0, a2 = 0, a3 = 0, a4 = 0, a5 = 0, a6 = 0, a7 = 0;
            const float* wsrc = p->w_ada + (size_t)l * 1024 * 6144 + c0 + tx;
#pragma unroll 8
            for (int k = ty * 256; k < ty * 256 + 256; ++k) {
                const float wv = wsrc[(size_t)k * 6144];
                a0 += cond[k] * wv; a1 += cond[1024 + k] * wv; a2 += cond[2048 + k] * wv; a3 += cond[3072 + k] * wv;
                a4 += cond[4096 + k] * wv; a5 += cond[5120 + k] * wv; a6 += cond[6144 + k] * wv; a7 += cond[7168 + k] * wv;
            }
            float* rr = red + ty * 512 + tx;
            rr[0] = a0; rr[64] = a1; rr[128] = a2; rr[192] = a3; rr[256] = a4; rr[320] = a5; rr[384] = a6; rr[448] = a7;
            __syncthreads();
            for (int o = tid; o < 512; o += 256) {
                const int b = o >> 6, xx = o & 63;
                const float s = red[o] + red[512 + o] + red[1024 + o] + red[1536 + o] + p->b_ada[l * 6144 + c0 + xx];
                p->mod[(size_t)(l * 8 + b) * 6144 + c0 + xx] = s;
            }
            __syncthreads();
        } else {
            const int e = (item - NW - NMOD) * 256 + tid;
            const int i = e & 15, tok = e >> 4;
            const float ang = (float)p->pos[tok] * ROPE_INV[i];
            const double a = (double)ang;
            const double kq = rint(a * 0.63661977236758134308);
            const double rr = fma(-kq, 1.57079632679489661923, a);
            const double r2 = rr * rr;
            const double* C = ROPE_POLY;
            const double sn = rr * (1.0 + r2 * (C[0] + r2 * (C[1] + r2 * (C[2] + r2 * (C[3] + r2 * C[4])))));
            const double cs = 1.0 + r2 * (C[5] + r2 * (C[6] + r2 * (C[7] + r2 * (C[8] + r2 * (C[9] + r2 * C[10])))));
            const int q = ((int)(long long)kq) & 3;
            const double co = (q == 0) ? cs : (q == 1) ? -sn : (q == 2) ? -cs : sn;
            const double si = (q == 0) ? sn : (q == 1) ? cs : (q == 2) ? -sn : -cs;
            p->ropetab[2 * (size_t)e] = (float)co; p->ropetab[2 * (size_t)e + 1] = (float)si;
        }
    }
}

DI float wave_sum(float v) {
#pragma unroll
    for (int o = 32; o >= 1; o >>= 1) v += __shfl_xor(v, o);
    return v;
}
DI void phase_norm(const float* __restrict__ xin, const float* __restrict__ g, const float* __restrict__ modl, int sh_idx, int sc_idx, bf16_t* __restrict__ uout) {
    const int lane = tidx() & 63, w = tidx() >> 6;
    for (int rg = bidx() * 4 + w; rg < T_TOK / 4; rg += gdim() * 4) {
        const int row = rg * 4, b = row >> 12;
        f32x4 v[4][4]; float ss[4];
#pragma unroll
        for (int k = 0; k < 4; ++k) { const f32x4* xr = (const f32x4*)(xin + (size_t)(row + k) * 1024);
#pragma unroll
            for (int j = 0; j < 4; ++j) v[k][j] = xr[lane + 64 * j]; }
#pragma unroll
        for (int k = 0; k < 4; ++k) { float t = 0.f;
#pragma unroll
            for (int j = 0; j < 4; ++j) t += v[k][j][0] * v[k][j][0] + v[k][j][1] * v[k][j][1] + v[k][j][2] * v[k][j][2] + v[k][j][3] * v[k][j][3];
            ss[k] = rsqrtf(wave_sum(t) * (1.0f / 1024.0f) + EPS); }
        const float* mb = modl + (size_t)b * 6144;
#pragma unroll
        for (int j = 0; j < 4; ++j) {
            const int col = 4 * (lane + 64 * j);
            const f32x4 g4 = *(const f32x4*)(g + col), sc4 = *(const f32x4*)(mb + sc_idx * 1024 + col), sh4 = *(const f32x4*)(mb + sh_idx * 1024 + col);
#pragma unroll
            for (int k = 0; k < 4; ++k) {
                float y[4];
#pragma unroll
                for (int e = 0; e < 4; ++e) y[e] = (v[k][j][e] * ss[k]) * g4[e] * (1.0f + sc4[e]) + sh4[e];
                u32x2 pk; pk.x = pack_bf16(y[0], y[1]); pk.y = pack_bf16(y[2], y[3]);
                *(u32x2*)(uout + (size_t)(row + k) * 1024 + col) = pk;
            }
        }
    }
}
DI void phase_final(KargPtr p) {
    const int lane = tidx() & 63, w = tidx() >> 6;
    for (int row = bidx() * 4 + w; row < T_TOK; row += gdim() * 4) {
        f32x4* xr = (f32x4*)(p->out + (size_t)row * 1024);
        f32x4 v[4]; float ss = 0.f;
#pragma unroll
        for (int j = 0; j < 4; ++j) { v[j] = xr[lane + 64 * j]; ss += v[j][0] * v[j][0] + v[j][1] * v[j][1] + v[j][2] * v[j][2] + v[j][3] * v[j][3]; }
        ss = wave_sum(ss);
        const float rstd = rsqrtf(ss * (1.0f / 1024.0f) + EPS);
#pragma unroll
        for (int j = 0; j < 4; ++j) {
            const f32x4 g4 = *(const f32x4*)(p->g_final + 4 * (lane + 64 * j));
            f32x4 o;
#pragma unroll
            for (int e = 0; e < 4; ++e) o[e] = (v[j][e] * rstd) * g4[e];
            xr[lane + 64 * j] = o;
        }
    }
}

struct EpiInprojA {
    static constexpr bool PERM = false, AFTER_DRAIN = false;
    bf16_t* qf; bf16_t* kf; bf16_t* qs; bf16_t* ks; bf16_t* ql; bf16_t* kvl; bf16_t* kr; float* logf; const float* ropetab; const float* bfox;
    __device__ __forceinline__ void operator()(const pg8::f32x4 (&acc)[2][2][4][2], const pg8::Unit& u, int wr, int wc, int fr, int fq) const {
        const int row0 = u.pm * 256 + wr * 64 + fr;
        const int cw = wc * 32 + fq * 4;
#pragma unroll
        for (int bj = 0; bj < 2; ++bj) {
            bf16_t* dst; int ld; float sc = 1.0f; bool special = false;
            if (u.pn < 8) { const int region = u.pn >> 1; dst = (region == 0 ? qf : region == 1 ? kf : region == 2 ? qs : ks) + (u.pn & 1) * 256 + bj * 128; ld = 512; if (region == 0 || region == 2) sc = FOX_QS; }
            else if (u.pn == 8) { dst = ql + bj * 128; ld = 384; }
            else if (u.pn == 9) { if (bj == 0) { dst = ql + 256; ld = 384; } else { dst = kvl; ld = 256; } }
            else { dst = kvl + 128; ld = 256; special = (bj == 1); }
            if (!special) {
#pragma unroll
                for (int ai = 0; ai < 2; ++ai)
#pragma unroll
                    for (int m = 0; m < 4; ++m) {
                        bf16_t* rowp = dst + (size_t)(row0 + ai * 128 + m * 16) * ld + cw;
#pragma unroll
                        for (int n = 0; n < 2; ++n) { const pg8::f32x4 v = acc[ai][bj][m][n] * sc; u32x2 pk; pk.x = pack_bf16(v[0], v[1]); pk.y = pack_bf16(v[2], v[3]); *(u32x2*)(rowp + n * 16) = pk; }
                    }
            } else if (wc == 0) {
#pragma unroll
                for (int ai = 0; ai < 2; ++ai)
#pragma unroll
                    for (int m = 0; m < 4; ++m) {
                        const int t = row0 + ai * 128 + m * 16;
                        const pg8::f32x4 x1 = acc[ai][1][m][0], x2 = acc[ai][1][m][1];
                        const pg8::f32x4 ca = *(const pg8::f32x4*)(ropetab + 2 * (t * 16 + fq * 4)), cb = *(const pg8::f32x4*)(ropetab + 2 * (t * 16 + fq * 4) + 4);
                        const float co[4] = {ca[0], ca[2], cb[0], cb[2]}, si[4] = {ca[1], ca[3], cb[1], cb[3]};
                        float o1[4], o2[4];
#pragma unroll
                        for (int j = 0; j < 4; ++j) { o1[j] = x1[j] * co[j] - x2[j] * si[j]; o2[j] = x1[j] * si[j] + x2[j] * co[j]; }
                        u32x2 p1, p2; p1.x = pack_bf16(o1[0], o1[1]); p1.y = pack_bf16(o1[2], o1[3]); p2.x = pack_bf16(o2[0], o2[1]); p2.y = pack_bf16(o2[2], o2[3]);
                        *(u32x2*)(kr + (size_t)t * 32 + fq * 4) = p1;
                        *(u32x2*)(kr + (size_t)t * 32 + 16 + fq * 4) = p2;
                    }
            } else if (wc == 1 && fq < 2) {
#pragma unroll
                for (int ai = 0; ai < 2; ++ai)
#pragma unroll
                    for (int m = 0; m < 4; ++m) {
                        const int t = row0 + ai * 128 + m * 16, b = t >> 12, sq = t & 4095;
#pragma unroll
                        for (int j = 0; j < 4; ++j) {
                            const int head = fq * 4 + j;
                            const float f = acc[ai][1][m][0][j] + bfox[head];
                            logf[(size_t)(b * 8 + head) * SEQ + sq] = fminf(f, 0.f) - log1pf(expf(-fabsf(f)));
                        }
                    }
            }
        }
    }
};
struct EpiInprojV {
    static constexpr bool PERM = false, AFTER_DRAIN = false;
    bf16_t* vtf; bf16_t* vts;
    __device__ __forceinline__ void operator()(const pg8::f32x4 (&acc)[2][2][4][2], const pg8::Unit& u, int wr, int wc, int fr, int fq) const {
        bf16_t* vt = u.pn < 2 ? vtf : vts;
        const int row0 = u.pm * 256 + wr * 64 + fq * 4, b = row0 >> 12, s0 = row0 & 4095;
        const int cv0 = (u.pn & 1) * 256 + wc * 32 + fr;
#pragma unroll
        for (int bj = 0; bj < 2; ++bj)
#pragma unroll
            for (int n = 0; n < 2; ++n) {
                const int cv = cv0 + bj * 128 + n * 16;
                bf16_t* vp = vt + (size_t)(b * 8 + (cv >> 6)) * SEQ * 64 + (cv & 63) * 64;
#pragma unroll
                for (int ai = 0; ai < 2; ++ai)
#pragma unroll
                    for (int m = 0; m < 4; ++m) { const int sq = s0 + ai * 128 + m * 16; const pg8::f32x4 v = acc[ai][bj][m][n]; u32x2 pk; pk.x = pack_bf16(v[0], v[1]); pk.y = pack_bf16(v[2], v[3]);
                        *(u32x2*)(vp + (size_t)(sq >> 6) * 4096 + (sq & 63)) = pk; }
            }
    }
};
struct EpiFfnUp {
    static constexpr bool PERM = false, AFTER_DRAIN = false;
    bf16_t* h;
    __device__ __forceinline__ void operator()(const pg8::f32x4 (&acc)[2][2][4][2], const pg8::Unit& u, int wr, int wc, int fr, int fq) const {
        const int row0 = u.pm * 256 + wr * 64 + fr;
#pragma unroll
        for (int ai = 0; ai < 2; ++ai)
#pragma unroll
            for (int m = 0; m < 4; ++m) {
                bf16_t* rowp = h + (size_t)(row0 + ai * 128 + m * 16) * 2816 + u.pn * 128 + wc * 16 + fq * 4;
#pragma unroll
                for (int bj = 0; bj < 2; ++bj) {
                    const pg8::f32x4 g = acc[ai][bj][m][0], up = acc[ai][bj][m][1];
                    float hv[4];
#pragma unroll
                    for (int j = 0; j < 4; ++j) hv[j] = g[j] * sigmoidf_(g[j]) * up[j];
                    u32x2 pk; pk.x = pack_bf16(hv[0], hv[1]); pk.y = pack_bf16(hv[2], hv[3]);
                    *(u32x2*)(rowp + bj * 64) = pk;
                }
            }
    }
};
struct EpiResidual {
    static constexpr bool PERM = false, AFTER_DRAIN = false;
    const float* xin; float* xout; const float* modl; int gidx;
    __device__ __forceinline__ void operator()(const pg8::f32x4 (&acc)[2][2][4][2], const pg8::Unit& u, int wr, int wc, int fr, int fq) const {
        const int row0 = u.pm * 256 + wr * 64 + fr, b = row0 >> 12;
        const float* gt = modl + (size_t)b * 6144 + gidx * 1024;
#pragma unroll
        for (int bj = 0; bj < 2; ++bj)
#pragma unroll
            for (int n = 0; n < 2; ++n) {
                const int col = u.pn * 256 + bj * 128 + wc * 32 + n * 16 + fq * 4;
                const pg8::f32x4 g4 = *(const pg8::f32x4*)(gt + col);
                pg8::f32x4 xv[2][4];
#pragma unroll
                for (int ai = 0; ai < 2; ++ai)
#pragma unroll
                    for (int m = 0; m < 4; ++m) xv[ai][m] = *(const pg8::f32x4*)(xin + (size_t)(row0 + ai * 128 + m * 16) * 1024 + col);
#pragma unroll
                for (int ai = 0; ai < 2; ++ai)
#pragma unroll
                    for (int m = 0; m < 4; ++m) *(pg8::f32x4*)(xout + (size_t)(row0 + ai * 128 + m * 16) * 1024 + col) = xv[ai][m] + g4 * acc[ai][bj][m][n];
            }
    }
};
template <class Epi, bool NAT = false>
DI void big_gemm(const bf16_t* A, const bf16_t* Bt, int N, int K, const Epi& E, unsigned char* smem) {
    __syncthreads();
    pg8::StaticOrder S; S.init(T_TOK, N, (int)gridDim.x, (int)blockIdx.x);
    pg8::Gemm g; g.A = A; g.Bt = Bt; g.M = T_TOK; g.N = N; g.K = K;
    pg8::gemm_phase<Epi, pg8::StaticOrder, true, true, NAT>((PG8_LAS unsigned char*)smem, g, S, E);
    __syncthreads();
}

DI void phase_inproj(KargPtr p, int l, unsigned char* smem_phys) {
    const bf16_t* W = p->wt + (size_t)l * W_LAYER + W_IN;
    { EpiInprojA E; E.qf = p->qf; E.kf = p->kf; E.qs = p->qs; E.ks = p->ks; E.ql = p->ql; E.kvl = p->kvl; E.kr = p->kr; E.logf = p->logf; E.ropetab = p->ropetab; E.bfox = p->b_fox_f + l * 8;
      big_gemm<EpiInprojA, false>(p->u, W, 2816, 1024, E, smem_phys); }
    { EpiInprojV E; E.vtf = p->vtf; E.vts = p->vts;
      big_gemm<EpiInprojV, true>(p->u, W + (size_t)2816 * 1024, 1024, 1024, E, smem_phys); }
}

DI void phase_mla_up(KargPtr p, int l, unsigned char* smem) {
    const int tid = tidx(), lane = tid & 63, w = tid >> 6;
    (void)l;
    for (int row = (bidx() * 4 + w) * 8; row < T_TOK; row += gdim() * 32) {
        uint4 a[8], c[8];
#pragma unroll
        for (int k = 0; k < 8; ++k) {
            a[k] = make_uint4(0, 0, 0, 0); c[k] = make_uint4(0, 0, 0, 0);
            if (lane < 48) a[k] = *(const uint4*)(p->ql + (size_t)(row + k) * 384 + lane * 8);
            if (lane < 32) c[k] = *(const uint4*)(p->kvl + (size_t)(row + k) * 256 + lane * 8);
        }
        float sq[8], skv[8];
#pragma unroll
        for (int k = 0; k < 8; ++k) {
            const unsigned ua[4] = {a[k].x, a[k].y, a[k].z, a[k].w}, uc[4] = {c[k].x, c[k].y, c[k].z, c[k].w};
            float s1 = 0.f, s2 = 0.f;
#pragma unroll
            for (int e = 0; e < 4; ++e) { float lo = __uint_as_float(ua[e] << 16), hi = __uint_as_float(ua[e] & 0xffff0000u); s1 += lo * lo + hi * hi;
                                          lo = __uint_as_float(uc[e] << 16); hi = __uint_as_float(uc[e] & 0xffff0000u); s2 += lo * lo + hi * hi; }
            sq[k] = wave_sum(s1); skv[k] = wave_sum(s2);
        }
        if (lane == 0) {
#pragma unroll
            for (int k = 0; k < 8; ++k) { p->rsq[row + k] = rsqrtf(sq[k] * (1.0f / 384.0f) + EPS); p->rskv[row + k] = rsqrtf(skv[k] * (1.0f / 256.0f) + EPS); }
        }
    }
    __syncthreads();
    float* fs = (float*)smem;
    for (int bh = bidx(); bh < 64; bh += gdim()) {
        const f32x4* src = (const f32x4*)(p->logf + (size_t)bh * SEQ + tid * 16);
        f32x4 v[4];
        float run = 0.f;
#pragma unroll
        for (int j = 0; j < 4; ++j) { v[j] = src[j];
#pragma unroll
            for (int e = 0; e < 4; ++e) { run += v[j][e]; v[j][e] = run; } }
        float incl = run;
#pragma unroll
        for (int o = 1; o < 64; o <<= 1) { const float tv = __shfl_up(incl, o); if (lane >= o) incl += tv; }
        if (lane == 63) fs[w] = incl;
        __syncthreads();
        float pre = incl - run;
        for (int ww = 0; ww < w; ++ww) pre += fs[ww];
        f32x4* dst = (f32x4*)(p->cum + (size_t)bh * SEQ + tid * 16);
#pragma unroll
        for (int j = 0; j < 4; ++j) { f32x4 o;
#pragma unroll
            for (int e = 0; e < 4; ++e) o[e] = v[j][e] + pre; dst[j] = o; }
        __syncthreads();
    }
    {
        const int v = bidx();
        if (v < 512) {
            const int bh = v >> 3, part = v & 7;
            const bf16_t* kp = p->kf + (size_t)(bh >> 3) * SEQ * 512 + (bh & 7) * 64 + (size_t)(part * 512 + tid * 2) * 512;
            float mx = 0.f;
#pragma unroll
            for (int rr = 0; rr < 2; ++rr) {
                const uint4* q4 = (const uint4*)(kp + (size_t)rr * 512);
                uint4 vv[8];
#pragma unroll
                for (int c = 0; c < 8; ++c) vv[c] = q4[c];
                float ss = 0.f;
#pragma unroll
                for (int c = 0; c < 8; ++c) { const unsigned uu[4] = {vv[c].x, vv[c].y, vv[c].z, vv[c].w};
#pragma unroll
                    for (int e = 0; e < 4; ++e) { const float lo = __uint_as_float(uu[e] << 16), hi = __uint_as_float(uu[e] & 0xffff0000u); ss += lo * lo + hi * hi; } }
                mx = fmaxf(mx, ss);
            }
#pragma unroll
            for (int o = 32; o >= 1; o >>= 1) mx = fmaxf(mx, __shfl_xor(mx, o));
            if (lane == 0) atomicMax((unsigned*)p->kmax + bh, __float_as_uint(mx));
        }
    }
}

template <int TYPE>
DI void attn_item(KargPtr p, int b, int h, int qb, unsigned char* smem) {
    constexpr int DK = (TYPE == 1) ? 96 : (TYPE == 0 ? 80 : 64), KS = DK / 16, KROWB = (DK + 8) * 2, VROWB = 144;
    constexpr int KBYTES = 64 * KROWB, VBYTES = 64 * VROWB, BUFB = KBYTES + VBYTES + 256;
    const int tid = tidx(), lane = tid & 63, w = tid >> 6, r = lane & 31, hh = lane >> 5;
    const int q0 = qb * 128, qw = q0 + 32 * w, myq = qw + r;
    const size_t tokq = (size_t)b * SEQ + myq;
    unsigned* flags = (unsigned*)(smem - vhalf() * VSMEM + FLAGS_OFF);
    const int w8 = vhalf() * 4 + w;

    bf16x8 qfrag[KS];
    if (TYPE == 1) {
#pragma unroll
        for (int ks = 0; ks < 4; ++ks) qfrag[ks] = *(const bf16x8*)(p->qn + tokq * 512 + h * 64 + ks * 16 + hh * 8);
#pragma unroll
        for (int ks = 4; ks < KS; ++ks) qfrag[ks] = *(const bf16x8*)(p->qr + tokq * 256 + h * 32 + (ks - 4) * 16 + hh * 8);
    } else {
        const bf16_t* qg = (TYPE == 0 ? p->qf : p->qs) + tokq * 512 + h * 64;
#pragma unroll
        for (int ks = 0; ks < 4; ++ks) qfrag[ks] = *(const bf16x8*)(qg + ks * 16 + hh * 8);
        if (TYPE == 0) { const u32x4 one3 = hh == 0 ? (u32x4){0x3F803F80u, 0x00003F80u, 0u, 0u} : (u32x4){0u, 0u, 0u, 0u}; qfrag[KS - 1] = __builtin_bit_cast(bf16x8, one3); }
    }
    const bf16_t* Kg = (TYPE == 0 ? p->kf : TYPE == 1 ? p->kn : p->ks) + (size_t)b * SEQ * 512 + h * 64;
    const bf16_t* Vg = (TYPE == 0 ? p->vtf : TYPE == 1 ? p->vtm : p->vts) + (size_t)(b * 8 + h) * 64 * SEQ;
    const bf16_t* Krg = p->kr + (size_t)b * SEQ * 32;
    const float* cumg = p->cum + (size_t)(b * 8 + h) * SEQ;

    const int ntiles = 2 * qb + 2;
    u32x4 rk0A, rk1A, rv0A, rv1A, rkrA, rk0B, rk1B, rv0B, rv1B, rkrB; float rckA = 0.f, rckB = 0.f;
    { unsigned z_ = 0u; asm volatile("" : "+v"(z_)); rkrA = (u32x4){z_, z_, z_, z_}; rkrB = rkrA; }
    const int ldrow = tid >> 3, ldch = tid & 7;
    const int vpos = 16 * (ldch >> 1) + 4 * (ldch & 1);
#define LOAD_TILE(S, KT_) do { \
        const int k0_ = (KT_) * 64; \
        GLOAD16(rk0##S, Kg + (size_t)(k0_ + ldrow) * 512 + ldch * 8); \
        GLOAD16(rk1##S, Kg + (size_t)(k0_ + 32 + ldrow) * 512 + ldch * 8); \
        GLOAD16(rv0##S, Vg + (size_t)k0_ * 64 + ldrow * 64 + ldch * 8); \
        GLOAD16(rv1##S, Vg + (size_t)k0_ * 64 + (32 + ldrow) * 64 + ldch * 8); \
        if (TYPE == 1) GLOAD16(rkr##S, Krg + (size_t)(k0_ + (tid >> 2)) * 32 + (tid & 3) * 8); \
        if (TYPE == 0) GLOAD4(rck##S, cumg + k0_ + (tid & 63)); \
    } while (0)
#define WAIT_ALL(S) asm volatile("s_waitcnt vmcnt(0)" : "+v"(rk0##S), "+v"(rk1##S), "+v"(rv0##S), "+v"(rv1##S), "+v"(rkr##S), "+v"(rck##S))
#define WAIT_OLD(S) do { if (TYPE == 2) asm volatile("s_waitcnt vmcnt(4)" : "+v"(rk0##S), "+v"(rk1##S), "+v"(rv0##S), "+v"(rv1##S), "+v"(rkr##S), "+v"(rck##S)); \
        else asm volatile("s_waitcnt vmcnt(5)" : "+v"(rk0##S), "+v"(rk1##S), "+v"(rv0##S), "+v"(rv1##S), "+v"(rkr##S), "+v"(rck##S)); } while (0)
#define STORE_TILE(S, BUF_) do { \
        unsigned char* kb_ = smem + (BUF_) * BUFB; unsigned char* vb_ = kb_ + KBYTES; \
        *(u32x4*)(kb_ + ldrow * KROWB + ldch * 16) = rk0##S; \
        *(u32x4*)(kb_ + (32 + ldrow) * KROWB + ldch * 16) = rk1##S; \
        { u32x2 lo, hi; lo.x = rv0##S.x; lo.y = rv0##S.y; hi.x = rv0##S.z; hi.y = rv0##S.w; \
          *(u32x2*)(vb_ + ldrow * VROWB + vpos * 2) = lo; *(u32x2*)(vb_ + ldrow * VROWB + (vpos + 8) * 2) = hi; } \
        { u32x2 lo, hi; lo.x = rv1##S.x; lo.y = rv1##S.y; hi.x = rv1##S.z; hi.y = rv1##S.w; \
          *(u32x2*)(vb_ + (32 + ldrow) * VROWB + vpos * 2) = lo; *(u32x2*)(vb_ + (32 + ldrow) * VROWB + (vpos + 8) * 2) = hi; } \
        if (TYPE == 1) *(u32x4*)(kb_ + (tid >> 2) * KROWB + 128 + (tid & 3) * 16) = rkr##S; \
        if (TYPE == 0) { if (tid < 64) { \
            const float c_ = -rck##S * LOG2E; \
            const unsigned h_ = pack_bf16(c_, 0.f) & 0xffffu; const float r1_ = c_ - __uint_as_float(h_ << 16); \
            const unsigned m_ = pack_bf16(r1_, 0.f) & 0xffffu; const float r2_ = r1_ - __uint_as_float(m_ << 16); \
            const unsigned l_ = pack_bf16(r2_, 0.f) & 0xffffu; \
            *(u32x4*)(kb_ + tid * KROWB + 128) = (u32x4){h_ | (m_ << 16), l_, 0u, 0u}; \
            { unsigned z_ = 0u; asm volatile("" : "+v"(z_)); *(u32x4*)(kb_ + tid * KROWB + 144) = (u32x4){z_, z_, z_, z_}; }        \
            if (tid == 63) *(float*)(vb_ + VBYTES) = c_; } } \
    } while (0)
#define TILE_OF(J_) ((TYPE != 1) ? (ntiles - 1 - ((J_) < ntiles ? (J_) : ntiles - 1)) : ((J_) < ntiles ? (J_) : ntiles - 1))

    f32x16 o0, o1;
#pragma unroll
    for (int i = 0; i < 16; ++i) { o0[i] = 0.f; o1[i] = 0.f; }
    float m = -1e30f, lsum = 0.f, carry = 0.f;
    bool wdone = false;
    float qbound = 0.f;
    if (TYPE == 0) {
        float ss = 0.f;
#pragma unroll
        for (int ks = 0; ks < 4; ++ks) { const u32x4 qq = __builtin_bit_cast(u32x4, qfrag[ks]);
#pragma unroll
            for (int e = 0; e < 4; ++e) { const float lo = __uint_as_float(qq[e] << 16), hi = __uint_as_float(qq[e] & 0xffff0000u); ss += lo * lo + hi * hi; } }
        ss += __shfl_xor(ss, 32);
        qbound = sqrtf(ss * p->kmax[b * 8 + h]) * 1.0201f;
    }

    auto compute = [&](const int kt, const int buf) __attribute__((always_inline)) {
        const unsigned char* kb = smem + buf * BUFB; const unsigned char* vb = kb + KBYTES;
        const int k0 = kt * 64;
        bool need;
        if (TYPE == 0) {
            if (!wdone && k0 <= qw + 31) wdone = (__all(qbound + *(const float*)(vb + VBYTES) - m < -150.f) != 0);
            need = (k0 <= qw + 31) && !wdone;
        }
        else if (TYPE == 1) need = (k0 <= qw);
        else need = (k0 <= qw + 30) && !wdone;
        if (need) {
            f32x16 s0, s1;
#pragma unroll
            for (int i = 0; i < 16; ++i) { s0[i] = 0.f; s1[i] = 0.f; }
#pragma unroll
            for (int ks = 0; ks < KS; ++ks) {
                const bf16x8 a0 = *(const bf16x8*)(kb + r * KROWB + ks * 32 + hh * 16);
                const bf16x8 a1 = *(const bf16x8*)(kb + (32 + r) * KROWB + ks * 32 + hh * 16);
                s0 = MFMA(a0, qfrag[ks], s0); s1 = MFMA(a1, qfrag[ks], s1);
            }
            if (TYPE != 2) {
                if (TYPE == 0) {
                    if (k0 + 63 > qw) {
                        asm volatile("");
                        const int rel = myq - k0 - 4 * hh;
#pragma unroll
                        for (int i = 0; i < 16; ++i) {
                            const int off = 8 * (i >> 2) + (i & 3);
                            if (off > rel) s0[i] = -1e30f;
                            if (off + 32 > rel) s1[i] = -1e30f;
                        }
                    }
                }
                float mx = s0[0];
#pragma unroll
                for (int i = 1; i < 16; ++i) mx = fmaxf(mx, s0[i]);
#pragma unroll
                for (int i = 0; i < 16; ++i) mx = fmaxf(mx, s1[i]);
                mx = fmaxf(mx, __shfl_xor(mx, 32));
                const float mnew = fmaxf(m, mx);
                const float alpha = fexp2(m - mnew);
                m = mnew;
                float ps = 0.f;
#pragma unroll
                for (int i = 0; i < 16; i += 2) {
                    const f32x2_t mm = {mnew, mnew};
                    const f32x2_t d0 = (f32x2_t){s0[i], s0[i + 1]} - mm, d1 = (f32x2_t){s1[i], s1[i + 1]} - mm;
                    s0[i] = fexp2(d0[0]); s0[i + 1] = fexp2(d0[1]); s1[i] = fexp2(d1[0]); s1[i + 1] = fexp2(d1[1]);
                    ps += (s0[i] + s0[i + 1]) + (s1[i] + s1[i + 1]);
                }
                lsum = lsum * alpha + ps;
#pragma unroll
                for (int i = 0; i < 16; ++i) { o0[i] *= alpha; o1[i] *= alpha; }
            } else {
                float lk0[16], lk1[16];
#pragma unroll
                for (int i = 0; i < 16; ++i) {
                    {
                        const float z = s0[i]; const float sp = flog2(1.0f + fexp2(-fabsf(z)));
                        const float lb = fminf(z, 0.f) - sp;
                        s0[i] = lb; lk0[i] = lb - z;
                    }
                    {
                        const float z = s1[i]; const float sp = flog2(1.0f + fexp2(-fabsf(z)));
                        const float lb = fminf(z, 0.f) - sp;
                        s1[i] = lb; lk1[i] = lb - z;
                    }
                }
                if (k0 + 63 >= qw) {
                    asm volatile("");
                    const int rel = myq - k0 - 4 * hh;
#pragma unroll
                    for (int i = 0; i < 16; ++i) {
                        const int off = 8 * (i >> 2) + (i & 3);
                        if (off >= rel) { lk0[i] = 0.f; s0[i] = -1e30f; }
                        if (off + 32 >= rel) { lk1[i] = 0.f; s1[i] = -1e30f; }
                    }
                }
                float run = carry;
#pragma unroll
                for (int g = 3; g >= 0; --g) {
                    const float G = (lk1[4 * g] + lk1[4 * g + 1]) + (lk1[4 * g + 2] + lk1[4 * g + 3]);
                    const float Gp = __shfl_xor(G, 32);
                    const float base = run + (hh == 0 ? Gp : 0.f);
                    const float e3 = base, e2 = e3 + lk1[4 * g + 3], e1 = e2 + lk1[4 * g + 2], e0 = e1 + lk1[4 * g + 1];
                    s1[4 * g + 3] = fexp2(s1[4 * g + 3] + e3); s1[4 * g + 2] = fexp2(s1[4 * g + 2] + e2);
                    s1[4 * g + 1] = fexp2(s1[4 * g + 1] + e1); s1[4 * g] = fexp2(s1[4 * g] + e0);
                    run += G + Gp;
                }
#pragma unroll
                for (int g = 3; g >= 0; --g) {
                    const float G = (lk0[4 * g] + lk0[4 * g + 1]) + (lk0[4 * g + 2] + lk0[4 * g + 3]);
                    const float Gp = __shfl_xor(G, 32);
                    const float base = run + (hh == 0 ? Gp : 0.f);
                    const float e3 = base, e2 = e3 + lk0[4 * g + 3], e1 = e2 + lk0[4 * g + 2], e0 = e1 + lk0[4 * g + 1];
                    s0[4 * g + 3] = fexp2(s0[4 * g + 3] + e3); s0[4 * g + 2] = fexp2(s0[4 * g + 2] + e2);
                    s0[4 * g + 1] = fexp2(s0[4 * g + 1] + e1); s0[4 * g] = fexp2(s0[4 * g] + e0);
                    run += G + Gp;
                }
                carry = run;
            }
#pragma unroll
            for (int s2 = 0; s2 < 2; ++s2) {
                unsigned pk0[4], pk1[4];
#pragma unroll
                for (int j = 0; j < 4; ++j) { pk0[j] = pack_bf16(s0[8 * s2 + 2 * j], s0[8 * s2 + 2 * j + 1]); pk1[j] = pack_bf16(s1[8 * s2 + 2 * j], s1[8 * s2 + 2 * j + 1]); }
                const uint4 u0 = make_uint4(pk0[0], pk0[1], pk0[2], pk0[3]), u1 = make_uint4(pk1[0], pk1[1], pk1[2], pk1[3]);
                const bf16x8 pf0 = __builtin_bit_cast(bf16x8, u0), pf1 = __builtin_bit_cast(bf16x8, u1);
                const bf16x8 v00 = *(const bf16x8*)(vb + r * VROWB + (16 * s2 + 8 * hh) * 2);
                const bf16x8 v01 = *(const bf16x8*)(vb + (32 + r) * VROWB + (16 * s2 + 8 * hh) * 2);
                const bf16x8 v10 = *(const bf16x8*)(vb + r * VROWB + (32 + 16 * s2 + 8 * hh) * 2);
                const bf16x8 v11 = *(const bf16x8*)(vb + (32 + r) * VROWB + (32 + 16 * s2 + 8 * hh) * 2);
                o0 = MFMA(v00, pf0, o0); o1 = MFMA(v01, pf0, o1);
                o0 = MFMA(v10, pf1, o0); o1 = MFMA(v11, pf1, o1);
            }
        }
    };
#define SB_FLAGS(N_) do { if (TYPE != 1) { if (TYPE == 2) wdone = (__all(carry < -170.f) != 0); if (lane == 0) flags[((N_) & 1) * 8 + w8] = wdone ? 1u : 0u; } } while (0)
#define SB_DONE(N_) (TYPE != 1 && ((flags[((N_) & 1) * 8] & flags[((N_) & 1) * 8 + 1] & flags[((N_) & 1) * 8 + 2] & flags[((N_) & 1) * 8 + 3] & flags[((N_) & 1) * 8 + 4] & flags[((N_) & 1) * 8 + 5] & flags[((N_) & 1) * 8 + 6] & flags[((N_) & 1) * 8 + 7]) != 0u))
    __syncthreads();
    if (TYPE != 1 && tid < 16) flags[tid] = 0;
    LOAD_TILE(A, TILE_OF(0));
    WAIT_ALL(A);
    STORE_TILE(A, 0);
    LOAD_TILE(A, TILE_OF(1));
    __syncthreads();
    for (int n = 0; n < ntiles; n += 2) {
        LOAD_TILE(B, TILE_OF(n + 2));
        __builtin_amdgcn_sched_barrier(0);
        compute(TILE_OF(n), 0);
        __builtin_amdgcn_sched_barrier(0);
        WAIT_OLD(A);
        STORE_TILE(A, 1);
        SB_FLAGS(n);
        __syncthreads();
        if (SB_DONE(n)) break;
        if (n + 1 >= ntiles) break;
        LOAD_TILE(A, TILE_OF(n + 3));
        __builtin_amdgcn_sched_barrier(0);
        compute(TILE_OF(n + 1), 1);
        __builtin_amdgcn_sched_barrier(0);
        WAIT_OLD(B);
        STORE_TILE(B, 0);
        SB_FLAGS(n + 1);
        __syncthreads();
        if (SB_DONE(n + 1)) break;
    }
    asm volatile("s_waitcnt vmcnt(0)" : "+v"(rk0A), "+v"(rk1A), "+v"(rv0A), "+v"(rv1A), "+v"(rkrA), "+v"(rckA), "+v"(rk0B), "+v"(rk1B), "+v"(rv0B), "+v"(rv1B), "+v"(rkrB), "+v"(rckB));
    float inv = 1.0f;
    if (TYPE != 2) { const float lt = lsum + __shfl_xor(lsum, 32); inv = frcp(lt); }
    bf16_t* yg = (TYPE == 0 ? p->qf : TYPE == 1 ? p->qn : p->qs) + tokq * 512 + h * 64;
#pragma unroll
    for (int g = 0; g < 4; ++g) {
        u32x2 a, c2;
        a.x = pack_bf16(o0[4 * g] * inv, o0[4 * g + 1] * inv); a.y = pack_bf16(o0[4 * g + 2] * inv, o0[4 * g + 3] * inv);
        c2.x = pack_bf16(o1[4 * g] * inv, o1[4 * g + 1] * inv); c2.y = pack_bf16(o1[4 * g + 2] * inv, o1[4 * g + 3] * inv);
        *(u32x2*)(yg + 8 * g + 4 * hh) = a;
        *(u32x2*)(yg + 32 + 8 * g + 4 * hh) = c2;
    }
}

DI void phase_attn(KargPtr p, unsigned char* smem) {
    for (int idx = bidx(); idx < 6144; idx += gdim()) {
        if (idx < 4096) {
            const int j = idx >> 9, g = (idx >> 7) & 3, rem = idx & 127, bh = ((rem & 63) + 13 * j) & 63;
            const int qb = 31 - 4 * j - ((j & 1) ? 3 - g : g);
            const int type = ((rem >> 6) + j) & 1;
            if (type == 0) attn_item<0>(p, bh >> 3, bh & 7, qb, smem);
            else attn_item<1>(p, bh >> 3, bh & 7, qb, smem);
        } else {
            const int j = idx - 4096; const int qb = 31 - (j >> 6), bh = j & 63;
            attn_item<2>(p, bh >> 3, bh & 7, qb, smem);
        }
    }
}

struct EpiUq {
    static constexpr bool PERM = false, AFTER_DRAIN = false;
    bf16_t* qn; bf16_t* qr; const float* rs; const float* ropetab;
    __device__ __forceinline__ void operator()(const pg8::f32x4 (&acc)[2][2][4][2], const pg8::Unit& u, int wr, int wc, int fr, int fq) const {
        const int row0 = u.pm * 256 + wr * 64 + fr;
#pragma unroll
        for (int ai = 0; ai < 2; ++ai)
#pragma unroll
            for (int m = 0; m < 4; ++m) {
                const int t = row0 + ai * 128 + m * 16;
                const float sc = rs[t] * MLA_QS;
                if (u.pn < 2) {
                    bf16_t* rowp = qn + (size_t)t * 512 + u.pn * 256 + wc * 32 + fq * 4;
#pragma unroll
                    for (int bj = 0; bj < 2; ++bj)
#pragma unroll
                        for (int n = 0; n < 2; ++n) { const pg8::f32x4 v = acc[ai][bj][m][n] * sc; u32x2 pk; pk.x = pack_bf16(v[0], v[1]); pk.y = pack_bf16(v[2], v[3]); *(u32x2*)(rowp + bj * 128 + n * 16) = pk; }
                } else {
                    const pg8::f32x4 ca = *(const pg8::f32x4*)(ropetab + 2 * (t * 16 + fq * 4)), cb = *(const pg8::f32x4*)(ropetab + 2 * (t * 16 + fq * 4) + 4);
                    const float co[4] = {ca[0], ca[2], cb[0], cb[2]}, si[4] = {ca[1], ca[3], cb[1], cb[3]};
#pragma unroll
                    for (int bj = 0; bj < 2; ++bj) {
                        const pg8::f32x4 x1 = acc[ai][bj][m][0] * sc, x2 = acc[ai][bj][m][1] * sc;
                        float o1[4], o2[4];
#pragma unroll
                        for (int j = 0; j < 4; ++j) { o1[j] = x1[j] * co[j] - x2[j] * si[j]; o2[j] = x1[j] * si[j] + x2[j] * co[j]; }
                        u32x2 p1, p2; p1.x = pack_bf16(o1[0], o1[1]); p1.y = pack_bf16(o1[2], o1[3]); p2.x = pack_bf16(o2[0], o2[1]); p2.y = pack_bf16(o2[2], o2[3]);
                        bf16_t* hp = qr + (size_t)t * 256 + (bj * 4 + wc) * 32 + fq * 4;
                        *(u32x2*)hp = p1; *(u32x2*)(hp + 16) = p2;
                    }
                }
            }
    }
};
struct EpiUkvK {
    static constexpr bool PERM = false, AFTER_DRAIN = false;
    bf16_t* kn; const float* rs;
    __device__ __forceinline__ void operator()(const pg8::f32x4 (&acc)[2][2][4][2], const pg8::Unit& u, int wr, int wc, int fr, int fq) const {
        const int row0 = u.pm * 256 + wr * 64 + fr;
#pragma unroll
        for (int ai = 0; ai < 2; ++ai)
#pragma unroll
            for (int m = 0; m < 4; ++m) {
                const int t = row0 + ai * 128 + m * 16;
                const float sc = rs[t];
                bf16_t* rowp = kn + (size_t)t * 512 + u.pn * 256 + wc * 32 + fq * 4;
#pragma unroll
                for (int bj = 0; bj < 2; ++bj)
#pragma unroll
                    for (int n = 0; n < 2; ++n) { const pg8::f32x4 v = acc[ai][bj][m][n] * sc; u32x2 pk; pk.x = pack_bf16(v[0], v[1]); pk.y = pack_bf16(v[2], v[3]); *(u32x2*)(rowp + bj * 128 + n * 16) = pk; }
            }
    }
};
struct EpiUkvV {
    static constexpr bool PERM = false, AFTER_DRAIN = false;
    bf16_t* vtm; const float* rs;
    __device__ __forceinline__ void operator()(const pg8::f32x4 (&acc)[2][2][4][2], const pg8::Unit& u, int wr, int wc, int fr, int fq) const {
        const int row0 = u.pm * 256 + wr * 64 + fq * 4, b = row0 >> 12, s0 = row0 & 4095;
        const int cv0 = u.pn * 256 + wc * 32 + fr;
#pragma unroll
        for (int ai = 0; ai < 2; ++ai)
#pragma unroll
            for (int m = 0; m < 4; ++m) {
                const int sq = s0 + ai * 128 + m * 16;
                const pg8::f32x4 sc4 = *(const pg8::f32x4*)(rs + row0 + ai * 128 + m * 16);
#pragma unroll
                for (int bj = 0; bj < 2; ++bj)
#pragma unroll
                    for (int n = 0; n < 2; ++n) {
                        const int cv = cv0 + bj * 128 + n * 16;
                        const pg8::f32x4 v = acc[ai][bj][m][n] * sc4; u32x2 pk; pk.x = pack_bf16(v[0], v[1]); pk.y = pack_bf16(v[2], v[3]);
                        *(u32x2*)(vtm + (size_t)(b * 8 + (cv >> 6)) * SEQ * 64 + (cv & 63) * 64 + (size_t)(sq >> 6) * 4096 + (sq & 63)) = pk;
                    }
            }
    }
};
DI void phase_mla_gemm(KargPtr p, int l, unsigned char* smem_phys) {
    const bf16_t* WQ = p->wt + (size_t)l * W_LAYER + W_UQ;
    const bf16_t* WKV = p->wt + (size_t)l * W_LAYER + W_UKV;
    { EpiUq E; E.qn = p->qn; E.qr = p->qr; E.rs = p->rsq; E.ropetab = p->ropetab; big_gemm<EpiUq, false>(p->ql, WQ, 768, 384, E, smem_phys); }
    { EpiUkvK E; E.kn = p->kn; E.rs = p->rskv; big_gemm<EpiUkvK, false>(p->kvl, WKV, 512, 256, E, smem_phys); }
    { EpiUkvV E; E.vtm = p->vtm; E.rs = p->rskv; big_gemm<EpiUkvV, true>(p->kvl, WKV + (size_t)512 * 256, 512, 256, E, smem_phys); }
}

struct EpiGate {
    static constexpr bool PERM = false, AFTER_DRAIN = false;
    bf16_t* gs0; bf16_t* gs1;
    __device__ __forceinline__ void operator()(const pg8::f32x4 (&acc)[2][2][4][2], const pg8::Unit& u, int wr, int wc, int fr, int fq) const {
        const int br = u.pn >> 2;
        bf16_t* dst = (br == 0 ? gs0 : gs1 + (size_t)(br - 1) * T_TOK * 1024) + (u.pn & 3) * 256 + wc * 32 + fq * 4;
        const int row0 = u.pm * 256 + wr * 64 + fr;
#pragma unroll
        for (int ai = 0; ai < 2; ++ai)
#pragma unroll
            for (int m = 0; m < 4; ++m) {
                bf16_t* rowp = dst + (size_t)(row0 + ai * 128 + m * 16) * 1024;
#pragma unroll
                for (int bj = 0; bj < 2; ++bj)
#pragma unroll
                    for (int n = 0; n < 2; ++n) { const pg8::f32x4 v = acc[ai][bj][m][n]; u32x2 pk; pk.x = pack_bf16(sigmoidf_(v[0]), sigmoidf_(v[1])); pk.y = pack_bf16(sigmoidf_(v[2]), sigmoidf_(v[3])); *(u32x2*)(rowp + bj * 128 + n * 16) = pk; }
            }
    }
};
DI void phase_gate(KargPtr p, int l, unsigned char* smem_phys) {
    EpiGate E; E.gs0 = p->gs0; E.gs1 = p->gs1;
    big_gemm<EpiGate, false>(p->u, p->wt + (size_t)l * W_LAYER + W_GATE, 3072, 1024, E, smem_phys);
}
DI void phase_merge(KargPtr p, int l, unsigned char* smem) {
    const int tid = tidx(), lane = tid & 63, w = tid >> 6, wm = w >> 1, wn = w & 1, r = lane & 31, hh = lane >> 5;
    const bf16_t* WL = p->wt + (size_t)l * W_LAYER;
    for (int it = 0;; ++it) {
        int mt, nt; if (!next_tile(it, 256, 8, mt, nt)) break;
        const int m0 = mt * 128;
        f32x16 mer[2][2]; zero_acc(mer);
#pragma unroll 1
        for (int br = 0; br < 3; ++br) {
            f32x16 acc[2][2]; zero_acc(acc);
            const bf16_t* Y = (br == 0 ? p->qf : br == 1 ? p->qn : p->qs) + (size_t)m0 * 512;
            const bf16_t* WO = WL + (br == 0 ? W_OF : br == 1 ? W_OM : W_OS) + (size_t)nt * 128 * 512;
            gemm_mainloop<64>(WO, 512, Y, 512, 512, acc, smem);
            const bf16_t* G = (br == 0 ? p->gs0 : p->gs1 + (size_t)(br - 1) * T_TOK * 1024) + (size_t)(m0 + wn * 64 + r) * 1024 + nt * 128 + wm * 64 + 4 * hh;
            u32x2 gv[2][2][4];
#pragma unroll
            for (int a = 0; a < 2; ++a)
#pragma unroll
                for (int c = 0; c < 2; ++c)
#pragma unroll
                    for (int g = 0; g < 4; ++g) gv[a][c][g] = *(const u32x2*)(G + (size_t)c * 32 * 1024 + a * 32 + 8 * g);
#pragma unroll
            for (int a = 0; a < 2; ++a)
#pragma unroll
                for (int c = 0; c < 2; ++c)
#pragma unroll
                    for (int g = 0; g < 4; ++g) {
                        const unsigned x0 = gv[a][c][g].x, x1 = gv[a][c][g].y;
                        mer[a][c][4 * g]     += __uint_as_float(x0 << 16) * acc[a][c][4 * g];
                        mer[a][c][4 * g + 1] += __uint_as_float(x0 & 0xffff0000u) * acc[a][c][4 * g + 1];
                        mer[a][c][4 * g + 2] += __uint_as_float(x1 << 16) * acc[a][c][4 * g + 2];
                        mer[a][c][4 * g + 3] += __uint_as_float(x1 & 0xffff0000u) * acc[a][c][4 * g + 3];
                    }
        }
        stage_store_128(mer, p->merged + (size_t)m0 * 1024 + nt * 128, 1024, smem);
    }
}

DI void phase_outproj(KargPtr p, int l, unsigned char* smem_phys) {
    EpiResidual E; E.xin = (l == 0) ? p->x : p->out; E.xout = p->out; E.modl = p->mod + (size_t)l * 8 * 6144; E.gidx = 2;
    big_gemm(p->merged, p->wt + (size_t)l * W_LAYER + W_OUT, 1024, 1024, E, smem_phys);
}
DI void phase_ffn_up(KargPtr p, int l, unsigned char* smem_phys) {
    EpiFfnUp E; E.h = p->h;
    big_gemm(p->u, p->wt + (size_t)l * W_LAYER + W_FGU, 5632, 1024, E, smem_phys);
}
DI void phase_ffn_down(KargPtr p, int l, unsigned char* smem_phys) {
    EpiResidual E; E.xin = p->out; E.xout = p->out; E.modl = p->mod + (size_t)l * 8 * 6144; E.gidx = 5;
    big_gemm(p->h, p->wt + (size_t)l * W_LAYER + W_FD, 1024, 2816, E, smem_phys);
}

DI void run_phase(int ph, int l, unsigned char* smem_phys) {
#ifdef ONLY_PH
    if (ph != ONLY_PH) return;
#endif
    KargPtr p = karg();
    unsigned char* smem = smem_phys + vhalf() * VSMEM;
    switch (ph) {
    case 0: phase_prep(p, smem); break;
    case 1: if (bidx() == 0 && tidx() < 64) __hip_atomic_store((unsigned*)p->kmax + tidx(), 0u, __ATOMIC_RELAXED, __HIP_MEMORY_SCOPE_AGENT);
            phase_norm((l == 0) ? p->x : p->out, p->g_mix + l * 1024, p->mod + (size_t)l * 8 * 6144, 0, 1, p->u); break;
    case 2: phase_inproj(p, l, smem_phys); break;
    case 3: phase_mla_up(p, l, smem); break;
    case 4: phase_attn(p, smem); break;
    case 5: phase_merge(p, l, smem); break;
    case 12: phase_gate(p, l, smem_phys); break;
    case 13: phase_mla_gemm(p, l, smem_phys); break;
    case 6: phase_outproj(p, l, smem_phys); break;
    case 7: phase_norm(p->out, p->g_ffn + l * 1024, p->mod + (size_t)l * 8 * 6144, 3, 4, p->u); break;
    case 8: phase_ffn_up(p, l, smem_phys); break;
    case 9: phase_ffn_down(p, l, smem_phys); break;
    default: phase_final(p); break;
    }
}

#define XB_TMO      128
#define XB_XCNT(j)  (256  + 64 * (j))
#define XB_XSUB(j)  (1280 + 64 * (j))
#define XB_XGEN(j)  (2304 + 64 * (j))
#define XB_TOP      3328
#define XB_TOPGEN   3392
#define XCD_BAR_WORDS 3456
#define XB_SPIN_CAP (1u << 20)
#define LAS __attribute__((address_space(3)))
DI unsigned xb_ld(unsigned* p)              { return __hip_atomic_load(p, __ATOMIC_RELAXED, __HIP_MEMORY_SCOPE_AGENT); }
DI unsigned xb_add(unsigned* p, unsigned v) { return __hip_atomic_fetch_add(p, v, __ATOMIC_RELAXED, __HIP_MEMORY_SCOPE_AGENT); }
DI unsigned xb_xcc_id() { return (unsigned)__builtin_amdgcn_s_getreg((3 << 11) | 20) & 0xFu; }
#define XB_SPIN(cond, bar) do { unsigned _sp = 0; while (cond) { __builtin_amdgcn_s_sleep(1); \
    if ((++_sp & 255u) == 0u) { if (xb_ld(&(bar)[XB_TMO])) break; if (_sp > XB_SPIN_CAP) { atomicAdd(&(bar)[XB_TMO], 1u); break; } } } } while (0)
struct XcdBarrier { unsigned* bar; unsigned x; volatile LAS unsigned* st; };
DI XcdBarrier xcd_barrier_post(unsigned* bar, volatile LAS unsigned* st) {
    XcdBarrier b; b.bar = bar; b.x = xb_xcc_id(); b.st = st;
    if (threadIdx.x == 0) (void)xb_add(&bar[XB_XCNT(b.x)], 1u);
    return b;
}
DI void xcd_barrier_complete(unsigned* bar, unsigned x, unsigned& nloc, unsigned& nx) {
    const unsigned G = gridDim.x * gridDim.y * gridDim.z;
    unsigned sum, cnt, mine, sp = 0u;
    for (;;) {
        sum = 0u; cnt = 0u; mine = 0u;
#pragma unroll
        for (unsigned j = 0; j < 16; ++j) { const unsigned c = xb_ld(&bar[XB_XCNT(j)]); sum += c; cnt += (c > 0u) ? 1u : 0u; mine = (j == x) ? c : mine; }
        if (sum == G) break;
        __builtin_amdgcn_s_sleep(1);
        if ((++sp & 255u) == 0u) { if (xb_ld(&bar[XB_TMO])) break; if (sp > XB_SPIN_CAP) { atomicAdd(&bar[XB_TMO], 1u); break; } }
    }
    nloc = mine > 0u ? mine : 1u; nx = cnt > 0u ? cnt : 1u;
}
DI void xcd_barrier(const XcdBarrier& b) {
    asm volatile("s_waitcnt vmcnt(0)" ::: "memory");
    __syncthreads();
    if (threadIdx.x == 0) {
        unsigned* bar = b.bar;
        __builtin_amdgcn_s_waitcnt(0);
        unsigned nloc = b.st[0], nx = b.st[1];
        if (nloc == 0u) { xcd_barrier_complete(bar, b.x, nloc, nx); b.st[0] = nloc; b.st[1] = nx; }
        const unsigned old = xb_add(&bar[XB_XSUB(b.x)], 1u);
        const unsigned gen = old / nloc;
        if (old + 1u == (gen + 1u) * nloc) {
            __builtin_amdgcn_fence(__ATOMIC_RELEASE, "agent");
            asm volatile("s_waitcnt vmcnt(0)" ::: "memory");
            const unsigned og = xb_add(&bar[XB_TOP], 1u);
            const unsigned tg = og / nx;
            if (og + 1u == (tg + 1u) * nx) xb_add(&bar[XB_TOPGEN], 1u);
            else XB_SPIN(xb_ld(&bar[XB_TOPGEN]) == tg, bar);
            __builtin_amdgcn_fence(__ATOMIC_ACQUIRE, "agent");
            xb_add(&bar[XB_XGEN(b.x)], 1u);
            asm volatile("s_waitcnt vmcnt(0)" ::: "memory");
        } else {
            XB_SPIN(xb_ld(&bar[XB_XGEN(b.x)]) == gen, bar);
            __builtin_amdgcn_fence(__ATOMIC_ACQUIRE, "agent");
            asm volatile("s_waitcnt vmcnt(0)" ::: "memory");
        }
    }
    __syncthreads();
}

#if MEGA
__global__ void __launch_bounds__(512, 2) __attribute__((amdgpu_waves_per_eu(2, 2))) mega_kernel(Params p) {
    extern __shared__ __attribute__((aligned(16))) unsigned char smem[];
    cg::grid_group grid = cg::this_grid();
    volatile LAS unsigned* st = (volatile LAS unsigned*)(smem + SMEM_BYTES - 16);
    if (threadIdx.x == 0) { st[0] = 0u; st[1] = 0u; }
    __syncthreads();
    (void)xcd_barrier_post(karg()->bar, st);
#define xb (XcdBarrier{karg()->bar, xb_xcc_id(), (volatile LAS unsigned*)(smem + SMEM_BYTES - 16)})
    run_phase(0, 0, smem);
    grid.sync();
#pragma unroll 1
    for (int l = 0; l < 2; ++l) {
#pragma unroll 1
        for (int ph = 1; ph <= 9; ++ph) {
            if (ph == 4) { run_phase(13, l, smem); xcd_barrier(xb); }
            if (ph == 5) { run_phase(12, l, smem); xcd_barrier(xb); }
            run_phase(ph, l, smem); xcd_barrier(xb);
#ifdef DBL_PH
            if (ph == DBL_PH) { run_phase(ph, l, smem); xcd_barrier(xb); }
#endif
        }
    }
    run_phase(10, 0, smem);
}
#else
__global__ void __launch_bounds__(512, 2) __attribute__((amdgpu_waves_per_eu(2, 2))) phase_kernel(Params p, int ph, int l) {
    extern __shared__ __attribute__((aligned(16))) unsigned char smem[];
    run_phase(ph, l, smem);
}
#endif

extern "C" void kernel_launch(void* const* d_in, const int* in_sizes, int n_in, void* d_out, int out_size, void* d_ws, size_t ws_size, hipStream_t stream) {
    (void)in_sizes; (void)n_in; (void)out_size;
    Params p{};
    p.x = (const float*)d_in[0]; p.c = (const float*)d_in[1]; p.pos = (const int*)d_in[2];
    p.g_mix = (const float*)d_in[3]; p.w_ada = (const float*)d_in[4]; p.b_ada = (const float*)d_in[5]; p.w_in = (const float*)d_in[6]; p.b_fox_f = (const float*)d_in[7];
    p.g_mla_q = (const float*)d_in[8]; p.w_mla_uq = (const float*)d_in[9]; p.g_mla_kv = (const float*)d_in[10]; p.w_mla_ukv = (const float*)d_in[11];
    p.w_o_fox = (const float*)d_in[12]; p.w_o_mla = (const float*)d_in[13]; p.w_o_sb = (const float*)d_in[14]; p.w_out = (const float*)d_in[15];
    p.g_ffn = (const float*)d_in[16]; p.w_ffn_gate = (const float*)d_in[17]; p.w_ffn_up = (const float*)d_in[18]; p.w_ffn_down = (const float*)d_in[19]; p.g_final = (const float*)d_in[20];
    p.out = (float*)d_out;
    unsigned char* ws = (unsigned char*)d_ws; size_t off = 0;
    auto take = [&](size_t bytes) { unsigned char* q = ws + off; off += (bytes + 255) & ~(size_t)255; return q; };
    p.bar = (unsigned*)take(16384);
    p.kmax = (float*)take(256);
    p.rsq = (float*)take((size_t)T_TOK * 4);
    p.rskv = (float*)take((size_t)T_TOK * 4);
    p.wt = (bf16_t*)take(2 * W_LAYER * 2);
    p.mod = (float*)take(2 * 8 * 6144 * 4);
    p.ropetab = (float*)take((size_t)T_TOK * 16 * 2 * 4);
    p.logf = (float*)take((size_t)64 * SEQ * 4);
    p.cum = (float*)take((size_t)64 * SEQ * 4);
    p.u = (bf16_t*)take((size_t)T_TOK * 1024 * 2);
    p.qf = (bf16_t*)take((size_t)T_TOK * 512 * 2);
    p.kf = (bf16_t*)take((size_t)T_TOK * 512 * 2);
    p.vtf = (bf16_t*)take((size_t)T_TOK * 512 * 2);
    p.qs = (bf16_t*)take((size_t)T_TOK * 512 * 2);
    p.ks = (bf16_t*)take((size_t)T_TOK * 512 * 2);
    p.vts = (bf16_t*)take((size_t)T_TOK * 512 * 2);
    p.qn = (bf16_t*)take((size_t)T_TOK * 512 * 2);
    p.ql = (bf16_t*)take((size_t)T_TOK * 384 * 2);
    p.kvl = (bf16_t*)take((size_t)T_TOK * 256 * 2);
    p.kr = (bf16_t*)take((size_t)T_TOK * 32 * 2);
    p.qr = (bf16_t*)take((size_t)T_TOK * 256 * 2);
    p.kn = (bf16_t*)take((size_t)T_TOK * 512 * 2);
    p.vtm = (bf16_t*)take((size_t)T_TOK * 512 * 2);
    (void)take((size_t)8 << 20);
    p.gs0 = p.ks;
    p.gs1 = p.ql;
    p.gs2 = p.ql + (size_t)T_TOK * 1024;
    p.merged = p.kf;
    p.h = p.qf;
    if (off > ws_size) { fprintf(stderr, "kernel_launch: workspace too small: need %zu, have %zu\n", off, ws_size); return; }

#if MEGA
    static int grid_blocks = 0;
    if (!grid_blocks) {
        int dev = 0, cus = 0, per_cu = 0;
        (void)hipGetDevice(&dev);
        (void)hipDeviceGetAttribute(&cus, hipDeviceAttributeMultiprocessorCount, dev);
        (void)hipFuncSetAttribute((const void*)mega_kernel, hipFuncAttributeMaxDynamicSharedMemorySize, SMEM_BYTES);
        (void)hipOccupancyMaxActiveBlocksPerMultiprocessor(&per_cu, (const void*)mega_kernel, 512, SMEM_BYTES);
        per_cu = 1;
        grid_blocks = cus * per_cu;
        grid_blocks &= ~7;
    }
    (void)hipMemsetAsync(p.bar, 0, 16384, stream);
    void* args[] = {&p};
    hipError_t e = hipLaunchCooperativeKernel((const void*)mega_kernel, dim3(grid_blocks), dim3(512), args, SMEM_BYTES, stream);
    if (e != hipSuccess) fprintf(stderr, "cooperative launch failed: %s (grid %d)\n", hipGetErrorString(e), grid_blocks);
#else
    static bool attr = false;
    if (!attr) { (void)hipFuncSetAttribute((const void*)phase_kernel, hipFuncAttributeMaxDynamicSharedMemorySize, SMEM_BYTES); attr = true; }
    const int G = 512;
    hipLaunchKernelGGL(phase_kernel, dim3(G), dim3(256), SMEM_BYTES, stream, p, 0, 0);
    for (int l = 0; l < 2; ++l)
        for (int ph = 1; ph <= 9; ++ph) hipLaunchKernelGGL(phase_kernel, dim3(G), dim3(256), SMEM_BYTES, stream, p, ph, l);
    hipLaunchKernelGGL(phase_kernel, dim3(G), dim3(256), SMEM_BYTES, stream, p, 10, 0);
#endif
}
```
